# Optimizing an MI355X kernel written in HIP

```python
import math
import jax
import jax.numpy as jnp
from jax import lax
import numpy as np

D_MODEL = 1024
BATCH = 8
SEQ = 4096
DEPTH = 2

CTX_LEN = 256
GRID_W = 64
EPS = 1e-6
NEG_INF = -1e30

RET_HEADS = 4
RET_DK = 128
RET_DV = 128
RET_CHUNK = 128
RET_ROPE_BASE = 10000.0
ATT_HEADS = 8
ATT_KV_HEADS = 2
ATT_HEAD_DIM = 64
ATT_WINDOW = 128
ATT_BLOCK = 128
ROPE_BASE = 10000.0
HY_WIDTH = 512
HY_SHORT = 3
HY_BANDS = 16
HY_EMB = 1 + 2 * HY_BANDS
HY_FFN = 64
HY_SLOW_DECAY_PCT = 1.5
HY_FAST_DECAY_PCT = 0.3
HY_DECAY_TARGET = 1e-2
N_BRANCH = 3
BRANCH_WIDTH = 512
N_EXPERTS = 32
TOP_K = 4
D_FF = 1024
SWIGLU_ALPHA = 1.702
SWIGLU_LIMIT = 7.0

RET_W = RET_HEADS * RET_DK
RET_VW = RET_HEADS * RET_DV
ATT_QW = ATT_HEADS * ATT_HEAD_DIM
ATT_KW = ATT_KV_HEADS * ATT_HEAD_DIM
HY_IN = 3 * HY_WIDTH
GATE_W = N_BRANCH * D_MODEL
IN_COLS = 2 * RET_W + 2 * RET_VW + ATT_QW + 2 * ATT_KW + HY_IN + GATE_W
IN_SPLITS = (RET_W,
             2 * RET_W,
             2 * RET_W + RET_VW,
             2 * RET_W + 2 * RET_VW,
             2 * RET_W + 2 * RET_VW + ATT_QW,
             2 * RET_W + 2 * RET_VW + ATT_QW + ATT_KW,
             2 * RET_W + 2 * RET_VW + ATT_QW + 2 * ATT_KW,
             2 * RET_W + 2 * RET_VW + ATT_QW + 2 * ATT_KW + HY_IN)

kernel_name = "hybrid_parallel_mixers_moe_dit_trunk"


def _rms_norm(x, g):
    xf = x.astype(jnp.float32)
    xf = xf * lax.rsqrt(jnp.mean(xf * xf, axis=-1, keepdims=True) + EPS)
    return xf.astype(x.dtype) * g


def _modulate(x, g, shift, scale):
    return _rms_norm(x, g) * (1.0 + scale) + shift


def _rope(x, pos, inv_freq):
    n = x.shape[-1] // 2
    ang = pos[:, None] * inv_freq[None, :]
    cos = jnp.cos(ang)[None, :, None, :]
    sin = jnp.sin(ang)[None, :, None, :]
    x1 = x[..., :n].astype(jnp.float32)
    x2 = x[..., n:].astype(jnp.float32)
    return jnp.concatenate([x1 * cos - x2 * sin, x1 * sin + x2 * cos], axis=-1).astype(x.dtype)


def _rope_axial(x, rows, cols):
    half = x.shape[-1] // 2
    nf = half // 2
    inv = 1.0 / (ROPE_BASE ** (jnp.arange(nf, dtype=jnp.float32) / nf))
    return jnp.concatenate([_rope(x[..., :half], rows, inv), _rope(x[..., half:], cols, inv)], axis=-1)


def _retention_dir(q, k, v, log_g, s0, inclusive):
    B, L, H, dk = q.shape
    dv = v.shape[-1]
    C = RET_CHUNK
    n = L // C
    qc = q.reshape(B, n, C, H, dk)
    kc = k.reshape(B, n, C, H, dk)
    vc = v.reshape(B, n, C, H, dv)
    idx = jnp.arange(C, dtype=jnp.float32)
    diff = idx[:, None] - idx[None, :]
    keep = (diff >= 0) if inclusive else (diff > 0)
    dmat = jnp.where(keep[None], jnp.exp(log_g[:, None, None] * jnp.maximum(diff, 0.0)[None]), 0.0)
    scores = jnp.einsum('bnihd,bnjhd->bnhij', qc, kc) * dmat
    inner = jnp.einsum('bnhij,bnjhe->bnihe', scores, vc)
    w_state = jnp.exp(log_g[None, :] * (C - 1.0 - idx)[:, None])
    kv = jnp.einsum('bnjhd,jh,bnjhe->nbhde', kc, w_state, vc)
    chunk_decay = jnp.exp(log_g * C)[None, :, None, None]

    def step(s, kv_c):
        return chunk_decay * s + kv_c, s

    s_fin, s_prev = lax.scan(step, s0, kv)
    w_read = jnp.exp(log_g[None, :] * (idx + 1.0)[:, None])
    cross = jnp.einsum('bnihd,ih,nbhde->bnihe', qc, w_read, s_prev)
    return (inner + cross).reshape(B, L, H, dv), s_fin


def _retention_bidir(q, k, v, log_g, s0_fwd, s0_bwd):
    y_f, s_f = _retention_dir(q, k, v, log_g[0], s0_fwd, True)
    y_b, s_b = _retention_dir(q[:, ::-1], k[:, ::-1], v[:, ::-1], log_g[1], s0_bwd, False)
    return y_f + y_b[:, ::-1], s_f, s_b


def _head_rms(y):
    y = y * lax.rsqrt(jnp.mean(y * y, axis=-1, keepdims=True) + EPS)
    return y.reshape(y.shape[0], y.shape[1], -1)


def _softmax_with_sink(s, sink):
    G = sink.shape[0] // ATT_KV_HEADS
    sk = sink.astype(jnp.float32).reshape(1, ATT_KV_HEADS, G, 1, 1)
    m = jnp.maximum(jnp.max(s, axis=-1, keepdims=True), sk)
    e = jnp.exp(s - m)
    return e / (jnp.sum(e, axis=-1, keepdims=True) + jnp.exp(sk - m))


def _attn_latent(q, k, v, k_ctx, v_ctx, sink):
    B, L, H, d = q.shape
    G = H // ATT_KV_HEADS
    nb = L // ATT_BLOCK
    span = ATT_BLOCK + 2 * ATT_WINDOW
    Lc = k_ctx.shape[1]
    qg = q.reshape(B, L, ATT_KV_HEADS, G, d) * (d ** -0.5)
    pad = ((0, 0), (ATT_WINDOW, ATT_WINDOW), (0, 0), (0, 0))
    k_pad = jnp.pad(k, pad)
    v_pad = jnp.pad(v, pad)
    ctx_valid = jnp.ones((ATT_BLOCK, Lc), dtype=bool)

    def one_block(bi):
        start = bi * ATT_BLOCK
        qb = lax.dynamic_slice_in_dim(qg, start, ATT_BLOCK, axis=1)
        kb = jnp.concatenate([lax.dynamic_slice_in_dim(k_pad, start, span, axis=1), k_ctx], axis=1)
        vb = jnp.concatenate([lax.dynamic_slice_in_dim(v_pad, start, span, axis=1), v_ctx], axis=1)
        s = jnp.einsum('bqhgd,bkhd->bhgqk', qb, kb).astype(jnp.float32)
        qpos = start + jnp.arange(ATT_BLOCK)
        kpos = start - ATT_WINDOW + jnp.arange(span)
        valid = ((kpos[None, :] >= 0) & (kpos[None, :] < L)
                 & (jnp.abs(qpos[:, None] - kpos[None, :]) <= ATT_WINDOW))
        valid = jnp.concatenate([valid, ctx_valid], axis=1)
        p = _softmax_with_sink(jnp.where(valid, s, NEG_INF), sink)
        o = jnp.einsum('bhgqk,bkhd->bqhgd', p.astype(vb.dtype), vb)
        return o.reshape(B, ATT_BLOCK, H * d)

    out = lax.map(one_block, jnp.arange(nb))
    return jnp.transpose(out, (1, 0, 2, 3)).reshape(B, L, H * d)


def _attn_context(q, k, v, sink):
    B, Lc, H, d = q.shape
    G = H // ATT_KV_HEADS
    qg = q.reshape(B, Lc, ATT_KV_HEADS, G, d) * (d ** -0.5)
    s = jnp.einsum('bqhgd,bkhd->bhgqk', qg, k).astype(jnp.float32)
    p = _softmax_with_sink(s, sink)
    o = jnp.einsum('bhgqk,bkhd->bqhgd', p.astype(v.dtype), v)
    return o.reshape(B, Lc, H * d)


def _short_conv(u, w, b):
    L = u.shape[1]
    p = HY_SHORT // 2
    up = jnp.pad(u, ((0, 0), (p, HY_SHORT - 1 - p), (0, 0)))
    y = b
    for j in range(HY_SHORT):
        y = y + up[:, j:j + L] * w[j]
    return y


def _hyena_filter(L, w1, b1, f1, w2, b2, f2, w3):
    f32 = jnp.float32
    t = jnp.linspace(0.0, 1.0, L, dtype=f32)[:, None]
    bands = jnp.linspace(1e-4, HY_BANDS - 1, HY_BANDS, dtype=f32)
    ang = (2.0 * math.pi / L) * jnp.arange(L, dtype=f32)[:, None] * bands[None, :]
    z = jnp.concatenate([t, jnp.cos(ang), -jnp.sin(ang)], axis=-1)
    h = jnp.sin(f1.astype(f32) * (z @ w1.astype(f32) + b1.astype(f32)))
    h = jnp.sin(f2.astype(f32) * (h @ w2.astype(f32) + b2.astype(f32)))
    h = h @ w3.astype(f32)
    deltas = jnp.abs(jnp.linspace(math.log(HY_DECAY_TARGET) / HY_SLOW_DECAY_PCT,
                                  math.log(HY_DECAY_TARGET) / HY_FAST_DECAY_PCT, HY_WIDTH, dtype=f32))
    decay = jnp.exp(-t * deltas[None, :])
    h_fwd = h[:, :HY_WIDTH] * decay
    h_bwd = h[:, HY_WIDTH:] * decay
    l1 = jnp.sum(jnp.abs(h_fwd), axis=0) + jnp.sum(jnp.abs(h_bwd[1:]), axis=0)
    h_fwd = h_fwd / l1
    h_bwd = h_bwd / l1
    filt2l = jnp.concatenate([h_fwd, jnp.zeros((1, HY_WIDTH), f32), h_bwd[:0:-1]], axis=0)
    return jnp.fft.rfft(filt2l, axis=0)


def _long_conv(u, filt_f):
    L = u.shape[1]
    uf = jnp.fft.rfft(u.astype(jnp.float32), n=2 * L, axis=1)
    y = jnp.fft.irfft(uf * filt_f[None], n=2 * L, axis=1)[:, :L]
    return y.astype(u.dtype)


def _hyena_seq(u, conv_w, conv_b, skip, filt_params):
    L = u.shape[1]
    u = _short_conv(u, conv_w, conv_b)
    x0, x1, v = jnp.split(u, 3, axis=-1)
    z = x1 * v
    z = _long_conv(z, _hyena_filter(L, *filt_params)) + skip * z
    return x0 * z


def _merge(ret, att, hy, gate_cols, w_branch, b_gate, w_out):
    g = jax.nn.sigmoid(gate_cols + b_gate)
    g_r, g_a, g_h = jnp.split(g, N_BRANCH, axis=-1)
    m = g_r * (ret @ w_branch[0]) + g_a * (att @ w_branch[1]) + g_h * (hy @ w_branch[2])
    return m @ w_out


def _moe(h, router_w, router_b, w1, b1, w2, b2):
    shp = h.shape
    t = h.reshape(-1, shp[-1])
    logits = (t @ router_w + router_b).astype(jnp.float32)
    top_v, top_i = lax.top_k(logits, TOP_K)
    wts = jax.nn.softmax(top_v, axis=-1)
    combine = jnp.sum(jax.nn.one_hot(top_i, N_EXPERTS, dtype=jnp.float32) * wts[..., None], axis=1).astype(t.dtype)
    y = jnp.zeros_like(t)
    for e in range(N_EXPERTS):
        hh = t @ w1[e] + b1[e]
        glu = jnp.minimum(hh[:, :D_FF], SWIGLU_LIMIT)
        lin = jnp.clip(hh[:, D_FF:], -SWIGLU_LIMIT, SWIGLU_LIMIT)
        act = glu * jax.nn.sigmoid(SWIGLU_ALPHA * glu) * (lin + 1.0)
        y = y + combine[:, e:e + 1] * (act @ w2[e] + b2[e])
    return y.reshape(shp)


def _layer(x, ctx, c, c_ctx, w_mod, b_mod, norm1_g, w_in, ret_decay_logit, attn_sink,
           hy_conv_w, hy_conv_b, hy_filter, hy_skip, w_branch, b_gate, w_out, norm2_g,
           router_w, router_b, moe_w1, moe_b1, moe_w2, moe_b2, tpos, rows, cols, last):
    B, L, _ = x.shape
    Lc = ctx.shape[1]
    mod_l = (jax.nn.silu(c) @ w_mod + b_mod)[:, None, :]
    mod_c = (jax.nn.silu(c_ctx) @ w_mod + b_mod)[None, None, :]
    sh1_l, sc1_l, g1_l, sh2_l, sc2_l, g2_l = jnp.split(mod_l, 6, axis=-1)
    sh1_c, sc1_c, g1_c, sh2_c, sc2_c, g2_c = jnp.split(mod_c, 6, axis=-1)

    pl = _modulate(x, norm1_g, sh1_l, sc1_l) @ w_in
    pc = _modulate(ctx, norm1_g, sh1_c, sc1_c) @ w_in
    rq_l, rk_l, rv_l, rg_l, aq_l, ak_l, av_l, hu_l, mg_l = jnp.split(pl, IN_SPLITS, axis=-1)
    rq_c, rk_c, rv_c, rg_c, aq_c, ak_c, av_c, hu_c, mg_c = jnp.split(pc, IN_SPLITS, axis=-1)

    f32 = jnp.float32
    log_g = jax.nn.log_sigmoid(ret_decay_logit.astype(f32))
    inv_r = 1.0 / (RET_ROPE_BASE ** jnp.linspace(0.0, 1.0, RET_DK // 2, dtype=f32))
    k_scale = RET_DK ** -0.5
    q_rl = _rope(rq_l.reshape(B, L, RET_HEADS, RET_DK), tpos, inv_r).astype(f32)
    k_rl = (_rope(rk_l.reshape(B, L, RET_HEADS, RET_DK), tpos, inv_r) * k_scale).astype(f32)
    v_rl = rv_l.reshape(B, L, RET_HEADS, RET_DV).astype(f32)
    q_rc = rq_c.reshape(B, Lc, RET_HEADS, RET_DK).astype(f32)
    k_rc = (rk_c.reshape(B, Lc, RET_HEADS, RET_DK) * k_scale).astype(f32)
    v_rc = rv_c.reshape(B, Lc, RET_HEADS, RET_DV).astype(f32)
    s0 = jnp.zeros((B, RET_HEADS, RET_DK, RET_DV), f32)
    y_rc, s_f, s_b = _retention_bidir(q_rc, k_rc, v_rc, log_g, s0, s0)
    y_rl, _, _ = _retention_bidir(q_rl, k_rl, v_rl, log_g, s_f, s_b)
    ret_l = _head_rms(y_rl).astype(x.dtype) * jax.nn.silu(rg_l)

    q_al = _rope_axial(aq_l.reshape(B, L, ATT_HEADS, ATT_HEAD_DIM), rows, cols)
    k_al = _rope_axial(ak_l.reshape(B, L, ATT_KV_HEADS, ATT_HEAD_DIM), rows, cols)
    v_al = av_l.reshape(B, L, ATT_KV_HEADS, ATT_HEAD_DIM)
    k_ac = ak_c.reshape(B, Lc, ATT_KV_HEADS, ATT_HEAD_DIM)
    v_ac = av_c.reshape(B, Lc, ATT_KV_HEADS, ATT_HEAD_DIM)
    att_l = _attn_latent(q_al, k_al, v_al, k_ac, v_ac, attn_sink)

    hy_l = _hyena_seq(hu_l, hy_conv_w, hy_conv_b, hy_skip, hy_filter)

    x_new = x + g1_l * _merge(ret_l, att_l, hy_l, mg_l, w_branch, b_gate, w_out)
    x_new = x_new + g2_l * _moe(_modulate(x_new, norm2_g, sh2_l, sc2_l),
                                router_w, router_b, moe_w1, moe_b1, moe_w2, moe_b2)
    if last:
        return x_new, ctx

    ret_c = _head_rms(y_rc).astype(ctx.dtype) * jax.nn.silu(rg_c)
    att_c = _attn_context(aq_c.reshape(B, Lc, ATT_HEADS, ATT_HEAD_DIM), k_ac, v_ac, attn_sink)
    hy_c = _hyena_seq(hu_c, hy_conv_w, hy_conv_b, hy_skip, hy_filter)
    ctx_new = ctx + g1_c * _merge(ret_c, att_c, hy_c, mg_c, w_branch, b_gate, w_out)
    ctx_new = ctx_new + g2_c * _moe(_modulate(ctx_new, norm2_g, sh2_c, sc2_c),
                                    router_w, router_b, moe_w1, moe_b1, moe_w2, moe_b2)
    return x_new, ctx_new


def setup_inputs(seed: int = 0) -> dict:
    key = jax.random.key(seed)
    ks = jax.random.split(key, 32)
    D = D_MODEL

    def nrm(k, shape, scale):
        return jax.random.normal(k, shape, dtype=jnp.float32) * scale

    gam = 1.0 - 2.0 ** (-5.0 - jnp.arange(RET_HEADS, dtype=jnp.float32))
    decay_logit0 = jnp.log(gam) - jnp.log1p(-gam)
    return {
        "x": nrm(ks[0], (BATCH, SEQ, D), 1.0),
        "c": nrm(ks[1], (BATCH, D), 1.0),
        "ctx": nrm(ks[2], (BATCH, CTX_LEN, D), 1.0),
        "c_ctx": nrm(ks[3], (D,), 1.0),
        "w_mod": nrm(ks[4], (DEPTH, D, 6 * D), 0.5 * D ** -0.5),
        "b_mod": nrm(ks[5], (DEPTH, 6 * D), 0.01),
        "norm1_g": 1.0 + nrm(ks[6], (DEPTH, D), 0.05),
        "w_in": nrm(ks[7], (DEPTH, D, IN_COLS), D ** -0.5),
        "ret_decay_logit": decay_logit0[None, None, :] + nrm(ks[8], (DEPTH, 2, RET_HEADS), 0.1),
        "attn_sink": nrm(ks[9], (DEPTH, ATT_HEADS), 0.5),
        "hy_conv_w": nrm(ks[10], (DEPTH, HY_SHORT, HY_IN), HY_SHORT ** -0.5),
        "hy_conv_b": nrm(ks[11], (DEPTH, HY_IN), 0.01),
        "hy_w1": nrm(ks[12], (DEPTH, HY_EMB, HY_FFN), HY_EMB ** -0.5),
        "hy_b1": nrm(ks[13], (DEPTH, HY_FFN), 0.1),
        "hy_freq1": 1.0 + nrm(ks[14], (DEPTH, HY_FFN), 0.05),
        "hy_w2": nrm(ks[15], (DEPTH, HY_FFN, HY_FFN), HY_FFN ** -0.5),
        "hy_b2": nrm(ks[16], (DEPTH, HY_FFN), 0.1),
        "hy_freq2": 1.0 + nrm(ks[17], (DEPTH, HY_FFN), 0.05),
        "hy_w3": nrm(ks[18], (DEPTH, HY_FFN, 2 * HY_WIDTH), HY_FFN ** -0.5),
        "hy_skip": nrm(ks[19], (DEPTH, HY_WIDTH), 0.5),
        "w_branch": nrm(ks[20], (DEPTH, N_BRANCH, BRANCH_WIDTH, D), BRANCH_WIDTH ** -0.5),
        "b_gate": nrm(ks[21], (DEPTH, GATE_W), 0.01),
        "w_out": nrm(ks[22], (DEPTH, D, D), D ** -0.5),
        "norm2_g": 1.0 + nrm(ks[23], (DEPTH, D), 0.05),
        "router_w": nrm(ks[24], (DEPTH, D, N_EXPERTS), D ** -0.5),
        "router_b": nrm(ks[25], (DEPTH, N_EXPERTS), 0.01),
        "moe_w1": nrm(ks[26], (DEPTH, N_EXPERTS, D, 2 * D_FF), D ** -0.5),
        "moe_b1": nrm(ks[27], (DEPTH, N_EXPERTS, 2 * D_FF), 0.01),
        "moe_w2": nrm(ks[28], (DEPTH, N_EXPERTS, D_FF, D), D_FF ** -0.5),
        "moe_b2": nrm(ks[29], (DEPTH, N_EXPERTS, D), 0.01),
        "final_norm_g": 1.0 + nrm(ks[30], (D,), 0.05),
    }


def reference(x, c, ctx, c_ctx, w_mod, b_mod, norm1_g, w_in, ret_decay_logit, attn_sink,
              hy_conv_w, hy_conv_b, hy_w1, hy_b1, hy_freq1, hy_w2, hy_b2, hy_freq2, hy_w3,
              hy_skip, w_branch, b_gate, w_out, norm2_g, router_w, router_b,
              moe_w1, moe_b1, moe_w2, moe_b2, final_norm_g):
    L = x.shape[1]
    ROWS = L // GRID_W
    tpos = jnp.arange(L, dtype=jnp.float32)
    rows = jnp.repeat(jnp.arange(ROWS, dtype=jnp.float32), GRID_W)
    cols = jnp.tile(jnp.arange(GRID_W, dtype=jnp.float32), ROWS)
    for l in range(DEPTH):
        hy_filter = (hy_w1[l], hy_b1[l], hy_freq1[l], hy_w2[l], hy_b2[l], hy_freq2[l], hy_w3[l])
        x, ctx = _layer(x, ctx, c, c_ctx, w_mod[l], b_mod[l], norm1_g[l], w_in[l],
                        ret_decay_logit[l], attn_sink[l], hy_conv_w[l], hy_conv_b[l],
                        hy_filter, hy_skip[l], w_branch[l], b_gate[l], w_out[l], norm2_g[l],
                        router_w[l], router_b[l], moe_w1[l], moe_b1[l], moe_w2[l], moe_b2[l],
                        tpos, rows, cols, l == DEPTH - 1)
    return _rms_norm(x, final_norm_g)
```

```cpp
#include <hip/hip_runtime.h>
#include <cstdio>
#include <cstdint>
#define MK_ONE_LAUNCH 0
namespace pg8 {
#define PG8_LAS __attribute__((address_space(3)))
typedef unsigned short bf16_t;
typedef short bf16x8 __attribute__((ext_vector_type(8)));
typedef float f32x4 __attribute__((ext_vector_type(4)));
typedef unsigned u32x4 __attribute__((ext_vector_type(4)));
constexpr int BM = 256, BK = 64, HALF = 128, HTB = HALF * BK * 2  , STAGE_BYTES = 8 * HTB, NXCD = 8, WGM = 8;

__host__ __device__ __forceinline__ int lds_byte(int r, int c) { const int st = (r >> 4) * 2 + (c >> 5), rr = r & 15, cc = c & 31, ob = rr * 64 + cc * 2; return st * 1024 + (ob ^ (((ob >> 9) & 1) << 5)); }
__host__ __device__ __forceinline__ void stage_rc(int b, int& R, int& C) { const int st = b / 1024, sb = b % 1024, swz = sb ^ (((sb >> 9) & 1) << 5); R = (st >> 1) * 16 + swz / 64; C = (st & 1) * 32 + (swz % 64) / 2; }
__host__ __device__ __forceinline__ int perm32(int rho) { const int n = rho >> 4, i = rho & 15; return 8 * (i >> 2) + 4 * n + (i & 3); }

struct Unit { int pm, pn; };
struct Gemm { const bf16_t* A; const bf16_t* Bt; int M, N, K; };

struct StaticOrder {
    int nM, nN, nwg, G, c;
    __host__ __device__ void init(int M, int N, int G_, int c_) { nM = M / BM; nN = N / BM; nwg = nM * nN; G = G_; c = c_; }
    __host__ __device__ bool next(int i, Unit& u) const {
        const long L = (long)i * G + c; if (L >= nwg) return false;
        int wgid = (int)L; { const int q = nwg / NXCD, r = nwg % NXCD, xcd = wgid % NXCD, off = wgid / NXCD; wgid = (xcd < r ? xcd * (q + 1) : r * (q + 1) + (xcd - r) * q) + off; }
        const int nig = WGM * nN, gid = wgid / nig, fm = gid * WGM, gsz = (nM - fm) < WGM ? (nM - fm) : WGM;
        u.pm = fm + ((wgid % nig) % gsz); u.pn = (wgid % nig) / gsz; return true;
    }
    __device__ __forceinline__ void a_ready(const Unit&) const {}
    __device__ __forceinline__ void done(const Unit&) const {}
};

__device__ __forceinline__ unsigned cvt_pk_bf16(float lo, float hi) { unsigned r; asm volatile("v_cvt_pk_bf16_f32 %0, %1, %2" : "=v"(r) : "v"(lo), "v"(hi)); return r; }
template <class Epi, class Sched, bool ALIGN_EPI = false, bool SP2 = false>
__device__ __forceinline__ void gemm_phase(PG8_LAS unsigned char* lds, const Gemm g, const Sched& S, const Epi& E) {
    const int tid = threadIdx.x, wid = __builtin_amdgcn_readfirstlane(tid >> 6), lane = tid & 63, wr = wid >> 2, wc = wid & 3, fr = lane & 15, fq = lane >> 4;
    const int K = g.K, nt = K / BK;
    unsigned voffA[2], voffB[2];
#pragma unroll
    for (int i = 0; i < 2; ++i) { int R, C; stage_rc(tid * 16 + i * 8192, R, C); const int Rb = Epi::PERM ? ((R & ~31) + perm32(R & 31)) : R;
        voffA[i] = (unsigned)(R * K + C) * 2u; voffB[i] = (unsigned)(Rb * K + C) * 2u; }
    const size_t kstep = (size_t)(BK * 2);
    const size_t hstep = (size_t)HALF * K * 2;
    const size_t tstep = 2 * hstep;
    const unsigned ldsw = (unsigned)wid * 1024u;
    const int aoff = lds_byte(wr * 64 + fr, fq * 8), boff = lds_byte(wc * 32 + fr, fq * 8);
#define PG8_SA(b, h) (((b) * 2 + (h)) * HTB)
#define PG8_SB(b, h) ((4 + (b) * 2 + (h)) * HTB)
#define PG8_STAGE(bufoff, gbase, voff) do { _Pragma("unroll") for (int _i = 0; _i < 2; ++_i) \
        __builtin_amdgcn_global_load_lds((const unsigned*)((const char*)(gbase) + (voff)[_i]), (PG8_LAS unsigned*)(lds + (bufoff) + ldsw + _i * 8192), 16, 0, 0); } while (0)
#define PG8_LDA(dst, b, h) do { _Pragma("unroll") for (int m = 0; m < 4; ++m) _Pragma("unroll") for (int k = 0; k < 2; ++k) dst[m][k] = *(const PG8_LAS bf16x8*)(lds + PG8_SA(b, h) + aoff + m * 2048 + k * 1024); } while (0)
#define PG8_LDB(dst, b, h) do { _Pragma("unroll") for (int n = 0; n < 2; ++n) _Pragma("unroll") for (int k = 0; k < 2; ++k) dst[n][k] = *(const PG8_LAS bf16x8*)(lds + PG8_SB(b, h) + boff + n * 2048 + k * 1024); } while (0)
#define PG8_MMA(ai, bj, At, Bt) do { __builtin_amdgcn_s_setprio(1); _Pragma("unroll") for (int m = 0; m < 4; ++m) _Pragma("unroll") for (int n = 0; n < 2; ++n) _Pragma("unroll") for (int k = 0; k < 2; ++k) \
        acc[ai][bj][m][n] = __builtin_amdgcn_mfma_f32_16x16x32_bf16(Bt[n][k], At[m][k], acc[ai][bj][m][n], 0, 0, 0); __builtin_amdgcn_s_setprio(0); } while (0)
#define PG8_WAIT_V(n) asm volatile("s_waitcnt vmcnt(" #n ")" ::: "memory")
#define PG8_WAIT_L(n) asm volatile("s_waitcnt lgkmcnt(" #n ")" ::: "memory")
#define PG8_BAR __builtin_amdgcn_s_barrier()
#define PG8_SCHED __builtin_amdgcn_sched_barrier(0)
    Unit cur, nxt; int ui = 0;
    if (!S.next(0, cur)) return;
    f32x4 acc[2][2][4][2];
#pragma unroll
    for (int a = 0; a < 2; ++a)
#pragma unroll
        for (int b = 0; b < 2; ++b)
#pragma unroll
            for (int m = 0; m < 4; ++m)
#pragma unroll
                for (int n = 0; n < 2; ++n) acc[a][b][m][n] = (f32x4){0.f, 0.f, 0.f, 0.f};
    bf16x8 At[4][2], B0[2][2], B1[2][2];
    const char* cA = (const char*)g.A + (size_t)cur.pm * tstep; const char* cB = (const char*)g.Bt + (size_t)cur.pn * tstep;
    S.a_ready(cur);
    if constexpr (SP2) {
        PG8_STAGE(PG8_SB(0, 0), cB, voffB); PG8_STAGE(PG8_SB(0, 1), cB + hstep, voffB); PG8_STAGE(PG8_SA(0, 0), cA, voffA); PG8_STAGE(PG8_SA(0, 1), cA + hstep, voffA);
        if (wr == 1) PG8_BAR;
        PG8_WAIT_V(2); PG8_BAR;
        PG8_STAGE(PG8_SB(1, 0), cB + kstep, voffB); PG8_STAGE(PG8_SA(1, 0), cA + kstep, voffA); PG8_STAGE(PG8_SB(1, 1), cB + hstep + kstep, voffB);
        PG8_WAIT_V(6); PG8_BAR;
    } else {
        PG8_STAGE(PG8_SB(0, 0), cB, voffB); PG8_STAGE(PG8_SA(0, 0), cA, voffA); PG8_STAGE(PG8_SB(0, 1), cB + hstep, voffB); PG8_STAGE(PG8_SA(0, 1), cA + hstep, voffA);
        if (wr == 1) PG8_BAR;
        PG8_WAIT_V(4); PG8_BAR;
        PG8_STAGE(PG8_SB(1, 0), cB + kstep, voffB); PG8_STAGE(PG8_SA(1, 0), cA + kstep, voffA); PG8_STAGE(PG8_SB(1, 1), cB + hstep + kstep, voffB);
        PG8_WAIT_V(6); PG8_BAR;
    }
    for (;;) {
        const bool has_next = S.next(ui + 1, nxt);
        const char* nA = has_next ? (const char*)g.A + (size_t)nxt.pm * tstep : cA; const char* nB = has_next ? (const char*)g.Bt + (size_t)nxt.pn * tstep : cB;
        for (int t = 0; t < nt; t += 2) {
            const bool last = (t == nt - 2);
            const char* a1 = cA + (size_t)(t + 1) * kstep;
            const char* a2 = last ? nA : cA + (size_t)(t + 2) * kstep; const char* b2 = last ? nB : cB + (size_t)(t + 2) * kstep;
            const char* a3 = a2 + kstep; const char* b3 = b2 + kstep;
            if (last && has_next) S.a_ready(nxt);
            if constexpr (SP2) {
            PG8_LDB(B0, 0, 0); PG8_LDB(B1, 0, 1); PG8_SCHED; PG8_LDA(At, 0, 0); PG8_STAGE(PG8_SA(1, 1), a1 + hstep, voffA);
            PG8_WAIT_V(8); PG8_WAIT_L(0); PG8_BAR; PG8_MMA(0, 0, At, B0); PG8_MMA(0, 1, At, B1); PG8_BAR; PG8_SCHED;
            PG8_LDA(At, 0, 1); PG8_STAGE(PG8_SB(0, 0), b2, voffB); PG8_STAGE(PG8_SB(0, 1), b2 + hstep, voffB); PG8_STAGE(PG8_SA(0, 0), a2, voffA);
            PG8_WAIT_V(8); PG8_WAIT_L(0); PG8_BAR; PG8_MMA(1, 0, At, B0); PG8_MMA(1, 1, At, B1); PG8_BAR; PG8_SCHED;
            PG8_LDB(B0, 1, 0); PG8_LDB(B1, 1, 1); PG8_SCHED; PG8_LDA(At, 1, 0); PG8_STAGE(PG8_SA(0, 1), a2 + hstep, voffA);
            PG8_WAIT_V(8); PG8_WAIT_L(0); PG8_BAR; PG8_MMA(0, 0, At, B0); PG8_MMA(0, 1, At, B1); PG8_BAR; PG8_SCHED;
            PG8_LDA(At, 1, 1); PG8_STAGE(PG8_SB(1, 0), b3, voffB); PG8_STAGE(PG8_SB(1, 1), b3 + hstep, voffB); PG8_STAGE(PG8_SA(1, 0), a3, voffA);
            PG8_WAIT_V(8); PG8_WAIT_L(0); PG8_BAR; PG8_MMA(1, 0, At, B0); PG8_MMA(1, 1, At, B1); PG8_BAR; PG8_SCHED;
            } else {
            PG8_LDB(B0, 0, 0); PG8_SCHED; PG8_LDA(At, 0, 0); PG8_STAGE(PG8_SA(1, 1), a1 + hstep, voffA);
            PG8_WAIT_L(8); PG8_BAR; PG8_WAIT_L(0); PG8_MMA(0, 0, At, B0); PG8_BAR; PG8_SCHED;
            PG8_LDB(B1, 0, 1); PG8_STAGE(PG8_SB(0, 0), b2, voffB);
            PG8_BAR; PG8_WAIT_L(0); PG8_MMA(0, 1, At, B1); PG8_BAR;
            PG8_LDA(At, 0, 1); PG8_STAGE(PG8_SA(0, 0), a2, voffA);
            PG8_BAR; PG8_WAIT_L(0); PG8_MMA(1, 0, At, B0); PG8_BAR; PG8_SCHED;
            PG8_STAGE(PG8_SB(0, 1), b2 + hstep, voffB);
            PG8_WAIT_V(6); PG8_BAR; PG8_MMA(1, 1, At, B1); PG8_BAR;
            PG8_LDB(B0, 1, 0); PG8_SCHED; PG8_LDA(At, 1, 0); PG8_STAGE(PG8_SA(0, 1), a2 + hstep, voffA);
            PG8_WAIT_L(8); PG8_BAR; PG8_WAIT_L(0); PG8_MMA(0, 0, At, B0); PG8_BAR; PG8_SCHED;
            PG8_LDB(B1, 1, 1); PG8_STAGE(PG8_SB(1, 0), b3, voffB);
            PG8_BAR; PG8_WAIT_L(0); PG8_MMA(0, 1, At, B1); PG8_BAR;
            PG8_LDA(At, 1, 1); PG8_STAGE(PG8_SA(1, 0), a3, voffA);
            PG8_BAR; PG8_WAIT_L(0); PG8_MMA(1, 0, At, B0); PG8_BAR; PG8_SCHED;
            PG8_STAGE(PG8_SB(1, 1), b3 + hstep, voffB);
            PG8_WAIT_V(6); PG8_BAR; PG8_MMA(1, 1, At, B1); PG8_BAR;
            }
        }
        if constexpr (ALIGN_EPI) { if (wr == 0) PG8_BAR; }
        if constexpr (!Epi::AFTER_DRAIN) { E(acc, cur, wr, wc, fr, fq); S.done(cur); }
        if (!has_next) break;
#pragma unroll
        for (int a = 0; a < 2; ++a)
#pragma unroll
            for (int b = 0; b < 2; ++b)
#pragma unroll
                for (int m = 0; m < 4; ++m)
#pragma unroll
                    for (int n = 0; n < 2; ++n) acc[a][b][m][n] = (f32x4){0.f, 0.f, 0.f, 0.f};
        cur = nxt; cA = nA; cB = nB; ++ui;
        if constexpr (ALIGN_EPI) { if (wr == 1) PG8_BAR; }
    }
    PG8_WAIT_V(0);
    if constexpr (!ALIGN_EPI) { if (wr == 0) PG8_BAR; }
    PG8_BAR;
    if constexpr (Epi::AFTER_DRAIN) { E.fused(acc, cur, wr, wc, fr, fq, lds, wid, lane); S.done(cur); }
#undef PG8_SA
#undef PG8_SB
#undef PG8_STAGE
#undef PG8_LDA
#undef PG8_LDB
#undef PG8_MMA
#undef PG8_WAIT_V
#undef PG8_WAIT_L
#undef PG8_BAR
#undef PG8_SCHED
}
}
#define XB_TMO      128
#define XB_XCNT(j)  (256  + 64 * (j))
#define XB_XSUB(j)  (1280 + 64 * (j))
#define XB_XGEN(j)  (2304 + 64 * (j))
#define XB_TOP      3328
#define XB_TOPGEN   3392
#define XCD_BAR_WORDS 3456
#define XB_SPIN_CAP (1u << 18)
#define LAS __attribute__((address_space(3)))

__device__ __forceinline__ unsigned xb_ld(unsigned* p)              { return __hip_atomic_load(p, __ATOMIC_RELAXED, __HIP_MEMORY_SCOPE_AGENT); }
__device__ __forceinline__ unsigned xb_add(unsigned* p, unsigned v) { return __hip_atomic_fetch_add(p, v, __ATOMIC_RELAXED, __HIP_MEMORY_SCOPE_AGENT); }
__device__ __forceinline__ unsigned xb_xcc_id() { return (unsigned)__builtin_amdgcn_s_getreg((3 << 11) | 20) & 0xFu; }
#define XB_SPIN(cond, bar) do { unsigned _sp = 0; while (cond) { __builtin_amdgcn_s_sleep(1); \
    if ((++_sp & 255u) == 0u) { if (xb_ld(&(bar)[XB_TMO])) break; if (_sp > XB_SPIN_CAP) { atomicAdd(&(bar)[XB_TMO], 1u); break; } } } } while (0)

struct XcdBarrier {
    unsigned* bar; unsigned x;
    volatile LAS unsigned* st;
};

__device__ __forceinline__ XcdBarrier xcd_barrier_post(unsigned* bar, volatile LAS unsigned* st) {
    XcdBarrier b; b.bar = bar; b.x = xb_xcc_id(); b.st = st;
    if (threadIdx.x == 0) (void)xb_add(&bar[XB_XCNT(b.x)], 1u);
    return b;
}
__device__ __forceinline__ void xcd_barrier_complete(unsigned* bar, unsigned x, unsigned& nloc, unsigned& nx) {
    const unsigned G = gridDim.x * gridDim.y * gridDim.z;
    unsigned sum, cnt, mine, sp = 0u;
    for (;;) {
        sum = 0u; cnt = 0u; mine = 0u;
#pragma unroll
        for (unsigned j = 0; j < 16; ++j) { const unsigned c = xb_ld(&bar[XB_XCNT(j)]); sum += c; cnt += (c > 0u) ? 1u : 0u; mine = (j == x) ? c : mine; }
        if (sum == G) break;
        __builtin_amdgcn_s_sleep(1);
        if ((++sp & 255u) == 0u) { if (xb_ld(&bar[XB_TMO])) break; if (sp > XB_SPIN_CAP) { atomicAdd(&bar[XB_TMO], 1u); break; } }
    }
    nloc = mine > 0u ? mine : 1u; nx = cnt > 0u ? cnt : 1u;
}

__device__ __forceinline__ void xcd_barrier(const XcdBarrier& b) {
    asm volatile("s_waitcnt vmcnt(0)" ::: "memory");
    __syncthreads();
    if (threadIdx.x == 0) {
        unsigned* bar = b.bar;
        __builtin_amdgcn_s_waitcnt(0);
        unsigned nloc = b.st[0], nx = b.st[1];
        if (nloc == 0u) { xcd_barrier_complete(bar, b.x, nloc, nx); b.st[0] = nloc; b.st[1] = nx; }
        const unsigned old = xb_add(&bar[XB_XSUB(b.x)], 1u);
        const unsigned gen = old / nloc;
        if (old + 1u == (gen + 1u) * nloc) {
            __builtin_amdgcn_fence(__ATOMIC_RELEASE, "agent");
            asm volatile("s_waitcnt vmcnt(0)" ::: "memory");
            const unsigned og = xb_add(&bar[XB_TOP], 1u);
            const unsigned tg = og / nx;
            if (og + 1u == (tg + 1u) * nx) xb_add(&bar[XB_TOPGEN], 1u);
            else XB_SPIN(xb_ld(&bar[XB_TOPGEN]) == tg, bar);
            __builtin_amdgcn_fence(__ATOMIC_ACQUIRE, "agent");
            xb_add(&bar[XB_XGEN(b.x)], 1u);
            asm volatile("s_waitcnt vmcnt(0)" ::: "memory");
        } else {
            XB_SPIN(xb_ld(&bar[XB_XGEN(b.x)]) == gen, bar);
            __builtin_amdgcn_fence(__ATOMIC_ACQUIRE, "agent");
            asm volatile("s_waitcnt vmcnt(0)" ::: "memory");
        }
    }
    __syncthreads();
}

#define GAS __attribute__((address_space(1)))
typedef unsigned short bf16;
typedef float f32x4 __attribute__((ext_vector_type(4)));
typedef unsigned u32x4 __attribute__((ext_vector_type(4)));
typedef unsigned u32x2 __attribute__((ext_vector_type(2)));
constexpr int DM = 1024, NB = 8, SEQ = 4096, CTXL = 256, NLAT = NB * SEQ, NCTX = NB * CTXL, NROWS = NLAT + NCTX;
constexpr int INC = 7424;
constexpr int C_RQ = 0, C_RK = 512, C_RV = 1024, C_RG = 1536, C_AQ = 2048, C_AK = 2560, C_AV = 2688, C_HU = 2816, C_MG = 4352;
constexpr int NEXP = 32, DFF = 1024;
constexpr int MPAD = 147456;
constexpr float EPS = 1e-6f;
constexpr int NWAVES = 8, NTHR = 512;
constexpr int LDS_BYTES = 147456, LDSX = 131072;
constexpr int NPH_LAYER = 14, NPH = 1 + 2 * NPH_LAYER + 1;

constexpr size_t MiB = 1u << 20;
constexpr size_t WS_CTL = 0, CTL_ZERO_BYTES = 1 * MiB;
constexpr size_t CTL_BAR = 16384;
constexpr size_t CTL_MOD = 262144;
constexpr size_t WS_L1P = 5 * MiB;
constexpr size_t WS_TOPI = 1 * MiB, WS_TOPW = 2 * MiB, WS_POS = 3 * MiB, WS_BLKCNT = 4 * MiB, WS_TILES = 4 * MiB + 65536;
constexpr size_t WS_WIN = 8 * MiB, WS_WBR = 37 * MiB, WS_WOUT = 43 * MiB, WS_W1 = 48 * MiB, WS_W2 = 304 * MiB;
constexpr size_t WS_HF = 432 * MiB;
constexpr size_t WS_HFC = 464 * MiB;
constexpr size_t WS_XM = 466 * MiB, WS_XO = 602 * MiB, WS_XN = 738 * MiB;
constexpr size_t WS_A = 806 * MiB;
constexpr size_t WS_P = WS_A, WS_RET = WS_A + 494 * MiB, WS_ATT = WS_RET + 34 * MiB, WS_HY = WS_ATT + 34 * MiB;
constexpr size_t WS_HS = WS_A, WS_ACT = WS_A + 288 * MiB;
constexpr size_t WS_MF32 = 1406 * MiB, WS_M = 1542 * MiB;
constexpr size_t WS_ZT = 1610 * MiB, WS_ZTC = 1674 * MiB, WS_YT = 1678 * MiB, WS_YTC = 1742 * MiB;
constexpr size_t WS_KV = 1746 * MiB, WS_SP = 1882 * MiB, WS_END = 2018 * MiB;
static_assert(WS_HY + 34 * MiB <= WS_MF32 && WS_ACT + 288 * MiB <= WS_MF32, "region A");
static_assert((size_t)NROWS * INC * 2 <= 494 * MiB, "P size");

__device__ __forceinline__ float bf2f(bf16 v) { return __uint_as_float(((unsigned)v) << 16); }
__device__ __forceinline__ bf16 f2bf(float f) { unsigned u = __float_as_uint(f); u += 0x7FFFu + ((u >> 16) & 1u); return (bf16)(u >> 16); }
__device__ __forceinline__ unsigned pk2(float lo, float hi) { return pg8::cvt_pk_bf16(lo, hi); }
__device__ __forceinline__ float wave_sum(float v) {
#pragma unroll
    for (int o = 1; o < 64; o <<= 1) v += __shfl_xor(v, o);
    return v;
}
__device__ __forceinline__ float rdlane(float v, int l) { return __int_as_float(__builtin_amdgcn_readlane(__float_as_int(v), l)); }
__device__ __forceinline__ float sin_rev(float rev) { return __builtin_amdgcn_sinf(__builtin_amdgcn_fractf(rev)); }
__device__ __forceinline__ float cos_rev(float rev) { return __builtin_amdgcn_cosf(__builtin_amdgcn_fractf(rev)); }
__device__ __forceinline__ float sin_rad(float x) { return sin_rev(x * 0.15915494309189535f); }
__device__ __forceinline__ float sigmoidf_(float x) { return 1.0f / (1.0f + __expf(-x)); }
__device__ __forceinline__ float siluf_(float x) { return x / (1.0f + __expf(-x)); }
__device__ __forceinline__ float log_sigmoid_(float x) {
    const float y = __expf(-x);
    if (y < 0.1f) { return -(y * (1.0f + y * (-0.5f + y * (0.33333333f + y * (-0.25f + y * (0.2f + y * (-0.16666667f + y * (0.14285714f + y * (-0.125f))))))))); }
    return -logf(1.0f + y);
}
#define LDS_WAIT() asm volatile("s_waitcnt lgkmcnt(0)" ::: "memory")
#define VM_WAIT() asm volatile("s_waitcnt vmcnt(0)" ::: "memory")

struct Args { const float* in[31]; float* out; unsigned char* ws; int ph_lo, ph_hi; };

struct Frame {
    LAS unsigned char* lds;
    int tid, lane, wave, G, bx;
    const float* const* in;
    float* out;
    unsigned char* ws;
};
__device__ __forceinline__ const float* IN_(const Frame& F, int i) { return F.in[i]; }
template <class T> __device__ __forceinline__ T* WSP(const Frame& F, size_t off) { return (T*)(F.ws + off); }
__device__ __forceinline__ const float* mod_ptr(const Frame& F, int l, int modrow, int chunk) { return WSP<float>(F, WS_CTL + CTL_MOD) + ((size_t)(l * 9 + modrow) * 6 + chunk) * DM; }
__device__ __forceinline__ int modrow_of(int r) { return r < NLAT ? (r >> 12) : 8; }

__device__ __forceinline__ void tr_item(const float* W, int K, int N, bf16* WT, int item, int w1map, LAS float* scr, int lane) {
    const int nblk = N / 32, kb = item / nblk, nb = item % nblk, k0 = 64 * kb, n0 = 32 * nb;
#pragma unroll 8
    for (int i = 0; i < 32; ++i) { const int kk = 2 * i + (lane >> 5); scr[kk * 33 + (lane & 31)] = W[(size_t)(k0 + kk) * N + n0 + (lane & 31)]; }
    LDS_WAIT(); asm volatile("" ::: "memory");
    int r0 = n0;
    if (w1map) r0 = (n0 < 1024) ? ((n0 >> 7) * 256 + (n0 & 127)) : ((((n0 - 1024) >> 7) * 256) + 128 + ((n0 - 1024) & 127));
    const int c = lane & 7;
#pragma unroll
    for (int j = 0; j < 4; ++j) { const int n = (lane >> 3) + 8 * j; const LAS float* s = scr + (8 * c) * 33 + n;
        u32x4 o; o.x = pk2(s[0 * 33], s[1 * 33]); o.y = pk2(s[2 * 33], s[3 * 33]); o.z = pk2(s[4 * 33], s[5 * 33]); o.w = pk2(s[6 * 33], s[7 * 33]);
        *(u32x4*)(WT + (size_t)(r0 + n) * K + k0 + 8 * c) = o; }
    LDS_WAIT(); asm volatile("" ::: "memory");
}

__device__ __forceinline__ void p0_prologue(Frame& F) {
    LAS float* scr = (LAS float*)(F.lds + F.wave * 16384);
    const int gw = F.bx * NWAVES + F.wave, NGW = F.G * NWAVES, lane = F.lane;
    constexpr int I_WIN = 16 * 232, I_WBR = 8 * 32, I_WOUT = 16 * 32, I_W1 = 16 * 64, I_W2 = 16 * 32;
    constexpr int N_WIN = 2 * I_WIN, N_WBR = 6 * I_WBR, N_WOUT = 2 * I_WOUT, N_W1 = 64 * I_W1, N_W2 = 64 * I_W2;
    constexpr int NTR = N_WIN + N_WBR + N_WOUT + N_W1 + N_W2;
    for (int it = gw; it < NTR; it += NGW) {
        int r = it;
        if (r < N_WIN) { const int l = r / I_WIN; tr_item(F.in[7] + (size_t)l * 1024 * INC, 1024, INC, WSP<bf16>(F, WS_WIN) + (size_t)l * INC * 1024, r % I_WIN, 0, scr, lane); continue; } r -= N_WIN;
        if (r < N_WBR) { const int q = r / I_WBR; tr_item(F.in[20] + (size_t)q * 512 * 1024, 512, 1024, WSP<bf16>(F, WS_WBR) + (size_t)q * 1024 * 512, r % I_WBR, 0, scr, lane); continue; } r -= N_WBR;
        if (r < N_WOUT) { const int l = r / I_WOUT; tr_item(F.in[22] + (size_t)l * 1024 * 1024, 1024, 1024, WSP<bf16>(F, WS_WOUT) + (size_t)l * 1024 * 1024, r % I_WOUT, 0, scr, lane); continue; } r -= N_WOUT;
        if (r < N_W1) { const int q = r / I_W1; tr_item(F.in[26] + (size_t)q * 1024 * 2048, 1024, 2048, WSP<bf16>(F, WS_W1) + (size_t)q * 2048 * 1024, r % I_W1, 1, scr, lane); continue; } r -= N_W1;
        { const int q = r / I_W2; tr_item(F.in[28] + (size_t)q * 1024 * 1024, 1024, 1024, WSP<bf16>(F, WS_W2) + (size_t)q * 1024 * 1024, r % I_W2, 0, scr, lane); }
    }
    __syncthreads();
    {
        float* mod = WSP<float>(F, WS_CTL + CTL_MOD);
        LAS float* red = (LAS float*)F.lds;
        for (int it = F.bx; it < 2 * 96; it += F.G) {
            const int l = it / 96, cc = it % 96, col = cc * 64 + lane, k0 = F.wave * 128;
            const float* wm = F.in[4] + (size_t)l * 1024 * 6144;
            float acc[9];
#pragma unroll
            for (int r = 0; r < 9; ++r) acc[r] = 0.f;
#pragma unroll 4
            for (int k = 0; k < 128; ++k) {
                const float w = wm[(size_t)(k0 + k) * 6144 + col];
#pragma unroll
                for (int r = 0; r < 9; ++r) { const float cv = (r < 8) ? F.in[1][r * 1024 + k0 + k] : F.in[3][k0 + k]; acc[r] += siluf_(cv) * w; }
            }
            __syncthreads();
#pragma unroll
            for (int r = 0; r < 9; ++r) red[(F.wave * 9 + r) * 64 + lane] = acc[r];
            __syncthreads();
            for (int idx = F.tid; idx < 576; idx += NTHR) { const int r = idx >> 6, c = idx & 63; float s = 0.f;
#pragma unroll
                for (int w = 0; w < 8; ++w) s += red[(w * 9 + r) * 64 + c];
                mod[(size_t)(l * 9 + r) * 6144 + cc * 64 + c] = s + F.in[5][l * 6144 + cc * 64 + c]; }
        }
    }
    {
        float* L1P = WSP<float>(F, WS_L1P);
        LAS float* red = (LAS float*)F.lds;
        for (int it = F.bx; it < 128 + 128 + 8; it += F.G) {
            const int f = it < 128 ? 0 : (it < 256 ? 1 : 2), tb = it - (f == 0 ? 0 : (f == 1 ? 128 : 256)), t0 = tb * 32 + F.wave * 4;
            const int L = (f == 2) ? 256 : 4096, l = (f == 1) ? 1 : 0;
            const float* w1 = F.in[12] + l * 33 * 64; const float* b1 = F.in[13] + l * 64; const float* f1 = F.in[14] + l * 64;
            const float* w2 = F.in[15] + l * 64 * 64; const float* b2 = F.in[16] + l * 64; const float* f2 = F.in[17] + l * 64;
            const float* w3 = F.in[18] + (size_t)l * 64 * 1024;
            float* HFp = (f == 2) ? WSP<float>(F, WS_HFC) : WSP<float>(F, WS_HF + (size_t)l * 16 * MiB);
            float* HBp = (f == 2) ? WSP<float>(F, WS_HFC + 512 * 1024) : WSP<float>(F, WS_HF + (size_t)l * 16 * MiB + 8 * MiB);
            float h2r[4];
#pragma unroll
            for (int r = 0; r < 4; ++r) {
                const int n = t0 + r;
                float zl = 0.f;
                if (lane == 0) zl = (float)n / (float)(L - 1);
                else if (lane <= 32) { const int j = (lane - 1) & 15; const float band = 1e-4f + (15.0f - 1e-4f) * (float)j / 15.0f; const float rev = (float)n * band / (float)L;
                    zl = (lane <= 16) ? cos_rev(rev) : -sin_rev(rev); }
                float a = 0.f;
#pragma unroll
                for (int i = 0; i < 33; ++i) a += rdlane(zl, i) * w1[i * 64 + lane];
                const float h1 = sin_rad(f1[lane] * (a + b1[lane]));
                float a2 = 0.f;
#pragma unroll
                for (int i = 0; i < 64; ++i) a2 += rdlane(h1, i) * w2[i * 64 + lane];
                h2r[r] = sin_rad(f2[lane] * (a2 + b2[lane]));
            }
            float acc[4][16];
#pragma unroll
            for (int r = 0; r < 4; ++r)
#pragma unroll
                for (int q = 0; q < 16; ++q) acc[r][q] = 0.f;
#pragma unroll 2
            for (int i = 0; i < 64; ++i) {
                float hr[4];
#pragma unroll
                for (int r = 0; r < 4; ++r) hr[r] = __shfl(h2r[r], i);
#pragma unroll
                for (int q = 0; q < 16; ++q) { const float w = w3[i * 1024 + lane + 64 * q];
#pragma unroll
                    for (int r = 0; r < 4; ++r) acc[r][q] += hr[r] * w; }
            }
            __syncthreads();
#pragma unroll
            for (int q = 0; q < 16; ++q) {
                const int c = lane + 64 * q, cc = c & 511;
                const float delta = 3.0701134573253944f + (15.350567286626973f - 3.0701134573253944f) * (float)cc / 511.0f;
                float l1p = 0.f;
#pragma unroll
                for (int r = 0; r < 4; ++r) { const int n = t0 + r; const float tn = (float)n / (float)(L - 1); const float v = acc[r][q] * __expf(-tn * delta);
                    if (c < 512) HFp[(size_t)n * 512 + cc] = v; else HBp[(size_t)n * 512 + cc] = v;
                    if (c < 512 || n >= 1) l1p += fabsf(v); }
                red[F.wave * 1024 + c] = l1p;
            }
            __syncthreads();
            { const int cc = F.tid; float s = 0.f;
#pragma unroll
              for (int w = 0; w < 8; ++w) s += red[w * 1024 + cc] + red[w * 1024 + 512 + cc];
              L1P[(size_t)(f * 128 + tb) * 512 + cc] = s; }
        }
    }
}
__device__ __forceinline__ float hy_inv_l1(const Frame& F, int f, int c) {
    const float* L1P = WSP<float>(F, WS_L1P) + (size_t)f * 128 * 512 + c; const int nb = (f == 2) ? 8 : 128; float s = 0.f;
    for (int tb = 0; tb < nb; ++tb) s += L1P[(size_t)tb * 512];
    return 1.0f / s;
}

__device__ __forceinline__ void ph_norm1(Frame& F, int mode) {
    const int gw = F.bx * NWAVES + F.wave, NGW = F.G * NWAVES, lane = F.lane;
    const int nrows = (mode == 2) ? NLAT : NROWS;
    const int l = (mode == 0) ? 0 : 1;
    const bf16* Y = WSP<bf16>(F, WS_HS);
    const int* POS = WSP<int>(F, WS_POS); const float* TOPW = WSP<float>(F, WS_TOPW);
    for (int r = gw; r < nrows; r += NGW) {
        const int mr = modrow_of(r);
        f32x4 v[4];
        if (mode == 0) {
            const float* xr = (r < NLAT) ? F.in[0] + (size_t)r * DM : F.in[2] + (size_t)(r - NLAT) * DM;
#pragma unroll
            for (int j = 0; j < 4; ++j) v[j] = *(const f32x4*)(xr + 4 * lane + 256 * j);
        } else {
            const float* xm = WSP<float>(F, WS_XM) + (size_t)r * DM;
            const float* g2 = mod_ptr(F, 0, mr, 5);
            f32x4 s[4];
#pragma unroll
            for (int j = 0; j < 4; ++j) s[j] = (f32x4){0.f, 0.f, 0.f, 0.f};
#pragma unroll
            for (int k = 0; k < 4; ++k) {
                const int p = POS[r * 4 + k]; const float w = TOPW[r * 4 + k];
                const bf16* yr = Y + (size_t)p * DM;
#pragma unroll
                for (int j = 0; j < 4; ++j) { const u32x2 y2 = *(const u32x2*)(yr + 4 * lane + 256 * j);
                    s[j][0] += w * __uint_as_float(y2.x << 16); s[j][1] += w * __uint_as_float(y2.x & 0xffff0000u);
                    s[j][2] += w * __uint_as_float(y2.y << 16); s[j][3] += w * __uint_as_float(y2.y & 0xffff0000u); }
            }
            if (mode == 2) {   }
            const float* g2l = (mode == 2) ? mod_ptr(F, 1, mr, 5) : g2;
#pragma unroll
            for (int j = 0; j < 4; ++j) { const f32x4 x = *(const f32x4*)(xm + 4 * lane + 256 * j); const f32x4 g = *(const f32x4*)(g2l + 4 * lane + 256 * j); v[j] = x + g * s[j]; }
            if (mode == 1) { float* xo = WSP<float>(F, WS_XO) + (size_t)r * DM;
#pragma unroll
                for (int j = 0; j < 4; ++j) *(f32x4*)(xo + 4 * lane + 256 * j) = v[j]; }
        }
        float ss = 0.f;
#pragma unroll
        for (int j = 0; j < 4; ++j) ss += (v[j][0] * v[j][0] + v[j][1] * v[j][1]) + (v[j][2] * v[j][2] + v[j][3] * v[j][3]);
        const float rstd = 1.0f / sqrtf(wave_sum(ss) * (1.0f / DM) + EPS);
        if (mode == 2) {
            const float* fg = F.in[30]; float* o = F.out + (size_t)r * DM;
#pragma unroll
            for (int j = 0; j < 4; ++j) { const f32x4 g = *(const f32x4*)(fg + 4 * lane + 256 * j); *(f32x4*)(o + 4 * lane + 256 * j) = v[j] * rstd * g; }
        } else {
            const float* gw_ = F.in[6] + l * DM; const float* sh = mod_ptr(F, l, mr, 0); const float* sc = mod_ptr(F, l, mr, 1);
            bf16* o = WSP<bf16>(F, WS_XN) + (size_t)r * DM;
#pragma unroll
            for (int j = 0; j < 4; ++j) { const f32x4 g = *(const f32x4*)(gw_ + 4 * lane + 256 * j); const f32x4 a = *(const f32x4*)(sh + 4 * lane + 256 * j); const f32x4 b = *(const f32x4*)(sc + 4 * lane + 256 * j);
                const f32x4 y = v[j] * rstd * g * (b + 1.0f) + a;
                u32x2 w2; w2.x = pk2(y[0], y[1]); w2.y = pk2(y[2], y[3]); *(u32x2*)(o + 4 * lane + 256 * j) = w2; }
        }
    }
}

struct EpiP {
    static constexpr bool PERM = true, AFTER_DRAIN = false;
    bf16* O;
    __device__ __forceinline__ void operator()(const f32x4 (&acc)[2][2][4][2], const pg8::Unit& u, int wr, int wc, int fr, int fq) const {
        const int row0 = u.pm * 256 + wr * 64 + fr, col0 = u.pn * 256 + wc * 32 + 8 * fq;
#pragma unroll
        for (int ai = 0; ai < 2; ++ai)
#pragma unroll
            for (int m = 0; m < 4; ++m) { bf16* rowp = O + (size_t)(row0 + ai * 128 + m * 16) * INC + col0;
#pragma unroll
                for (int bj = 0; bj < 2; ++bj) { const f32x4 v0 = acc[ai][bj][m][0], v1 = acc[ai][bj][m][1];
                    u32x4 w; w.x = pk2(v0[0], v0[1]); w.y = pk2(v0[2], v0[3]); w.z = pk2(v1[0], v1[1]); w.w = pk2(v1[2], v1[3]);
                    *(u32x4*)(rowp + bj * 128) = w; } }
    }
};
template <int BR> struct EpiBranch {
    static constexpr bool PERM = false, AFTER_DRAIN = false;
    const bf16* P; const float* bgate; float* MF; bf16* Mo;
    __device__ __forceinline__ void operator()(const f32x4 (&acc)[2][2][4][2], const pg8::Unit& u, int wr, int wc, int fr, int fq) const {
        const int row0 = u.pm * 256 + wr * 64 + fr, col0 = u.pn * 256 + wc * 32 + 4 * fq;
#pragma unroll
        for (int ai = 0; ai < 2; ++ai)
#pragma unroll
            for (int m = 0; m < 4; ++m) { const size_t row = (size_t)(row0 + ai * 128 + m * 16);
#pragma unroll
                for (int bj = 0; bj < 2; ++bj)
#pragma unroll
                    for (int n = 0; n < 2; ++n) { const int col = col0 + bj * 128 + n * 16;
                        const u32x2 g2 = *(const u32x2*)(P + row * INC + C_MG + BR * 1024 + col);
                        const f32x4 bg = *(const f32x4*)(bgate + BR * 1024 + col);
                        f32x4 g; g[0] = sigmoidf_(__uint_as_float(g2.x << 16) + bg[0]); g[1] = sigmoidf_(__uint_as_float(g2.x & 0xffff0000u) + bg[1]);
                        g[2] = sigmoidf_(__uint_as_float(g2.y << 16) + bg[2]); g[3] = sigmoidf_(__uint_as_float(g2.y & 0xffff0000u) + bg[3]);
                        f32x4 v = g * acc[ai][bj][m][n];
                        float* mp = MF + row * DM + col;
                        if (BR > 0) v = v + *(const f32x4*)mp;
                        if (BR < 2) *(f32x4*)mp = v;
                        else { u32x2 w; w.x = pk2(v[0], v[1]); w.y = pk2(v[2], v[3]); *(u32x2*)(Mo + row * DM + col) = w; } } }
    }
};
struct EpiOut {
    static constexpr bool PERM = false, AFTER_DRAIN = false;
    const float* xlat; const float* xctx; const float* g1base; float* XM;
    __device__ __forceinline__ void operator()(const f32x4 (&acc)[2][2][4][2], const pg8::Unit& u, int wr, int wc, int fr, int fq) const {
        const int row0 = u.pm * 256 + wr * 64 + fr, col0 = u.pn * 256 + wc * 32 + 4 * fq;
#pragma unroll
        for (int ai = 0; ai < 2; ++ai)
#pragma unroll
            for (int m = 0; m < 4; ++m) { const int row = row0 + ai * 128 + m * 16;
                const float* xr = (row < NLAT) ? xlat + (size_t)row * DM : xctx + (size_t)(row - NLAT) * DM;
                const float* g1 = g1base + (size_t)modrow_of(row) * 6 * DM;
#pragma unroll
                for (int bj = 0; bj < 2; ++bj)
#pragma unroll
                    for (int n = 0; n < 2; ++n) { const int col = col0 + bj * 128 + n * 16;
                        const f32x4 x = *(const f32x4*)(xr + col), g = *(const f32x4*)(g1 + col);
                        *(f32x4*)(XM + (size_t)row * DM + col) = x + g * acc[ai][bj][m][n]; } }
    }
};
struct EpiMoe1 {
    static constexpr bool PERM = true, AFTER_DRAIN = false;
    const float* b1; bf16* ACT;
    __device__ __forceinline__ void operator()(const f32x4 (&acc)[2][2][4][2], const pg8::Unit& u, int wr, int wc, int fr, int fq) const {
        const int e = u.pn >> 3, p = u.pn & 7;
        const int row0 = u.pm * 256 + wr * 64 + fr, gcol0 = p * 128 + wc * 32 + 8 * fq;
        const float* bb = b1 + (size_t)e * 2048 + gcol0;
        const f32x4 bg0 = *(const f32x4*)(bb), bg1 = *(const f32x4*)(bb + 4), bl0 = *(const f32x4*)(bb + 1024), bl1 = *(const f32x4*)(bb + 1028);
#pragma unroll
        for (int ai = 0; ai < 2; ++ai)
#pragma unroll
            for (int m = 0; m < 4; ++m) { bf16* rowp = ACT + (size_t)(row0 + ai * 128 + m * 16) * DFF + gcol0;
                float a[8];
#pragma unroll
                for (int n = 0; n < 2; ++n)
#pragma unroll
                    for (int j = 0; j < 4; ++j) { float glu = acc[ai][0][m][n][j] + (n ? bg1[j] : bg0[j]); float lin = acc[ai][1][m][n][j] + (n ? bl1[j] : bl0[j]);
                        glu = fminf(glu, 7.0f); lin = fminf(fmaxf(lin, -7.0f), 7.0f);
                        a[n * 4 + j] = glu * sigmoidf_(1.702f * glu) * (lin + 1.0f); }
                u32x4 w; w.x = pk2(a[0], a[1]); w.y = pk2(a[2], a[3]); w.z = pk2(a[4], a[5]); w.w = pk2(a[6], a[7]);
                *(u32x4*)rowp = w; }
    }
};
struct EpiMoe2 {
    static constexpr bool PERM = true, AFTER_DRAIN = false;
    const float* b2; bf16* Y;
    __device__ __forceinline__ void operator()(const f32x4 (&acc)[2][2][4][2], const pg8::Unit& u, int wr, int wc, int fr, int fq) const {
        const int e = u.pn >> 2, p = u.pn & 3;
        const int row0 = u.pm * 256 + wr * 64 + fr, col0 = p * 256 + wc * 32 + 8 * fq;
        f32x4 bv[2][2];
#pragma unroll
        for (int bj = 0; bj < 2; ++bj)
#pragma unroll
            for (int n = 0; n < 2; ++n) bv[bj][n] = *(const f32x4*)(b2 + (size_t)e * 1024 + col0 + bj * 128 + 4 * n);
#pragma unroll
        for (int ai = 0; ai < 2; ++ai)
#pragma unroll
            for (int m = 0; m < 4; ++m) { bf16* rowp = Y + (size_t)(row0 + ai * 128 + m * 16) * DM + col0;
#pragma unroll
                for (int bj = 0; bj < 2; ++bj) { const f32x4 v0 = acc[ai][bj][m][0] + bv[bj][0], v1 = acc[ai][bj][m][1] + bv[bj][1];
                    u32x4 w; w.x = pk2(v0[0], v0[1]); w.y = pk2(v0[2], v0[3]); w.z = pk2(v1[0], v1[1]); w.w = pk2(v1[2], v1[3]);
                    *(u32x4*)(rowp + bj * 128) = w; } }
    }
};
struct MoeOrder {
    const LAS int* list; int n;
    __device__ __forceinline__ bool next(int i, pg8::Unit& u) const { if (i >= n) return false; u.pm = list[2 * i]; u.pn = list[2 * i + 1]; return true; }
    __device__ __forceinline__ void a_ready(const pg8::Unit&) const {}
    __device__ __forceinline__ void done(const pg8::Unit&) const {}
};
__device__ __forceinline__ int moe_list_units(Frame& F, int nN, LAS int* list) {
    const int* tl = WSP<int>(F, WS_TILES);
    const int T = tl[32], total = T * nN;
    int n = 0;
    for (int i = 0;; ++i) {
        const int Lu = i * F.G + F.bx; if (Lu >= total) break;
        const int pm = Lu / nN, pnl = Lu % nN;
        int e = 0;
        for (int q = 1; q < 32; ++q) if (tl[q] <= pm) e = q;
        if (F.tid == 0) { list[2 * i] = pm; list[2 * i + 1] = e * nN + pnl; }
        n = i + 1;
    }
    __syncthreads();
    return n;
}

__device__ __forceinline__ void ph_rope(Frame& F) {
    bf16* P = WSP<bf16>(F, WS_P);
    const size_t total = (size_t)NLAT * 832, stride = (size_t)F.G * NTHR;
    for (size_t idx = (size_t)F.bx * NTHR + F.tid; idx < total; idx += stride) {
        const int row = (int)(idx / 832), pi = (int)(idx % 832), t = row & 4095;
        int c1, c2; float rev;
        if (pi < 512) {
            const int qk = pi >> 8, h = (pi >> 6) & 3, i = pi & 63;
            c1 = (qk ? C_RK : C_RQ) + h * 128 + i; c2 = c1 + 64;
            const float invf = __expf(-(float)i * (9.210340371976184f / 63.0f));
            rev = (float)t * invf * 0.15915494309189535f;
        } else {
            const int pj = pi - 512, hh = pj >> 5, w = pj & 31, half = w >> 4, i = w & 15;
            const int base = (hh < 8) ? (C_AQ + hh * 64) : (C_AK + (hh - 8) * 64);
            c1 = base + half * 32 + i; c2 = c1 + 16;
            const float invf = __expf(-(float)i * (9.210340371976184f / 16.0f));
            const float pos = half ? (float)(t & 63) : (float)(t >> 6);
            rev = pos * invf * 0.15915494309189535f;
        }
        const float cs = cos_rev(rev), sn = sin_rev(rev);
        bf16* pr = P + (size_t)row * INC;
        const float x1 = bf2f(pr[c1]), x2 = bf2f(pr[c2]);
        pr[c1] = f2bf(x1 * cs - x2 * sn); pr[c2] = f2bf(x1 * sn + x2 * cs);
    }
}

__device__ __forceinline__ void attn_naive_item(Frame& F, int l, int item) {
    const bf16* P = WSP<bf16>(F, WS_P);
    LAS float* Ks = (LAS float*)F.lds; LAS float* Vs = Ks + 64 * 64;
    const bool isctx = item >= 512;
    int b, kvh, qb;
    if (!isctx) { b = item >> 6; kvh = (item >> 5) & 1; qb = item & 31; } else { const int it = item - 512; b = it >> 2; kvh = (it >> 1) & 1; qb = it & 1; }
    const int qi = F.tid & 127, g = F.tid >> 7, h = kvh * 4 + g;
    const int qpos = qb * 128 + qi;
    const int rowq = isctx ? (NLAT + b * CTXL + qpos) : (b * SEQ + qpos);
    float q[64], o[64];
    { const bf16* qp = P + (size_t)rowq * INC + C_AQ + h * 64;
#pragma unroll
      for (int d = 0; d < 64; ++d) { q[d] = bf2f(qp[d]) * 0.125f; o[d] = 0.f; } }
    const float sink = F.in[9][l * 8 + h];
    float mrun = sink, lsum = 1.0f;
    const int nkc = isctx ? 4 : 10, start = qb * 128;
    for (int kc = 0; kc < nkc; ++kc) {
        __syncthreads();
        { const int key = F.tid >> 3, d0 = (F.tid & 7) * 8;
          const bool ctxchunk = isctx || kc >= 6;
          int row = -1;
          if (ctxchunk) row = NLAT + b * CTXL + (isctx ? kc : kc - 6) * 64 + key;
          else { const int kpos = start - 128 + kc * 64 + key; if (kpos >= 0 && kpos < SEQ) row = b * SEQ + kpos; }
          u32x4 kk = (u32x4){0u, 0u, 0u, 0u}, vv = kk;
          if (row >= 0) { kk = *(const u32x4*)(P + (size_t)row * INC + C_AK + kvh * 64 + d0); vv = *(const u32x4*)(P + (size_t)row * INC + C_AV + kvh * 64 + d0); }
          LAS float* kd = Ks + key * 64 + d0; LAS float* vd = Vs + key * 64 + d0;
          kd[0] = __uint_as_float(kk.x << 16); kd[1] = __uint_as_float(kk.x & 0xffff0000u); kd[2] = __uint_as_float(kk.y << 16); kd[3] = __uint_as_float(kk.y & 0xffff0000u);
          kd[4] = __uint_as_float(kk.z << 16); kd[5] = __uint_as_float(kk.z & 0xffff0000u); kd[6] = __uint_as_float(kk.w << 16); kd[7] = __uint_as_float(kk.w & 0xffff0000u);
          vd[0] = __uint_as_float(vv.x << 16); vd[1] = __uint_as_float(vv.x & 0xffff0000u); vd[2] = __uint_as_float(vv.y << 16); vd[3] = __uint_as_float(vv.y & 0xffff0000u);
          vd[4] = __uint_as_float(vv.z << 16); vd[5] = __uint_as_float(vv.z & 0xffff0000u); vd[6] = __uint_as_float(vv.w << 16); vd[7] = __uint_as_float(vv.w & 0xffff0000u); }
        __syncthreads();
        const bool ctxchunk = isctx || kc >= 6;
        for (int key = 0; key < 64; ++key) {
            bool valid = true;
            if (!ctxchunk) { const int kpos = start - 128 + kc * 64 + key; const int dd = qpos - kpos; valid = (kpos >= 0) && (kpos < SEQ) && (dd <= 128) && (dd >= -128); }
            float s = 0.f;
#pragma unroll
            for (int d = 0; d < 64; ++d) s += q[d] * Ks[key * 64 + d];
            if (valid) {
                const float mnew = fmaxf(mrun, s), sc = __expf(mrun - mnew), p = __expf(s - mnew);
                lsum = lsum * sc + p; mrun = mnew;
#pragma unroll
                for (int d = 0; d < 64; ++d) o[d] = o[d] * sc + p * Vs[key * 64 + d];
            }
        }
    }
    const float inv = 1.0f / lsum;
    bf16* op = WSP<bf16>(F, WS_ATT) + (size_t)rowq * 512 + h * 64;
#pragma unroll
    for (int d = 0; d < 64; d += 2) *(unsigned*)(op + d) = pk2(o[d] * inv, o[d + 1] * inv);
}

__device__ __forceinline__ void ret_naive_item(Frame& F, int l, int item) {
    const bf16* P = WSP<bf16>(F, WS_P);
    LAS float* Ks = (LAS float*)F.lds; LAS float* Vs = Ks + 32 * 128; LAS float* red = Vs + 32 * 128;
    const bool isctx = item >= 1024;
    int b, h, qb;
    if (!isctx) { b = item >> 7; h = (item >> 5) & 3; qb = item & 31; } else { const int it = item - 1024; b = it >> 3; h = (it >> 1) & 3; qb = it & 1; }
    const int quarter = F.wave >> 1, qi = (F.wave & 1) * 64 + F.lane;
    const int n = qb * 128 + qi;
    const int rowq = isctx ? (NLAT + b * CTXL + n) : (b * SEQ + n);
    const float LOG2E = 1.4426950408889634f;
    const float lgf = log_sigmoid_(F.in[8][l * 8 + h]) * LOG2E, lgb = log_sigmoid_(F.in[8][l * 8 + 4 + h]) * LOG2E;
    float q[128], y[32];
    { const bf16* qp = P + (size_t)rowq * INC + C_RQ + h * 128;
#pragma unroll
      for (int d = 0; d < 128; ++d) q[d] = bf2f(qp[d]); }
#pragma unroll
    for (int e = 0; e < 32; ++e) y[e] = 0.f;
    const int nch = isctx ? 8 : 136;
    for (int kc = 0; kc < nch; ++kc) {
        __syncthreads();
        const bool ctxchunk = isctx || kc >= 128;
        const int krow0 = ctxchunk ? (NLAT + b * CTXL + (isctx ? kc : kc - 128) * 32) : (b * SEQ + kc * 32);
        { const int key = F.tid >> 4, d0 = (F.tid & 15) * 8;
          const u32x4 kk = *(const u32x4*)(P + (size_t)(krow0 + key) * INC + C_RK + h * 128 + d0), vv = *(const u32x4*)(P + (size_t)(krow0 + key) * INC + C_RV + h * 128 + d0);
          LAS float* kd = Ks + key * 128 + d0; LAS float* vd = Vs + key * 128 + d0;
          kd[0] = __uint_as_float(kk.x << 16); kd[1] = __uint_as_float(kk.x & 0xffff0000u); kd[2] = __uint_as_float(kk.y << 16); kd[3] = __uint_as_float(kk.y & 0xffff0000u);
          kd[4] = __uint_as_float(kk.z << 16); kd[5] = __uint_as_float(kk.z & 0xffff0000u); kd[6] = __uint_as_float(kk.w << 16); kd[7] = __uint_as_float(kk.w & 0xffff0000u);
          vd[0] = __uint_as_float(vv.x << 16); vd[1] = __uint_as_float(vv.x & 0xffff0000u); vd[2] = __uint_as_float(vv.y << 16); vd[3] = __uint_as_float(vv.y & 0xffff0000u);
          vd[4] = __uint_as_float(vv.z << 16); vd[5] = __uint_as_float(vv.z & 0xffff0000u); vd[6] = __uint_as_float(vv.w << 16); vd[7] = __uint_as_float(vv.w & 0xffff0000u); }
        __syncthreads();
        for (int key = 0; key < 32; ++key) {
            float w;
            if (!ctxchunk) { const int m = kc * 32 + key; const int dd = n - m; w = (dd >= 0) ? __builtin_amdgcn_exp2f(lgf * (float)dd) : __builtin_amdgcn_exp2f(lgb * (float)(-dd)); }
            else if (!isctx) { const int j = (kc - 128) * 32 + key; w = __builtin_amdgcn_exp2f(lgf * (float)(n + CTXL - j)) + __builtin_amdgcn_exp2f(lgb * (float)(SEQ - n + j)); }
            else { const int j = kc * 32 + key; const int dd = n - j; w = (dd >= 0) ? __builtin_amdgcn_exp2f(lgf * (float)dd) : __builtin_amdgcn_exp2f(lgb * (float)(-dd)); }
            float s = 0.f;
#pragma unroll
            for (int d = 0; d < 128; ++d) s += q[d] * Ks[key * 128 + d];
            s *= w;
#pragma unroll
            for (int e = 0; e < 32; ++e) y[e] += s * Vs[key * 128 + quarter * 32 + e];
        }
    }
    const float ksc = 0.08838834764831845f;
    float ss = 0.f;
#pragma unroll
    for (int e = 0; e < 32; ++e) { y[e] *= ksc; ss += y[e] * y[e]; }
    __syncthreads();
    red[qi * 4 + quarter] = ss;
    __syncthreads();
    const float tot = (red[qi * 4 + 0] + red[qi * 4 + 1]) + (red[qi * 4 + 2] + red[qi * 4 + 3]);
    const float rs = 1.0f / sqrtf(tot * (1.0f / 128.0f) + EPS);
    const bf16* gp = P + (size_t)rowq * INC + C_RG + h * 128 + quarter * 32;
    bf16* op = WSP<bf16>(F, WS_RET) + (size_t)rowq * 512 + h * 128 + quarter * 32;
#pragma unroll
    for (int e = 0; e < 32; e += 2) *(unsigned*)(op + e) = pk2(y[e] * rs * siluf_(bf2f(gp[e])), y[e + 1] * rs * siluf_(bf2f(gp[e + 1])));
}

__device__ __forceinline__ float hy_sconv(const bf16* P, const float* cw, const float* cb, int base, int t, int L, int ch) {
    float a = cb[ch] + bf2f(P[(size_t)(base + t) * INC + C_HU + ch]) * cw[1536 + ch];
    if (t > 0) a += bf2f(P[(size_t)(base + t - 1) * INC + C_HU + ch]) * cw[ch];
    if (t + 1 < L) a += bf2f(P[(size_t)(base + t + 1) * INC + C_HU + ch]) * cw[2 * 1536 + ch];
    return a;
}
__device__ __forceinline__ void ph_hyprep(Frame& F, int l, bool do_ctx) {
    const bf16* P = WSP<bf16>(F, WS_P);
    const float* cw = F.in[10] + l * 3 * 1536; const float* cb = F.in[11] + l * 1536;
    float* ZT = WSP<float>(F, WS_ZT); float* ZTC = WSP<float>(F, WS_ZTC);
    const size_t total = (size_t)(do_ctx ? NROWS : NLAT) * 512, stride = (size_t)F.G * NTHR;
    for (size_t idx = (size_t)F.bx * NTHR + F.tid; idx < total; idx += stride) {
        const int row = (int)(idx >> 9), c = (int)(idx & 511);
        if (row < NLAT) { const int b = row >> 12, t = row & 4095;
            const float x1 = hy_sconv(P, cw, cb, b * SEQ, t, SEQ, 512 + c), v = hy_sconv(P, cw, cb, b * SEQ, t, SEQ, 1024 + c);
            ZT[((size_t)c * NB + b) * SEQ + t] = x1 * v;
        } else { const int j = row - NLAT, b = j >> 8, t = j & 255;
            const float x1 = hy_sconv(P, cw, cb, NLAT + b * CTXL, t, CTXL, 512 + c), v = hy_sconv(P, cw, cb, NLAT + b * CTXL, t, CTXL, 1024 + c);
            ZTC[((size_t)c * NB + b) * CTXL + t] = x1 * v;
        }
    }
}
__device__ __forceinline__ void hyconv_naive_item(Frame& F, int l, int item) {
    const int c = item >> 1, bh = item & 1;
    LAS float* Kc = (LAS float*)F.lds;
    LAS float* Zs = Kc + 8192;
    const float* HFp = WSP<float>(F, WS_HF + (size_t)l * 16 * MiB); const float* HBp = WSP<float>(F, WS_HF + (size_t)l * 16 * MiB + 8 * MiB);
    const float il1 = hy_inv_l1(F, l, c);
    const float* ZT = WSP<float>(F, WS_ZT) + ((size_t)c * NB + bh * 4) * SEQ;
    __syncthreads();
    for (int i = F.tid; i < 8191; i += NTHR) { const int d = i - 4095; Kc[i] = (d >= 0 ? HFp[(size_t)d * 512 + c] : HBp[(size_t)(-d) * 512 + c]) * il1; }
    for (int i = F.tid; i < 4 * SEQ; i += NTHR) { const int bb = i >> 12, s = i & 4095; Zs[s * 4 + bb] = ZT[i]; }
    __syncthreads();
    float acc[8][4];
#pragma unroll
    for (int i = 0; i < 8; ++i)
#pragma unroll
        for (int bb = 0; bb < 4; ++bb) acc[i][bb] = 0.f;
    for (int s = 0; s < SEQ; ++s) {
        const f32x4 z = *(const LAS f32x4*)(Zs + s * 4);
#pragma unroll
        for (int i = 0; i < 8; ++i) { const float k = Kc[F.tid + 512 * i - s + 4095];
#pragma unroll
            for (int bb = 0; bb < 4; ++bb) acc[i][bb] += k * z[bb]; }
    }
    float* YT = WSP<float>(F, WS_YT) + ((size_t)c * NB + bh * 4) * SEQ;
#pragma unroll
    for (int i = 0; i < 8; ++i)
#pragma unroll
        for (int bb = 0; bb < 4; ++bb) YT[(size_t)bb * SEQ + F.tid + 512 * i] = acc[i][bb];
}
__device__ __forceinline__ void hyconv_ctx_item(Frame& F, int c) {
    const float* HFp = WSP<float>(F, WS_HFC); const float* HBp = WSP<float>(F, WS_HFC + 512 * 1024);
    const float il1 = hy_inv_l1(F, 2, c);
    const float* Z = WSP<float>(F, WS_ZTC) + (size_t)c * NB * CTXL; float* Yo = WSP<float>(F, WS_YTC) + (size_t)c * NB * CTXL;
#pragma unroll
    for (int i = 0; i < 4; ++i) {
        const int o = F.tid * 4 + i, b = o >> 8, t = o & 255;
        float a = 0.f;
        for (int s = 0; s < CTXL; ++s) { const int d = t - s; const float k = (d >= 0) ? HFp[(size_t)d * 512 + c] : HBp[(size_t)(-d) * 512 + c]; a += k * Z[b * CTXL + s]; }
        Yo[o] = a * il1;
    }
}
__device__ __forceinline__ void ph_hypost(Frame& F, int l, bool do_ctx) {
    const bf16* P = WSP<bf16>(F, WS_P);
    const float* cw = F.in[10] + l * 3 * 1536; const float* cb = F.in[11] + l * 1536; const float* skip = F.in[19] + l * 512;
    const float* YT = WSP<float>(F, WS_YT); const float* YTC = WSP<float>(F, WS_YTC);
    bf16* HY = WSP<bf16>(F, WS_HY);
    const size_t total = (size_t)(do_ctx ? NROWS : NLAT) * 512, stride = (size_t)F.G * NTHR;
    for (size_t idx = (size_t)F.bx * NTHR + F.tid; idx < total; idx += stride) {
        const int row = (int)(idx >> 9), c = (int)(idx & 511);
        int base, t, L; float y;
        if (row < NLAT) { const int b = row >> 12; t = row & 4095; base = b * SEQ; L = SEQ; y = YT[((size_t)c * NB + b) * SEQ + t]; }
        else { const int j = row - NLAT, b = j >> 8; t = j & 255; base = NLAT + b * CTXL; L = CTXL; y = YTC[((size_t)c * NB + b) * CTXL + t]; }
        const float x0 = hy_sconv(P, cw, cb, base, t, L, c), x1 = hy_sconv(P, cw, cb, base, t, L, 512 + c), v = hy_sconv(P, cw, cb, base, t, L, 1024 + c);
        const float z = x1 * v;
        HY[(size_t)row * 512 + c] = f2bf(x0 * (y + skip[c] * z));
    }
}

__device__ __forceinline__ void ph_norm2_router(Frame& F, int l, int nrows) {
    const int lane = F.lane, RPB = nrows / 256;
    LAS float* RW = (LAS float*)F.lds;
    LAS unsigned* cnt = (LAS unsigned*)(F.lds + LDSX + 64);
    __syncthreads();
    { const float* rw = F.in[24] + (size_t)l * 1024 * 32;
      for (int i = F.tid; i < 1024 * 32 / 4; i += NTHR) *(LAS f32x4*)(RW + 4 * i) = *(const f32x4*)(rw + 4 * i); }
    if (F.tid < 32) cnt[F.tid] = 0u;
    __syncthreads();
    const float* xm_all = WSP<float>(F, WS_XM);
    const float* gw_ = F.in[23] + l * DM;
    const float rb = (lane < 32) ? F.in[25][l * 32 + lane] : 0.f;
    int* TOPI = WSP<int>(F, WS_TOPI); float* TOPW = WSP<float>(F, WS_TOPW);
    for (int rr = F.wave; rr < RPB; rr += NWAVES) {
        const int r = F.bx * RPB + rr, mr = modrow_of(r);
        const float* xr = xm_all + (size_t)r * DM;
        const float* sh = mod_ptr(F, l, mr, 3); const float* sc = mod_ptr(F, l, mr, 4);
        f32x4 v[4]; float ss = 0.f;
#pragma unroll
        for (int j = 0; j < 4; ++j) { v[j] = *(const f32x4*)(xr + 4 * lane + 256 * j); ss += (v[j][0] * v[j][0] + v[j][1] * v[j][1]) + (v[j][2] * v[j][2] + v[j][3] * v[j][3]); }
        const float rstd = 1.0f / sqrtf(wave_sum(ss) * (1.0f / DM) + EPS);
        bf16* o = WSP<bf16>(F, WS_XN) + (size_t)r * DM;
#pragma unroll
        for (int j = 0; j < 4; ++j) { const f32x4 g = *(const f32x4*)(gw_ + 4 * lane + 256 * j); const f32x4 a = *(const f32x4*)(sh + 4 * lane + 256 * j); const f32x4 b = *(const f32x4*)(sc + 4 * lane + 256 * j);
            v[j] = v[j] * rstd * g * (b + 1.0f) + a;
            u32x2 w2; w2.x = pk2(v[j][0], v[j][1]); w2.y = pk2(v[j][2], v[j][3]); *(u32x2*)(o + 4 * lane + 256 * j) = w2; }
        float acc = 0.f;
        const int e = lane & 31, hf = lane >> 5;
#pragma unroll 4
        for (int src = 0; src < 64; ++src) {
#pragma unroll
            for (int jj = 0; jj < 2; ++jj)
#pragma unroll
                for (int q = 0; q < 4; ++q) {
                    const float h0 = rdlane(v[jj][q], src), h1 = rdlane(v[jj + 2][q], src);
                    const float hv = hf ? h1 : h0;
                    const int col = 4 * src + 256 * (jj + 2 * hf) + q;
                    acc += hv * RW[col * 32 + e];
                }
        }
        acc += __shfl_xor(acc, 32);
        float logit = acc + rb;
        logit = __shfl(logit, e);
        float tv[4]; int ti[4];
        float cur = logit;
#pragma unroll
        for (int k = 0; k < 4; ++k) {
            float bvv = cur; int bi = e;
#pragma unroll
            for (int off = 1; off < 32; off <<= 1) { const float ov = __shfl_xor(bvv, off); const int oi = __shfl_xor(bi, off);
                if (ov > bvv || (ov == bvv && oi < bi)) { bvv = ov; bi = oi; } }
            tv[k] = bvv; ti[k] = bi;
            if (e == bi) cur = -3.0e38f;
        }
        const float mx = tv[0];
        float ex[4], den = 0.f;
#pragma unroll
        for (int k = 0; k < 4; ++k) { ex[k] = __expf(tv[k] - mx); den += ex[k]; }
        if (lane < 4) { const int k = lane; const int id = (k == 0) ? ti[0] : (k == 1) ? ti[1] : (k == 2) ? ti[2] : ti[3]; const float wv = ((k == 0) ? ex[0] : (k == 1) ? ex[1] : (k == 2) ? ex[2] : ex[3]) / den;
            TOPI[r * 4 + k] = id; TOPW[r * 4 + k] = wv; __hip_atomic_fetch_add(cnt + id, 1u, __ATOMIC_RELAXED, __HIP_MEMORY_SCOPE_WORKGROUP); }
    }
    __syncthreads();
    if (F.tid < 32) WSP<int>(F, WS_BLKCNT)[F.bx * 32 + F.tid] = (int)cnt[F.tid];
}

__device__ __forceinline__ void ph_moe_assign(Frame& F, int nrows) {
    const int RPB = nrows / 256, lane = F.lane;
    LAS int* part = (LAS int*)F.lds;
    LAS int* base = part + 1024;
    LAS int* idx = base + 32;
    LAS int* posl = idx + 1024;
    const int* BC = WSP<int>(F, WS_BLKCNT);
    __syncthreads();
    { const int e = F.tid & 31, pt = F.tid >> 5; int st = 0, sp = 0;
      for (int q = 0; q < 16; ++q) { const int blk = pt * 16 + q; const int v = BC[blk * 32 + e]; st += v; if (blk < F.bx) sp += v; }
      part[pt * 32 + e] = st; part[512 + pt * 32 + e] = sp; }
    for (int i = F.tid; i < RPB * 4; i += NTHR) idx[i] = WSP<int>(F, WS_TOPI)[F.bx * RPB * 4 + i];
    __syncthreads();
    if (F.tid < 32) { int st = 0, sp = 0; for (int q = 0; q < 16; ++q) { st += part[q * 32 + F.tid]; sp += part[512 + q * 32 + F.tid]; }
        part[F.tid] = st; part[512 + F.tid] = sp; }
    __syncthreads();
    if (F.tid == 0) { int t0 = 0; int* tl = WSP<int>(F, WS_TILES);
        for (int e = 0; e < 32; ++e) { base[e] = t0 * 256 + part[512 + e]; if (F.bx == 0) tl[e] = t0; t0 += (part[e] + 255) >> 8; }
        if (F.bx == 0) tl[32] = t0; }
    __syncthreads();
    if (F.tid < 32) { const int e = F.tid; int c = base[e]; for (int j = 0; j < RPB * 4; ++j) if (idx[j] == e) posl[j] = c++; }
    __syncthreads();
    const bf16* H = WSP<bf16>(F, WS_XN); bf16* HS = WSP<bf16>(F, WS_HS); int* POS = WSP<int>(F, WS_POS);
    for (int rr = F.wave; rr < RPB; rr += NWAVES) {
        const int r = F.bx * RPB + rr;
        const u32x4 a = *(const u32x4*)(H + (size_t)r * DM + 8 * lane), b = *(const u32x4*)(H + (size_t)r * DM + 512 + 8 * lane);
#pragma unroll
        for (int k = 0; k < 4; ++k) { const int p = posl[rr * 4 + k];
            *(u32x4*)(HS + (size_t)p * DM + 8 * lane) = a; *(u32x4*)(HS + (size_t)p * DM + 512 + 8 * lane) = b; }
        if (lane < 4) POS[r * 4 + lane] = posl[rr * 4 + lane];
    }
}

template <int ONLY> __global__ void __launch_bounds__(NTHR, 2) mk_fwd(Args args) {
    extern __shared__ __attribute__((aligned(16))) unsigned char lds_raw[];
    Frame F;
    F.lds = (LAS unsigned char*)lds_raw;
    F.tid = threadIdx.x; F.lane = F.tid & 63; F.wave = __builtin_amdgcn_readfirstlane(F.tid >> 6);
    F.G = gridDim.x; F.bx = blockIdx.x;
    F.in = args.in; F.out = args.out; F.ws = args.ws;
    for (int u = F.tid; u < (LDS_BYTES - LDSX) / 4; u += NTHR) ((LAS unsigned*)(F.lds + LDSX))[u] = 0u;
    __syncthreads();
    const int lo = args.ph_lo, hi = args.ph_hi;
    const bool one_launch = (hi - lo) > 1;
    XcdBarrier bar; bar.bar = (unsigned*)(F.ws + WS_CTL + CTL_BAR); bar.x = 0; bar.st = nullptr;
    if (one_launch) bar = xcd_barrier_post((unsigned*)(F.ws + WS_CTL + CTL_BAR), (volatile LAS unsigned*)(F.lds + LDSX));
#define ENAB(k) (ONLY < 0 || ONLY == (k))
#define IN(k) (lo <= (k) && (k) < hi)
#define SEAM(k) do { if (IN(k) && IN((k) + 1)) xcd_barrier(bar); } while (0)
    LAS unsigned char* ring = F.lds;

    if (ENAB(100)) if (IN(0)) { p0_prologue(F); } SEAM(0);

    for (int l = 0; l < 2; ++l) {
        const int pb = 1 + NPH_LAYER * l;
        const bool last = (l == 1);
        const int mrows = last ? NLAT : NROWS;
        if (ENAB(0)) if (IN(pb + 0)) { ph_norm1(F, l == 0 ? 0 : 1); } SEAM(pb + 0);
        if (ENAB(1)) if (IN(pb + 1)) {
            pg8::Gemm g{WSP<bf16>(F, WS_XN), WSP<bf16>(F, WS_WIN) + (size_t)l * INC * 1024, NROWS, INC, 1024};
            pg8::StaticOrder S; S.init(NROWS, INC, F.G, F.bx);
            EpiP E{WSP<bf16>(F, WS_P)};
            pg8::gemm_phase<EpiP, pg8::StaticOrder, true, true>(ring, g, S, E);
        } SEAM(pb + 1);
        if (ENAB(2)) if (IN(pb + 2)) { ph_rope(F); } SEAM(pb + 2);
        if (ENAB(3)) if (IN(pb + 3)) {
            const int na = last ? 512 : 544, nr = last ? 1024 : 1088;
            for (int it = F.bx; it < na; it += F.G) attn_naive_item(F, l, it);
            for (int it = F.bx; it < nr; it += F.G) ret_naive_item(F, l, it);
            ph_hyprep(F, l, !last);
        } SEAM(pb + 3);
        if (ENAB(4)) if (IN(pb + 4)) {
            for (int it = F.bx; it < 1024; it += F.G) hyconv_naive_item(F, l, it);
            if (!last) for (int it = F.bx; it < 512; it += F.G) hyconv_ctx_item(F, it);
        } SEAM(pb + 4);
        if (ENAB(5)) if (IN(pb + 5)) { ph_hypost(F, l, !last); } SEAM(pb + 5);
        if (ENAB(6)) if (IN(pb + 6)) {
            pg8::Gemm g{WSP<bf16>(F, WS_RET), WSP<bf16>(F, WS_WBR) + (size_t)(l * 3 + 0) * 1024 * 512, mrows, 1024, 512};
            pg8::StaticOrder S; S.init(mrows, 1024, F.G, F.bx);
            EpiBranch<0> E{WSP<bf16>(F, WS_P), F.in[21] + l * 3072, WSP<float>(F, WS_MF32), WSP<bf16>(F, WS_M)};
            pg8::gemm_phase<EpiBranch<0>, pg8::StaticOrder, true, true>(ring, g, S, E);
        } SEAM(pb + 6);
        if (ENAB(7)) if (IN(pb + 7)) {
            pg8::Gemm g{WSP<bf16>(F, WS_ATT), WSP<bf16>(F, WS_WBR) + (size_t)(l * 3 + 1) * 1024 * 512, mrows, 1024, 512};
            pg8::StaticOrder S; S.init(mrows, 1024, F.G, F.bx);
            EpiBranch<1> E{WSP<bf16>(F, WS_P), F.in[21] + l * 3072, WSP<float>(F, WS_MF32), WSP<bf16>(F, WS_M)};
            pg8::gemm_phase<EpiBranch<1>, pg8::StaticOrder, true, true>(ring, g, S, E);
        } SEAM(pb + 7);
        if (ENAB(8)) if (IN(pb + 8)) {
            pg8::Gemm g{WSP<bf16>(F, WS_HY), WSP<bf16>(F, WS_WBR) + (size_t)(l * 3 + 2) * 1024 * 512, mrows, 1024, 512};
            pg8::StaticOrder S; S.init(mrows, 1024, F.G, F.bx);
            EpiBranch<2> E{WSP<bf16>(F, WS_P), F.in[21] + l * 3072, WSP<float>(F, WS_MF32), WSP<bf16>(F, WS_M)};
            pg8::gemm_phase<EpiBranch<2>, pg8::StaticOrder, true, true>(ring, g, S, E);
        } SEAM(pb + 8);
        if (ENAB(9)) if (IN(pb + 9)) {
            pg8::Gemm g{WSP<bf16>(F, WS_M), WSP<bf16>(F, WS_WOUT) + (size_t)l * 1024 * 1024, mrows, 1024, 1024};
            pg8::StaticOrder S; S.init(mrows, 1024, F.G, F.bx);
            const float* xl = (l == 0) ? F.in[0] : WSP<float>(F, WS_XO);
            const float* xc = (l == 0) ? F.in[2] : WSP<float>(F, WS_XO) + (size_t)NLAT * DM;
            EpiOut E{xl, xc, mod_ptr(F, l, 0, 2), WSP<float>(F, WS_XM)};
            pg8::gemm_phase<EpiOut, pg8::StaticOrder, true, true>(ring, g, S, E);
        } SEAM(pb + 9);
        if (ENAB(10)) if (IN(pb + 10)) { ph_norm2_router(F, l, mrows); } SEAM(pb + 10);
        if (ENAB(11)) if (IN(pb + 11)) { ph_moe_assign(F, mrows); } SEAM(pb + 11);
        if (ENAB(12)) if (IN(pb + 12)) {
            LAS int* list = (LAS int*)(F.lds + LDSX + 256);
            const int n = moe_list_units(F, 8, list);
            pg8::Gemm g{WSP<bf16>(F, WS_HS), WSP<bf16>(F, WS_W1) + (size_t)l * 32 * 2048 * 1024, MPAD, 32 * 2048, 1024};
            MoeOrder S{list, n};
            EpiMoe1 E{F.in[27] + (size_t)l * 32 * 2048, WSP<bf16>(F, WS_ACT)};
            pg8::gemm_phase<EpiMoe1, MoeOrder, true, true>(ring, g, S, E);
        } SEAM(pb + 12);
        if (ENAB(13)) if (IN(pb + 13)) {
            LAS int* list = (LAS int*)(F.lds + LDSX + 256);
            const int n = moe_list_units(F, 4, list);
            pg8::Gemm g{WSP<bf16>(F, WS_ACT), WSP<bf16>(F, WS_W2) + (size_t)l * 32 * 1024 * 1024, MPAD, 32 * 1024, 1024};
            MoeOrder S{list, n};
            EpiMoe2 E{F.in[29] + (size_t)l * 32 * 1024, WSP<bf16>(F, WS_HS)};
            pg8::gemm_phase<EpiMoe2, MoeOrder, true, true>(ring, g, S, E);
        } SEAM(pb + 13);
    }
    if (ENAB(101)) if (IN(NPH - 1)) { ph_norm1(F, 2); }
#undef IN
#undef SEAM
}

template <int ONLY> static void launch_phase(Args a, int lo, int hi, int grid, hipStream_t stream) {
    static bool attr_set = false;
    if (!attr_set) { (void)hipFuncSetAttribute((const void*)mk_fwd<ONLY>, hipFuncAttributeMaxDynamicSharedMemorySize, LDS_BYTES); attr_set = true; }
    a.ph_lo = lo; a.ph_hi = hi;
    hipLaunchKernelGGL(mk_fwd<ONLY>, dim3(grid), dim3(NTHR), LDS_BYTES, stream, a);
}
extern "C" void kernel_launch(void* const* d_in, const int* in_sizes, int n_in, void* d_out, int out_size, void* d_ws, size_t ws_size, hipStream_t stream) {
    static int grid = 0;
    if (grid == 0) {
        if (n_in != 31 || ws_size < WS_END) { fprintf(stderr, "kernel_launch: unexpected n_in %d / ws_size %zu\n", n_in, ws_size); grid = -1; return; }
        int dev = 0, cus = 0;
        if (hipGetDevice(&dev) != hipSuccess || hipDeviceGetAttribute(&cus, hipDeviceAttributeMultiprocessorCount, dev) != hipSuccess) { grid = -1; return; }
        grid = (cus == 256) ? 256 : -1;
        if (grid < 0) { fprintf(stderr, "kernel_launch: needs a 256-CU device, got %d\n", cus); return; }
    }
    if (grid < 0) return;
    (void)hipMemsetAsync((char*)d_ws + WS_CTL, 0, CTL_ZERO_BYTES, stream);
    Args a{};
    for (int i = 0; i < 31; ++i) a.in[i] = (const float*)d_in[i];
    a.out = (float*)d_out; a.ws = (unsigned char*)d_ws;
#if MK_ONE_LAUNCH
    launch_phase<-1>(a, 0, NPH, grid, stream);
#else
    launch_phase<100>(a, 0, 1, grid, stream);
    for (int l = 0; l < 2; ++l) {
        const int pb = 1 + NPH_LAYER * l;
        launch_phase<0>(a, pb + 0, pb + 1, grid, stream);   launch_phase<1>(a, pb + 1, pb + 2, grid, stream);   launch_phase<2>(a, pb + 2, pb + 3, grid, stream);
        launch_phase<3>(a, pb + 3, pb + 4, grid, stream);   launch_phase<4>(a, pb + 4, pb + 5, grid, stream);   launch_phase<5>(a, pb + 5, pb + 6, grid, stream);
        launch_phase<6>(a, pb + 6, pb + 7, grid, stream);   launch_phase<7>(a, pb + 7, pb + 8, grid, stream);   launch_phase<8>(a, pb + 8, pb + 9, grid, stream);
        launch_phase<9>(a, pb + 9, pb + 10, grid, stream);  launch_phase<10>(a, pb + 10, pb + 11, grid, stream); launch_phase<11>(a, pb + 11, pb + 12, grid, stream);
        launch_phase<12>(a, pb + 12, pb + 13, grid, stream); launch_phase<13>(a, pb + 13, pb + 14, grid, stream);
    }
    launch_phase<101>(a, NPH - 1, NPH, grid, stream);
#endif
}
```

```cpp
#include <hip/hip_runtime.h>
#include <cstdio>
#include <cstdint>
#define MK_ONE_LAUNCH 1
namespace pg8 {
#define PG8_LAS __attribute__((address_space(3)))
typedef unsigned short bf16_t;
typedef short bf16x8 __attribute__((ext_vector_type(8)));
typedef float f32x4 __attribute__((ext_vector_type(4)));
typedef unsigned u32x4 __attribute__((ext_vector_type(4)));
constexpr int BM = 256, BK = 64, HALF = 128, HTB = HALF * BK * 2  , STAGE_BYTES = 8 * HTB, NXCD = 8, WGM = 8;

__host__ __device__ __forceinline__ int lds_byte(int r, int c) { const int st = (r >> 4) * 2 + (c >> 5), rr = r & 15, cc = c & 31, ob = rr * 64 + cc * 2; return st * 1024 + (ob ^ (((ob >> 9) & 1) << 5)); }
__host__ __device__ __forceinline__ void stage_rc(int b, int& R, int& C) { const int st = b / 1024, sb = b % 1024, swz = sb ^ (((sb >> 9) & 1) << 5); R = (st >> 1) * 16 + swz / 64; C = (st & 1) * 32 + (swz % 64) / 2; }
__host__ __device__ __forceinline__ int perm32(int rho) { const int n = rho >> 4, i = rho & 15; return 8 * (i >> 2) + 4 * n + (i & 3); }

struct Unit { int pm, pn; };
struct Gemm { const bf16_t* A; const bf16_t* Bt; int M, N, K; };

struct StaticOrder {
    int nM, nN, nwg, G, c;
    __host__ __device__ void init(int M, int N, int G_, int c_) { nM = M / BM; nN = N / BM; nwg = nM * nN; G = G_; c = c_; }
    __host__ __device__ bool next(int i, Unit& u) const {
        const long L = (long)i * G + c; if (L >= nwg) return false;
        int wgid = (int)L; { const int q = nwg / NXCD, r = nwg % NXCD, xcd = wgid % NXCD, off = wgid / NXCD; wgid = (xcd < r ? xcd * (q + 1) : r * (q + 1) + (xcd - r) * q) + off; }
        const int nig = WGM * nN, gid = wgid / nig, fm = gid * WGM, gsz = (nM - fm) < WGM ? (nM - fm) : WGM;
        u.pm = fm + ((wgid % nig) % gsz); u.pn = (wgid % nig) / gsz; return true;
    }
    __device__ __forceinline__ void a_ready(const Unit&) const {}
    __device__ __forceinline__ void done(const Unit&) const {}
};

__device__ __forceinline__ unsigned cvt_pk_bf16(float lo, float hi) { unsigned r; asm volatile("v_cvt_pk_bf16_f32 %0, %1, %2" : "=v"(r) : "v"(lo), "v"(hi)); return r; }
template <class Epi, class Sched, bool ALIGN_EPI = false, bool SP2 = false>
__device__ __forceinline__ void gemm_phase(PG8_LAS unsigned char* lds, const Gemm g, const Sched& S, const Epi& E) {
    const int tid = threadIdx.x, wid = __builtin_amdgcn_readfirstlane(tid >> 6), lane = tid & 63, wr = wid >> 2, wc = wid & 3, fr = lane & 15, fq = lane >> 4;
    const int K = g.K, nt = K / BK;
    unsigned voffA[2], voffB[2];
#pragma unroll
    for (int i = 0; i < 2; ++i) { int R, C; stage_rc(tid * 16 + i * 8192, R, C); const int Rb = Epi::PERM ? ((R & ~31) + perm32(R & 31)) : R;
        voffA[i] = (unsigned)(R * K + C) * 2u; voffB[i] = (unsigned)(Rb * K + C) * 2u; }
    const size_t kstep = (size_t)(BK * 2);
    const size_t hstep = (size_t)HALF * K * 2;
    const size_t tstep = 2 * hstep;
    const unsigned ldsw = (unsigned)wid * 1024u;
    const int aoff = lds_byte(wr * 64 + fr, fq * 8), boff = lds_byte(wc * 32 + fr, fq * 8);
#define PG8_SA(b, h) (((b) * 2 + (h)) * HTB)
#define PG8_SB(b, h) ((4 + (b) * 2 + (h)) * HTB)
#define PG8_STAGE(bufoff, gbase, voff) do { _Pragma("unroll") for (int _i = 0; _i < 2; ++_i) \
        __builtin_amdgcn_global_load_lds((const unsigned*)((const char*)(gbase) + (voff)[_i]), (PG8_LAS unsigned*)(lds + (bufoff) + ldsw + _i * 8192), 16, 0, 0); } while (0)
#define PG8_LDA(dst, b, h) do { _Pragma("unroll") for (int m = 0; m < 4; ++m) _Pragma("unroll") for (int k = 0; k < 2; ++k) dst[m][k] = *(const PG8_LAS bf16x8*)(lds + PG8_SA(b, h) + aoff + m * 2048 + k * 1024); } while (0)
#define PG8_LDB(dst, b, h) do { _Pragma("unroll") for (int n = 0; n < 2; ++n) _Pragma("unroll") for (int k = 0; k < 2; ++k) dst[n][k] = *(const PG8_LAS bf16x8*)(lds + PG8_SB(b, h) + boff + n * 2048 + k * 1024); } while (0)
#define PG8_MMA(ai, bj, At, Bt) do { __builtin_amdgcn_s_setprio(1); _Pragma("unroll") for (int m = 0; m < 4; ++m) _Pragma("unroll") for (int n = 0; n < 2; ++n) _Pragma("unroll") for (int k = 0; k < 2; ++k) \
        acc[ai][bj][m][n] = __builtin_amdgcn_mfma_f32_16x16x32_bf16(Bt[n][k], At[m][k], acc[ai][bj][m][n], 0, 0, 0); __builtin_amdgcn_s_setprio(0); } while (0)
#define PG8_WAIT_V(n) asm volatile("s_waitcnt vmcnt(" #n ")" ::: "memory")
#define PG8_WAIT_L(n) asm volatile("s_waitcnt lgkmcnt(" #n ")" ::: "memory")
#define PG8_BAR __builtin_amdgcn_s_barrier()
#define PG8_SCHED __builtin_amdgcn_sched_barrier(0)
    Unit cur, nxt; int ui = 0;
    if (!S.next(0, cur)) return;
    f32x4 acc[2][2][4][2];
#pragma unroll
    for (int a = 0; a < 2; ++a)
#pragma unroll
        for (int b = 0; b < 2; ++b)
#pragma unroll
            for (int m = 0; m < 4; ++m)
#pragma unroll
                for (int n = 0; n < 2; ++n) acc[a][b][m][n] = (f32x4){0.f, 0.f, 0.f, 0.f};
    bf16x8 At[4][2], B0[2][2], B1[2][2];
    const char* cA = (const char*)g.A + (size_t)cur.pm * tstep; const char* cB = (const char*)g.Bt + (size_t)cur.pn * tstep;
    S.a_ready(cur);
    if constexpr (SP2) {
        PG8_STAGE(PG8_SB(0, 0), cB, voffB); PG8_STAGE(PG8_SB(0, 1), cB + hstep, voffB); PG8_STAGE(PG8_SA(0, 0), cA, voffA); PG8_STAGE(PG8_SA(0, 1), cA + hstep, voffA);
        if (wr == 1) PG8_BAR;
        PG8_WAIT_V(2); PG8_BAR;
        PG8_STAGE(PG8_SB(1, 0), cB + kstep, voffB); PG8_STAGE(PG8_SA(1, 0), cA + kstep, voffA); PG8_STAGE(PG8_SB(1, 1), cB + hstep + kstep, voffB);
        PG8_WAIT_V(6); PG8_BAR;
    } else {
        PG8_STAGE(PG8_SB(0, 0), cB, voffB); PG8_STAGE(PG8_SA(0, 0), cA, voffA); PG8_STAGE(PG8_SB(0, 1), cB + hstep, voffB); PG8_STAGE(PG8_SA(0, 1), cA + hstep, voffA);
        if (wr == 1) PG8_BAR;
        PG8_WAIT_V(4); PG8_BAR;
        PG8_STAGE(PG8_SB(1, 0), cB + kstep, voffB); PG8_STAGE(PG8_SA(1, 0), cA + kstep, voffA); PG8_STAGE(PG8_SB(1, 1), cB + hstep + kstep, voffB);
        PG8_WAIT_V(6); PG8_BAR;
    }
    for (;;) {
        const bool has_next = S.next(ui + 1, nxt);
        const char* nA = has_next ? (const char*)g.A + (size_t)nxt.pm * tstep : cA; const char* nB = has_next ? (const char*)g.Bt + (size_t)nxt.pn * tstep : cB;
        for (int t = 0; t < nt; t += 2) {
            const bool last = (t == nt - 2);
            const char* a1 = cA + (size_t)(t + 1) * kstep;
            const char* a2 = last ? nA : cA + (size_t)(t + 2) * kstep; const char* b2 = last ? nB : cB + (size_t)(t + 2) * kstep;
            const char* a3 = a2 + kstep; const char* b3 = b2 + kstep;
            if (last && has_next) S.a_ready(nxt);
            if constexpr (SP2) {
            PG8_LDB(B0, 0, 0); PG8_LDB(B1, 0, 1); PG8_SCHED; PG8_LDA(At, 0, 0); PG8_STAGE(PG8_SA(1, 1), a1 + hstep, voffA);
            PG8_WAIT_V(8); PG8_WAIT_L(0); PG8_BAR; PG8_MMA(0, 0, At, B0); PG8_MMA(0, 1, At, B1); PG8_BAR; PG8_SCHED;
            PG8_LDA(At, 0, 1); PG8_STAGE(PG8_SB(0, 0), b2, voffB); PG8_STAGE(PG8_SB(0, 1), b2 + hstep, voffB); PG8_STAGE(PG8_SA(0, 0), a2, voffA);
            PG8_WAIT_V(8); PG8_WAIT_L(0); PG8_BAR; PG8_MMA(1, 0, At, B0); PG8_MMA(1, 1, At, B1); PG8_BAR; PG8_SCHED;
            PG8_LDB(B0, 1, 0); PG8_LDB(B1, 1, 1); PG8_SCHED; PG8_LDA(At, 1, 0); PG8_STAGE(PG8_SA(0, 1), a2 + hstep, voffA);
            PG8_WAIT_V(8); PG8_WAIT_L(0); PG8_BAR; PG8_MMA(0, 0, At, B0); PG8_MMA(0, 1, At, B1); PG8_BAR; PG8_SCHED;
            PG8_LDA(At, 1, 1); PG8_STAGE(PG8_SB(1, 0), b3, voffB); PG8_STAGE(PG8_SB(1, 1), b3 + hstep, voffB); PG8_STAGE(PG8_SA(1, 0), a3, voffA);
            PG8_WAIT_V(8); PG8_WAIT_L(0); PG8_BAR; PG8_MMA(1, 0, At, B0); PG8_MMA(1, 1, At, B1); PG8_BAR; PG8_SCHED;
            } else {
            PG8_LDB(B0, 0, 0); PG8_SCHED; PG8_LDA(At, 0, 0); PG8_STAGE(PG8_SA(1, 1), a1 + hstep, voffA);
            PG8_WAIT_L(8); PG8_BAR; PG8_WAIT_L(0); PG8_MMA(0, 0, At, B0); PG8_BAR; PG8_SCHED;
            PG8_LDB(B1, 0, 1); PG8_STAGE(PG8_SB(0, 0), b2, voffB);
            PG8_BAR; PG8_WAIT_L(0); PG8_MMA(0, 1, At, B1); PG8_BAR;
            PG8_LDA(At, 0, 1); PG8_STAGE(PG8_SA(0, 0), a2, voffA);
            PG8_BAR; PG8_WAIT_L(0); PG8_MMA(1, 0, At, B0); PG8_BAR; PG8_SCHED;
            PG8_STAGE(PG8_SB(0, 1), b2 + hstep, voffB);
            PG8_WAIT_V(6); PG8_BAR; PG8_MMA(1, 1, At, B1); PG8_BAR;
            PG8_LDB(B0, 1, 0); PG8_SCHED; PG8_LDA(At, 1, 0); PG8_STAGE(PG8_SA(0, 1), a2 + hstep, voffA);
            PG8_WAIT_L(8); PG8_BAR; PG8_WAIT_L(0); PG8_MMA(0, 0, At, B0); PG8_BAR; PG8_SCHED;
            PG8_LDB(B1, 1, 1); PG8_STAGE(PG8_SB(1, 0), b3, voffB);
            PG8_BAR; PG8_WAIT_L(0); PG8_MMA(0, 1, At, B1); PG8_BAR;
            PG8_LDA(At, 1, 1); PG8_STAGE(PG8_SA(1, 0), a3, voffA);
            PG8_BAR; PG8_WAIT_L(0); PG8_MMA(1, 0, At, B0); PG8_BAR; PG8_SCHED;
            PG8_STAGE(PG8_SB(1, 1), b3 + hstep, voffB);
            PG8_WAIT_V(6); PG8_BAR; PG8_MMA(1, 1, At, B1); PG8_BAR;
            }
        }
        if constexpr (ALIGN_EPI) { if (wr == 0) PG8_BAR; }
        if constexpr (!Epi::AFTER_DRAIN) { E(acc, cur, wr, wc, fr, fq); S.done(cur); }
        if (!has_next) break;
#pragma unroll
        for (int a = 0; a < 2; ++a)
#pragma unroll
            for (int b = 0; b < 2; ++b)
#pragma unroll
                for (int m = 0; m < 4; ++m)
#pragma unroll
                    for (int n = 0; n < 2; ++n) acc[a][b][m][n] = (f32x4){0.f, 0.f, 0.f, 0.f};
        cur = nxt; cA = nA; cB = nB; ++ui;
        if constexpr (ALIGN_EPI) { if (wr == 1) PG8_BAR; }
    }
    PG8_WAIT_V(0);
    if constexpr (!ALIGN_EPI) { if (wr == 0) PG8_BAR; }
    PG8_BAR;
    if constexpr (Epi::AFTER_DRAIN) { E.fused(acc, cur, wr, wc, fr, fq, lds, wid, lane); S.done(cur); }
#undef PG8_SA
#undef PG8_SB
#undef PG8_STAGE
#undef PG8_LDA
#undef PG8_LDB
#undef PG8_MMA
#undef PG8_WAIT_V
#undef PG8_WAIT_L
#undef PG8_BAR
#undef PG8_SCHED
}
}
#define XB_TMO      128
#define XB_XCNT(j)  (256  + 64 * (j))
#define XB_XSUB(j)  (1280 + 64 * (j))
#define XB_XGEN(j)  (2304 + 64 * (j))
#define XB_TOP      3328
#define XB_TOPGEN   3392
#define XCD_BAR_WORDS 3456
#define XB_SPIN_CAP (1u << 18)
#define LAS __attribute__((address_space(3)))

__device__ __forceinline__ unsigned xb_ld(unsigned* p)              { return __hip_atomic_load(p, __ATOMIC_RELAXED, __HIP_MEMORY_SCOPE_AGENT); }
__device__ __forceinline__ unsigned xb_add(unsigned* p, unsigned v) { return __hip_atomic_fetch_add(p, v, __ATOMIC_RELAXED, __HIP_MEMORY_SCOPE_AGENT); }
__device__ __forceinline__ unsigned xb_xcc_id() { return (unsigned)__builtin_amdgcn_s_getreg((3 << 11) | 20) & 0xFu; }
#define XB_SPIN(cond, bar) do { unsigned _sp = 0; while (cond) { __builtin_amdgcn_s_sleep(1); \
    if ((++_sp & 255u) == 0u) { if (xb_ld(&(bar)[XB_TMO])) break; if (_sp > XB_SPIN_CAP) { atomicAdd(&(bar)[XB_TMO], 1u); break; } } } } while (0)

struct XcdBarrier {
    unsigned* bar; unsigned x;
    volatile LAS unsigned* st;
};

__device__ __forceinline__ XcdBarrier xcd_barrier_post(unsigned* bar, volatile LAS unsigned* st) {
    XcdBarrier b; b.bar = bar; b.x = xb_xcc_id(); b.st = st;
    if (threadIdx.x == 0) (void)xb_add(&bar[XB_XCNT(b.x)], 1u);
    return b;
}
__device__ __forceinline__ void xcd_barrier_complete(unsigned* bar, unsigned x, unsigned& nloc, unsigned& nx) {
    const unsigned G = gridDim.x * gridDim.y * gridDim.z;
    unsigned sum, cnt, mine, sp = 0u;
    for (;;) {
        sum = 0u; cnt = 0u; mine = 0u;
#pragma unroll
        for (unsigned j = 0; j < 16; ++j) { const unsigned c = xb_ld(&bar[XB_XCNT(j)]); sum += c; cnt += (c > 0u) ? 1u : 0u; mine = (j == x) ? c : mine; }
        if (sum == G) break;
        __builtin_amdgcn_s_sleep(1);
        if ((++sp & 255u) == 0u) { if (xb_ld(&bar[XB_TMO])) break; if (sp > XB_SPIN_CAP) { atomicAdd(&bar[XB_TMO], 1u); break; } }
    }
    nloc = mine > 0u ? mine : 1u; nx = cnt > 0u ? cnt : 1u;
}

__device__ __forceinline__ void xcd_barrier(const XcdBarrier& b) {
    asm volatile("s_waitcnt vmcnt(0)" ::: "memory");
    __syncthreads();
    if (threadIdx.x == 0) {
        unsigned* bar = b.bar;
        __builtin_amdgcn_s_waitcnt(0);
        unsigned nloc = b.st[0], nx = b.st[1];
        if (nloc == 0u) { xcd_barrier_complete(bar, b.x, nloc, nx); b.st[0] = nloc; b.st[1] = nx; }
        const unsigned old = xb_add(&bar[XB_XSUB(b.x)], 1u);
        const unsigned gen = old / nloc;
        if (old + 1u == (gen + 1u) * nloc) {
            __builtin_amdgcn_fence(__ATOMIC_RELEASE, "agent");
            asm volatile("s_waitcnt vmcnt(0)" ::: "memory");
            const unsigned og = xb_add(&bar[XB_TOP], 1u);
            const unsigned tg = og / nx;
            if (og + 1u == (tg + 1u) * nx) xb_add(&bar[XB_TOPGEN], 1u);
            else XB_SPIN(xb_ld(&bar[XB_TOPGEN]) == tg, bar);
            __builtin_amdgcn_fence(__ATOMIC_ACQUIRE, "agent");
            xb_add(&bar[XB_XGEN(b.x)], 1u);
            asm volatile("s_waitcnt vmcnt(0)" ::: "memory");
        } else {
            XB_SPIN(xb_ld(&bar[XB_XGEN(b.x)]) == gen, bar);
            __builtin_amdgcn_fence(__ATOMIC_ACQUIRE, "agent");
            asm volatile("s_waitcnt vmcnt(0)" ::: "memory");
        }
    }
    __syncthreads();
}

#define GAS __attribute__((address_space(1)))
typedef unsigned short bf16;
typedef float f32x4 __attribute__((ext_vector_type(4)));
typedef unsigned u32x4 __attribute__((ext_vector_type(4)));
typedef unsigned u32x2 __attribute__((ext_vector_type(2)));
constexpr int DM = 1024, NB = 8, SEQ = 4096, CTXL = 256, NLAT = NB * SEQ, NCTX = NB * CTXL, NROWS = NLAT + NCTX;
constexpr int INC = 7424;
constexpr int C_RQ = 0, C_RK = 512, C_RV = 1024, C_RG = 1536, C_AQ = 2048, C_AK = 2560, C_AV = 2688, C_HU = 2816, C_MG = 4352;
constexpr int NEXP = 32, DFF = 1024;
constexpr int MPAD = 147456;
constexpr float EPS = 1e-6f;
constexpr int NWAVES = 8, NTHR = 512;
constexpr int LDS_BYTES = 147456, LDSX = 131072;
constexpr int NPH_LAYER = 14, NPH = 1 + 2 * NPH_LAYER + 1;

constexpr size_t MiB = 1u << 20;
constexpr size_t WS_CTL = 0, CTL_ZERO_BYTES = 1 * MiB;
constexpr size_t CTL_BAR = 16384;
constexpr size_t CTL_MOD = 262144;
constexpr size_t WS_L1P = 5 * MiB;
constexpr size_t WS_TOPI = 1 * MiB, WS_TOPW = 2 * MiB, WS_POS = 3 * MiB, WS_BLKCNT = 4 * MiB, WS_TILES = 4 * MiB + 65536;
constexpr size_t WS_WIN = 8 * MiB, WS_WBR = 37 * MiB, WS_WOUT = 43 * MiB, WS_W1 = 48 * MiB, WS_W2 = 304 * MiB;
constexpr size_t WS_HF = 432 * MiB;
constexpr size_t WS_HFC = 464 * MiB;
constexpr size_t WS_XM = 466 * MiB, WS_XO = 602 * MiB, WS_XN = 738 * MiB;
constexpr size_t WS_A = 806 * MiB;
constexpr size_t WS_P = WS_A, WS_RET = WS_A + 494 * MiB, WS_ATT = WS_RET + 34 * MiB, WS_HY = WS_ATT + 34 * MiB;
constexpr size_t WS_HS = WS_A, WS_ACT = WS_A + 288 * MiB;
constexpr size_t WS_MF32 = 1406 * MiB, WS_M = 1542 * MiB;
constexpr size_t WS_ZT = 1610 * MiB, WS_ZTC = 1674 * MiB, WS_YT = 1678 * MiB, WS_YTC = 1742 * MiB;
constexpr size_t WS_KV = 1746 * MiB, WS_SP = 1882 * MiB, WS_END = 2018 * MiB;
static_assert(WS_HY + 34 * MiB <= WS_MF32 && WS_ACT + 288 * MiB <= WS_MF32, "region A");
static_assert((size_t)NROWS * INC * 2 <= 494 * MiB, "P size");

__device__ __forceinline__ float bf2f(bf16 v) { return __uint_as_float(((unsigned)v) << 16); }
__device__ __forceinline__ bf16 f2bf(float f) { unsigned u = __float_as_uint(f); u += 0x7FFFu + ((u >> 16) & 1u); return (bf16)(u >> 16); }
__device__ __forceinline__ unsigned pk2(float lo, float hi) { return pg8::cvt_pk_bf16(lo, hi); }
__device__ __forceinline__ float wave_sum(float v) {
#pragma unroll
    for (int o = 1; o < 64; o <<= 1) v += __shfl_xor(v, o);
    return v;
}
__device__ __forceinline__ float rdlane(float v, int l) { return __int_as_float(__builtin_amdgcn_readlane(__float_as_int(v), l)); }
__device__ __forceinline__ float sin_rev(float rev) { return __builtin_amdgcn_sinf(__builtin_amdgcn_fractf(rev)); }
__device__ __forceinline__ float cos_rev(float rev) { return __builtin_amdgcn_cosf(__builtin_amdgcn_fractf(rev)); }
__device__ __forceinline__ float sin_rad(float x) { return sin_rev(x * 0.15915494309189535f); }
__device__ __forceinline__ float sigmoidf_(float x) { return 1.0f / (1.0f + __expf(-x)); }
__device__ __forceinline__ float siluf_(float x) { return x / (1.0f + __expf(-x)); }
__device__ __forceinline__ float log_sigmoid_(float x) {
    const float y = __expf(-x);
    if (y < 0.1f) { return -(y * (1.0f + y * (-0.5f + y * (0.33333333f + y * (-0.25f + y * (0.2f + y * (-0.16666667f + y * (0.14285714f + y * (-0.125f))))))))); }
    return -logf(1.0f + y);
}
#define LDS_WAIT() asm volatile("s_waitcnt lgkmcnt(0)" ::: "memory")
#define VM_WAIT() asm volatile("s_waitcnt vmcnt(0)" ::: "memory")

struct Args { const float* in[31]; float* out; unsigned char* ws; int ph_lo, ph_hi; };

extern __shared__ __attribute__((aligned(16))) unsigned char lds_raw[];
constexpr int LDS_PTAB = LDSX + 1024;
struct Frame {
    LAS unsigned char* lds;
    int tid, lane, wave, G, bx;
    unsigned char* ws;
};
__device__ __forceinline__ unsigned long long ptab_read(int i) {
    const LAS unsigned* p = (const LAS unsigned*)((LAS unsigned char*)lds_raw + LDS_PTAB) + 2 * i;
    const unsigned lo = (unsigned)__builtin_amdgcn_readfirstlane((int)p[0]), hi = (unsigned)__builtin_amdgcn_readfirstlane((int)p[1]);
    return ((unsigned long long)hi << 32) | lo;
}
__device__ __forceinline__ const float* IN_(const Frame& F, int i) { return (const float*)ptab_read(i); }
__device__ __forceinline__ float* OUT_(const Frame& F) { return (float*)ptab_read(31); }
__device__ __forceinline__ Frame make_frame() {
    Frame F; F.lds = (LAS unsigned char*)lds_raw;
    int t = threadIdx.x; asm volatile("" : "+v"(t)); F.tid = t; F.lane = t & 63; F.wave = __builtin_amdgcn_readfirstlane(t >> 6);
    int g = gridDim.x, bx = blockIdx.x; asm volatile("" : "+s"(g), "+s"(bx)); F.G = g; F.bx = bx;
    unsigned long long w = ptab_read(32); asm volatile("" : "+s"(w)); F.ws = (unsigned char*)w; return F;
}
template <class T> __device__ __forceinline__ T* WSP(const Frame& F, size_t off) { return (T*)(F.ws + off); }
__device__ __forceinline__ const float* mod_ptr(const Frame& F, int l, int modrow, int chunk) { return WSP<float>(F, WS_CTL + CTL_MOD) + ((size_t)(l * 9 + modrow) * 6 + chunk) * DM; }
__device__ __forceinline__ int modrow_of(int r) { return r < NLAT ? (r >> 12) : 8; }

__device__ __forceinline__ void tr_item(const float* W, int K, int N, bf16* WT, int item, int w1map, LAS float* scr, int lane) {
    const int nblk = N / 32, kb = item / nblk, nb = item % nblk, k0 = 64 * kb, n0 = 32 * nb;
#pragma unroll 8
    for (int i = 0; i < 32; ++i) { const int kk = 2 * i + (lane >> 5); scr[kk * 33 + (lane & 31)] = W[(size_t)(k0 + kk) * N + n0 + (lane & 31)]; }
    LDS_WAIT(); asm volatile("" ::: "memory");
    int r0 = n0;
    if (w1map) r0 = (n0 < 1024) ? ((n0 >> 7) * 256 + (n0 & 127)) : ((((n0 - 1024) >> 7) * 256) + 128 + ((n0 - 1024) & 127));
    const int c = lane & 7;
#pragma unroll
    for (int j = 0; j < 4; ++j) { const int n = (lane >> 3) + 8 * j; const LAS float* s = scr + (8 * c) * 33 + n;
        u32x4 o; o.x = pk2(s[0 * 33], s[1 * 33]); o.y = pk2(s[2 * 33], s[3 * 33]); o.z = pk2(s[4 * 33], s[5 * 33]); o.w = pk2(s[6 * 33], s[7 * 33]);
        *(u32x4*)(WT + (size_t)(r0 + n) * K + k0 + 8 * c) = o; }
    LDS_WAIT(); asm volatile("" ::: "memory");
}

__device__ __forceinline__ void p0_prologue(Frame& F) {
    LAS float* scr = (LAS float*)(F.lds + F.wave * 16384);
    const int gw = F.bx * NWAVES + F.wave, NGW = F.G * NWAVES, lane = F.lane;
    constexpr int I_WIN = 16 * 232, I_WBR = 8 * 32, I_WOUT = 16 * 32, I_W1 = 16 * 64, I_W2 = 16 * 32;
    constexpr int N_WIN = 2 * I_WIN, N_WBR = 6 * I_WBR, N_WOUT = 2 * I_WOUT, N_W1 = 64 * I_W1, N_W2 = 64 * I_W2;
    constexpr int NTR = N_WIN + N_WBR + N_WOUT + N_W1 + N_W2;
    for (int it = gw; it < NTR; it += NGW) {
        int r = it;
        if (r < N_WIN) { const int l = r / I_WIN; tr_item(IN_(F, 7) + (size_t)l * 1024 * INC, 1024, INC, WSP<bf16>(F, WS_WIN) + (size_t)l * INC * 1024, r % I_WIN, 0, scr, lane); continue; } r -= N_WIN;
        if (r < N_WBR) { const int q = r / I_WBR; tr_item(IN_(F, 20) + (size_t)q * 512 * 1024, 512, 1024, WSP<bf16>(F, WS_WBR) + (size_t)q * 1024 * 512, r % I_WBR, 0, scr, lane); continue; } r -= N_WBR;
        if (r < N_WOUT) { const int l = r / I_WOUT; tr_item(IN_(F, 22) + (size_t)l * 1024 * 1024, 1024, 1024, WSP<bf16>(F, WS_WOUT) + (size_t)l * 1024 * 1024, r % I_WOUT, 0, scr, lane); continue; } r -= N_WOUT;
        if (r < N_W1) { const int q = r / I_W1; tr_item(IN_(F, 26) + (size_t)q * 1024 * 2048, 1024, 2048, WSP<bf16>(F, WS_W1) + (size_t)q * 2048 * 1024, r % I_W1, 1, scr, lane); continue; } r -= N_W1;
        { const int q = r / I_W2; tr_item(IN_(F, 28) + (size_t)q * 1024 * 1024, 1024, 1024, WSP<bf16>(F, WS_W2) + (size_t)q * 1024 * 1024, r % I_W2, 0, scr, lane); }
    }
    __syncthreads();
    {
        float* mod = WSP<float>(F, WS_CTL + CTL_MOD);
        LAS float* red = (LAS float*)F.lds;
        for (int it = F.bx; it < 2 * 96; it += F.G) {
            const int l = it / 96, cc = it % 96, col = cc * 64 + lane, k0 = F.wave * 128;
            const float* wm = IN_(F, 4) + (size_t)l * 1024 * 6144;
            float acc[9];
#pragma unroll
            for (int r = 0; r < 9; ++r) acc[r] = 0.f;
#pragma unroll 4
            for (int k = 0; k < 128; ++k) {
                const float w = wm[(size_t)(k0 + k) * 6144 + col];
#pragma unroll
                for (int r = 0; r < 9; ++r) { const float cv = (r < 8) ? IN_(F, 1)[r * 1024 + k0 + k] : IN_(F, 3)[k0 + k]; acc[r] += siluf_(cv) * w; }
            }
            __syncthreads();
#pragma unroll
            for (int r = 0; r < 9; ++r) red[(F.wave * 9 + r) * 64 + lane] = acc[r];
            __syncthreads();
            for (int idx = F.tid; idx < 576; idx += NTHR) { const int r = idx >> 6, c = idx & 63; float s = 0.f;
#pragma unroll
                for (int w = 0; w < 8; ++w) s += red[(w * 9 + r) * 64 + c];
                mod[(size_t)(l * 9 + r) * 6144 + cc * 64 + c] = s + IN_(F, 5)[l * 6144 + cc * 64 + c]; }
        }
    }
    {
        float* L1P = WSP<float>(F, WS_L1P);
        LAS float* red = (LAS float*)F.lds;
        for (int it = F.bx; it < 128 + 128 + 8; it += F.G) {
            const int f = it < 128 ? 0 : (it < 256 ? 1 : 2), tb = it - (f == 0 ? 0 : (f == 1 ? 128 : 256)), t0 = tb * 32 + F.wave * 4;
            const int L = (f == 2) ? 256 : 4096, l = (f == 1) ? 1 : 0;
            const float* w1 = IN_(F, 12) + l * 33 * 64; const float* b1 = IN_(F, 13) + l * 64; const float* f1 = IN_(F, 14) + l * 64;
            const float* w2 = IN_(F, 15) + l * 64 * 64; const float* b2 = IN_(F, 16) + l * 64; const float* f2 = IN_(F, 17) + l * 64;
            const float* w3 = IN_(F, 18) + (size_t)l * 64 * 1024;
            float* HFp = (f == 2) ? WSP<float>(F, WS_HFC) : WSP<float>(F, WS_HF + (size_t)l * 16 * MiB);
            float* HBp = (f == 2) ? WSP<float>(F, WS_HFC + 512 * 1024) : WSP<float>(F, WS_HF + (size_t)l * 16 * MiB + 8 * MiB);
            float h2r[4];
#pragma unroll
            for (int r = 0; r < 4; ++r) {
                const int n = t0 + r;
                float zl = 0.f;
                if (lane == 0) zl = (float)n / (float)(L - 1);
                else if (lane <= 32) { const int j = (lane - 1) & 15; const float band = 1e-4f + (15.0f - 1e-4f) * (float)j / 15.0f; const float rev = (float)n * band / (float)L;
                    zl = (lane <= 16) ? cos_rev(rev) : -sin_rev(rev); }
                float a = 0.f;
#pragma unroll
                for (int i = 0; i < 33; ++i) a += rdlane(zl, i) * w1[i * 64 + lane];
                const float h1 = sin_rad(f1[lane] * (a + b1[lane]));
                float a2 = 0.f;
#pragma unroll
                for (int i = 0; i < 64; ++i) a2 += rdlane(h1, i) * w2[i * 64 + lane];
                h2r[r] = sin_rad(f2[lane] * (a2 + b2[lane]));
            }
            float acc[4][16];
#pragma unroll
            for (int r = 0; r < 4; ++r)
#pragma unroll
                for (int q = 0; q < 16; ++q) acc[r][q] = 0.f;
#pragma unroll 2
            for (int i = 0; i < 64; ++i) {
                float hr[4];
#pragma unroll
                for (int r = 0; r < 4; ++r) hr[r] = __shfl(h2r[r], i);
#pragma unroll
                for (int q = 0; q < 16; ++q) { const float w = w3[i * 1024 + lane + 64 * q];
#pragma unroll
                    for (int r = 0; r < 4; ++r) acc[r][q] += hr[r] * w; }
            }
            __syncthreads();
#pragma unroll
            for (int q = 0; q < 16; ++q) {
                const int c = lane + 64 * q, cc = c & 511;
                const float delta = 3.0701134573253944f + (15.350567286626973f - 3.0701134573253944f) * (float)cc / 511.0f;
                float l1p = 0.f;
#pragma unroll
                for (int r = 0; r < 4; ++r) { const int n = t0 + r; const float tn = (float)n / (float)(L - 1); const float v = acc[r][q] * __expf(-tn * delta);
                    if (c < 512) HFp[(size_t)n * 512 + cc] = v; else HBp[(size_t)n * 512 + cc] = v;
                    if (c < 512 || n >= 1) l1p += fabsf(v); }
                red[F.wave * 1024 + c] = l1p;
            }
            __syncthreads();
            { const int cc = F.tid; float s = 0.f;
#pragma unroll
              for (int w = 0; w < 8; ++w) s += red[w * 1024 + cc] + red[w * 1024 + 512 + cc];
              L1P[(size_t)(f * 128 + tb) * 512 + cc] = s; }
        }
    }
}
__device__ __forceinline__ float hy_inv_l1(const Frame& F, int f, int c) {
    const float* L1P = WSP<float>(F, WS_L1P) + (size_t)f * 128 * 512 + c; const int nb = (f == 2) ? 8 : 128; float s = 0.f;
    for (int tb = 0; tb < nb; ++tb) s += L1P[(size_t)tb * 512];
    return 1.0f / s;
}

__device__ __forceinline__ void ph_norm1(Frame& F, int mode) {
    const int gw = F.bx * NWAVES + F.wave, NGW = F.G * NWAVES, lane = F.lane;
    const int nrows = (mode == 2) ? NLAT : NROWS;
    const int l = (mode == 0) ? 0 : 1;
    const bf16* Y = WSP<bf16>(F, WS_HS);
    const int* POS = WSP<int>(F, WS_POS); const float* TOPW = WSP<float>(F, WS_TOPW);
    for (int r = gw; r < nrows; r += NGW) {
        const int mr = modrow_of(r);
        f32x4 v[4];
        if (mode == 0) {
            const float* xr = (r < NLAT) ? IN_(F, 0) + (size_t)r * DM : IN_(F, 2) + (size_t)(r - NLAT) * DM;
#pragma unroll
            for (int j = 0; j < 4; ++j) v[j] = *(const f32x4*)(xr + 4 * lane + 256 * j);
        } else {
            const float* xm = WSP<float>(F, WS_XM) + (size_t)r * DM;
            const float* g2 = mod_ptr(F, 0, mr, 5);
            f32x4 s[4];
#pragma unroll
            for (int j = 0; j < 4; ++j) s[j] = (f32x4){0.f, 0.f, 0.f, 0.f};
#pragma unroll
            for (int k = 0; k < 4; ++k) {
                const int p = POS[r * 4 + k]; const float w = TOPW[r * 4 + k];
                const bf16* yr = Y + (size_t)p * DM;
#pragma unroll
                for (int j = 0; j < 4; ++j) { const u32x2 y2 = *(const u32x2*)(yr + 4 * lane + 256 * j);
                    s[j][0] += w * __uint_as_float(y2.x << 16); s[j][1] += w * __uint_as_float(y2.x & 0xffff0000u);
                    s[j][2] += w * __uint_as_float(y2.y << 16); s[j][3] += w * __uint_as_float(y2.y & 0xffff0000u); }
            }
            if (mode == 2) {   }
            const float* g2l = (mode == 2) ? mod_ptr(F, 1, mr, 5) : g2;
#pragma unroll
            for (int j = 0; j < 4; ++j) { const f32x4 x = *(const f32x4*)(xm + 4 * lane + 256 * j); const f32x4 g = *(const f32x4*)(g2l + 4 * lane + 256 * j); v[j] = x + g * s[j]; }
            if (mode == 1) { float* xo = WSP<float>(F, WS_XO) + (size_t)r * DM;
#pragma unroll
                for (int j = 0; j < 4; ++j) *(f32x4*)(xo + 4 * lane + 256 * j) = v[j]; }
        }
        float ss = 0.f;
#pragma unroll
        for (int j = 0; j < 4; ++j) ss += (v[j][0] * v[j][0] + v[j][1] * v[j][1]) + (v[j][2] * v[j][2] + v[j][3] * v[j][3]);
        const float rstd = 1.0f / sqrtf(wave_sum(ss) * (1.0f / DM) + EPS);
        if (mode == 2) {
            const float* fg = IN_(F, 30); float* o = OUT_(F) + (size_t)r * DM;
#pragma unroll
            for (int j = 0; j < 4; ++j) { const f32x4 g = *(const f32x4*)(fg + 4 * lane + 256 * j); *(f32x4*)(o + 4 * lane + 256 * j) = v[j] * rstd * g; }
        } else {
            const float* gw_ = IN_(F, 6) + l * DM; const float* sh = mod_ptr(F, l, mr, 0); const float* sc = mod_ptr(F, l, mr, 1);
            bf16* o = WSP<bf16>(F, WS_XN) + (size_t)r * DM;
#pragma unroll
            for (int j = 0; j < 4; ++j) { const f32x4 g = *(const f32x4*)(gw_ + 4 * lane + 256 * j); const f32x4 a = *(const f32x4*)(sh + 4 * lane + 256 * j); const f32x4 b = *(const f32x4*)(sc + 4 * lane + 256 * j);
                const f32x4 y = v[j] * rstd * g * (b + 1.0f) + a;
                u32x2 w2; w2.x = pk2(y[0], y[1]); w2.y = pk2(y[2], y[3]); *(u32x2*)(o + 4 * lane + 256 * j) = w2; }
        }
    }
}

struct EpiP {
    static constexpr bool PERM = true, AFTER_DRAIN = false;
    bf16* O;
    __device__ __forceinline__ void operator()(const f32x4 (&acc)[2][2][4][2], const pg8::Unit& u, int wr, int wc, int fr, int fq) const {
        const int row0 = u.pm * 256 + wr * 64 + fr, col0 = u.pn * 256 + wc * 32 + 8 * fq;
#pragma unroll
        for (int ai = 0; ai < 2; ++ai)
#pragma unroll
            for (int m = 0; m < 4; ++m) { bf16* rowp = O + (size_t)(row0 + ai * 128 + m * 16) * INC + col0;
#pragma unroll
                for (int bj = 0; bj < 2; ++bj) { const f32x4 v0 = acc[ai][bj][m][0], v1 = acc[ai][bj][m][1];
                    u32x4 w; w.x = pk2(v0[0], v0[1]); w.y = pk2(v0[2], v0[3]); w.z = pk2(v1[0], v1[1]); w.w = pk2(v1[2], v1[3]);
                    *(u32x4*)(rowp + bj * 128) = w; } }
    }
};
template <int BR> struct EpiBranch {
    static constexpr bool PERM = false, AFTER_DRAIN = false;
    const bf16* P; const float* bgate; float* MF; bf16* Mo;
    __device__ __forceinline__ void operator()(const f32x4 (&acc)[2][2][4][2], const pg8::Unit& u, int wr, int wc, int fr, int fq) const {
        const int row0 = u.pm * 256 + wr * 64 + fr, col0 = u.pn * 256 + wc * 32 + 4 * fq;
#pragma unroll
        for (int ai = 0; ai < 2; ++ai)
#pragma unroll
            for (int m = 0; m < 4; ++m) { const size_t row = (size_t)(row0 + ai * 128 + m * 16);
#pragma unroll
                for (int bj = 0; bj < 2; ++bj)
#pragma unroll
                    for (int n = 0; n < 2; ++n) { const int col = col0 + bj * 128 + n * 16;
                        const u32x2 g2 = *(const u32x2*)(P + row * INC + C_MG + BR * 1024 + col);
                        const f32x4 bg = *(const f32x4*)(bgate + BR * 1024 + col);
                        f32x4 g; g[0] = sigmoidf_(__uint_as_float(g2.x << 16) + bg[0]); g[1] = sigmoidf_(__uint_as_float(g2.x & 0xffff0000u) + bg[1]);
                        g[2] = sigmoidf_(__uint_as_float(g2.y << 16) + bg[2]); g[3] = sigmoidf_(__uint_as_float(g2.y & 0xffff0000u) + bg[3]);
                        f32x4 v = g * acc[ai][bj][m][n];
                        float* mp = MF + row * DM + col;
                        if (BR > 0) v = v + *(const f32x4*)mp;
                        if (BR < 2) *(f32x4*)mp = v;
                        else { u32x2 w; w.x = pk2(v[0], v[1]); w.y = pk2(v[2], v[3]); *(u32x2*)(Mo + row * DM + col) = w; } } }
    }
};
struct EpiOut {
    static constexpr bool PERM = false, AFTER_DRAIN = false;
    const float* xlat; const float* xctx; const float* g1base; float* XM;
    __device__ __forceinline__ void operator()(const f32x4 (&acc)[2][2][4][2], const pg8::Unit& u, int wr, int wc, int fr, int fq) const {
        const int row0 = u.pm * 256 + wr * 64 + fr, col0 = u.pn * 256 + wc * 32 + 4 * fq;
#pragma unroll
        for (int ai = 0; ai < 2; ++ai)
#pragma unroll
            for (int m = 0; m < 4; ++m) { const int row = row0 + ai * 128 + m * 16;
                const float* xr = (row < NLAT) ? xlat + (size_t)row * DM : xctx + (size_t)(row - NLAT) * DM;
                const float* g1 = g1base + (size_t)modrow_of(row) * 6 * DM;
#pragma unroll
                for (int bj = 0; bj < 2; ++bj)
#pragma unroll
                    for (int n = 0; n < 2; ++n) { const int col = col0 + bj * 128 + n * 16;
                        const f32x4 x = *(const f32x4*)(xr + col), g = *(const f32x4*)(g1 + col);
                        *(f32x4*)(XM + (size_t)row * DM + col) = x + g * acc[ai][bj][m][n]; } }
    }
};
struct EpiMoe1 {
    static constexpr bool PERM = true, AFTER_DRAIN = false;
    const float* b1; bf16* ACT;
    __device__ __forceinline__ void operator()(const f32x4 (&acc)[2][2][4][2], const pg8::Unit& u, int wr, int wc, int fr, int fq) const {
        const int e = u.pn >> 3, p = u.pn & 7;
        const int row0 = u.pm * 256 + wr * 64 + fr, gcol0 = p * 128 + wc * 32 + 8 * fq;
        const float* bb = b1 + (size_t)e * 2048 + gcol0;
#pragma unroll
        for (int ai = 0; ai < 2; ++ai)
#pragma unroll
            for (int m = 0; m < 4; ++m) { bf16* rowp = ACT + (size_t)(row0 + ai * 128 + m * 16) * DFF + gcol0;
                unsigned w[4];
#pragma unroll
                for (int n = 0; n < 2; ++n) { const f32x4 bg = *(const f32x4*)(bb + 4 * n), bl = *(const f32x4*)(bb + 1024 + 4 * n);
                    float a[4];
#pragma unroll
                    for (int j = 0; j < 4; ++j) { float glu = acc[ai][0][m][n][j] + bg[j]; float lin = acc[ai][1][m][n][j] + bl[j];
                        glu = fminf(glu, 7.0f); lin = fminf(fmaxf(lin, -7.0f), 7.0f);
                        a[j] = glu * __builtin_amdgcn_rcpf(1.0f + __builtin_amdgcn_exp2f(-2.4554669595930156f * glu)) * (lin + 1.0f); }
                    w[2 * n] = pk2(a[0], a[1]); w[2 * n + 1] = pk2(a[2], a[3]); }
                u32x4 wv; wv.x = w[0]; wv.y = w[1]; wv.z = w[2]; wv.w = w[3];
                *(u32x4*)rowp = wv;
                asm volatile("" ::: "memory"); }
    }
};
struct EpiMoe2 {
    static constexpr bool PERM = true, AFTER_DRAIN = false;
    const float* b2; bf16* Y;
    __device__ __forceinline__ void operator()(const f32x4 (&acc)[2][2][4][2], const pg8::Unit& u, int wr, int wc, int fr, int fq) const {
        const int e = u.pn >> 2, p = u.pn & 3;
        const int row0 = u.pm * 256 + wr * 64 + fr, col0 = p * 256 + wc * 32 + 8 * fq;
        f32x4 bv[2][2];
#pragma unroll
        for (int bj = 0; bj < 2; ++bj)
#pragma unroll
            for (int n = 0; n < 2; ++n) bv[bj][n] = *(const f32x4*)(b2 + (size_t)e * 1024 + col0 + bj * 128 + 4 * n);
#pragma unroll
        for (int ai = 0; ai < 2; ++ai)
#pragma unroll
            for (int m = 0; m < 4; ++m) { bf16* rowp = Y + (size_t)(row0 + ai * 128 + m * 16) * DM + col0;
#pragma unroll
                for (int bj = 0; bj < 2; ++bj) { const f32x4 v0 = acc[ai][bj][m][0] + bv[bj][0], v1 = acc[ai][bj][m][1] + bv[bj][1];
                    u32x4 w; w.x = pk2(v0[0], v0[1]); w.y = pk2(v0[2], v0[3]); w.z = pk2(v1[0], v1[1]); w.w = pk2(v1[2], v1[3]);
                    *(u32x4*)(rowp + bj * 128) = w; } }
    }
};
struct MoeOrder {
    const LAS int* list; int n;
    __device__ __forceinline__ bool next(int i, pg8::Unit& u) const { if (i >= n) return false; u.pm = __builtin_amdgcn_readfirstlane(list[2 * i]); u.pn = __builtin_amdgcn_readfirstlane(list[2 * i + 1]); return true; }
    __device__ __forceinline__ void a_ready(const pg8::Unit&) const {}
    __device__ __forceinline__ void done(const pg8::Unit&) const {}
};
__device__ __forceinline__ int moe_list_units(Frame& F, int nN, LAS int* list) {
    const int* tl = WSP<int>(F, WS_TILES);
    const int T = __builtin_amdgcn_readfirstlane(tl[32]), total = T * nN;
    int n = 0;
#pragma unroll 1
    for (int i = 0;; ++i) {
        const int Lu = i * F.G + F.bx; if (Lu >= total) break;
        const int pm = Lu / nN, pnl = Lu % nN;
        int e = 0;
#pragma unroll 1
        for (int q = 1; q < 32; ++q) { const int tq = __builtin_amdgcn_readfirstlane(tl[q]); if (tq <= pm) e = q; }
        if (F.tid == 0) { list[2 * i] = pm; list[2 * i + 1] = e * nN + pnl; }
        n = i + 1;
    }
    __syncthreads();
    return n;
}

__device__ __forceinline__ void ph_rope(Frame& F) {
    bf16* P = WSP<bf16>(F, WS_P);
    const size_t total = (size_t)NLAT * 832, stride = (size_t)F.G * NTHR;
    for (size_t idx = (size_t)F.bx * NTHR + F.tid; idx < total; idx += stride) {
        const int row = (int)(idx / 832), pi = (int)(idx % 832), t = row & 4095;
        int c1, c2; float rev;
        if (pi < 512) {
            const int qk = pi >> 8, h = (pi >> 6) & 3, i = pi & 63;
            c1 = (qk ? C_RK : C_RQ) + h * 128 + i; c2 = c1 + 64;
            const float invf = __expf(-(float)i * (9.210340371976184f / 63.0f));
            rev = (float)t * invf * 0.15915494309189535f;
        } else {
            const int pj = pi - 512, hh = pj >> 5, w = pj & 31, half = w >> 4, i = w & 15;
            const int base = (hh < 8) ? (C_AQ + hh * 64) : (C_AK + (hh - 8) * 64);
            c1 = base + half * 32 + i; c2 = c1 + 16;
            const float invf = __expf(-(float)i * (9.210340371976184f / 16.0f));
            const float pos = half ? (float)(t & 63) : (float)(t >> 6);
            rev = pos * invf * 0.15915494309189535f;
        }
        const float cs = cos_rev(rev), sn = sin_rev(rev);
        bf16* pr = P + (size_t)row * INC;
        const float x1 = bf2f(pr[c1]), x2 = bf2f(pr[c2]);
        pr[c1] = f2bf(x1 * cs - x2 * sn); pr[c2] = f2bf(x1 * sn + x2 * cs);
    }
}

__device__ __forceinline__ void attn_naive_item(Frame& F, int l, int item) {
    const bf16* P = WSP<bf16>(F, WS_P);
    LAS float* Ks = (LAS float*)F.lds; LAS float* Vs = Ks + 64 * 64;
    const bool isctx = item >= 512;
    int b, kvh, qb;
    if (!isctx) { b = item >> 6; kvh = (item >> 5) & 1; qb = item & 31; } else { const int it = item - 512; b = it >> 2; kvh = (it >> 1) & 1; qb = it & 1; }
    const int qi = F.tid & 127, g = F.tid >> 7, h = kvh * 4 + g;
    const int qpos = qb * 128 + qi;
    const int rowq = isctx ? (NLAT + b * CTXL + qpos) : (b * SEQ + qpos);
    float q[64], o[64];
    { const bf16* qp = P + (size_t)rowq * INC + C_AQ + h * 64;
#pragma unroll
      for (int d = 0; d < 64; ++d) { q[d] = bf2f(qp[d]) * 0.125f; o[d] = 0.f; } }
    const float sink = IN_(F, 9)[l * 8 + h];
    float mrun = sink, lsum = 1.0f;
    const int nkc = isctx ? 4 : 10, start = qb * 128;
    for (int kc = 0; kc < nkc; ++kc) {
        __syncthreads();
        { const int key = F.tid >> 3, d0 = (F.tid & 7) * 8;
          const bool ctxchunk = isctx || kc >= 6;
          int row = -1;
          if (ctxchunk) row = NLAT + b * CTXL + (isctx ? kc : kc - 6) * 64 + key;
          else { const int kpos = start - 128 + kc * 64 + key; if (kpos >= 0 && kpos < SEQ) row = b * SEQ + kpos; }
          u32x4 kk = (u32x4){0u, 0u, 0u, 0u}, vv = kk;
          if (row >= 0) { kk = *(const u32x4*)(P + (size_t)row * INC + C_AK + kvh * 64 + d0); vv = *(const u32x4*)(P + (size_t)row * INC + C_AV + kvh * 64 + d0); }
          LAS float* kd = Ks + key * 64 + d0; LAS float* vd = Vs + key * 64 + d0;
          kd[0] = __uint_as_float(kk.x << 16); kd[1] = __uint_as_float(kk.x & 0xffff0000u); kd[2] = __uint_as_float(kk.y << 16); kd[3] = __uint_as_float(kk.y & 0xffff0000u);
          kd[4] = __uint_as_float(kk.z << 16); kd[5] = __uint_as_float(kk.z & 0xffff0000u); kd[6] = __uint_as_float(kk.w << 16); kd[7] = __uint_as_float(kk.w & 0xffff0000u);
          vd[0] = __uint_as_float(vv.x << 16); vd[1] = __uint_as_float(vv.x & 0xffff0000u); vd[2] = __uint_as_float(vv.y << 16); vd[3] = __uint_as_float(vv.y & 0xffff0000u);
          vd[4] = __uint_as_float(vv.z << 16); vd[5] = __uint_as_float(vv.z & 0xffff0000u); vd[6] = __uint_as_float(vv.w << 16); vd[7] = __uint_as_float(vv.w & 0xffff0000u); }
        __syncthreads();
        const bool ctxchunk = isctx || kc >= 6;
        for (int key = 0; key < 64; ++key) {
            bool valid = true;
            if (!ctxchunk) { const int kpos = start - 128 + kc * 64 + key; const int dd = qpos - kpos; valid = (kpos >= 0) && (kpos < SEQ) && (dd <= 128) && (dd >= -128); }
            float s = 0.f;
#pragma unroll
            for (int d = 0; d < 64; ++d) s += q[d] * Ks[key * 64 + d];
            if (valid) {
                const float mnew = fmaxf(mrun, s), sc = __expf(mrun - mnew), p = __expf(s - mnew);
                lsum = lsum * sc + p; mrun = mnew;
#pragma unroll
                for (int d = 0; d < 64; ++d) o[d] = o[d] * sc + p * Vs[key * 64 + d];
            }
        }
    }
    const float inv = 1.0f / lsum;
    bf16* op = WSP<bf16>(F, WS_ATT) + (size_t)rowq * 512 + h * 64;
#pragma unroll
    for (int d = 0; d < 64; d += 2) *(unsigned*)(op + d) = pk2(o[d] * inv, o[d + 1] * inv);
}

__device__ __forceinline__ void ret_naive_item(Frame& F, int l, int item) {
    const bf16* P = WSP<bf16>(F, WS_P);
    LAS float* Ks = (LAS float*)F.lds; LAS float* Vs = Ks + 32 * 128; LAS float* red = Vs + 32 * 128;
    const bool isctx = item >= 1024;
    int b, h, qb;
    if (!isctx) { b = item >> 7; h = (item >> 5) & 3; qb = item & 31; } else { const int it = item - 1024; b = it >> 3; h = (it >> 1) & 3; qb = it & 1; }
    const int quarter = F.wave >> 1, qi = (F.wave & 1) * 64 + F.lane;
    const int n = qb * 128 + qi;
    const int rowq = isctx ? (NLAT + b * CTXL + n) : (b * SEQ + n);
    const float LOG2E = 1.4426950408889634f;
    const float lgf = log_sigmoid_(IN_(F, 8)[l * 8 + h]) * LOG2E, lgb = log_sigmoid_(IN_(F, 8)[l * 8 + 4 + h]) * LOG2E;
    float q[128], y[32];
    { const bf16* qp = P + (size_t)rowq * INC + C_RQ + h * 128;
#pragma unroll
      for (int d = 0; d < 128; ++d) q[d] = bf2f(qp[d]); }
#pragma unroll
    for (int e = 0; e < 32; ++e) y[e] = 0.f;
    const int nch = isctx ? 8 : 136;
    for (int kc = 0; kc < nch; ++kc) {
        __syncthreads();
        const bool ctxchunk = isctx || kc >= 128;
        const int krow0 = ctxchunk ? (NLAT + b * CTXL + (isctx ? kc : kc - 128) * 32) : (b * SEQ + kc * 32);
        { const int key = F.tid >> 4, d0 = (F.tid & 15) * 8;
          const u32x4 kk = *(const u32x4*)(P + (size_t)(krow0 + key) * INC + C_RK + h * 128 + d0), vv = *(const u32x4*)(P + (size_t)(krow0 + key) * INC + C_RV + h * 128 + d0);
          LAS float* kd = Ks + key * 128 + d0; LAS float* vd = Vs + key * 128 + d0;
          kd[0] = __uint_as_float(kk.x << 16); kd[1] = __uint_as_float(kk.x & 0xffff0000u); kd[2] = __uint_as_float(kk.y << 16); kd[3] = __uint_as_float(kk.y & 0xffff0000u);
          kd[4] = __uint_as_float(kk.z << 16); kd[5] = __uint_as_float(kk.z & 0xffff0000u); kd[6] = __uint_as_float(kk.w << 16); kd[7] = __uint_as_float(kk.w & 0xffff0000u);
          vd[0] = __uint_as_float(vv.x << 16); vd[1] = __uint_as_float(vv.x & 0xffff0000u); vd[2] = __uint_as_float(vv.y << 16); vd[3] = __uint_as_float(vv.y & 0xffff0000u);
          vd[4] = __uint_as_float(vv.z << 16); vd[5] = __uint_as_float(vv.z & 0xffff0000u); vd[6] = __uint_as_float(vv.w << 16); vd[7] = __uint_as_float(vv.w & 0xffff0000u); }
        __syncthreads();
        for (int key = 0; key < 32; ++key) {
            float w;
            if (!ctxchunk) { const int m = kc * 32 + key; const int dd = n - m; w = (dd >= 0) ? __builtin_amdgcn_exp2f(lgf * (float)dd) : __builtin_amdgcn_exp2f(lgb * (float)(-dd)); }
            else if (!isctx) { const int j = (kc - 128) * 32 + key; w = __builtin_amdgcn_exp2f(lgf * (float)(n + CTXL - j)) + __builtin_amdgcn_exp2f(lgb * (float)(SEQ - n + j)); }
            else { const int j = kc * 32 + key; const int dd = n - j; w = (dd >= 0) ? __builtin_amdgcn_exp2f(lgf * (float)dd) : __builtin_amdgcn_exp2f(lgb * (float)(-dd)); }
            float s = 0.f;
#pragma unroll
            for (int d = 0; d < 128; ++d) s += q[d] * Ks[key * 128 + d];
            s *= w;
#pragma unroll
            for (int e = 0; e < 32; ++e) y[e] += s * Vs[key * 128 + quarter * 32 + e];
        }
    }
    const float ksc = 0.08838834764831845f;
    float ss = 0.f;
#pragma unroll
    for (int e = 0; e < 32; ++e) { y[e] *= ksc; ss += y[e] * y[e]; }
    __syncthreads();
    red[qi * 4 + quarter] = ss;
    __syncthreads();
    const float tot = (red[qi * 4 + 0] + red[qi * 4 + 1]) + (red[qi * 4 + 2] + red[qi * 4 + 3]);
    const float rs = 1.0f / sqrtf(tot * (1.0f / 128.0f) + EPS);
    const bf16* gp = P + (size_t)rowq * INC + C_RG + h * 128 + quarter * 32;
    bf16* op = WSP<bf16>(F, WS_RET) + (size_t)rowq * 512 + h * 128 + quarter * 32;
#pragma unroll
    for (int e = 0; e < 32; e += 2) *(unsigned*)(op + e) = pk2(y[e] * rs * siluf_(bf2f(gp[e])), y[e + 1] * rs * siluf_(bf2f(gp[e + 1])));
}

__device__ __forceinline__ float hy_sconv(const bf16* P, const float* cw, const float* cb, int base, int t, int L, int ch) {
    float a = cb[ch] + bf2f(P[(size_t)(base + t) * INC + C_HU + ch]) * cw[1536 + ch];
    if (t > 0) a += bf2f(P[(size_t)(base + t - 1) * INC + C_HU + ch]) * cw[ch];
    if (t + 1 < L) a += bf2f(P[(size_t)(base + t + 1) * INC + C_HU + ch]) * cw[2 * 1536 + ch];
    return a;
}
__device__ __forceinline__ void ph_hyprep(Frame& F, int l, bool do_ctx) {
    const bf16* P = WSP<bf16>(F, WS_P);
    const float* cw = IN_(F, 10) + l * 3 * 1536; const float* cb = IN_(F, 11) + l * 1536;
    float* ZT = WSP<float>(F, WS_ZT); float* ZTC = WSP<float>(F, WS_ZTC);
    const size_t total = (size_t)(do_ctx ? NROWS : NLAT) * 512, stride = (size_t)F.G * NTHR;
    for (size_t idx = (size_t)F.bx * NTHR + F.tid; idx < total; idx += stride) {
        const int row = (int)(idx >> 9), c = (int)(idx & 511);
        if (row < NLAT) { const int b = row >> 12, t = row & 4095;
            const float x1 = hy_sconv(P, cw, cb, b * SEQ, t, SEQ, 512 + c), v = hy_sconv(P, cw, cb, b * SEQ, t, SEQ, 1024 + c);
            ZT[((size_t)c * NB + b) * SEQ + t] = x1 * v;
        } else { const int j = row - NLAT, b = j >> 8, t = j & 255;
            const float x1 = hy_sconv(P, cw, cb, NLAT + b * CTXL, t, CTXL, 512 + c), v = hy_sconv(P, cw, cb, NLAT + b * CTXL, t, CTXL, 1024 + c);
            ZTC[((size_t)c * NB + b) * CTXL + t] = x1 * v;
        }
    }
}
__device__ __forceinline__ void hyconv_naive_item(Frame& F, int l, int item) {
    const int c = item >> 1, bh = item & 1;
    LAS float* Kc = (LAS float*)F.lds;
    LAS float* Zs = Kc + 8192;
    const float* HFp = WSP<float>(F, WS_HF + (size_t)l * 16 * MiB); const float* HBp = WSP<float>(F, WS_HF + (size_t)l * 16 * MiB + 8 * MiB);
    const float il1 = hy_inv_l1(F, l, c);
    const float* ZT = WSP<float>(F, WS_ZT) + ((size_t)c * NB + bh * 4) * SEQ;
    __syncthreads();
    for (int i = F.tid; i < 8191; i += NTHR) { const int d = i - 4095; Kc[i] = (d >= 0 ? HFp[(size_t)d * 512 + c] : HBp[(size_t)(-d) * 512 + c]) * il1; }
    for (int i = F.tid; i < 4 * SEQ; i += NTHR) { const int bb = i >> 12, s = i & 4095; Zs[s * 4 + bb] = ZT[i]; }
    __syncthreads();
    float acc[8][4];
#pragma unroll
    for (int i = 0; i < 8; ++i)
#pragma unroll
        for (int bb = 0; bb < 4; ++bb) acc[i][bb] = 0.f;
    for (int s = 0; s < SEQ; ++s) {
        const f32x4 z = *(const LAS f32x4*)(Zs + s * 4);
#pragma unroll
        for (int i = 0; i < 8; ++i) { const float k = Kc[F.tid + 512 * i - s + 4095];
#pragma unroll
            for (int bb = 0; bb < 4; ++bb) acc[i][bb] += k * z[bb]; }
    }
    float* YT = WSP<float>(F, WS_YT) + ((size_t)c * NB + bh * 4) * SEQ;
#pragma unroll
    for (int i = 0; i < 8; ++i)
#pragma unroll
        for (int bb = 0; bb < 4; ++bb) YT[(size_t)bb * SEQ + F.tid + 512 * i] = acc[i][bb];
}
__device__ __forceinline__ void hyconv_ctx_item(Frame& F, int c) {
    const float* HFp = WSP<float>(F, WS_HFC); const float* HBp = WSP<float>(F, WS_HFC + 512 * 1024);
    const float il1 = hy_inv_l1(F, 2, c);
    const float* Z = WSP<float>(F, WS_ZTC) + (size_t)c * NB * CTXL; float* Yo = WSP<float>(F, WS_YTC) + (size_t)c * NB * CTXL;
#pragma unroll
    for (int i = 0; i < 4; ++i) {
        const int o = F.tid * 4 + i, b = o >> 8, t = o & 255;
        float a = 0.f;
        for (int s = 0; s < CTXL; ++s) { const int d = t - s; const float k = (d >= 0) ? HFp[(size_t)d * 512 + c] : HBp[(size_t)(-d) * 512 + c]; a += k * Z[b * CTXL + s]; }
        Yo[o] = a * il1;
    }
}
__device__ __forceinline__ void ph_hypost(Frame& F, int l, bool do_ctx) {
    const bf16* P = WSP<bf16>(F, WS_P);
    const float* cw = IN_(F, 10) + l * 3 * 1536; const float* cb = IN_(F, 11) + l * 1536; const float* skip = IN_(F, 19) + l * 512;
    const float* YT = WSP<float>(F, WS_YT); const float* YTC = WSP<float>(F, WS_YTC);
    bf16* HY = WSP<bf16>(F, WS_HY);
    const size_t total = (size_t)(do_ctx ? NROWS : NLAT) * 512, stride = (size_t)F.G * NTHR;
    for (size_t idx = (size_t)F.bx * NTHR + F.tid; idx < total; idx += stride) {
        const int row = (int)(idx >> 9), c = (int)(idx & 511);
        int base, t, L; float y;
        if (row < NLAT) { const int b = row >> 12; t = row & 4095; base = b * SEQ; L = SEQ; y = YT[((size_t)c * NB + b) * SEQ + t]; }
        else { const int j = row - NLAT, b = j >> 8; t = j & 255; base = NLAT + b * CTXL; L = CTXL; y = YTC[((size_t)c * NB + b) * CTXL + t]; }
        const float x0 = hy_sconv(P, cw, cb, base, t, L, c), x1 = hy_sconv(P, cw, cb, base, t, L, 512 + c), v = hy_sconv(P, cw, cb, base, t, L, 1024 + c);
        const float z = x1 * v;
        HY[(size_t)row * 512 + c] = f2bf(x0 * (y + skip[c] * z));
    }
}

__device__ __forceinline__ void ph_norm2_router(Frame& F, int l, int nrows) {
    const int lane = F.lane, RPB = nrows / 256;
    LAS float* RW = (LAS float*)F.lds;
    LAS unsigned* cnt = (LAS unsigned*)(F.lds + LDSX + 64);
    __syncthreads();
    { const float* rw = IN_(F, 24) + (size_t)l * 1024 * 32;
      for (int i = F.tid; i < 1024 * 32 / 4; i += NTHR) *(LAS f32x4*)(RW + 4 * i) = *(const f32x4*)(rw + 4 * i); }
    if (F.tid < 32) cnt[F.tid] = 0u;
    __syncthreads();
    const float* xm_all = WSP<float>(F, WS_XM);
    const float* gw_ = IN_(F, 23) + l * DM;
    const float rb = (lane < 32) ? IN_(F, 25)[l * 32 + lane] : 0.f;
    int* TOPI = WSP<int>(F, WS_TOPI); float* TOPW = WSP<float>(F, WS_TOPW);
    for (int rr = F.wave; rr < RPB; rr += NWAVES) {
        const int r = F.bx * RPB + rr, mr = modrow_of(r);
        const float* xr = xm_all + (size_t)r * DM;
        const float* sh = mod_ptr(F, l, mr, 3); const float* sc = mod_ptr(F, l, mr, 4);
        f32x4 v[4]; float ss = 0.f;
#pragma unroll
        for (int j = 0; j < 4; ++j) { v[j] = *(const f32x4*)(xr + 4 * lane + 256 * j); ss += (v[j][0] * v[j][0] + v[j][1] * v[j][1]) + (v[j][2] * v[j][2] + v[j][3] * v[j][3]); }
        const float rstd = 1.0f / sqrtf(wave_sum(ss) * (1.0f / DM) + EPS);
        bf16* o = WSP<bf16>(F, WS_XN) + (size_t)r * DM;
#pragma unroll
        for (int j = 0; j < 4; ++j) { const f32x4 g = *(const f32x4*)(gw_ + 4 * lane + 256 * j); const f32x4 a = *(const f32x4*)(sh + 4 * lane + 256 * j); const f32x4 b = *(const f32x4*)(sc + 4 * lane + 256 * j);
            v[j] = v[j] * rstd * g * (b + 1.0f) + a;
            u32x2 w2; w2.x = pk2(v[j][0], v[j][1]); w2.y = pk2(v[j][2], v[j][3]); *(u32x2*)(o + 4 * lane + 256 * j) = w2; }
        float acc = 0.f;
        const int e = lane & 31, hf = lane >> 5;
#pragma unroll 4
        for (int src = 0; src < 64; ++src) {
#pragma unroll
            for (int jj = 0; jj < 2; ++jj)
#pragma unroll
                for (int q = 0; q < 4; ++q) {
                    const float h0 = rdlane(v[jj][q], src), h1 = rdlane(v[jj + 2][q], src);
                    const float hv = hf ? h1 : h0;
                    const int col = 4 * src + 256 * (jj + 2 * hf) + q;
                    acc += hv * RW[col * 32 + e];
                }
        }
        acc += __shfl_xor(acc, 32);
        float logit = acc + rb;
        logit = __shfl(logit, e);
        float tv[4]; int ti[4];
        float cur = logit;
#pragma unroll
        for (int k = 0; k < 4; ++k) {
            float bvv = cur; int bi = e;
#pragma unroll
            for (int off = 1; off < 32; off <<= 1) { const float ov = __shfl_xor(bvv, off); const int oi = __shfl_xor(bi, off);
                if (ov > bvv || (ov == bvv && oi < bi)) { bvv = ov; bi = oi; } }
            tv[k] = bvv; ti[k] = bi;
            if (e == bi) cur = -3.0e38f;
        }
        const float mx = tv[0];
        float ex[4], den = 0.f;
#pragma unroll
        for (int k = 0; k < 4; ++k) { ex[k] = __expf(tv[k] - mx); den += ex[k]; }
        if (lane < 4) { const int k = lane; const int id = (k == 0) ? ti[0] : (k == 1) ? ti[1] : (k == 2) ? ti[2] : ti[3]; const float wv = ((k == 0) ? ex[0] : (k == 1) ? ex[1] : (k == 2) ? ex[2] : ex[3]) / den;
            TOPI[r * 4 + k] = id; TOPW[r * 4 + k] = wv; __hip_atomic_fetch_add(cnt + id, 1u, __ATOMIC_RELAXED, __HIP_MEMORY_SCOPE_WORKGROUP); }
    }
    __syncthreads();
    if (F.tid < 32) WSP<int>(F, WS_BLKCNT)[F.bx * 32 + F.tid] = (int)cnt[F.tid];
}

__device__ __forceinline__ void ph_moe_assign(Frame& F, int nrows) {
    const int RPB = nrows / 256, lane = F.lane;
    LAS int* part = (LAS int*)F.lds;
    LAS int* base = part + 1024;
    LAS int* idx = base + 32;
    LAS int* posl = idx + 1024;
    const int* BC = WSP<int>(F, WS_BLKCNT);
    __syncthreads();
    { const int e = F.tid & 31, pt = F.tid >> 5; int st = 0, sp = 0;
      for (int q = 0; q < 16; ++q) { const int blk = pt * 16 + q; const int v = BC[blk * 32 + e]; st += v; if (blk < F.bx) sp += v; }
      part[pt * 32 + e] = st; part[512 + pt * 32 + e] = sp; }
    for (int i = F.tid; i < RPB * 4; i += NTHR) idx[i] = WSP<int>(F, WS_TOPI)[F.bx * RPB * 4 + i];
    __syncthreads();
    if (F.tid < 32) { int st = 0, sp = 0; for (int q = 0; q < 16; ++q) { st += part[q * 32 + F.tid]; sp += part[512 + q * 32 + F.tid]; }
        part[F.tid] = st; part[512 + F.tid] = sp; }
    __syncthreads();
    if (F.tid == 0) { int t0 = 0; int* tl = WSP<int>(F, WS_TILES);
        for (int e = 0; e < 32; ++e) { base[e] = t0 * 256 + part[512 + e]; if (F.bx == 0) tl[e] = t0; t0 += (part[e] + 255) >> 8; }
        if (F.bx == 0) tl[32] = t0; }
    __syncthreads();
    if (F.tid < 32) { const int e = F.tid; int c = base[e]; for (int j = 0; j < RPB * 4; ++j) if (idx[j] == e) posl[j] = c++; }
    __syncthreads();
    const bf16* H = WSP<bf16>(F, WS_XN); bf16* HS = WSP<bf16>(F, WS_HS); int* POS = WSP<int>(F, WS_POS);
    for (int rr = F.wave; rr < RPB; rr += NWAVES) {
        const int r = F.bx * RPB + rr;
        const u32x4 a = *(const u32x4*)(H + (size_t)r * DM + 8 * lane), b = *(const u32x4*)(H + (size_t)r * DM + 512 + 8 * lane);
#pragma unroll
        for (int k = 0; k < 4; ++k) { const int p = posl[rr * 4 + k];
            *(u32x4*)(HS + (size_t)p * DM + 8 * lane) = a; *(u32x4*)(HS + (size_t)p * DM + 512 + 8 * lane) = b; }
        if (lane < 4) POS[r * 4 + lane] = posl[rr * 4 + lane];
    }
}

#define PHASE_FN __device__ __forceinline__
PHASE_FN void P_prologue() { Frame F = make_frame(); p0_prologue(F); }
PHASE_FN void P_norm1(int mode) { Frame F = make_frame(); ph_norm1(F, mode); }
PHASE_FN void P_inproj(int l) { Frame F = make_frame();
    pg8::Gemm g{WSP<bf16>(F, WS_XN), WSP<bf16>(F, WS_WIN) + (size_t)l * INC * 1024, NROWS, INC, 1024};
    pg8::StaticOrder S; S.init(NROWS, INC, F.G, F.bx);
    EpiP E{WSP<bf16>(F, WS_P)};
    pg8::gemm_phase<EpiP, pg8::StaticOrder, true, true>(F.lds, g, S, E); }
PHASE_FN void P_rope() { Frame F = make_frame(); ph_rope(F); }
PHASE_FN void P_mix(int l) { Frame F = make_frame(); const bool last = (l == 1);
    const int na = last ? 512 : 544, nr = last ? 1024 : 1088;
    for (int it = F.bx; it < na; it += F.G) attn_naive_item(F, l, it);
    for (int it = F.bx; it < nr; it += F.G) ret_naive_item(F, l, it);
    ph_hyprep(F, l, !last); }
PHASE_FN void P_hyconv(int l) { Frame F = make_frame(); const bool last = (l == 1);
    for (int it = F.bx; it < 1024; it += F.G) hyconv_naive_item(F, l, it);
    if (!last) for (int it = F.bx; it < 512; it += F.G) hyconv_ctx_item(F, it); }
PHASE_FN void P_hypost(int l) { Frame F = make_frame(); ph_hypost(F, l, l == 0); }
template <int BR> PHASE_FN void P_branch(int l) { Frame F = make_frame(); const int mrows = (l == 1) ? NLAT : NROWS;
    const bf16* A = WSP<bf16>(F, BR == 0 ? WS_RET : (BR == 1 ? WS_ATT : WS_HY));
    pg8::Gemm g{A, WSP<bf16>(F, WS_WBR) + (size_t)(l * 3 + BR) * 1024 * 512, mrows, 1024, 512};
    pg8::StaticOrder S; S.init(mrows, 1024, F.G, F.bx);
    EpiBranch<BR> E{WSP<bf16>(F, WS_P), IN_(F, 21) + l * 3072, WSP<float>(F, WS_MF32), WSP<bf16>(F, WS_M)};
    pg8::gemm_phase<EpiBranch<BR>, pg8::StaticOrder, true, true>(F.lds, g, S, E); }
PHASE_FN void P_out(int l) { Frame F = make_frame(); const int mrows = (l == 1) ? NLAT : NROWS;
    pg8::Gemm g{WSP<bf16>(F, WS_M), WSP<bf16>(F, WS_WOUT) + (size_t)l * 1024 * 1024, mrows, 1024, 1024};
    pg8::StaticOrder S; S.init(mrows, 1024, F.G, F.bx);
    const float* xl = (l == 0) ? IN_(F, 0) : WSP<float>(F, WS_XO);
    const float* xc = (l == 0) ? IN_(F, 2) : WSP<float>(F, WS_XO) + (size_t)NLAT * DM;
    EpiOut E{xl, xc, mod_ptr(F, l, 0, 2), WSP<float>(F, WS_XM)};
    pg8::gemm_phase<EpiOut, pg8::StaticOrder, true, true>(F.lds, g, S, E); }
PHASE_FN void P_router(int l) { Frame F = make_frame(); ph_norm2_router(F, l, (l == 1) ? NLAT : NROWS); }
PHASE_FN void P_assign(int l) { Frame F = make_frame(); ph_moe_assign(F, (l == 1) ? NLAT : NROWS); }
PHASE_FN void P_moe1(int l) { Frame F = make_frame();
    LAS int* list = (LAS int*)(F.lds + LDSX + 256);
    const int n = moe_list_units(F, 8, list);
    pg8::Gemm g{WSP<bf16>(F, WS_HS), WSP<bf16>(F, WS_W1) + (size_t)l * 32 * 2048 * 1024, MPAD, 32 * 2048, 1024};
    MoeOrder S{list, n};
    EpiMoe1 E{IN_(F, 27) + (size_t)l * 32 * 2048, WSP<bf16>(F, WS_ACT)};
    pg8::gemm_phase<EpiMoe1, MoeOrder, true, true>(F.lds, g, S, E); }
PHASE_FN void P_moe2(int l) { Frame F = make_frame();
    LAS int* list = (LAS int*)(F.lds + LDSX + 256);
    const int n = moe_list_units(F, 4, list);
    pg8::Gemm g{WSP<bf16>(F, WS_ACT), WSP<bf16>(F, WS_W2) + (size_t)l * 32 * 1024 * 1024, MPAD, 32 * 1024, 1024};
    MoeOrder S{list, n};
    EpiMoe2 E{IN_(F, 29) + (size_t)l * 32 * 1024, WSP<bf16>(F, WS_HS)};
    pg8::gemm_phase<EpiMoe2, MoeOrder, true, true>(F.lds, g, S, E); }

template <int ONLY> __global__ void __launch_bounds__(NTHR, 2) mk_fwd(Args args) {
    LAS unsigned char* lds = (LAS unsigned char*)lds_raw;
    const int tid = threadIdx.x;
    for (int u = tid; u < (LDS_BYTES - LDSX) / 4; u += NTHR) ((LAS unsigned*)(lds + LDSX))[u] = 0u;
    __syncthreads();
    if (tid < 33) { const unsigned long long v = (tid < 31) ? (unsigned long long)args.in[tid] : (tid == 31 ? (unsigned long long)args.out : (unsigned long long)args.ws);
        *(LAS unsigned long long*)(lds + LDS_PTAB + 8 * tid) = v; }
    __syncthreads();
    const int lo = args.ph_lo, hi = args.ph_hi;
    const bool one_launch = (hi - lo) > 1;
    unsigned* barw = (unsigned*)(args.ws + WS_CTL + CTL_BAR);
    XcdBarrier bar; bar.bar = barw; bar.x = 0; bar.st = nullptr;
    if (one_launch) bar = xcd_barrier_post(barw, (volatile LAS unsigned*)(lds + LDSX));
#ifndef MK_MASK
#define MK_MASK 0xFFFFFFFFu
#endif
#define ENAB(k) ((ONLY < 0 && ((MK_MASK >> ((k) >= 100 ? (k) - 100 + 14 : (k))) & 1u)) || ONLY == (k))
#define IN(k) (lo <= (k) && (k) < hi)
#define SEAM(k) do { if (IN(k) && IN((k) + 1)) xcd_barrier(bar); } while (0)
    if (ENAB(100)) if (IN(0)) { P_prologue(); } SEAM(0);
    for (int l = 0; l < 2; ++l) {
        const int pb = 1 + NPH_LAYER * l;
        if (ENAB(0)) if (IN(pb + 0)) { P_norm1(l == 0 ? 0 : 1); } SEAM(pb + 0);
        if (ENAB(1)) if (IN(pb + 1)) { P_inproj(l); } SEAM(pb + 1);
        if (ENAB(2)) if (IN(pb + 2)) { P_rope(); } SEAM(pb + 2);
        if (ENAB(3)) if (IN(pb + 3)) { P_mix(l); } SEAM(pb + 3);
        if (ENAB(4)) if (IN(pb + 4)) { P_hyconv(l); } SEAM(pb + 4);
        if (ENAB(5)) if (IN(pb + 5)) { P_hypost(l); } SEAM(pb + 5);
        if (ENAB(6)) if (IN(pb + 6)) { P_branch<0>(l); } SEAM(pb + 6);
        if (ENAB(7)) if (IN(pb + 7)) { P_branch<1>(l); } SEAM(pb + 7);
        if (ENAB(8)) if (IN(pb + 8)) { P_branch<2>(l); } SEAM(pb + 8);
        if (ENAB(9)) if (IN(pb + 9)) { P_out(l); } SEAM(pb + 9);
        if (ENAB(10)) if (IN(pb + 10)) { P_router(l); } SEAM(pb + 10);
        if (ENAB(11)) if (IN(pb + 11)) { P_assign(l); } SEAM(pb + 11);
        if (ENAB(12)) if (IN(pb + 12)) { P_moe1(l); } SEAM(pb + 12);
        if (ENAB(13)) if (IN(pb + 13)) { P_moe2(l); } SEAM(pb + 13);
    }
    if (ENAB(101)) if (IN(NPH - 1)) { P_norm1(2); }
#undef IN
#undef SEAM
#undef ENAB
}

template <int ONLY> static void launch_phase(Args a, int lo, int hi, int grid, hipStream_t stream) {
    static bool attr_set = false;
    if (!attr_set) { (void)hipFuncSetAttribute((const void*)mk_fwd<ONLY>, hipFuncAttributeMaxDynamicSharedMemorySize, LDS_BYTES); attr_set = true; }
    a.ph_lo = lo; a.ph_hi = hi;
    hipLaunchKernelGGL(mk_fwd<ONLY>, dim3(grid), dim3(NTHR), LDS_BYTES, stream, a);
}
extern "C" void kernel_launch(void* const* d_in, const int* in_sizes, int n_in, void* d_out, int out_size, void* d_ws, size_t ws_size, hipStream_t stream) {
    static int grid = 0;
    if (grid == 0) {
        if (n_in != 31 || ws_size < WS_END) { fprintf(stderr, "kernel_launch: unexpected n_in %d / ws_size %zu\n", n_in, ws_size); grid = -1; return; }
        int dev = 0, cus = 0;
        if (hipGetDevice(&dev) != hipSuccess || hipDeviceGetAttribute(&cus, hipDeviceAttributeMultiprocessorCount, dev) != hipSuccess) { grid = -1; return; }
        grid = (cus == 256) ? 256 : -1;
        if (grid < 0) { fprintf(stderr, "kernel_launch: needs a 256-CU device, got %d\n", cus); return; }
    }
    if (grid < 0) return;
    (void)hipMemsetAsync((char*)d_ws + WS_CTL, 0, CTL_ZERO_BYTES, stream);
    Args a{};
    for (int i = 0; i < 31; ++i) a.in[i] = (const float*)d_in[i];
    a.out = (float*)d_out; a.ws = (unsigned char*)d_ws;
#if MK_ONE_LAUNCH
    launch_phase<-1>(a, 0, NPH, grid, stream);
#else
    launch_phase<100>(a, 0, 1, grid, stream);
    for (int l = 0; l < 2; ++l) {
        const int pb = 1 + NPH_LAYER * l;
        launch_phase<0>(a, pb + 0, pb + 1, grid, stream);   launch_phase<1>(a, pb + 1, pb + 2, grid, stream);   launch_phase<2>(a, pb + 2, pb + 3, grid, stream);
        launch_phase<3>(a, pb + 3, pb + 4, grid, stream);   launch_phase<4>(a, pb + 4, pb + 5, grid, stream);   launch_phase<5>(a, pb + 5, pb + 6, grid, stream);
        launch_phase<6>(a, pb + 6, pb + 7, grid, stream);   launch_phase<7>(a, pb + 7, pb + 8, grid, stream);   launch_phase<8>(a, pb + 8, pb + 9, grid, stream);
        launch_phase<9>(a, pb + 9, pb + 10, grid, stream);  launch_phase<10>(a, pb + 10, pb + 11, grid, stream); launch_phase<11>(a, pb + 11, pb + 12, grid, stream);
        launch_phase<12>(a, pb + 12, pb + 13, grid, stream); launch_phase<13>(a, pb + 13, pb + 14, grid, stream);
    }
    launch_phase<101>(a, NPH - 1, NPH, grid, stream);
#endif
}
```

```cpp
#include <hip/hip_runtime.h>
#include <cstdio>
#include <cstdint>
#define MK_ONE_LAUNCH 1
namespace pg8 {
#define PG8_LAS __attribute__((address_space(3)))
typedef unsigned short bf16_t;
typedef short bf16x8 __attribute__((ext_vector_type(8)));
typedef float f32x4 __attribute__((ext_vector_type(4)));
typedef unsigned u32x4 __attribute__((ext_vector_type(4)));
constexpr int BM = 256, BK = 64, HALF = 128, HTB = HALF * BK * 2  , STAGE_BYTES = 8 * HTB, NXCD = 8, WGM = 8;

__host__ __device__ __forceinline__ int lds_byte(int r, int c) { const int st = (r >> 4) * 2 + (c >> 5), rr = r & 15, cc = c & 31, ob = rr * 64 + cc * 2; return st * 1024 + (ob ^ (((ob >> 9) & 1) << 5)); }
__host__ __device__ __forceinline__ void stage_rc(int b, int& R, int& C) { const int st = b / 1024, sb = b % 1024, swz = sb ^ (((sb >> 9) & 1) << 5); R = (st >> 1) * 16 + swz / 64; C = (st & 1) * 32 + (swz % 64) / 2; }
__host__ __device__ __forceinline__ int perm32(int rho) { const int n = rho >> 4, i = rho & 15; return 8 * (i >> 2) + 4 * n + (i & 3); }

struct Unit { int pm, pn; };
struct Gemm { const bf16_t* A; const bf16_t* Bt; int M, N, K; };

struct StaticOrder {
    int nM, nN, nwg, G, c;
    __host__ __device__ void init(int M, int N, int G_, int c_) { nM = M / BM; nN = N / BM; nwg = nM * nN; G = G_; c = c_; }
    __host__ __device__ bool next(int i, Unit& u) const {
        const long L = (long)i * G + c; if (L >= nwg) return false;
        int wgid = (int)L; { const int q = nwg / NXCD, r = nwg % NXCD, xcd = wgid % NXCD, off = wgid / NXCD; wgid = (xcd < r ? xcd * (q + 1) : r * (q + 1) + (xcd - r) * q) + off; }
        const int nig = WGM * nN, gid = wgid / nig, fm = gid * WGM, gsz = (nM - fm) < WGM ? (nM - fm) : WGM;
        u.pm = fm + ((wgid % nig) % gsz); u.pn = (wgid % nig) / gsz; return true;
    }
    __device__ __forceinline__ void a_ready(const Unit&) const {}
    __device__ __forceinline__ void done(const Unit&) const {}
};

__device__ __forceinline__ unsigned cvt_pk_bf16(float lo, float hi) { unsigned r; asm volatile("v_cvt_pk_bf16_f32 %0, %1, %2" : "=v"(r) : "v"(lo), "v"(hi)); return r; }
template <class Epi, class Sched, bool ALIGN_EPI = false, bool SP2 = false>
__device__ __forceinline__ void gemm_phase(PG8_LAS unsigned char* lds, const Gemm g, const Sched& S, const Epi& E) {
    const int tid = threadIdx.x, wid = __builtin_amdgcn_readfirstlane(tid >> 6), lane = tid & 63, wr = wid >> 2, wc = wid & 3, fr = lane & 15, fq = lane >> 4;
    const int K = g.K, nt = K / BK;
    unsigned voffA[2], voffB[2];
#pragma unroll
    for (int i = 0; i < 2; ++i) { int R, C; stage_rc(tid * 16 + i * 8192, R, C); const int Rb = Epi::PERM ? ((R & ~31) + perm32(R & 31)) : R;
        voffA[i] = (unsigned)(R * K + C) * 2u; voffB[i] = (unsigned)(Rb * K + C) * 2u; }
    const size_t kstep = (size_t)(BK * 2);
    const size_t hstep = (size_t)HALF * K * 2;
    const size_t tstep = 2 * hstep;
    const unsigned ldsw = (unsigned)wid * 1024u;
    const int aoff = lds_byte(wr * 64 + fr, fq * 8), boff = lds_byte(wc * 32 + fr, fq * 8);
#define PG8_SA(b, h) (((b) * 2 + (h)) * HTB)
#define PG8_SB(b, h) ((4 + (b) * 2 + (h)) * HTB)
#define PG8_STAGE(bufoff, gbase, voff) do { _Pragma("unroll") for (int _i = 0; _i < 2; ++_i) \
        __builtin_amdgcn_global_load_lds((const unsigned*)((const char*)(gbase) + (voff)[_i]), (PG8_LAS unsigned*)(lds + (bufoff) + ldsw + _i * 8192), 16, 0, 0); } while (0)
#define PG8_LDA(dst, b, h) do { _Pragma("unroll") for (int m = 0; m < 4; ++m) _Pragma("unroll") for (int k = 0; k < 2; ++k) dst[m][k] = *(const PG8_LAS bf16x8*)(lds + PG8_SA(b, h) + aoff + m * 2048 + k * 1024); } while (0)
#define PG8_LDB(dst, b, h) do { _Pragma("unroll") for (int n = 0; n < 2; ++n) _Pragma("unroll") for (int k = 0; k < 2; ++k) dst[n][k] = *(const PG8_LAS bf16x8*)(lds + PG8_SB(b, h) + boff + n * 2048 + k * 1024); } while (0)
#define PG8_MMA(ai, bj, At, Bt) do { __builtin_amdgcn_s_setprio(1); _Pragma("unroll") for (int m = 0; m < 4; ++m) _Pragma("unroll") for (int n = 0; n < 2; ++n) _Pragma("unroll") for (int k = 0; k < 2; ++k) \
        acc[ai][bj][m][n] = __builtin_amdgcn_mfma_f32_16x16x32_bf16(Bt[n][k], At[m][k], acc[ai][bj][m][n], 0, 0, 0); __builtin_amdgcn_s_setprio(0); } while (0)
#define PG8_WAIT_V(n) asm volatile("s_waitcnt vmcnt(" #n ")" ::: "memory")
#define PG8_WAIT_L(n) asm volatile("s_waitcnt lgkmcnt(" #n ")" ::: "memory")
#define PG8_BAR __builtin_amdgcn_s_barrier()
#define PG8_SCHED __builtin_amdgcn_sched_barrier(0)
    Unit cur, nxt; int ui = 0;
    if (!S.next(0, cur)) return;
    f32x4 acc[2][2][4][2];
#pragma unroll
    for (int a = 0; a < 2; ++a)
#pragma unroll
        for (int b = 0; b < 2; ++b)
#pragma unroll
            for (int m = 0; m < 4; ++m)
#pragma unroll
                for (int n = 0; n < 2; ++n) acc[a][b][m][n] = (f32x4){0.f, 0.f, 0.f, 0.f};
    bf16x8 At[4][2], B0[2][2], B1[2][2];
    const char* cA = (const char*)g.A + (size_t)cur.pm * tstep; const char* cB = (const char*)g.Bt + (size_t)cur.pn * tstep;
    S.a_ready(cur);
    if constexpr (SP2) {
        PG8_STAGE(PG8_SB(0, 0), cB, voffB); PG8_STAGE(PG8_SB(0, 1), cB + hstep, voffB); PG8_STAGE(PG8_SA(0, 0), cA, voffA); PG8_STAGE(PG8_SA(0, 1), cA + hstep, voffA);
        if (wr == 1) PG8_BAR;
        PG8_WAIT_V(2); PG8_BAR;
        PG8_STAGE(PG8_SB(1, 0), cB + kstep, voffB); PG8_STAGE(PG8_SA(1, 0), cA + kstep, voffA); PG8_STAGE(PG8_SB(1, 1), cB + hstep + kstep, voffB);
        PG8_WAIT_V(6); PG8_BAR;
    } else {
        PG8_STAGE(PG8_SB(0, 0), cB, voffB); PG8_STAGE(PG8_SA(0, 0), cA, voffA); PG8_STAGE(PG8_SB(0, 1), cB + hstep, voffB); PG8_STAGE(PG8_SA(0, 1), cA + hstep, voffA);
        if (wr == 1) PG8_BAR;
        PG8_WAIT_V(4); PG8_BAR;
        PG8_STAGE(PG8_SB(1, 0), cB + kstep, voffB); PG8_STAGE(PG8_SA(1, 0), cA + kstep, voffA); PG8_STAGE(PG8_SB(1, 1), cB + hstep + kstep, voffB);
        PG8_WAIT_V(6); PG8_BAR;
    }
    for (;;) {
        const bool has_next = S.next(ui + 1, nxt);
        const char* nA = has_next ? (const char*)g.A + (size_t)nxt.pm * tstep : cA; const char* nB = has_next ? (const char*)g.Bt + (size_t)nxt.pn * tstep : cB;
        for (int t = 0; t < nt; t += 2) {
            const bool last = (t == nt - 2);
            const char* a1 = cA + (size_t)(t + 1) * kstep;
            const char* a2 = last ? nA : cA + (size_t)(t + 2) * kstep; const char* b2 = last ? nB : cB + (size_t)(t + 2) * kstep;
            const char* a3 = a2 + kstep; const char* b3 = b2 + kstep;
            if (last && has_next) S.a_ready(nxt);
            if constexpr (SP2) {
            PG8_LDB(B0, 0, 0); PG8_LDB(B1, 0, 1); PG8_SCHED; PG8_LDA(At, 0, 0); PG8_STAGE(PG8_SA(1, 1), a1 + hstep, voffA);
            PG8_WAIT_V(8); PG8_WAIT_L(0); PG8_BAR; PG8_MMA(0, 0, At, B0); PG8_MMA(0, 1, At, B1); PG8_BAR; PG8_SCHED;
            PG8_LDA(At, 0, 1); PG8_STAGE(PG8_SB(0, 0), b2, voffB); PG8_STAGE(PG8_SB(0, 1), b2 + hstep, voffB); PG8_STAGE(PG8_SA(0, 0), a2, voffA);
            PG8_WAIT_V(8); PG8_WAIT_L(0); PG8_BAR; PG8_MMA(1, 0, At, B0); PG8_MMA(1, 1, At, B1); PG8_BAR; PG8_SCHED;
            PG8_LDB(B0, 1, 0); PG8_LDB(B1, 1, 1); PG8_SCHED; PG8_LDA(At, 1, 0); PG8_STAGE(PG8_SA(0, 1), a2 + hstep, voffA);
            PG8_WAIT_V(8); PG8_WAIT_L(0); PG8_BAR; PG8_MMA(0, 0, At, B0); PG8_MMA(0, 1, At, B1); PG8_BAR; PG8_SCHED;
            PG8_LDA(At, 1, 1); PG8_STAGE(PG8_SB(1, 0), b3, voffB); PG8_STAGE(PG8_SB(1, 1), b3 + hstep, voffB); PG8_STAGE(PG8_SA(1, 0), a3, voffA);
            PG8_WAIT_V(8); PG8_WAIT_L(0); PG8_BAR; PG8_MMA(1, 0, At, B0); PG8_MMA(1, 1, At, B1); PG8_BAR; PG8_SCHED;
            } else {
            PG8_LDB(B0, 0, 0); PG8_SCHED; PG8_LDA(At, 0, 0); PG8_STAGE(PG8_SA(1, 1), a1 + hstep, voffA);
            PG8_WAIT_L(8); PG8_BAR; PG8_WAIT_L(0); PG8_MMA(0, 0, At, B0); PG8_BAR; PG8_SCHED;
            PG8_LDB(B1, 0, 1); PG8_STAGE(PG8_SB(0, 0), b2, voffB);
            PG8_BAR; PG8_WAIT_L(0); PG8_MMA(0, 1, At, B1); PG8_BAR;
            PG8_LDA(At, 0, 1); PG8_STAGE(PG8_SA(0, 0), a2, voffA);
            PG8_BAR; PG8_WAIT_L(0); PG8_MMA(1, 0, At, B0); PG8_BAR; PG8_SCHED;
            PG8_STAGE(PG8_SB(0, 1), b2 + hstep, voffB);
            PG8_WAIT_V(6); PG8_BAR; PG8_MMA(1, 1, At, B1); PG8_BAR;
            PG8_LDB(B0, 1, 0); PG8_SCHED; PG8_LDA(At, 1, 0); PG8_STAGE(PG8_SA(0, 1), a2 + hstep, voffA);
            PG8_WAIT_L(8); PG8_BAR; PG8_WAIT_L(0); PG8_MMA(0, 0, At, B0); PG8_BAR; PG8_SCHED;
            PG8_LDB(B1, 1, 1); PG8_STAGE(PG8_SB(1, 0), b3, voffB);
            PG8_BAR; PG8_WAIT_L(0); PG8_MMA(0, 1, At, B1); PG8_BAR;
            PG8_LDA(At, 1, 1); PG8_STAGE(PG8_SA(1, 0), a3, voffA);
            PG8_BAR; PG8_WAIT_L(0); PG8_MMA(1, 0, At, B0); PG8_BAR; PG8_SCHED;
            PG8_STAGE(PG8_SB(1, 1), b3 + hstep, voffB);
            PG8_WAIT_V(6); PG8_BAR; PG8_MMA(1, 1, At, B1); PG8_BAR;
            }
        }
        if constexpr (ALIGN_EPI) { if (wr == 0) PG8_BAR; }
        if constexpr (!Epi::AFTER_DRAIN) { E(acc, cur, wr, wc, fr, fq); S.done(cur); }
        if (!has_next) break;
#pragma unroll
        for (int a = 0; a < 2; ++a)
#pragma unroll
            for (int b = 0; b < 2; ++b)
#pragma unroll
                for (int m = 0; m < 4; ++m)
#pragma unroll
                    for (int n = 0; n < 2; ++n) acc[a][b][m][n] = (f32x4){0.f, 0.f, 0.f, 0.f};
        cur = nxt; cA = nA; cB = nB; ++ui;
        if constexpr (ALIGN_EPI) { if (wr == 1) PG8_BAR; }
    }
    PG8_WAIT_V(0);
    if constexpr (!ALIGN_EPI) { if (wr == 0) PG8_BAR; }
    PG8_BAR;
    if constexpr (Epi::AFTER_DRAIN) { E.fused(acc, cur, wr, wc, fr, fq, lds, wid, lane); S.done(cur); }
#undef PG8_SA
#undef PG8_SB
#undef PG8_STAGE
#undef PG8_LDA
#undef PG8_LDB
#undef PG8_MMA
#undef PG8_WAIT_V
#undef PG8_WAIT_L
#undef PG8_BAR
#undef PG8_SCHED
}
}
#define XB_TMO      128
#define XB_XCNT(j)  (256  + 64 * (j))
#define XB_XSUB(j)  (1280 + 64 * (j))
#define XB_XGEN(j)  (2304 + 64 * (j))
#define XB_TOP      3328
#define XB_TOPGEN   3392
#define XCD_BAR_WORDS 3456
#define XB_SPIN_CAP (1u << 18)
#define LAS __attribute__((address_space(3)))

__device__ __forceinline__ unsigned xb_ld(unsigned* p)              { return __hip_atomic_load(p, __ATOMIC_RELAXED, __HIP_MEMORY_SCOPE_AGENT); }
__device__ __forceinline__ unsigned xb_add(unsigned* p, unsigned v) { return __hip_atomic_fetch_add(p, v, __ATOMIC_RELAXED, __HIP_MEMORY_SCOPE_AGENT); }
__device__ __forceinline__ unsigned xb_xcc_id() { return (unsigned)__builtin_amdgcn_s_getreg((3 << 11) | 20) & 0xFu; }
#define XB_SPIN(cond, bar) do { unsigned _sp = 0; while (cond) { __builtin_amdgcn_s_sleep(1); \
    if ((++_sp & 255u) == 0u) { if (xb_ld(&(bar)[XB_TMO])) break; if (_sp > XB_SPIN_CAP) { atomicAdd(&(bar)[XB_TMO], 1u); break; } } } } while (0)

struct XcdBarrier {
    unsigned* bar; unsigned x;
    volatile LAS unsigned* st;
};

__device__ __forceinline__ XcdBarrier xcd_barrier_post(unsigned* bar, volatile LAS unsigned* st) {
    XcdBarrier b; b.bar = bar; b.x = xb_xcc_id(); b.st = st;
    if (threadIdx.x == 0) (void)xb_add(&bar[XB_XCNT(b.x)], 1u);
    return b;
}
__device__ __forceinline__ void xcd_barrier_complete(unsigned* bar, unsigned x, unsigned& nloc, unsigned& nx) {
    const unsigned G = gridDim.x * gridDim.y * gridDim.z;
    unsigned sum, cnt, mine, sp = 0u;
    for (;;) {
        sum = 0u; cnt = 0u; mine = 0u;
#pragma unroll
        for (unsigned j = 0; j < 16; ++j) { const unsigned c = xb_ld(&bar[XB_XCNT(j)]); sum += c; cnt += (c > 0u) ? 1u : 0u; mine = (j == x) ? c : mine; }
        if (sum == G) break;
        __builtin_amdgcn_s_sleep(1);
        if ((++sp & 255u) == 0u) { if (xb_ld(&bar[XB_TMO])) break; if (sp > XB_SPIN_CAP) { atomicAdd(&bar[XB_TMO], 1u); break; } }
    }
    nloc = mine > 0u ? mine : 1u; nx = cnt > 0u ? cnt : 1u;
}

__device__ __forceinline__ void xcd_barrier(const XcdBarrier& b) {
    asm volatile("s_waitcnt vmcnt(0)" ::: "memory");
    __syncthreads();
    if (threadIdx.x == 0) {
        unsigned* bar = b.bar;
        __builtin_amdgcn_s_waitcnt(0);
        unsigned nloc = b.st[0], nx = b.st[1];
        if (nloc == 0u) { xcd_barrier_complete(bar, b.x, nloc, nx); b.st[0] = nloc; b.st[1] = nx; }
        const unsigned old = xb_add(&bar[XB_XSUB(b.x)], 1u);
        const unsigned gen = old / nloc;
        if (old + 1u == (gen + 1u) * nloc) {
            __builtin_amdgcn_fence(__ATOMIC_RELEASE, "agent");
            asm volatile("s_waitcnt vmcnt(0)" ::: "memory");
            const unsigned og = xb_add(&bar[XB_TOP], 1u);
            const unsigned tg = og / nx;
            if (og + 1u == (tg + 1u) * nx) xb_add(&bar[XB_TOPGEN], 1u);
            else XB_SPIN(xb_ld(&bar[XB_TOPGEN]) == tg, bar);
            __builtin_amdgcn_fence(__ATOMIC_ACQUIRE, "agent");
            xb_add(&bar[XB_XGEN(b.x)], 1u);
            asm volatile("s_waitcnt vmcnt(0)" ::: "memory");
        } else {
            XB_SPIN(xb_ld(&bar[XB_XGEN(b.x)]) == gen, bar);
            __builtin_amdgcn_fence(__ATOMIC_ACQUIRE, "agent");
            asm volatile("s_waitcnt vmcnt(0)" ::: "memory");
        }
    }
    __syncthreads();
}

#define GAS __attribute__((address_space(1)))
typedef unsigned short bf16;
typedef float f32x4 __attribute__((ext_vector_type(4)));
typedef unsigned u32x4 __attribute__((ext_vector_type(4)));
typedef unsigned u32x2 __attribute__((ext_vector_type(2)));
constexpr int DM = 1024, NB = 8, SEQ = 4096, CTXL = 256, NLAT = NB * SEQ, NCTX = NB * CTXL, NROWS = NLAT + NCTX;
constexpr int INC = 7424;
constexpr int C_RQ = 0, C_RK = 512, C_RV = 1024, C_RG = 1536, C_AQ = 2048, C_AK = 2560, C_AV = 2688, C_HU = 2816, C_MG = 4352;
constexpr int NEXP = 32, DFF = 1024;
constexpr int MPAD = 147456;
constexpr float EPS = 1e-6f;
constexpr int NWAVES = 8, NTHR = 512;
constexpr int LDS_BYTES = 147456, LDSX = 139264;
constexpr int NPH_LAYER = 14, NPH = 1 + 2 * NPH_LAYER + 1;

constexpr size_t MiB = 1u << 20;
constexpr size_t WS_CTL = 0, CTL_ZERO_BYTES = 1 * MiB;
constexpr size_t CTL_BAR = 16384;
constexpr size_t CTL_MOD = 262144;
constexpr size_t WS_L1P = 5 * MiB;
constexpr size_t WS_TOPI = 1 * MiB, WS_TOPW = 2 * MiB, WS_POS = 3 * MiB, WS_BLKCNT = 4 * MiB, WS_TILES = 4 * MiB + 65536;
constexpr size_t WS_WIN = 8 * MiB, WS_WBR = 37 * MiB, WS_WOUT = 43 * MiB, WS_W1 = 48 * MiB, WS_W2 = 304 * MiB;
constexpr size_t WS_HF = 432 * MiB;
constexpr size_t WS_HFC = 464 * MiB;
constexpr size_t WS_XM = 466 * MiB, WS_XO = 602 * MiB, WS_XN = 738 * MiB;
constexpr size_t WS_A = 806 * MiB;
constexpr size_t WS_P = WS_A, WS_RET = WS_A + 494 * MiB, WS_ATT = WS_RET + 34 * MiB, WS_HY = WS_ATT + 34 * MiB;
constexpr size_t WS_HS = WS_A, WS_ACT = WS_A + 288 * MiB;
constexpr size_t WS_MF32 = 1406 * MiB, WS_M = 1542 * MiB;
constexpr size_t WS_ZT = 1610 * MiB, WS_ZTC = 1674 * MiB, WS_YT = 1678 * MiB, WS_YTC = 1742 * MiB;
constexpr size_t WS_KV = 1746 * MiB, WS_SP = 1882 * MiB, WS_HSPEC = 1950 * MiB, WS_END = 2014 * MiB;
static_assert(WS_HY + 34 * MiB <= WS_MF32 && WS_ACT + 288 * MiB <= WS_MF32, "region A");
static_assert((size_t)NROWS * INC * 2 <= 494 * MiB, "P size");

__device__ __forceinline__ float bf2f(bf16 v) { return __uint_as_float(((unsigned)v) << 16); }
__device__ __forceinline__ bf16 f2bf(float f) { unsigned u = __float_as_uint(f); u += 0x7FFFu + ((u >> 16) & 1u); return (bf16)(u >> 16); }
__device__ __forceinline__ unsigned pk2(float lo, float hi) { return pg8::cvt_pk_bf16(lo, hi); }
__device__ __forceinline__ float wave_sum(float v) {
#pragma unroll
    for (int o = 1; o < 64; o <<= 1) v += __shfl_xor(v, o);
    return v;
}
__device__ __forceinline__ float rdlane(float v, int l) { return __int_as_float(__builtin_amdgcn_readlane(__float_as_int(v), l)); }
__device__ __forceinline__ float sin_rev(float rev) { return __builtin_amdgcn_sinf(__builtin_amdgcn_fractf(rev)); }
__device__ __forceinline__ float cos_rev(float rev) { return __builtin_amdgcn_cosf(__builtin_amdgcn_fractf(rev)); }
__device__ __forceinline__ float sin_rad(float x) { return sin_rev(x * 0.15915494309189535f); }
__device__ __forceinline__ float sigmoidf_(float x) { return 1.0f / (1.0f + __expf(-x)); }
__device__ __forceinline__ float siluf_(float x) { return x / (1.0f + __expf(-x)); }
__device__ __forceinline__ float log_sigmoid_(float x) {
    const float y = __expf(-x);
    if (y < 0.1f) { return -(y * (1.0f + y * (-0.5f + y * (0.33333333f + y * (-0.25f + y * (0.2f + y * (-0.16666667f + y * (0.14285714f + y * (-0.125f))))))))); }
    return -logf(1.0f + y);
}
#define LDS_WAIT() asm volatile("s_waitcnt lgkmcnt(0)" ::: "memory")
#define VM_WAIT() asm volatile("s_waitcnt vmcnt(0)" ::: "memory")

struct Args { const float* in[31]; float* out; unsigned char* ws; int ph_lo, ph_hi; };

extern __shared__ __attribute__((aligned(16))) unsigned char lds_raw[];
constexpr int LDS_PTAB = LDSX + 1024;
struct Frame {
    LAS unsigned char* lds;
    int tid, lane, wave, G, bx;
    unsigned char* ws;
};
__device__ __forceinline__ unsigned long long ptab_read(int i) {
    const LAS unsigned* p = (const LAS unsigned*)((LAS unsigned char*)lds_raw + LDS_PTAB) + 2 * i;
    const unsigned lo = (unsigned)__builtin_amdgcn_readfirstlane((int)p[0]), hi = (unsigned)__builtin_amdgcn_readfirstlane((int)p[1]);
    return ((unsigned long long)hi << 32) | lo;
}
__device__ __forceinline__ const float* IN_(const Frame& F, int i) { return (const float*)ptab_read(i); }
__device__ __forceinline__ float* OUT_(const Frame& F) { return (float*)ptab_read(31); }
__device__ __forceinline__ Frame make_frame() {
    Frame F; F.lds = (LAS unsigned char*)lds_raw;
    int t = threadIdx.x; asm volatile("" : "+v"(t)); F.tid = t; F.lane = t & 63; F.wave = __builtin_amdgcn_readfirstlane(t >> 6);
    int g = gridDim.x, bx = blockIdx.x; asm volatile("" : "+s"(g), "+s"(bx)); F.G = g; F.bx = bx;
    unsigned long long w = ptab_read(32); asm volatile("" : "+s"(w)); F.ws = (unsigned char*)w; return F;
}
template <class T> __device__ __forceinline__ T* WSP(const Frame& F, size_t off) { return (T*)(F.ws + off); }
__device__ __forceinline__ const float* mod_ptr(const Frame& F, int l, int modrow, int chunk) { return WSP<float>(F, WS_CTL + CTL_MOD) + ((size_t)(l * 9 + modrow) * 6 + chunk) * DM; }
__device__ __forceinline__ int modrow_of(int r) { return r < NLAT ? (r >> 12) : 8; }

__device__ __forceinline__ void tr_item(const float* W, int K, int N, bf16* WT, int item, int w1map, LAS float* scr, int lane) {
    const int nblk = N / 32, kb = item / nblk, nb = item % nblk, k0 = 64 * kb, n0 = 32 * nb;
#pragma unroll 8
    for (int i = 0; i < 32; ++i) { const int kk = 2 * i + (lane >> 5); scr[kk * 33 + (lane & 31)] = W[(size_t)(k0 + kk) * N + n0 + (lane & 31)]; }
    LDS_WAIT(); asm volatile("" ::: "memory");
    int r0 = n0;
    if (w1map) r0 = (n0 < 1024) ? ((n0 >> 7) * 256 + (n0 & 127)) : ((((n0 - 1024) >> 7) * 256) + 128 + ((n0 - 1024) & 127));
    const int c = lane & 7;
#pragma unroll
    for (int j = 0; j < 4; ++j) { const int n = (lane >> 3) + 8 * j; const LAS float* s = scr + (8 * c) * 33 + n;
        u32x4 o; o.x = pk2(s[0 * 33], s[1 * 33]); o.y = pk2(s[2 * 33], s[3 * 33]); o.z = pk2(s[4 * 33], s[5 * 33]); o.w = pk2(s[6 * 33], s[7 * 33]);
        *(u32x4*)(WT + (size_t)(r0 + n) * K + k0 + 8 * c) = o; }
    LDS_WAIT(); asm volatile("" ::: "memory");
}

__device__ __forceinline__ void p0_prologue(Frame& F) {
    LAS float* scr = (LAS float*)(F.lds + F.wave * 16384);
    const int gw = F.bx * NWAVES + F.wave, NGW = F.G * NWAVES, lane = F.lane;
    constexpr int I_WIN = 16 * 232, I_WBR = 8 * 32, I_WOUT = 16 * 32, I_W1 = 16 * 64, I_W2 = 16 * 32;
    constexpr int N_WIN = 2 * I_WIN, N_WBR = 6 * I_WBR, N_WOUT = 2 * I_WOUT, N_W1 = 64 * I_W1, N_W2 = 64 * I_W2;
    constexpr int NTR = N_WIN + N_WBR + N_WOUT + N_W1 + N_W2;
    for (int it = gw; it < NTR; it += NGW) {
        int r = it;
        if (r < N_WIN) { const int l = r / I_WIN; tr_item(IN_(F, 7) + (size_t)l * 1024 * INC, 1024, INC, WSP<bf16>(F, WS_WIN) + (size_t)l * INC * 1024, r % I_WIN, 0, scr, lane); continue; } r -= N_WIN;
        if (r < N_WBR) { const int q = r / I_WBR; tr_item(IN_(F, 20) + (size_t)q * 512 * 1024, 512, 1024, WSP<bf16>(F, WS_WBR) + (size_t)q * 1024 * 512, r % I_WBR, 0, scr, lane); continue; } r -= N_WBR;
        if (r < N_WOUT) { const int l = r / I_WOUT; tr_item(IN_(F, 22) + (size_t)l * 1024 * 1024, 1024, 1024, WSP<bf16>(F, WS_WOUT) + (size_t)l * 1024 * 1024, r % I_WOUT, 0, scr, lane); continue; } r -= N_WOUT;
        if (r < N_W1) { const int q = r / I_W1; tr_item(IN_(F, 26) + (size_t)q * 1024 * 2048, 1024, 2048, WSP<bf16>(F, WS_W1) + (size_t)q * 2048 * 1024, r % I_W1, 1, scr, lane); continue; } r -= N_W1;
        { const int q = r / I_W2; tr_item(IN_(F, 28) + (size_t)q * 1024 * 1024, 1024, 1024, WSP<bf16>(F, WS_W2) + (size_t)q * 1024 * 1024, r % I_W2, 0, scr, lane); }
    }
    __syncthreads();
    {
        float* mod = WSP<float>(F, WS_CTL + CTL_MOD);
        LAS float* red = (LAS float*)F.lds;
        for (int it = F.bx; it < 2 * 96; it += F.G) {
            const int l = it / 96, cc = it % 96, col = cc * 64 + lane, k0 = F.wave * 128;
            const float* wm = IN_(F, 4) + (size_t)l * 1024 * 6144;
            float acc[9];
#pragma unroll
            for (int r = 0; r < 9; ++r) acc[r] = 0.f;
#pragma unroll 4
            for (int k = 0; k < 128; ++k) {
                const float w = wm[(size_t)(k0 + k) * 6144 + col];
#pragma unroll
                for (int r = 0; r < 9; ++r) { const float cv = (r < 8) ? IN_(F, 1)[r * 1024 + k0 + k] : IN_(F, 3)[k0 + k]; acc[r] += siluf_(cv) * w; }
            }
            __syncthreads();
#pragma unroll
            for (int r = 0; r < 9; ++r) red[(F.wave * 9 + r) * 64 + lane] = acc[r];
            __syncthreads();
            for (int idx = F.tid; idx < 576; idx += NTHR) { const int r = idx >> 6, c = idx & 63; float s = 0.f;
#pragma unroll
                for (int w = 0; w < 8; ++w) s += red[(w * 9 + r) * 64 + c];
                mod[(size_t)(l * 9 + r) * 6144 + cc * 64 + c] = s + IN_(F, 5)[l * 6144 + cc * 64 + c]; }
        }
    }
    {
        float* L1P = WSP<float>(F, WS_L1P);
        LAS float* red = (LAS float*)F.lds;
        for (int it = F.bx; it < 128 + 128 + 8; it += F.G) {
            const int f = it < 128 ? 0 : (it < 256 ? 1 : 2), tb = it - (f == 0 ? 0 : (f == 1 ? 128 : 256)), t0 = tb * 32 + F.wave * 4;
            const int L = (f == 2) ? 256 : 4096, l = (f == 1) ? 1 : 0;
            const float* w1 = IN_(F, 12) + l * 33 * 64; const float* b1 = IN_(F, 13) + l * 64; const float* f1 = IN_(F, 14) + l * 64;
            const float* w2 = IN_(F, 15) + l * 64 * 64; const float* b2 = IN_(F, 16) + l * 64; const float* f2 = IN_(F, 17) + l * 64;
            const float* w3 = IN_(F, 18) + (size_t)l * 64 * 1024;
            float* HFp = (f == 2) ? WSP<float>(F, WS_HFC) : WSP<float>(F, WS_HF + (size_t)l * 16 * MiB);
            float* HBp = (f == 2) ? WSP<float>(F, WS_HFC + 512 * 1024) : WSP<float>(F, WS_HF + (size_t)l * 16 * MiB + 8 * MiB);
            float h2r[4];
#pragma unroll
            for (int r = 0; r < 4; ++r) {
                const int n = t0 + r;
                float zl = 0.f;
                if (lane == 0) zl = (float)n / (float)(L - 1);
                else if (lane <= 32) { const int j = (lane - 1) & 15; const float band = 1e-4f + (15.0f - 1e-4f) * (float)j / 15.0f; const float rev = (float)n * band / (float)L;
                    zl = (lane <= 16) ? cos_rev(rev) : -sin_rev(rev); }
                float a = 0.f;
#pragma unroll
                for (int i = 0; i < 33; ++i) a += rdlane(zl, i) * w1[i * 64 + lane];
                const float h1 = sin_rad(f1[lane] * (a + b1[lane]));
                float a2 = 0.f;
#pragma unroll
                for (int i = 0; i < 64; ++i) a2 += rdlane(h1, i) * w2[i * 64 + lane];
                h2r[r] = sin_rad(f2[lane] * (a2 + b2[lane]));
            }
            float acc[4][16];
#pragma unroll
            for (int r = 0; r < 4; ++r)
#pragma unroll
                for (int q = 0; q < 16; ++q) acc[r][q] = 0.f;
#pragma unroll 2
            for (int i = 0; i < 64; ++i) {
                float hr[4];
#pragma unroll
                for (int r = 0; r < 4; ++r) hr[r] = __shfl(h2r[r], i);
#pragma unroll
                for (int q = 0; q < 16; ++q) { const float w = w3[i * 1024 + lane + 64 * q];
#pragma unroll
                    for (int r = 0; r < 4; ++r) acc[r][q] += hr[r] * w; }
            }
            __syncthreads();
#pragma unroll
            for (int q = 0; q < 16; ++q) {
                const int c = lane + 64 * q, cc = c & 511;
                const float delta = 3.0701134573253944f + (15.350567286626973f - 3.0701134573253944f) * (float)cc / 511.0f;
                float l1p = 0.f;
#pragma unroll
                for (int r = 0; r < 4; ++r) { const int n = t0 + r; const float tn = (float)n / (float)(L - 1); const float v = acc[r][q] * __expf(-tn * delta);
                    if (c < 512) HFp[(size_t)n * 512 + cc] = v; else HBp[(size_t)n * 512 + cc] = v;
                    if (c < 512 || n >= 1) l1p += fabsf(v); }
                red[F.wave * 1024 + c] = l1p;
            }
            __syncthreads();
            { const int cc = F.tid; float s = 0.f;
#pragma unroll
              for (int w = 0; w < 8; ++w) s += red[w * 1024 + cc] + red[w * 1024 + 512 + cc];
              L1P[(size_t)(f * 128 + tb) * 512 + cc] = s; }
        }
    }
}
__device__ __forceinline__ float hy_inv_l1(const Frame& F, int f, int c) {
    const float* L1P = WSP<float>(F, WS_L1P) + (size_t)f * 128 * 512 + c; const int nb = (f == 2) ? 8 : 128; float s = 0.f;
    for (int tb = 0; tb < nb; ++tb) s += L1P[(size_t)tb * 512];
    return 1.0f / s;
}

__device__ __forceinline__ void ph_norm1(Frame& F, int mode) {
    const int gw = F.bx * NWAVES + F.wave, NGW = F.G * NWAVES, lane = F.lane;
    const int nrows = (mode == 2) ? NLAT : NROWS;
    const int l = (mode == 0) ? 0 : 1;
    const bf16* Y = WSP<bf16>(F, WS_HS);
    const int* POS = WSP<int>(F, WS_POS); const float* TOPW = WSP<float>(F, WS_TOPW);
    for (int r = gw; r < nrows; r += NGW) {
        const int mr = modrow_of(r);
        f32x4 v[4];
        if (mode == 0) {
            const float* xr = (r < NLAT) ? IN_(F, 0) + (size_t)r * DM : IN_(F, 2) + (size_t)(r - NLAT) * DM;
#pragma unroll
            for (int j = 0; j < 4; ++j) v[j] = *(const f32x4*)(xr + 4 * lane + 256 * j);
        } else {
            const float* xm = WSP<float>(F, WS_XM) + (size_t)r * DM;
            const float* g2 = mod_ptr(F, 0, mr, 5);
            f32x4 s[4];
#pragma unroll
            for (int j = 0; j < 4; ++j) s[j] = (f32x4){0.f, 0.f, 0.f, 0.f};
#pragma unroll
            for (int k = 0; k < 4; ++k) {
                const int p = POS[r * 4 + k]; const float w = TOPW[r * 4 + k];
                const bf16* yr = Y + (size_t)p * DM;
#pragma unroll
                for (int j = 0; j < 4; ++j) { const u32x2 y2 = *(const u32x2*)(yr + 4 * lane + 256 * j);
                    s[j][0] += w * __uint_as_float(y2.x << 16); s[j][1] += w * __uint_as_float(y2.x & 0xffff0000u);
                    s[j][2] += w * __uint_as_float(y2.y << 16); s[j][3] += w * __uint_as_float(y2.y & 0xffff0000u); }
            }
            if (mode == 2) {   }
            const float* g2l = (mode == 2) ? mod_ptr(F, 1, mr, 5) : g2;
#pragma unroll
            for (int j = 0; j < 4; ++j) { const f32x4 x = *(const f32x4*)(xm + 4 * lane + 256 * j); const f32x4 g = *(const f32x4*)(g2l + 4 * lane + 256 * j); v[j] = x + g * s[j]; }
            if (mode == 1) { float* xo = WSP<float>(F, WS_XO) + (size_t)r * DM;
#pragma unroll
                for (int j = 0; j < 4; ++j) *(f32x4*)(xo + 4 * lane + 256 * j) = v[j]; }
        }
        float ss = 0.f;
#pragma unroll
        for (int j = 0; j < 4; ++j) ss += (v[j][0] * v[j][0] + v[j][1] * v[j][1]) + (v[j][2] * v[j][2] + v[j][3] * v[j][3]);
        const float rstd = 1.0f / sqrtf(wave_sum(ss) * (1.0f / DM) + EPS);
        if (mode == 2) {
            const float* fg = IN_(F, 30); float* o = OUT_(F) + (size_t)r * DM;
#pragma unroll
            for (int j = 0; j < 4; ++j) { const f32x4 g = *(const f32x4*)(fg + 4 * lane + 256 * j); *(f32x4*)(o + 4 * lane + 256 * j) = v[j] * rstd * g; }
        } else {
            const float* gw_ = IN_(F, 6) + l * DM; const float* sh = mod_ptr(F, l, mr, 0); const float* sc = mod_ptr(F, l, mr, 1);
            bf16* o = WSP<bf16>(F, WS_XN) + (size_t)r * DM;
#pragma unroll
            for (int j = 0; j < 4; ++j) { const f32x4 g = *(const f32x4*)(gw_ + 4 * lane + 256 * j); const f32x4 a = *(const f32x4*)(sh + 4 * lane + 256 * j); const f32x4 b = *(const f32x4*)(sc + 4 * lane + 256 * j);
                const f32x4 y = v[j] * rstd * g * (b + 1.0f) + a;
                u32x2 w2; w2.x = pk2(y[0], y[1]); w2.y = pk2(y[2], y[3]); *(u32x2*)(o + 4 * lane + 256 * j) = w2; }
        }
    }
}

struct EpiP {
    static constexpr bool PERM = true, AFTER_DRAIN = false;
    bf16* O;
    __device__ __forceinline__ void operator()(const f32x4 (&acc)[2][2][4][2], const pg8::Unit& u, int wr, int wc, int fr, int fq) const {
        const int row0 = u.pm * 256 + wr * 64 + fr, col0 = u.pn * 256 + wc * 32 + 8 * fq;
#pragma unroll
        for (int ai = 0; ai < 2; ++ai)
#pragma unroll
            for (int m = 0; m < 4; ++m) { bf16* rowp = O + (size_t)(row0 + ai * 128 + m * 16) * INC + col0;
#pragma unroll
                for (int bj = 0; bj < 2; ++bj) { const f32x4 v0 = acc[ai][bj][m][0], v1 = acc[ai][bj][m][1];
                    u32x4 w; w.x = pk2(v0[0], v0[1]); w.y = pk2(v0[2], v0[3]); w.z = pk2(v1[0], v1[1]); w.w = pk2(v1[2], v1[3]);
                    *(u32x4*)(rowp + bj * 128) = w; } }
    }
};
template <int BR> struct EpiBranch {
    static constexpr bool PERM = false, AFTER_DRAIN = false;
    const bf16* P; const float* bgate; float* MF; bf16* Mo;
    __device__ __forceinline__ void operator()(const f32x4 (&acc)[2][2][4][2], const pg8::Unit& u, int wr, int wc, int fr, int fq) const {
        const int row0 = u.pm * 256 + wr * 64 + fr, col0 = u.pn * 256 + wc * 32 + 4 * fq;
#pragma unroll
        for (int ai = 0; ai < 2; ++ai)
#pragma unroll
            for (int m = 0; m < 4; ++m) { const size_t row = (size_t)(row0 + ai * 128 + m * 16);
#pragma unroll
                for (int bj = 0; bj < 2; ++bj)
#pragma unroll
                    for (int n = 0; n < 2; ++n) { const int col = col0 + bj * 128 + n * 16;
                        const u32x2 g2 = *(const u32x2*)(P + row * INC + C_MG + BR * 1024 + col);
                        const f32x4 bg = *(const f32x4*)(bgate + BR * 1024 + col);
                        f32x4 g; g[0] = sigmoidf_(__uint_as_float(g2.x << 16) + bg[0]); g[1] = sigmoidf_(__uint_as_float(g2.x & 0xffff0000u) + bg[1]);
                        g[2] = sigmoidf_(__uint_as_float(g2.y << 16) + bg[2]); g[3] = sigmoidf_(__uint_as_float(g2.y & 0xffff0000u) + bg[3]);
                        f32x4 v = g * acc[ai][bj][m][n];
                        float* mp = MF + row * DM + col;
                        if (BR > 0) v = v + *(const f32x4*)mp;
                        if (BR < 2) *(f32x4*)mp = v;
                        else { u32x2 w; w.x = pk2(v[0], v[1]); w.y = pk2(v[2], v[3]); *(u32x2*)(Mo + row * DM + col) = w; } } }
    }
};
struct EpiOut {
    static constexpr bool PERM = false, AFTER_DRAIN = false;
    const float* xlat; const float* xctx; const float* g1base; float* XM;
    __device__ __forceinline__ void operator()(const f32x4 (&acc)[2][2][4][2], const pg8::Unit& u, int wr, int wc, int fr, int fq) const {
        const int row0 = u.pm * 256 + wr * 64 + fr, col0 = u.pn * 256 + wc * 32 + 4 * fq;
#pragma unroll
        for (int ai = 0; ai < 2; ++ai)
#pragma unroll
            for (int m = 0; m < 4; ++m) { const int row = row0 + ai * 128 + m * 16;
                const float* xr = (row < NLAT) ? xlat + (size_t)row * DM : xctx + (size_t)(row - NLAT) * DM;
                const float* g1 = g1base + (size_t)modrow_of(row) * 6 * DM;
#pragma unroll
                for (int bj = 0; bj < 2; ++bj)
#pragma unroll
                    for (int n = 0; n < 2; ++n) { const int col = col0 + bj * 128 + n * 16;
                        const f32x4 x = *(const f32x4*)(xr + col), g = *(const f32x4*)(g1 + col);
                        *(f32x4*)(XM + (size_t)row * DM + col) = x + g * acc[ai][bj][m][n]; } }
    }
};
struct EpiMoe1 {
    static constexpr bool PERM = true, AFTER_DRAIN = false;
    const float* b1; bf16* ACT;
    __device__ __forceinline__ void operator()(const f32x4 (&acc)[2][2][4][2], const pg8::Unit& u, int wr, int wc, int fr, int fq) const {
        const int e = u.pn >> 3, p = u.pn & 7;
        const int row0 = u.pm * 256 + wr * 64 + fr, gcol0 = p * 128 + wc * 32 + 8 * fq;
        const float* bb = b1 + (size_t)e * 2048 + gcol0;
#pragma unroll
        for (int ai = 0; ai < 2; ++ai)
#pragma unroll
            for (int m = 0; m < 4; ++m) { bf16* rowp = ACT + (size_t)(row0 + ai * 128 + m * 16) * DFF + gcol0;
                unsigned w[4];
#pragma unroll
                for (int n = 0; n < 2; ++n) { const f32x4 bg = *(const f32x4*)(bb + 4 * n), bl = *(const f32x4*)(bb + 1024 + 4 * n);
                    float a[4];
#pragma unroll
                    for (int j = 0; j < 4; ++j) { float glu = acc[ai][0][m][n][j] + bg[j]; float lin = acc[ai][1][m][n][j] + bl[j];
                        glu = fminf(glu, 7.0f); lin = fminf(fmaxf(lin, -7.0f), 7.0f);
                        a[j] = glu * __builtin_amdgcn_rcpf(1.0f + __builtin_amdgcn_exp2f(-2.4554669595930156f * glu)) * (lin + 1.0f); }
                    w[2 * n] = pk2(a[0], a[1]); w[2 * n + 1] = pk2(a[2], a[3]); }
                u32x4 wv; wv.x = w[0]; wv.y = w[1]; wv.z = w[2]; wv.w = w[3];
                *(u32x4*)rowp = wv;
                asm volatile("" ::: "memory"); }
    }
};
struct EpiMoe2 {
    static constexpr bool PERM = true, AFTER_DRAIN = false;
    const float* b2; bf16* Y;
    __device__ __forceinline__ void operator()(const f32x4 (&acc)[2][2][4][2], const pg8::Unit& u, int wr, int wc, int fr, int fq) const {
        const int e = u.pn >> 2, p = u.pn & 3;
        const int row0 = u.pm * 256 + wr * 64 + fr, col0 = p * 256 + wc * 32 + 8 * fq;
        f32x4 bv[2][2];
#pragma unroll
        for (int bj = 0; bj < 2; ++bj)
#pragma unroll
            for (int n = 0; n < 2; ++n) bv[bj][n] = *(const f32x4*)(b2 + (size_t)e * 1024 + col0 + bj * 128 + 4 * n);
#pragma unroll
        for (int ai = 0; ai < 2; ++ai)
#pragma unroll
            for (int m = 0; m < 4; ++m) { bf16* rowp = Y + (size_t)(row0 + ai * 128 + m * 16) * DM + col0;
#pragma unroll
                for (int bj = 0; bj < 2; ++bj) { const f32x4 v0 = acc[ai][bj][m][0] + bv[bj][0], v1 = acc[ai][bj][m][1] + bv[bj][1];
                    u32x4 w; w.x = pk2(v0[0], v0[1]); w.y = pk2(v0[2], v0[3]); w.z = pk2(v1[0], v1[1]); w.w = pk2(v1[2], v1[3]);
                    *(u32x4*)(rowp + bj * 128) = w; } }
    }
};
struct MoeOrder {
    const LAS int* list; int n;
    __device__ __forceinline__ bool next(int i, pg8::Unit& u) const { if (i >= n) return false; u.pm = __builtin_amdgcn_readfirstlane(list[2 * i]); u.pn = __builtin_amdgcn_readfirstlane(list[2 * i + 1]); return true; }
    __device__ __forceinline__ void a_ready(const pg8::Unit&) const {}
    __device__ __forceinline__ void done(const pg8::Unit&) const {}
};
__device__ __forceinline__ int moe_list_units(Frame& F, int nN, LAS int* list) {
    const int* tl = WSP<int>(F, WS_TILES);
    const int T = __builtin_amdgcn_readfirstlane(tl[32]), total = T * nN;
    int n = 0;
#pragma unroll 1
    for (int i = 0;; ++i) {
        const int Lu = i * F.G + F.bx; if (Lu >= total) break;
        const int pm = Lu / nN, pnl = Lu % nN;
        int e = 0;
#pragma unroll 1
        for (int q = 1; q < 32; ++q) { const int tq = __builtin_amdgcn_readfirstlane(tl[q]); if (tq <= pm) e = q; }
        if (F.tid == 0) { list[2 * i] = pm; list[2 * i + 1] = e * nN + pnl; }
        n = i + 1;
    }
    __syncthreads();
    return n;
}

__device__ __forceinline__ void ph_rope(Frame& F) {
    bf16* P = WSP<bf16>(F, WS_P);
    const size_t total = (size_t)NLAT * 832, stride = (size_t)F.G * NTHR;
    for (size_t idx = (size_t)F.bx * NTHR + F.tid; idx < total; idx += stride) {
        const int row = (int)(idx / 832), pi = (int)(idx % 832), t = row & 4095;
        int c1, c2; float rev;
        if (pi < 512) {
            const int qk = pi >> 8, h = (pi >> 6) & 3, i = pi & 63;
            c1 = (qk ? C_RK : C_RQ) + h * 128 + i; c2 = c1 + 64;
            const float invf = __expf(-(float)i * (9.210340371976184f / 63.0f));
            rev = (float)t * invf * 0.15915494309189535f;
        } else {
            const int pj = pi - 512, hh = pj >> 5, w = pj & 31, half = w >> 4, i = w & 15;
            const int base = (hh < 8) ? (C_AQ + hh * 64) : (C_AK + (hh - 8) * 64);
            c1 = base + half * 32 + i; c2 = c1 + 16;
            const float invf = __expf(-(float)i * (9.210340371976184f / 16.0f));
            const float pos = half ? (float)(t & 63) : (float)(t >> 6);
            rev = pos * invf * 0.15915494309189535f;
        }
        const float cs = cos_rev(rev), sn = sin_rev(rev);
        bf16* pr = P + (size_t)row * INC;
        const float x1 = bf2f(pr[c1]), x2 = bf2f(pr[c2]);
        pr[c1] = f2bf(x1 * cs - x2 * sn); pr[c2] = f2bf(x1 * sn + x2 * cs);
    }
}

__device__ __forceinline__ void attn_naive_item(Frame& F, int l, int item) {
    const bf16* P = WSP<bf16>(F, WS_P);
    LAS float* Ks = (LAS float*)F.lds; LAS float* Vs = Ks + 64 * 64;
    const bool isctx = item >= 512;
    int b, kvh, qb;
    if (!isctx) { b = item >> 6; kvh = (item >> 5) & 1; qb = item & 31; } else { const int it = item - 512; b = it >> 2; kvh = (it >> 1) & 1; qb = it & 1; }
    const int qi = F.tid & 127, g = F.tid >> 7, h = kvh * 4 + g;
    const int qpos = qb * 128 + qi;
    const int rowq = isctx ? (NLAT + b * CTXL + qpos) : (b * SEQ + qpos);
    float q[64], o[64];
    { const bf16* qp = P + (size_t)rowq * INC + C_AQ + h * 64;
#pragma unroll
      for (int d = 0; d < 64; ++d) { q[d] = bf2f(qp[d]) * 0.125f; o[d] = 0.f; } }
    const float sink = IN_(F, 9)[l * 8 + h];
    float mrun = sink, lsum = 1.0f;
    const int nkc = isctx ? 4 : 10, start = qb * 128;
    for (int kc = 0; kc < nkc; ++kc) {
        __syncthreads();
        { const int key = F.tid >> 3, d0 = (F.tid & 7) * 8;
          const bool ctxchunk = isctx || kc >= 6;
          int row = -1;
          if (ctxchunk) row = NLAT + b * CTXL + (isctx ? kc : kc - 6) * 64 + key;
          else { const int kpos = start - 128 + kc * 64 + key; if (kpos >= 0 && kpos < SEQ) row = b * SEQ + kpos; }
          u32x4 kk = (u32x4){0u, 0u, 0u, 0u}, vv = kk;
          if (row >= 0) { kk = *(const u32x4*)(P + (size_t)row * INC + C_AK + kvh * 64 + d0); vv = *(const u32x4*)(P + (size_t)row * INC + C_AV + kvh * 64 + d0); }
          LAS float* kd = Ks + key * 64 + d0; LAS float* vd = Vs + key * 64 + d0;
          kd[0] = __uint_as_float(kk.x << 16); kd[1] = __uint_as_float(kk.x & 0xffff0000u); kd[2] = __uint_as_float(kk.y << 16); kd[3] = __uint_as_float(kk.y & 0xffff0000u);
          kd[4] = __uint_as_float(kk.z << 16); kd[5] = __uint_as_float(kk.z & 0xffff0000u); kd[6] = __uint_as_float(kk.w << 16); kd[7] = __uint_as_float(kk.w & 0xffff0000u);
          vd[0] = __uint_as_float(vv.x << 16); vd[1] = __uint_as_float(vv.x & 0xffff0000u); vd[2] = __uint_as_float(vv.y << 16); vd[3] = __uint_as_float(vv.y & 0xffff0000u);
          vd[4] = __uint_as_float(vv.z << 16); vd[5] = __uint_as_float(vv.z & 0xffff0000u); vd[6] = __uint_as_float(vv.w << 16); vd[7] = __uint_as_float(vv.w & 0xffff0000u); }
        __syncthreads();
        const bool ctxchunk = isctx || kc >= 6;
        for (int key = 0; key < 64; ++key) {
            bool valid = true;
            if (!ctxchunk) { const int kpos = start - 128 + kc * 64 + key; const int dd = qpos - kpos; valid = (kpos >= 0) && (kpos < SEQ) && (dd <= 128) && (dd >= -128); }
            float s = 0.f;
#pragma unroll
            for (int d = 0; d < 64; ++d) s += q[d] * Ks[key * 64 + d];
            if (valid) {
                const float mnew = fmaxf(mrun, s), sc = __expf(mrun - mnew), p = __expf(s - mnew);
                lsum = lsum * sc + p; mrun = mnew;
#pragma unroll
                for (int d = 0; d < 64; ++d) o[d] = o[d] * sc + p * Vs[key * 64 + d];
            }
        }
    }
    const float inv = 1.0f / lsum;
    bf16* op = WSP<bf16>(F, WS_ATT) + (size_t)rowq * 512 + h * 64;
#pragma unroll
    for (int d = 0; d < 64; d += 2) *(unsigned*)(op + d) = pk2(o[d] * inv, o[d + 1] * inv);
}

__device__ __forceinline__ void ret_naive_item(Frame& F, int l, int item) {
    const bf16* P = WSP<bf16>(F, WS_P);
    LAS float* Ks = (LAS float*)F.lds; LAS float* Vs = Ks + 32 * 128; LAS float* red = Vs + 32 * 128;
    const bool isctx = item >= 1024;
    int b, h, qb;
    if (!isctx) { b = item >> 7; h = (item >> 5) & 3; qb = item & 31; } else { const int it = item - 1024; b = it >> 3; h = (it >> 1) & 3; qb = it & 1; }
    const int quarter = F.wave >> 1, qi = (F.wave & 1) * 64 + F.lane;
    const int n = qb * 128 + qi;
    const int rowq = isctx ? (NLAT + b * CTXL + n) : (b * SEQ + n);
    const float LOG2E = 1.4426950408889634f;
    const float lgf = log_sigmoid_(IN_(F, 8)[l * 8 + h]) * LOG2E, lgb = log_sigmoid_(IN_(F, 8)[l * 8 + 4 + h]) * LOG2E;
    float q[128], y[32];
    { const bf16* qp = P + (size_t)rowq * INC + C_RQ + h * 128;
#pragma unroll
      for (int d = 0; d < 128; ++d) q[d] = bf2f(qp[d]); }
#pragma unroll
    for (int e = 0; e < 32; ++e) y[e] = 0.f;
    const int nch = isctx ? 8 : 136;
    for (int kc = 0; kc < nch; ++kc) {
        __syncthreads();
        const bool ctxchunk = isctx || kc >= 128;
        const int krow0 = ctxchunk ? (NLAT + b * CTXL + (isctx ? kc : kc - 128) * 32) : (b * SEQ + kc * 32);
        { const int key = F.tid >> 4, d0 = (F.tid & 15) * 8;
          const u32x4 kk = *(const u32x4*)(P + (size_t)(krow0 + key) * INC + C_RK + h * 128 + d0), vv = *(const u32x4*)(P + (size_t)(krow0 + key) * INC + C_RV + h * 128 + d0);
          LAS float* kd = Ks + key * 128 + d0; LAS float* vd = Vs + key * 128 + d0;
          kd[0] = __uint_as_float(kk.x << 16); kd[1] = __uint_as_float(kk.x & 0xffff0000u); kd[2] = __uint_as_float(kk.y << 16); kd[3] = __uint_as_float(kk.y & 0xffff0000u);
          kd[4] = __uint_as_float(kk.z << 16); kd[5] = __uint_as_float(kk.z & 0xffff0000u); kd[6] = __uint_as_float(kk.w << 16); kd[7] = __uint_as_float(kk.w & 0xffff0000u);
          vd[0] = __uint_as_float(vv.x << 16); vd[1] = __uint_as_float(vv.x & 0xffff0000u); vd[2] = __uint_as_float(vv.y << 16); vd[3] = __uint_as_float(vv.y & 0xffff0000u);
          vd[4] = __uint_as_float(vv.z << 16); vd[5] = __uint_as_float(vv.z & 0xffff0000u); vd[6] = __uint_as_float(vv.w << 16); vd[7] = __uint_as_float(vv.w & 0xffff0000u); }
        __syncthreads();
        for (int key = 0; key < 32; ++key) {
            float w;
            if (!ctxchunk) { const int m = kc * 32 + key; const int dd = n - m; w = (dd >= 0) ? __builtin_amdgcn_exp2f(lgf * (float)dd) : __builtin_amdgcn_exp2f(lgb * (float)(-dd)); }
            else if (!isctx) { const int j = (kc - 128) * 32 + key; w = __builtin_amdgcn_exp2f(lgf * (float)(n + CTXL - j)) + __builtin_amdgcn_exp2f(lgb * (float)(SEQ - n + j)); }
            else { const int j = kc * 32 + key; const int dd = n - j; w = (dd >= 0) ? __builtin_amdgcn_exp2f(lgf * (float)dd) : __builtin_amdgcn_exp2f(lgb * (float)(-dd)); }
            float s = 0.f;
#pragma unroll
            for (int d = 0; d < 128; ++d) s += q[d] * Ks[key * 128 + d];
            s *= w;
#pragma unroll
            for (int e = 0; e < 32; ++e) y[e] += s * Vs[key * 128 + quarter * 32 + e];
        }
    }
    const float ksc = 0.08838834764831845f;
    float ss = 0.f;
#pragma unroll
    for (int e = 0; e < 32; ++e) { y[e] *= ksc; ss += y[e] * y[e]; }
    __syncthreads();
    red[qi * 4 + quarter] = ss;
    __syncthreads();
    const float tot = (red[qi * 4 + 0] + red[qi * 4 + 1]) + (red[qi * 4 + 2] + red[qi * 4 + 3]);
    const float rs = 1.0f / sqrtf(tot * (1.0f / 128.0f) + EPS);
    const bf16* gp = P + (size_t)rowq * INC + C_RG + h * 128 + quarter * 32;
    bf16* op = WSP<bf16>(F, WS_RET) + (size_t)rowq * 512 + h * 128 + quarter * 32;
#pragma unroll
    for (int e = 0; e < 32; e += 2) *(unsigned*)(op + e) = pk2(y[e] * rs * siluf_(bf2f(gp[e])), y[e + 1] * rs * siluf_(bf2f(gp[e + 1])));
}

__device__ __forceinline__ float hy_sconv(const bf16* P, const float* cw, const float* cb, int base, int t, int L, int ch) {
    float a = cb[ch] + bf2f(P[(size_t)(base + t) * INC + C_HU + ch]) * cw[1536 + ch];
    if (t > 0) a += bf2f(P[(size_t)(base + t - 1) * INC + C_HU + ch]) * cw[ch];
    if (t + 1 < L) a += bf2f(P[(size_t)(base + t + 1) * INC + C_HU + ch]) * cw[2 * 1536 + ch];
    return a;
}
__device__ __forceinline__ void ph_hyprep(Frame& F, int l, bool do_ctx) {
    const bf16* P = WSP<bf16>(F, WS_P);
    const float* cw = IN_(F, 10) + l * 3 * 1536; const float* cb = IN_(F, 11) + l * 1536;
    float* ZT = WSP<float>(F, WS_ZT); float* ZTC = WSP<float>(F, WS_ZTC);
    const size_t total = (size_t)(do_ctx ? NROWS : NLAT) * 512, stride = (size_t)F.G * NTHR;
    for (size_t idx = (size_t)F.bx * NTHR + F.tid; idx < total; idx += stride) {
        const int row = (int)(idx >> 9), c = (int)(idx & 511);
        if (row < NLAT) { const int b = row >> 12, t = row & 4095;
            const float x1 = hy_sconv(P, cw, cb, b * SEQ, t, SEQ, 512 + c), v = hy_sconv(P, cw, cb, b * SEQ, t, SEQ, 1024 + c);
            ZT[((size_t)c * NB + b) * SEQ + t] = x1 * v;
        } else { const int j = row - NLAT, b = j >> 8, t = j & 255;
            const float x1 = hy_sconv(P, cw, cb, NLAT + b * CTXL, t, CTXL, 512 + c), v = hy_sconv(P, cw, cb, NLAT + b * CTXL, t, CTXL, 1024 + c);
            ZTC[((size_t)c * NB + b) * CTXL + t] = x1 * v;
        }
    }
}
__device__ __forceinline__ void hyconv_naive_item(Frame& F, int l, int item) {
    const int c = item >> 1, bh = item & 1;
    LAS float* Kc = (LAS float*)F.lds;
    LAS float* Zs = Kc + 8192;
    const float* HFp = WSP<float>(F, WS_HF + (size_t)l * 16 * MiB); const float* HBp = WSP<float>(F, WS_HF + (size_t)l * 16 * MiB + 8 * MiB);
    const float il1 = hy_inv_l1(F, l, c);
    const float* ZT = WSP<float>(F, WS_ZT) + ((size_t)c * NB + bh * 4) * SEQ;
    __syncthreads();
    for (int i = F.tid; i < 8191; i += NTHR) { const int d = i - 4095; Kc[i] = (d >= 0 ? HFp[(size_t)d * 512 + c] : HBp[(size_t)(-d) * 512 + c]) * il1; }
    for (int i = F.tid; i < 4 * SEQ; i += NTHR) { const int bb = i >> 12, s = i & 4095; Zs[s * 4 + bb] = ZT[i]; }
    __syncthreads();
    float acc[8][4];
#pragma unroll
    for (int i = 0; i < 8; ++i)
#pragma unroll
        for (int bb = 0; bb < 4; ++bb) acc[i][bb] = 0.f;
    for (int s = 0; s < SEQ; ++s) {
        const f32x4 z = *(const LAS f32x4*)(Zs + s * 4);
#pragma unroll
        for (int i = 0; i < 8; ++i) { const float k = Kc[F.tid + 512 * i - s + 4095];
#pragma unroll
            for (int bb = 0; bb < 4; ++bb) acc[i][bb] += k * z[bb]; }
    }
    float* YT = WSP<float>(F, WS_YT) + ((size_t)c * NB + bh * 4) * SEQ;
#pragma unroll
    for (int i = 0; i < 8; ++i)
#pragma unroll
        for (int bb = 0; bb < 4; ++bb) YT[(size_t)bb * SEQ + F.tid + 512 * i] = acc[i][bb];
}
__device__ __forceinline__ void hyconv_ctx_item(Frame& F, int c) {
    const float* HFp = WSP<float>(F, WS_HFC); const float* HBp = WSP<float>(F, WS_HFC + 512 * 1024);
    const float il1 = hy_inv_l1(F, 2, c);
    const float* Z = WSP<float>(F, WS_ZTC) + (size_t)c * NB * CTXL; float* Yo = WSP<float>(F, WS_YTC) + (size_t)c * NB * CTXL;
#pragma unroll
    for (int i = 0; i < 4; ++i) {
        const int o = F.tid * 4 + i, b = o >> 8, t = o & 255;
        float a = 0.f;
        for (int s = 0; s < CTXL; ++s) { const int d = t - s; const float k = (d >= 0) ? HFp[(size_t)d * 512 + c] : HBp[(size_t)(-d) * 512 + c]; a += k * Z[b * CTXL + s]; }
        Yo[o] = a * il1;
    }
}
__device__ __forceinline__ void ph_hypost(Frame& F, int l, bool do_ctx) {
    const bf16* P = WSP<bf16>(F, WS_P);
    const float* cw = IN_(F, 10) + l * 3 * 1536; const float* cb = IN_(F, 11) + l * 1536; const float* skip = IN_(F, 19) + l * 512;
    const float* YT = WSP<float>(F, WS_YT); const float* YTC = WSP<float>(F, WS_YTC);
    bf16* HY = WSP<bf16>(F, WS_HY);
    const size_t total = (size_t)(do_ctx ? NROWS : NLAT) * 512, stride = (size_t)F.G * NTHR;
    for (size_t idx = (size_t)F.bx * NTHR + F.tid; idx < total; idx += stride) {
        const int row = (int)(idx >> 9), c = (int)(idx & 511);
        int base, t, L; float y;
        if (row < NLAT) { const int b = row >> 12; t = row & 4095; base = b * SEQ; L = SEQ; y = YT[((size_t)c * NB + b) * SEQ + t]; }
        else { const int j = row - NLAT, b = j >> 8; t = j & 255; base = NLAT + b * CTXL; L = CTXL; y = YTC[((size_t)c * NB + b) * CTXL + t]; }
        const float x0 = hy_sconv(P, cw, cb, base, t, L, c), x1 = hy_sconv(P, cw, cb, base, t, L, 512 + c), v = hy_sconv(P, cw, cb, base, t, L, 1024 + c);
        const float z = x1 * v;
        HY[(size_t)row * 512 + c] = f2bf(x0 * (y + skip[c] * z));
    }
}

typedef short bf16x8 __attribute__((ext_vector_type(8)));
typedef short bf16x4 __attribute__((ext_vector_type(4)));
constexpr int RLD = 136;
constexpr int RTILE = 128 * RLD * 2;
__device__ __forceinline__ bf16x8 lds_frag16(const LAS bf16* tile, int row0, int k0, int lane) {
    return *(const LAS bf16x8*)(tile + (row0 + (lane & 15)) * RLD + k0 + 8 * (lane >> 4));
}
__device__ __forceinline__ void ret_unit_decode(int u, int& bh, int& ci, int& rowbase) {
    bh = u / 34; ci = u - bh * 34; const int b = bh >> 2;
    rowbase = (ci < 2) ? (NLAT + b * CTXL + ci * 128) : (b * SEQ + (ci - 2) * 128);
}
__device__ __forceinline__ void ret_load_tile(LAS bf16* tile, const bf16* g, size_t gp, int tid) {
    const int r = tid >> 2, seg = tid & 3;
#pragma unroll
    for (int q = 0; q < 4; ++q) *(LAS u32x4*)(tile + r * RLD + seg * 32 + q * 8) = *(const u32x4*)(g + (size_t)r * gp + seg * 32 + q * 8);
}
__device__ __forceinline__ void ret_kv_unit(Frame& F, int l, int u) {
    const bf16* P = WSP<bf16>(F, WS_P);
    LAS bf16* Ktf = (LAS bf16*)F.lds; LAS bf16* Ktb = Ktf + 128 * RLD; LAS bf16* Vt = Ktb + 128 * RLD;
    int bh, ci, rowbase; ret_unit_decode(u, bh, ci, rowbase);
    const int h = bh & 3, tid = F.tid, lane = F.lane, w = F.wave;
    const float LOG2E = 1.4426950408889634f;
    const float lgf = log_sigmoid_(IN_(F, 8)[l * 8 + h]) * LOG2E, lgb = log_sigmoid_(IN_(F, 8)[l * 8 + 4 + h]) * LOG2E;
    __syncthreads();
    { const int j = tid >> 2, seg = tid & 3;
      const float wf = __builtin_amdgcn_exp2f(lgf * (float)(127 - j)), wb = __builtin_amdgcn_exp2f(lgb * (float)j);
      const bf16* kp = P + (size_t)(rowbase + j) * INC + C_RK + h * 128 + seg * 32; const bf16* vp = P + (size_t)(rowbase + j) * INC + C_RV + h * 128 + seg * 32;
#pragma unroll
      for (int q = 0; q < 4; ++q) { const u32x4 kk = *(const u32x4*)(kp + q * 8), vv = *(const u32x4*)(vp + q * 8);
          const unsigned kw[4] = {kk.x, kk.y, kk.z, kk.w}, vw[4] = {vv.x, vv.y, vv.z, vv.w};
#pragma unroll
          for (int i = 0; i < 4; ++i) { const int d = seg * 32 + q * 8 + 2 * i;
              const float k0 = __uint_as_float(kw[i] << 16), k1 = __uint_as_float(kw[i] & 0xffff0000u);
              Ktf[d * RLD + j] = f2bf(k0 * wf); Ktf[(d + 1) * RLD + j] = f2bf(k1 * wf);
              Ktb[d * RLD + j] = f2bf(k0 * wb); Ktb[(d + 1) * RLD + j] = f2bf(k1 * wb);
              Vt[d * RLD + j] = (bf16)(vw[i] & 0xffffu); Vt[(d + 1) * RLD + j] = (bf16)(vw[i] >> 16); } } }
    __syncthreads();
    bf16x8 af[4], ab[4];
#pragma unroll
    for (int ks = 0; ks < 4; ++ks) { af[ks] = lds_frag16(Ktf, 16 * w, 32 * ks, lane); ab[ks] = lds_frag16(Ktb, 16 * w, 32 * ks, lane); }
    float* KV = WSP<float>(F, WS_KV) + ((size_t)(bh * 34 + ci) * 2) * 16384;
    const int d0 = 16 * w + 4 * (lane >> 4);
#pragma unroll 2
    for (int et = 0; et < 8; ++et) {
        f32x4 cf = (f32x4){0.f, 0.f, 0.f, 0.f}, cb = cf;
#pragma unroll
        for (int ks = 0; ks < 4; ++ks) { const bf16x8 bv = lds_frag16(Vt, 16 * et, 32 * ks, lane);
            cf = __builtin_amdgcn_mfma_f32_16x16x32_bf16(af[ks], bv, cf, 0, 0, 0); cb = __builtin_amdgcn_mfma_f32_16x16x32_bf16(ab[ks], bv, cb, 0, 0, 0); }
        const int e = 16 * et + (lane & 15);
        *(f32x4*)(KV + (size_t)e * 128 + d0) = cf; *(f32x4*)(KV + 16384 + (size_t)e * 128 + d0) = cb;
    }
}
__device__ __forceinline__ void ret_scan(Frame& F, int l) {
    const float* KV = WSP<float>(F, WS_KV); bf16* SP = WSP<bf16>(F, WS_SP);
    const float LOG2E = 1.4426950408889634f;
    const int total = 64 * 16384, stride = F.G * NTHR;
    for (int idx = F.bx * NTHR + F.tid; idx < total; idx += stride) {
        const int bhd = idx >> 14, elem = idx & 16383, bh = bhd >> 1, dir = bhd & 1, h = bh & 3;
        const float cd = __builtin_amdgcn_exp2f(log_sigmoid_(IN_(F, 8)[l * 8 + dir * 4 + h]) * LOG2E * 128.0f);
        const size_t base = ((size_t)bh * 34 * 2 + dir) * 16384 + elem;
        float s = 0.f;
#pragma unroll 2
        for (int st = 0; st < 34; ++st) {
            const int ci = dir == 0 ? st : (st == 0 ? 1 : (st == 1 ? 0 : 35 - st));
            const size_t o = base + (size_t)ci * 2 * 16384;
            SP[o] = f2bf(s);
            s = cd * s + KV[o];
        }
    }
}
__device__ __forceinline__ void ret_out_unit(Frame& F, int l, int u) {
    const bf16* P = WSP<bf16>(F, WS_P);
    LAS bf16* Qs = (LAS bf16*)F.lds; LAS bf16* Ks = Qs + 128 * RLD; LAS bf16* Vt = Ks + 128 * RLD; LAS bf16* Ps = Vt + 128 * RLD;
    int bh, ci, rowbase; ret_unit_decode(u, bh, ci, rowbase);
    const int h = bh & 3, tid = F.tid, lane = F.lane, w = F.wave;
    const float LOG2E = 1.4426950408889634f;
    const float lgf = log_sigmoid_(IN_(F, 8)[l * 8 + h]) * LOG2E, lgb = log_sigmoid_(IN_(F, 8)[l * 8 + 4 + h]) * LOG2E;
    __syncthreads();
    ret_load_tile(Qs, P + (size_t)rowbase * INC + C_RQ + h * 128, INC, tid);
    ret_load_tile(Ks, P + (size_t)rowbase * INC + C_RK + h * 128, INC, tid);
    { const int j = tid >> 2, seg = tid & 3; const bf16* vp = P + (size_t)(rowbase + j) * INC + C_RV + h * 128 + seg * 32;
#pragma unroll
      for (int q = 0; q < 4; ++q) { const u32x4 vv = *(const u32x4*)(vp + q * 8); const unsigned vw[4] = {vv.x, vv.y, vv.z, vv.w};
#pragma unroll
          for (int i = 0; i < 4; ++i) { const int d = seg * 32 + q * 8 + 2 * i; Vt[d * RLD + j] = (bf16)(vw[i] & 0xffffu); Vt[(d + 1) * RLD + j] = (bf16)(vw[i] >> 16); } } }
    __syncthreads();
    const int icol = 16 * w + (lane & 15);
    bf16x8 bq[4];
#pragma unroll
    for (int ks = 0; ks < 4; ++ks) bq[ks] = lds_frag16(Qs, 16 * w, 32 * ks, lane);
#pragma unroll 2
    for (int jt = 0; jt < 8; ++jt) {
        f32x4 c = (f32x4){0.f, 0.f, 0.f, 0.f};
#pragma unroll
        for (int ks = 0; ks < 4; ++ks) c = __builtin_amdgcn_mfma_f32_16x16x32_bf16(lds_frag16(Ks, 16 * jt, 32 * ks, lane), bq[ks], c, 0, 0, 0);
        const int j0 = 16 * jt + 4 * (lane >> 4);
        float pv[4];
#pragma unroll
        for (int r = 0; r < 4; ++r) { const int dd = icol - (j0 + r); const float dec = dd >= 0 ? __builtin_amdgcn_exp2f(lgf * (float)dd) : __builtin_amdgcn_exp2f(lgb * (float)(-dd)); pv[r] = c[r] * dec; }
        u32x2 pw; pw.x = pk2(pv[0], pv[1]); pw.y = pk2(pv[2], pv[3]);
        *(LAS u32x2*)(Ps + icol * RLD + j0) = pw;
    }
    LDS_WAIT(); asm volatile("" ::: "memory");
    f32x4 acc[8];
    {
        bf16x8 bp[4];
#pragma unroll
        for (int ks = 0; ks < 4; ++ks) bp[ks] = lds_frag16(Ps, 16 * w, 32 * ks, lane);
#pragma unroll
        for (int et = 0; et < 8; ++et) { f32x4 c = (f32x4){0.f, 0.f, 0.f, 0.f};
#pragma unroll
            for (int ks = 0; ks < 4; ++ks) c = __builtin_amdgcn_mfma_f32_16x16x32_bf16(lds_frag16(Vt, 16 * et, 32 * ks, lane), bp[ks], c, 0, 0, 0);
            acc[et] = c; }
    }
    const bf16* SPg = WSP<bf16>(F, WS_SP) + ((size_t)(bh * 34 + ci) * 2) * 16384;
#pragma unroll 1
    for (int dir = 0; dir < 2; ++dir) {
        const bool zero = (dir == 0) ? (ci == 0) : (ci == 1);
        __syncthreads();
        if (!zero) ret_load_tile(Ks, SPg + (size_t)dir * 16384, 128, tid);
        __syncthreads();
        if (!zero) {
            const float sc = (dir == 0) ? __builtin_amdgcn_exp2f(lgf * (float)((icol & 127) + 1)) : __builtin_amdgcn_exp2f(lgb * (float)(128 - (icol & 127)));
#pragma unroll
            for (int et = 0; et < 8; ++et) { f32x4 c = (f32x4){0.f, 0.f, 0.f, 0.f};
#pragma unroll
                for (int ks = 0; ks < 4; ++ks) c = __builtin_amdgcn_mfma_f32_16x16x32_bf16(lds_frag16(Ks, 16 * et, 32 * ks, lane), bq[ks], c, 0, 0, 0);
                acc[et] = acc[et] + c * sc; }
        }
    }
    const float ksc = 0.08838834764831845f;
    float ss = 0.f;
#pragma unroll
    for (int et = 0; et < 8; ++et) { acc[et] = acc[et] * ksc; ss += (acc[et][0] * acc[et][0] + acc[et][1] * acc[et][1]) + (acc[et][2] * acc[et][2] + acc[et][3] * acc[et][3]); }
    ss += __shfl_xor(ss, 16); ss += __shfl_xor(ss, 32);
    const float rs = 1.0f / sqrtf(ss * (1.0f / 128.0f) + EPS);
    const size_t row = (size_t)(rowbase + icol);
    const bf16* gp = P + row * INC + C_RG + h * 128; bf16* op = WSP<bf16>(F, WS_RET) + row * 512 + h * 128;
#pragma unroll
    for (int et = 0; et < 8; ++et) { const int e0 = 16 * et + 4 * (lane >> 4);
        const u32x2 g2 = *(const u32x2*)(gp + e0);
        const float g0 = __uint_as_float(g2.x << 16), g1 = __uint_as_float(g2.x & 0xffff0000u), g2f = __uint_as_float(g2.y << 16), g3 = __uint_as_float(g2.y & 0xffff0000u);
        u32x2 o; o.x = pk2(acc[et][0] * rs * siluf_(g0), acc[et][1] * rs * siluf_(g1)); o.y = pk2(acc[et][2] * rs * siluf_(g2f), acc[et][3] * rs * siluf_(g3));
        *(u32x2*)(op + e0) = o; }
}

typedef float f32x2 __attribute__((ext_vector_type(2)));
__device__ __forceinline__ f32x2 cmul_(f32x2 a, f32x2 b) { return (f32x2){a.x * b.x - a.y * b.y, a.x * b.y + a.y * b.x}; }
__device__ __forceinline__ f32x2 cmulc_(f32x2 a, f32x2 b) { return (f32x2){a.x * b.x + a.y * b.y, a.y * b.x - a.x * b.y}; }
__device__ __forceinline__ f32x2 twid_(float rev) { return (f32x2){cos_rev(rev), -sin_rev(rev)}; }
__device__ __forceinline__ int fpad(int n) { return n + (n >> 3); }
template <int R> __device__ __forceinline__ void fft_twiddles(f32x2 (&tw)[R - 1], int t, int s, int M) {
    int o = 0, u = 0;
#pragma unroll
    for (int half = R / 2; half >= 1; half >>= 1) {
        const float invMu = 1.0f / (float)(M >> u);
#pragma unroll
        for (int qq = 0; qq < half; ++qq) tw[o + qq] = twid_((float)(t + qq * s) * invMu);
        o += half; ++u;
    }
}
template <int R, int HALF, int OFF> __device__ __forceinline__ void fft_sub_fwd(f32x2 (&v)[R], const f32x2 (&tw)[R - 1]) {
#pragma unroll
    for (int qq = 0; qq < HALF; ++qq) {
        const f32x2 w = tw[OFF + qq];
#pragma unroll
        for (int g0 = 0; g0 < R; g0 += 2 * HALF) { const f32x2 a = v[g0 + qq], b = v[g0 + qq + HALF]; v[g0 + qq] = a + b; v[g0 + qq + HALF] = cmul_(a - b, w); }
    }
}
template <int R, int HALF, int OFF> __device__ __forceinline__ void fft_sub_inv(f32x2 (&v)[R], const f32x2 (&tw)[R - 1]) {
#pragma unroll
    for (int qq = 0; qq < HALF; ++qq) {
        const f32x2 w = tw[OFF + qq];
#pragma unroll
        for (int g0 = 0; g0 < R; g0 += 2 * HALF) { const f32x2 A = v[g0 + qq], Bp = cmulc_(v[g0 + qq + HALF], w); v[g0 + qq] = A + Bp; v[g0 + qq + HALF] = A - Bp; }
    }
}
template <int R> __device__ __forceinline__ void fft_bf_fwd(f32x2 (&v)[R], const f32x2 (&tw)[R - 1]) {
    if constexpr (R == 16) { fft_sub_fwd<16, 8, 0>(v, tw); fft_sub_fwd<16, 4, 8>(v, tw); fft_sub_fwd<16, 2, 12>(v, tw); fft_sub_fwd<16, 1, 14>(v, tw); }
    else { fft_sub_fwd<8, 4, 0>(v, tw); fft_sub_fwd<8, 2, 4>(v, tw); fft_sub_fwd<8, 1, 6>(v, tw); }
}
template <int R> __device__ __forceinline__ void fft_bf_inv(f32x2 (&v)[R], const f32x2 (&tw)[R - 1]) {
    if constexpr (R == 16) { fft_sub_inv<16, 1, 14>(v, tw); fft_sub_inv<16, 2, 12>(v, tw); fft_sub_inv<16, 4, 8>(v, tw); fft_sub_inv<16, 8, 0>(v, tw); }
    else { fft_sub_inv<8, 1, 6>(v, tw); fft_sub_inv<8, 2, 4>(v, tw); fft_sub_inv<8, 4, 0>(v, tw); }
}
__device__ __forceinline__ void fft_tw_last(f32x2 (&tw)[7]) {
    const float h = 0.70710678118654752f;
    tw[0] = (f32x2){1.f, 0.f}; tw[1] = (f32x2){h, -h}; tw[2] = (f32x2){0.f, -1.f}; tw[3] = (f32x2){-h, -h};
    tw[4] = (f32x2){1.f, 0.f}; tw[5] = (f32x2){0.f, -1.f}; tw[6] = (f32x2){1.f, 0.f};
}
struct FftTw { f32x2 t1[15]; f32x2 t2[2][7]; f32x2 t3[2][7]; };
__device__ __forceinline__ void fft_tw_init(FftTw& T, int tid) {
    fft_twiddles<16>(T.t1, tid, 512, 8192);
#pragma unroll
    for (int it = 0; it < 2; ++it) { const int uu = tid + 512 * it; fft_twiddles<8>(T.t2[it], uu & 63, 64, 512); fft_twiddles<8>(T.t3[it], uu & 7, 8, 64); }
}
template <bool INV, int M> __device__ __forceinline__ void fft_pass8(LAS f32x2* X, int tid, const f32x2 (&tw)[2][7]) {
    asm volatile("" : "+v"(tid));
    constexpr int s = M >> 3;
#pragma unroll
    for (int it = 0; it < 2; ++it) {
        const int uu = tid + 512 * it, blk = uu / s, t = uu - blk * s, n0 = blk * M + t;
        f32x2 v[8];
#pragma unroll
        for (int q = 0; q < 8; ++q) v[q] = X[fpad(n0 + q * s)];
        if (INV) fft_bf_inv<8>(v, tw[it]); else fft_bf_fwd<8>(v, tw[it]);
#pragma unroll
        for (int q = 0; q < 8; ++q) X[fpad(n0 + q * s)] = v[q];
    }
}
__device__ __forceinline__ void fft_filter_unit(Frame& F, const FftTw& T, int l, int c) {
    LAS f32x2* X = (LAS f32x2*)F.lds;
    const float* HFp = WSP<float>(F, WS_HF + (size_t)l * 16 * MiB); const float* HBp = WSP<float>(F, WS_HF + (size_t)l * 16 * MiB + 8 * MiB);
    const float scale = hy_inv_l1(F, l, c) * (1.0f / 8192.0f);
    int tid = F.tid; asm volatile("" : "+v"(tid));
    __syncthreads();
    {   f32x2 v[16];
#pragma unroll
        for (int q = 0; q < 16; ++q) { const int n = tid + 512 * q; float x;
            if (q < 8) x = HFp[(size_t)n * 512 + c]; else x = (n == 4096) ? 0.f : HBp[(size_t)(8192 - n) * 512 + c];
            v[q] = (f32x2){x * scale, 0.f}; }
        fft_bf_fwd<16>(v, T.t1);
#pragma unroll
        for (int q = 0; q < 16; ++q) X[fpad(tid + 512 * q)] = v[q];
    }
    __syncthreads(); fft_pass8<false, 512>(X, tid, T.t2);
    __syncthreads(); fft_pass8<false, 64>(X, tid, T.t3);
    __syncthreads();
    f32x2* Hc = WSP<f32x2>(F, WS_HSPEC) + ((size_t)l * 512 + c) * 8192;
    asm volatile("" : "+v"(tid));
    f32x2 tl[7]; fft_tw_last(tl);
#pragma unroll
    for (int it = 0; it < 2; ++it) {
        const int uu = tid + 512 * it;
        f32x2 v[8];
#pragma unroll
        for (int q = 0; q < 8; ++q) v[q] = X[fpad(8 * uu + q)];
        fft_bf_fwd<8>(v, tl);
#pragma unroll
        for (int q = 0; q < 4; ++q) { f32x4 o; o[0] = v[2 * q].x; o[1] = v[2 * q].y; o[2] = v[2 * q + 1].x; o[3] = v[2 * q + 1].y; *(f32x4*)(Hc + 8 * uu + 2 * q) = o; }
    }
}
__device__ __forceinline__ void fft_conv_unit(Frame& F, const FftTw& T, int l, int unit) {
    LAS f32x2* X = (LAS f32x2*)F.lds;
    const int c = unit >> 2, p = unit & 3; int tid = F.tid; asm volatile("" : "+v"(tid));
    const bf16* z1 = WSP<bf16>(F, WS_ZT) + ((size_t)c * NB + 2 * p) * SEQ; const bf16* z2 = z1 + SEQ;
    const f32x2* Hc = WSP<f32x2>(F, WS_HSPEC) + ((size_t)l * 512 + c) * 8192;
    f32x4 hp[2][4];
#pragma unroll
    for (int it = 0; it < 2; ++it)
#pragma unroll
        for (int q = 0; q < 4; ++q) hp[it][q] = *(const f32x4*)(Hc + 8 * (tid + 512 * it) + 2 * q);
    __syncthreads();
    {   f32x2 v[16];
#pragma unroll
        for (int q = 0; q < 8; ++q) { const int n = tid + 512 * q; v[q] = (f32x2){bf2f(z1[n]), bf2f(z2[n])}; }
#pragma unroll
        for (int q = 8; q < 16; ++q) v[q] = (f32x2){0.f, 0.f};
        fft_bf_fwd<16>(v, T.t1);
#pragma unroll
        for (int q = 0; q < 16; ++q) X[fpad(tid + 512 * q)] = v[q];
    }
    __syncthreads(); fft_pass8<false, 512>(X, tid, T.t2);
    __syncthreads(); fft_pass8<false, 64>(X, tid, T.t3);
    __syncthreads();
    asm volatile("" : "+v"(tid));
    f32x2 tl[7]; fft_tw_last(tl);
#pragma unroll
    for (int it = 0; it < 2; ++it) {
        const int uu = tid + 512 * it;
        f32x2 v[8];
#pragma unroll
        for (int q = 0; q < 8; ++q) v[q] = X[fpad(8 * uu + q)];
        fft_bf_fwd<8>(v, tl);
#pragma unroll
        for (int q = 0; q < 4; ++q) { const f32x4 h = hp[it][q]; v[2 * q] = cmul_(v[2 * q], (f32x2){h[0], h[1]}); v[2 * q + 1] = cmul_(v[2 * q + 1], (f32x2){h[2], h[3]}); }
        fft_bf_inv<8>(v, tl);
#pragma unroll
        for (int q = 0; q < 8; ++q) X[fpad(8 * uu + q)] = v[q];
    }
    __syncthreads(); fft_pass8<true, 64>(X, tid, T.t3);
    __syncthreads(); fft_pass8<true, 512>(X, tid, T.t2);
    __syncthreads();
    asm volatile("" : "+v"(tid));
    {   f32x2 v[16];
#pragma unroll
        for (int q = 0; q < 16; ++q) v[q] = X[fpad(tid + 512 * q)];
        fft_bf_inv<16>(v, T.t1);
        bf16* y1 = WSP<bf16>(F, WS_YT) + ((size_t)c * NB + 2 * p) * SEQ; bf16* y2 = y1 + SEQ;
#pragma unroll
        for (int q = 0; q < 8; ++q) { const int n = tid + 512 * q; y1[n] = f2bf(v[q].x); y2[n] = f2bf(v[q].y); }
    }
}

constexpr int HLD = 72;
__device__ __forceinline__ void hy_sconv8(const bf16* P, int base, int t, int L, int ch0, const float (&w)[4][8], float (&out)[8]) {
    const bf16* p1 = P + (size_t)(base + t) * INC + C_HU + ch0;
    const u32x4 zero = (u32x4){0u, 0u, 0u, 0u};
    const u32x4 c1 = *(const u32x4*)p1, c0 = (t > 0) ? *(const u32x4*)(p1 - INC) : zero, c2 = (t + 1 < L) ? *(const u32x4*)(p1 + INC) : zero;
    const unsigned a0[4] = {c0.x, c0.y, c0.z, c0.w}, a1[4] = {c1.x, c1.y, c1.z, c1.w}, a2[4] = {c2.x, c2.y, c2.z, c2.w};
#pragma unroll
    for (int i = 0; i < 4; ++i) {
        out[2 * i] = w[3][2 * i] + __uint_as_float(a0[i] << 16) * w[0][2 * i] + __uint_as_float(a1[i] << 16) * w[1][2 * i] + __uint_as_float(a2[i] << 16) * w[2][2 * i];
        out[2 * i + 1] = w[3][2 * i + 1] + __uint_as_float(a0[i] & 0xffff0000u) * w[0][2 * i + 1] + __uint_as_float(a1[i] & 0xffff0000u) * w[1][2 * i + 1] + __uint_as_float(a2[i] & 0xffff0000u) * w[2][2 * i + 1];
    }
}
__device__ __forceinline__ void hy_load_w8(const float* cw, const float* cb, int ch0, float (&w)[4][8]) {
#pragma unroll
    for (int i = 0; i < 8; ++i) { w[0][i] = cw[ch0 + i]; w[1][i] = cw[1536 + ch0 + i]; w[2][i] = cw[2 * 1536 + ch0 + i]; w[3][i] = cb[ch0 + i]; }
}
__device__ __forceinline__ void hy_item_decode(int it, int& ct, int& base, int& t0, int& L, int& b, bool& isctx) {
    isctx = it >= 4096;
    if (!isctx) { ct = it & 7; t0 = ((it >> 3) & 63) * 64; b = it >> 9; base = b * SEQ; L = SEQ; }
    else { const int j = it - 4096; ct = j & 7; t0 = ((j >> 3) & 3) * 64; b = j >> 5; base = NLAT + b * CTXL; L = CTXL; }
}
__device__ __forceinline__ void ph_hyprep2(Frame& F, int l, bool do_ctx) {
    const bf16* P = WSP<bf16>(F, WS_P);
    const float* cw = IN_(F, 10) + l * 3 * 1536; const float* cb = IN_(F, 11) + l * 1536;
    LAS bf16* Zs = (LAS bf16*)F.lds;
    int tid = F.tid; asm volatile("" : "+v"(tid));
    const int cg = tid & 7, tl = tid >> 3, c0 = (F.bx & 7) * 64;
    float w1[4][8], wv[4][8];
    hy_load_w8(cw, cb, 512 + c0 + 8 * cg, w1); hy_load_w8(cw, cb, 1024 + c0 + 8 * cg, wv);
    const int nit = do_ctx ? 4352 : 4096;
#pragma unroll 1
    for (int it = F.bx; it < nit; it += F.G) {
        int ct, base, t0, L, b; bool isctx; hy_item_decode(it, ct, base, t0, L, b, isctx);
        float x1[8], v[8];
        hy_sconv8(P, base, t0 + tl, L, 512 + c0 + 8 * cg, w1, x1); hy_sconv8(P, base, t0 + tl, L, 1024 + c0 + 8 * cg, wv, v);
        __syncthreads();
#pragma unroll
        for (int i = 0; i < 8; ++i) Zs[(8 * cg + i) * HLD + tl] = f2bf(x1[i] * v[i]);
        __syncthreads();
        { const int c = tid >> 3, seg = tid & 7;
          const u32x4 o = *(const LAS u32x4*)(Zs + c * HLD + 8 * seg);
          bf16* dst = isctx ? (WSP<bf16>(F, WS_ZTC) + ((size_t)(c0 + c) * NB + b) * CTXL + t0 + 8 * seg) : (WSP<bf16>(F, WS_ZT) + ((size_t)(c0 + c) * NB + b) * SEQ + t0 + 8 * seg);
          *(u32x4*)dst = o; }
    }
}
__device__ __forceinline__ void ph_hypost2(Frame& F, int l, bool do_ctx) {
    const bf16* P = WSP<bf16>(F, WS_P);
    const float* cw = IN_(F, 10) + l * 3 * 1536; const float* cb = IN_(F, 11) + l * 1536; const float* skip = IN_(F, 19) + l * 512;
    LAS bf16* Ys = (LAS bf16*)F.lds;
    int tid = F.tid; asm volatile("" : "+v"(tid));
    const int cg = tid & 7, tl = tid >> 3, c0 = (F.bx & 7) * 64;
    float w0[4][8], w1[4][8], wv[4][8], sk[8];
    hy_load_w8(cw, cb, c0 + 8 * cg, w0); hy_load_w8(cw, cb, 512 + c0 + 8 * cg, w1); hy_load_w8(cw, cb, 1024 + c0 + 8 * cg, wv);
#pragma unroll
    for (int i = 0; i < 8; ++i) sk[i] = skip[c0 + 8 * cg + i];
    bf16* HY = WSP<bf16>(F, WS_HY);
    const int nit = do_ctx ? 4352 : 4096;
#pragma unroll 1
    for (int it = F.bx; it < nit; it += F.G) {
        int ct, base, t0, L, b; bool isctx; hy_item_decode(it, ct, base, t0, L, b, isctx);
        __syncthreads();
        { const int c = tid >> 3, seg = tid & 7;
          const bf16* src = isctx ? (WSP<bf16>(F, WS_YTC) + ((size_t)(c0 + c) * NB + b) * CTXL + t0 + 8 * seg) : (WSP<bf16>(F, WS_YT) + ((size_t)(c0 + c) * NB + b) * SEQ + t0 + 8 * seg);
          *(LAS u32x4*)(Ys + c * HLD + 8 * seg) = *(const u32x4*)src; }
        float x0[8], x1[8], v[8];
        hy_sconv8(P, base, t0 + tl, L, c0 + 8 * cg, w0, x0); hy_sconv8(P, base, t0 + tl, L, 512 + c0 + 8 * cg, w1, x1); hy_sconv8(P, base, t0 + tl, L, 1024 + c0 + 8 * cg, wv, v);
        __syncthreads();
        float hy[8];
#pragma unroll
        for (int i = 0; i < 8; ++i) { const float y = bf2f(Ys[(8 * cg + i) * HLD + tl]); hy[i] = x0[i] * (y + sk[i] * (x1[i] * v[i])); }
        u32x4 o; o.x = pk2(hy[0], hy[1]); o.y = pk2(hy[2], hy[3]); o.z = pk2(hy[4], hy[5]); o.w = pk2(hy[6], hy[7]);
        *(u32x4*)(HY + (size_t)(base + t0 + tl) * 512 + c0 + 8 * cg) = o;
    }
}
__device__ __forceinline__ void hyconv_ctx_item2(Frame& F, int c) {
    const float* HFp = WSP<float>(F, WS_HFC); const float* HBp = WSP<float>(F, WS_HFC + 512 * 1024);
    const float il1 = hy_inv_l1(F, 2, c);
    const bf16* Z = WSP<bf16>(F, WS_ZTC) + (size_t)c * NB * CTXL; bf16* Yo = WSP<bf16>(F, WS_YTC) + (size_t)c * NB * CTXL;
#pragma unroll
    for (int i = 0; i < 4; ++i) {
        const int o = F.tid * 4 + i, b = o >> 8, t = o & 255;
        float a = 0.f;
        for (int s = 0; s < CTXL; ++s) { const int d = t - s; const float k = (d >= 0) ? HFp[(size_t)d * 512 + c] : HBp[(size_t)(-d) * 512 + c]; a += k * bf2f(Z[b * CTXL + s]); }
        Yo[o] = f2bf(a * il1);
    }
}

constexpr int ALD = 72;
__device__ __forceinline__ void attn_unit(Frame& F, int l, int unit) {
    const bf16* P = WSP<bf16>(F, WS_P);
    LAS bf16* Kb = (LAS bf16*)F.lds; LAS bf16* Vt = Kb + 64 * ALD;
    const bool isctx = unit >= 1024;
    int b, kvh, qb;
    if (!isctx) { b = unit >> 7; kvh = (unit >> 6) & 1; qb = unit & 63; } else { const int it = unit - 1024; b = it >> 3; kvh = (it >> 2) & 1; qb = it & 3; }
    int tid = F.tid; asm volatile("" : "+v"(tid));
    const int lane = tid & 63, w = F.wave, g = w >> 1, h = kvh * 4 + g, lg = lane >> 4, lc = lane & 15;
    const int start = qb * 64, q0 = start + (w & 1) * 32;
    const int rowq0 = isctx ? (NLAT + b * CTXL + q0) : (b * SEQ + q0);
    bf16x8 bq[2][2];
#pragma unroll
    for (int qt = 0; qt < 2; ++qt)
#pragma unroll
        for (int ks = 0; ks < 2; ++ks) bq[qt][ks] = *(const bf16x8*)(P + (size_t)(rowq0 + 16 * qt + lc) * INC + C_AQ + h * 64 + 32 * ks + 8 * lg);
    const float sink = IN_(F, 9)[l * 8 + h];
    float mrun[2], lsum[2]; f32x4 o[4][2];
#pragma unroll
    for (int qt = 0; qt < 2; ++qt) { mrun[qt] = sink; lsum[qt] = (lg == 0) ? 1.0f : 0.0f;
#pragma unroll
        for (int dt = 0; dt < 4; ++dt) o[dt][qt] = (f32x4){0.f, 0.f, 0.f, 0.f}; }
    const int nkb = isctx ? 4 : 9;
#pragma unroll 1
    for (int kb = 0; kb < nkb; ++kb) {
        const bool ctxblk = isctx || kb >= 5;
        __syncthreads();
        { const int key = tid >> 3, d0 = (tid & 7) * 8;
          int row = -1;
          if (ctxblk) row = NLAT + b * CTXL + (isctx ? kb : kb - 5) * 64 + key;
          else { const int kpos = start - 128 + kb * 64 + key; if (kpos >= 0 && kpos < SEQ) row = b * SEQ + kpos; }
          u32x4 kk = (u32x4){0u, 0u, 0u, 0u}, vv = kk;
          if (row >= 0) { kk = *(const u32x4*)(P + (size_t)row * INC + C_AK + kvh * 64 + d0); vv = *(const u32x4*)(P + (size_t)row * INC + C_AV + kvh * 64 + d0); }
          *(LAS u32x4*)(Kb + key * ALD + d0) = kk;
          const unsigned vw[4] = {vv.x, vv.y, vv.z, vv.w};
#pragma unroll
          for (int i = 0; i < 4; ++i) { Vt[(d0 + 2 * i) * ALD + key] = (bf16)(vw[i] & 0xffffu); Vt[(d0 + 2 * i + 1) * ALD + key] = (bf16)(vw[i] >> 16); } }
        __syncthreads();
        f32x4 s[4][2];
#pragma unroll
        for (int kt = 0; kt < 4; ++kt) {
            const bf16x8 k0 = *(const LAS bf16x8*)(Kb + (16 * kt + lc) * ALD + 8 * lg), k1 = *(const LAS bf16x8*)(Kb + (16 * kt + lc) * ALD + 32 + 8 * lg);
#pragma unroll
            for (int qt = 0; qt < 2; ++qt) { f32x4 c = (f32x4){0.f, 0.f, 0.f, 0.f};
                c = __builtin_amdgcn_mfma_f32_16x16x32_bf16(k0, bq[qt][0], c, 0, 0, 0); c = __builtin_amdgcn_mfma_f32_16x16x32_bf16(k1, bq[qt][1], c, 0, 0, 0);
                s[kt][qt] = c * 0.125f; }
        }
        if (!ctxblk) {
#pragma unroll
            for (int kt = 0; kt < 4; ++kt)
#pragma unroll
                for (int qt = 0; qt < 2; ++qt)
#pragma unroll
                    for (int r = 0; r < 4; ++r) { const int kpos = start - 128 + kb * 64 + 16 * kt + 4 * lg + r, qpos = q0 + 16 * qt + lc, dd = qpos - kpos;
                        const bool valid = (kpos >= 0) && (kpos < SEQ) && (dd <= 128) && (dd >= -128);
                        s[kt][qt][r] = valid ? s[kt][qt][r] : -1.0e30f; }
        }
        bf16x8 pf[2][2];
#pragma unroll
        for (int qt = 0; qt < 2; ++qt) {
            float bm = -3.0e38f;
#pragma unroll
            for (int kt = 0; kt < 4; ++kt) bm = fmaxf(bm, fmaxf(fmaxf(s[kt][qt][0], s[kt][qt][1]), fmaxf(s[kt][qt][2], s[kt][qt][3])));
            bm = fmaxf(bm, __shfl_xor(bm, 16)); bm = fmaxf(bm, __shfl_xor(bm, 32));
            const float mnew = fmaxf(mrun[qt], bm), sc = __expf(mrun[qt] - mnew);
            mrun[qt] = mnew;
            float ps = 0.f; unsigned pw[8];
#pragma unroll
            for (int kt = 0; kt < 4; ++kt) { const float p0 = __expf(s[kt][qt][0] - mnew), p1 = __expf(s[kt][qt][1] - mnew), p2 = __expf(s[kt][qt][2] - mnew), p3 = __expf(s[kt][qt][3] - mnew);
                ps += (p0 + p1) + (p2 + p3); pw[2 * kt] = pk2(p0, p1); pw[2 * kt + 1] = pk2(p2, p3); }
            lsum[qt] = lsum[qt] * sc + ps;
#pragma unroll
            for (int dt = 0; dt < 4; ++dt) o[dt][qt] = o[dt][qt] * sc;
            u32x4 f0; f0.x = pw[0]; f0.y = pw[1]; f0.z = pw[2]; f0.w = pw[3];
            u32x4 f1; f1.x = pw[4]; f1.y = pw[5]; f1.z = pw[6]; f1.w = pw[7];
            pf[qt][0] = __builtin_bit_cast(bf16x8, f0); pf[qt][1] = __builtin_bit_cast(bf16x8, f1);
        }
#pragma unroll
        for (int dt = 0; dt < 4; ++dt)
#pragma unroll
            for (int ks = 0; ks < 2; ++ks) {
                const u32x2 a0 = *(const LAS u32x2*)(Vt + (16 * dt + lc) * ALD + 32 * ks + 4 * lg), a1 = *(const LAS u32x2*)(Vt + (16 * dt + lc) * ALD + 32 * ks + 16 + 4 * lg);
                u32x4 av; av.x = a0.x; av.y = a0.y; av.z = a1.x; av.w = a1.y;
                const bf16x8 va = __builtin_bit_cast(bf16x8, av);
#pragma unroll
                for (int qt = 0; qt < 2; ++qt) o[dt][qt] = __builtin_amdgcn_mfma_f32_16x16x32_bf16(va, pf[qt][ks], o[dt][qt], 0, 0, 0);
            }
    }
    bf16* ATT = WSP<bf16>(F, WS_ATT);
#pragma unroll
    for (int qt = 0; qt < 2; ++qt) {
        float lt = lsum[qt]; lt += __shfl_xor(lt, 16); lt += __shfl_xor(lt, 32);
        const float inv = 1.0f / lt;
        bf16* op = ATT + (size_t)(rowq0 + 16 * qt + lc) * 512 + h * 64 + 4 * lg;
#pragma unroll
        for (int dt = 0; dt < 4; ++dt) { u32x2 ov; ov.x = pk2(o[dt][qt][0] * inv, o[dt][qt][1] * inv); ov.y = pk2(o[dt][qt][2] * inv, o[dt][qt][3] * inv); *(u32x2*)(op + 16 * dt) = ov; }
    }
}

__device__ __forceinline__ void ph_norm2_router(Frame& F, int l, int nrows) {
    const int lane = F.lane, RPB = nrows / 256;
    LAS float* RW = (LAS float*)F.lds;
    LAS unsigned* cnt = (LAS unsigned*)(F.lds + LDSX + 64);
    __syncthreads();
    { const float* rw = IN_(F, 24) + (size_t)l * 1024 * 32;
      for (int i = F.tid; i < 1024 * 32 / 4; i += NTHR) *(LAS f32x4*)(RW + 4 * i) = *(const f32x4*)(rw + 4 * i); }
    if (F.tid < 32) cnt[F.tid] = 0u;
    __syncthreads();
    const float* xm_all = WSP<float>(F, WS_XM);
    const float* gw_ = IN_(F, 23) + l * DM;
    const float rb = (lane < 32) ? IN_(F, 25)[l * 32 + lane] : 0.f;
    int* TOPI = WSP<int>(F, WS_TOPI); float* TOPW = WSP<float>(F, WS_TOPW);
    for (int rr = F.wave; rr < RPB; rr += NWAVES) {
        const int r = F.bx * RPB + rr, mr = modrow_of(r);
        const float* xr = xm_all + (size_t)r * DM;
        const float* sh = mod_ptr(F, l, mr, 3); const float* sc = mod_ptr(F, l, mr, 4);
        f32x4 v[4]; float ss = 0.f;
#pragma unroll
        for (int j = 0; j < 4; ++j) { v[j] = *(const f32x4*)(xr + 4 * lane + 256 * j); ss += (v[j][0] * v[j][0] + v[j][1] * v[j][1]) + (v[j][2] * v[j][2] + v[j][3] * v[j][3]); }
        const float rstd = 1.0f / sqrtf(wave_sum(ss) * (1.0f / DM) + EPS);
        bf16* o = WSP<bf16>(F, WS_XN) + (size_t)r * DM;
#pragma unroll
        for (int j = 0; j < 4; ++j) { const f32x4 g = *(const f32x4*)(gw_ + 4 * lane + 256 * j); const f32x4 a = *(const f32x4*)(sh + 4 * lane + 256 * j); const f32x4 b = *(const f32x4*)(sc + 4 * lane + 256 * j);
            v[j] = v[j] * rstd * g * (b + 1.0f) + a;
            u32x2 w2; w2.x = pk2(v[j][0], v[j][1]); w2.y = pk2(v[j][2], v[j][3]); *(u32x2*)(o + 4 * lane + 256 * j) = w2; }
        float acc = 0.f;
        const int e = lane & 31, hf = lane >> 5;
#pragma unroll 4
        for (int src = 0; src < 64; ++src) {
#pragma unroll
            for (int jj = 0; jj < 2; ++jj)
#pragma unroll
                for (int q = 0; q < 4; ++q) {
                    const float h0 = rdlane(v[jj][q], src), h1 = rdlane(v[jj + 2][q], src);
                    const float hv = hf ? h1 : h0;
                    const int col = 4 * src + 256 * (jj + 2 * hf) + q;
                    acc += hv * RW[col * 32 + e];
                }
        }
        acc += __shfl_xor(acc, 32);
        float logit = acc + rb;
        logit = __shfl(logit, e);
        float tv[4]; int ti[4];
        float cur = logit;
#pragma unroll
        for (int k = 0; k < 4; ++k) {
            float bvv = cur; int bi = e;
#pragma unroll
            for (int off = 1; off < 32; off <<= 1) { const float ov = __shfl_xor(bvv, off); const int oi = __shfl_xor(bi, off);
                if (ov > bvv || (ov == bvv && oi < bi)) { bvv = ov; bi = oi; } }
            tv[k] = bvv; ti[k] = bi;
            if (e == bi) cur = -3.0e38f;
        }
        const float mx = tv[0];
        float ex[4], den = 0.f;
#pragma unroll
        for (int k = 0; k < 4; ++k) { ex[k] = __expf(tv[k] - mx); den += ex[k]; }
        if (lane < 4) { const int k = lane; const int id = (k == 0) ? ti[0] : (k == 1) ? ti[1] : (k == 2) ? ti[2] : ti[3]; const float wv = ((k == 0) ? ex[0] : (k == 1) ? ex[1] : (k == 2) ? ex[2] : ex[3]) / den;
            TOPI[r * 4 + k] = id; TOPW[r * 4 + k] = wv; __hip_atomic_fetch_add(cnt + id, 1u, __ATOMIC_RELAXED, __HIP_MEMORY_SCOPE_WORKGROUP); }
    }
    __syncthreads();
    if (F.tid < 32) WSP<int>(F, WS_BLKCNT)[F.bx * 32 + F.tid] = (int)cnt[F.tid];
}

__device__ __forceinline__ void ph_moe_assign(Frame& F, int nrows) {
    const int RPB = nrows / 256, lane = F.lane;
    LAS int* part = (LAS int*)F.lds;
    LAS int* base = part + 1024;
    LAS int* idx = base + 32;
    LAS int* posl = idx + 1024;
    const int* BC = WSP<int>(F, WS_BLKCNT);
    __syncthreads();
    { const int e = F.tid & 31, pt = F.tid >> 5; int st = 0, sp = 0;
      for (int q = 0; q < 16; ++q) { const int blk = pt * 16 + q; const int v = BC[blk * 32 + e]; st += v; if (blk < F.bx) sp += v; }
      part[pt * 32 + e] = st; part[512 + pt * 32 + e] = sp; }
    for (int i = F.tid; i < RPB * 4; i += NTHR) idx[i] = WSP<int>(F, WS_TOPI)[F.bx * RPB * 4 + i];
    __syncthreads();
    if (F.tid < 32) { int st = 0, sp = 0; for (int q = 0; q < 16; ++q) { st += part[q * 32 + F.tid]; sp += part[512 + q * 32 + F.tid]; }
        part[F.tid] = st; part[512 + F.tid] = sp; }
    __syncthreads();
    if (F.tid == 0) { int t0 = 0; int* tl = WSP<int>(F, WS_TILES);
        for (int e = 0; e < 32; ++e) { base[e] = t0 * 256 + part[512 + e]; if (F.bx == 0) tl[e] = t0; t0 += (part[e] + 255) >> 8; }
        if (F.bx == 0) tl[32] = t0; }
    __syncthreads();
    if (F.tid < 32) { const int e = F.tid; int c = base[e]; for (int j = 0; j < RPB * 4; ++j) if (idx[j] == e) posl[j] = c++; }
    __syncthreads();
    const bf16* H = WSP<bf16>(F, WS_XN); bf16* HS = WSP<bf16>(F, WS_HS); int* POS = WSP<int>(F, WS_POS);
    for (int rr = F.wave; rr < RPB; rr += NWAVES) {
        const int r = F.bx * RPB + rr;
        const u32x4 a = *(const u32x4*)(H + (size_t)r * DM + 8 * lane), b = *(const u32x4*)(H + (size_t)r * DM + 512 + 8 * lane);
#pragma unroll
        for (int k = 0; k < 4; ++k) { const int p = posl[rr * 4 + k];
            *(u32x4*)(HS + (size_t)p * DM + 8 * lane) = a; *(u32x4*)(HS + (size_t)p * DM + 512 + 8 * lane) = b; }
        if (lane < 4) POS[r * 4 + lane] = posl[rr * 4 + lane];
    }
}

#define PHASE_FN __device__ __forceinline__
PHASE_FN void P_prologue() { Frame F = make_frame(); p0_prologue(F); }
PHASE_FN void P_norm1(int mode) { Frame F = make_frame(); ph_norm1(F, mode);
    if (mode == 0) { FftTw T; fft_tw_init(T, F.tid); for (int it = F.bx; it < 1024; it += F.G) fft_filter_unit(F, T, it >> 9, it & 511); } }
PHASE_FN void P_inproj(int l) { Frame F = make_frame();
    pg8::Gemm g{WSP<bf16>(F, WS_XN), WSP<bf16>(F, WS_WIN) + (size_t)l * INC * 1024, NROWS, INC, 1024};
    pg8::StaticOrder S; S.init(NROWS, INC, F.G, F.bx);
    EpiP E{WSP<bf16>(F, WS_P)};
    pg8::gemm_phase<EpiP, pg8::StaticOrder, true, true>(F.lds, g, S, E); }
PHASE_FN void P_rope() { Frame F = make_frame(); ph_rope(F); }
PHASE_FN void P_mix(int l) { Frame F = make_frame(); const bool last = (l == 1);
    const int na = last ? 1024 : 1088;
    for (int it = F.bx; it < na; it += F.G) attn_unit(F, l, it);
    for (int it = F.bx; it < 1088; it += F.G) ret_kv_unit(F, l, it);
    ph_hyprep2(F, l, !last); }

PHASE_FN void P_hyconv(int l) { Frame F = make_frame(); const bool last = (l == 1);
    ret_scan(F, l);
    { FftTw T; fft_tw_init(T, F.tid); for (int it = F.bx; it < 2048; it += F.G) fft_conv_unit(F, T, l, it); }
    if (!last) for (int it = F.bx; it < 512; it += F.G) hyconv_ctx_item2(F, it); }
PHASE_FN void P_hypost(int l) { Frame F = make_frame(); const bool last = (l == 1);
    for (int it = F.bx; it < 1088; it += F.G) { const int ci = it % 34; if (last && ci < 2) continue; ret_out_unit(F, l, it); }
    ph_hypost2(F, l, !last); }
template <int BR> PHASE_FN void P_branch(int l) { Frame F = make_frame(); const int mrows = (l == 1) ? NLAT : NROWS;
    const bf16* A = WSP<bf16>(F, BR == 0 ? WS_RET : (BR == 1 ? WS_ATT : WS_HY));
    pg8::Gemm g{A, WSP<bf16>(F, WS_WBR) + (size_t)(l * 3 + BR) * 1024 * 512, mrows, 1024, 512};
    pg8::StaticOrder S; S.init(mrows, 1024, F.G, F.bx);
    EpiBranch<BR> E{WSP<bf16>(F, WS_P), IN_(F, 21) + l * 3072, WSP<float>(F, WS_MF32), WSP<bf16>(F, WS_M)};
    pg8::gemm_phase<EpiBranch<BR>, pg8::StaticOrder, true, true>(F.lds, g, S, E); }
PHASE_FN void P_out(int l) { Frame F = make_frame(); const int mrows = (l == 1) ? NLAT : NROWS;
    pg8::Gemm g{WSP<bf16>(F, WS_M), WSP<bf16>(F, WS_WOUT) + (size_t)l * 1024 * 1024, mrows, 1024, 1024};
    pg8::StaticOrder S; S.init(mrows, 1024, F.G, F.bx);
    const float* xl = (l == 0) ? IN_(F, 0) : WSP<float>(F, WS_XO);
    const float* xc = (l == 0) ? IN_(F, 2) : WSP<float>(F, WS_XO) + (size_t)NLAT * DM;
    EpiOut E{xl, xc, mod_ptr(F, l, 0, 2), WSP<float>(F, WS_XM)};
    pg8::gemm_phase<EpiOut, pg8::StaticOrder, true, true>(F.lds, g, S, E); }
PHASE_FN void P_router(int l) { Frame F = make_frame(); ph_norm2_router(F, l, (l == 1) ? NLAT : NROWS); }
PHASE_FN void P_assign(int l) { Frame F = make_frame(); ph_moe_assign(F, (l == 1) ? NLAT : NROWS); }
PHASE_FN void P_moe1(int l) { Frame F = make_frame();
    LAS int* list = (LAS int*)(F.lds + LDSX + 256);
    const int n = moe_list_units(F, 8, list);
    pg8::Gemm g{WSP<bf16>(F, WS_HS), WSP<bf16>(F, WS_W1) + (size_t)l * 32 * 2048 * 1024, MPAD, 32 * 2048, 1024};
    MoeOrder S{list, n};
    EpiMoe1 E{IN_(F, 27) + (size_t)l * 32 * 2048, WSP<bf16>(F, WS_ACT)};
    pg8::gemm_phase<EpiMoe1, MoeOrder, true, true>(F.lds, g, S, E); }
PHASE_FN void P_moe2(int l) { Frame F = make_frame();
    LAS int* list = (LAS int*)(F.lds + LDSX + 256);
    const int n = moe_list_units(F, 4, list);
    pg8::Gemm g{WSP<bf16>(F, WS_ACT), WSP<bf16>(F, WS_W2) + (size_t)l * 32 * 1024 * 1024, MPAD, 32 * 1024, 1024};
    MoeOrder S{list, n};
    EpiMoe2 E{IN_(F, 29) + (size_t)l * 32 * 1024, WSP<bf16>(F, WS_HS)};
    pg8::gemm_phase<EpiMoe2, MoeOrder, true, true>(F.lds, g, S, E); }

template <int ONLY> __global__ void __launch_bounds__(NTHR, 2) mk_fwd(Args args) {
    LAS unsigned char* lds = (LAS unsigned char*)lds_raw;
    const int tid = threadIdx.x;
    for (int u = tid; u < (LDS_BYTES - LDSX) / 4; u += NTHR) ((LAS unsigned*)(lds + LDSX))[u] = 0u;
    __syncthreads();
    if (tid < 33) { const unsigned long long v = (tid < 31) ? (unsigned long long)args.in[tid] : (tid == 31 ? (unsigned long long)args.out : (unsigned long long)args.ws);
        *(LAS unsigned long long*)(lds + LDS_PTAB + 8 * tid) = v; }
    __syncthreads();
    const int lo = args.ph_lo, hi = args.ph_hi;
    const bool one_launch = (hi - lo) > 1;
    unsigned* barw = (unsigned*)(args.ws + WS_CTL + CTL_BAR);
    XcdBarrier bar; bar.bar = barw; bar.x = 0; bar.st = nullptr;
    if (one_launch) bar = xcd_barrier_post(barw, (volatile LAS unsigned*)(lds + LDSX));
#ifndef MK_MASK
#define MK_MASK 0xFFFFFFFFu
#endif
#define ENAB(k) ((ONLY < 0 && ((MK_MASK >> ((k) >= 100 ? (k) - 100 + 14 : (k))) & 1u)) || ONLY == (k))
#ifndef MK_REP
#define MK_REP 0u
#endif
#define REPB(k) (((MK_REP) >> ((k) >= 100 ? (k) - 100 + 14 : (k))) & 1u)
#define IN(k) (lo <= (k) && (k) < hi)
#define SEAM(k) do { if (IN(k) && IN((k) + 1)) xcd_barrier(bar); } while (0)
    if (ENAB(100)) if (IN(0)) { P_prologue(); if (REPB(100)) { xcd_barrier(bar); P_prologue(); } } SEAM(0);
    for (int l = 0; l < 2; ++l) {
        const int pb = 1 + NPH_LAYER * l;
        if (ENAB(0)) if (IN(pb + 0)) { P_norm1(l == 0 ? 0 : 1); if (REPB(0)) { xcd_barrier(bar); P_norm1(l == 0 ? 0 : 1); } } SEAM(pb + 0);
        if (ENAB(1)) if (IN(pb + 1)) { P_inproj(l); if (REPB(1)) { xcd_barrier(bar); P_inproj(l); } } SEAM(pb + 1);
        if (ENAB(2)) if (IN(pb + 2)) { P_rope(); } SEAM(pb + 2);
        if (ENAB(3)) if (IN(pb + 3)) { P_mix(l); if (REPB(3)) { xcd_barrier(bar); P_mix(l); } } SEAM(pb + 3);
        if (ENAB(4)) if (IN(pb + 4)) { P_hyconv(l); if (REPB(4)) { xcd_barrier(bar); P_hyconv(l); } } SEAM(pb + 4);
        if (ENAB(5)) if (IN(pb + 5)) { P_hypost(l); if (REPB(5)) { xcd_barrier(bar); P_hypost(l); } } SEAM(pb + 5);
        if (ENAB(6)) if (IN(pb + 6)) { P_branch<0>(l); } SEAM(pb + 6);
        if (ENAB(7)) if (IN(pb + 7)) { P_branch<1>(l); } SEAM(pb + 7);
        if (ENAB(8)) if (IN(pb + 8)) { P_branch<2>(l); } SEAM(pb + 8);
        if (ENAB(9)) if (IN(pb + 9)) { P_out(l); if (REPB(9)) { xcd_barrier(bar); P_out(l); } } SEAM(pb + 9);
        if (ENAB(10)) if (IN(pb + 10)) { P_router(l); if (REPB(10)) { xcd_barrier(bar); P_router(l); } } SEAM(pb + 10);
        if (ENAB(11)) if (IN(pb + 11)) { P_assign(l); if (REPB(11)) { xcd_barrier(bar); P_assign(l); } } SEAM(pb + 11);
        if (ENAB(12)) if (IN(pb + 12)) { P_moe1(l); if (REPB(12)) { xcd_barrier(bar); P_moe1(l); } } SEAM(pb + 12);
        if (ENAB(13)) if (IN(pb + 13)) { P_moe2(l); if (REPB(13)) { xcd_barrier(bar); P_moe2(l); } } SEAM(pb + 13);
    }
    if (ENAB(101)) if (IN(NPH - 1)) { P_norm1(2); }
#undef IN
#undef SEAM
#undef ENAB
}

template <int ONLY> static void launch_phase(Args a, int lo, int hi, int grid, hipStream_t stream) {
    static bool attr_set = false;
    if (!attr_set) { (void)hipFuncSetAttribute((const void*)mk_fwd<ONLY>, hipFuncAttributeMaxDynamicSharedMemorySize, LDS_BYTES); attr_set = true; }
    a.ph_lo = lo; a.ph_hi = hi;
    hipLaunchKernelGGL(mk_fwd<ONLY>, dim3(grid), dim3(NTHR), LDS_BYTES, stream, a);
}
extern "C" void kernel_launch(void* const* d_in, const int* in_sizes, int n_in, void* d_out, int out_size, void* d_ws, size_t ws_size, hipStream_t stream) {
    static int grid = 0;
    if (grid == 0) {
        if (n_in != 31 || ws_size < WS_END) { fprintf(stderr, "kernel_launch: unexpected n_in %d / ws_size %zu\n", n_in, ws_size); grid = -1; return; }
        int dev = 0, cus = 0;
        if (hipGetDevice(&dev) != hipSuccess || hipDeviceGetAttribute(&cus, hipDeviceAttributeMultiprocessorCount, dev) != hipSuccess) { grid = -1; return; }
        grid = (cus == 256) ? 256 : -1;
        if (grid < 0) { fprintf(stderr, "kernel_launch: needs a 256-CU device, got %d\n", cus); return; }
    }
    if (grid < 0) return;
    (void)hipMemsetAsync((char*)d_ws + WS_CTL, 0, CTL_ZERO_BYTES, stream);
    Args a{};
    for (int i = 0; i < 31; ++i) a.in[i] = (const float*)d_in[i];
    a.out = (float*)d_out; a.ws = (unsigned char*)d_ws;
#if MK_ONE_LAUNCH
    launch_phase<-1>(a, 0, NPH, grid, stream);
#else
    launch_phase<100>(a, 0, 1, grid, stream);
    for (int l = 0; l < 2; ++l) {
        const int pb = 1 + NPH_LAYER * l;
        launch_phase<0>(a, pb + 0, pb + 1, grid, stream);   launch_phase<1>(a, pb + 1, pb + 2, grid, stream);   launch_phase<2>(a, pb + 2, pb + 3, grid, stream);
        launch_phase<3>(a, pb + 3, pb + 4, grid, stream);   launch_phase<4>(a, pb + 4, pb + 5, grid, stream);   launch_phase<5>(a, pb + 5, pb + 6, grid, stream);
        launch_phase<6>(a, pb + 6, pb + 7, grid, stream);   launch_phase<7>(a, pb + 7, pb + 8, grid, stream);   launch_phase<8>(a, pb + 8, pb + 9, grid, stream);
        launch_phase<9>(a, pb + 9, pb + 10, grid, stream);  launch_phase<10>(a, pb + 10, pb + 11, grid, stream); launch_phase<11>(a, pb + 11, pb + 12, grid, stream);
        launch_phase<12>(a, pb + 12, pb + 13, grid, stream); launch_phase<13>(a, pb + 13, pb + 14, grid, stream);
    }
    launch_phase<101>(a, NPH - 1, NPH, grid, stream);
#endif
}
```

```cpp
#include <hip/hip_runtime.h>
#include <cstdio>
#include <cstdint>
#define MK_ONE_LAUNCH 1
namespace pg8 {
#define PG8_LAS __attribute__((address_space(3)))
typedef unsigned short bf16_t;
typedef short bf16x8 __attribute__((ext_vector_type(8)));
typedef float f32x4 __attribute__((ext_vector_type(4)));
typedef unsigned u32x4 __attribute__((ext_vector_type(4)));
constexpr int BM = 256, BK = 64, HALF = 128, HTB = HALF * BK * 2  , STAGE_BYTES = 8 * HTB, NXCD = 8, WGM = 8;

__host__ __device__ __forceinline__ int lds_byte(int r, int c) { const int st = (r >> 4) * 2 + (c >> 5), rr = r & 15, cc = c & 31, ob = rr * 64 + cc * 2; return st * 1024 + (ob ^ (((ob >> 9) & 1) << 5)); }
__host__ __device__ __forceinline__ void stage_rc(int b, int& R, int& C) { const int st = b / 1024, sb = b % 1024, swz = sb ^ (((sb >> 9) & 1) << 5); R = (st >> 1) * 16 + swz / 64; C = (st & 1) * 32 + (swz % 64) / 2; }
__host__ __device__ __forceinline__ int perm32(int rho) { const int n = rho >> 4, i = rho & 15; return 8 * (i >> 2) + 4 * n + (i & 3); }

struct Unit { int pm, pn; };
struct Gemm { const bf16_t* A; const bf16_t* Bt; int M, N, K; };

struct StaticOrder {
    int nM, nN, nwg, G, c;
    __host__ __device__ void init(int M, int N, int G_, int c_) { nM = M / BM; nN = N / BM; nwg = nM * nN; G = G_; c = c_; }
    __host__ __device__ bool next(int i, Unit& u) const {
        const long L = (long)i * G + c; if (L >= nwg) return false;
        int wgid = (int)L; { const int q = nwg / NXCD, r = nwg % NXCD, xcd = wgid % NXCD, off = wgid / NXCD; wgid = (xcd < r ? xcd * (q + 1) : r * (q + 1) + (xcd - r) * q) + off; }
        const int nig = WGM * nN, gid = wgid / nig, fm = gid * WGM, gsz = (nM - fm) < WGM ? (nM - fm) : WGM;
        u.pm = fm + ((wgid % nig) % gsz); u.pn = (wgid % nig) / gsz; return true;
    }
    __device__ __forceinline__ void a_ready(const Unit&) const {}
    __device__ __forceinline__ void done(const Unit&) const {}
};

__device__ __forceinline__ unsigned cvt_pk_bf16(float lo, float hi) { unsigned r; asm volatile("v_cvt_pk_bf16_f32 %0, %1, %2" : "=v"(r) : "v"(lo), "v"(hi)); return r; }
template <class Epi, class Sched, bool ALIGN_EPI = false, bool SP2 = false>
__device__ __forceinline__ void gemm_phase(PG8_LAS unsigned char* lds, const Gemm g, const Sched& S, const Epi& E) {
    int tid_ = threadIdx.x; asm volatile("" : "+v"(tid_));
    const int tid = tid_, wid = __builtin_amdgcn_readfirstlane(tid >> 6), lane = tid & 63, wr = wid >> 2, wc = wid & 3, fr = lane & 15, fq = lane >> 4;
    const int K = g.K, nt = K / BK;
    unsigned voffA[2], voffB[2];
#pragma unroll
    for (int i = 0; i < 2; ++i) { int R, C; stage_rc(tid * 16 + i * 8192, R, C); const int Rb = Epi::PERM ? ((R & ~31) + perm32(R & 31)) : R;
        voffA[i] = (unsigned)(R * K + C) * 2u; voffB[i] = (unsigned)(Rb * K + C) * 2u; }
    const size_t kstep = (size_t)(BK * 2);
    const size_t hstep = (size_t)HALF * K * 2;
    const size_t tstep = 2 * hstep;
    const unsigned ldsw = (unsigned)wid * 1024u;
    const int aoff = lds_byte(wr * 64 + fr, fq * 8), boff = lds_byte(wc * 32 + fr, fq * 8);
#define PG8_SA(b, h) (((b) * 2 + (h)) * HTB)
#define PG8_SB(b, h) ((4 + (b) * 2 + (h)) * HTB)
#define PG8_STAGE(bufoff, gbase, voff) do { _Pragma("unroll") for (int _i = 0; _i < 2; ++_i) \
        __builtin_amdgcn_global_load_lds((const unsigned*)((const char*)(gbase) + (voff)[_i]), (PG8_LAS unsigned*)(lds + (bufoff) + ldsw + _i * 8192), 16, 0, 0); } while (0)
#define PG8_LDA(dst, b, h) do { _Pragma("unroll") for (int m = 0; m < 4; ++m) _Pragma("unroll") for (int k = 0; k < 2; ++k) dst[m][k] = *(const PG8_LAS bf16x8*)(lds + PG8_SA(b, h) + aoff + m * 2048 + k * 1024); } while (0)
#define PG8_LDB(dst, b, h) do { _Pragma("unroll") for (int n = 0; n < 2; ++n) _Pragma("unroll") for (int k = 0; k < 2; ++k) dst[n][k] = *(const PG8_LAS bf16x8*)(lds + PG8_SB(b, h) + boff + n * 2048 + k * 1024); } while (0)
#define PG8_MMA(ai, bj, At, Bt) do { __builtin_amdgcn_s_setprio(1); _Pragma("unroll") for (int m = 0; m < 4; ++m) _Pragma("unroll") for (int n = 0; n < 2; ++n) _Pragma("unroll") for (int k = 0; k < 2; ++k) \
        acc[ai][bj][m][n] = __builtin_amdgcn_mfma_f32_16x16x32_bf16(Bt[n][k], At[m][k], acc[ai][bj][m][n], 0, 0, 0); __builtin_amdgcn_s_setprio(0); } while (0)
#define PG8_WAIT_V(n) asm volatile("s_waitcnt vmcnt(" #n ")" ::: "memory")
#define PG8_WAIT_L(n) asm volatile("s_waitcnt lgkmcnt(" #n ")" ::: "memory")
#define PG8_BAR __builtin_amdgcn_s_barrier()
#define PG8_SCHED __builtin_amdgcn_sched_barrier(0)
    Unit cur, nxt; int ui = 0;
    if (!S.next(0, cur)) return;
    f32x4 acc[2][2][4][2];
#pragma unroll
    for (int a = 0; a < 2; ++a)
#pragma unroll
        for (int b = 0; b < 2; ++b)
#pragma unroll
            for (int m = 0; m < 4; ++m)
#pragma unroll
                for (int n = 0; n < 2; ++n) acc[a][b][m][n] = (f32x4){0.f, 0.f, 0.f, 0.f};
    bf16x8 At[4][2], B0[2][2], B1[2][2];
    const char* cA = (const char*)g.A + (size_t)cur.pm * tstep; const char* cB = (const char*)g.Bt + (size_t)cur.pn * tstep;
    S.a_ready(cur);
    if constexpr (SP2) {
        PG8_STAGE(PG8_SB(0, 0), cB, voffB); PG8_STAGE(PG8_SB(0, 1), cB + hstep, voffB); PG8_STAGE(PG8_SA(0, 0), cA, voffA); PG8_STAGE(PG8_SA(0, 1), cA + hstep, voffA);
        if (wr == 1) PG8_BAR;
        PG8_WAIT_V(2); PG8_BAR;
        PG8_STAGE(PG8_SB(1, 0), cB + kstep, voffB); PG8_STAGE(PG8_SA(1, 0), cA + kstep, voffA); PG8_STAGE(PG8_SB(1, 1), cB + hstep + kstep, voffB);
        PG8_WAIT_V(6); PG8_BAR;
    } else {
        PG8_STAGE(PG8_SB(0, 0), cB, voffB); PG8_STAGE(PG8_SA(0, 0), cA, voffA); PG8_STAGE(PG8_SB(0, 1), cB + hstep, voffB); PG8_STAGE(PG8_SA(0, 1), cA + hstep, voffA);
        if (wr == 1) PG8_BAR;
        PG8_WAIT_V(4); PG8_BAR;
        PG8_STAGE(PG8_SB(1, 0), cB + kstep, voffB); PG8_STAGE(PG8_SA(1, 0), cA + kstep, voffA); PG8_STAGE(PG8_SB(1, 1), cB + hstep + kstep, voffB);
        PG8_WAIT_V(6); PG8_BAR;
    }
    for (;;) {
        const bool has_next = S.next(ui + 1, nxt);
        const char* nA = has_next ? (const char*)g.A + (size_t)nxt.pm * tstep : cA; const char* nB = has_next ? (const char*)g.Bt + (size_t)nxt.pn * tstep : cB;
        for (int t = 0; t < nt; t += 2) {
            if constexpr (Epi::KMID) { if (t == 8 || t == 16) E.kmid(t, acc, cur, wr, wc, fr, fq); }
            const bool last = (t == nt - 2);
            const char* a1 = cA + (size_t)(t + 1) * kstep;
            const char* a2 = last ? nA : cA + (size_t)(t + 2) * kstep; const char* b2 = last ? nB : cB + (size_t)(t + 2) * kstep;
            const char* a3 = a2 + kstep; const char* b3 = b2 + kstep;
            if (last && has_next) S.a_ready(nxt);
            if constexpr (SP2) {
            PG8_LDB(B0, 0, 0); PG8_LDB(B1, 0, 1); PG8_SCHED; PG8_LDA(At, 0, 0); PG8_STAGE(PG8_SA(1, 1), a1 + hstep, voffA);
            PG8_WAIT_V(8); PG8_WAIT_L(0); PG8_BAR; PG8_MMA(0, 0, At, B0); PG8_MMA(0, 1, At, B1); PG8_BAR; PG8_SCHED;
            PG8_LDA(At, 0, 1); PG8_STAGE(PG8_SB(0, 0), b2, voffB); PG8_STAGE(PG8_SB(0, 1), b2 + hstep, voffB); PG8_STAGE(PG8_SA(0, 0), a2, voffA);
            PG8_WAIT_V(8); PG8_WAIT_L(0); PG8_BAR; PG8_MMA(1, 0, At, B0); PG8_MMA(1, 1, At, B1); PG8_BAR; PG8_SCHED;
            PG8_LDB(B0, 1, 0); PG8_LDB(B1, 1, 1); PG8_SCHED; PG8_LDA(At, 1, 0); PG8_STAGE(PG8_SA(0, 1), a2 + hstep, voffA);
            PG8_WAIT_V(8); PG8_WAIT_L(0); PG8_BAR; PG8_MMA(0, 0, At, B0); PG8_MMA(0, 1, At, B1); PG8_BAR; PG8_SCHED;
            PG8_LDA(At, 1, 1); PG8_STAGE(PG8_SB(1, 0), b3, voffB); PG8_STAGE(PG8_SB(1, 1), b3 + hstep, voffB); PG8_STAGE(PG8_SA(1, 0), a3, voffA);
            PG8_WAIT_V(8); PG8_WAIT_L(0); PG8_BAR; PG8_MMA(1, 0, At, B0); PG8_MMA(1, 1, At, B1); PG8_BAR; PG8_SCHED;
            } else {
            PG8_LDB(B0, 0, 0); PG8_SCHED; PG8_LDA(At, 0, 0); PG8_STAGE(PG8_SA(1, 1), a1 + hstep, voffA);
            PG8_WAIT_L(8); PG8_BAR; PG8_WAIT_L(0); PG8_MMA(0, 0, At, B0); PG8_BAR; PG8_SCHED;
            PG8_LDB(B1, 0, 1); PG8_STAGE(PG8_SB(0, 0), b2, voffB);
            PG8_BAR; PG8_WAIT_L(0); PG8_MMA(0, 1, At, B1); PG8_BAR;
            PG8_LDA(At, 0, 1); PG8_STAGE(PG8_SA(0, 0), a2, voffA);
            PG8_BAR; PG8_WAIT_L(0); PG8_MMA(1, 0, At, B0); PG8_BAR; PG8_SCHED;
            PG8_STAGE(PG8_SB(0, 1), b2 + hstep, voffB);
            PG8_WAIT_V(6); PG8_BAR; PG8_MMA(1, 1, At, B1); PG8_BAR;
            PG8_LDB(B0, 1, 0); PG8_SCHED; PG8_LDA(At, 1, 0); PG8_STAGE(PG8_SA(0, 1), a2 + hstep, voffA);
            PG8_WAIT_L(8); PG8_BAR; PG8_WAIT_L(0); PG8_MMA(0, 0, At, B0); PG8_BAR; PG8_SCHED;
            PG8_LDB(B1, 1, 1); PG8_STAGE(PG8_SB(1, 0), b3, voffB);
            PG8_BAR; PG8_WAIT_L(0); PG8_MMA(0, 1, At, B1); PG8_BAR;
            PG8_LDA(At, 1, 1); PG8_STAGE(PG8_SA(1, 0), a3, voffA);
            PG8_BAR; PG8_WAIT_L(0); PG8_MMA(1, 0, At, B0); PG8_BAR; PG8_SCHED;
            PG8_STAGE(PG8_SB(1, 1), b3 + hstep, voffB);
            PG8_WAIT_V(6); PG8_BAR; PG8_MMA(1, 1, At, B1); PG8_BAR;
            }
        }
        if constexpr (ALIGN_EPI) { if (wr == 0) PG8_BAR; }
        if constexpr (!Epi::AFTER_DRAIN) { E(acc, cur, wr, wc, fr, fq); S.done(cur); }
        if (!has_next) break;
#pragma unroll
        for (int a = 0; a < 2; ++a)
#pragma unroll
            for (int b = 0; b < 2; ++b)
#pragma unroll
                for (int m = 0; m < 4; ++m)
#pragma unroll
                    for (int n = 0; n < 2; ++n) acc[a][b][m][n] = (f32x4){0.f, 0.f, 0.f, 0.f};
        cur = nxt; cA = nA; cB = nB; ++ui;
        if constexpr (ALIGN_EPI) { if (wr == 1) PG8_BAR; }
    }
    PG8_WAIT_V(0);
    if constexpr (!ALIGN_EPI) { if (wr == 0) PG8_BAR; }
    PG8_BAR;
    if constexpr (Epi::AFTER_DRAIN) { E.fused(acc, cur, wr, wc, fr, fq, lds, wid, lane); S.done(cur); }
#undef PG8_SA
#undef PG8_SB
#undef PG8_STAGE
#undef PG8_LDA
#undef PG8_LDB
#undef PG8_MMA
#undef PG8_WAIT_V
#undef PG8_WAIT_L
#undef PG8_BAR
#undef PG8_SCHED
}
}
#define XB_TMO      128
#define XB_XCNT(j)  (256  + 64 * (j))
#define XB_XSUB(j)  (1280 + 64 * (j))
#define XB_XGEN(j)  (2304 + 64 * (j))
#define XB_TOP      3328
#define XB_TOPGEN   3392
#define XCD_BAR_WORDS 3456
#define XB_SPIN_CAP (1u << 18)
#define LAS __attribute__((address_space(3)))

__device__ __forceinline__ unsigned xb_ld(unsigned* p)              { return __hip_atomic_load(p, __ATOMIC_RELAXED, __HIP_MEMORY_SCOPE_AGENT); }
__device__ __forceinline__ unsigned xb_add(unsigned* p, unsigned v) { return __hip_atomic_fetch_add(p, v, __ATOMIC_RELAXED, __HIP_MEMORY_SCOPE_AGENT); }
__device__ __forceinline__ unsigned xb_xcc_id() { return (unsigned)__builtin_amdgcn_s_getreg((3 << 11) | 20) & 0xFu; }
#define XB_SPIN(cond, bar) do { unsigned _sp = 0; while (cond) { __builtin_amdgcn_s_sleep(1); \
    if ((++_sp & 255u) == 0u) { if (xb_ld(&(bar)[XB_TMO])) break; if (_sp > XB_SPIN_CAP) { atomicAdd(&(bar)[XB_TMO], 1u); break; } } } } while (0)

struct XcdBarrier {
    unsigned* bar; unsigned x;
    volatile LAS unsigned* st;
};

__device__ __forceinline__ XcdBarrier xcd_barrier_post(unsigned* bar, volatile LAS unsigned* st) {
    XcdBarrier b; b.bar = bar; b.x = xb_xcc_id(); b.st = st;
    if (threadIdx.x == 0) (void)xb_add(&bar[XB_XCNT(b.x)], 1u);
    return b;
}
__device__ __forceinline__ void xcd_barrier_complete(unsigned* bar, unsigned x, unsigned& nloc, unsigned& nx) {
    const unsigned G = gridDim.x * gridDim.y * gridDim.z;
    unsigned sum, cnt, mine, sp = 0u;
    for (;;) {
        sum = 0u; cnt = 0u; mine = 0u;
#pragma unroll
        for (unsigned j = 0; j < 16; ++j) { const unsigned c = xb_ld(&bar[XB_XCNT(j)]); sum += c; cnt += (c > 0u) ? 1u : 0u; mine = (j == x) ? c : mine; }
        if (sum == G) break;
        __builtin_amdgcn_s_sleep(1);
        if ((++sp & 255u) == 0u) { if (xb_ld(&bar[XB_TMO])) break; if (sp > XB_SPIN_CAP) { atomicAdd(&bar[XB_TMO], 1u); break; } }
    }
    nloc = mine > 0u ? mine : 1u; nx = cnt > 0u ? cnt : 1u;
}

__device__ __forceinline__ void xcd_barrier(const XcdBarrier& b) {
    asm volatile("s_waitcnt vmcnt(0)" ::: "memory");
    __syncthreads();
    if (threadIdx.x == 0) {
        unsigned* bar = b.bar;
        __builtin_amdgcn_s_waitcnt(0);
        unsigned nloc = b.st[0], nx = b.st[1];
        if (nloc == 0u) { xcd_barrier_complete(bar, b.x, nloc, nx); b.st[0] = nloc; b.st[1] = nx; }
        const unsigned old = xb_add(&bar[XB_XSUB(b.x)], 1u);
        const unsigned gen = old / nloc;
        if (old + 1u == (gen + 1u) * nloc) {
            __builtin_amdgcn_fence(__ATOMIC_RELEASE, "agent");
            asm volatile("s_waitcnt vmcnt(0)" ::: "memory");
            const unsigned og = xb_add(&bar[XB_TOP], 1u);
            const unsigned tg = og / nx;
            if (og + 1u == (tg + 1u) * nx) xb_add(&bar[XB_TOPGEN], 1u);
            else XB_SPIN(xb_ld(&bar[XB_TOPGEN]) == tg, bar);
            __builtin_amdgcn_fence(__ATOMIC_ACQUIRE, "agent");
            xb_add(&bar[XB_XGEN(b.x)], 1u);
            asm volatile("s_waitcnt vmcnt(0)" ::: "memory");
        } else {
            XB_SPIN(xb_ld(&bar[XB_XGEN(b.x)]) == gen, bar);
            __builtin_amdgcn_fence(__ATOMIC_ACQUIRE, "agent");
            asm volatile("s_waitcnt vmcnt(0)" ::: "memory");
        }
    }
    __syncthreads();
}

#define GAS __attribute__((address_space(1)))
typedef unsigned short bf16;
typedef float f32x4 __attribute__((ext_vector_type(4)));
typedef unsigned u32x4 __attribute__((ext_vector_type(4)));
typedef unsigned u32x2 __attribute__((ext_vector_type(2)));
constexpr int DM = 1024, NB = 8, SEQ = 4096, CTXL = 256, NLAT = NB * SEQ, NCTX = NB * CTXL, NROWS = NLAT + NCTX;
constexpr int INC = 7424;
constexpr int C_RQ = 0, C_RK = 512, C_RV = 1024, C_RG = 1536, C_AQ = 2048, C_AK = 2560, C_AV = 2688, C_HU = 2816, C_MG = 4352;
constexpr int NEXP = 32, DFF = 1024;
constexpr int MPAD = 147456;
constexpr float EPS = 1e-6f;
constexpr int NWAVES = 8, NTHR = 512;
constexpr int LDS_BYTES = 147456, LDSX = 139264;
constexpr int NPH_LAYER = 14, NPH = 1 + 2 * NPH_LAYER + 1;

constexpr size_t MiB = 1u << 20;
constexpr size_t WS_CTL = 0, CTL_ZERO_BYTES = 1 * MiB;
constexpr size_t CTL_BAR = 16384;
constexpr size_t CTL_MOD = 262144;
constexpr size_t WS_L1P = 5 * MiB;
constexpr size_t WS_TOPI = 1 * MiB, WS_TOPW = 2 * MiB, WS_POS = 3 * MiB, WS_BLKCNT = 4 * MiB, WS_TILES = 4 * MiB + 65536;
constexpr size_t WS_WIN = 8 * MiB, WS_WBR = 37 * MiB, WS_WOUT = 43 * MiB, WS_W1 = 48 * MiB, WS_W2 = 304 * MiB;
constexpr size_t WS_HF = 432 * MiB;
constexpr size_t WS_HFC = 464 * MiB;
constexpr size_t WS_XM = 466 * MiB, WS_XO = 602 * MiB, WS_XN = 738 * MiB;
constexpr size_t WS_A = 806 * MiB;
constexpr size_t WS_P = WS_A, WS_RET = WS_A + 494 * MiB, WS_ATT = WS_RET + 34 * MiB, WS_HY = WS_ATT + 34 * MiB;
constexpr size_t WS_HS = WS_A, WS_ACT = WS_A + 288 * MiB;
constexpr size_t WS_MF32 = 1406 * MiB, WS_M = 1542 * MiB;
constexpr size_t WS_ZT = 1610 * MiB, WS_ZTC = 1674 * MiB, WS_YT = 1678 * MiB, WS_YTC = 1742 * MiB;
constexpr size_t WS_KV = 1746 * MiB, WS_SP = 1882 * MiB, WS_HSPEC = 1950 * MiB, WS_END = 2014 * MiB;
static_assert(WS_HY + 34 * MiB <= WS_MF32 && WS_ACT + 288 * MiB <= WS_MF32, "region A");
static_assert((size_t)NROWS * INC * 2 <= 494 * MiB, "P size");

__device__ __forceinline__ float bf2f(bf16 v) { return __uint_as_float(((unsigned)v) << 16); }
__device__ __forceinline__ bf16 f2bf(float f) { unsigned u = __float_as_uint(f); u += 0x7FFFu + ((u >> 16) & 1u); return (bf16)(u >> 16); }
__device__ __forceinline__ unsigned pk2(float lo, float hi) { return pg8::cvt_pk_bf16(lo, hi); }
__device__ __forceinline__ float wave_sum(float v) {
#pragma unroll
    for (int o = 1; o < 64; o <<= 1) v += __shfl_xor(v, o);
    return v;
}
__device__ __forceinline__ float rdlane(float v, int l) { return __int_as_float(__builtin_amdgcn_readlane(__float_as_int(v), l)); }
__device__ __forceinline__ float sin_rev(float rev) { return __builtin_amdgcn_sinf(__builtin_amdgcn_fractf(rev)); }
__device__ __forceinline__ float cos_rev(float rev) { return __builtin_amdgcn_cosf(__builtin_amdgcn_fractf(rev)); }
__device__ __forceinline__ float sin_rad(float x) { return sin_rev(x * 0.15915494309189535f); }
__device__ __forceinline__ float sigmoidf_(float x) { return 1.0f / (1.0f + __expf(-x)); }
__device__ __forceinline__ float siluf_(float x) { return x / (1.0f + __expf(-x)); }
__device__ __forceinline__ float log_sigmoid_(float x) {
    const float y = __expf(-x);
    if (y < 0.1f) { return -(y * (1.0f + y * (-0.5f + y * (0.33333333f + y * (-0.25f + y * (0.2f + y * (-0.16666667f + y * (0.14285714f + y * (-0.125f))))))))); }
    return -logf(1.0f + y);
}
#define LDS_WAIT() asm volatile("s_waitcnt lgkmcnt(0)" ::: "memory")
#define VM_WAIT() asm volatile("s_waitcnt vmcnt(0)" ::: "memory")

struct Args { const float* in[31]; float* out; unsigned char* ws; int ph_lo, ph_hi; };

extern __shared__ __attribute__((aligned(16))) unsigned char lds_raw[];
constexpr int LDS_PTAB = LDSX + 1024;
struct Frame {
    LAS unsigned char* lds;
    int tid, lane, wave, G, bx;
    unsigned char* ws;
};
__device__ __forceinline__ unsigned long long ptab_read(int i) {
    const LAS unsigned* p = (const LAS unsigned*)((LAS unsigned char*)lds_raw + LDS_PTAB) + 2 * i;
    const unsigned lo = (unsigned)__builtin_amdgcn_readfirstlane((int)p[0]), hi = (unsigned)__builtin_amdgcn_readfirstlane((int)p[1]);
    return ((unsigned long long)hi << 32) | lo;
}
__device__ __forceinline__ const float* IN_(const Frame& F, int i) { return (const float*)ptab_read(i); }
__device__ __forceinline__ float* OUT_(const Frame& F) { return (float*)ptab_read(31); }
__device__ __forceinline__ Frame make_frame() {
    Frame F; F.lds = (LAS unsigned char*)lds_raw;
    int t = threadIdx.x; asm volatile("" : "+v"(t)); F.tid = t; F.lane = t & 63; F.wave = __builtin_amdgcn_readfirstlane(t >> 6);
    int g = gridDim.x, bx = blockIdx.x; asm volatile("" : "+s"(g), "+s"(bx)); F.G = g; F.bx = bx;
    unsigned long long w = ptab_read(32); asm volatile("" : "+s"(w)); F.ws = (unsigned char*)w; return F;
}
template <class T> __device__ __forceinline__ T* WSP(const Frame& F, size_t off) { return (T*)(F.ws + off); }
__device__ __forceinline__ const float* mod_ptr(const Frame& F, int l, int modrow, int chunk) { return WSP<float>(F, WS_CTL + CTL_MOD) + ((size_t)(l * 9 + modrow) * 6 + chunk) * DM; }
__device__ __forceinline__ int modrow_of(int r) { return r < NLAT ? (r >> 12) : 8; }

constexpr int TRP = 65;
__device__ __forceinline__ void tr_item(const float* W, int K, int N, bf16* WT, int ldk, int item, int w1map, LAS float* scr, int lane) {
    const int nblk = N >> 6, kb = item / nblk, nb = item - kb * nblk, k0 = 64 * kb, n0 = 64 * nb;
    const int r = lane >> 4, cq = lane & 15;
    const float* src = W + (size_t)(k0 + r) * N + n0 + 4 * cq;
#pragma unroll 1
    for (int hh = 0; hh < 2; ++hh) {
        f32x4 v[8];
#pragma unroll
        for (int i = 0; i < 8; ++i) v[i] = *(const f32x4*)(src + (size_t)(4 * (8 * hh + i)) * N);
#pragma unroll
        for (int i = 0; i < 8; ++i) { LAS float* d = scr + (4 * (8 * hh + i) + r) * TRP + 4 * cq; d[0] = v[i][0]; d[1] = v[i][1]; d[2] = v[i][2]; d[3] = v[i][3]; }
    }
    LDS_WAIT(); asm volatile("" ::: "memory");
    int r0 = n0;
    if (w1map == 1) r0 = (n0 < 1024) ? ((n0 >> 7) * 256 + (n0 & 127)) : ((((n0 - 1024) >> 7) * 256) + 128 + ((n0 - 1024) & 127));
    const int kc = lane & 7;
#pragma unroll
    for (int j = 0; j < 8; ++j) { const int n = (lane >> 3) + 8 * j; const LAS float* s = scr + (8 * kc) * TRP + n;
        u32x4 o; o.x = pk2(s[0 * TRP], s[1 * TRP]); o.y = pk2(s[2 * TRP], s[3 * TRP]); o.z = pk2(s[4 * TRP], s[5 * TRP]); o.w = pk2(s[6 * TRP], s[7 * TRP]);
        int row = r0 + n;
        if (w1map == 2) {
            const int c = n0 + n;
            if (c < 1024) row = (c & ~255) + ((c >> 6) & 1) * 128 + ((c >> 7) & 1) * 64 + (c & 63);
            else if (c >= C_AQ && c < C_AV) { const int d = c & 63, gq = d >> 4, hd = (c >> 6) & 3; row = (c & ~255) + (gq & 1) * 128 + hd * 32 + (gq >> 1) * 16 + (d & 15); }
            else if (c >= C_AV && c < C_HU) { const int jv = c - C_AV; row = C_AK + (jv >> 6) * 128 + 64 + (jv & 63); }
        }
        *(u32x4*)(WT + (size_t)row * ldk + k0 + 8 * kc) = o; }
    LDS_WAIT(); asm volatile("" ::: "memory");
}

__device__ __forceinline__ void p0_prologue(Frame& F) {
    LAS float* scr = (LAS float*)(F.lds + F.wave * (64 * TRP * 4));
    const int gw = F.bx * NWAVES + F.wave, NGW = F.G * NWAVES, lane = F.lane;
    constexpr int I_WIN = 16 * 116, I_WBR = 8 * 16, I_WOUT = 16 * 16, I_W1 = 16 * 32, I_W2 = 16 * 16;
    constexpr int N_WIN = 2 * I_WIN, N_WBR = 6 * I_WBR, N_WOUT = 2 * I_WOUT, N_W1 = 64 * I_W1, N_W2 = 64 * I_W2;
    constexpr int NTR = N_WIN + N_WBR + N_WOUT + N_W1 + N_W2;
#pragma unroll 1
    for (int it = gw; it < NTR; it += NGW) {
        int r = it; const float* W; bf16* WT; int K, N, item, w1map = 0, ldk = 1024;
        if (r < N_WIN) { const int l = r / I_WIN; W = IN_(F, 7) + (size_t)l * 1024 * INC; K = 1024; N = INC; WT = WSP<bf16>(F, WS_WIN) + (size_t)l * INC * 1024; item = r % I_WIN; w1map = 2; }
        else if ((r -= N_WIN) < N_WBR) { const int q = r / I_WBR; W = IN_(F, 20) + (size_t)q * 512 * 1024; K = 512; N = 1024; WT = WSP<bf16>(F, WS_WBR) + (size_t)(q / 3) * 1024 * 1536 + (q % 3) * 512; ldk = 1536; item = r % I_WBR; }
        else if ((r -= N_WBR) < N_WOUT) { const int l = r / I_WOUT; W = IN_(F, 22) + (size_t)l * 1024 * 1024; K = 1024; N = 1024; WT = WSP<bf16>(F, WS_WOUT) + (size_t)l * 1024 * 1024; item = r % I_WOUT; }
        else if ((r -= N_WOUT) < N_W1) { const int q = r / I_W1; W = IN_(F, 26) + (size_t)q * 1024 * 2048; K = 1024; N = 2048; WT = WSP<bf16>(F, WS_W1) + (size_t)q * 2048 * 1024; item = r % I_W1; w1map = 1; }
        else { r -= N_W1; const int q = r / I_W2; W = IN_(F, 28) + (size_t)q * 1024 * 1024; K = 1024; N = 1024; WT = WSP<bf16>(F, WS_W2) + (size_t)q * 1024 * 1024; item = r % I_W2; }
        tr_item(W, K, N, WT, ldk, item, w1map, scr, lane);
    }
#ifndef PRO_B
#define PRO_B 1
#endif
#ifndef PRO_C
#define PRO_C 1
#endif
    __syncthreads();
    if (PRO_B) {
        float* mod = WSP<float>(F, WS_CTL + CTL_MOD);
        LAS float* sc = (LAS float*)F.lds;
        LAS float* red = sc + 1024 * 12;
        if (F.bx < 192) {
            for (int i = F.tid; i < 9 * 1024; i += NTHR) { const int r = i >> 10, k = i & 1023; const float cv = (r < 8) ? IN_(F, 1)[r * 1024 + k] : IN_(F, 3)[k]; sc[k * 12 + r] = siluf_(cv); }
            __syncthreads();
            const int it = F.bx, l = it / 96, cc = it % 96, col = cc * 64 + lane, k0 = F.wave * 128;
            const float* wm = IN_(F, 4) + (size_t)l * 1024 * 6144 + col;
            float acc[9];
#pragma unroll
            for (int r = 0; r < 9; ++r) acc[r] = 0.f;
#pragma unroll 1
            for (int kb = 0; kb < 128; kb += 16) {
                float w[16];
#pragma unroll
                for (int k = 0; k < 16; ++k) w[k] = wm[(size_t)(k0 + kb + k) * 6144];
#pragma unroll
                for (int k = 0; k < 16; ++k) { const LAS float* s = sc + (k0 + kb + k) * 12; const f32x4 s0 = *(const LAS f32x4*)s, s1 = *(const LAS f32x4*)(s + 4); const float s8 = s[8];
                    acc[0] += s0[0] * w[k]; acc[1] += s0[1] * w[k]; acc[2] += s0[2] * w[k]; acc[3] += s0[3] * w[k];
                    acc[4] += s1[0] * w[k]; acc[5] += s1[1] * w[k]; acc[6] += s1[2] * w[k]; acc[7] += s1[3] * w[k]; acc[8] += s8 * w[k]; }
            }
#pragma unroll
            for (int r = 0; r < 9; ++r) red[(F.wave * 9 + r) * 64 + lane] = acc[r];
            __syncthreads();
            for (int idx = F.tid; idx < 576; idx += NTHR) { const int r = idx >> 6, c = idx & 63; float s = 0.f;
#pragma unroll
                for (int w = 0; w < 8; ++w) s += red[(w * 9 + r) * 64 + c];
                mod[(size_t)(l * 9 + r) * 6144 + cc * 64 + c] = s + IN_(F, 5)[l * 6144 + cc * 64 + c]; }
        }
    }
    if (PRO_C) {
        float* L1P = WSP<float>(F, WS_L1P);
        LAS float* H2 = (LAS float*)F.lds + 16384;
        LAS float* red = H2 + 32 * 64;
#pragma unroll 1
        for (int it = F.bx; it < 128 + 128 + 8; it += F.G) {
            const int f = it < 128 ? 0 : (it < 256 ? 1 : 2), tb = it - (f == 0 ? 0 : (f == 1 ? 128 : 256));
            const int L = (f == 2) ? 256 : 4096, l = (f == 1) ? 1 : 0;
            const float* w1 = IN_(F, 12) + l * 33 * 64; const float* b1 = IN_(F, 13) + l * 64; const float* f1 = IN_(F, 14) + l * 64;
            const float* w2 = IN_(F, 15) + l * 64 * 64; const float* b2 = IN_(F, 16) + l * 64; const float* f2 = IN_(F, 17) + l * 64;
            const float* w3 = IN_(F, 18) + (size_t)l * 64 * 1024;
            float* HFp = (f == 2) ? WSP<float>(F, WS_HFC) : WSP<float>(F, WS_HF + (size_t)l * 16 * MiB);
            float* HBp = (f == 2) ? WSP<float>(F, WS_HFC + 512 * 1024) : WSP<float>(F, WS_HF + (size_t)l * 16 * MiB + 8 * MiB);
            __syncthreads();
#pragma unroll 1
            for (int r = 0; r < 4; ++r) {
                const int n = tb * 32 + F.wave * 4 + r;
                float zl = 0.f;
                if (lane == 0) zl = (float)n / (float)(L - 1);
                else if (lane <= 32) { const int j = (lane - 1) & 15; const float band = 1e-4f + (15.0f - 1e-4f) * (float)j / 15.0f; const float rev = (float)n * band / (float)L;
                    zl = (lane <= 16) ? cos_rev(rev) : -sin_rev(rev); }
                float a = 0.f;
#pragma unroll 1
                for (int i = 0; i < 33; ++i) a += __shfl(zl, i) * w1[i * 64 + lane];
                const float h1 = sin_rad(f1[lane] * (a + b1[lane]));
                float a2 = 0.f;
#pragma unroll 4
                for (int i = 0; i < 64; ++i) a2 += __shfl(h1, i) * w2[i * 64 + lane];
                H2[(F.wave * 4 + r) * 64 + lane] = sin_rad(f2[lane] * (a2 + b2[lane]));
            }
            __syncthreads();
            const int c1 = F.wave * 128 + lane, c2 = c1 + 64;
            float l1p[2] = {0.f, 0.f};
#pragma unroll 1
            for (int rh = 0; rh < 2; ++rh) {
                float acc[16][2];
#pragma unroll
                for (int r = 0; r < 16; ++r) { acc[r][0] = 0.f; acc[r][1] = 0.f; }
#pragma unroll 1
                for (int i = 0; i < 64; i += 4) {
                    float wa[4], wb[4];
#pragma unroll
                    for (int k = 0; k < 4; ++k) { wa[k] = w3[(i + k) * 1024 + c1]; wb[k] = w3[(i + k) * 1024 + c2]; }
#pragma unroll
                    for (int r = 0; r < 16; ++r) { const f32x4 h = *(const LAS f32x4*)(H2 + (rh * 16 + r) * 64 + i);
                        acc[r][0] += h[0] * wa[0] + h[1] * wa[1] + h[2] * wa[2] + h[3] * wa[3]; acc[r][1] += h[0] * wb[0] + h[1] * wb[1] + h[2] * wb[2] + h[3] * wb[3]; }
                }
#pragma unroll
                for (int q = 0; q < 2; ++q) {
                    const int c = q ? c2 : c1, cc = c & 511;
                    const float delta = 3.0701134573253944f + (15.350567286626973f - 3.0701134573253944f) * (float)cc / 511.0f;
                    float* dst = ((c < 512) ? HFp : HBp) + (size_t)(tb * 32 + rh * 16) * 512 + cc;
#pragma unroll
                    for (int r = 0; r < 16; ++r) { const int n = tb * 32 + rh * 16 + r; const float tn = (float)n / (float)(L - 1); const float v = acc[r][q] * __expf(-tn * delta);
                        dst[r * 512] = v;
                        if (c < 512 || n >= 1) l1p[q] += fabsf(v); }
                }
            }
            red[c1] = l1p[0]; red[c2] = l1p[1];
            __syncthreads();
            L1P[(size_t)(f * 128 + tb) * 512 + F.tid] = red[F.tid] + red[512 + F.tid];
        }
    }
}
__device__ __forceinline__ float hy_inv_l1(const Frame& F, int f, int c) {
    const float* L1P = WSP<float>(F, WS_L1P) + (size_t)f * 128 * 512 + c; const int nb = (f == 2) ? 8 : 128; float s = 0.f;
    for (int tb = 0; tb < nb; ++tb) s += L1P[(size_t)tb * 512];
    return 1.0f / s;
}

__device__ __forceinline__ void ph_norm1(Frame& F, int mode) {
    const int gw = F.bx * NWAVES + F.wave, NGW = F.G * NWAVES, lane = F.lane;
    const int nrows = (mode == 2) ? NLAT : NROWS;
    const int l = (mode == 0) ? 0 : 1;
    const bf16* Y = WSP<bf16>(F, WS_HS);
    const int* POS = WSP<int>(F, WS_POS); const float* TOPW = WSP<float>(F, WS_TOPW);
    for (int r = gw; r < nrows; r += NGW) {
        const int mr = modrow_of(r);
        f32x4 v[4];
        if (mode == 0) {
            const float* xr = (r < NLAT) ? IN_(F, 0) + (size_t)r * DM : IN_(F, 2) + (size_t)(r - NLAT) * DM;
#pragma unroll
            for (int j = 0; j < 4; ++j) v[j] = *(const f32x4*)(xr + 4 * lane + 256 * j);
        } else {
            const float* xm = WSP<float>(F, WS_XM) + (size_t)r * DM;
            const float* g2 = mod_ptr(F, 0, mr, 5);
            f32x4 s[4];
#pragma unroll
            for (int j = 0; j < 4; ++j) s[j] = (f32x4){0.f, 0.f, 0.f, 0.f};
#pragma unroll
            for (int k = 0; k < 4; ++k) {
                const int p = POS[r * 4 + k]; const float w = TOPW[r * 4 + k];
                const bf16* yr = Y + (size_t)p * DM;
#pragma unroll
                for (int j = 0; j < 4; ++j) { const u32x2 y2 = *(const u32x2*)(yr + 4 * lane + 256 * j);
                    s[j][0] += w * __uint_as_float(y2.x << 16); s[j][1] += w * __uint_as_float(y2.x & 0xffff0000u);
                    s[j][2] += w * __uint_as_float(y2.y << 16); s[j][3] += w * __uint_as_float(y2.y & 0xffff0000u); }
            }
            if (mode == 2) {   }
            const float* g2l = (mode == 2) ? mod_ptr(F, 1, mr, 5) : g2;
#pragma unroll
            for (int j = 0; j < 4; ++j) { const f32x4 x = *(const f32x4*)(xm + 4 * lane + 256 * j); const f32x4 g = *(const f32x4*)(g2l + 4 * lane + 256 * j); v[j] = x + g * s[j]; }
            if (mode == 1) { float* xo = WSP<float>(F, WS_XO) + (size_t)r * DM;
#pragma unroll
                for (int j = 0; j < 4; ++j) *(f32x4*)(xo + 4 * lane + 256 * j) = v[j]; }
        }
        float ss = 0.f;
#pragma unroll
        for (int j = 0; j < 4; ++j) ss += (v[j][0] * v[j][0] + v[j][1] * v[j][1]) + (v[j][2] * v[j][2] + v[j][3] * v[j][3]);
        const float rstd = 1.0f / sqrtf(wave_sum(ss) * (1.0f / DM) + EPS);
        if (mode == 2) {
            const float* fg = IN_(F, 30); float* o = OUT_(F) + (size_t)r * DM;
#pragma unroll
            for (int j = 0; j < 4; ++j) { const f32x4 g = *(const f32x4*)(fg + 4 * lane + 256 * j); *(f32x4*)(o + 4 * lane + 256 * j) = v[j] * rstd * g; }
        } else {
            const float* gw_ = IN_(F, 6) + l * DM; const float* sh = mod_ptr(F, l, mr, 0); const float* sc = mod_ptr(F, l, mr, 1);
            bf16* o = WSP<bf16>(F, WS_XN) + (size_t)r * DM;
#pragma unroll
            for (int j = 0; j < 4; ++j) { const f32x4 g = *(const f32x4*)(gw_ + 4 * lane + 256 * j); const f32x4 a = *(const f32x4*)(sh + 4 * lane + 256 * j); const f32x4 b = *(const f32x4*)(sc + 4 * lane + 256 * j);
                const f32x4 y = v[j] * rstd * g * (b + 1.0f) + a;
                u32x2 w2; w2.x = pk2(y[0], y[1]); w2.y = pk2(y[2], y[3]); *(u32x2*)(o + 4 * lane + 256 * j) = w2; }
        }
    }
}

struct EpiP {
    static constexpr bool PERM = true, AFTER_DRAIN = false, KMID = false;
    bf16* O;
    __device__ __forceinline__ static void st8(bf16* p, const float (&v)[8]) { u32x4 w; w.x = pk2(v[0], v[1]); w.y = pk2(v[2], v[3]); w.z = pk2(v[4], v[5]); w.w = pk2(v[6], v[7]); *(u32x4*)p = w; }
    __device__ __forceinline__ void operator()(const f32x4 (&acc)[2][2][4][2], const pg8::Unit& u, int wr, int wc, int fr, int fq) const {
        const int row0 = u.pm * 256 + wr * 64 + fr, pn = u.pn;
        const bool rot = u.pm < (NLAT / 256);
        const bool is_ret = pn < 4, is_aq = (pn == 8 || pn == 9), is_akv = (pn == 10);
        if (!(is_ret || is_aq || is_akv) || (is_akv && wc >= 2)) {
            const int colA = is_akv ? (C_AV + (wc - 2) * 32 + 8 * fq) : (pn * 256 + wc * 32 + 8 * fq), colB = is_akv ? (colA + 64) : (colA + 128);
#pragma unroll
            for (int ai = 0; ai < 2; ++ai)
#pragma unroll
                for (int m = 0; m < 4; ++m) { bf16* rowp = O + (size_t)(row0 + ai * 128 + m * 16) * INC;
                    float a[8], b[8];
#pragma unroll
                    for (int j = 0; j < 4; ++j) { a[j] = acc[ai][0][m][0][j]; a[4 + j] = acc[ai][0][m][1][j]; b[j] = acc[ai][1][m][0][j]; b[4 + j] = acc[ai][1][m][1][j]; }
                    st8(rowp + colA, a); st8(rowp + colB, b); asm volatile("" ::: "memory"); }
            return;
        }
        int col1, col2, ibase; float fexp; bool use_col = false;
        if (is_ret) { const int hd = wc >> 1; ibase = (wc & 1) * 32 + 8 * fq; col1 = pn * 256 + hd * 128 + ibase; col2 = col1 + 64; fexp = 13.287712379549449f / 63.0f; }
        else { const int rc = fq >> 1; ibase = 8 * (fq & 1); const int hb = is_aq ? (pn * 256 + wc * 64) : (C_AK + wc * 64); col1 = hb + rc * 32 + ibase; col2 = col1 + 16; fexp = 13.287712379549449f / 16.0f; use_col = rc != 0; }
        float invf[8];
#pragma unroll
        for (int k = 0; k < 8; ++k) invf[k] = __builtin_amdgcn_exp2f(-(float)(ibase + k) * fexp) * 0.15915494309189535f;
#pragma unroll
        for (int ai = 0; ai < 2; ++ai)
#pragma unroll
            for (int m = 0; m < 4; ++m) { const int row = row0 + ai * 128 + m * 16; bf16* rowp = O + (size_t)row * INC;
                const int t = row & 4095;
                const float pos = is_ret ? (float)t : (use_col ? (float)(t & 63) : (float)(t >> 6));
                float o1[8], o2[8];
#pragma unroll
                for (int k = 0; k < 8; ++k) { const float x1 = acc[ai][0][m][k >> 2][k & 3], x2 = acc[ai][1][m][k >> 2][k & 3];
                    float cs = 1.0f, sn = 0.0f;
                    if (rot) { const float rev = pos * invf[k]; cs = cos_rev(rev); sn = sin_rev(rev); }
                    o1[k] = x1 * cs - x2 * sn; o2[k] = x1 * sn + x2 * cs; }
                st8(rowp + col1, o1); st8(rowp + col2, o2); asm volatile("" ::: "memory"); }
    }
};
struct EpiMerge {
    static constexpr bool PERM = true, AFTER_DRAIN = false, KMID = true;
    const bf16* P; const float* bgate; bf16* Mo;
    __device__ __forceinline__ void den8(unsigned poff, unsigned boff, float (&d)[8]) const {
        const u32x4 g = *(const u32x4*)((const char*)P + poff);
        const f32x4 b0 = *(const f32x4*)(bgate + boff), b1 = *(const f32x4*)(bgate + boff + 4);
        const unsigned gw[4] = {g.x, g.y, g.z, g.w};
#pragma unroll
        for (int i = 0; i < 4; ++i) { const float z0 = __uint_as_float(gw[i] << 16) + (i < 2 ? b0[2 * i] : b1[2 * i - 4]), z1 = __uint_as_float(gw[i] & 0xffff0000u) + (i < 2 ? b0[2 * i + 1] : b1[2 * i - 3]);
            d[2 * i] = 1.0f + __builtin_amdgcn_exp2f(-1.4426950408889634f * z0); d[2 * i + 1] = 1.0f + __builtin_amdgcn_exp2f(-1.4426950408889634f * z1); }
    }
    __device__ __forceinline__ void kmid(int t, f32x4 (&acc)[2][2][4][2], const pg8::Unit& u, int wr, int wc, int fr, int fq) const {
        int row0 = u.pm * 256 + wr * 64 + fr; asm volatile("" : "+v"(row0));
        const unsigned col0 = (unsigned)(u.pn * 256 + wc * 32 + 8 * fq), g_old = (t == 8) ? 0u : 1u;
#pragma unroll
        for (int ai = 0; ai < 2; ++ai)
#pragma unroll
            for (int m = 0; m < 4; ++m) { const unsigned rowb = (unsigned)(row0 + ai * 128 + m * 16) * (unsigned)(INC * 2);
#pragma unroll
                for (int bj = 0; bj < 2; ++bj) { float dn[8], dd[8]; const unsigned c = col0 + bj * 128;
                    den8(rowb + (C_MG + (g_old + 1) * 1024 + c) * 2, (g_old + 1) * 1024 + c, dn); den8(rowb + (C_MG + g_old * 1024 + c) * 2, g_old * 1024 + c, dd);
#pragma unroll
                    for (int k = 0; k < 8; ++k) acc[ai][bj][m][k >> 2][k & 3] *= dn[k] * __builtin_amdgcn_rcpf(dd[k]); }
                asm volatile("" ::: "memory"); }
    }
    __device__ __forceinline__ void operator()(const f32x4 (&acc)[2][2][4][2], const pg8::Unit& u, int wr, int wc, int fr, int fq) const {
        int row0 = u.pm * 256 + wr * 64 + fr; asm volatile("" : "+v"(row0));
        const unsigned col0 = (unsigned)(u.pn * 256 + wc * 32 + 8 * fq);
#pragma unroll
        for (int ai = 0; ai < 2; ++ai)
#pragma unroll
            for (int m = 0; m < 4; ++m) { const unsigned row = (unsigned)(row0 + ai * 128 + m * 16), rowb = row * (unsigned)(INC * 2);
#pragma unroll
                for (int bj = 0; bj < 2; ++bj) { float dh[8], v[8]; const unsigned c = col0 + bj * 128; den8(rowb + (C_MG + 2 * 1024 + c) * 2, 2 * 1024 + c, dh);
#pragma unroll
                    for (int k = 0; k < 8; ++k) v[k] = acc[ai][bj][m][k >> 2][k & 3] * __builtin_amdgcn_rcpf(dh[k]);
                    u32x4 w; w.x = pk2(v[0], v[1]); w.y = pk2(v[2], v[3]); w.z = pk2(v[4], v[5]); w.w = pk2(v[6], v[7]);
                    *(u32x4*)((char*)Mo + (row * (unsigned)(DM * 2) + c * 2)) = w; }
                asm volatile("" ::: "memory"); }
    }
};
struct EpiOut {
    static constexpr bool PERM = false, AFTER_DRAIN = false, KMID = false;
    const float* xlat; const float* xctx; const float* g1base; float* XM;
    __device__ __forceinline__ void operator()(const f32x4 (&acc)[2][2][4][2], const pg8::Unit& u, int wr, int wc, int fr, int fq) const {
        const int row0 = u.pm * 256 + wr * 64 + fr, col0 = u.pn * 256 + wc * 32 + 4 * fq;
#pragma unroll
        for (int ai = 0; ai < 2; ++ai)
#pragma unroll
            for (int m = 0; m < 4; ++m) { const int row = row0 + ai * 128 + m * 16;
                const float* xr = (row < NLAT) ? xlat + (size_t)row * DM : xctx + (size_t)(row - NLAT) * DM;
                const float* g1 = g1base + (size_t)modrow_of(row) * 6 * DM;
#pragma unroll
                for (int bj = 0; bj < 2; ++bj)
#pragma unroll
                    for (int n = 0; n < 2; ++n) { const int col = col0 + bj * 128 + n * 16;
                        const f32x4 x = *(const f32x4*)(xr + col), g = *(const f32x4*)(g1 + col);
                        *(f32x4*)(XM + (size_t)row * DM + col) = x + g * acc[ai][bj][m][n]; } }
    }
};
struct EpiMoe1 {
    static constexpr bool PERM = true, AFTER_DRAIN = false, KMID = false;
    const float* b1; bf16* ACT;
    __device__ __forceinline__ void operator()(const f32x4 (&acc)[2][2][4][2], const pg8::Unit& u, int wr, int wc, int fr, int fq) const {
        const int e = u.pn >> 3, p = u.pn & 7;
        const int row0 = u.pm * 256 + wr * 64 + fr, gcol0 = p * 128 + wc * 32 + 8 * fq;
        const float* bb = b1 + (size_t)e * 2048 + gcol0;
#pragma unroll
        for (int ai = 0; ai < 2; ++ai)
#pragma unroll
            for (int m = 0; m < 4; ++m) { bf16* rowp = ACT + (size_t)(row0 + ai * 128 + m * 16) * DFF + gcol0;
                unsigned w[4];
#pragma unroll
                for (int n = 0; n < 2; ++n) { const f32x4 bg = *(const f32x4*)(bb + 4 * n), bl = *(const f32x4*)(bb + 1024 + 4 * n);
                    float a[4];
#pragma unroll
                    for (int j = 0; j < 4; ++j) { float glu = acc[ai][0][m][n][j] + bg[j]; float lin = acc[ai][1][m][n][j] + bl[j];
                        glu = fminf(glu, 7.0f); lin = fminf(fmaxf(lin, -7.0f), 7.0f);
                        a[j] = glu * __builtin_amdgcn_rcpf(1.0f + __builtin_amdgcn_exp2f(-2.4554669595930156f * glu)) * (lin + 1.0f); }
                    w[2 * n] = pk2(a[0], a[1]); w[2 * n + 1] = pk2(a[2], a[3]); }
                u32x4 wv; wv.x = w[0]; wv.y = w[1]; wv.z = w[2]; wv.w = w[3];
                *(u32x4*)rowp = wv;
                asm volatile("" ::: "memory"); }
    }
};
struct EpiMoe2 {
    static constexpr bool PERM = true, AFTER_DRAIN = false, KMID = false;
    const float* b2; bf16* Y;
    __device__ __forceinline__ void operator()(const f32x4 (&acc)[2][2][4][2], const pg8::Unit& u, int wr, int wc, int fr, int fq) const {
        const int e = u.pn >> 2, p = u.pn & 3;
        const int row0 = u.pm * 256 + wr * 64 + fr, col0 = p * 256 + wc * 32 + 8 * fq;
        f32x4 bv[2][2];
#pragma unroll
        for (int bj = 0; bj < 2; ++bj)
#pragma unroll
            for (int n = 0; n < 2; ++n) bv[bj][n] = *(const f32x4*)(b2 + (size_t)e * 1024 + col0 + bj * 128 + 4 * n);
#pragma unroll
        for (int ai = 0; ai < 2; ++ai)
#pragma unroll
            for (int m = 0; m < 4; ++m) { bf16* rowp = Y + (size_t)(row0 + ai * 128 + m * 16) * DM + col0;
#pragma unroll
                for (int bj = 0; bj < 2; ++bj) { const f32x4 v0 = acc[ai][bj][m][0] + bv[bj][0], v1 = acc[ai][bj][m][1] + bv[bj][1];
                    u32x4 w; w.x = pk2(v0[0], v0[1]); w.y = pk2(v0[2], v0[3]); w.z = pk2(v1[0], v1[1]); w.w = pk2(v1[2], v1[3]);
                    *(u32x4*)(rowp + bj * 128) = w; } }
    }
};
struct MoeOrder {
    const LAS int* list; int n;
    __device__ __forceinline__ bool next(int i, pg8::Unit& u) const { if (i >= n) return false; u.pm = __builtin_amdgcn_readfirstlane(list[2 * i]); u.pn = __builtin_amdgcn_readfirstlane(list[2 * i + 1]); return true; }
    __device__ __forceinline__ void a_ready(const pg8::Unit&) const {}
    __device__ __forceinline__ void done(const pg8::Unit&) const {}
};
__device__ __forceinline__ int moe_list_units(Frame& F, int nN, LAS int* list) {
    const int* tl = WSP<int>(F, WS_TILES);
    const int T = __builtin_amdgcn_readfirstlane(tl[32]), total = T * nN;
    int n = 0;
#pragma unroll 1
    for (int i = 0;; ++i) {
        const int Lu = i * F.G + F.bx; if (Lu >= total) break;
        const int pm = Lu / nN, pnl = Lu % nN;
        int e = 0;
#pragma unroll 1
        for (int q = 1; q < 32; ++q) { const int tq = __builtin_amdgcn_readfirstlane(tl[q]); if (tq <= pm) e = q; }
        if (F.tid == 0) { list[2 * i] = pm; list[2 * i + 1] = e * nN + pnl; }
        n = i + 1;
    }
    __syncthreads();
    return n;
}

__device__ __forceinline__ void ph_rope(Frame& F) {
    bf16* P = WSP<bf16>(F, WS_P);
    const size_t total = (size_t)NLAT * 832, stride = (size_t)F.G * NTHR;
    for (size_t idx = (size_t)F.bx * NTHR + F.tid; idx < total; idx += stride) {
        const int row = (int)(idx / 832), pi = (int)(idx % 832), t = row & 4095;
        int c1, c2; float rev;
        if (pi < 512) {
            const int qk = pi >> 8, h = (pi >> 6) & 3, i = pi & 63;
            c1 = (qk ? C_RK : C_RQ) + h * 128 + i; c2 = c1 + 64;
            const float invf = __expf(-(float)i * (9.210340371976184f / 63.0f));
            rev = (float)t * invf * 0.15915494309189535f;
        } else {
            const int pj = pi - 512, hh = pj >> 5, w = pj & 31, half = w >> 4, i = w & 15;
            const int base = (hh < 8) ? (C_AQ + hh * 64) : (C_AK + (hh - 8) * 64);
            c1 = base + half * 32 + i; c2 = c1 + 16;
            const float invf = __expf(-(float)i * (9.210340371976184f / 16.0f));
            const float pos = half ? (float)(t & 63) : (float)(t >> 6);
            rev = pos * invf * 0.15915494309189535f;
        }
        const float cs = cos_rev(rev), sn = sin_rev(rev);
        bf16* pr = P + (size_t)row * INC;
        const float x1 = bf2f(pr[c1]), x2 = bf2f(pr[c2]);
        pr[c1] = f2bf(x1 * cs - x2 * sn); pr[c2] = f2bf(x1 * sn + x2 * cs);
    }
}

__device__ __forceinline__ void attn_naive_item(Frame& F, int l, int item) {
    const bf16* P = WSP<bf16>(F, WS_P);
    LAS float* Ks = (LAS float*)F.lds; LAS float* Vs = Ks + 64 * 64;
    const bool isctx = item >= 512;
    int b, kvh, qb;
    if (!isctx) { b = item >> 6; kvh = (item >> 5) & 1; qb = item & 31; } else { const int it = item - 512; b = it >> 2; kvh = (it >> 1) & 1; qb = it & 1; }
    const int qi = F.tid & 127, g = F.tid >> 7, h = kvh * 4 + g;
    const int qpos = qb * 128 + qi;
    const int rowq = isctx ? (NLAT + b * CTXL + qpos) : (b * SEQ + qpos);
    float q[64], o[64];
    { const bf16* qp = P + (size_t)rowq * INC + C_AQ + h * 64;
#pragma unroll
      for (int d = 0; d < 64; ++d) { q[d] = bf2f(qp[d]) * 0.125f; o[d] = 0.f; } }
    const float sink = IN_(F, 9)[l * 8 + h];
    float mrun = sink, lsum = 1.0f;
    const int nkc = isctx ? 4 : 10, start = qb * 128;
    for (int kc = 0; kc < nkc; ++kc) {
        __syncthreads();
        { const int key = F.tid >> 3, d0 = (F.tid & 7) * 8;
          const bool ctxchunk = isctx || kc >= 6;
          int row = -1;
          if (ctxchunk) row = NLAT + b * CTXL + (isctx ? kc : kc - 6) * 64 + key;
          else { const int kpos = start - 128 + kc * 64 + key; if (kpos >= 0 && kpos < SEQ) row = b * SEQ + kpos; }
          u32x4 kk = (u32x4){0u, 0u, 0u, 0u}, vv = kk;
          if (row >= 0) { kk = *(const u32x4*)(P + (size_t)row * INC + C_AK + kvh * 64 + d0); vv = *(const u32x4*)(P + (size_t)row * INC + C_AV + kvh * 64 + d0); }
          LAS float* kd = Ks + key * 64 + d0; LAS float* vd = Vs + key * 64 + d0;
          kd[0] = __uint_as_float(kk.x << 16); kd[1] = __uint_as_float(kk.x & 0xffff0000u); kd[2] = __uint_as_float(kk.y << 16); kd[3] = __uint_as_float(kk.y & 0xffff0000u);
          kd[4] = __uint_as_float(kk.z << 16); kd[5] = __uint_as_float(kk.z & 0xffff0000u); kd[6] = __uint_as_float(kk.w << 16); kd[7] = __uint_as_float(kk.w & 0xffff0000u);
          vd[0] = __uint_as_float(vv.x << 16); vd[1] = __uint_as_float(vv.x & 0xffff0000u); vd[2] = __uint_as_float(vv.y << 16); vd[3] = __uint_as_float(vv.y & 0xffff0000u);
          vd[4] = __uint_as_float(vv.z << 16); vd[5] = __uint_as_float(vv.z & 0xffff0000u); vd[6] = __uint_as_float(vv.w << 16); vd[7] = __uint_as_float(vv.w & 0xffff0000u); }
        __syncthreads();
        const bool ctxchunk = isctx || kc >= 6;
        for (int key = 0; key < 64; ++key) {
            bool valid = true;
            if (!ctxchunk) { const int kpos = start - 128 + kc * 64 + key; const int dd = qpos - kpos; valid = (kpos >= 0) && (kpos < SEQ) && (dd <= 128) && (dd >= -128); }
            float s = 0.f;
#pragma unroll
            for (int d = 0; d < 64; ++d) s += q[d] * Ks[key * 64 + d];
            if (valid) {
                const float mnew = fmaxf(mrun, s), sc = __expf(mrun - mnew), p = __expf(s - mnew);
                lsum = lsum * sc + p; mrun = mnew;
#pragma unroll
                for (int d = 0; d < 64; ++d) o[d] = o[d] * sc + p * Vs[key * 64 + d];
            }
        }
    }
    const float inv = 1.0f / lsum;
    bf16* op = WSP<bf16>(F, WS_ATT) + (size_t)rowq * 512 + h * 64;
#pragma unroll
    for (int d = 0; d < 64; d += 2) *(unsigned*)(op + d) = pk2(o[d] * inv, o[d + 1] * inv);
}

__device__ __forceinline__ void ret_naive_item(Frame& F, int l, int item) {
    const bf16* P = WSP<bf16>(F, WS_P);
    LAS float* Ks = (LAS float*)F.lds; LAS float* Vs = Ks + 32 * 128; LAS float* red = Vs + 32 * 128;
    const bool isctx = item >= 1024;
    int b, h, qb;
    if (!isctx) { b = item >> 7; h = (item >> 5) & 3; qb = item & 31; } else { const int it = item - 1024; b = it >> 3; h = (it >> 1) & 3; qb = it & 1; }
    const int quarter = F.wave >> 1, qi = (F.wave & 1) * 64 + F.lane;
    const int n = qb * 128 + qi;
    const int rowq = isctx ? (NLAT + b * CTXL + n) : (b * SEQ + n);
    const float LOG2E = 1.4426950408889634f;
    const float lgf = log_sigmoid_(IN_(F, 8)[l * 8 + h]) * LOG2E, lgb = log_sigmoid_(IN_(F, 8)[l * 8 + 4 + h]) * LOG2E;
    float q[128], y[32];
    { const bf16* qp = P + (size_t)rowq * INC + C_RQ + h * 128;
#pragma unroll
      for (int d = 0; d < 128; ++d) q[d] = bf2f(qp[d]); }
#pragma unroll
    for (int e = 0; e < 32; ++e) y[e] = 0.f;
    const int nch = isctx ? 8 : 136;
    for (int kc = 0; kc < nch; ++kc) {
        __syncthreads();
        const bool ctxchunk = isctx || kc >= 128;
        const int krow0 = ctxchunk ? (NLAT + b * CTXL + (isctx ? kc : kc - 128) * 32) : (b * SEQ + kc * 32);
        { const int key = F.tid >> 4, d0 = (F.tid & 15) * 8;
          const u32x4 kk = *(const u32x4*)(P + (size_t)(krow0 + key) * INC + C_RK + h * 128 + d0), vv = *(const u32x4*)(P + (size_t)(krow0 + key) * INC + C_RV + h * 128 + d0);
          LAS float* kd = Ks + key * 128 + d0; LAS float* vd = Vs + key * 128 + d0;
          kd[0] = __uint_as_float(kk.x << 16); kd[1] = __uint_as_float(kk.x & 0xffff0000u); kd[2] = __uint_as_float(kk.y << 16); kd[3] = __uint_as_float(kk.y & 0xffff0000u);
          kd[4] = __uint_as_float(kk.z << 16); kd[5] = __uint_as_float(kk.z & 0xffff0000u); kd[6] = __uint_as_float(kk.w << 16); kd[7] = __uint_as_float(kk.w & 0xffff0000u);
          vd[0] = __uint_as_float(vv.x << 16); vd[1] = __uint_as_float(vv.x & 0xffff0000u); vd[2] = __uint_as_float(vv.y << 16); vd[3] = __uint_as_float(vv.y & 0xffff0000u);
          vd[4] = __uint_as_float(vv.z << 16); vd[5] = __uint_as_float(vv.z & 0xffff0000u); vd[6] = __uint_as_float(vv.w << 16); vd[7] = __uint_as_float(vv.w & 0xffff0000u); }
        __syncthreads();
        for (int key = 0; key < 32; ++key) {
            float w;
            if (!ctxchunk) { const int m = kc * 32 + key; const int dd = n - m; w = (dd >= 0) ? __builtin_amdgcn_exp2f(lgf * (float)dd) : __builtin_amdgcn_exp2f(lgb * (float)(-dd)); }
            else if (!isctx) { const int j = (kc - 128) * 32 + key; w = __builtin_amdgcn_exp2f(lgf * (float)(n + CTXL - j)) + __builtin_amdgcn_exp2f(lgb * (float)(SEQ - n + j)); }
            else { const int j = kc * 32 + key; const int dd = n - j; w = (dd >= 0) ? __builtin_amdgcn_exp2f(lgf * (float)dd) : __builtin_amdgcn_exp2f(lgb * (float)(-dd)); }
            float s = 0.f;
#pragma unroll
            for (int d = 0; d < 128; ++d) s += q[d] * Ks[key * 128 + d];
            s *= w;
#pragma unroll
            for (int e = 0; e < 32; ++e) y[e] += s * Vs[key * 128 + quarter * 32 + e];
        }
    }
    const float ksc = 0.08838834764831845f;
    float ss = 0.f;
#pragma unroll
    for (int e = 0; e < 32; ++e) { y[e] *= ksc; ss += y[e] * y[e]; }
    __syncthreads();
    red[qi * 4 + quarter] = ss;
    __syncthreads();
    const float tot = (red[qi * 4 + 0] + red[qi * 4 + 1]) + (red[qi * 4 + 2] + red[qi * 4 + 3]);
    const float rs = 1.0f / sqrtf(tot * (1.0f / 128.0f) + EPS);
    const bf16* gp = P + (size_t)rowq * INC + C_RG + h * 128 + quarter * 32;
    bf16* op = WSP<bf16>(F, WS_RET) + (size_t)rowq * 512 + h * 128 + quarter * 32;
#pragma unroll
    for (int e = 0; e < 32; e += 2) *(unsigned*)(op + e) = pk2(y[e] * rs * siluf_(bf2f(gp[e])), y[e + 1] * rs * siluf_(bf2f(gp[e + 1])));
}

__device__ __forceinline__ float hy_sconv(const bf16* P, const float* cw, const float* cb, int base, int t, int L, int ch) {
    float a = cb[ch] + bf2f(P[(size_t)(base + t) * INC + C_HU + ch]) * cw[1536 + ch];
    if (t > 0) a += bf2f(P[(size_t)(base + t - 1) * INC + C_HU + ch]) * cw[ch];
    if (t + 1 < L) a += bf2f(P[(size_t)(base + t + 1) * INC + C_HU + ch]) * cw[2 * 1536 + ch];
    return a;
}
__device__ __forceinline__ void ph_hyprep(Frame& F, int l, bool do_ctx) {
    const bf16* P = WSP<bf16>(F, WS_P);
    const float* cw = IN_(F, 10) + l * 3 * 1536; const float* cb = IN_(F, 11) + l * 1536;
    float* ZT = WSP<float>(F, WS_ZT); float* ZTC = WSP<float>(F, WS_ZTC);
    const size_t total = (size_t)(do_ctx ? NROWS : NLAT) * 512, stride = (size_t)F.G * NTHR;
    for (size_t idx = (size_t)F.bx * NTHR + F.tid; idx < total; idx += stride) {
        const int row = (int)(idx >> 9), c = (int)(idx & 511);
        if (row < NLAT) { const int b = row >> 12, t = row & 4095;
            const float x1 = hy_sconv(P, cw, cb, b * SEQ, t, SEQ, 512 + c), v = hy_sconv(P, cw, cb, b * SEQ, t, SEQ, 1024 + c);
            ZT[((size_t)c * NB + b) * SEQ + t] = x1 * v;
        } else { const int j = row - NLAT, b = j >> 8, t = j & 255;
            const float x1 = hy_sconv(P, cw, cb, NLAT + b * CTXL, t, CTXL, 512 + c), v = hy_sconv(P, cw, cb, NLAT + b * CTXL, t, CTXL, 1024 + c);
            ZTC[((size_t)c * NB + b) * CTXL + t] = x1 * v;
        }
    }
}
__device__ __forceinline__ void hyconv_naive_item(Frame& F, int l, int item) {
    const int c = item >> 1, bh = item & 1;
    LAS float* Kc = (LAS float*)F.lds;
    LAS float* Zs = Kc + 8192;
    const float* HFp = WSP<float>(F, WS_HF + (size_t)l * 16 * MiB); const float* HBp = WSP<float>(F, WS_HF + (size_t)l * 16 * MiB + 8 * MiB);
    const float il1 = hy_inv_l1(F, l, c);
    const float* ZT = WSP<float>(F, WS_ZT) + ((size_t)c * NB + bh * 4) * SEQ;
    __syncthreads();
    for (int i = F.tid; i < 8191; i += NTHR) { const int d = i - 4095; Kc[i] = (d >= 0 ? HFp[(size_t)d * 512 + c] : HBp[(size_t)(-d) * 512 + c]) * il1; }
    for (int i = F.tid; i < 4 * SEQ; i += NTHR) { const int bb = i >> 12, s = i & 4095; Zs[s * 4 + bb] = ZT[i]; }
    __syncthreads();
    float acc[8][4];
#pragma unroll
    for (int i = 0; i < 8; ++i)
#pragma unroll
        for (int bb = 0; bb < 4; ++bb) acc[i][bb] = 0.f;
    for (int s = 0; s < SEQ; ++s) {
        const f32x4 z = *(const LAS f32x4*)(Zs + s * 4);
#pragma unroll
        for (int i = 0; i < 8; ++i) { const float k = Kc[F.tid + 512 * i - s + 4095];
#pragma unroll
            for (int bb = 0; bb < 4; ++bb) acc[i][bb] += k * z[bb]; }
    }
    float* YT = WSP<float>(F, WS_YT) + ((size_t)c * NB + bh * 4) * SEQ;
#pragma unroll
    for (int i = 0; i < 8; ++i)
#pragma unroll
        for (int bb = 0; bb < 4; ++bb) YT[(size_t)bb * SEQ + F.tid + 512 * i] = acc[i][bb];
}
__device__ __forceinline__ void hyconv_ctx_item(Frame& F, int c) {
    const float* HFp = WSP<float>(F, WS_HFC); const float* HBp = WSP<float>(F, WS_HFC + 512 * 1024);
    const float il1 = hy_inv_l1(F, 2, c);
    const float* Z = WSP<float>(F, WS_ZTC) + (size_t)c * NB * CTXL; float* Yo = WSP<float>(F, WS_YTC) + (size_t)c * NB * CTXL;
#pragma unroll
    for (int i = 0; i < 4; ++i) {
        const int o = F.tid * 4 + i, b = o >> 8, t = o & 255;
        float a = 0.f;
        for (int s = 0; s < CTXL; ++s) { const int d = t - s; const float k = (d >= 0) ? HFp[(size_t)d * 512 + c] : HBp[(size_t)(-d) * 512 + c]; a += k * Z[b * CTXL + s]; }
        Yo[o] = a * il1;
    }
}
__device__ __forceinline__ void ph_hypost(Frame& F, int l, bool do_ctx) {
    const bf16* P = WSP<bf16>(F, WS_P);
    const float* cw = IN_(F, 10) + l * 3 * 1536; const float* cb = IN_(F, 11) + l * 1536; const float* skip = IN_(F, 19) + l * 512;
    const float* YT = WSP<float>(F, WS_YT); const float* YTC = WSP<float>(F, WS_YTC);
    bf16* HY = WSP<bf16>(F, WS_HY);
    const size_t total = (size_t)(do_ctx ? NROWS : NLAT) * 512, stride = (size_t)F.G * NTHR;
    for (size_t idx = (size_t)F.bx * NTHR + F.tid; idx < total; idx += stride) {
        const int row = (int)(idx >> 9), c = (int)(idx & 511);
        int base, t, L; float y;
        if (row < NLAT) { const int b = row >> 12; t = row & 4095; base = b * SEQ; L = SEQ; y = YT[((size_t)c * NB + b) * SEQ + t]; }
        else { const int j = row - NLAT, b = j >> 8; t = j & 255; base = NLAT + b * CTXL; L = CTXL; y = YTC[((size_t)c * NB + b) * CTXL + t]; }
        const float x0 = hy_sconv(P, cw, cb, base, t, L, c), x1 = hy_sconv(P, cw, cb, base, t, L, 512 + c), v = hy_sconv(P, cw, cb, base, t, L, 1024 + c);
        const float z = x1 * v;
        HY[(size_t)row * 512 + c] = f2bf(x0 * (y + skip[c] * z));
    }
}

typedef short bf16x8 __attribute__((ext_vector_type(8)));
typedef short bf16x4 __attribute__((ext_vector_type(4)));
constexpr int RLD = 136;
constexpr int RTILE = 128 * RLD * 2;
__device__ __forceinline__ bf16x8 lds_frag16(const LAS bf16* tile, int row0, int k0, int lane) {
    return *(const LAS bf16x8*)(tile + (row0 + (lane & 15)) * RLD + k0 + 8 * (lane >> 4));
}
__device__ __forceinline__ void ret_unit_decode(int u, int& bh, int& ci, int& rowbase) {
    bh = u / 34; ci = u - bh * 34; const int b = bh >> 2;
    rowbase = (ci < 2) ? (NLAT + b * CTXL + ci * 128) : (b * SEQ + (ci - 2) * 128);
}
__device__ __forceinline__ void ret_load_tile(LAS bf16* tile, const bf16* g, size_t gp, int tid) {
    const int r = tid >> 2, seg = tid & 3;
#pragma unroll
    for (int q = 0; q < 4; ++q) *(LAS u32x4*)(tile + r * RLD + seg * 32 + q * 8) = *(const u32x4*)(g + (size_t)r * gp + seg * 32 + q * 8);
}
__device__ __forceinline__ void ret_kv_unit(Frame& F, int l, int u) {
    const bf16* P = WSP<bf16>(F, WS_P);
    LAS bf16* Ktf = (LAS bf16*)F.lds; LAS bf16* Ktb = Ktf + 128 * RLD; LAS bf16* Vt = Ktb + 128 * RLD;
    int bh, ci, rowbase; ret_unit_decode(u, bh, ci, rowbase);
    const int h = bh & 3, tid = F.tid, lane = F.lane, w = F.wave;
    const float LOG2E = 1.4426950408889634f;
    const float lgf = log_sigmoid_(IN_(F, 8)[l * 8 + h]) * LOG2E, lgb = log_sigmoid_(IN_(F, 8)[l * 8 + 4 + h]) * LOG2E;
    __syncthreads();
    { const int j = tid >> 2, seg = tid & 3;
      const float wf = __builtin_amdgcn_exp2f(lgf * (float)(127 - j)), wb = __builtin_amdgcn_exp2f(lgb * (float)j);
      const bf16* kp = P + (size_t)(rowbase + j) * INC + C_RK + h * 128 + seg * 32; const bf16* vp = P + (size_t)(rowbase + j) * INC + C_RV + h * 128 + seg * 32;
#pragma unroll
      for (int q = 0; q < 4; ++q) { const u32x4 kk = *(const u32x4*)(kp + q * 8), vv = *(const u32x4*)(vp + q * 8);
          const unsigned kw[4] = {kk.x, kk.y, kk.z, kk.w}, vw[4] = {vv.x, vv.y, vv.z, vv.w};
#pragma unroll
          for (int i = 0; i < 4; ++i) { const int d = seg * 32 + q * 8 + 2 * i;
              const float k0 = __uint_as_float(kw[i] << 16), k1 = __uint_as_float(kw[i] & 0xffff0000u);
              Ktf[d * RLD + j] = f2bf(k0 * wf); Ktf[(d + 1) * RLD + j] = f2bf(k1 * wf);
              Ktb[d * RLD + j] = f2bf(k0 * wb); Ktb[(d + 1) * RLD + j] = f2bf(k1 * wb);
              Vt[d * RLD + j] = (bf16)(vw[i] & 0xffffu); Vt[(d + 1) * RLD + j] = (bf16)(vw[i] >> 16); } } }
    __syncthreads();
    bf16x8 af[4], ab[4];
#pragma unroll
    for (int ks = 0; ks < 4; ++ks) { af[ks] = lds_frag16(Ktf, 16 * w, 32 * ks, lane); ab[ks] = lds_frag16(Ktb, 16 * w, 32 * ks, lane); }
    float* KV = WSP<float>(F, WS_KV) + ((size_t)(bh * 34 + ci) * 2) * 16384;
    const int d0 = 16 * w + 4 * (lane >> 4);
#pragma unroll 2
    for (int et = 0; et < 8; ++et) {
        f32x4 cf = (f32x4){0.f, 0.f, 0.f, 0.f}, cb = cf;
#pragma unroll
        for (int ks = 0; ks < 4; ++ks) { const bf16x8 bv = lds_frag16(Vt, 16 * et, 32 * ks, lane);
            cf = __builtin_amdgcn_mfma_f32_16x16x32_bf16(af[ks], bv, cf, 0, 0, 0); cb = __builtin_amdgcn_mfma_f32_16x16x32_bf16(ab[ks], bv, cb, 0, 0, 0); }
        const int e = 16 * et + (lane & 15);
        *(f32x4*)(KV + (size_t)e * 128 + d0) = cf; *(f32x4*)(KV + 16384 + (size_t)e * 128 + d0) = cb;
    }
}
__device__ __forceinline__ void ret_scan(Frame& F, int l) {
    const float* KV = WSP<float>(F, WS_KV); bf16* SP = WSP<bf16>(F, WS_SP);
    const float LOG2E = 1.4426950408889634f;
    const int total = 64 * 4096, stride = F.G * NTHR;
#pragma unroll 1
    for (int idx = F.bx * NTHR + F.tid; idx < total; idx += stride) {
        const int bhd = idx >> 12, elem = (idx & 4095) * 4, bh = bhd >> 1, dir = bhd & 1, h = bh & 3;
        const float cd = __builtin_amdgcn_exp2f(log_sigmoid_(IN_(F, 8)[l * 8 + dir * 4 + h]) * LOG2E * 128.0f);
        const size_t base = ((size_t)bh * 34 * 2 + dir) * 16384 + elem;
        f32x4 s = (f32x4){0.f, 0.f, 0.f, 0.f};
#pragma unroll 1
        for (int half = 0; half < 2; ++half) {
            f32x4 kv[17];
#pragma unroll
            for (int k = 0; k < 17; ++k) { const int st = half * 17 + k; const int ci = dir == 0 ? st : (st == 0 ? 1 : (st == 1 ? 0 : 35 - st)); kv[k] = *(const f32x4*)(KV + base + (size_t)ci * 2 * 16384); }
#pragma unroll
            for (int k = 0; k < 17; ++k) { const int st = half * 17 + k; const int ci = dir == 0 ? st : (st == 0 ? 1 : (st == 1 ? 0 : 35 - st));
                u32x2 o; o.x = pk2(s[0], s[1]); o.y = pk2(s[2], s[3]); *(u32x2*)(SP + base + (size_t)ci * 2 * 16384) = o;
                s = s * cd + kv[k]; }
        }
    }
}
__device__ __forceinline__ void ret_out_unit(Frame& F, int l, int u) {
    const bf16* P = WSP<bf16>(F, WS_P);
    LAS bf16* Qs = (LAS bf16*)F.lds; LAS bf16* Ks = Qs + 128 * RLD; LAS bf16* Vt = Ks + 128 * RLD; LAS bf16* Ps = Vt + 128 * RLD;
    int bh, ci, rowbase; ret_unit_decode(u, bh, ci, rowbase);
    const int h = bh & 3, tid = F.tid, lane = F.lane, w = F.wave;
    const float LOG2E = 1.4426950408889634f;
    const float lgf = log_sigmoid_(IN_(F, 8)[l * 8 + h]) * LOG2E, lgb = log_sigmoid_(IN_(F, 8)[l * 8 + 4 + h]) * LOG2E;
    __syncthreads();
    ret_load_tile(Qs, P + (size_t)rowbase * INC + C_RQ + h * 128, INC, tid);
    ret_load_tile(Ks, P + (size_t)rowbase * INC + C_RK + h * 128, INC, tid);
    { const int j = tid >> 2, seg = tid & 3; const bf16* vp = P + (size_t)(rowbase + j) * INC + C_RV + h * 128 + seg * 32;
#pragma unroll
      for (int q = 0; q < 4; ++q) { const u32x4 vv = *(const u32x4*)(vp + q * 8); const unsigned vw[4] = {vv.x, vv.y, vv.z, vv.w};
#pragma unroll
          for (int i = 0; i < 4; ++i) { const int d = seg * 32 + q * 8 + 2 * i; Vt[d * RLD + j] = (bf16)(vw[i] & 0xffffu); Vt[(d + 1) * RLD + j] = (bf16)(vw[i] >> 16); } } }
    __syncthreads();
    const int icol = 16 * w + (lane & 15);
    bf16x8 bq[4];
#pragma unroll
    for (int ks = 0; ks < 4; ++ks) bq[ks] = lds_frag16(Qs, 16 * w, 32 * ks, lane);
#pragma unroll 2
    for (int jt = 0; jt < 8; ++jt) {
        f32x4 c = (f32x4){0.f, 0.f, 0.f, 0.f};
#pragma unroll
        for (int ks = 0; ks < 4; ++ks) c = __builtin_amdgcn_mfma_f32_16x16x32_bf16(lds_frag16(Ks, 16 * jt, 32 * ks, lane), bq[ks], c, 0, 0, 0);
        const int j0 = 16 * jt + 4 * (lane >> 4);
        float pv[4];
#pragma unroll
        for (int r = 0; r < 4; ++r) { const int dd = icol - (j0 + r); const float dec = dd >= 0 ? __builtin_amdgcn_exp2f(lgf * (float)dd) : __builtin_amdgcn_exp2f(lgb * (float)(-dd)); pv[r] = c[r] * dec; }
        u32x2 pw; pw.x = pk2(pv[0], pv[1]); pw.y = pk2(pv[2], pv[3]);
        *(LAS u32x2*)(Ps + icol * RLD + j0) = pw;
    }
    LDS_WAIT(); asm volatile("" ::: "memory");
    f32x4 acc[8];
    {
        bf16x8 bp[4];
#pragma unroll
        for (int ks = 0; ks < 4; ++ks) bp[ks] = lds_frag16(Ps, 16 * w, 32 * ks, lane);
#pragma unroll
        for (int et = 0; et < 8; ++et) { f32x4 c = (f32x4){0.f, 0.f, 0.f, 0.f};
#pragma unroll
            for (int ks = 0; ks < 4; ++ks) c = __builtin_amdgcn_mfma_f32_16x16x32_bf16(lds_frag16(Vt, 16 * et, 32 * ks, lane), bp[ks], c, 0, 0, 0);
            acc[et] = c; }
    }
    const bf16* SPg = WSP<bf16>(F, WS_SP) + ((size_t)(bh * 34 + ci) * 2) * 16384;
#pragma unroll 1
    for (int dir = 0; dir < 2; ++dir) {
        const bool zero = (dir == 0) ? (ci == 0) : (ci == 1);
        __syncthreads();
        if (!zero) ret_load_tile(Ks, SPg + (size_t)dir * 16384, 128, tid);
        __syncthreads();
        if (!zero) {
            const float sc = (dir == 0) ? __builtin_amdgcn_exp2f(lgf * (float)((icol & 127) + 1)) : __builtin_amdgcn_exp2f(lgb * (float)(128 - (icol & 127)));
#pragma unroll
            for (int et = 0; et < 8; ++et) { f32x4 c = (f32x4){0.f, 0.f, 0.f, 0.f};
#pragma unroll
                for (int ks = 0; ks < 4; ++ks) c = __builtin_amdgcn_mfma_f32_16x16x32_bf16(lds_frag16(Ks, 16 * et, 32 * ks, lane), bq[ks], c, 0, 0, 0);
                acc[et] = acc[et] + c * sc; }
        }
    }
    const float ksc = 0.08838834764831845f;
    float ss = 0.f;
#pragma unroll
    for (int et = 0; et < 8; ++et) { acc[et] = acc[et] * ksc; ss += (acc[et][0] * acc[et][0] + acc[et][1] * acc[et][1]) + (acc[et][2] * acc[et][2] + acc[et][3] * acc[et][3]); }
    ss += __shfl_xor(ss, 16); ss += __shfl_xor(ss, 32);
    const float rs = 1.0f / sqrtf(ss * (1.0f / 128.0f) + EPS);
    const size_t row = (size_t)(rowbase + icol);
    const bf16* gp = P + row * INC + C_RG + h * 128; bf16* op = WSP<bf16>(F, WS_RET) + row * 1536 + h * 128;
#pragma unroll
    for (int et = 0; et < 8; ++et) { const int e0 = 16 * et + 4 * (lane >> 4);
        const u32x2 g2 = *(const u32x2*)(gp + e0);
        const float g0 = __uint_as_float(g2.x << 16), g1 = __uint_as_float(g2.x & 0xffff0000u), g2f = __uint_as_float(g2.y << 16), g3 = __uint_as_float(g2.y & 0xffff0000u);
        u32x2 o; o.x = pk2(acc[et][0] * rs * siluf_(g0), acc[et][1] * rs * siluf_(g1)); o.y = pk2(acc[et][2] * rs * siluf_(g2f), acc[et][3] * rs * siluf_(g3));
        *(u32x2*)(op + e0) = o; }
}

typedef float f32x2 __attribute__((ext_vector_type(2)));
__device__ __forceinline__ f32x2 cmul_(f32x2 a, f32x2 b) { return (f32x2){a.x * b.x - a.y * b.y, a.x * b.y + a.y * b.x}; }
__device__ __forceinline__ f32x2 cmulc_(f32x2 a, f32x2 b) { return (f32x2){a.x * b.x + a.y * b.y, a.y * b.x - a.x * b.y}; }
__device__ __forceinline__ f32x2 twid_(float rev) { return (f32x2){cos_rev(rev), -sin_rev(rev)}; }
__device__ __forceinline__ int fpad(int n) { return n + (n >> 3); }
template <int R> __device__ __forceinline__ void fft_twiddles(f32x2 (&tw)[R - 1], int t, int s, int M) {
    int o = 0, u = 0;
#pragma unroll
    for (int half = R / 2; half >= 1; half >>= 1) {
        const float invMu = 1.0f / (float)(M >> u);
#pragma unroll
        for (int qq = 0; qq < half; ++qq) tw[o + qq] = twid_((float)(t + qq * s) * invMu);
        o += half; ++u;
    }
}
template <int R, int HALF, int OFF> __device__ __forceinline__ void fft_sub_fwd(f32x2 (&v)[R], const f32x2 (&tw)[R - 1]) {
#pragma unroll
    for (int qq = 0; qq < HALF; ++qq) {
        const f32x2 w = tw[OFF + qq];
#pragma unroll
        for (int g0 = 0; g0 < R; g0 += 2 * HALF) { const f32x2 a = v[g0 + qq], b = v[g0 + qq + HALF]; v[g0 + qq] = a + b; v[g0 + qq + HALF] = cmul_(a - b, w); }
    }
}
template <int R, int HALF, int OFF> __device__ __forceinline__ void fft_sub_inv(f32x2 (&v)[R], const f32x2 (&tw)[R - 1]) {
#pragma unroll
    for (int qq = 0; qq < HALF; ++qq) {
        const f32x2 w = tw[OFF + qq];
#pragma unroll
        for (int g0 = 0; g0 < R; g0 += 2 * HALF) { const f32x2 A = v[g0 + qq], Bp = cmulc_(v[g0 + qq + HALF], w); v[g0 + qq] = A + Bp; v[g0 + qq + HALF] = A - Bp; }
    }
}
template <int R> __device__ __forceinline__ void fft_bf_fwd(f32x2 (&v)[R], const f32x2 (&tw)[R - 1]) {
    if constexpr (R == 16) { fft_sub_fwd<16, 8, 0>(v, tw); fft_sub_fwd<16, 4, 8>(v, tw); fft_sub_fwd<16, 2, 12>(v, tw); fft_sub_fwd<16, 1, 14>(v, tw); }
    else { fft_sub_fwd<8, 4, 0>(v, tw); fft_sub_fwd<8, 2, 4>(v, tw); fft_sub_fwd<8, 1, 6>(v, tw); }
}
template <int R> __device__ __forceinline__ void fft_bf_inv(f32x2 (&v)[R], const f32x2 (&tw)[R - 1]) {
    if constexpr (R == 16) { fft_sub_inv<16, 1, 14>(v, tw); fft_sub_inv<16, 2, 12>(v, tw); fft_sub_inv<16, 4, 8>(v, tw); fft_sub_inv<16, 8, 0>(v, tw); }
    else { fft_sub_inv<8, 1, 6>(v, tw); fft_sub_inv<8, 2, 4>(v, tw); fft_sub_inv<8, 4, 0>(v, tw); }
}
__device__ __forceinline__ void fft_tw_last(f32x2 (&tw)[7]) {
    const float h = 0.70710678118654752f;
    tw[0] = (f32x2){1.f, 0.f}; tw[1] = (f32x2){h, -h}; tw[2] = (f32x2){0.f, -1.f}; tw[3] = (f32x2){-h, -h};
    tw[4] = (f32x2){1.f, 0.f}; tw[5] = (f32x2){0.f, -1.f}; tw[6] = (f32x2){1.f, 0.f};
}
struct FftTw { f32x2 t1[15]; f32x2 t2[2][7]; f32x2 t3[2][7]; };
__device__ __forceinline__ void fft_tw_init(FftTw& T, int tid) {
    fft_twiddles<16>(T.t1, tid, 512, 8192);
#pragma unroll
    for (int it = 0; it < 2; ++it) { const int uu = tid + 512 * it; fft_twiddles<8>(T.t2[it], uu & 63, 64, 512); fft_twiddles<8>(T.t3[it], uu & 7, 8, 64); }
}
template <bool INV, int M> __device__ __forceinline__ void fft_pass8(LAS f32x2* X, int tid, const f32x2 (&tw)[2][7]) {
    asm volatile("" : "+v"(tid));
    constexpr int s = M >> 3;
#pragma unroll
    for (int it = 0; it < 2; ++it) {
        const int uu = tid + 512 * it, blk = uu / s, t = uu - blk * s, n0 = blk * M + t;
        f32x2 v[8];
#pragma unroll
        for (int q = 0; q < 8; ++q) v[q] = X[fpad(n0 + q * s)];
        if (INV) fft_bf_inv<8>(v, tw[it]); else fft_bf_fwd<8>(v, tw[it]);
#pragma unroll
        for (int q = 0; q < 8; ++q) X[fpad(n0 + q * s)] = v[q];
    }
}
__device__ __forceinline__ void fft_filter_unit(Frame& F, const FftTw& T, int l, int c) {
    LAS f32x2* X = (LAS f32x2*)F.lds;
    const float* HFp = WSP<float>(F, WS_HF + (size_t)l * 16 * MiB); const float* HBp = WSP<float>(F, WS_HF + (size_t)l * 16 * MiB + 8 * MiB);
    const float scale = hy_inv_l1(F, l, c) * (1.0f / 8192.0f);
    int tid = F.tid; asm volatile("" : "+v"(tid));
    __syncthreads();
    {   f32x2 v[16];
#pragma unroll
        for (int q = 0; q < 16; ++q) { const int n = tid + 512 * q; float x;
            if (q < 8) x = HFp[(size_t)n * 512 + c]; else x = (n == 4096) ? 0.f : HBp[(size_t)(8192 - n) * 512 + c];
            v[q] = (f32x2){x * scale, 0.f}; }
        fft_bf_fwd<16>(v, T.t1);
#pragma unroll
        for (int q = 0; q < 16; ++q) X[fpad(tid + 512 * q)] = v[q];
    }
    __syncthreads(); fft_pass8<false, 512>(X, tid, T.t2);
    __syncthreads(); fft_pass8<false, 64>(X, tid, T.t3);
    __syncthreads();
    f32x2* Hc = WSP<f32x2>(F, WS_HSPEC) + ((size_t)l * 512 + c) * 8192;
    asm volatile("" : "+v"(tid));
    f32x2 tl[7]; fft_tw_last(tl);
#pragma unroll
    for (int it = 0; it < 2; ++it) {
        const int uu = tid + 512 * it;
        f32x2 v[8];
#pragma unroll
        for (int q = 0; q < 8; ++q) v[q] = X[fpad(8 * uu + q)];
        fft_bf_fwd<8>(v, tl);
#pragma unroll
        for (int q = 0; q < 4; ++q) { f32x4 o; o[0] = v[2 * q].x; o[1] = v[2 * q].y; o[2] = v[2 * q + 1].x; o[3] = v[2 * q + 1].y; *(f32x4*)(Hc + 8 * uu + 2 * q) = o; }
    }
}
__device__ __forceinline__ void fft_conv_unit(Frame& F, const FftTw& T, int l, int unit) {
    LAS f32x2* X = (LAS f32x2*)F.lds;
    const int c = unit >> 2, p = unit & 3; int tid = F.tid; asm volatile("" : "+v"(tid));
    const bf16* z1 = WSP<bf16>(F, WS_ZT) + ((size_t)c * NB + 2 * p) * SEQ; const bf16* z2 = z1 + SEQ;
    const f32x2* Hc = WSP<f32x2>(F, WS_HSPEC) + ((size_t)l * 512 + c) * 8192;
    f32x4 hp[2][4];
#pragma unroll
    for (int it = 0; it < 2; ++it)
#pragma unroll
        for (int q = 0; q < 4; ++q) hp[it][q] = *(const f32x4*)(Hc + 8 * (tid + 512 * it) + 2 * q);
    __syncthreads();
    {   f32x2 v[16];
#pragma unroll
        for (int q = 0; q < 8; ++q) { const int n = tid + 512 * q; v[q] = (f32x2){bf2f(z1[n]), bf2f(z2[n])}; }
#pragma unroll
        for (int q = 8; q < 16; ++q) v[q] = (f32x2){0.f, 0.f};
        fft_bf_fwd<16>(v, T.t1);
#pragma unroll
        for (int q = 0; q < 16; ++q) X[fpad(tid + 512 * q)] = v[q];
    }
    __syncthreads(); fft_pass8<false, 512>(X, tid, T.t2);
    __syncthreads(); fft_pass8<false, 64>(X, tid, T.t3);
    __syncthreads();
    asm volatile("" : "+v"(tid));
    f32x2 tl[7]; fft_tw_last(tl);
#pragma unroll
    for (int it = 0; it < 2; ++it) {
        const int uu = tid + 512 * it;
        f32x2 v[8];
#pragma unroll
        for (int q = 0; q < 8; ++q) v[q] = X[fpad(8 * uu + q)];
        fft_bf_fwd<8>(v, tl);
#pragma unroll
        for (int q = 0; q < 4; ++q) { const f32x4 h = hp[it][q]; v[2 * q] = cmul_(v[2 * q], (f32x2){h[0], h[1]}); v[2 * q + 1] = cmul_(v[2 * q + 1], (f32x2){h[2], h[3]}); }
        fft_bf_inv<8>(v, tl);
#pragma unroll
        for (int q = 0; q < 8; ++q) X[fpad(8 * uu + q)] = v[q];
    }
    __syncthreads(); fft_pass8<true, 64>(X, tid, T.t3);
    __syncthreads(); fft_pass8<true, 512>(X, tid, T.t2);
    __syncthreads();
    asm volatile("" : "+v"(tid));
    {   f32x2 v[16];
#pragma unroll
        for (int q = 0; q < 16; ++q) v[q] = X[fpad(tid + 512 * q)];
        fft_bf_inv<16>(v, T.t1);
        bf16* y1 = WSP<bf16>(F, WS_YT) + ((size_t)c * NB + 2 * p) * SEQ; bf16* y2 = y1 + SEQ;
#pragma unroll
        for (int q = 0; q < 8; ++q) { const int n = tid + 512 * q; y1[n] = f2bf(v[q].x); y2[n] = f2bf(v[q].y); }
    }
}

constexpr int HLD = 72;
__device__ __forceinline__ void hy_sconv8(const bf16* P, int base, int t, int L, int ch0, const float (&w)[4][8], float (&out)[8]) {
    const bf16* p1 = P + (size_t)(base + t) * INC + C_HU + ch0;
    const u32x4 zero = (u32x4){0u, 0u, 0u, 0u};
    const u32x4 c1 = *(const u32x4*)p1, c0 = (t > 0) ? *(const u32x4*)(p1 - INC) : zero, c2 = (t + 1 < L) ? *(const u32x4*)(p1 + INC) : zero;
    const unsigned a0[4] = {c0.x, c0.y, c0.z, c0.w}, a1[4] = {c1.x, c1.y, c1.z, c1.w}, a2[4] = {c2.x, c2.y, c2.z, c2.w};
#pragma unroll
    for (int i = 0; i < 4; ++i) {
        out[2 * i] = w[3][2 * i] + __uint_as_float(a0[i] << 16) * w[0][2 * i] + __uint_as_float(a1[i] << 16) * w[1][2 * i] + __uint_as_float(a2[i] << 16) * w[2][2 * i];
        out[2 * i + 1] = w[3][2 * i + 1] + __uint_as_float(a0[i] & 0xffff0000u) * w[0][2 * i + 1] + __uint_as_float(a1[i] & 0xffff0000u) * w[1][2 * i + 1] + __uint_as_float(a2[i] & 0xffff0000u) * w[2][2 * i + 1];
    }
}
__device__ __forceinline__ void hy_load_w8(const float* cw, const float* cb, int ch0, float (&w)[4][8]) {
#pragma unroll
    for (int i = 0; i < 8; ++i) { w[0][i] = cw[ch0 + i]; w[1][i] = cw[1536 + ch0 + i]; w[2][i] = cw[2 * 1536 + ch0 + i]; w[3][i] = cb[ch0 + i]; }
}
__device__ __forceinline__ void hy_item_decode(int it, int& ct, int& base, int& t0, int& L, int& b, bool& isctx) {
    isctx = it >= 4096;
    if (!isctx) { ct = it & 7; t0 = ((it >> 3) & 63) * 64; b = it >> 9; base = b * SEQ; L = SEQ; }
    else { const int j = it - 4096; ct = j & 7; t0 = ((j >> 3) & 3) * 64; b = j >> 5; base = NLAT + b * CTXL; L = CTXL; }
}
__device__ __forceinline__ void ph_hyprep2(Frame& F, int l, bool do_ctx) {
    const bf16* P = WSP<bf16>(F, WS_P);
    const float* cw = IN_(F, 10) + l * 3 * 1536; const float* cb = IN_(F, 11) + l * 1536;
    LAS bf16* Zs = (LAS bf16*)F.lds;
    int tid = F.tid; asm volatile("" : "+v"(tid));
    const int cg = tid & 7, tl = tid >> 3, c0 = (F.bx & 7) * 64;
    float w1[4][8], wv[4][8];
    hy_load_w8(cw, cb, 512 + c0 + 8 * cg, w1); hy_load_w8(cw, cb, 1024 + c0 + 8 * cg, wv);
    const int nit = do_ctx ? 4352 : 4096;
#pragma unroll 1
    for (int it = F.bx; it < nit; it += F.G) {
        int ct, base, t0, L, b; bool isctx; hy_item_decode(it, ct, base, t0, L, b, isctx);
        float x1[8], v[8];
        hy_sconv8(P, base, t0 + tl, L, 512 + c0 + 8 * cg, w1, x1); hy_sconv8(P, base, t0 + tl, L, 1024 + c0 + 8 * cg, wv, v);
        __syncthreads();
#pragma unroll
        for (int i = 0; i < 8; ++i) Zs[(8 * cg + i) * HLD + tl] = f2bf(x1[i] * v[i]);
        __syncthreads();
        { const int c = tid >> 3, seg = tid & 7;
          const u32x4 o = *(const LAS u32x4*)(Zs + c * HLD + 8 * seg);
          bf16* dst = isctx ? (WSP<bf16>(F, WS_ZTC) + ((size_t)(c0 + c) * NB + b) * CTXL + t0 + 8 * seg) : (WSP<bf16>(F, WS_ZT) + ((size_t)(c0 + c) * NB + b) * SEQ + t0 + 8 * seg);
          *(u32x4*)dst = o; }
    }
}
__device__ __forceinline__ void ph_hypost2(Frame& F, int l, bool do_ctx) {
    const bf16* P = WSP<bf16>(F, WS_P);
    const float* cw = IN_(F, 10) + l * 3 * 1536; const float* cb = IN_(F, 11) + l * 1536; const float* skip = IN_(F, 19) + l * 512;
    LAS bf16* Ys = (LAS bf16*)F.lds;
    int tid = F.tid; asm volatile("" : "+v"(tid));
    const int cg = tid & 7, tl = tid >> 3, c0 = (F.bx & 7) * 64;
    float w0[4][8], w1[4][8], wv[4][8], sk[8];
    hy_load_w8(cw, cb, c0 + 8 * cg, w0); hy_load_w8(cw, cb, 512 + c0 + 8 * cg, w1); hy_load_w8(cw, cb, 1024 + c0 + 8 * cg, wv);
#pragma unroll
    for (int i = 0; i < 8; ++i) sk[i] = skip[c0 + 8 * cg + i];
    bf16* HY = WSP<bf16>(F, WS_RET) + 1024;
    const int nit = do_ctx ? 4352 : 4096;
#pragma unroll 1
    for (int it = F.bx; it < nit; it += F.G) {
        int ct, base, t0, L, b; bool isctx; hy_item_decode(it, ct, base, t0, L, b, isctx);
        __syncthreads();
        { const int c = tid >> 3, seg = tid & 7;
          const bf16* src = isctx ? (WSP<bf16>(F, WS_YTC) + ((size_t)(c0 + c) * NB + b) * CTXL + t0 + 8 * seg) : (WSP<bf16>(F, WS_YT) + ((size_t)(c0 + c) * NB + b) * SEQ + t0 + 8 * seg);
          *(LAS u32x4*)(Ys + c * HLD + 8 * seg) = *(const u32x4*)src; }
        float x0[8], x1[8], v[8];
        hy_sconv8(P, base, t0 + tl, L, c0 + 8 * cg, w0, x0); hy_sconv8(P, base, t0 + tl, L, 512 + c0 + 8 * cg, w1, x1); hy_sconv8(P, base, t0 + tl, L, 1024 + c0 + 8 * cg, wv, v);
        __syncthreads();
        float hy[8];
#pragma unroll
        for (int i = 0; i < 8; ++i) { const float y = bf2f(Ys[(8 * cg + i) * HLD + tl]); hy[i] = x0[i] * (y + sk[i] * (x1[i] * v[i])); }
        u32x4 o; o.x = pk2(hy[0], hy[1]); o.y = pk2(hy[2], hy[3]); o.z = pk2(hy[4], hy[5]); o.w = pk2(hy[6], hy[7]);
        *(u32x4*)(HY + (size_t)(base + t0 + tl) * 1536 + c0 + 8 * cg) = o;
    }
}
__device__ __forceinline__ void hyconv_ctx_item2(Frame& F, int c) {
    const float* HFp = WSP<float>(F, WS_HFC); const float* HBp = WSP<float>(F, WS_HFC + 512 * 1024);
    LAS float* Kc = (LAS float*)F.lds; LAS float* Zs = Kc + 512;
    const float il1 = hy_inv_l1(F, 2, c);
    const bf16* Z = WSP<bf16>(F, WS_ZTC) + (size_t)c * NB * CTXL; bf16* Yo = WSP<bf16>(F, WS_YTC) + (size_t)c * NB * CTXL;
    const int tid = F.tid;
    __syncthreads();
    if (tid < 511) { const int d = tid - 255; Kc[tid] = (d >= 0 ? HFp[(size_t)d * 512 + c] : HBp[(size_t)(-d) * 512 + c]) * il1; }
#pragma unroll
    for (int i = 0; i < 4; ++i) Zs[tid + 512 * i] = bf2f(Z[tid + 512 * i]);
    __syncthreads();
    const int t = tid & 255, b0 = tid >> 8;
    float a[4] = {0.f, 0.f, 0.f, 0.f};
#pragma unroll 4
    for (int s = 0; s < CTXL; ++s) { const float k = Kc[t - s + 255];
#pragma unroll
        for (int i = 0; i < 4; ++i) a[i] += k * Zs[(b0 + 2 * i) * CTXL + s]; }
#pragma unroll
    for (int i = 0; i < 4; ++i) Yo[(b0 + 2 * i) * CTXL + t] = f2bf(a[i]);
}

constexpr int ALD = 72;
__device__ __forceinline__ void attn_unit(Frame& F, int l, int unit) {
    const bf16* P = WSP<bf16>(F, WS_P);
    LAS bf16* Kb = (LAS bf16*)F.lds; LAS bf16* Vt = Kb + 64 * ALD;
    const bool isctx = unit >= 1024;
    int b, kvh, qb;
    if (!isctx) { b = unit >> 7; kvh = (unit >> 6) & 1; qb = unit & 63; } else { const int it = unit - 1024; b = it >> 3; kvh = (it >> 2) & 1; qb = it & 3; }
    int tid = F.tid; asm volatile("" : "+v"(tid));
    const int lane = tid & 63, w = F.wave, g = w >> 1, h = kvh * 4 + g, lg = lane >> 4, lc = lane & 15;
    const int start = qb * 64, q0 = start + (w & 1) * 32;
    const int rowq0 = isctx ? (NLAT + b * CTXL + q0) : (b * SEQ + q0);
    bf16x8 bq[2][2];
#pragma unroll
    for (int qt = 0; qt < 2; ++qt)
#pragma unroll
        for (int ks = 0; ks < 2; ++ks) bq[qt][ks] = *(const bf16x8*)(P + (size_t)(rowq0 + 16 * qt + lc) * INC + C_AQ + h * 64 + 32 * ks + 8 * lg);
    const float sink = IN_(F, 9)[l * 8 + h];
    float mrun[2], lsum[2]; f32x4 o[4][2];
#pragma unroll
    for (int qt = 0; qt < 2; ++qt) { mrun[qt] = sink; lsum[qt] = (lg == 0) ? 1.0f : 0.0f;
#pragma unroll
        for (int dt = 0; dt < 4; ++dt) o[dt][qt] = (f32x4){0.f, 0.f, 0.f, 0.f}; }
    const int nkb = isctx ? 4 : 9;
#pragma unroll 1
    for (int kb = 0; kb < nkb; ++kb) {
        const bool ctxblk = isctx || kb >= 5;
        __syncthreads();
        { const int key = tid >> 3, d0 = (tid & 7) * 8;
          int row = -1;
          if (ctxblk) row = NLAT + b * CTXL + (isctx ? kb : kb - 5) * 64 + key;
          else { const int kpos = start - 128 + kb * 64 + key; if (kpos >= 0 && kpos < SEQ) row = b * SEQ + kpos; }
          u32x4 kk = (u32x4){0u, 0u, 0u, 0u}, vv = kk;
          if (row >= 0) { kk = *(const u32x4*)(P + (size_t)row * INC + C_AK + kvh * 64 + d0); vv = *(const u32x4*)(P + (size_t)row * INC + C_AV + kvh * 64 + d0); }
          *(LAS u32x4*)(Kb + key * ALD + d0) = kk;
          const unsigned vw[4] = {vv.x, vv.y, vv.z, vv.w};
#pragma unroll
          for (int i = 0; i < 4; ++i) { Vt[(d0 + 2 * i) * ALD + key] = (bf16)(vw[i] & 0xffffu); Vt[(d0 + 2 * i + 1) * ALD + key] = (bf16)(vw[i] >> 16); } }
        __syncthreads();
        f32x4 s[4][2];
#pragma unroll
        for (int kt = 0; kt < 4; ++kt) {
            const bf16x8 k0 = *(const LAS bf16x8*)(Kb + (16 * kt + lc) * ALD + 8 * lg), k1 = *(const LAS bf16x8*)(Kb + (16 * kt + lc) * ALD + 32 + 8 * lg);
#pragma unroll
            for (int qt = 0; qt < 2; ++qt) { f32x4 c = (f32x4){0.f, 0.f, 0.f, 0.f};
                c = __builtin_amdgcn_mfma_f32_16x16x32_bf16(k0, bq[qt][0], c, 0, 0, 0); c = __builtin_amdgcn_mfma_f32_16x16x32_bf16(k1, bq[qt][1], c, 0, 0, 0);
                s[kt][qt] = c * 0.125f; }
        }
        if (!ctxblk) {
#pragma unroll
            for (int kt = 0; kt < 4; ++kt)
#pragma unroll
                for (int qt = 0; qt < 2; ++qt)
#pragma unroll
                    for (int r = 0; r < 4; ++r) { const int kpos = start - 128 + kb * 64 + 16 * kt + 4 * lg + r, qpos = q0 + 16 * qt + lc, dd = qpos - kpos;
                        const bool valid = (kpos >= 0) && (kpos < SEQ) && (dd <= 128) && (dd >= -128);
                        s[kt][qt][r] = valid ? s[kt][qt][r] : -1.0e30f; }
        }
        bf16x8 pf[2][2];
#pragma unroll
        for (int qt = 0; qt < 2; ++qt) {
            float bm = -3.0e38f;
#pragma unroll
            for (int kt = 0; kt < 4; ++kt) bm = fmaxf(bm, fmaxf(fmaxf(s[kt][qt][0], s[kt][qt][1]), fmaxf(s[kt][qt][2], s[kt][qt][3])));
            bm = fmaxf(bm, __shfl_xor(bm, 16)); bm = fmaxf(bm, __shfl_xor(bm, 32));
            const float mnew = fmaxf(mrun[qt], bm), sc = __expf(mrun[qt] - mnew);
            mrun[qt] = mnew;
            float ps = 0.f; unsigned pw[8];
#pragma unroll
            for (int kt = 0; kt < 4; ++kt) { const float p0 = __expf(s[kt][qt][0] - mnew), p1 = __expf(s[kt][qt][1] - mnew), p2 = __expf(s[kt][qt][2] - mnew), p3 = __expf(s[kt][qt][3] - mnew);
                ps += (p0 + p1) + (p2 + p3); pw[2 * kt] = pk2(p0, p1); pw[2 * kt + 1] = pk2(p2, p3); }
            lsum[qt] = lsum[qt] * sc + ps;
#pragma unroll
            for (int dt = 0; dt < 4; ++dt) o[dt][qt] = o[dt][qt] * sc;
            u32x4 f0; f0.x = pw[0]; f0.y = pw[1]; f0.z = pw[2]; f0.w = pw[3];
            u32x4 f1; f1.x = pw[4]; f1.y = pw[5]; f1.z = pw[6]; f1.w = pw[7];
            pf[qt][0] = __builtin_bit_cast(bf16x8, f0); pf[qt][1] = __builtin_bit_cast(bf16x8, f1);
        }
#pragma unroll
        for (int dt = 0; dt < 4; ++dt)
#pragma unroll
            for (int ks = 0; ks < 2; ++ks) {
                const u32x2 a0 = *(const LAS u32x2*)(Vt + (16 * dt + lc) * ALD + 32 * ks + 4 * lg), a1 = *(const LAS u32x2*)(Vt + (16 * dt + lc) * ALD + 32 * ks + 16 + 4 * lg);
                u32x4 av; av.x = a0.x; av.y = a0.y; av.z = a1.x; av.w = a1.y;
                const bf16x8 va = __builtin_bit_cast(bf16x8, av);
#pragma unroll
                for (int qt = 0; qt < 2; ++qt) o[dt][qt] = __builtin_amdgcn_mfma_f32_16x16x32_bf16(va, pf[qt][ks], o[dt][qt], 0, 0, 0);
            }
    }
    bf16* ATT = WSP<bf16>(F, WS_RET) + 512;
#pragma unroll
    for (int qt = 0; qt < 2; ++qt) {
        float lt = lsum[qt]; lt += __shfl_xor(lt, 16); lt += __shfl_xor(lt, 32);
        const float inv = 1.0f / lt;
        bf16* op = ATT + (size_t)(rowq0 + 16 * qt + lc) * 1536 + h * 64 + 4 * lg;
#pragma unroll
        for (int dt = 0; dt < 4; ++dt) { u32x2 ov; ov.x = pk2(o[dt][qt][0] * inv, o[dt][qt][1] * inv); ov.y = pk2(o[dt][qt][2] * inv, o[dt][qt][3] * inv); *(u32x2*)(op + 16 * dt) = ov; }
    }
}

__device__ __forceinline__ void ph_norm2_router(Frame& F, int l, int nrows) {
    const int lane = F.lane, RPB = nrows / 256;
    LAS float* RW = (LAS float*)F.lds;
    LAS unsigned* cnt = (LAS unsigned*)(F.lds + LDSX + 64);
    __syncthreads();
    { const float* rw = IN_(F, 24) + (size_t)l * 1024 * 32;
      for (int i = F.tid; i < 1024 * 32 / 4; i += NTHR) { const int col = i >> 3, ch = i & 7; *(LAS f32x4*)(RW + col * 32 + ((ch ^ ((col >> 2) & 7)) << 2)) = *(const f32x4*)(rw + 4 * i); } }
    if (F.tid < 32) cnt[F.tid] = 0u;
    __syncthreads();
    const float* xm_all = WSP<float>(F, WS_XM);
    const float* gw_ = IN_(F, 23) + l * DM;
    const int e = lane >> 1, sw = lane & 7;
    const float rb = IN_(F, 25)[l * 32 + e];
    int* TOPI = WSP<int>(F, WS_TOPI); float* TOPW = WSP<float>(F, WS_TOPW);
#pragma unroll 1
    for (int rr = F.wave; rr < RPB; rr += NWAVES) {
        const int r = F.bx * RPB + rr, mr = modrow_of(r);
        const float* xr = xm_all + (size_t)r * DM;
        const float* sh = mod_ptr(F, l, mr, 3); const float* sc = mod_ptr(F, l, mr, 4);
        f32x4 v[4]; float ss = 0.f;
#pragma unroll
        for (int j = 0; j < 4; ++j) { v[j] = *(const f32x4*)(xr + 4 * lane + 256 * j); ss += (v[j][0] * v[j][0] + v[j][1] * v[j][1]) + (v[j][2] * v[j][2] + v[j][3] * v[j][3]); }
        const float rstd = 1.0f / sqrtf(wave_sum(ss) * (1.0f / DM) + EPS);
        bf16* o = WSP<bf16>(F, WS_XN) + (size_t)r * DM;
#pragma unroll
        for (int j = 0; j < 4; ++j) { const f32x4 g = *(const f32x4*)(gw_ + 4 * lane + 256 * j); const f32x4 a = *(const f32x4*)(sh + 4 * lane + 256 * j); const f32x4 b = *(const f32x4*)(sc + 4 * lane + 256 * j);
            v[j] = v[j] * rstd * g * (b + 1.0f) + a;
            u32x2 w2; w2.x = pk2(v[j][0], v[j][1]); w2.y = pk2(v[j][2], v[j][3]); *(u32x2*)(o + 4 * lane + 256 * j) = w2; }
        float acc[32];
#pragma unroll
        for (int i = 0; i < 32; ++i) acc[i] = 0.f;
#pragma unroll
        for (int j = 0; j < 4; ++j)
#pragma unroll
            for (int q = 0; q < 4; ++q) { const int col = 4 * lane + q + 256 * j; const float hv = v[j][q];
#pragma unroll
                for (int c8 = 0; c8 < 8; ++c8) { const f32x4 w4 = *(const LAS f32x4*)(RW + col * 32 + ((c8 ^ sw) << 2));
                    acc[4 * c8 + 0] += hv * w4[0]; acc[4 * c8 + 1] += hv * w4[1]; acc[4 * c8 + 2] += hv * w4[2]; acc[4 * c8 + 3] += hv * w4[3]; } }
        float r16[16], r8[8], r4[4], r2[2];
        { const bool hi = (lane & 32) != 0;
#pragma unroll
          for (int i = 0; i < 16; ++i) { const float keep = hi ? acc[16 + i] : acc[i], send = hi ? acc[i] : acc[16 + i]; r16[i] = keep + __shfl_xor(send, 32); } }
        { const bool hi = (lane & 16) != 0;
#pragma unroll
          for (int i = 0; i < 8; ++i) { const float keep = hi ? r16[8 + i] : r16[i], send = hi ? r16[i] : r16[8 + i]; r8[i] = keep + __shfl_xor(send, 16); } }
        { const bool hi = (lane & 8) != 0;
#pragma unroll
          for (int i = 0; i < 4; ++i) { const float keep = hi ? r8[4 + i] : r8[i], send = hi ? r8[i] : r8[4 + i]; r4[i] = keep + __shfl_xor(send, 8); } }
        { const bool hi = (lane & 4) != 0;
#pragma unroll
          for (int i = 0; i < 2; ++i) { const float keep = hi ? r4[2 + i] : r4[i], send = hi ? r4[i] : r4[2 + i]; r2[i] = keep + __shfl_xor(send, 4); } }
        float logit;
        { const bool hi = (lane & 2) != 0; const float keep = hi ? r2[1] : r2[0], send = hi ? r2[0] : r2[1]; logit = keep + __shfl_xor(send, 2); }
        logit += __shfl_xor(logit, 1);
        logit += rb;
        float tv[4]; int ti[4];
        float cur = logit;
#pragma unroll
        for (int k = 0; k < 4; ++k) {
            float bvv = cur; int bi = e;
#pragma unroll
            for (int off = 2; off < 64; off <<= 1) { const float ov = __shfl_xor(bvv, off); const int oi = __shfl_xor(bi, off);
                if (ov > bvv || (ov == bvv && oi < bi)) { bvv = ov; bi = oi; } }
            tv[k] = bvv; ti[k] = bi;
            if (e == bi) cur = -3.0e38f;
        }
        const float mx = tv[0];
        float ex[4], den = 0.f;
#pragma unroll
        for (int k = 0; k < 4; ++k) { ex[k] = __expf(tv[k] - mx); den += ex[k]; }
        if (lane < 4) { const int k = lane; const int id = (k == 0) ? ti[0] : (k == 1) ? ti[1] : (k == 2) ? ti[2] : ti[3]; const float wv = ((k == 0) ? ex[0] : (k == 1) ? ex[1] : (k == 2) ? ex[2] : ex[3]) / den;
            TOPI[r * 4 + k] = id; TOPW[r * 4 + k] = wv; __hip_atomic_fetch_add(cnt + id, 1u, __ATOMIC_RELAXED, __HIP_MEMORY_SCOPE_WORKGROUP); }
    }
    __syncthreads();
    if (F.tid < 32) WSP<int>(F, WS_BLKCNT)[F.bx * 32 + F.tid] = (int)cnt[F.tid];
}

__device__ __forceinline__ void ph_moe_assign(Frame& F, int nrows) {
    const int RPB = nrows / 256, lane = F.lane;
    LAS int* part = (LAS int*)F.lds;
    LAS int* base = part + 1024;
    LAS int* idx = base + 32;
    LAS int* posl = idx + 1024;
    const int* BC = WSP<int>(F, WS_BLKCNT);
    __syncthreads();
    { const int e = F.tid & 31, pt = F.tid >> 5; int st = 0, sp = 0;
      for (int q = 0; q < 16; ++q) { const int blk = pt * 16 + q; const int v = BC[blk * 32 + e]; st += v; if (blk < F.bx) sp += v; }
      part[pt * 32 + e] = st; part[512 + pt * 32 + e] = sp; }
    for (int i = F.tid; i < RPB * 4; i += NTHR) idx[i] = WSP<int>(F, WS_TOPI)[F.bx * RPB * 4 + i];
    __syncthreads();
    if (F.tid < 32) { int st = 0, sp = 0; for (int q = 0; q < 16; ++q) { st += part[q * 32 + F.tid]; sp += part[512 + q * 32 + F.tid]; }
        part[F.tid] = st; part[512 + F.tid] = sp; }
    __syncthreads();
    if (F.tid == 0) { int t0 = 0; int* tl = WSP<int>(F, WS_TILES);
        for (int e = 0; e < 32; ++e) { base[e] = t0 * 256 + part[512 + e]; if (F.bx == 0) tl[e] = t0; t0 += (part[e] + 255) >> 8; }
        if (F.bx == 0) tl[32] = t0; }
    __syncthreads();
    if (F.tid < 32) { const int e = F.tid; int c = base[e]; for (int j = 0; j < RPB * 4; ++j) if (idx[j] == e) posl[j] = c++; }
    __syncthreads();
    const bf16* H = WSP<bf16>(F, WS_XN); bf16* HS = WSP<bf16>(F, WS_HS); int* POS = WSP<int>(F, WS_POS);
    for (int rr = F.wave; rr < RPB; rr += NWAVES) {
        const int r = F.bx * RPB + rr;
        const u32x4 a = *(const u32x4*)(H + (size_t)r * DM + 8 * lane), b = *(const u32x4*)(H + (size_t)r * DM + 512 + 8 * lane);
#pragma unroll
        for (int k = 0; k < 4; ++k) { const int p = posl[rr * 4 + k];
            *(u32x4*)(HS + (size_t)p * DM + 8 * lane) = a; *(u32x4*)(HS + (size_t)p * DM + 512 + 8 * lane) = b; }
        if (lane < 4) POS[r * 4 + lane] = posl[rr * 4 + lane];
    }
}

#define PHASE_FN __device__ __forceinline__
PHASE_FN void P_prologue() { Frame F = make_frame(); p0_prologue(F); }
PHASE_FN void P_norm1(int mode) { Frame F = make_frame(); ph_norm1(F, mode);
    if (mode == 0) { FftTw T; fft_tw_init(T, F.tid); for (int it = F.bx; it < 1024; it += F.G) fft_filter_unit(F, T, it >> 9, it & 511); } }
PHASE_FN void P_inproj(int l) { Frame F = make_frame();
    pg8::Gemm g{WSP<bf16>(F, WS_XN), WSP<bf16>(F, WS_WIN) + (size_t)l * INC * 1024, NROWS, INC, 1024};
    pg8::StaticOrder S; S.init(NROWS, INC, F.G, F.bx);
    EpiP E{WSP<bf16>(F, WS_P)};
    pg8::gemm_phase<EpiP, pg8::StaticOrder, true, true>(F.lds, g, S, E); }
PHASE_FN void P_rope() { Frame F = make_frame(); ph_rope(F); }
PHASE_FN void P_mix(int l) { Frame F = make_frame(); const bool last = (l == 1);
    const int na = last ? 1024 : 1088;
    for (int it = F.bx; it < na; it += F.G) attn_unit(F, l, it);
    for (int it = F.bx; it < 1088; it += F.G) ret_kv_unit(F, l, it);
    ph_hyprep2(F, l, !last); }

PHASE_FN void P_hyconv(int l) { Frame F = make_frame(); const bool last = (l == 1);
    ret_scan(F, l);
    { FftTw T; fft_tw_init(T, F.tid); for (int it = F.bx; it < 2048; it += F.G) fft_conv_unit(F, T, l, it); }
    if (!last) for (int it = F.bx; it < 512; it += F.G) hyconv_ctx_item2(F, it); }
PHASE_FN void P_hypost(int l) { Frame F = make_frame(); const bool last = (l == 1);
    for (int it = F.bx; it < 1088; it += F.G) { const int ci = it % 34; if (last && ci < 2) continue; ret_out_unit(F, l, it); }
    ph_hypost2(F, l, !last); }
PHASE_FN void P_merge(int l) { Frame F = make_frame(); const int mrows = (l == 1) ? NLAT : NROWS;
    pg8::Gemm g{WSP<bf16>(F, WS_RET), WSP<bf16>(F, WS_WBR) + (size_t)l * 1024 * 1536, mrows, 1024, 1536};
    pg8::StaticOrder S; S.init(mrows, 1024, F.G, F.bx);
    EpiMerge E{WSP<bf16>(F, WS_P), IN_(F, 21) + l * 3072, WSP<bf16>(F, WS_M)};
    pg8::gemm_phase<EpiMerge, pg8::StaticOrder, true, true>(F.lds, g, S, E); }
PHASE_FN void P_out(int l) { Frame F = make_frame(); const int mrows = (l == 1) ? NLAT : NROWS;
    pg8::Gemm g{WSP<bf16>(F, WS_M), WSP<bf16>(F, WS_WOUT) + (size_t)l * 1024 * 1024, mrows, 1024, 1024};
    pg8::StaticOrder S; S.init(mrows, 1024, F.G, F.bx);
    const float* xl = (l == 0) ? IN_(F, 0) : WSP<float>(F, WS_XO);
    const float* xc = (l == 0) ? IN_(F, 2) : WSP<float>(F, WS_XO) + (size_t)NLAT * DM;
    EpiOut E{xl, xc, mod_ptr(F, l, 0, 2), WSP<float>(F, WS_XM)};
    pg8::gemm_phase<EpiOut, pg8::StaticOrder, true, true>(F.lds, g, S, E); }
PHASE_FN void P_router(int l) { Frame F = make_frame(); ph_norm2_router(F, l, (l == 1) ? NLAT : NROWS); }
PHASE_FN void P_assign(int l) { Frame F = make_frame(); ph_moe_assign(F, (l == 1) ? NLAT : NROWS); }
PHASE_FN void P_moe1(int l) { Frame F = make_frame();
    LAS int* list = (LAS int*)(F.lds + LDSX + 256);
    const int n = moe_list_units(F, 8, list);
    pg8::Gemm g{WSP<bf16>(F, WS_HS), WSP<bf16>(F, WS_W1) + (size_t)l * 32 * 2048 * 1024, MPAD, 32 * 2048, 1024};
    MoeOrder S{list, n};
    EpiMoe1 E{IN_(F, 27) + (size_t)l * 32 * 2048, WSP<bf16>(F, WS_ACT)};
    pg8::gemm_phase<EpiMoe1, MoeOrder, true, true>(F.lds, g, S, E); }
PHASE_FN void P_moe2(int l) { Frame F = make_frame();
    LAS int* list = (LAS int*)(F.lds + LDSX + 256);
    const int n = moe_list_units(F, 4, list);
    pg8::Gemm g{WSP<bf16>(F, WS_ACT), WSP<bf16>(F, WS_W2) + (size_t)l * 32 * 1024 * 1024, MPAD, 32 * 1024, 1024};
    MoeOrder S{list, n};
    EpiMoe2 E{IN_(F, 29) + (size_t)l * 32 * 1024, WSP<bf16>(F, WS_HS)};
    pg8::gemm_phase<EpiMoe2, MoeOrder, true, true>(F.lds, g, S, E); }

template <int ONLY> __global__ void __launch_bounds__(NTHR, 2) mk_fwd(Args args) {
    LAS unsigned char* lds = (LAS unsigned char*)lds_raw;
    const int tid = threadIdx.x;
    for (int u = tid; u < (LDS_BYTES - LDSX) / 4; u += NTHR) ((LAS unsigned*)(lds + LDSX))[u] = 0u;
    __syncthreads();
    if (tid < 33) { const unsigned long long v = (tid < 31) ? (unsigned long long)args.in[tid] : (tid == 31 ? (unsigned long long)args.out : (unsigned long long)args.ws);
        *(LAS unsigned long long*)(lds + LDS_PTAB + 8 * tid) = v; }
    __syncthreads();
    const int lo = args.ph_lo, hi = args.ph_hi;
    const bool one_launch = (hi - lo) > 1;
    unsigned* barw = (unsigned*)(args.ws + WS_CTL + CTL_BAR);
    XcdBarrier bar; bar.bar = barw; bar.x = 0; bar.st = nullptr;
    if (one_launch) bar = xcd_barrier_post(barw, (volatile LAS unsigned*)(lds + LDSX));
#ifndef MK_MASK
#define MK_MASK 0xFFFFFFFFu
#endif
#define ENAB(k) ((ONLY < 0 && ((MK_MASK >> ((k) >= 100 ? (k) - 100 + 14 : (k))) & 1u)) || ONLY == (k))
#ifndef MK_REP
#define MK_REP 0u
#endif
#define REPB(k) (((MK_REP) >> ((k) >= 100 ? (k) - 100 + 14 : (k))) & 1u)
#define IN(k) (lo <= (k) && (k) < hi)
#define SEAM(k) do { if (IN(k) && IN((k) + 1)) xcd_barrier(bar); } while (0)
    if (ENAB(100)) if (IN(0)) { P_prologue(); if (REPB(100)) { xcd_barrier(bar); P_prologue(); } } SEAM(0);
    for (int l = 0; l < 2; ++l) {
        const int pb = 1 + NPH_LAYER * l;
        if (ENAB(0)) if (IN(pb + 0)) { P_norm1(l == 0 ? 0 : 1); if (REPB(0)) { xcd_barrier(bar); P_norm1(l == 0 ? 0 : 1); } } SEAM(pb + 0);
        if (ENAB(1)) if (IN(pb + 1)) { P_inproj(l); if (REPB(1)) { xcd_barrier(bar); P_inproj(l); } } SEAM(pb + 1);
        if (ENAB(3)) if (IN(pb + 3)) { P_mix(l); if (REPB(3)) { xcd_barrier(bar); P_mix(l); } } SEAM(pb + 3);
        if (ENAB(4)) if (IN(pb + 4)) { P_hyconv(l); if (REPB(4)) { xcd_barrier(bar); P_hyconv(l); } } SEAM(pb + 4);
        if (ENAB(5)) if (IN(pb + 5)) { P_hypost(l); if (REPB(5)) { xcd_barrier(bar); P_hypost(l); } } SEAM(pb + 5);
        if (ENAB(6)) if (IN(pb + 6)) { P_merge(l); } SEAM(pb + 6);
        if (ENAB(9)) if (IN(pb + 9)) { P_out(l); if (REPB(9)) { xcd_barrier(bar); P_out(l); } } SEAM(pb + 9);
        if (ENAB(10)) if (IN(pb + 10)) { P_router(l); if (REPB(10)) { xcd_barrier(bar); P_router(l); } } SEAM(pb + 10);
        if (ENAB(11)) if (IN(pb + 11)) { P_assign(l); if (REPB(11)) { xcd_barrier(bar); P_assign(l); } } SEAM(pb + 11);
        if (ENAB(12)) if (IN(pb + 12)) { P_moe1(l); if (REPB(12)) { xcd_barrier(bar); P_moe1(l); } } SEAM(pb + 12);
        if (ENAB(13)) if (IN(pb + 13)) { P_moe2(l); if (REPB(13)) { xcd_barrier(bar); P_moe2(l); } } SEAM(pb + 13);
    }
    if (ENAB(101)) if (IN(NPH - 1)) { P_norm1(2); }
#undef IN
#undef SEAM
#undef ENAB
}

template <int ONLY> static void launch_phase(Args a, int lo, int hi, int grid, hipStream_t stream) {
    static bool attr_set = false;
    if (!attr_set) { (void)hipFuncSetAttribute((const void*)mk_fwd<ONLY>, hipFuncAttributeMaxDynamicSharedMemorySize, LDS_BYTES); attr_set = true; }
    a.ph_lo = lo; a.ph_hi = hi;
    hipLaunchKernelGGL(mk_fwd<ONLY>, dim3(grid), dim3(NTHR), LDS_BYTES, stream, a);
}
extern "C" void kernel_launch(void* const* d_in, const int* in_sizes, int n_in, void* d_out, int out_size, void* d_ws, size_t ws_size, hipStream_t stream) {
    static int grid = 0;
    if (grid == 0) {
        if (n_in != 31 || ws_size < WS_END) { fprintf(stderr, "kernel_launch: unexpected n_in %d / ws_size %zu\n", n_in, ws_size); grid = -1; return; }
        int dev = 0, cus = 0;
        if (hipGetDevice(&dev) != hipSuccess || hipDeviceGetAttribute(&cus, hipDeviceAttributeMultiprocessorCount, dev) != hipSuccess) { grid = -1; return; }
        grid = (cus == 256) ? 256 : -1;
        if (grid < 0) { fprintf(stderr, "kernel_launch: needs a 256-CU device, got %d\n", cus); return; }
    }
    if (grid < 0) return;
    (void)hipMemsetAsync((char*)d_ws + WS_CTL, 0, CTL_ZERO_BYTES, stream);
    Args a{};
    for (int i = 0; i < 31; ++i) a.in[i] = (const float*)d_in[i];
    a.out = (float*)d_out; a.ws = (unsigned char*)d_ws;
#if MK_ONE_LAUNCH
    launch_phase<-1>(a, 0, NPH, grid, stream);
#else
    launch_phase<100>(a, 0, 1, grid, stream);
    for (int l = 0; l < 2; ++l) {
        const int pb = 1 + NPH_LAYER * l;
        launch_phase<0>(a, pb + 0, pb + 1, grid, stream);   launch_phase<1>(a, pb + 1, pb + 2, grid, stream);   launch_phase<2>(a, pb + 2, pb + 3, grid, stream);
        launch_phase<3>(a, pb + 3, pb + 4, grid, stream);   launch_phase<4>(a, pb + 4, pb + 5, grid, stream);   launch_phase<5>(a, pb + 5, pb + 6, grid, stream);
        launch_phase<6>(a, pb + 6, pb + 7, grid, stream);   launch_phase<7>(a, pb + 7, pb + 8, grid, stream);   launch_phase<8>(a, pb + 8, pb + 9, grid, stream);
        launch_phase<9>(a, pb + 9, pb + 10, grid, stream);  launch_phase<10>(a, pb + 10, pb + 11, grid, stream); launch_phase<11>(a, pb + 11, pb + 12, grid, stream);
        launch_phase<12>(a, pb + 12, pb + 13, grid, stream); launch_phase<13>(a, pb + 13, pb + 14, grid, stream);
    }
    launch_phase<101>(a, NPH - 1, NPH, grid, stream);
#endif
}
```

```cpp
#include <hip/hip_runtime.h>
#include <cstdio>
#include <cstdint>
#define MK_ONE_LAUNCH 1
namespace pg8 {
#define PG8_LAS __attribute__((address_space(3)))
typedef unsigned short bf16_t;
typedef short bf16x8 __attribute__((ext_vector_type(8)));
typedef float f32x4 __attribute__((ext_vector_type(4)));
typedef unsigned u32x4 __attribute__((ext_vector_type(4)));
constexpr int BM = 256, BK = 64, HALF = 128, HTB = HALF * BK * 2  , STAGE_BYTES = 8 * HTB, NXCD = 8, WGM = 8;

__host__ __device__ __forceinline__ int lds_byte(int r, int c) { const int st = (r >> 4) * 2 + (c >> 5), rr = r & 15, cc = c & 31, ob = rr * 64 + cc * 2; return st * 1024 + (ob ^ (((ob >> 9) & 1) << 5)); }
__host__ __device__ __forceinline__ void stage_rc(int b, int& R, int& C) { const int st = b / 1024, sb = b % 1024, swz = sb ^ (((sb >> 9) & 1) << 5); R = (st >> 1) * 16 + swz / 64; C = (st & 1) * 32 + (swz % 64) / 2; }
__host__ __device__ __forceinline__ int perm32(int rho) { const int n = rho >> 4, i = rho & 15; return 8 * (i >> 2) + 4 * n + (i & 3); }

struct Unit { int pm, pn; };
struct Gemm { const bf16_t* A; const bf16_t* Bt; int M, N, K; };

struct StaticOrder {
    static constexpr bool GATHER = false; const PG8_LAS int* src;
    int nM, nN, nwg, G, c;
    __host__ __device__ void init(int M, int N, int G_, int c_) { nM = M / BM; nN = N / BM; nwg = nM * nN; G = G_; c = c_; }
    __host__ __device__ bool next(int i, Unit& u) const {
        const long L = (long)i * G + c; if (L >= nwg) return false;
        int wgid = (int)L; { const int q = nwg / NXCD, r = nwg % NXCD, xcd = wgid % NXCD, off = wgid / NXCD; wgid = (xcd < r ? xcd * (q + 1) : r * (q + 1) + (xcd - r) * q) + off; }
        const int nig = WGM * nN, gid = wgid / nig, fm = gid * WGM, gsz = (nM - fm) < WGM ? (nM - fm) : WGM;
        u.pm = fm + ((wgid % nig) % gsz); u.pn = (wgid % nig) / gsz; return true;
    }
    __device__ __forceinline__ void a_ready(const Unit&) const {}
    __device__ __forceinline__ void done(const Unit&) const {}
};

__device__ __forceinline__ unsigned cvt_pk_bf16(float lo, float hi) { unsigned r; asm volatile("v_cvt_pk_bf16_f32 %0, %1, %2" : "=v"(r) : "v"(lo), "v"(hi)); return r; }
template <class Epi, class Sched, bool ALIGN_EPI = false, bool SP2 = false>
__device__ __forceinline__ void gemm_phase(PG8_LAS unsigned char* lds, const Gemm g, const Sched& S, const Epi& E) {
    int tid_ = threadIdx.x; asm volatile("" : "+v"(tid_));
    const int tid = tid_, wid = __builtin_amdgcn_readfirstlane(tid >> 6), lane = tid & 63, wr = wid >> 2, wc = wid & 3, fr = lane & 15, fq = lane >> 4;
    const int K = g.K, nt = K / BK;
    unsigned voffA[2], voffB[2];
#pragma unroll
    for (int i = 0; i < 2; ++i) { int R, C; stage_rc(tid * 16 + i * 8192, R, C); const int Rb = Epi::PERM ? ((R & ~31) + perm32(R & 31)) : R;
        voffA[i] = (unsigned)(R * K + C) * 2u; voffB[i] = (unsigned)(Rb * K + C) * 2u; }
    constexpr bool GATHER = Sched::GATHER;
    static_assert(!GATHER || SP2, "the gathered A path is wired into the SP2 loop only");
    unsigned vAc[2][2], vAn[2][2];
#define PG8_GIDX(dst, ord) do { _Pragma("unroll") for (int _h = 0; _h < 2; ++_h) _Pragma("unroll") for (int _i = 0; _i < 2; ++_i) { int _R, _C; stage_rc(tid * 16 + _i * 8192, _R, _C); \
        dst[_h][_i] = (unsigned)S.src[(ord) * 256 + _h * 128 + _R] * (unsigned)(K * 2) + (unsigned)(_C * 2); } } while (0)
    const size_t kstep = (size_t)(BK * 2);
    const size_t hstep = (size_t)HALF * K * 2;
    const size_t tstep = 2 * hstep;
    const unsigned ldsw = (unsigned)wid * 1024u;
    const int aoff = lds_byte(wr * 64 + fr, fq * 8), boff = lds_byte(wc * 32 + fr, fq * 8);
#define PG8_SA(b, h) (((b) * 2 + (h)) * HTB)
#define PG8_SB(b, h) ((4 + (b) * 2 + (h)) * HTB)
#define PG8_STAGE(bufoff, gbase, voff) do { _Pragma("unroll") for (int _i = 0; _i < 2; ++_i) \
        __builtin_amdgcn_global_load_lds((const unsigned*)((const char*)(gbase) + (voff)[_i]), (PG8_LAS unsigned*)(lds + (bufoff) + ldsw + _i * 8192), 16, 0, 0); } while (0)
#define PG8_STAGE_A(bufoff, gbase, h, vg) do { if constexpr (GATHER) { PG8_STAGE(bufoff, gbase, (vg)[h]); } else { PG8_STAGE(bufoff, (gbase) + ((h) ? hstep : 0), voffA); } } while (0)
#define PG8_LDA(dst, b, h) do { _Pragma("unroll") for (int m = 0; m < 4; ++m) _Pragma("unroll") for (int k = 0; k < 2; ++k) dst[m][k] = *(const PG8_LAS bf16x8*)(lds + PG8_SA(b, h) + aoff + m * 2048 + k * 1024); } while (0)
#define PG8_LDB(dst, b, h) do { _Pragma("unroll") for (int n = 0; n < 2; ++n) _Pragma("unroll") for (int k = 0; k < 2; ++k) dst[n][k] = *(const PG8_LAS bf16x8*)(lds + PG8_SB(b, h) + boff + n * 2048 + k * 1024); } while (0)
#define PG8_MMA(ai, bj, At, Bt) do { __builtin_amdgcn_s_setprio(1); _Pragma("unroll") for (int m = 0; m < 4; ++m) _Pragma("unroll") for (int n = 0; n < 2; ++n) _Pragma("unroll") for (int k = 0; k < 2; ++k) \
        acc[ai][bj][m][n] = __builtin_amdgcn_mfma_f32_16x16x32_bf16(Bt[n][k], At[m][k], acc[ai][bj][m][n], 0, 0, 0); __builtin_amdgcn_s_setprio(0); } while (0)
#define PG8_WAIT_V(n) asm volatile("s_waitcnt vmcnt(" #n ")" ::: "memory")
#define PG8_WAIT_L(n) asm volatile("s_waitcnt lgkmcnt(" #n ")" ::: "memory")
#define PG8_BAR __builtin_amdgcn_s_barrier()
#define PG8_SCHED __builtin_amdgcn_sched_barrier(0)
    Unit cur, nxt; int ui = 0;
    if (!S.next(0, cur)) return;
    f32x4 acc[2][2][4][2];
#pragma unroll
    for (int a = 0; a < 2; ++a)
#pragma unroll
        for (int b = 0; b < 2; ++b)
#pragma unroll
            for (int m = 0; m < 4; ++m)
#pragma unroll
                for (int n = 0; n < 2; ++n) acc[a][b][m][n] = (f32x4){0.f, 0.f, 0.f, 0.f};
    bf16x8 At[4][2], B0[2][2], B1[2][2];
    const char* cA = (const char*)g.A + (GATHER ? (size_t)0 : (size_t)cur.pm * tstep); const char* cB = (const char*)g.Bt + (size_t)cur.pn * tstep;
    S.a_ready(cur);
    if constexpr (GATHER) { PG8_GIDX(vAc, 0); }
    if constexpr (SP2) {
        PG8_STAGE(PG8_SB(0, 0), cB, voffB); PG8_STAGE(PG8_SB(0, 1), cB + hstep, voffB); PG8_STAGE_A(PG8_SA(0, 0), cA, 0, vAc); PG8_STAGE_A(PG8_SA(0, 1), cA, 1, vAc);
        if (wr == 1) PG8_BAR;
        PG8_WAIT_V(2); PG8_BAR;
        PG8_STAGE(PG8_SB(1, 0), cB + kstep, voffB); PG8_STAGE_A(PG8_SA(1, 0), cA + kstep, 0, vAc); PG8_STAGE(PG8_SB(1, 1), cB + hstep + kstep, voffB);
        PG8_WAIT_V(6); PG8_BAR;
    } else {
        PG8_STAGE(PG8_SB(0, 0), cB, voffB); PG8_STAGE(PG8_SA(0, 0), cA, voffA); PG8_STAGE(PG8_SB(0, 1), cB + hstep, voffB); PG8_STAGE(PG8_SA(0, 1), cA + hstep, voffA);
        if (wr == 1) PG8_BAR;
        PG8_WAIT_V(4); PG8_BAR;
        PG8_STAGE(PG8_SB(1, 0), cB + kstep, voffB); PG8_STAGE(PG8_SA(1, 0), cA + kstep, voffA); PG8_STAGE(PG8_SB(1, 1), cB + hstep + kstep, voffB);
        PG8_WAIT_V(6); PG8_BAR;
    }
    for (;;) {
        const bool has_next = S.next(ui + 1, nxt);
        if constexpr (GATHER) { if (has_next) { PG8_GIDX(vAn, ui + 1); } else { _Pragma("unroll") for (int _h = 0; _h < 2; ++_h) _Pragma("unroll") for (int _i = 0; _i < 2; ++_i) vAn[_h][_i] = vAc[_h][_i]; } }
        const char* nA = GATHER ? cA : (has_next ? (const char*)g.A + (size_t)nxt.pm * tstep : cA); const char* nB = has_next ? (const char*)g.Bt + (size_t)nxt.pn * tstep : cB;
        for (int t = 0; t < nt; t += 2) {
            if constexpr (Epi::KMID) { if (t == 8 || t == 16) E.kmid(t, acc, cur, wr, wc, fr, fq); }
            const bool last = (t == nt - 2);
            const char* a1 = cA + (size_t)(t + 1) * kstep;
            const char* a2 = last ? nA : cA + (size_t)(t + 2) * kstep; const char* b2 = last ? nB : cB + (size_t)(t + 2) * kstep;
            const char* a3 = a2 + kstep; const char* b3 = b2 + kstep;
            if (last && has_next) S.a_ready(nxt);
            unsigned v2[2][2];
            if constexpr (GATHER) { _Pragma("unroll") for (int _h = 0; _h < 2; ++_h) _Pragma("unroll") for (int _i = 0; _i < 2; ++_i) v2[_h][_i] = last ? vAn[_h][_i] : vAc[_h][_i]; }
            if constexpr (SP2) {
            PG8_LDB(B0, 0, 0); PG8_LDB(B1, 0, 1); PG8_SCHED; PG8_LDA(At, 0, 0); PG8_STAGE_A(PG8_SA(1, 1), a1, 1, vAc);
            PG8_WAIT_V(8); PG8_WAIT_L(0); PG8_BAR; PG8_MMA(0, 0, At, B0); PG8_MMA(0, 1, At, B1); PG8_BAR; PG8_SCHED;
            PG8_LDA(At, 0, 1); PG8_STAGE(PG8_SB(0, 0), b2, voffB); PG8_STAGE(PG8_SB(0, 1), b2 + hstep, voffB); PG8_STAGE_A(PG8_SA(0, 0), a2, 0, v2);
            PG8_WAIT_V(8); PG8_WAIT_L(0); PG8_BAR; PG8_MMA(1, 0, At, B0); PG8_MMA(1, 1, At, B1); PG8_BAR; PG8_SCHED;
            PG8_LDB(B0, 1, 0); PG8_LDB(B1, 1, 1); PG8_SCHED; PG8_LDA(At, 1, 0); PG8_STAGE_A(PG8_SA(0, 1), a2, 1, v2);
            PG8_WAIT_V(8); PG8_WAIT_L(0); PG8_BAR; PG8_MMA(0, 0, At, B0); PG8_MMA(0, 1, At, B1); PG8_BAR; PG8_SCHED;
            PG8_LDA(At, 1, 1); PG8_STAGE(PG8_SB(1, 0), b3, voffB); PG8_STAGE(PG8_SB(1, 1), b3 + hstep, voffB); PG8_STAGE_A(PG8_SA(1, 0), a3, 0, v2);
            PG8_WAIT_V(8); PG8_WAIT_L(0); PG8_BAR; PG8_MMA(1, 0, At, B0); PG8_MMA(1, 1, At, B1); PG8_BAR; PG8_SCHED;
            } else {
            PG8_LDB(B0, 0, 0); PG8_SCHED; PG8_LDA(At, 0, 0); PG8_STAGE(PG8_SA(1, 1), a1 + hstep, voffA);
            PG8_WAIT_L(8); PG8_BAR; PG8_WAIT_L(0); PG8_MMA(0, 0, At, B0); PG8_BAR; PG8_SCHED;
            PG8_LDB(B1, 0, 1); PG8_STAGE(PG8_SB(0, 0), b2, voffB);
            PG8_BAR; PG8_WAIT_L(0); PG8_MMA(0, 1, At, B1); PG8_BAR;
            PG8_LDA(At, 0, 1); PG8_STAGE(PG8_SA(0, 0), a2, voffA);
            PG8_BAR; PG8_WAIT_L(0); PG8_MMA(1, 0, At, B0); PG8_BAR; PG8_SCHED;
            PG8_STAGE(PG8_SB(0, 1), b2 + hstep, voffB);
            PG8_WAIT_V(6); PG8_BAR; PG8_MMA(1, 1, At, B1); PG8_BAR;
            PG8_LDB(B0, 1, 0); PG8_SCHED; PG8_LDA(At, 1, 0); PG8_STAGE(PG8_SA(0, 1), a2 + hstep, voffA);
            PG8_WAIT_L(8); PG8_BAR; PG8_WAIT_L(0); PG8_MMA(0, 0, At, B0); PG8_BAR; PG8_SCHED;
            PG8_LDB(B1, 1, 1); PG8_STAGE(PG8_SB(1, 0), b3, voffB);
            PG8_BAR; PG8_WAIT_L(0); PG8_MMA(0, 1, At, B1); PG8_BAR;
            PG8_LDA(At, 1, 1); PG8_STAGE(PG8_SA(1, 0), a3, voffA);
            PG8_BAR; PG8_WAIT_L(0); PG8_MMA(1, 0, At, B0); PG8_BAR; PG8_SCHED;
            PG8_STAGE(PG8_SB(1, 1), b3 + hstep, voffB);
            PG8_WAIT_V(6); PG8_BAR; PG8_MMA(1, 1, At, B1); PG8_BAR;
            }
        }
        if constexpr (ALIGN_EPI) { if (wr == 0) PG8_BAR; }
        if constexpr (!Epi::AFTER_DRAIN) { E(acc, cur, wr, wc, fr, fq); S.done(cur); }
        if (!has_next) break;
#pragma unroll
        for (int a = 0; a < 2; ++a)
#pragma unroll
            for (int b = 0; b < 2; ++b)
#pragma unroll
                for (int m = 0; m < 4; ++m)
#pragma unroll
                    for (int n = 0; n < 2; ++n) acc[a][b][m][n] = (f32x4){0.f, 0.f, 0.f, 0.f};
        cur = nxt; cA = nA; cB = nB; ++ui;
        if constexpr (GATHER) { _Pragma("unroll") for (int _h = 0; _h < 2; ++_h) _Pragma("unroll") for (int _i = 0; _i < 2; ++_i) vAc[_h][_i] = vAn[_h][_i]; }
        if constexpr (ALIGN_EPI) { if (wr == 1) PG8_BAR; }
    }
    PG8_WAIT_V(0);
    if constexpr (!ALIGN_EPI) { if (wr == 0) PG8_BAR; }
    PG8_BAR;
    if constexpr (Epi::AFTER_DRAIN) { E.fused(acc, cur, wr, wc, fr, fq, lds, wid, lane); S.done(cur); }
#undef PG8_SA
#undef PG8_SB
#undef PG8_STAGE
#undef PG8_STAGE_A
#undef PG8_GIDX
#undef PG8_LDA
#undef PG8_LDB
#undef PG8_MMA
#undef PG8_WAIT_V
#undef PG8_WAIT_L
#undef PG8_BAR
#undef PG8_SCHED
}
}
#define XB_TMO      128
#define XB_XCNT(j)  (256  + 64 * (j))
#define XB_XSUB(j)  (1280 + 64 * (j))
#define XB_XGEN(j)  (2304 + 64 * (j))
#define XB_TOP      3328
#define XB_TOPGEN   3392
#define XCD_BAR_WORDS 3456
#define XB_SPIN_CAP (1u << 18)
#define LAS __attribute__((address_space(3)))

__device__ __forceinline__ unsigned xb_ld(unsigned* p)              { return __hip_atomic_load(p, __ATOMIC_RELAXED, __HIP_MEMORY_SCOPE_AGENT); }
__device__ __forceinline__ unsigned xb_add(unsigned* p, unsigned v) { return __hip_atomic_fetch_add(p, v, __ATOMIC_RELAXED, __HIP_MEMORY_SCOPE_AGENT); }
__device__ __forceinline__ unsigned xb_xcc_id() { return (unsigned)__builtin_amdgcn_s_getreg((3 << 11) | 20) & 0xFu; }
#define XB_SPIN(cond, bar) do { unsigned _sp = 0; while (cond) { __builtin_amdgcn_s_sleep(1); \
    if ((++_sp & 255u) == 0u) { if (xb_ld(&(bar)[XB_TMO])) break; if (_sp > XB_SPIN_CAP) { atomicAdd(&(bar)[XB_TMO], 1u); break; } } } } while (0)

struct XcdBarrier {
    unsigned* bar; unsigned x;
    volatile LAS unsigned* st;
};

__device__ __forceinline__ XcdBarrier xcd_barrier_post(unsigned* bar, volatile LAS unsigned* st) {
    XcdBarrier b; b.bar = bar; b.x = xb_xcc_id(); b.st = st;
    if (threadIdx.x == 0) (void)xb_add(&bar[XB_XCNT(b.x)], 1u);
    return b;
}
__device__ __forceinline__ void xcd_barrier_complete(unsigned* bar, unsigned x, unsigned& nloc, unsigned& nx) {
    const unsigned G = gridDim.x * gridDim.y * gridDim.z;
    unsigned sum, cnt, mine, sp = 0u;
    for (;;) {
        sum = 0u; cnt = 0u; mine = 0u;
#pragma unroll
        for (unsigned j = 0; j < 16; ++j) { const unsigned c = xb_ld(&bar[XB_XCNT(j)]); sum += c; cnt += (c > 0u) ? 1u : 0u; mine = (j == x) ? c : mine; }
        if (sum == G) break;
        __builtin_amdgcn_s_sleep(1);
        if ((++sp & 255u) == 0u) { if (xb_ld(&bar[XB_TMO])) break; if (sp > XB_SPIN_CAP) { atomicAdd(&bar[XB_TMO], 1u); break; } }
    }
    nloc = mine > 0u ? mine : 1u; nx = cnt > 0u ? cnt : 1u;
}

__device__ __forceinline__ void xcd_barrier(const XcdBarrier& b) {
    asm volatile("s_waitcnt vmcnt(0)" ::: "memory");
    __syncthreads();
    if (threadIdx.x == 0) {
        unsigned* bar = b.bar;
        __builtin_amdgcn_s_waitcnt(0);
        unsigned nloc = b.st[0], nx = b.st[1];
        if (nloc == 0u) { xcd_barrier_complete(bar, b.x, nloc, nx); b.st[0] = nloc; b.st[1] = nx; }
        const unsigned old = xb_add(&bar[XB_XSUB(b.x)], 1u);
        const unsigned gen = old / nloc;
        if (old + 1u == (gen + 1u) * nloc) {
            __builtin_amdgcn_fence(__ATOMIC_RELEASE, "agent");
            asm volatile("s_waitcnt vmcnt(0)" ::: "memory");
            const unsigned og = xb_add(&bar[XB_TOP], 1u);
            const unsigned tg = og / nx;
            if (og + 1u == (tg + 1u) * nx) xb_add(&bar[XB_TOPGEN], 1u);
            else XB_SPIN(xb_ld(&bar[XB_TOPGEN]) == tg, bar);
            __builtin_amdgcn_fence(__ATOMIC_ACQUIRE, "agent");
            xb_add(&bar[XB_XGEN(b.x)], 1u);
            asm volatile("s_waitcnt vmcnt(0)" ::: "memory");
        } else {
            XB_SPIN(xb_ld(&bar[XB_XGEN(b.x)]) == gen, bar);
            __builtin_amdgcn_fence(__ATOMIC_ACQUIRE, "agent");
            asm volatile("s_waitcnt vmcnt(0)" ::: "memory");
        }
    }
    __syncthreads();
}

#define GAS __attribute__((address_space(1)))
typedef unsigned short bf16;
typedef float f32x4 __attribute__((ext_vector_type(4)));
typedef unsigned u32x4 __attribute__((ext_vector_type(4)));
typedef unsigned u32x2 __attribute__((ext_vector_type(2)));
constexpr int DM = 1024, NB = 8, SEQ = 4096, CTXL = 256, NLAT = NB * SEQ, NCTX = NB * CTXL, NROWS = NLAT + NCTX;
constexpr int INC = 7424;
constexpr int C_RQ = 0, C_RK = 512, C_RV = 1024, C_RG = 1536, C_AQ = 2048, C_AK = 2560, C_AV = 2688, C_HU = 2816, C_MG = 4352;
constexpr int NEXP = 32, DFF = 1024;
constexpr int MPAD = 147456;
constexpr float EPS = 1e-6f;
constexpr int NWAVES = 8, NTHR = 512;
constexpr int LDS_BYTES = 163840, LDSX = 155648, LDS_SRC = 131072;
constexpr int NPH_LAYER = 14, NPH = 1 + 2 * NPH_LAYER + 1;

constexpr size_t MiB = 1u << 20;
constexpr size_t WS_CTL = 0, CTL_ZERO_BYTES = 1 * MiB;
constexpr size_t CTL_BAR = 16384;
constexpr size_t CTL_MOD = 262144;
constexpr size_t WS_SRC = 6 * MiB;
constexpr size_t WS_L1P = 5 * MiB;
constexpr size_t WS_TOPI = 1 * MiB, WS_TOPW = 2 * MiB, WS_POS = 3 * MiB, WS_BLKCNT = 4 * MiB, WS_TILES = 4 * MiB + 65536;
constexpr size_t WS_WIN = 8 * MiB, WS_WBR = 37 * MiB, WS_WOUT = 43 * MiB, WS_W1 = 48 * MiB, WS_W2 = 304 * MiB;
constexpr size_t WS_HF = 432 * MiB;
constexpr size_t WS_HFC = 464 * MiB;
constexpr size_t WS_XM = 466 * MiB, WS_XO = 602 * MiB, WS_XN = 738 * MiB;
constexpr size_t WS_A = 806 * MiB;
constexpr size_t WS_P = WS_A, WS_RET = WS_A + 494 * MiB, WS_ATT = WS_RET + 34 * MiB, WS_HY = WS_ATT + 34 * MiB;
constexpr size_t WS_HS = WS_A, WS_ACT = WS_A + 288 * MiB;
constexpr size_t WS_MF32 = 1406 * MiB, WS_M = 1542 * MiB;
constexpr size_t WS_ZT = 1610 * MiB, WS_ZTC = 1674 * MiB, WS_YT = 1678 * MiB, WS_YTC = 1742 * MiB;
constexpr size_t WS_KV = 1746 * MiB, WS_SP = 1882 * MiB, WS_HSPEC = 1950 * MiB, WS_END = 2014 * MiB;
static_assert(WS_HY + 34 * MiB <= WS_MF32 && WS_ACT + 288 * MiB <= WS_MF32, "region A");
static_assert((size_t)NROWS * INC * 2 <= 494 * MiB, "P size");

__device__ __forceinline__ float bf2f(bf16 v) { return __uint_as_float(((unsigned)v) << 16); }
__device__ __forceinline__ bf16 f2bf(float f) { unsigned u = __float_as_uint(f); u += 0x7FFFu + ((u >> 16) & 1u); return (bf16)(u >> 16); }
__device__ __forceinline__ unsigned pk2(float lo, float hi) { return pg8::cvt_pk_bf16(lo, hi); }
__device__ __forceinline__ float wave_sum(float v) {
#pragma unroll
    for (int o = 1; o < 64; o <<= 1) v += __shfl_xor(v, o);
    return v;
}
__device__ __forceinline__ float rdlane(float v, int l) { return __int_as_float(__builtin_amdgcn_readlane(__float_as_int(v), l)); }
__device__ __forceinline__ float sin_rev(float rev) { return __builtin_amdgcn_sinf(__builtin_amdgcn_fractf(rev)); }
__device__ __forceinline__ float cos_rev(float rev) { return __builtin_amdgcn_cosf(__builtin_amdgcn_fractf(rev)); }
__device__ __forceinline__ float sin_rad(float x) { return sin_rev(x * 0.15915494309189535f); }
__device__ __forceinline__ float sigmoidf_(float x) { return 1.0f / (1.0f + __expf(-x)); }
__device__ __forceinline__ float siluf_(float x) { return x / (1.0f + __expf(-x)); }
__device__ __forceinline__ float log_sigmoid_(float x) {
    const float y = __expf(-x);
    if (y < 0.1f) { return -(y * (1.0f + y * (-0.5f + y * (0.33333333f + y * (-0.25f + y * (0.2f + y * (-0.16666667f + y * (0.14285714f + y * (-0.125f))))))))); }
    return -logf(1.0f + y);
}
#define LDS_WAIT() asm volatile("s_waitcnt lgkmcnt(0)" ::: "memory")
#define VM_WAIT() asm volatile("s_waitcnt vmcnt(0)" ::: "memory")

struct Args { const float* in[31]; float* out; unsigned char* ws; int ph_lo, ph_hi; };

extern __shared__ __attribute__((aligned(16))) unsigned char lds_raw[];
constexpr int LDS_PTAB = LDSX + 1024;
struct Frame {
    LAS unsigned char* lds;
    int tid, lane, wave, G, bx;
    unsigned char* ws;
};
__device__ __forceinline__ unsigned long long ptab_read(int i) {
    const LAS unsigned* p = (const LAS unsigned*)((LAS unsigned char*)lds_raw + LDS_PTAB) + 2 * i;
    const unsigned lo = (unsigned)__builtin_amdgcn_readfirstlane((int)p[0]), hi = (unsigned)__builtin_amdgcn_readfirstlane((int)p[1]);
    return ((unsigned long long)hi << 32) | lo;
}
__device__ __forceinline__ const float* IN_(const Frame& F, int i) { return (const float*)ptab_read(i); }
__device__ __forceinline__ float* OUT_(const Frame& F) { return (float*)ptab_read(31); }
__device__ __forceinline__ Frame make_frame() {
    Frame F; F.lds = (LAS unsigned char*)lds_raw;
    int t = threadIdx.x; asm volatile("" : "+v"(t)); F.tid = t; F.lane = t & 63; F.wave = __builtin_amdgcn_readfirstlane(t >> 6);
    int g = gridDim.x, bx = blockIdx.x; asm volatile("" : "+s"(g), "+s"(bx)); F.G = g; F.bx = bx;
    unsigned long long w = ptab_read(32); asm volatile("" : "+s"(w)); F.ws = (unsigned char*)w; return F;
}
template <class T> __device__ __forceinline__ T* WSP(const Frame& F, size_t off) { return (T*)(F.ws + off); }
__device__ __forceinline__ const float* mod_ptr(const Frame& F, int l, int modrow, int chunk) { return WSP<float>(F, WS_CTL + CTL_MOD) + ((size_t)(l * 9 + modrow) * 6 + chunk) * DM; }
__device__ __forceinline__ int modrow_of(int r) { return r < NLAT ? (r >> 12) : 8; }

constexpr int TRP = 65;
__device__ __forceinline__ void tr_item(const float* W, int K, int N, bf16* WT, int ldk, int item, int w1map, LAS float* scr, int lane) {
    const int nblk = N >> 6, kb = item / nblk, nb = item - kb * nblk, k0 = 64 * kb, n0 = 64 * nb;
    const int r = lane >> 4, cq = lane & 15;
    const float* src = W + (size_t)(k0 + r) * N + n0 + 4 * cq;
#pragma unroll 1
    for (int hh = 0; hh < 2; ++hh) {
        f32x4 v[8];
#pragma unroll
        for (int i = 0; i < 8; ++i) v[i] = *(const f32x4*)(src + (size_t)(4 * (8 * hh + i)) * N);
#pragma unroll
        for (int i = 0; i < 8; ++i) { LAS float* d = scr + (4 * (8 * hh + i) + r) * TRP + 4 * cq; d[0] = v[i][0]; d[1] = v[i][1]; d[2] = v[i][2]; d[3] = v[i][3]; }
    }
    LDS_WAIT(); asm volatile("" ::: "memory");
    int r0 = n0;
    if (w1map == 1) r0 = (n0 < 1024) ? ((n0 >> 7) * 256 + (n0 & 127)) : ((((n0 - 1024) >> 7) * 256) + 128 + ((n0 - 1024) & 127));
    const int kc = lane & 7;
#pragma unroll
    for (int j = 0; j < 8; ++j) { const int n = (lane >> 3) + 8 * j; const LAS float* s = scr + (8 * kc) * TRP + n;
        u32x4 o; o.x = pk2(s[0 * TRP], s[1 * TRP]); o.y = pk2(s[2 * TRP], s[3 * TRP]); o.z = pk2(s[4 * TRP], s[5 * TRP]); o.w = pk2(s[6 * TRP], s[7 * TRP]);
        int row = r0 + n;
        if (w1map == 2) {
            const int c = n0 + n;
            if (c < 1024) row = (c & ~255) + ((c >> 6) & 1) * 128 + ((c >> 7) & 1) * 64 + (c & 63);
            else if (c >= C_AQ && c < C_AV) { const int d = c & 63, gq = d >> 4, hd = (c >> 6) & 3; row = (c & ~255) + (gq & 1) * 128 + hd * 32 + (gq >> 1) * 16 + (d & 15); }
            else if (c >= C_AV && c < C_HU) { const int jv = c - C_AV; row = C_AK + (jv >> 6) * 128 + 64 + (jv & 63); }
        }
        *(u32x4*)(WT + (size_t)row * ldk + k0 + 8 * kc) = o; }
    LDS_WAIT(); asm volatile("" ::: "memory");
}

__device__ __forceinline__ void p0_prologue(Frame& F) {
    LAS float* scr = (LAS float*)(F.lds + F.wave * (64 * TRP * 4));
    const int gw = F.bx * NWAVES + F.wave, NGW = F.G * NWAVES, lane = F.lane;
    constexpr int I_WIN = 16 * 116, I_WBR = 8 * 16, I_WOUT = 16 * 16, I_W1 = 16 * 32, I_W2 = 16 * 16;
    constexpr int N_WIN = 2 * I_WIN, N_WBR = 6 * I_WBR, N_WOUT = 2 * I_WOUT, N_W1 = 64 * I_W1, N_W2 = 64 * I_W2;
    constexpr int NTR = N_WIN + N_WBR + N_WOUT + N_W1 + N_W2;
#pragma unroll 1
    for (int it = gw; it < NTR; it += NGW) {
        int r = it; const float* W; bf16* WT; int K, N, item, w1map = 0, ldk = 1024;
        if (r < N_WIN) { const int l = r / I_WIN; W = IN_(F, 7) + (size_t)l * 1024 * INC; K = 1024; N = INC; WT = WSP<bf16>(F, WS_WIN) + (size_t)l * INC * 1024; item = r % I_WIN; w1map = 2; }
        else if ((r -= N_WIN) < N_WBR) { const int q = r / I_WBR; W = IN_(F, 20) + (size_t)q * 512 * 1024; K = 512; N = 1024; WT = WSP<bf16>(F, WS_WBR) + (size_t)(q / 3) * 1024 * 1536 + (q % 3) * 512; ldk = 1536; item = r % I_WBR; }
        else if ((r -= N_WBR) < N_WOUT) { const int l = r / I_WOUT; W = IN_(F, 22) + (size_t)l * 1024 * 1024; K = 1024; N = 1024; WT = WSP<bf16>(F, WS_WOUT) + (size_t)l * 1024 * 1024; item = r % I_WOUT; }
        else if ((r -= N_WOUT) < N_W1) { const int q = r / I_W1; W = IN_(F, 26) + (size_t)q * 1024 * 2048; K = 1024; N = 2048; WT = WSP<bf16>(F, WS_W1) + (size_t)q * 2048 * 1024; item = r % I_W1; w1map = 1; }
        else { r -= N_W1; const int q = r / I_W2; W = IN_(F, 28) + (size_t)q * 1024 * 1024; K = 1024; N = 1024; WT = WSP<bf16>(F, WS_W2) + (size_t)q * 1024 * 1024; item = r % I_W2; }
        tr_item(W, K, N, WT, ldk, item, w1map, scr, lane);
    }
#ifndef PRO_B
#define PRO_B 1
#endif
#ifndef PRO_C
#define PRO_C 1
#endif
    __syncthreads();
    if (PRO_B) {
        float* mod = WSP<float>(F, WS_CTL + CTL_MOD);
        LAS float* sc = (LAS float*)F.lds;
        LAS float* red = sc + 1024 * 12;
        if (F.bx < 192) {
            for (int i = F.tid; i < 9 * 1024; i += NTHR) { const int r = i >> 10, k = i & 1023; const float cv = (r < 8) ? IN_(F, 1)[r * 1024 + k] : IN_(F, 3)[k]; sc[k * 12 + r] = siluf_(cv); }
            __syncthreads();
            const int it = F.bx, l = it / 96, cc = it % 96, col = cc * 64 + lane, k0 = F.wave * 128;
            const float* wm = IN_(F, 4) + (size_t)l * 1024 * 6144 + col;
            float acc[9];
#pragma unroll
            for (int r = 0; r < 9; ++r) acc[r] = 0.f;
#pragma unroll 1
            for (int kb = 0; kb < 128; kb += 16) {
                float w[16];
#pragma unroll
                for (int k = 0; k < 16; ++k) w[k] = wm[(size_t)(k0 + kb + k) * 6144];
#pragma unroll
                for (int k = 0; k < 16; ++k) { const LAS float* s = sc + (k0 + kb + k) * 12; const f32x4 s0 = *(const LAS f32x4*)s, s1 = *(const LAS f32x4*)(s + 4); const float s8 = s[8];
                    acc[0] += s0[0] * w[k]; acc[1] += s0[1] * w[k]; acc[2] += s0[2] * w[k]; acc[3] += s0[3] * w[k];
                    acc[4] += s1[0] * w[k]; acc[5] += s1[1] * w[k]; acc[6] += s1[2] * w[k]; acc[7] += s1[3] * w[k]; acc[8] += s8 * w[k]; }
            }
#pragma unroll
            for (int r = 0; r < 9; ++r) red[(F.wave * 9 + r) * 64 + lane] = acc[r];
            __syncthreads();
            for (int idx = F.tid; idx < 576; idx += NTHR) { const int r = idx >> 6, c = idx & 63; float s = 0.f;
#pragma unroll
                for (int w = 0; w < 8; ++w) s += red[(w * 9 + r) * 64 + c];
                mod[(size_t)(l * 9 + r) * 6144 + cc * 64 + c] = s + IN_(F, 5)[l * 6144 + cc * 64 + c]; }
        }
    }
    if (PRO_C) {
        float* L1P = WSP<float>(F, WS_L1P);
        LAS float* H2 = (LAS float*)F.lds + 16384;
        LAS float* red = H2 + 32 * 64;
#pragma unroll 1
        for (int it = F.bx; it < 128 + 128 + 8; it += F.G) {
            const int f = it < 128 ? 0 : (it < 256 ? 1 : 2), tb = it - (f == 0 ? 0 : (f == 1 ? 128 : 256));
            const int L = (f == 2) ? 256 : 4096, l = (f == 1) ? 1 : 0;
            const float* w1 = IN_(F, 12) + l * 33 * 64; const float* b1 = IN_(F, 13) + l * 64; const float* f1 = IN_(F, 14) + l * 64;
            const float* w2 = IN_(F, 15) + l * 64 * 64; const float* b2 = IN_(F, 16) + l * 64; const float* f2 = IN_(F, 17) + l * 64;
            const float* w3 = IN_(F, 18) + (size_t)l * 64 * 1024;
            float* HFp = (f == 2) ? WSP<float>(F, WS_HFC) : WSP<float>(F, WS_HF + (size_t)l * 16 * MiB);
            float* HBp = (f == 2) ? WSP<float>(F, WS_HFC + 512 * 1024) : WSP<float>(F, WS_HF + (size_t)l * 16 * MiB + 8 * MiB);
            __syncthreads();
#pragma unroll 1
            for (int r = 0; r < 4; ++r) {
                const int n = tb * 32 + F.wave * 4 + r;
                float zl = 0.f;
                if (lane == 0) zl = (float)n / (float)(L - 1);
                else if (lane <= 32) { const int j = (lane - 1) & 15; const float band = 1e-4f + (15.0f - 1e-4f) * (float)j / 15.0f; const float rev = (float)n * band / (float)L;
                    zl = (lane <= 16) ? cos_rev(rev) : -sin_rev(rev); }
                float a = 0.f;
#pragma unroll 1
                for (int i = 0; i < 33; ++i) a += __shfl(zl, i) * w1[i * 64 + lane];
                const float h1 = sin_rad(f1[lane] * (a + b1[lane]));
                float a2 = 0.f;
#pragma unroll 4
                for (int i = 0; i < 64; ++i) a2 += __shfl(h1, i) * w2[i * 64 + lane];
                H2[(F.wave * 4 + r) * 64 + lane] = sin_rad(f2[lane] * (a2 + b2[lane]));
            }
            __syncthreads();
            const int c1 = F.wave * 128 + lane, c2 = c1 + 64;
            float l1p[2] = {0.f, 0.f};
#pragma unroll 1
            for (int rh = 0; rh < 2; ++rh) {
                float acc[16][2];
#pragma unroll
                for (int r = 0; r < 16; ++r) { acc[r][0] = 0.f; acc[r][1] = 0.f; }
#pragma unroll 1
                for (int i = 0; i < 64; i += 4) {
                    float wa[4], wb[4];
#pragma unroll
                    for (int k = 0; k < 4; ++k) { wa[k] = w3[(i + k) * 1024 + c1]; wb[k] = w3[(i + k) * 1024 + c2]; }
#pragma unroll
                    for (int r = 0; r < 16; ++r) { const f32x4 h = *(const LAS f32x4*)(H2 + (rh * 16 + r) * 64 + i);
                        acc[r][0] += h[0] * wa[0] + h[1] * wa[1] + h[2] * wa[2] + h[3] * wa[3]; acc[r][1] += h[0] * wb[0] + h[1] * wb[1] + h[2] * wb[2] + h[3] * wb[3]; }
                }
#pragma unroll
                for (int q = 0; q < 2; ++q) {
                    const int c = q ? c2 : c1, cc = c & 511;
                    const float delta = 3.0701134573253944f + (15.350567286626973f - 3.0701134573253944f) * (float)cc / 511.0f;
                    float* dst = ((c < 512) ? HFp : HBp) + (size_t)(tb * 32 + rh * 16) * 512 + cc;
#pragma unroll
                    for (int r = 0; r < 16; ++r) { const int n = tb * 32 + rh * 16 + r; const float tn = (float)n / (float)(L - 1); const float v = acc[r][q] * __expf(-tn * delta);
                        dst[r * 512] = v;
                        if (c < 512 || n >= 1) l1p[q] += fabsf(v); }
                }
            }
            red[c1] = l1p[0]; red[c2] = l1p[1];
            __syncthreads();
            L1P[(size_t)(f * 128 + tb) * 512 + F.tid] = red[F.tid] + red[512 + F.tid];
        }
    }
}
__device__ __forceinline__ float hy_inv_l1(const Frame& F, int f, int c) {
    const float* L1P = WSP<float>(F, WS_L1P) + (size_t)f * 128 * 512 + c; const int nb = (f == 2) ? 8 : 128; const int lane = F.lane;
    float s = (lane < nb ? L1P[(size_t)lane * 512] : 0.f) + (lane + 64 < nb ? L1P[(size_t)(lane + 64) * 512] : 0.f);
    return 1.0f / wave_sum(s);
}

__device__ __forceinline__ void ph_norm1(Frame& F, int mode) {
    const int gw = F.bx * NWAVES + F.wave, NGW = F.G * NWAVES, lane = F.lane;
    const int nrows = (mode == 2) ? NLAT : NROWS;
    const int l = (mode == 0) ? 0 : 1;
    const bf16* Y = WSP<bf16>(F, WS_HS);
    const int* POS = WSP<int>(F, WS_POS); const float* TOPW = WSP<float>(F, WS_TOPW);
    for (int r = gw; r < nrows; r += NGW) {
        const int mr = modrow_of(r);
        f32x4 v[4];
        if (mode == 0) {
            const float* xr = (r < NLAT) ? IN_(F, 0) + (size_t)r * DM : IN_(F, 2) + (size_t)(r - NLAT) * DM;
#pragma unroll
            for (int j = 0; j < 4; ++j) v[j] = *(const f32x4*)(xr + 4 * lane + 256 * j);
        } else {
            const float* xm = WSP<float>(F, WS_XM) + (size_t)r * DM;
            const float* g2 = mod_ptr(F, 0, mr, 5);
            f32x4 s[4];
#pragma unroll
            for (int j = 0; j < 4; ++j) s[j] = (f32x4){0.f, 0.f, 0.f, 0.f};
#pragma unroll
            for (int k = 0; k < 4; ++k) {
                const int p = POS[r * 4 + k]; const float w = TOPW[r * 4 + k];
                const bf16* yr = Y + (size_t)p * DM;
#pragma unroll
                for (int j = 0; j < 4; ++j) { const u32x2 y2 = *(const u32x2*)(yr + 4 * lane + 256 * j);
                    s[j][0] += w * __uint_as_float(y2.x << 16); s[j][1] += w * __uint_as_float(y2.x & 0xffff0000u);
                    s[j][2] += w * __uint_as_float(y2.y << 16); s[j][3] += w * __uint_as_float(y2.y & 0xffff0000u); }
            }
            if (mode == 2) {   }
            const float* g2l = (mode == 2) ? mod_ptr(F, 1, mr, 5) : g2;
#pragma unroll
            for (int j = 0; j < 4; ++j) { const f32x4 x = *(const f32x4*)(xm + 4 * lane + 256 * j); const f32x4 g = *(const f32x4*)(g2l + 4 * lane + 256 * j); v[j] = x + g * s[j]; }
            if (mode == 1) { float* xo = WSP<float>(F, WS_XO) + (size_t)r * DM;
#pragma unroll
                for (int j = 0; j < 4; ++j) *(f32x4*)(xo + 4 * lane + 256 * j) = v[j]; }
        }
        float ss = 0.f;
#pragma unroll
        for (int j = 0; j < 4; ++j) ss += (v[j][0] * v[j][0] + v[j][1] * v[j][1]) + (v[j][2] * v[j][2] + v[j][3] * v[j][3]);
        const float rstd = 1.0f / sqrtf(wave_sum(ss) * (1.0f / DM) + EPS);
        if (mode == 2) {
            const float* fg = IN_(F, 30); float* o = OUT_(F) + (size_t)r * DM;
#pragma unroll
            for (int j = 0; j < 4; ++j) { const f32x4 g = *(const f32x4*)(fg + 4 * lane + 256 * j); *(f32x4*)(o + 4 * lane + 256 * j) = v[j] * rstd * g; }
        } else {
            const float* gw_ = IN_(F, 6) + l * DM; const float* sh = mod_ptr(F, l, mr, 0); const float* sc = mod_ptr(F, l, mr, 1);
            bf16* o = WSP<bf16>(F, WS_XN) + (size_t)r * DM;
#pragma unroll
            for (int j = 0; j < 4; ++j) { const f32x4 g = *(const f32x4*)(gw_ + 4 * lane + 256 * j); const f32x4 a = *(const f32x4*)(sh + 4 * lane + 256 * j); const f32x4 b = *(const f32x4*)(sc + 4 * lane + 256 * j);
                const f32x4 y = v[j] * rstd * g * (b + 1.0f) + a;
                u32x2 w2; w2.x = pk2(y[0], y[1]); w2.y = pk2(y[2], y[3]); *(u32x2*)(o + 4 * lane + 256 * j) = w2; }
        }
    }
}

struct EpiP {
    static constexpr bool PERM = true, AFTER_DRAIN = false, KMID = false;
    bf16* O;
    __device__ __forceinline__ static void st8(bf16* p, const float (&v)[8]) { u32x4 w; w.x = pk2(v[0], v[1]); w.y = pk2(v[2], v[3]); w.z = pk2(v[4], v[5]); w.w = pk2(v[6], v[7]); *(u32x4*)p = w; }
    __device__ __forceinline__ void operator()(const f32x4 (&acc)[2][2][4][2], const pg8::Unit& u, int wr, int wc, int fr, int fq) const {
        const int row0 = u.pm * 256 + wr * 64 + fr, pn = u.pn;
        const bool rot = u.pm < (NLAT / 256);
        const bool is_ret = pn < 4, is_aq = (pn == 8 || pn == 9), is_akv = (pn == 10);
        if (!(is_ret || is_aq || is_akv) || (is_akv && wc >= 2)) {
            const int colA = is_akv ? (C_AV + (wc - 2) * 32 + 8 * fq) : (pn * 256 + wc * 32 + 8 * fq), colB = is_akv ? (colA + 64) : (colA + 128);
#pragma unroll
            for (int ai = 0; ai < 2; ++ai)
#pragma unroll
                for (int m = 0; m < 4; ++m) { bf16* rowp = O + (size_t)(row0 + ai * 128 + m * 16) * INC;
                    float a[8], b[8];
#pragma unroll
                    for (int j = 0; j < 4; ++j) { a[j] = acc[ai][0][m][0][j]; a[4 + j] = acc[ai][0][m][1][j]; b[j] = acc[ai][1][m][0][j]; b[4 + j] = acc[ai][1][m][1][j]; }
                    st8(rowp + colA, a); st8(rowp + colB, b); asm volatile("" ::: "memory"); }
            return;
        }
        int col1, col2, ibase; float fexp; bool use_col = false;
        if (is_ret) { const int hd = wc >> 1; ibase = (wc & 1) * 32 + 8 * fq; col1 = pn * 256 + hd * 128 + ibase; col2 = col1 + 64; fexp = 13.287712379549449f / 63.0f; }
        else { const int rc = fq >> 1; ibase = 8 * (fq & 1); const int hb = is_aq ? (pn * 256 + wc * 64) : (C_AK + wc * 64); col1 = hb + rc * 32 + ibase; col2 = col1 + 16; fexp = 13.287712379549449f / 16.0f; use_col = rc != 0; }
        float invf[8];
#pragma unroll
        for (int k = 0; k < 8; ++k) invf[k] = __builtin_amdgcn_exp2f(-(float)(ibase + k) * fexp) * 0.15915494309189535f;
#pragma unroll
        for (int ai = 0; ai < 2; ++ai)
#pragma unroll
            for (int m = 0; m < 4; ++m) { const int row = row0 + ai * 128 + m * 16; bf16* rowp = O + (size_t)row * INC;
                const int t = row & 4095;
                const float pos = is_ret ? (float)t : (use_col ? (float)(t & 63) : (float)(t >> 6));
                float o1[8], o2[8];
#pragma unroll
                for (int k = 0; k < 8; ++k) { const float x1 = acc[ai][0][m][k >> 2][k & 3], x2 = acc[ai][1][m][k >> 2][k & 3];
                    float cs = 1.0f, sn = 0.0f;
                    if (rot) { const float rev = pos * invf[k]; cs = cos_rev(rev); sn = sin_rev(rev); }
                    o1[k] = x1 * cs - x2 * sn; o2[k] = x1 * sn + x2 * cs; }
                st8(rowp + col1, o1); st8(rowp + col2, o2); asm volatile("" ::: "memory"); }
    }
};
struct EpiMerge {
    static constexpr bool PERM = true, AFTER_DRAIN = false, KMID = true;
    const bf16* P; const float* bgate; bf16* Mo;
    __device__ __forceinline__ void den8(unsigned poff, unsigned boff, float (&d)[8]) const {
        const u32x4 g = *(const u32x4*)((const char*)P + poff);
        const f32x4 b0 = *(const f32x4*)(bgate + boff), b1 = *(const f32x4*)(bgate + boff + 4);
        const unsigned gw[4] = {g.x, g.y, g.z, g.w};
#pragma unroll
        for (int i = 0; i < 4; ++i) { const float z0 = __uint_as_float(gw[i] << 16) + (i < 2 ? b0[2 * i] : b1[2 * i - 4]), z1 = __uint_as_float(gw[i] & 0xffff0000u) + (i < 2 ? b0[2 * i + 1] : b1[2 * i - 3]);
            d[2 * i] = 1.0f + __builtin_amdgcn_exp2f(-1.4426950408889634f * z0); d[2 * i + 1] = 1.0f + __builtin_amdgcn_exp2f(-1.4426950408889634f * z1); }
    }
    __device__ __forceinline__ void kmid(int t, f32x4 (&acc)[2][2][4][2], const pg8::Unit& u, int wr, int wc, int fr, int fq) const {
        int row0 = u.pm * 256 + wr * 64 + fr; asm volatile("" : "+v"(row0));
        const unsigned col0 = (unsigned)(u.pn * 256 + wc * 32 + 8 * fq), g_old = (t == 8) ? 0u : 1u;
#pragma unroll
        for (int ai = 0; ai < 2; ++ai)
#pragma unroll
            for (int m = 0; m < 4; ++m) { const unsigned rowb = (unsigned)(row0 + ai * 128 + m * 16) * (unsigned)(INC * 2);
#pragma unroll
                for (int bj = 0; bj < 2; ++bj) { float dn[8], dd[8]; const unsigned c = col0 + bj * 128;
                    den8(rowb + (C_MG + (g_old + 1) * 1024 + c) * 2, (g_old + 1) * 1024 + c, dn); den8(rowb + (C_MG + g_old * 1024 + c) * 2, g_old * 1024 + c, dd);
#pragma unroll
                    for (int k = 0; k < 8; ++k) acc[ai][bj][m][k >> 2][k & 3] *= dn[k] * __builtin_amdgcn_rcpf(dd[k]); }
                asm volatile("" ::: "memory"); }
    }
    __device__ __forceinline__ void operator()(const f32x4 (&acc)[2][2][4][2], const pg8::Unit& u, int wr, int wc, int fr, int fq) const {
        int row0 = u.pm * 256 + wr * 64 + fr; asm volatile("" : "+v"(row0));
        const unsigned col0 = (unsigned)(u.pn * 256 + wc * 32 + 8 * fq);
#pragma unroll
        for (int ai = 0; ai < 2; ++ai)
#pragma unroll
            for (int m = 0; m < 4; ++m) { const unsigned row = (unsigned)(row0 + ai * 128 + m * 16), rowb = row * (unsigned)(INC * 2);
#pragma unroll
                for (int bj = 0; bj < 2; ++bj) { float dh[8], v[8]; const unsigned c = col0 + bj * 128; den8(rowb + (C_MG + 2 * 1024 + c) * 2, 2 * 1024 + c, dh);
#pragma unroll
                    for (int k = 0; k < 8; ++k) v[k] = acc[ai][bj][m][k >> 2][k & 3] * __builtin_amdgcn_rcpf(dh[k]);
                    u32x4 w; w.x = pk2(v[0], v[1]); w.y = pk2(v[2], v[3]); w.z = pk2(v[4], v[5]); w.w = pk2(v[6], v[7]);
                    *(u32x4*)((char*)Mo + (row * (unsigned)(DM * 2) + c * 2)) = w; }
                asm volatile("" ::: "memory"); }
    }
};
struct EpiOut {
    static constexpr bool PERM = false, AFTER_DRAIN = false, KMID = false;
    const float* xlat; const float* xctx; const float* g1base; float* XM;
    __device__ __forceinline__ void operator()(const f32x4 (&acc)[2][2][4][2], const pg8::Unit& u, int wr, int wc, int fr, int fq) const {
        const int row0 = u.pm * 256 + wr * 64 + fr, col0 = u.pn * 256 + wc * 32 + 4 * fq;
#pragma unroll
        for (int ai = 0; ai < 2; ++ai)
#pragma unroll
            for (int m = 0; m < 4; ++m) { const int row = row0 + ai * 128 + m * 16;
                const float* xr = (row < NLAT) ? xlat + (size_t)row * DM : xctx + (size_t)(row - NLAT) * DM;
                const float* g1 = g1base + (size_t)modrow_of(row) * 6 * DM;
#pragma unroll
                for (int bj = 0; bj < 2; ++bj)
#pragma unroll
                    for (int n = 0; n < 2; ++n) { const int col = col0 + bj * 128 + n * 16;
                        const f32x4 x = *(const f32x4*)(xr + col), g = *(const f32x4*)(g1 + col);
                        *(f32x4*)(XM + (size_t)row * DM + col) = x + g * acc[ai][bj][m][n]; } }
    }
};
struct EpiMoe1 {
    static constexpr bool PERM = true, AFTER_DRAIN = false, KMID = false;
    const float* b1; bf16* ACT;
    __device__ __forceinline__ void operator()(const f32x4 (&acc)[2][2][4][2], const pg8::Unit& u, int wr, int wc, int fr, int fq) const {
        const int e = u.pn >> 3, p = u.pn & 7;
        const int row0 = u.pm * 256 + wr * 64 + fr, gcol0 = p * 128 + wc * 32 + 8 * fq;
        const float* bb = b1 + (size_t)e * 2048 + gcol0;
#pragma unroll
        for (int ai = 0; ai < 2; ++ai)
#pragma unroll
            for (int m = 0; m < 4; ++m) { bf16* rowp = ACT + (size_t)(row0 + ai * 128 + m * 16) * DFF + gcol0;
                unsigned w[4];
#pragma unroll
                for (int n = 0; n < 2; ++n) { const f32x4 bg = *(const f32x4*)(bb + 4 * n), bl = *(const f32x4*)(bb + 1024 + 4 * n);
                    float a[4];
#pragma unroll
                    for (int j = 0; j < 4; ++j) { float glu = acc[ai][0][m][n][j] + bg[j]; float lin = acc[ai][1][m][n][j] + bl[j];
                        glu = fminf(glu, 7.0f); lin = fminf(fmaxf(lin, -7.0f), 7.0f);
                        a[j] = glu * __builtin_amdgcn_rcpf(1.0f + __builtin_amdgcn_exp2f(-2.4554669595930156f * glu)) * (lin + 1.0f); }
                    w[2 * n] = pk2(a[0], a[1]); w[2 * n + 1] = pk2(a[2], a[3]); }
                u32x4 wv; wv.x = w[0]; wv.y = w[1]; wv.z = w[2]; wv.w = w[3];
                *(u32x4*)rowp = wv;
                asm volatile("" ::: "memory"); }
    }
};
struct EpiMoe2 {
    static constexpr bool PERM = true, AFTER_DRAIN = false, KMID = false;
    const float* b2; bf16* Y;
    __device__ __forceinline__ void operator()(const f32x4 (&acc)[2][2][4][2], const pg8::Unit& u, int wr, int wc, int fr, int fq) const {
        const int e = u.pn >> 2, p = u.pn & 3;
        const int row0 = u.pm * 256 + wr * 64 + fr, col0 = p * 256 + wc * 32 + 8 * fq;
        f32x4 bv[2][2];
#pragma unroll
        for (int bj = 0; bj < 2; ++bj)
#pragma unroll
            for (int n = 0; n < 2; ++n) bv[bj][n] = *(const f32x4*)(b2 + (size_t)e * 1024 + col0 + bj * 128 + 4 * n);
#pragma unroll
        for (int ai = 0; ai < 2; ++ai)
#pragma unroll
            for (int m = 0; m < 4; ++m) { bf16* rowp = Y + (size_t)(row0 + ai * 128 + m * 16) * DM + col0;
#pragma unroll
                for (int bj = 0; bj < 2; ++bj) { const f32x4 v0 = acc[ai][bj][m][0] + bv[bj][0], v1 = acc[ai][bj][m][1] + bv[bj][1];
                    u32x4 w; w.x = pk2(v0[0], v0[1]); w.y = pk2(v0[2], v0[3]); w.z = pk2(v1[0], v1[1]); w.w = pk2(v1[2], v1[3]);
                    *(u32x4*)(rowp + bj * 128) = w; } }
    }
};
struct MoeOrder {
    static constexpr bool GATHER = false; const LAS int* src;
    const LAS int* list; int n;
    __device__ __forceinline__ bool next(int i, pg8::Unit& u) const { if (i >= n) return false; u.pm = __builtin_amdgcn_readfirstlane(list[2 * i]); u.pn = __builtin_amdgcn_readfirstlane(list[2 * i + 1]); return true; }
    __device__ __forceinline__ void a_ready(const pg8::Unit&) const {}
    __device__ __forceinline__ void done(const pg8::Unit&) const {}
};
struct MoeOrderG {
    static constexpr bool GATHER = true; const LAS int* src;
    const LAS int* list; int n;
    __device__ __forceinline__ bool next(int i, pg8::Unit& u) const { if (i >= n) return false; u.pm = __builtin_amdgcn_readfirstlane(list[2 * i]); u.pn = __builtin_amdgcn_readfirstlane(list[2 * i + 1]); return true; }
    __device__ __forceinline__ void a_ready(const pg8::Unit&) const {}
    __device__ __forceinline__ void done(const pg8::Unit&) const {}
};
__device__ __forceinline__ int moe_list_units(Frame& F, int nN, LAS int* list) {
    const int* tl = WSP<int>(F, WS_TILES);
    const int T = __builtin_amdgcn_readfirstlane(tl[32]);
    pg8::StaticOrder SO; SO.init(T * 256, nN * 256, F.G, F.bx);
    int n = 0;
#pragma unroll 1
    for (int i = 0;; ++i) {
        pg8::Unit u; if (!SO.next(i, u)) break;
        const int pm = u.pm, pnl = u.pn;
        int e = 0;
#pragma unroll 1
        for (int q = 1; q < 32; ++q) { const int tq = __builtin_amdgcn_readfirstlane(tl[q]); if (tq <= pm) e = q; }
        if (F.tid == 0) { list[2 * i] = pm; list[2 * i + 1] = e * nN + pnl; }
        n = i + 1;
    }
    __syncthreads();
    return n;
}

__device__ __forceinline__ void ph_rope(Frame& F) {
    bf16* P = WSP<bf16>(F, WS_P);
    const size_t total = (size_t)NLAT * 832, stride = (size_t)F.G * NTHR;
    for (size_t idx = (size_t)F.bx * NTHR + F.tid; idx < total; idx += stride) {
        const int row = (int)(idx / 832), pi = (int)(idx % 832), t = row & 4095;
        int c1, c2; float rev;
        if (pi < 512) {
            const int qk = pi >> 8, h = (pi >> 6) & 3, i = pi & 63;
            c1 = (qk ? C_RK : C_RQ) + h * 128 + i; c2 = c1 + 64;
            const float invf = __expf(-(float)i * (9.210340371976184f / 63.0f));
            rev = (float)t * invf * 0.15915494309189535f;
        } else {
            const int pj = pi - 512, hh = pj >> 5, w = pj & 31, half = w >> 4, i = w & 15;
            const int base = (hh < 8) ? (C_AQ + hh * 64) : (C_AK + (hh - 8) * 64);
            c1 = base + half * 32 + i; c2 = c1 + 16;
            const float invf = __expf(-(float)i * (9.210340371976184f / 16.0f));
            const float pos = half ? (float)(t & 63) : (float)(t >> 6);
            rev = pos * invf * 0.15915494309189535f;
        }
        const float cs = cos_rev(rev), sn = sin_rev(rev);
        bf16* pr = P + (size_t)row * INC;
        const float x1 = bf2f(pr[c1]), x2 = bf2f(pr[c2]);
        pr[c1] = f2bf(x1 * cs - x2 * sn); pr[c2] = f2bf(x1 * sn + x2 * cs);
    }
}

__device__ __forceinline__ void attn_naive_item(Frame& F, int l, int item) {
    const bf16* P = WSP<bf16>(F, WS_P);
    LAS float* Ks = (LAS float*)F.lds; LAS float* Vs = Ks + 64 * 64;
    const bool isctx = item >= 512;
    int b, kvh, qb;
    if (!isctx) { b = item >> 6; kvh = (item >> 5) & 1; qb = item & 31; } else { const int it = item - 512; b = it >> 2; kvh = (it >> 1) & 1; qb = it & 1; }
    const int qi = F.tid & 127, g = F.tid >> 7, h = kvh * 4 + g;
    const int qpos = qb * 128 + qi;
    const int rowq = isctx ? (NLAT + b * CTXL + qpos) : (b * SEQ + qpos);
    float q[64], o[64];
    { const bf16* qp = P + (size_t)rowq * INC + C_AQ + h * 64;
#pragma unroll
      for (int d = 0; d < 64; ++d) { q[d] = bf2f(qp[d]) * 0.125f; o[d] = 0.f; } }
    const float sink = IN_(F, 9)[l * 8 + h];
    float mrun = sink, lsum = 1.0f;
    const int nkc = isctx ? 4 : 10, start = qb * 128;
    for (int kc = 0; kc < nkc; ++kc) {
        __syncthreads();
        { const int key = F.tid >> 3, d0 = (F.tid & 7) * 8;
          const bool ctxchunk = isctx || kc >= 6;
          int row = -1;
          if (ctxchunk) row = NLAT + b * CTXL + (isctx ? kc : kc - 6) * 64 + key;
          else { const int kpos = start - 128 + kc * 64 + key; if (kpos >= 0 && kpos < SEQ) row = b * SEQ + kpos; }
          u32x4 kk = (u32x4){0u, 0u, 0u, 0u}, vv = kk;
          if (row >= 0) { kk = *(const u32x4*)(P + (size_t)row * INC + C_AK + kvh * 64 + d0); vv = *(const u32x4*)(P + (size_t)row * INC + C_AV + kvh * 64 + d0); }
          LAS float* kd = Ks + key * 64 + d0; LAS float* vd = Vs + key * 64 + d0;
          kd[0] = __uint_as_float(kk.x << 16); kd[1] = __uint_as_float(kk.x & 0xffff0000u); kd[2] = __uint_as_float(kk.y << 16); kd[3] = __uint_as_float(kk.y & 0xffff0000u);
          kd[4] = __uint_as_float(kk.z << 16); kd[5] = __uint_as_float(kk.z & 0xffff0000u); kd[6] = __uint_as_float(kk.w << 16); kd[7] = __uint_as_float(kk.w & 0xffff0000u);
          vd[0] = __uint_as_float(vv.x << 16); vd[1] = __uint_as_float(vv.x & 0xffff0000u); vd[2] = __uint_as_float(vv.y << 16); vd[3] = __uint_as_float(vv.y & 0xffff0000u);
          vd[4] = __uint_as_float(vv.z << 16); vd[5] = __uint_as_float(vv.z & 0xffff0000u); vd[6] = __uint_as_float(vv.w << 16); vd[7] = __uint_as_float(vv.w & 0xffff0000u); }
        __syncthreads();
        const bool ctxchunk = isctx || kc >= 6;
        for (int key = 0; key < 64; ++key) {
            bool valid = true;
            if (!ctxchunk) { const int kpos = start - 128 + kc * 64 + key; const int dd = qpos - kpos; valid = (kpos >= 0) && (kpos < SEQ) && (dd <= 128) && (dd >= -128); }
            float s = 0.f;
#pragma unroll
            for (int d = 0; d < 64; ++d) s += q[d] * Ks[key * 64 + d];
            if (valid) {
                const float mnew = fmaxf(mrun, s), sc = __expf(mrun - mnew), p = __expf(s - mnew);
                lsum = lsum * sc + p; mrun = mnew;
#pragma unroll
                for (int d = 0; d < 64; ++d) o[d] = o[d] * sc + p * Vs[key * 64 + d];
            }
        }
    }
    const float inv = 1.0f / lsum;
    bf16* op = WSP<bf16>(F, WS_ATT) + (size_t)rowq * 512 + h * 64;
#pragma unroll
    for (int d = 0; d < 64; d += 2) *(unsigned*)(op + d) = pk2(o[d] * inv, o[d + 1] * inv);
}

__device__ __forceinline__ void ret_naive_item(Frame& F, int l, int item) {
    const bf16* P = WSP<bf16>(F, WS_P);
    LAS float* Ks = (LAS float*)F.lds; LAS float* Vs = Ks + 32 * 128; LAS float* red = Vs + 32 * 128;
    const bool isctx = item >= 1024;
    int b, h, qb;
    if (!isctx) { b = item >> 7; h = (item >> 5) & 3; qb = item & 31; } else { const int it = item - 1024; b = it >> 3; h = (it >> 1) & 3; qb = it & 1; }
    const int quarter = F.wave >> 1, qi = (F.wave & 1) * 64 + F.lane;
    const int n = qb * 128 + qi;
    const int rowq = isctx ? (NLAT + b * CTXL + n) : (b * SEQ + n);
    const float LOG2E = 1.4426950408889634f;
    const float lgf = log_sigmoid_(IN_(F, 8)[l * 8 + h]) * LOG2E, lgb = log_sigmoid_(IN_(F, 8)[l * 8 + 4 + h]) * LOG2E;
    float q[128], y[32];
    { const bf16* qp = P + (size_t)rowq * INC + C_RQ + h * 128;
#pragma unroll
      for (int d = 0; d < 128; ++d) q[d] = bf2f(qp[d]); }
#pragma unroll
    for (int e = 0; e < 32; ++e) y[e] = 0.f;
    const int nch = isctx ? 8 : 136;
    for (int kc = 0; kc < nch; ++kc) {
        __syncthreads();
        const bool ctxchunk = isctx || kc >= 128;
        const int krow0 = ctxchunk ? (NLAT + b * CTXL + (isctx ? kc : kc - 128) * 32) : (b * SEQ + kc * 32);
        { const int key = F.tid >> 4, d0 = (F.tid & 15) * 8;
          const u32x4 kk = *(const u32x4*)(P + (size_t)(krow0 + key) * INC + C_RK + h * 128 + d0), vv = *(const u32x4*)(P + (size_t)(krow0 + key) * INC + C_RV + h * 128 + d0);
          LAS float* kd = Ks + key * 128 + d0; LAS float* vd = Vs + key * 128 + d0;
          kd[0] = __uint_as_float(kk.x << 16); kd[1] = __uint_as_float(kk.x & 0xffff0000u); kd[2] = __uint_as_float(kk.y << 16); kd[3] = __uint_as_float(kk.y & 0xffff0000u);
          kd[4] = __uint_as_float(kk.z << 16); kd[5] = __uint_as_float(kk.z & 0xffff0000u); kd[6] = __uint_as_float(kk.w << 16); kd[7] = __uint_as_float(kk.w & 0xffff0000u);
          vd[0] = __uint_as_float(vv.x << 16); vd[1] = __uint_as_float(vv.x & 0xffff0000u); vd[2] = __uint_as_float(vv.y << 16); vd[3] = __uint_as_float(vv.y & 0xffff0000u);
          vd[4] = __uint_as_float(vv.z << 16); vd[5] = __uint_as_float(vv.z & 0xffff0000u); vd[6] = __uint_as_float(vv.w << 16); vd[7] = __uint_as_float(vv.w & 0xffff0000u); }
        __syncthreads();
        for (int key = 0; key < 32; ++key) {
            float w;
            if (!ctxchunk) { const int m = kc * 32 + key; const int dd = n - m; w = (dd >= 0) ? __builtin_amdgcn_exp2f(lgf * (float)dd) : __builtin_amdgcn_exp2f(lgb * (float)(-dd)); }
            else if (!isctx) { const int j = (kc - 128) * 32 + key; w = __builtin_amdgcn_exp2f(lgf * (float)(n + CTXL - j)) + __builtin_amdgcn_exp2f(lgb * (float)(SEQ - n + j)); }
            else { const int j = kc * 32 + key; const int dd = n - j; w = (dd >= 0) ? __builtin_amdgcn_exp2f(lgf * (float)dd) : __builtin_amdgcn_exp2f(lgb * (float)(-dd)); }
            float s = 0.f;
#pragma unroll
            for (int d = 0; d < 128; ++d) s += q[d] * Ks[key * 128 + d];
            s *= w;
#pragma unroll
            for (int e = 0; e < 32; ++e) y[e] += s * Vs[key * 128 + quarter * 32 + e];
        }
    }
    const float ksc = 0.08838834764831845f;
    float ss = 0.f;
#pragma unroll
    for (int e = 0; e < 32; ++e) { y[e] *= ksc; ss += y[e] * y[e]; }
    __syncthreads();
    red[qi * 4 + quarter] = ss;
    __syncthreads();
    const float tot = (red[qi * 4 + 0] + red[qi * 4 + 1]) + (red[qi * 4 + 2] + red[qi * 4 + 3]);
    const float rs = 1.0f / sqrtf(tot * (1.0f / 128.0f) + EPS);
    const bf16* gp = P + (size_t)rowq * INC + C_RG + h * 128 + quarter * 32;
    bf16* op = WSP<bf16>(F, WS_RET) + (size_t)rowq * 512 + h * 128 + quarter * 32;
#pragma unroll
    for (int e = 0; e < 32; e += 2) *(unsigned*)(op + e) = pk2(y[e] * rs * siluf_(bf2f(gp[e])), y[e + 1] * rs * siluf_(bf2f(gp[e + 1])));
}

__device__ __forceinline__ float hy_sconv(const bf16* P, const float* cw, const float* cb, int base, int t, int L, int ch) {
    float a = cb[ch] + bf2f(P[(size_t)(base + t) * INC + C_HU + ch]) * cw[1536 + ch];
    if (t > 0) a += bf2f(P[(size_t)(base + t - 1) * INC + C_HU + ch]) * cw[ch];
    if (t + 1 < L) a += bf2f(P[(size_t)(base + t + 1) * INC + C_HU + ch]) * cw[2 * 1536 + ch];
    return a;
}
__device__ __forceinline__ void ph_hyprep(Frame& F, int l, bool do_ctx) {
    const bf16* P = WSP<bf16>(F, WS_P);
    const float* cw = IN_(F, 10) + l * 3 * 1536; const float* cb = IN_(F, 11) + l * 1536;
    float* ZT = WSP<float>(F, WS_ZT); float* ZTC = WSP<float>(F, WS_ZTC);
    const size_t total = (size_t)(do_ctx ? NROWS : NLAT) * 512, stride = (size_t)F.G * NTHR;
    for (size_t idx = (size_t)F.bx * NTHR + F.tid; idx < total; idx += stride) {
        const int row = (int)(idx >> 9), c = (int)(idx & 511);
        if (row < NLAT) { const int b = row >> 12, t = row & 4095;
            const float x1 = hy_sconv(P, cw, cb, b * SEQ, t, SEQ, 512 + c), v = hy_sconv(P, cw, cb, b * SEQ, t, SEQ, 1024 + c);
            ZT[((size_t)c * NB + b) * SEQ + t] = x1 * v;
        } else { const int j = row - NLAT, b = j >> 8, t = j & 255;
            const float x1 = hy_sconv(P, cw, cb, NLAT + b * CTXL, t, CTXL, 512 + c), v = hy_sconv(P, cw, cb, NLAT + b * CTXL, t, CTXL, 1024 + c);
            ZTC[((size_t)c * NB + b) * CTXL + t] = x1 * v;
        }
    }
}
__device__ __forceinline__ void hyconv_naive_item(Frame& F, int l, int item) {
    const int c = item >> 1, bh = item & 1;
    LAS float* Kc = (LAS float*)F.lds;
    LAS float* Zs = Kc + 8192;
    const float* HFp = WSP<float>(F, WS_HF + (size_t)l * 16 * MiB); const float* HBp = WSP<float>(F, WS_HF + (size_t)l * 16 * MiB + 8 * MiB);
    const float il1 = hy_inv_l1(F, l, c);
    const float* ZT = WSP<float>(F, WS_ZT) + ((size_t)c * NB + bh * 4) * SEQ;
    __syncthreads();
    for (int i = F.tid; i < 8191; i += NTHR) { const int d = i - 4095; Kc[i] = (d >= 0 ? HFp[(size_t)d * 512 + c] : HBp[(size_t)(-d) * 512 + c]) * il1; }
    for (int i = F.tid; i < 4 * SEQ; i += NTHR) { const int bb = i >> 12, s = i & 4095; Zs[s * 4 + bb] = ZT[i]; }
    __syncthreads();
    float acc[8][4];
#pragma unroll
    for (int i = 0; i < 8; ++i)
#pragma unroll
        for (int bb = 0; bb < 4; ++bb) acc[i][bb] = 0.f;
    for (int s = 0; s < SEQ; ++s) {
        const f32x4 z = *(const LAS f32x4*)(Zs + s * 4);
#pragma unroll
        for (int i = 0; i < 8; ++i) { const float k = Kc[F.tid + 512 * i - s + 4095];
#pragma unroll
            for (int bb = 0; bb < 4; ++bb) acc[i][bb] += k * z[bb]; }
    }
    float* YT = WSP<float>(F, WS_YT) + ((size_t)c * NB + bh * 4) * SEQ;
#pragma unroll
    for (int i = 0; i < 8; ++i)
#pragma unroll
        for (int bb = 0; bb < 4; ++bb) YT[(size_t)bb * SEQ + F.tid + 512 * i] = acc[i][bb];
}
__device__ __forceinline__ void hyconv_ctx_item(Frame& F, int c) {
    const float* HFp = WSP<float>(F, WS_HFC); const float* HBp = WSP<float>(F, WS_HFC + 512 * 1024);
    const float il1 = hy_inv_l1(F, 2, c);
    const float* Z = WSP<float>(F, WS_ZTC) + (size_t)c * NB * CTXL; float* Yo = WSP<float>(F, WS_YTC) + (size_t)c * NB * CTXL;
#pragma unroll
    for (int i = 0; i < 4; ++i) {
        const int o = F.tid * 4 + i, b = o >> 8, t = o & 255;
        float a = 0.f;
        for (int s = 0; s < CTXL; ++s) { const int d = t - s; const float k = (d >= 0) ? HFp[(size_t)d * 512 + c] : HBp[(size_t)(-d) * 512 + c]; a += k * Z[b * CTXL + s]; }
        Yo[o] = a * il1;
    }
}
__device__ __forceinline__ void ph_hypost(Frame& F, int l, bool do_ctx) {
    const bf16* P = WSP<bf16>(F, WS_P);
    const float* cw = IN_(F, 10) + l * 3 * 1536; const float* cb = IN_(F, 11) + l * 1536; const float* skip = IN_(F, 19) + l * 512;
    const float* YT = WSP<float>(F, WS_YT); const float* YTC = WSP<float>(F, WS_YTC);
    bf16* HY = WSP<bf16>(F, WS_HY);
    const size_t total = (size_t)(do_ctx ? NROWS : NLAT) * 512, stride = (size_t)F.G * NTHR;
    for (size_t idx = (size_t)F.bx * NTHR + F.tid; idx < total; idx += stride) {
        const int row = (int)(idx >> 9), c = (int)(idx & 511);
        int base, t, L; float y;
        if (row < NLAT) { const int b = row >> 12; t = row & 4095; base = b * SEQ; L = SEQ; y = YT[((size_t)c * NB + b) * SEQ + t]; }
        else { const int j = row - NLAT, b = j >> 8; t = j & 255; base = NLAT + b * CTXL; L = CTXL; y = YTC[((size_t)c * NB + b) * CTXL + t]; }
        const float x0 = hy_sconv(P, cw, cb, base, t, L, c), x1 = hy_sconv(P, cw, cb, base, t, L, 512 + c), v = hy_sconv(P, cw, cb, base, t, L, 1024 + c);
        const float z = x1 * v;
        HY[(size_t)row * 512 + c] = f2bf(x0 * (y + skip[c] * z));
    }
}

typedef short bf16x8 __attribute__((ext_vector_type(8)));
typedef short bf16x4 __attribute__((ext_vector_type(4)));
constexpr int RLD = 136;
constexpr int RTILE = 128 * RLD * 2;
__device__ __forceinline__ bf16x8 lds_frag16(const LAS bf16* tile, int row0, int k0, int lane) {
    return *(const LAS bf16x8*)(tile + (row0 + (lane & 15)) * RLD + k0 + 8 * (lane >> 4));
}
__device__ __forceinline__ void ret_unit_decode(int u, int& bh, int& ci, int& rowbase) {
    bh = u / 34; ci = u - bh * 34; const int b = bh >> 2;
    rowbase = (ci < 2) ? (NLAT + b * CTXL + ci * 128) : (b * SEQ + (ci - 2) * 128);
}
__device__ __forceinline__ void ret_load_tile(LAS bf16* tile, const bf16* g, size_t gp, int tid) {
    const int r = tid >> 2, seg = tid & 3;
#pragma unroll
    for (int q = 0; q < 4; ++q) *(LAS u32x4*)(tile + r * RLD + seg * 32 + q * 8) = *(const u32x4*)(g + (size_t)r * gp + seg * 32 + q * 8);
}
__device__ __forceinline__ void ret_kv_unit(Frame& F, int l, int u) {
    const bf16* P = WSP<bf16>(F, WS_P);
    LAS bf16* Ktf = (LAS bf16*)F.lds; LAS bf16* Ktb = Ktf + 128 * RLD; LAS bf16* Vt = Ktb + 128 * RLD;
    int bh, ci, rowbase; ret_unit_decode(u, bh, ci, rowbase);
    const int h = bh & 3, tid = F.tid, lane = F.lane, w = F.wave;
    const float LOG2E = 1.4426950408889634f;
    const float lgf = log_sigmoid_(IN_(F, 8)[l * 8 + h]) * LOG2E, lgb = log_sigmoid_(IN_(F, 8)[l * 8 + 4 + h]) * LOG2E;
    __syncthreads();
    { const int j = tid >> 2, seg = tid & 3;
      const float wf = __builtin_amdgcn_exp2f(lgf * (float)(127 - j)), wb = __builtin_amdgcn_exp2f(lgb * (float)j);
      const bf16* kp = P + (size_t)(rowbase + j) * INC + C_RK + h * 128 + seg * 32; const bf16* vp = P + (size_t)(rowbase + j) * INC + C_RV + h * 128 + seg * 32;
#pragma unroll
      for (int q = 0; q < 4; ++q) { const u32x4 kk = *(const u32x4*)(kp + q * 8), vv = *(const u32x4*)(vp + q * 8);
          const unsigned kw[4] = {kk.x, kk.y, kk.z, kk.w}, vw[4] = {vv.x, vv.y, vv.z, vv.w};
#pragma unroll
          for (int i = 0; i < 4; ++i) { const int d = seg * 32 + q * 8 + 2 * i;
              const float k0 = __uint_as_float(kw[i] << 16), k1 = __uint_as_float(kw[i] & 0xffff0000u);
              Ktf[d * RLD + j] = f2bf(k0 * wf); Ktf[(d + 1) * RLD + j] = f2bf(k1 * wf);
              Ktb[d * RLD + j] = f2bf(k0 * wb); Ktb[(d + 1) * RLD + j] = f2bf(k1 * wb);
              Vt[d * RLD + j] = (bf16)(vw[i] & 0xffffu); Vt[(d + 1) * RLD + j] = (bf16)(vw[i] >> 16); } } }
    __syncthreads();
    bf16x8 af[4], ab[4];
#pragma unroll
    for (int ks = 0; ks < 4; ++ks) { af[ks] = lds_frag16(Ktf, 16 * w, 32 * ks, lane); ab[ks] = lds_frag16(Ktb, 16 * w, 32 * ks, lane); }
    float* KV = WSP<float>(F, WS_KV) + ((size_t)(bh * 34 + ci) * 2) * 16384;
    const int d0 = 16 * w + 4 * (lane >> 4);
#pragma unroll 2
    for (int et = 0; et < 8; ++et) {
        f32x4 cf = (f32x4){0.f, 0.f, 0.f, 0.f}, cb = cf;
#pragma unroll
        for (int ks = 0; ks < 4; ++ks) { const bf16x8 bv = lds_frag16(Vt, 16 * et, 32 * ks, lane);
            cf = __builtin_amdgcn_mfma_f32_16x16x32_bf16(af[ks], bv, cf, 0, 0, 0); cb = __builtin_amdgcn_mfma_f32_16x16x32_bf16(ab[ks], bv, cb, 0, 0, 0); }
        const int e = 16 * et + (lane & 15);
        *(f32x4*)(KV + (size_t)e * 128 + d0) = cf; *(f32x4*)(KV + 16384 + (size_t)e * 128 + d0) = cb;
    }
}
__device__ __forceinline__ void ret_scan(Frame& F, int l) {
    const float* KV = WSP<float>(F, WS_KV); bf16* SP = WSP<bf16>(F, WS_SP);
    const float LOG2E = 1.4426950408889634f;
    const int total = 64 * 4096, stride = F.G * NTHR;
#pragma unroll 1
    for (int idx = F.bx * NTHR + F.tid; idx < total; idx += stride) {
        const int bhd = idx >> 12, elem = (idx & 4095) * 4, bh = bhd >> 1, dir = bhd & 1, h = bh & 3;
        const float cd = __builtin_amdgcn_exp2f(log_sigmoid_(IN_(F, 8)[l * 8 + dir * 4 + h]) * LOG2E * 128.0f);
        const size_t base = ((size_t)bh * 34 * 2 + dir) * 16384 + elem;
        f32x4 s = (f32x4){0.f, 0.f, 0.f, 0.f};
#pragma unroll 1
        for (int half = 0; half < 2; ++half) {
            f32x4 kv[17];
#pragma unroll
            for (int k = 0; k < 17; ++k) { const int st = half * 17 + k; const int ci = dir == 0 ? st : (st == 0 ? 1 : (st == 1 ? 0 : 35 - st)); kv[k] = *(const f32x4*)(KV + base + (size_t)ci * 2 * 16384); }
#pragma unroll
            for (int k = 0; k < 17; ++k) { const int st = half * 17 + k; const int ci = dir == 0 ? st : (st == 0 ? 1 : (st == 1 ? 0 : 35 - st));
                u32x2 o; o.x = pk2(s[0], s[1]); o.y = pk2(s[2], s[3]); *(u32x2*)(SP + base + (size_t)ci * 2 * 16384) = o;
                s = s * cd + kv[k]; }
        }
    }
}
__device__ __forceinline__ void ret_out_unit(Frame& F, int l, int u) {
    const bf16* P = WSP<bf16>(F, WS_P);
    LAS bf16* Qs = (LAS bf16*)F.lds; LAS bf16* Ks = Qs + 128 * RLD; LAS bf16* Vt = Ks + 128 * RLD; LAS bf16* Ps = Vt + 128 * RLD;
    int bh, ci, rowbase; ret_unit_decode(u, bh, ci, rowbase);
    const int h = bh & 3, tid = F.tid, lane = F.lane, w = F.wave;
    const float LOG2E = 1.4426950408889634f;
    const float lgf = log_sigmoid_(IN_(F, 8)[l * 8 + h]) * LOG2E, lgb = log_sigmoid_(IN_(F, 8)[l * 8 + 4 + h]) * LOG2E;
    __syncthreads();
    ret_load_tile(Qs, P + (size_t)rowbase * INC + C_RQ + h * 128, INC, tid);
    ret_load_tile(Ks, P + (size_t)rowbase * INC + C_RK + h * 128, INC, tid);
    { const int j = tid >> 2, seg = tid & 3; const bf16* vp = P + (size_t)(rowbase + j) * INC + C_RV + h * 128 + seg * 32;
#pragma unroll
      for (int q = 0; q < 4; ++q) { const u32x4 vv = *(const u32x4*)(vp + q * 8); const unsigned vw[4] = {vv.x, vv.y, vv.z, vv.w};
#pragma unroll
          for (int i = 0; i < 4; ++i) { const int d = seg * 32 + q * 8 + 2 * i; Vt[d * RLD + j] = (bf16)(vw[i] & 0xffffu); Vt[(d + 1) * RLD + j] = (bf16)(vw[i] >> 16); } } }
    __syncthreads();
    const int icol = 16 * w + (lane & 15);
    bf16x8 bq[4];
#pragma unroll
    for (int ks = 0; ks < 4; ++ks) bq[ks] = lds_frag16(Qs, 16 * w, 32 * ks, lane);
#pragma unroll 2
    for (int jt = 0; jt < 8; ++jt) {
        f32x4 c = (f32x4){0.f, 0.f, 0.f, 0.f};
#pragma unroll
        for (int ks = 0; ks < 4; ++ks) c = __builtin_amdgcn_mfma_f32_16x16x32_bf16(lds_frag16(Ks, 16 * jt, 32 * ks, lane), bq[ks], c, 0, 0, 0);
        const int j0 = 16 * jt + 4 * (lane >> 4);
        float pv[4];
#pragma unroll
        for (int r = 0; r < 4; ++r) { const int dd = icol - (j0 + r); const float dec = dd >= 0 ? __builtin_amdgcn_exp2f(lgf * (float)dd) : __builtin_amdgcn_exp2f(lgb * (float)(-dd)); pv[r] = c[r] * dec; }
        u32x2 pw; pw.x = pk2(pv[0], pv[1]); pw.y = pk2(pv[2], pv[3]);
        *(LAS u32x2*)(Ps + icol * RLD + j0) = pw;
    }
    LDS_WAIT(); asm volatile("" ::: "memory");
    f32x4 acc[8];
    {
        bf16x8 bp[4];
#pragma unroll
        for (int ks = 0; ks < 4; ++ks) bp[ks] = lds_frag16(Ps, 16 * w, 32 * ks, lane);
#pragma unroll
        for (int et = 0; et < 8; ++et) { f32x4 c = (f32x4){0.f, 0.f, 0.f, 0.f};
#pragma unroll
            for (int ks = 0; ks < 4; ++ks) c = __builtin_amdgcn_mfma_f32_16x16x32_bf16(lds_frag16(Vt, 16 * et, 32 * ks, lane), bp[ks], c, 0, 0, 0);
            acc[et] = c; }
    }
    const bf16* SPg = WSP<bf16>(F, WS_SP) + ((size_t)(bh * 34 + ci) * 2) * 16384;
#pragma unroll 1
    for (int dir = 0; dir < 2; ++dir) {
        const bool zero = (dir == 0) ? (ci == 0) : (ci == 1);
        __syncthreads();
        if (!zero) ret_load_tile(Ks, SPg + (size_t)dir * 16384, 128, tid);
        __syncthreads();
        if (!zero) {
            const float sc = (dir == 0) ? __builtin_amdgcn_exp2f(lgf * (float)((icol & 127) + 1)) : __builtin_amdgcn_exp2f(lgb * (float)(128 - (icol & 127)));
#pragma unroll
            for (int et = 0; et < 8; ++et) { f32x4 c = (f32x4){0.f, 0.f, 0.f, 0.f};
#pragma unroll
                for (int ks = 0; ks < 4; ++ks) c = __builtin_amdgcn_mfma_f32_16x16x32_bf16(lds_frag16(Ks, 16 * et, 32 * ks, lane), bq[ks], c, 0, 0, 0);
                acc[et] = acc[et] + c * sc; }
        }
    }
    const float ksc = 0.08838834764831845f;
    float ss = 0.f;
#pragma unroll
    for (int et = 0; et < 8; ++et) { acc[et] = acc[et] * ksc; ss += (acc[et][0] * acc[et][0] + acc[et][1] * acc[et][1]) + (acc[et][2] * acc[et][2] + acc[et][3] * acc[et][3]); }
    ss += __shfl_xor(ss, 16); ss += __shfl_xor(ss, 32);
    const float rs = 1.0f / sqrtf(ss * (1.0f / 128.0f) + EPS);
    const size_t row = (size_t)(rowbase + icol);
    const bf16* gp = P + row * INC + C_RG + h * 128; bf16* op = WSP<bf16>(F, WS_RET) + row * 1536 + h * 128;
#pragma unroll
    for (int et = 0; et < 8; ++et) { const int e0 = 16 * et + 4 * (lane >> 4);
        const u32x2 g2 = *(const u32x2*)(gp + e0);
        const float g0 = __uint_as_float(g2.x << 16), g1 = __uint_as_float(g2.x & 0xffff0000u), g2f = __uint_as_float(g2.y << 16), g3 = __uint_as_float(g2.y & 0xffff0000u);
        u32x2 o; o.x = pk2(acc[et][0] * rs * siluf_(g0), acc[et][1] * rs * siluf_(g1)); o.y = pk2(acc[et][2] * rs * siluf_(g2f), acc[et][3] * rs * siluf_(g3));
        *(u32x2*)(op + e0) = o; }
}

typedef float f32x2 __attribute__((ext_vector_type(2)));
__device__ __forceinline__ f32x2 cmul_(f32x2 a, f32x2 b) { return (f32x2){a.x * b.x - a.y * b.y, a.x * b.y + a.y * b.x}; }
__device__ __forceinline__ f32x2 cmulc_(f32x2 a, f32x2 b) { return (f32x2){a.x * b.x + a.y * b.y, a.y * b.x - a.x * b.y}; }
__device__ __forceinline__ f32x2 twid_(float rev) { return (f32x2){cos_rev(rev), -sin_rev(rev)}; }
__device__ __forceinline__ int fpad(int n) { return n + (n >> 3); }
template <int R> __device__ __forceinline__ void fft_twiddles(f32x2 (&tw)[R - 1], int t, int s, int M) {
    int o = 0, u = 0;
#pragma unroll
    for (int half = R / 2; half >= 1; half >>= 1) {
        const float invMu = 1.0f / (float)(M >> u);
#pragma unroll
        for (int qq = 0; qq < half; ++qq) tw[o + qq] = twid_((float)(t + qq * s) * invMu);
        o += half; ++u;
    }
}
template <int R, int HALF, int OFF> __device__ __forceinline__ void fft_sub_fwd(f32x2 (&v)[R], const f32x2 (&tw)[R - 1]) {
#pragma unroll
    for (int qq = 0; qq < HALF; ++qq) {
        const f32x2 w = tw[OFF + qq];
#pragma unroll
        for (int g0 = 0; g0 < R; g0 += 2 * HALF) { const f32x2 a = v[g0 + qq], b = v[g0 + qq + HALF]; v[g0 + qq] = a + b; v[g0 + qq + HALF] = cmul_(a - b, w); }
    }
}
template <int R, int HALF, int OFF> __device__ __forceinline__ void fft_sub_inv(f32x2 (&v)[R], const f32x2 (&tw)[R - 1]) {
#pragma unroll
    for (int qq = 0; qq < HALF; ++qq) {
        const f32x2 w = tw[OFF + qq];
#pragma unroll
        for (int g0 = 0; g0 < R; g0 += 2 * HALF) { const f32x2 A = v[g0 + qq], Bp = cmulc_(v[g0 + qq + HALF], w); v[g0 + qq] = A + Bp; v[g0 + qq + HALF] = A - Bp; }
    }
}
template <int R> __device__ __forceinline__ void fft_bf_fwd(f32x2 (&v)[R], const f32x2 (&tw)[R - 1]) {
    if constexpr (R == 16) { fft_sub_fwd<16, 8, 0>(v, tw); fft_sub_fwd<16, 4, 8>(v, tw); fft_sub_fwd<16, 2, 12>(v, tw); fft_sub_fwd<16, 1, 14>(v, tw); }
    else { fft_sub_fwd<8, 4, 0>(v, tw); fft_sub_fwd<8, 2, 4>(v, tw); fft_sub_fwd<8, 1, 6>(v, tw); }
}
template <int R> __device__ __forceinline__ void fft_bf_inv(f32x2 (&v)[R], const f32x2 (&tw)[R - 1]) {
    if constexpr (R == 16) { fft_sub_inv<16, 1, 14>(v, tw); fft_sub_inv<16, 2, 12>(v, tw); fft_sub_inv<16, 4, 8>(v, tw); fft_sub_inv<16, 8, 0>(v, tw); }
    else { fft_sub_inv<8, 1, 6>(v, tw); fft_sub_inv<8, 2, 4>(v, tw); fft_sub_inv<8, 4, 0>(v, tw); }
}
__device__ __forceinline__ void fft_tw_last(f32x2 (&tw)[7]) {
    const float h = 0.70710678118654752f;
    tw[0] = (f32x2){1.f, 0.f}; tw[1] = (f32x2){h, -h}; tw[2] = (f32x2){0.f, -1.f}; tw[3] = (f32x2){-h, -h};
    tw[4] = (f32x2){1.f, 0.f}; tw[5] = (f32x2){0.f, -1.f}; tw[6] = (f32x2){1.f, 0.f};
}
struct FftTw { f32x2 t1[15]; f32x2 t2[2][7]; f32x2 t3[2][7]; };
__device__ __forceinline__ void fft_tw_init(FftTw& T, int tid) {
    fft_twiddles<16>(T.t1, tid, 512, 8192);
#pragma unroll
    for (int it = 0; it < 2; ++it) { const int uu = tid + 512 * it; fft_twiddles<8>(T.t2[it], uu & 63, 64, 512); fft_twiddles<8>(T.t3[it], uu & 7, 8, 64); }
}
template <bool INV, int M> __device__ __forceinline__ void fft_pass8(LAS f32x2* X, int tid, const f32x2 (&tw)[2][7]) {
    asm volatile("" : "+v"(tid));
    constexpr int s = M >> 3;
#pragma unroll
    for (int it = 0; it < 2; ++it) {
        const int uu = tid + 512 * it, blk = uu / s, t = uu - blk * s, n0 = blk * M + t;
        f32x2 v[8];
#pragma unroll
        for (int q = 0; q < 8; ++q) v[q] = X[fpad(n0 + q * s)];
        if (INV) fft_bf_inv<8>(v, tw[it]); else fft_bf_fwd<8>(v, tw[it]);
#pragma unroll
        for (int q = 0; q < 8; ++q) X[fpad(n0 + q * s)] = v[q];
    }
}
__device__ __forceinline__ void fft_filter_unit(Frame& F, const FftTw& T, int l, int c) {
    LAS f32x2* X = (LAS f32x2*)F.lds;
    const float* HFp = WSP<float>(F, WS_HF + (size_t)l * 16 * MiB); const float* HBp = WSP<float>(F, WS_HF + (size_t)l * 16 * MiB + 8 * MiB);
    const float scale = hy_inv_l1(F, l, c) * (1.0f / 8192.0f);
    int tid = F.tid; asm volatile("" : "+v"(tid));
    __syncthreads();
    {   f32x2 v[16];
#pragma unroll
        for (int q = 0; q < 16; ++q) { const int n = tid + 512 * q; float x;
            if (q < 8) x = HFp[(size_t)n * 512 + c]; else x = (n == 4096) ? 0.f : HBp[(size_t)(8192 - n) * 512 + c];
            v[q] = (f32x2){x * scale, 0.f}; }
        fft_bf_fwd<16>(v, T.t1);
#pragma unroll
        for (int q = 0; q < 16; ++q) X[fpad(tid + 512 * q)] = v[q];
    }
    __syncthreads(); fft_pass8<false, 512>(X, tid, T.t2);
    __syncthreads(); fft_pass8<false, 64>(X, tid, T.t3);
    __syncthreads();
    f32x2* Hc = WSP<f32x2>(F, WS_HSPEC) + ((size_t)l * 512 + c) * 8192;
    asm volatile("" : "+v"(tid));
    f32x2 tl[7]; fft_tw_last(tl);
#pragma unroll
    for (int it = 0; it < 2; ++it) {
        const int uu = tid + 512 * it;
        f32x2 v[8];
#pragma unroll
        for (int q = 0; q < 8; ++q) v[q] = X[fpad(8 * uu + q)];
        fft_bf_fwd<8>(v, tl);
#pragma unroll
        for (int q = 0; q < 4; ++q) { f32x4 o; o[0] = v[2 * q].x; o[1] = v[2 * q].y; o[2] = v[2 * q + 1].x; o[3] = v[2 * q + 1].y; *(f32x4*)(Hc + 8 * uu + 2 * q) = o; }
    }
}
__device__ __forceinline__ void fft_conv_unit(Frame& F, const FftTw& T, int l, int unit, int next_unit, unsigned (&zp)[8]) {
    LAS f32x2* X = (LAS f32x2*)F.lds;
    const int c = unit >> 2, p = unit & 3; int tid = F.tid; asm volatile("" : "+v"(tid));
    const bf16* z1 = WSP<bf16>(F, WS_ZT) + ((size_t)c * NB + 2 * p) * SEQ; const bf16* z2 = z1 + SEQ;
    const f32x2* Hc = WSP<f32x2>(F, WS_HSPEC) + ((size_t)l * 512 + c) * 8192;
    f32x4 hp[2][4];
#pragma unroll
    for (int it = 0; it < 2; ++it)
#pragma unroll
        for (int q = 0; q < 4; ++q) hp[it][q] = *(const f32x4*)(Hc + 8 * (tid + 512 * it) + 2 * q);
    __syncthreads();
    {   f32x2 v[16];
#pragma unroll
        for (int q = 0; q < 8; ++q) v[q] = (f32x2){__uint_as_float(zp[q] << 16), __uint_as_float(zp[q] & 0xffff0000u)};
        if (next_unit < 2048) { const bf16* n1 = WSP<bf16>(F, WS_ZT) + ((size_t)(next_unit >> 2) * NB + 2 * (next_unit & 3)) * SEQ; const bf16* n2 = n1 + SEQ;
#pragma unroll
            for (int q = 0; q < 8; ++q) { const int n = tid + 512 * q; zp[q] = (unsigned)n1[n] | ((unsigned)n2[n] << 16); } }
#pragma unroll
        for (int q = 8; q < 16; ++q) v[q] = (f32x2){0.f, 0.f};
        fft_bf_fwd<16>(v, T.t1);
#pragma unroll
        for (int q = 0; q < 16; ++q) X[fpad(tid + 512 * q)] = v[q];
    }
    __syncthreads(); fft_pass8<false, 512>(X, tid, T.t2);
    __syncthreads(); fft_pass8<false, 64>(X, tid, T.t3);
    __syncthreads();
    asm volatile("" : "+v"(tid));
    f32x2 tl[7]; fft_tw_last(tl);
#pragma unroll
    for (int it = 0; it < 2; ++it) {
        const int uu = tid + 512 * it;
        f32x2 v[8];
#pragma unroll
        for (int q = 0; q < 8; ++q) v[q] = X[fpad(8 * uu + q)];
        fft_bf_fwd<8>(v, tl);
#pragma unroll
        for (int q = 0; q < 4; ++q) { const f32x4 h = hp[it][q]; v[2 * q] = cmul_(v[2 * q], (f32x2){h[0], h[1]}); v[2 * q + 1] = cmul_(v[2 * q + 1], (f32x2){h[2], h[3]}); }
        fft_bf_inv<8>(v, tl);
#pragma unroll
        for (int q = 0; q < 8; ++q) X[fpad(8 * uu + q)] = v[q];
    }
    __syncthreads(); fft_pass8<true, 64>(X, tid, T.t3);
    __syncthreads(); fft_pass8<true, 512>(X, tid, T.t2);
    __syncthreads();
    asm volatile("" : "+v"(tid));
    {   f32x2 v[16];
#pragma unroll
        for (int q = 0; q < 16; ++q) v[q] = X[fpad(tid + 512 * q)];
        fft_bf_inv<16>(v, T.t1);
        bf16* y1 = WSP<bf16>(F, WS_YT) + ((size_t)c * NB + 2 * p) * SEQ; bf16* y2 = y1 + SEQ;
#pragma unroll
        for (int q = 0; q < 8; ++q) { const int n = tid + 512 * q; y1[n] = f2bf(v[q].x); y2[n] = f2bf(v[q].y); }
    }
}

constexpr int HLD = 72;
__device__ __forceinline__ void hy_sconv8(const bf16* P, int base, int t, int L, int ch0, const float (&w)[4][8], float (&out)[8]) {
    const bf16* p1 = P + (size_t)(base + t) * INC + C_HU + ch0;
    const u32x4 zero = (u32x4){0u, 0u, 0u, 0u};
    const u32x4 c1 = *(const u32x4*)p1, c0 = (t > 0) ? *(const u32x4*)(p1 - INC) : zero, c2 = (t + 1 < L) ? *(const u32x4*)(p1 + INC) : zero;
    const unsigned a0[4] = {c0.x, c0.y, c0.z, c0.w}, a1[4] = {c1.x, c1.y, c1.z, c1.w}, a2[4] = {c2.x, c2.y, c2.z, c2.w};
#pragma unroll
    for (int i = 0; i < 4; ++i) {
        out[2 * i] = w[3][2 * i] + __uint_as_float(a0[i] << 16) * w[0][2 * i] + __uint_as_float(a1[i] << 16) * w[1][2 * i] + __uint_as_float(a2[i] << 16) * w[2][2 * i];
        out[2 * i + 1] = w[3][2 * i + 1] + __uint_as_float(a0[i] & 0xffff0000u) * w[0][2 * i + 1] + __uint_as_float(a1[i] & 0xffff0000u) * w[1][2 * i + 1] + __uint_as_float(a2[i] & 0xffff0000u) * w[2][2 * i + 1];
    }
}
__device__ __forceinline__ void hy_load_w8(const float* cw, const float* cb, int ch0, float (&w)[4][8]) {
#pragma unroll
    for (int i = 0; i < 8; ++i) { w[0][i] = cw[ch0 + i]; w[1][i] = cw[1536 + ch0 + i]; w[2][i] = cw[2 * 1536 + ch0 + i]; w[3][i] = cb[ch0 + i]; }
}
__device__ __forceinline__ void hy_item_decode(int it, int& ct, int& base, int& t0, int& L, int& b, bool& isctx) {
    isctx = it >= 4096;
    if (!isctx) { ct = it & 7; t0 = ((it >> 3) & 63) * 64; b = it >> 9; base = b * SEQ; L = SEQ; }
    else { const int j = it - 4096; ct = j & 7; t0 = ((j >> 3) & 3) * 64; b = j >> 5; base = NLAT + b * CTXL; L = CTXL; }
}
__device__ __forceinline__ void ph_hyprep2(Frame& F, int l, bool do_ctx) {
    const bf16* P = WSP<bf16>(F, WS_P);
    const float* cw = IN_(F, 10) + l * 3 * 1536; const float* cb = IN_(F, 11) + l * 1536;
    LAS bf16* Zs = (LAS bf16*)F.lds;
    int tid = F.tid; asm volatile("" : "+v"(tid));
    const int cg = tid & 7, tl = tid >> 3, c0 = (F.bx & 7) * 64;
    float w1[4][8], wv[4][8];
    hy_load_w8(cw, cb, 512 + c0 + 8 * cg, w1); hy_load_w8(cw, cb, 1024 + c0 + 8 * cg, wv);
    const int nit = do_ctx ? 4352 : 4096;
#pragma unroll 1
    for (int it = F.bx; it < nit; it += F.G) {
        int ct, base, t0, L, b; bool isctx; hy_item_decode(it, ct, base, t0, L, b, isctx);
        float x1[8], v[8];
        hy_sconv8(P, base, t0 + tl, L, 512 + c0 + 8 * cg, w1, x1); hy_sconv8(P, base, t0 + tl, L, 1024 + c0 + 8 * cg, wv, v);
        __syncthreads();
#pragma unroll
        for (int i = 0; i < 8; ++i) Zs[(8 * cg + i) * HLD + tl] = f2bf(x1[i] * v[i]);
        __syncthreads();
        { const int c = tid >> 3, seg = tid & 7;
          const u32x4 o = *(const LAS u32x4*)(Zs + c * HLD + 8 * seg);
          bf16* dst = isctx ? (WSP<bf16>(F, WS_ZTC) + ((size_t)(c0 + c) * NB + b) * CTXL + t0 + 8 * seg) : (WSP<bf16>(F, WS_ZT) + ((size_t)(c0 + c) * NB + b) * SEQ + t0 + 8 * seg);
          *(u32x4*)dst = o; }
    }
}
__device__ __forceinline__ void ph_hypost2(Frame& F, int l, bool do_ctx) {
    const bf16* P = WSP<bf16>(F, WS_P);
    const float* cw = IN_(F, 10) + l * 3 * 1536; const float* cb = IN_(F, 11) + l * 1536; const float* skip = IN_(F, 19) + l * 512;
    LAS bf16* Ys = (LAS bf16*)F.lds;
    int tid = F.tid; asm volatile("" : "+v"(tid));
    const int cg = tid & 7, tl = tid >> 3, c0 = (F.bx & 7) * 64;
    float w0[4][8], w1[4][8], wv[4][8], sk[8];
    hy_load_w8(cw, cb, c0 + 8 * cg, w0); hy_load_w8(cw, cb, 512 + c0 + 8 * cg, w1); hy_load_w8(cw, cb, 1024 + c0 + 8 * cg, wv);
#pragma unroll
    for (int i = 0; i < 8; ++i) sk[i] = skip[c0 + 8 * cg + i];
    bf16* HY = WSP<bf16>(F, WS_RET) + 1024;
    const int nit = do_ctx ? 4352 : 4096;
#pragma unroll 1
    for (int it = F.bx; it < nit; it += F.G) {
        int ct, base, t0, L, b; bool isctx; hy_item_decode(it, ct, base, t0, L, b, isctx);
        __syncthreads();
        { const int c = tid >> 3, seg = tid & 7;
          const bf16* src = isctx ? (WSP<bf16>(F, WS_YTC) + ((size_t)(c0 + c) * NB + b) * CTXL + t0 + 8 * seg) : (WSP<bf16>(F, WS_YT) + ((size_t)(c0 + c) * NB + b) * SEQ + t0 + 8 * seg);
          *(LAS u32x4*)(Ys + c * HLD + 8 * seg) = *(const u32x4*)src; }
        float x0[8], x1[8], v[8];
        hy_sconv8(P, base, t0 + tl, L, c0 + 8 * cg, w0, x0); hy_sconv8(P, base, t0 + tl, L, 512 + c0 + 8 * cg, w1, x1); hy_sconv8(P, base, t0 + tl, L, 1024 + c0 + 8 * cg, wv, v);
        __syncthreads();
        float hy[8];
#pragma unroll
        for (int i = 0; i < 8; ++i) { const float y = bf2f(Ys[(8 * cg + i) * HLD + tl]); hy[i] = x0[i] * (y + sk[i] * (x1[i] * v[i])); }
        u32x4 o; o.x = pk2(hy[0], hy[1]); o.y = pk2(hy[2], hy[3]); o.z = pk2(hy[4], hy[5]); o.w = pk2(hy[6], hy[7]);
        *(u32x4*)(HY + (size_t)(base + t0 + tl) * 1536 + c0 + 8 * cg) = o;
    }
}
__device__ __forceinline__ void hyconv_ctx_item2(Frame& F, int c) {
    const float* HFp = WSP<float>(F, WS_HFC); const float* HBp = WSP<float>(F, WS_HFC + 512 * 1024);
    LAS float* Kc = (LAS float*)F.lds; LAS float* Zs = Kc + 512;
    const float il1 = hy_inv_l1(F, 2, c);
    const bf16* Z = WSP<bf16>(F, WS_ZTC) + (size_t)c * NB * CTXL; bf16* Yo = WSP<bf16>(F, WS_YTC) + (size_t)c * NB * CTXL;
    const int tid = F.tid;
    __syncthreads();
    if (tid < 511) { const int d = tid - 255; Kc[tid] = (d >= 0 ? HFp[(size_t)d * 512 + c] : HBp[(size_t)(-d) * 512 + c]) * il1; }
#pragma unroll
    for (int i = 0; i < 4; ++i) Zs[tid + 512 * i] = bf2f(Z[tid + 512 * i]);
    __syncthreads();
    const int t = tid & 255, b0 = tid >> 8;
    float a[4] = {0.f, 0.f, 0.f, 0.f};
#pragma unroll 4
    for (int s = 0; s < CTXL; ++s) { const float k = Kc[t - s + 255];
#pragma unroll
        for (int i = 0; i < 4; ++i) a[i] += k * Zs[(b0 + 2 * i) * CTXL + s]; }
#pragma unroll
    for (int i = 0; i < 4; ++i) Yo[(b0 + 2 * i) * CTXL + t] = f2bf(a[i]);
}

constexpr int ALD = 72;
__device__ __forceinline__ void attn_unit(Frame& F, int l, int unit) {
    const bf16* P = WSP<bf16>(F, WS_P);
    LAS bf16* Kb = (LAS bf16*)F.lds; LAS bf16* Vt = Kb + 64 * ALD;
    const bool isctx = unit >= 1024;
    int b, kvh, qb;
    if (!isctx) { b = unit >> 7; kvh = (unit >> 6) & 1; qb = unit & 63; } else { const int it = unit - 1024; b = it >> 3; kvh = (it >> 2) & 1; qb = it & 3; }
    int tid = F.tid; asm volatile("" : "+v"(tid));
    const int lane = tid & 63, w = F.wave, g = w >> 1, h = kvh * 4 + g, lg = lane >> 4, lc = lane & 15;
    const int start = qb * 64, q0 = start + (w & 1) * 32;
    const int rowq0 = isctx ? (NLAT + b * CTXL + q0) : (b * SEQ + q0);
    bf16x8 bq[2][2];
#pragma unroll
    for (int qt = 0; qt < 2; ++qt)
#pragma unroll
        for (int ks = 0; ks < 2; ++ks) bq[qt][ks] = *(const bf16x8*)(P + (size_t)(rowq0 + 16 * qt + lc) * INC + C_AQ + h * 64 + 32 * ks + 8 * lg);
    const float sink = IN_(F, 9)[l * 8 + h];
    float mrun[2], lsum[2]; f32x4 o[4][2];
#pragma unroll
    for (int qt = 0; qt < 2; ++qt) { mrun[qt] = sink; lsum[qt] = (lg == 0) ? 1.0f : 0.0f;
#pragma unroll
        for (int dt = 0; dt < 4; ++dt) o[dt][qt] = (f32x4){0.f, 0.f, 0.f, 0.f}; }
    const int nkb = isctx ? 4 : 9;
    const int key = tid >> 3, d0 = (tid & 7) * 8;
    u32x4 kk, vv;
#define ATT_FETCH(kb_) do { const bool cb_ = isctx || (kb_) >= 5; int row_ = -1; \
        if (cb_) row_ = NLAT + b * CTXL + (isctx ? (kb_) : (kb_) - 5) * 64 + key; \
        else { const int kpos_ = start - 128 + (kb_) * 64 + key; if (kpos_ >= 0 && kpos_ < SEQ) row_ = b * SEQ + kpos_; } \
        kk = (u32x4){0u, 0u, 0u, 0u}; vv = kk; \
        if (row_ >= 0) { kk = *(const u32x4*)(P + (size_t)row_ * INC + C_AK + kvh * 64 + d0); vv = *(const u32x4*)(P + (size_t)row_ * INC + C_AV + kvh * 64 + d0); } } while (0)
    ATT_FETCH(0);
#pragma unroll 1
    for (int kb = 0; kb < nkb; ++kb) {
        const bool ctxblk = isctx || kb >= 5;
        __syncthreads();
        { *(LAS u32x4*)(Kb + key * ALD + d0) = kk;
          const unsigned vw[4] = {vv.x, vv.y, vv.z, vv.w};
#pragma unroll
          for (int i = 0; i < 4; ++i) { Vt[(d0 + 2 * i) * ALD + key] = (bf16)(vw[i] & 0xffffu); Vt[(d0 + 2 * i + 1) * ALD + key] = (bf16)(vw[i] >> 16); } }
        __syncthreads();
        if (kb + 1 < nkb) ATT_FETCH(kb + 1);
        f32x4 s[4][2];
#pragma unroll
        for (int kt = 0; kt < 4; ++kt) {
            const bf16x8 k0 = *(const LAS bf16x8*)(Kb + (16 * kt + lc) * ALD + 8 * lg), k1 = *(const LAS bf16x8*)(Kb + (16 * kt + lc) * ALD + 32 + 8 * lg);
#pragma unroll
            for (int qt = 0; qt < 2; ++qt) { f32x4 c = (f32x4){0.f, 0.f, 0.f, 0.f};
                c = __builtin_amdgcn_mfma_f32_16x16x32_bf16(k0, bq[qt][0], c, 0, 0, 0); c = __builtin_amdgcn_mfma_f32_16x16x32_bf16(k1, bq[qt][1], c, 0, 0, 0);
                s[kt][qt] = c * 0.125f; }
        }
        if (!ctxblk) {
#pragma unroll
            for (int kt = 0; kt < 4; ++kt)
#pragma unroll
                for (int qt = 0; qt < 2; ++qt)
#pragma unroll
                    for (int r = 0; r < 4; ++r) { const int kpos = start - 128 + kb * 64 + 16 * kt + 4 * lg + r, qpos = q0 + 16 * qt + lc, dd = qpos - kpos;
                        const bool valid = (kpos >= 0) && (kpos < SEQ) && (dd <= 128) && (dd >= -128);
                        s[kt][qt][r] = valid ? s[kt][qt][r] : -1.0e30f; }
        }
        bf16x8 pf[2][2];
#pragma unroll
        for (int qt = 0; qt < 2; ++qt) {
            float bm = -3.0e38f;
#pragma unroll
            for (int kt = 0; kt < 4; ++kt) bm = fmaxf(bm, fmaxf(fmaxf(s[kt][qt][0], s[kt][qt][1]), fmaxf(s[kt][qt][2], s[kt][qt][3])));
            bm = fmaxf(bm, __shfl_xor(bm, 16)); bm = fmaxf(bm, __shfl_xor(bm, 32));
            const float mnew = fmaxf(mrun[qt], bm), sc = __expf(mrun[qt] - mnew);
            mrun[qt] = mnew;
            float ps = 0.f; unsigned pw[8];
#pragma unroll
            for (int kt = 0; kt < 4; ++kt) { const float p0 = __expf(s[kt][qt][0] - mnew), p1 = __expf(s[kt][qt][1] - mnew), p2 = __expf(s[kt][qt][2] - mnew), p3 = __expf(s[kt][qt][3] - mnew);
                ps += (p0 + p1) + (p2 + p3); pw[2 * kt] = pk2(p0, p1); pw[2 * kt + 1] = pk2(p2, p3); }
            lsum[qt] = lsum[qt] * sc + ps;
#pragma unroll
            for (int dt = 0; dt < 4; ++dt) o[dt][qt] = o[dt][qt] * sc;
            u32x4 f0; f0.x = pw[0]; f0.y = pw[1]; f0.z = pw[2]; f0.w = pw[3];
            u32x4 f1; f1.x = pw[4]; f1.y = pw[5]; f1.z = pw[6]; f1.w = pw[7];
            pf[qt][0] = __builtin_bit_cast(bf16x8, f0); pf[qt][1] = __builtin_bit_cast(bf16x8, f1);
        }
#pragma unroll
        for (int dt = 0; dt < 4; ++dt)
#pragma unroll
            for (int ks = 0; ks < 2; ++ks) {
                const u32x2 a0 = *(const LAS u32x2*)(Vt + (16 * dt + lc) * ALD + 32 * ks + 4 * lg), a1 = *(const LAS u32x2*)(Vt + (16 * dt + lc) * ALD + 32 * ks + 16 + 4 * lg);
                u32x4 av; av.x = a0.x; av.y = a0.y; av.z = a1.x; av.w = a1.y;
                const bf16x8 va = __builtin_bit_cast(bf16x8, av);
#pragma unroll
                for (int qt = 0; qt < 2; ++qt) o[dt][qt] = __builtin_amdgcn_mfma_f32_16x16x32_bf16(va, pf[qt][ks], o[dt][qt], 0, 0, 0);
            }
    }
#undef ATT_FETCH
    bf16* ATT = WSP<bf16>(F, WS_RET) + 512;
#pragma unroll
    for (int qt = 0; qt < 2; ++qt) {
        float lt = lsum[qt]; lt += __shfl_xor(lt, 16); lt += __shfl_xor(lt, 32);
        const float inv = 1.0f / lt;
        bf16* op = ATT + (size_t)(rowq0 + 16 * qt + lc) * 1536 + h * 64 + 4 * lg;
#pragma unroll
        for (int dt = 0; dt < 4; ++dt) { u32x2 ov; ov.x = pk2(o[dt][qt][0] * inv, o[dt][qt][1] * inv); ov.y = pk2(o[dt][qt][2] * inv, o[dt][qt][3] * inv); *(u32x2*)(op + 16 * dt) = ov; }
    }
}

__device__ __forceinline__ void ph_norm2_router(Frame& F, int l, int nrows) {
    const int lane = F.lane, RPB = nrows / 256;
    LAS float* RW = (LAS float*)F.lds;
    LAS unsigned* cnt = (LAS unsigned*)(F.lds + LDSX + 64);
    __syncthreads();
    { const float* rw = IN_(F, 24) + (size_t)l * 1024 * 32;
      for (int i = F.tid; i < 1024 * 32 / 4; i += NTHR) { const int col = i >> 3, ch = i & 7; *(LAS f32x4*)(RW + col * 32 + ((ch ^ ((col >> 2) & 7)) << 2)) = *(const f32x4*)(rw + 4 * i); } }
    if (F.tid < 32) cnt[F.tid] = 0u;
    { int* SRC = WSP<int>(F, WS_SRC); for (int i = F.bx * NTHR + F.tid; i < MPAD; i += F.G * NTHR) SRC[i] = 0; }
    __syncthreads();
    const float* xm_all = WSP<float>(F, WS_XM);
    const float* gw_ = IN_(F, 23) + l * DM;
    const int e = lane >> 1, sw = lane & 7;
    const float rb = IN_(F, 25)[l * 32 + e];
    int* TOPI = WSP<int>(F, WS_TOPI); float* TOPW = WSP<float>(F, WS_TOPW);
#pragma unroll 1
    for (int rr = F.wave; rr < RPB; rr += NWAVES) {
        const int r = F.bx * RPB + rr, mr = modrow_of(r);
        const float* xr = xm_all + (size_t)r * DM;
        const float* sh = mod_ptr(F, l, mr, 3); const float* sc = mod_ptr(F, l, mr, 4);
        f32x4 v[4]; float ss = 0.f;
#pragma unroll
        for (int j = 0; j < 4; ++j) { v[j] = *(const f32x4*)(xr + 4 * lane + 256 * j); ss += (v[j][0] * v[j][0] + v[j][1] * v[j][1]) + (v[j][2] * v[j][2] + v[j][3] * v[j][3]); }
        const float rstd = 1.0f / sqrtf(wave_sum(ss) * (1.0f / DM) + EPS);
        bf16* o = WSP<bf16>(F, WS_XN) + (size_t)r * DM;
#pragma unroll
        for (int j = 0; j < 4; ++j) { const f32x4 g = *(const f32x4*)(gw_ + 4 * lane + 256 * j); const f32x4 a = *(const f32x4*)(sh + 4 * lane + 256 * j); const f32x4 b = *(const f32x4*)(sc + 4 * lane + 256 * j);
            v[j] = v[j] * rstd * g * (b + 1.0f) + a;
            u32x2 w2; w2.x = pk2(v[j][0], v[j][1]); w2.y = pk2(v[j][2], v[j][3]); *(u32x2*)(o + 4 * lane + 256 * j) = w2; }
        float acc[32];
#pragma unroll
        for (int i = 0; i < 32; ++i) acc[i] = 0.f;
#pragma unroll
        for (int j = 0; j < 4; ++j)
#pragma unroll
            for (int q = 0; q < 4; ++q) { const int col = 4 * lane + q + 256 * j; const float hv = v[j][q];
#pragma unroll
                for (int c8 = 0; c8 < 8; ++c8) { const f32x4 w4 = *(const LAS f32x4*)(RW + col * 32 + ((c8 ^ sw) << 2));
                    acc[4 * c8 + 0] += hv * w4[0]; acc[4 * c8 + 1] += hv * w4[1]; acc[4 * c8 + 2] += hv * w4[2]; acc[4 * c8 + 3] += hv * w4[3]; } }
        float r16[16], r8[8], r4[4], r2[2];
        { const bool hi = (lane & 32) != 0;
#pragma unroll
          for (int i = 0; i < 16; ++i) { const float keep = hi ? acc[16 + i] : acc[i], send = hi ? acc[i] : acc[16 + i]; r16[i] = keep + __shfl_xor(send, 32); } }
        { const bool hi = (lane & 16) != 0;
#pragma unroll
          for (int i = 0; i < 8; ++i) { const float keep = hi ? r16[8 + i] : r16[i], send = hi ? r16[i] : r16[8 + i]; r8[i] = keep + __shfl_xor(send, 16); } }
        { const bool hi = (lane & 8) != 0;
#pragma unroll
          for (int i = 0; i < 4; ++i) { const float keep = hi ? r8[4 + i] : r8[i], send = hi ? r8[i] : r8[4 + i]; r4[i] = keep + __shfl_xor(send, 8); } }
        { const bool hi = (lane & 4) != 0;
#pragma unroll
          for (int i = 0; i < 2; ++i) { const float keep = hi ? r4[2 + i] : r4[i], send = hi ? r4[i] : r4[2 + i]; r2[i] = keep + __shfl_xor(send, 4); } }
        float logit;
        { const bool hi = (lane & 2) != 0; const float keep = hi ? r2[1] : r2[0], send = hi ? r2[0] : r2[1]; logit = keep + __shfl_xor(send, 2); }
        logit += __shfl_xor(logit, 1);
        logit += rb;
        float tv[4]; int ti[4];
        float cur = logit;
#pragma unroll
        for (int k = 0; k < 4; ++k) {
            float bvv = cur; int bi = e;
#pragma unroll
            for (int off = 2; off < 64; off <<= 1) { const float ov = __shfl_xor(bvv, off); const int oi = __shfl_xor(bi, off);
                if (ov > bvv || (ov == bvv && oi < bi)) { bvv = ov; bi = oi; } }
            tv[k] = bvv; ti[k] = bi;
            if (e == bi) cur = -3.0e38f;
        }
        const float mx = tv[0];
        float ex[4], den = 0.f;
#pragma unroll
        for (int k = 0; k < 4; ++k) { ex[k] = __expf(tv[k] - mx); den += ex[k]; }
        if (lane < 4) { const int k = lane; const int id = (k == 0) ? ti[0] : (k == 1) ? ti[1] : (k == 2) ? ti[2] : ti[3]; const float wv = ((k == 0) ? ex[0] : (k == 1) ? ex[1] : (k == 2) ? ex[2] : ex[3]) / den;
            TOPI[r * 4 + k] = id; TOPW[r * 4 + k] = wv; __hip_atomic_fetch_add(cnt + id, 1u, __ATOMIC_RELAXED, __HIP_MEMORY_SCOPE_WORKGROUP); }
    }
    __syncthreads();
    if (F.tid < 32) WSP<int>(F, WS_BLKCNT)[F.bx * 32 + F.tid] = (int)cnt[F.tid];
}

__device__ __forceinline__ void ph_moe_assign(Frame& F, int nrows) {
    const int RPB = nrows / 256, lane = F.lane;
    LAS int* part = (LAS int*)F.lds;
    LAS int* base = part + 1024;
    LAS int* idx = base + 32;
    LAS int* posl = idx + 1024;
    const int* BC = WSP<int>(F, WS_BLKCNT);
    __syncthreads();
    { const int e = F.tid & 31, pt = F.tid >> 5; int st = 0, sp = 0;
      for (int q = 0; q < 16; ++q) { const int blk = pt * 16 + q; const int v = BC[blk * 32 + e]; st += v; if (blk < F.bx) sp += v; }
      part[pt * 32 + e] = st; part[512 + pt * 32 + e] = sp; }
    for (int i = F.tid; i < RPB * 4; i += NTHR) idx[i] = WSP<int>(F, WS_TOPI)[F.bx * RPB * 4 + i];
    __syncthreads();
    if (F.tid < 32) { int st = 0, sp = 0; for (int q = 0; q < 16; ++q) { st += part[q * 32 + F.tid]; sp += part[512 + q * 32 + F.tid]; }
        part[F.tid] = st; part[512 + F.tid] = sp; }
    __syncthreads();
    if (F.tid == 0) { int t0 = 0; int* tl = WSP<int>(F, WS_TILES);
        for (int e = 0; e < 32; ++e) { base[e] = t0 * 256 + part[512 + e]; if (F.bx == 0) tl[e] = t0; t0 += (part[e] + 255) >> 8; }
        if (F.bx == 0) tl[32] = t0; }
    __syncthreads();
    if (F.tid < 32) { const int e = F.tid; int c = base[e]; for (int j = 0; j < RPB * 4; ++j) if (idx[j] == e) posl[j] = c++; }
    __syncthreads();
    int* POS = WSP<int>(F, WS_POS); int* SRC = WSP<int>(F, WS_SRC);
    for (int j = F.tid; j < RPB * 4; j += NTHR) { const int p = posl[j]; POS[F.bx * RPB * 4 + j] = p; SRC[p] = F.bx * RPB + (j >> 2); }
}

#define PHASE_FN __device__ __forceinline__
PHASE_FN void P_prologue() { Frame F = make_frame(); p0_prologue(F); }
PHASE_FN void P_norm1(int mode) { Frame F = make_frame(); ph_norm1(F, mode);
    if (mode == 0) { FftTw T; fft_tw_init(T, F.tid); for (int it = F.bx; it < 1024; it += F.G) fft_filter_unit(F, T, it >> 9, it & 511); } }
PHASE_FN void P_inproj(int l) { Frame F = make_frame();
    pg8::Gemm g{WSP<bf16>(F, WS_XN), WSP<bf16>(F, WS_WIN) + (size_t)l * INC * 1024, NROWS, INC, 1024};
    pg8::StaticOrder S; S.init(NROWS, INC, F.G, F.bx);
    EpiP E{WSP<bf16>(F, WS_P)};
    pg8::gemm_phase<EpiP, pg8::StaticOrder, true, true>(F.lds, g, S, E); }
PHASE_FN void P_rope() { Frame F = make_frame(); ph_rope(F); }
PHASE_FN void P_mix(int l) { Frame F = make_frame(); const bool last = (l == 1);
    const int na = last ? 1024 : 1088;
    for (int it = F.bx; it < na; it += F.G) attn_unit(F, l, it);
    for (int it = F.G - 1 - F.bx; it < 1088; it += F.G) ret_kv_unit(F, l, it);
    ph_hyprep2(F, l, !last); }

PHASE_FN void P_hyconv(int l) { Frame F = make_frame(); const bool last = (l == 1);
    ret_scan(F, l);
    { FftTw T; fft_tw_init(T, F.tid); unsigned zp[8];
      { const int u0 = F.bx; const bf16* n1 = WSP<bf16>(F, WS_ZT) + ((size_t)(u0 >> 2) * NB + 2 * (u0 & 3)) * SEQ; const bf16* n2 = n1 + SEQ;
#pragma unroll
        for (int q = 0; q < 8; ++q) { const int n = F.tid + 512 * q; zp[q] = (unsigned)n1[n] | ((unsigned)n2[n] << 16); } }
      for (int it = F.bx; it < 2048; it += F.G) fft_conv_unit(F, T, l, it, it + F.G, zp); }
    if (!last) for (int it = F.bx; it < 512; it += F.G) hyconv_ctx_item2(F, it); }
PHASE_FN void P_hypost(int l) { Frame F = make_frame(); const bool last = (l == 1);
    for (int it = F.bx; it < 1088; it += F.G) { const int ci = it % 34; if (last && ci < 2) continue; ret_out_unit(F, l, it); }
    ph_hypost2(F, l, !last); }
PHASE_FN void P_merge(int l) { Frame F = make_frame(); const int mrows = (l == 1) ? NLAT : NROWS;
    pg8::Gemm g{WSP<bf16>(F, WS_RET), WSP<bf16>(F, WS_WBR) + (size_t)l * 1024 * 1536, mrows, 1024, 1536};
    pg8::StaticOrder S; S.init(mrows, 1024, F.G, F.bx);
    EpiMerge E{WSP<bf16>(F, WS_P), IN_(F, 21) + l * 3072, WSP<bf16>(F, WS_M)};
    pg8::gemm_phase<EpiMerge, pg8::StaticOrder, true, true>(F.lds, g, S, E); }
PHASE_FN void P_out(int l) { Frame F = make_frame(); const int mrows = (l == 1) ? NLAT : NROWS;
    pg8::Gemm g{WSP<bf16>(F, WS_M), WSP<bf16>(F, WS_WOUT) + (size_t)l * 1024 * 1024, mrows, 1024, 1024};
    pg8::StaticOrder S; S.init(mrows, 1024, F.G, F.bx);
    const float* xl = (l == 0) ? IN_(F, 0) : WSP<float>(F, WS_XO);
    const float* xc = (l == 0) ? IN_(F, 2) : WSP<float>(F, WS_XO) + (size_t)NLAT * DM;
    EpiOut E{xl, xc, mod_ptr(F, l, 0, 2), WSP<float>(F, WS_XM)};
    pg8::gemm_phase<EpiOut, pg8::StaticOrder, true, true>(F.lds, g, S, E); }
PHASE_FN void P_router(int l) { Frame F = make_frame(); ph_norm2_router(F, l, (l == 1) ? NLAT : NROWS); }
PHASE_FN void P_assign(int l) { Frame F = make_frame(); ph_moe_assign(F, (l == 1) ? NLAT : NROWS); }
PHASE_FN void P_moe1(int l) { Frame F = make_frame();
    LAS int* list = (LAS int*)(F.lds + LDSX + 256);
    const int n = moe_list_units(F, 8, list);
    LAS int* srcl = (LAS int*)(F.lds + LDS_SRC);
    { const int* SRC = WSP<int>(F, WS_SRC);
      for (int i = F.tid; i < n * 256; i += NTHR) srcl[i] = SRC[list[2 * (i >> 8)] * 256 + (i & 255)]; }
    __syncthreads();
    pg8::Gemm g{WSP<bf16>(F, WS_XN), WSP<bf16>(F, WS_W1) + (size_t)l * 32 * 2048 * 1024, MPAD, 32 * 2048, 1024};
    MoeOrderG S{srcl, list, n};
    EpiMoe1 E{IN_(F, 27) + (size_t)l * 32 * 2048, WSP<bf16>(F, WS_ACT)};
    pg8::gemm_phase<EpiMoe1, MoeOrderG, true, true>(F.lds, g, S, E); }
PHASE_FN void P_moe2(int l) { Frame F = make_frame();
    LAS int* list = (LAS int*)(F.lds + LDSX + 256);
    const int n = moe_list_units(F, 4, list);
    pg8::Gemm g{WSP<bf16>(F, WS_ACT), WSP<bf16>(F, WS_W2) + (size_t)l * 32 * 1024 * 1024, MPAD, 32 * 1024, 1024};
    MoeOrder S{nullptr, list, n};
    EpiMoe2 E{IN_(F, 29) + (size_t)l * 32 * 1024, WSP<bf16>(F, WS_HS)};
    pg8::gemm_phase<EpiMoe2, MoeOrder, true, true>(F.lds, g, S, E); }

template <int ONLY> __global__ void __launch_bounds__(NTHR, 2) mk_fwd(Args args) {
    LAS unsigned char* lds = (LAS unsigned char*)lds_raw;
    const int tid = threadIdx.x;
    for (int u = tid; u < (LDS_BYTES - LDSX) / 4; u += NTHR) ((LAS unsigned*)(lds + LDSX))[u] = 0u;
    __syncthreads();
    if (tid < 33) { const unsigned long long v = (tid < 31) ? (unsigned long long)args.in[tid] : (tid == 31 ? (unsigned long long)args.out : (unsigned long long)args.ws);
        *(LAS unsigned long long*)(lds + LDS_PTAB + 8 * tid) = v; }
    __syncthreads();
    const int lo = args.ph_lo, hi = args.ph_hi;
    const bool one_launch = (hi - lo) > 1;
    unsigned* barw = (unsigned*)(args.ws + WS_CTL + CTL_BAR);
    XcdBarrier bar; bar.bar = barw; bar.x = 0; bar.st = nullptr;
    if (one_launch) bar = xcd_barrier_post(barw, (volatile LAS unsigned*)(lds + LDSX));
#ifndef MK_MASK
#define MK_MASK 0xFFFFFFFFu
#endif
#define ENAB(k) ((ONLY < 0 && ((MK_MASK >> ((k) >= 100 ? (k) - 100 + 14 : (k))) & 1u)) || ONLY == (k))
#ifndef MK_REP
#define MK_REP 0u
#endif
#define REPB(k) (((MK_REP) >> ((k) >= 100 ? (k) - 100 + 14 : (k))) & 1u)
#define IN(k) (lo <= (k) && (k) < hi)
#define SEAM(k) do { if (IN(k) && IN((k) + 1)) xcd_barrier(bar); } while (0)
    if (ENAB(100)) if (IN(0)) { P_prologue(); if (REPB(100)) { xcd_barrier(bar); P_prologue(); } } SEAM(0);
    for (int l = 0; l < 2; ++l) {
        const int pb = 1 + NPH_LAYER * l;
        if (ENAB(0)) if (IN(pb + 0)) { P_norm1(l == 0 ? 0 : 1); if (REPB(0)) { xcd_barrier(bar); P_norm1(l == 0 ? 0 : 1); } } SEAM(pb + 0);
        if (ENAB(1)) if (IN(pb + 1)) { P_inproj(l); if (REPB(1)) { xcd_barrier(bar); P_inproj(l); } } SEAM(pb + 1);
        if (ENAB(3)) if (IN(pb + 3)) { P_mix(l); if (REPB(3)) { xcd_barrier(bar); P_mix(l); } } SEAM(pb + 3);
        if (ENAB(4)) if (IN(pb + 4)) { P_hyconv(l); if (REPB(4)) { xcd_barrier(bar); P_hyconv(l); } } SEAM(pb + 4);
        if (ENAB(5)) if (IN(pb + 5)) { P_hypost(l); if (REPB(5)) { xcd_barrier(bar); P_hypost(l); } } SEAM(pb + 5);
        if (ENAB(6)) if (IN(pb + 6)) { P_merge(l); } SEAM(pb + 6);
        if (ENAB(9)) if (IN(pb + 9)) { P_out(l); if (REPB(9)) { xcd_barrier(bar); P_out(l); } } SEAM(pb + 9);
        if (ENAB(10)) if (IN(pb + 10)) { P_router(l); if (REPB(10)) { xcd_barrier(bar); P_router(l); } } SEAM(pb + 10);
        if (ENAB(11)) if (IN(pb + 11)) { P_assign(l); if (REPB(11)) { xcd_barrier(bar); P_assign(l); } } SEAM(pb + 11);
        if (ENAB(12)) if (IN(pb + 12)) { P_moe1(l); if (REPB(12)) { xcd_barrier(bar); P_moe1(l); } } SEAM(pb + 12);
        if (ENAB(13)) if (IN(pb + 13)) { P_moe2(l); if (REPB(13)) { xcd_barrier(bar); P_moe2(l); } } SEAM(pb + 13);
    }
    if (ENAB(101)) if (IN(NPH - 1)) { P_norm1(2); }
#undef IN
#undef SEAM
#undef ENAB
}

template <int ONLY> static void launch_phase(Args a, int lo, int hi, int grid, hipStream_t stream) {
    static bool attr_set = false;
    if (!attr_set) { (void)hipFuncSetAttribute((const void*)mk_fwd<ONLY>, hipFuncAttributeMaxDynamicSharedMemorySize, LDS_BYTES); attr_set = true; }
    a.ph_lo = lo; a.ph_hi = hi;
    hipLaunchKernelGGL(mk_fwd<ONLY>, dim3(grid), dim3(NTHR), LDS_BYTES, stream, a);
}
extern "C" void kernel_launch(void* const* d_in, const int* in_sizes, int n_in, void* d_out, int out_size, void* d_ws, size_t ws_size, hipStream_t stream) {
    static int grid = 0;
    if (grid == 0) {
        if (n_in != 31 || ws_size < WS_END) { fprintf(stderr, "kernel_launch: unexpected n_in %d / ws_size %zu\n", n_in, ws_size); grid = -1; return; }
        int dev = 0, cus = 0;
        if (hipGetDevice(&dev) != hipSuccess || hipDeviceGetAttribute(&cus, hipDeviceAttributeMultiprocessorCount, dev) != hipSuccess) { grid = -1; return; }
        grid = (cus == 256) ? 256 : -1;
        if (grid < 0) { fprintf(stderr, "kernel_launch: needs a 256-CU device, got %d\n", cus); return; }
    }
    if (grid < 0) return;
    (void)hipMemsetAsync((char*)d_ws + WS_CTL, 0, CTL_ZERO_BYTES, stream);
    Args a{};
    for (int i = 0; i < 31; ++i) a.in[i] = (const float*)d_in[i];
    a.out = (float*)d_out; a.ws = (unsigned char*)d_ws;
#if MK_ONE_LAUNCH
    launch_phase<-1>(a, 0, NPH, grid, stream);
#else
    launch_phase<100>(a, 0, 1, grid, stream);
    for (int l = 0; l < 2; ++l) {
        const int pb = 1 + NPH_LAYER * l;
        launch_phase<0>(a, pb + 0, pb + 1, grid, stream);   launch_phase<1>(a, pb + 1, pb + 2, grid, stream);   launch_phase<2>(a, pb + 2, pb + 3, grid, stream);
        launch_phase<3>(a, pb + 3, pb + 4, grid, stream);   launch_phase<4>(a, pb + 4, pb + 5, grid, stream);   launch_phase<5>(a, pb + 5, pb + 6, grid, stream);
        launch_phase<6>(a, pb + 6, pb + 7, grid, stream);   launch_phase<7>(a, pb + 7, pb + 8, grid, stream);   launch_phase<8>(a, pb + 8, pb + 9, grid, stream);
        launch_phase<9>(a, pb + 9, pb + 10, grid, stream);  launch_phase<10>(a, pb + 10, pb + 11, grid, stream); launch_phase<11>(a, pb + 11, pb + 12, grid, stream);
        launch_phase<12>(a, pb + 12, pb + 13, grid, stream); launch_phase<13>(a, pb + 13, pb + 14, grid, stream);
    }
    launch_phase<101>(a, NPH - 1, NPH, grid, stream);
#endif
}
```

```cpp
#include <hip/hip_runtime.h>
#include <cstdio>
#include <cstdint>
#define MK_ONE_LAUNCH 1
namespace pg8 {
#define PG8_LAS __attribute__((address_space(3)))
typedef unsigned short bf16_t;
typedef short bf16x8 __attribute__((ext_vector_type(8)));
typedef float f32x4 __attribute__((ext_vector_type(4)));
typedef unsigned u32x4 __attribute__((ext_vector_type(4)));
constexpr int BM = 256, BK = 64, HALF = 128, HTB = HALF * BK * 2  , STAGE_BYTES = 8 * HTB, NXCD = 8, WGM = 8;

__host__ __device__ __forceinline__ int lds_byte(int r, int c) { const int st = (r >> 4) * 2 + (c >> 5), rr = r & 15, cc = c & 31, ob = rr * 64 + cc * 2; return st * 1024 + (ob ^ (((ob >> 9) & 1) << 5)); }
__host__ __device__ __forceinline__ void stage_rc(int b, int& R, int& C) { const int st = b / 1024, sb = b % 1024, swz = sb ^ (((sb >> 9) & 1) << 5); R = (st >> 1) * 16 + swz / 64; C = (st & 1) * 32 + (swz % 64) / 2; }
__host__ __device__ __forceinline__ int perm32(int rho) { const int n = rho >> 4, i = rho & 15; return 8 * (i >> 2) + 4 * n + (i & 3); }

struct Unit { int pm, pn; };
struct Gemm { const bf16_t* A; const bf16_t* Bt; int M, N, K; };

struct StaticOrder {
    static constexpr bool GATHER = false; const PG8_LAS int* src;
    int nM, nN, nwg, G, c;
    __host__ __device__ void init(int M, int N, int G_, int c_) { nM = M / BM; nN = N / BM; nwg = nM * nN; G = G_; c = c_; }
    __host__ __device__ bool next(int i, Unit& u) const {
        const long L = (long)i * G + c; if (L >= nwg) return false;
        int wgid = (int)L; { const int q = nwg / NXCD, r = nwg % NXCD, xcd = wgid % NXCD, off = wgid / NXCD; wgid = (xcd < r ? xcd * (q + 1) : r * (q + 1) + (xcd - r) * q) + off; }
        const int nig = WGM * nN, gid = wgid / nig, fm = gid * WGM, gsz = (nM - fm) < WGM ? (nM - fm) : WGM;
        u.pm = fm + ((wgid % nig) % gsz); u.pn = (wgid % nig) / gsz; return true;
    }
    __device__ __forceinline__ void a_ready(const Unit&) const {}
    __device__ __forceinline__ void done(const Unit&) const {}
};

__device__ __forceinline__ unsigned cvt_pk_bf16(float lo, float hi) { unsigned r; asm("v_cvt_pk_bf16_f32 %0, %1, %2" : "=v"(r) : "v"(lo), "v"(hi));     return r; }
template <class Epi, class Sched, bool ALIGN_EPI = false, bool SP2 = false>
__device__ __forceinline__ void gemm_phase(PG8_LAS unsigned char* lds, const Gemm g, const Sched& S, const Epi& E) {
    int tid_ = threadIdx.x; asm volatile("" : "+v"(tid_));
    const int tid = tid_, wid = __builtin_amdgcn_readfirstlane(tid >> 6), lane = tid & 63, wr = wid >> 2, wc = wid & 3, fr = lane & 15, fq = lane >> 4;
    const int K = g.K, nt = K / BK;
    unsigned voffA[2], voffB[2];
#pragma unroll
    for (int i = 0; i < 2; ++i) { int R, C; stage_rc(tid * 16 + i * 8192, R, C); const int Rb = Epi::PERM ? ((R & ~31) + perm32(R & 31)) : R;
        voffA[i] = (unsigned)(R * K + C) * 2u; voffB[i] = (unsigned)(Rb * K + C) * 2u; }
    constexpr bool GATHER = Sched::GATHER;
    static_assert(!GATHER || SP2, "the gathered A path is wired into the SP2 loop only");
    unsigned vAc[2][2], vAn[2][2];
#define PG8_GIDX(dst, ord) do { _Pragma("unroll") for (int _h = 0; _h < 2; ++_h) _Pragma("unroll") for (int _i = 0; _i < 2; ++_i) { int _R, _C; stage_rc(tid * 16 + _i * 8192, _R, _C); \
        dst[_h][_i] = (unsigned)S.src[(ord) * 256 + _h * 128 + _R] * (unsigned)(K * 2) + (unsigned)(_C * 2); } } while (0)
    const size_t kstep = (size_t)(BK * 2);
    const size_t hstep = (size_t)HALF * K * 2;
    const size_t tstep = 2 * hstep;
    const unsigned ldsw = (unsigned)wid * 1024u;
    const int aoff = lds_byte(wr * 64 + fr, fq * 8), boff = lds_byte(wc * 32 + fr, fq * 8);
#define PG8_SA(b, h) (((b) * 2 + (h)) * HTB)
#define PG8_SB(b, h) ((4 + (b) * 2 + (h)) * HTB)
#define PG8_STAGE(bufoff, gbase, voff) do { _Pragma("unroll") for (int _i = 0; _i < 2; ++_i) \
        __builtin_amdgcn_global_load_lds((const unsigned*)((const char*)(gbase) + (voff)[_i]), (PG8_LAS unsigned*)(lds + (bufoff) + ldsw + _i * 8192), 16, 0, 0); } while (0)
#define PG8_STAGE_A(bufoff, gbase, h, vg) do { if constexpr (GATHER) { PG8_STAGE(bufoff, gbase, (vg)[h]); } else { PG8_STAGE(bufoff, (gbase) + ((h) ? hstep : 0), voffA); } } while (0)
#define PG8_LDA(dst, b, h) do { _Pragma("unroll") for (int m = 0; m < 4; ++m) _Pragma("unroll") for (int k = 0; k < 2; ++k) dst[m][k] = *(const PG8_LAS bf16x8*)(lds + PG8_SA(b, h) + aoff + m * 2048 + k * 1024); } while (0)
#define PG8_LDB(dst, b, h) do { _Pragma("unroll") for (int n = 0; n < 2; ++n) _Pragma("unroll") for (int k = 0; k < 2; ++k) dst[n][k] = *(const PG8_LAS bf16x8*)(lds + PG8_SB(b, h) + boff + n * 2048 + k * 1024); } while (0)
#define PG8_MMA(ai, bj, At, Bt) do { __builtin_amdgcn_s_setprio(1); _Pragma("unroll") for (int m = 0; m < 4; ++m) _Pragma("unroll") for (int n = 0; n < 2; ++n) _Pragma("unroll") for (int k = 0; k < 2; ++k) \
        acc[ai][bj][m][n] = __builtin_amdgcn_mfma_f32_16x16x32_bf16(Bt[n][k], At[m][k], acc[ai][bj][m][n], 0, 0, 0); __builtin_amdgcn_s_setprio(0); } while (0)
#define PG8_WAIT_V(n) asm volatile("s_waitcnt vmcnt(" #n ")" ::: "memory")
#define PG8_WAIT_L(n) asm volatile("s_waitcnt lgkmcnt(" #n ")" ::: "memory")
#define PG8_BAR __builtin_amdgcn_s_barrier()
#define PG8_SCHED __builtin_amdgcn_sched_barrier(0)
    Unit cur, nxt; int ui = 0;
    if (!S.next(0, cur)) return;
    f32x4 acc[2][2][4][2];
#pragma unroll
    for (int a = 0; a < 2; ++a)
#pragma unroll
        for (int b = 0; b < 2; ++b)
#pragma unroll
            for (int m = 0; m < 4; ++m)
#pragma unroll
                for (int n = 0; n < 2; ++n) acc[a][b][m][n] = (f32x4){0.f, 0.f, 0.f, 0.f};
    bf16x8 At[4][2], B0[2][2], B1[2][2];
    const char* cA = (const char*)g.A + (GATHER ? (size_t)0 : (size_t)cur.pm * tstep); const char* cB = (const char*)g.Bt + (size_t)cur.pn * tstep;
    S.a_ready(cur);
    if constexpr (GATHER) { PG8_GIDX(vAc, 0); }
    if constexpr (SP2) {
        PG8_STAGE(PG8_SB(0, 0), cB, voffB); PG8_STAGE(PG8_SB(0, 1), cB + hstep, voffB); PG8_STAGE_A(PG8_SA(0, 0), cA, 0, vAc); PG8_STAGE_A(PG8_SA(0, 1), cA, 1, vAc);
        if (wr == 1) PG8_BAR;
        PG8_WAIT_V(2); PG8_BAR;
        PG8_STAGE(PG8_SB(1, 0), cB + kstep, voffB); PG8_STAGE_A(PG8_SA(1, 0), cA + kstep, 0, vAc); PG8_STAGE(PG8_SB(1, 1), cB + hstep + kstep, voffB);
        PG8_WAIT_V(6); PG8_BAR;
    } else {
        PG8_STAGE(PG8_SB(0, 0), cB, voffB); PG8_STAGE(PG8_SA(0, 0), cA, voffA); PG8_STAGE(PG8_SB(0, 1), cB + hstep, voffB); PG8_STAGE(PG8_SA(0, 1), cA + hstep, voffA);
        if (wr == 1) PG8_BAR;
        PG8_WAIT_V(4); PG8_BAR;
        PG8_STAGE(PG8_SB(1, 0), cB + kstep, voffB); PG8_STAGE(PG8_SA(1, 0), cA + kstep, voffA); PG8_STAGE(PG8_SB(1, 1), cB + hstep + kstep, voffB);
        PG8_WAIT_V(6); PG8_BAR;
    }
    for (;;) {
        const bool has_next = S.next(ui + 1, nxt);
        if constexpr (GATHER) { if (has_next) { PG8_GIDX(vAn, ui + 1); } else { _Pragma("unroll") for (int _h = 0; _h < 2; ++_h) _Pragma("unroll") for (int _i = 0; _i < 2; ++_i) vAn[_h][_i] = vAc[_h][_i]; } }
        const char* nA = GATHER ? cA : (has_next ? (const char*)g.A + (size_t)nxt.pm * tstep : cA); const char* nB = has_next ? (const char*)g.Bt + (size_t)nxt.pn * tstep : cB;
        for (int t = 0; t < nt; t += 2) {
            if constexpr (Epi::KMID) { if (t == 8 || t == 16) E.kmid(t, acc, cur, wr, wc, fr, fq); }
            const bool last = (t == nt - 2);
            const char* a1 = cA + (size_t)(t + 1) * kstep;
            const char* a2 = last ? nA : cA + (size_t)(t + 2) * kstep; const char* b2 = last ? nB : cB + (size_t)(t + 2) * kstep;
            const char* a3 = a2 + kstep; const char* b3 = b2 + kstep;
            if (last && has_next) S.a_ready(nxt);
            unsigned v2[2][2];
            if constexpr (GATHER) { _Pragma("unroll") for (int _h = 0; _h < 2; ++_h) _Pragma("unroll") for (int _i = 0; _i < 2; ++_i) v2[_h][_i] = last ? vAn[_h][_i] : vAc[_h][_i]; }
            if constexpr (SP2) {
            PG8_LDB(B0, 0, 0); PG8_LDB(B1, 0, 1); PG8_SCHED; PG8_LDA(At, 0, 0); PG8_STAGE_A(PG8_SA(1, 1), a1, 1, vAc);
            PG8_WAIT_V(8); PG8_WAIT_L(0); PG8_BAR; PG8_MMA(0, 0, At, B0); PG8_MMA(0, 1, At, B1); PG8_BAR; PG8_SCHED;
            PG8_LDA(At, 0, 1); PG8_STAGE(PG8_SB(0, 0), b2, voffB); PG8_STAGE(PG8_SB(0, 1), b2 + hstep, voffB); PG8_STAGE_A(PG8_SA(0, 0), a2, 0, v2);
            PG8_WAIT_V(8); PG8_WAIT_L(0); PG8_BAR; PG8_MMA(1, 0, At, B0); PG8_MMA(1, 1, At, B1); PG8_BAR; PG8_SCHED;
            PG8_LDB(B0, 1, 0); PG8_LDB(B1, 1, 1); PG8_SCHED; PG8_LDA(At, 1, 0); PG8_STAGE_A(PG8_SA(0, 1), a2, 1, v2);
            PG8_WAIT_V(8); PG8_WAIT_L(0); PG8_BAR; PG8_MMA(0, 0, At, B0); PG8_MMA(0, 1, At, B1); PG8_BAR; PG8_SCHED;
            PG8_LDA(At, 1, 1); PG8_STAGE(PG8_SB(1, 0), b3, voffB); PG8_STAGE(PG8_SB(1, 1), b3 + hstep, voffB); PG8_STAGE_A(PG8_SA(1, 0), a3, 0, v2);
            PG8_WAIT_V(8); PG8_WAIT_L(0); PG8_BAR; PG8_MMA(1, 0, At, B0); PG8_MMA(1, 1, At, B1); PG8_BAR; PG8_SCHED;
            } else {
            PG8_LDB(B0, 0, 0); PG8_SCHED; PG8_LDA(At, 0, 0); PG8_STAGE(PG8_SA(1, 1), a1 + hstep, voffA);
            PG8_WAIT_L(8); PG8_BAR; PG8_WAIT_L(0); PG8_MMA(0, 0, At, B0); PG8_BAR; PG8_SCHED;
            PG8_LDB(B1, 0, 1); PG8_STAGE(PG8_SB(0, 0), b2, voffB);
            PG8_BAR; PG8_WAIT_L(0); PG8_MMA(0, 1, At, B1); PG8_BAR;
            PG8_LDA(At, 0, 1); PG8_STAGE(PG8_SA(0, 0), a2, voffA);
            PG8_BAR; PG8_WAIT_L(0); PG8_MMA(1, 0, At, B0); PG8_BAR; PG8_SCHED;
            PG8_STAGE(PG8_SB(0, 1), b2 + hstep, voffB);
            PG8_WAIT_V(6); PG8_BAR; PG8_MMA(1, 1, At, B1); PG8_BAR;
            PG8_LDB(B0, 1, 0); PG8_SCHED; PG8_LDA(At, 1, 0); PG8_STAGE(PG8_SA(0, 1), a2 + hstep, voffA);
            PG8_WAIT_L(8); PG8_BAR; PG8_WAIT_L(0); PG8_MMA(0, 0, At, B0); PG8_BAR; PG8_SCHED;
            PG8_LDB(B1, 1, 1); PG8_STAGE(PG8_SB(1, 0), b3, voffB);
            PG8_BAR; PG8_WAIT_L(0); PG8_MMA(0, 1, At, B1); PG8_BAR;
            PG8_LDA(At, 1, 1); PG8_STAGE(PG8_SA(1, 0), a3, voffA);
            PG8_BAR; PG8_WAIT_L(0); PG8_MMA(1, 0, At, B0); PG8_BAR; PG8_SCHED;
            PG8_STAGE(PG8_SB(1, 1), b3 + hstep, voffB);
            PG8_WAIT_V(6); PG8_BAR; PG8_MMA(1, 1, At, B1); PG8_BAR;
            }
        }
        if constexpr (ALIGN_EPI) { if (wr == 0) PG8_BAR; }
        if constexpr (!Epi::AFTER_DRAIN) { E(acc, cur, wr, wc, fr, fq);
#ifdef MK_EPI2
            asm volatile("" ::: "memory"); E(acc, cur, wr, wc, fr, fq);
#endif
#ifdef MK_EPI3
            { char* sp = (char*)MK_EPI3_BASE + (size_t)blockIdx.x * 131072 + (size_t)wid * 16384 + (size_t)lane * 16;
              _Pragma("unroll") for (int q_ = 0; q_ < 16; ++q_) { u32x4 w_; w_.x = __float_as_uint(acc[q_ >> 3][(q_ >> 2) & 1][q_ & 3][0][0]); w_.y = __float_as_uint(acc[q_ >> 3][(q_ >> 2) & 1][q_ & 3][0][1]); w_.z = __float_as_uint(acc[q_ >> 3][(q_ >> 2) & 1][q_ & 3][1][0]); w_.w = __float_as_uint(acc[q_ >> 3][(q_ >> 2) & 1][q_ & 3][1][1]);
                  *(u32x4*)(sp + q_ * 1024) = w_; } }
#endif
            S.done(cur); }
        if (!has_next) break;
#pragma unroll
        for (int a = 0; a < 2; ++a)
#pragma unroll
            for (int b = 0; b < 2; ++b)
#pragma unroll
                for (int m = 0; m < 4; ++m)
#pragma unroll
                    for (int n = 0; n < 2; ++n) acc[a][b][m][n] = (f32x4){0.f, 0.f, 0.f, 0.f};
        cur = nxt; cA = nA; cB = nB; ++ui;
        if constexpr (GATHER) { _Pragma("unroll") for (int _h = 0; _h < 2; ++_h) _Pragma("unroll") for (int _i = 0; _i < 2; ++_i) vAc[_h][_i] = vAn[_h][_i]; }
        if constexpr (ALIGN_EPI) { if (wr == 1) PG8_BAR; }
    }
    PG8_WAIT_V(0);
    if constexpr (!ALIGN_EPI) { if (wr == 0) PG8_BAR; }
    PG8_BAR;
    if constexpr (Epi::AFTER_DRAIN) { E.fused(acc, cur, wr, wc, fr, fq, lds, wid, lane); S.done(cur); }
#undef PG8_SA
#undef PG8_SB
#undef PG8_STAGE
#undef PG8_STAGE_A
#undef PG8_GIDX
#undef PG8_LDA
#undef PG8_LDB
#undef PG8_MMA
#undef PG8_WAIT_V
#undef PG8_WAIT_L
#undef PG8_BAR
#undef PG8_SCHED
}
}
#define XB_TMO      128
#define XB_XCNT(j)  (256  + 64 * (j))
#define XB_XSUB(j)  (1280 + 64 * (j))
#define XB_XGEN(j)  (2304 + 64 * (j))
#define XB_TOP      3328
#define XB_TOPGEN   3392
#define XCD_BAR_WORDS 3456
#define XB_SPIN_CAP (1u << 18)
#define LAS __attribute__((address_space(3)))

__device__ __forceinline__ unsigned xb_ld(unsigned* p)              { return __hip_atomic_load(p, __ATOMIC_RELAXED, __HIP_MEMORY_SCOPE_AGENT); }
__device__ __forceinline__ unsigned xb_add(unsigned* p, unsigned v) { return __hip_atomic_fetch_add(p, v, __ATOMIC_RELAXED, __HIP_MEMORY_SCOPE_AGENT); }
__device__ __forceinline__ unsigned xb_xcc_id() { return (unsigned)__builtin_amdgcn_s_getreg((3 << 11) | 20) & 0xFu; }
#define XB_SPIN(cond, bar) do { unsigned _sp = 0; while (cond) { __builtin_amdgcn_s_sleep(1); \
    if ((++_sp & 255u) == 0u) { if (xb_ld(&(bar)[XB_TMO])) break; if (_sp > XB_SPIN_CAP) { atomicAdd(&(bar)[XB_TMO], 1u); break; } } } } while (0)

struct XcdBarrier {
    unsigned* bar; unsigned x;
    volatile LAS unsigned* st;
};

__device__ __forceinline__ XcdBarrier xcd_barrier_post(unsigned* bar, volatile LAS unsigned* st) {
    XcdBarrier b; b.bar = bar; b.x = xb_xcc_id(); b.st = st;
    if (threadIdx.x == 0) (void)xb_add(&bar[XB_XCNT(b.x)], 1u);
    return b;
}
__device__ __forceinline__ void xcd_barrier_complete(unsigned* bar, unsigned x, unsigned& nloc, unsigned& nx) {
    const unsigned G = gridDim.x * gridDim.y * gridDim.z;
    unsigned sum, cnt, mine, sp = 0u;
    for (;;) {
        sum = 0u; cnt = 0u; mine = 0u;
#pragma unroll
        for (unsigned j = 0; j < 16; ++j) { const unsigned c = xb_ld(&bar[XB_XCNT(j)]); sum += c; cnt += (c > 0u) ? 1u : 0u; mine = (j == x) ? c : mine; }
        if (sum == G) break;
        __builtin_amdgcn_s_sleep(1);
        if ((++sp & 255u) == 0u) { if (xb_ld(&bar[XB_TMO])) break; if (sp > XB_SPIN_CAP) { atomicAdd(&bar[XB_TMO], 1u); break; } }
    }
    nloc = mine > 0u ? mine : 1u; nx = cnt > 0u ? cnt : 1u;
}

__device__ __forceinline__ void xcd_barrier(const XcdBarrier& b) {
    asm volatile("s_waitcnt vmcnt(0)" ::: "memory");
    __syncthreads();
    if (threadIdx.x == 0) {
        unsigned* bar = b.bar;
        __builtin_amdgcn_s_waitcnt(0);
        unsigned nloc = b.st[0], nx = b.st[1];
        if (nloc == 0u) { xcd_barrier_complete(bar, b.x, nloc, nx); b.st[0] = nloc; b.st[1] = nx; }
        const unsigned old = xb_add(&bar[XB_XSUB(b.x)], 1u);
        const unsigned gen = old / nloc;
        if (old + 1u == (gen + 1u) * nloc) {
            __builtin_amdgcn_fence(__ATOMIC_RELEASE, "agent");
            asm volatile("s_waitcnt vmcnt(0)" ::: "memory");
            const unsigned og = xb_add(&bar[XB_TOP], 1u);
            const unsigned tg = og / nx;
            if (og + 1u == (tg + 1u) * nx) xb_add(&bar[XB_TOPGEN], 1u);
            else XB_SPIN(xb_ld(&bar[XB_TOPGEN]) == tg, bar);
            __builtin_amdgcn_fence(__ATOMIC_ACQUIRE, "agent");
            xb_add(&bar[XB_XGEN(b.x)], 1u);
            asm volatile("s_waitcnt vmcnt(0)" ::: "memory");
        } else {
            XB_SPIN(xb_ld(&bar[XB_XGEN(b.x)]) == gen, bar);
            __builtin_amdgcn_fence(__ATOMIC_ACQUIRE, "agent");
            asm volatile("s_waitcnt vmcnt(0)" ::: "memory");
        }
    }
    __syncthreads();
}

#define GAS __attribute__((address_space(1)))
typedef unsigned short bf16;
typedef float f32x4 __attribute__((ext_vector_type(4)));
typedef unsigned u32x4 __attribute__((ext_vector_type(4)));
typedef unsigned u32x2 __attribute__((ext_vector_type(2)));
constexpr int DM = 1024, NB = 8, SEQ = 4096, CTXL = 256, NLAT = NB * SEQ, NCTX = NB * CTXL, NROWS = NLAT + NCTX;
constexpr int INC = 7424;
constexpr int C_RQ = 0, C_RK = 512, C_RV = 1024, C_RG = 1536, C_AQ = 2048, C_AK = 2560, C_AV = 2688, C_HU = 2816, C_MG = 4352;
constexpr int NEXP = 32, DFF = 1024;
constexpr int MPAD = 147456;
constexpr float EPS = 1e-6f;
constexpr int NWAVES = 8, NTHR = 512;
constexpr int LDS_BYTES = 163840, LDSX = 155648, LDS_SRC = 131072;
constexpr int NPH_LAYER = 14, NPH = 1 + 2 * NPH_LAYER + 1;

constexpr size_t MiB = 1u << 20;
constexpr size_t WS_CTL = 0, CTL_ZERO_BYTES = 32768;
constexpr size_t CTL_BAR = 16384;
constexpr size_t CTL_MOD = 262144;
constexpr size_t WS_SRC = 6 * MiB;
constexpr size_t WS_L1P = 5 * MiB;
constexpr size_t WS_TOPI = 1 * MiB, WS_TOPW = 2 * MiB, WS_POS = 3 * MiB, WS_BLKCNT = 4 * MiB, WS_TILES = 4 * MiB + 65536;
constexpr size_t WS_WIN = 8 * MiB, WS_WBR = 37 * MiB, WS_WOUT = 43 * MiB, WS_W1 = 48 * MiB, WS_W2 = 304 * MiB;
constexpr size_t WS_HF = 432 * MiB;
constexpr size_t WS_HFC = 464 * MiB;
constexpr size_t WS_XM = 466 * MiB, WS_XO = 602 * MiB, WS_XN = 738 * MiB;
constexpr size_t WS_A = 806 * MiB;
constexpr size_t WS_P = WS_A, WS_RET = WS_A + 494 * MiB, WS_ATT = WS_RET + 34 * MiB, WS_HY = WS_ATT + 34 * MiB;
constexpr size_t WS_HS = WS_A, WS_ACT = WS_A + 288 * MiB;
constexpr size_t WS_MF32 = 1406 * MiB, WS_M = 1542 * MiB;
constexpr size_t WS_ZT = 1610 * MiB, WS_ZTC = 1674 * MiB, WS_YT = 1678 * MiB, WS_YTC = 1742 * MiB;
constexpr size_t WS_KV = 1746 * MiB, WS_SP = 1882 * MiB, WS_HSPEC = 1950 * MiB, WS_END = 2014 * MiB;
static_assert(WS_HY + 34 * MiB <= WS_MF32 && WS_ACT + 288 * MiB <= WS_MF32, "region A");
static_assert((size_t)NROWS * INC * 2 <= 494 * MiB, "P size");

__device__ __forceinline__ float bf2f(bf16 v) { return __uint_as_float(((unsigned)v) << 16); }
__device__ __forceinline__ bf16 f2bf(float f) { unsigned u = __float_as_uint(f); u += 0x7FFFu + ((u >> 16) & 1u); return (bf16)(u >> 16); }
__device__ __forceinline__ unsigned pk2(float lo, float hi) { return pg8::cvt_pk_bf16(lo, hi); }
#define WS_DPP(v, ctrl) __int_as_float(__builtin_amdgcn_update_dpp(0, __float_as_int(v), (ctrl), 0xF, 0xF, false))
__device__ __forceinline__ float wave_sum(float v) {
    v += WS_DPP(v, 0xB1);
    v += WS_DPP(v, 0x4E);
    v += WS_DPP(v, 0x124);
    v += WS_DPP(v, 0x128);
    const float s0 = __int_as_float(__builtin_amdgcn_readlane(__float_as_int(v), 0)), s1 = __int_as_float(__builtin_amdgcn_readlane(__float_as_int(v), 16));
    const float s2 = __int_as_float(__builtin_amdgcn_readlane(__float_as_int(v), 32)), s3 = __int_as_float(__builtin_amdgcn_readlane(__float_as_int(v), 48));
    return (s0 + s1) + (s2 + s3);
}
__device__ __forceinline__ float rdlane(float v, int l) { return __int_as_float(__builtin_amdgcn_readlane(__float_as_int(v), l)); }
__device__ __forceinline__ float sin_rev(float rev) { return __builtin_amdgcn_sinf(__builtin_amdgcn_fractf(rev)); }
__device__ __forceinline__ float cos_rev(float rev) { return __builtin_amdgcn_cosf(__builtin_amdgcn_fractf(rev)); }
__device__ __forceinline__ float sin_rad(float x) { return sin_rev(x * 0.15915494309189535f); }
__device__ __forceinline__ float sigmoidf_(float x) { return 1.0f / (1.0f + __expf(-x)); }
__device__ __forceinline__ float siluf_(float x) { return x / (1.0f + __expf(-x)); }
__device__ __forceinline__ float log_sigmoid_(float x) {
    const float y = __expf(-x);
    if (y < 0.1f) { return -(y * (1.0f + y * (-0.5f + y * (0.33333333f + y * (-0.25f + y * (0.2f + y * (-0.16666667f + y * (0.14285714f + y * (-0.125f))))))))); }
    return -logf(1.0f + y);
}
#define LDS_WAIT() asm volatile("s_waitcnt lgkmcnt(0)" ::: "memory")
#define VM_WAIT() asm volatile("s_waitcnt vmcnt(0)" ::: "memory")

struct Args { const float* in[31]; float* out; unsigned char* ws; int ph_lo, ph_hi; };

extern __shared__ __attribute__((aligned(16))) unsigned char lds_raw[];
constexpr int LDS_PTAB = LDSX + 1024;
struct Frame {
    LAS unsigned char* lds;
    int tid, lane, wave, G, bx;
    unsigned char* ws;
};
__device__ __forceinline__ unsigned long long ptab_read(int i) {
    const LAS unsigned* p = (const LAS unsigned*)((LAS unsigned char*)lds_raw + LDS_PTAB) + 2 * i;
    const unsigned lo = (unsigned)__builtin_amdgcn_readfirstlane((int)p[0]), hi = (unsigned)__builtin_amdgcn_readfirstlane((int)p[1]);
    return ((unsigned long long)hi << 32) | lo;
}
__device__ __forceinline__ const float* IN_(const Frame& F, int i) { return (const float*)(const GAS float*)ptab_read(i); }
__device__ __forceinline__ float* OUT_(const Frame& F) { return (float*)(GAS float*)ptab_read(31); }
__device__ __forceinline__ Frame make_frame() {
    Frame F; F.lds = (LAS unsigned char*)lds_raw;
    int t = threadIdx.x; asm volatile("" : "+v"(t)); F.tid = t; F.lane = t & 63; F.wave = __builtin_amdgcn_readfirstlane(t >> 6);
    int g = gridDim.x, bx = blockIdx.x; asm volatile("" : "+s"(g), "+s"(bx)); F.G = g; F.bx = bx;
    unsigned long long w = ptab_read(32); asm volatile("" : "+s"(w)); F.ws = (unsigned char*)(GAS unsigned char*)w; return F;
}
template <class T> __device__ __forceinline__ T* WSP(const Frame& F, size_t off) { return (T*)(F.ws + off); }
__device__ __forceinline__ const float* mod_ptr(const Frame& F, int l, int modrow, int chunk) { return WSP<float>(F, WS_CTL + CTL_MOD) + ((size_t)(l * 9 + modrow) * 6 + chunk) * DM; }
__device__ __forceinline__ int modrow_of(int r) { return r < NLAT ? (r >> 12) : 8; }

constexpr int TRP = 65;
__device__ __forceinline__ void tr_item(const float* W, int K, int N, bf16* WT, int ldk, int item, int w1map, LAS float* scr, int lane) {
    const int nblk = N >> 6, kb = item / nblk, nb = item - kb * nblk, k0 = 64 * kb, n0 = 64 * nb;
    const int r = lane >> 4, cq = lane & 15;
    const float* src = W + (size_t)(k0 + r) * N + n0 + 4 * cq;
#pragma unroll 1
    for (int hh = 0; hh < 2; ++hh) {
        f32x4 v[8];
#pragma unroll
        for (int i = 0; i < 8; ++i) v[i] = *(const f32x4*)(src + (size_t)(4 * (8 * hh + i)) * N);
#pragma unroll
        for (int i = 0; i < 8; ++i) { LAS float* d = scr + (4 * (8 * hh + i) + r) * TRP + 4 * cq; d[0] = v[i][0]; d[1] = v[i][1]; d[2] = v[i][2]; d[3] = v[i][3]; }
    }
    LDS_WAIT(); asm volatile("" ::: "memory");
    int r0 = n0;
    if (w1map == 1) r0 = (n0 < 1024) ? ((n0 >> 7) * 256 + (n0 & 127)) : ((((n0 - 1024) >> 7) * 256) + 128 + ((n0 - 1024) & 127));
    const int kc = lane & 7;
#pragma unroll
    for (int j = 0; j < 8; ++j) { const int n = (lane >> 3) + 8 * j; const LAS float* s = scr + (8 * kc) * TRP + n;
        u32x4 o; o.x = pk2(s[0 * TRP], s[1 * TRP]); o.y = pk2(s[2 * TRP], s[3 * TRP]); o.z = pk2(s[4 * TRP], s[5 * TRP]); o.w = pk2(s[6 * TRP], s[7 * TRP]);
        int row = r0 + n;
        if (w1map == 2) {
            const int c = n0 + n;
            if (c < 1024) row = (c & ~255) + ((c >> 6) & 1) * 128 + ((c >> 7) & 1) * 64 + (c & 63);
            else if (c >= C_AQ && c < C_AV) { const int d = c & 63, gq = d >> 4, hd = (c >> 6) & 3; row = (c & ~255) + (gq & 1) * 128 + hd * 32 + (gq >> 1) * 16 + (d & 15); }
            else if (c >= C_AV && c < C_HU) { const int jv = c - C_AV; row = C_AK + (jv >> 6) * 128 + 64 + (jv & 63); }
        }
        *(u32x4*)(WT + (size_t)row * ldk + k0 + 8 * kc) = o; }
    LDS_WAIT(); asm volatile("" ::: "memory");
}

__device__ __forceinline__ void hy_filter_item(Frame& F, int f, int tb) {
    const int lane = F.lane;
    float* L1P = WSP<float>(F, WS_L1P);
    LAS float* H2 = (LAS float*)F.lds + 16384;
    LAS float* red = H2 + 32 * 64;
    const int L = (f == 2) ? 256 : 4096, l = (f == 1) ? 1 : 0;
    const float* w1 = IN_(F, 12) + l * 33 * 64; const float* b1 = IN_(F, 13) + l * 64; const float* f1 = IN_(F, 14) + l * 64;
    const float* w2 = IN_(F, 15) + l * 64 * 64; const float* b2 = IN_(F, 16) + l * 64; const float* f2 = IN_(F, 17) + l * 64;
    const float* w3 = IN_(F, 18) + (size_t)l * 64 * 1024;
    float* HFp = (f == 2) ? WSP<float>(F, WS_HFC) : WSP<float>(F, WS_HF + (size_t)l * 16 * MiB);
    float* HBp = (f == 2) ? WSP<float>(F, WS_HFC + 512 * 1024) : WSP<float>(F, WS_HF + (size_t)l * 16 * MiB + 8 * MiB);
    __syncthreads();
    {
        float w1c[33], w2c[64];
#pragma unroll
        for (int i = 0; i < 33; ++i) w1c[i] = w1[i * 64 + lane];
#pragma unroll
        for (int i = 0; i < 64; ++i) w2c[i] = w2[i * 64 + lane];
        const float b1l = b1[lane], f1l = f1[lane], b2l = b2[lane], f2l = f2[lane];
#pragma unroll 1
        for (int r = 0; r < 4; ++r) {
            const int n = tb * 32 + F.wave * 4 + r;
            float zl = 0.f;
            if (lane == 0) zl = (float)n / (float)(L - 1);
            else if (lane <= 32) { const int j = (lane - 1) & 15; const float band = 1e-4f + (15.0f - 1e-4f) * (float)j / 15.0f; const float rev = (float)n * band / (float)L;
                zl = (lane <= 16) ? cos_rev(rev) : -sin_rev(rev); }
            float a = 0.f;
#pragma unroll
            for (int i = 0; i < 33; ++i) a += rdlane(zl, i) * w1c[i];
            const float h1 = sin_rad(f1l * (a + b1l));
            float a2 = 0.f;
#pragma unroll
            for (int i = 0; i < 64; ++i) a2 += rdlane(h1, i) * w2c[i];
            H2[(F.wave * 4 + r) * 64 + lane] = sin_rad(f2l * (a2 + b2l));
        }
    }
    __syncthreads();
    const int c1 = F.wave * 128 + lane, c2 = c1 + 64;
    float l1p[2] = {0.f, 0.f};
#pragma unroll 1
    for (int rh = 0; rh < 2; ++rh) {
        float acc[16][2];
#pragma unroll
        for (int r = 0; r < 16; ++r) { acc[r][0] = 0.f; acc[r][1] = 0.f; }
#pragma unroll 1
        for (int i = 0; i < 64; i += 4) {
            float wa[4], wb[4];
#pragma unroll
            for (int k = 0; k < 4; ++k) { wa[k] = w3[(i + k) * 1024 + c1]; wb[k] = w3[(i + k) * 1024 + c2]; }
            f32x4 hh[16];
#pragma unroll
            for (int r = 0; r < 16; ++r) hh[r] = *(const LAS f32x4*)(H2 + (rh * 16 + r) * 64 + i);
            __builtin_amdgcn_sched_barrier(0);
#pragma unroll
            for (int r = 0; r < 16; ++r) { const f32x4 h = hh[r];
                acc[r][0] += h[0] * wa[0] + h[1] * wa[1] + h[2] * wa[2] + h[3] * wa[3]; acc[r][1] += h[0] * wb[0] + h[1] * wb[1] + h[2] * wb[2] + h[3] * wb[3]; }
        }
#pragma unroll
        for (int q = 0; q < 2; ++q) {
            const int c = q ? c2 : c1, cc = c & 511;
            const float delta = 3.0701134573253944f + (15.350567286626973f - 3.0701134573253944f) * (float)cc / 511.0f;
            float* dst = ((c < 512) ? HFp : HBp) + (size_t)(tb * 32 + rh * 16) * 512 + cc;
#pragma unroll
            for (int r = 0; r < 16; ++r) { const int n = tb * 32 + rh * 16 + r; const float tn = (float)n / (float)(L - 1); const float v = acc[r][q] * __expf(-tn * delta);
                dst[r * 512] = v;
                if (c < 512 || n >= 1) l1p[q] += fabsf(v); }
        }
    }
    red[c1] = l1p[0]; red[c2] = l1p[1];
    __syncthreads();
    L1P[(size_t)(f * 128 + tb) * 512 + F.tid] = red[F.tid] + red[512 + F.tid];
}
__device__ __forceinline__ void p0_prologue(Frame& F) {
    LAS float* scr = (LAS float*)(F.lds + F.wave * (64 * TRP * 4));
    const int gw = F.bx * NWAVES + F.wave, NGW = F.G * NWAVES, lane = F.lane;
    constexpr int I_WIN = 16 * 116, I_WBR = 8 * 16, I_WOUT = 16 * 16, I_W1 = 16 * 32, I_W2 = 16 * 16;
    constexpr int N_WIN = 2 * I_WIN, N_WBR = 6 * I_WBR, N_WOUT = 2 * I_WOUT, N_W1 = 32 * I_W1, N_W2 = 32 * I_W2;
    constexpr int NTR = N_WIN + N_WBR + N_WOUT + N_W1 + N_W2;
#pragma unroll 1
    for (int it = gw; it < NTR; it += NGW) {
        int r = it; const float* W; bf16* WT; int K, N, item, w1map = 0, ldk = 1024;
        if (r < N_WIN) { const int l = r / I_WIN; W = IN_(F, 7) + (size_t)l * 1024 * INC; K = 1024; N = INC; WT = WSP<bf16>(F, WS_WIN) + (size_t)l * INC * 1024; item = r % I_WIN; w1map = 2; }
        else if ((r -= N_WIN) < N_WBR) { const int q = r / I_WBR; W = IN_(F, 20) + (size_t)q * 512 * 1024; K = 512; N = 1024; WT = WSP<bf16>(F, WS_WBR) + (size_t)(q / 3) * 1024 * 1536 + (q % 3) * 512; ldk = 1536; item = r % I_WBR; }
        else if ((r -= N_WBR) < N_WOUT) { const int l = r / I_WOUT; W = IN_(F, 22) + (size_t)l * 1024 * 1024; K = 1024; N = 1024; WT = WSP<bf16>(F, WS_WOUT) + (size_t)l * 1024 * 1024; item = r % I_WOUT; }
        else if ((r -= N_WOUT) < N_W1) { const int q = r / I_W1; W = IN_(F, 26) + (size_t)q * 1024 * 2048; K = 1024; N = 2048; WT = WSP<bf16>(F, WS_W1) + (size_t)q * 2048 * 1024; item = r % I_W1; w1map = 1; }
        else { r -= N_W1; const int q = r / I_W2; W = IN_(F, 28) + (size_t)q * 1024 * 1024; K = 1024; N = 1024; WT = WSP<bf16>(F, WS_W2) + (size_t)q * 1024 * 1024; item = r % I_W2; }
        tr_item(W, K, N, WT, ldk, item, w1map, scr, lane);
    }
#ifndef PRO_B
#define PRO_B 1
#endif
#ifndef PRO_C
#define PRO_C 1
#endif
    __syncthreads();
    if (PRO_B) {
        float* mod = WSP<float>(F, WS_CTL + CTL_MOD);
        LAS float* sc = (LAS float*)F.lds;
        LAS float* red = sc + 1024 * 12;
        if (F.bx < 192) {
            for (int i = F.tid; i < 9 * 1024; i += NTHR) { const int r = i >> 10, k = i & 1023; const float cv = (r < 8) ? IN_(F, 1)[r * 1024 + k] : IN_(F, 3)[k]; sc[k * 12 + r] = siluf_(cv); }
            __syncthreads();
            const int it = F.bx, l = it / 96, cc = it % 96, col = cc * 64 + lane, k0 = F.wave * 128;
            const float* wm = IN_(F, 4) + (size_t)l * 1024 * 6144 + col;
            float acc[9];
#pragma unroll
            for (int r = 0; r < 9; ++r) acc[r] = 0.f;
#pragma unroll 1
            for (int kb = 0; kb < 128; kb += 16) {
                float w[16];
#pragma unroll
                for (int k = 0; k < 16; ++k) w[k] = wm[(size_t)(k0 + kb + k) * 6144];
#pragma unroll
                for (int k = 0; k < 16; ++k) { const LAS float* s = sc + (k0 + kb + k) * 12; const f32x4 s0 = *(const LAS f32x4*)s, s1 = *(const LAS f32x4*)(s + 4); const float s8 = s[8];
                    acc[0] += s0[0] * w[k]; acc[1] += s0[1] * w[k]; acc[2] += s0[2] * w[k]; acc[3] += s0[3] * w[k];
                    acc[4] += s1[0] * w[k]; acc[5] += s1[1] * w[k]; acc[6] += s1[2] * w[k]; acc[7] += s1[3] * w[k]; acc[8] += s8 * w[k]; }
            }
#pragma unroll
            for (int r = 0; r < 9; ++r) red[(F.wave * 9 + r) * 64 + lane] = acc[r];
            __syncthreads();
            for (int idx = F.tid; idx < 576; idx += NTHR) { const int r = idx >> 6, c = idx & 63; float s = 0.f;
#pragma unroll
                for (int w = 0; w < 8; ++w) s += red[(w * 9 + r) * 64 + c];
                mod[(size_t)(l * 9 + r) * 6144 + cc * 64 + c] = s + IN_(F, 5)[l * 6144 + cc * 64 + c]; }
        }
    }
    if (PRO_C) {
#pragma unroll 1
        for (int it = F.bx; it < 256; it += F.G) hy_filter_item(F, it >> 7, it & 127);
    }
}
constexpr int TRD_TOTAL = 32 * 512 + 32 * 256;
__device__ __forceinline__ void tr_deferred(Frame& F, int first, int count, int rank, int nblk) {
    LAS float* scr = (LAS float*)(F.lds + F.wave * (64 * TRP * 4));
    __syncthreads();
#pragma unroll 1
    for (int d = first + rank * NWAVES + F.wave; d < first + count; d += nblk * NWAVES) {
        if (d < 32 * 512) { const int q = 32 + (d >> 9); tr_item(IN_(F, 26) + (size_t)q * 1024 * 2048, 1024, 2048, WSP<bf16>(F, WS_W1) + (size_t)q * 2048 * 1024, 1024, d & 511, 1, scr, F.lane); }
        else { const int dd = d - 32 * 512, q = 32 + (dd >> 8); tr_item(IN_(F, 28) + (size_t)q * 1024 * 1024, 1024, 1024, WSP<bf16>(F, WS_W2) + (size_t)q * 1024 * 1024, 1024, dd & 255, 0, scr, F.lane); }
    }
}
__device__ __forceinline__ float hy_inv_l1(const Frame& F, int f, int c) {
    const float* L1P = WSP<float>(F, WS_L1P) + (size_t)f * 128 * 512 + c; const int nb = (f == 2) ? 8 : 128; const int lane = F.lane;
    float s = (lane < nb ? L1P[(size_t)lane * 512] : 0.f) + (lane + 64 < nb ? L1P[(size_t)(lane + 64) * 512] : 0.f);
    return 1.0f / wave_sum(s);
}

__device__ __forceinline__ void ph_norm1(Frame& F, int mode) {
    const int gw = F.bx * NWAVES + F.wave, NGW = F.G * NWAVES, lane = F.lane;
    const int nrows = (mode == 2) ? NLAT : NROWS;
    const int l = (mode == 0) ? 0 : 1;
    const bf16* Y = WSP<bf16>(F, WS_HS);
    const int* POS = WSP<int>(F, WS_POS); const float* TOPW = WSP<float>(F, WS_TOPW);
    f32x4 xnext[4]; int pnext[4]; float wnext[4];
#define N1_FETCH(r_) do { const int rf_ = (r_); \
        const float* xr_ = (mode == 0) ? ((rf_ < NLAT) ? IN_(F, 0) + (size_t)rf_ * DM : IN_(F, 2) + (size_t)(rf_ - NLAT) * DM) : (WSP<float>(F, WS_XM) + (size_t)rf_ * DM); \
        _Pragma("unroll") for (int j = 0; j < 4; ++j) xnext[j] = *(const f32x4*)(xr_ + 4 * lane + 256 * j); \
        if (mode != 0) { _Pragma("unroll") for (int k = 0; k < 4; ++k) { pnext[k] = POS[rf_ * 4 + k]; wnext[k] = TOPW[rf_ * 4 + k]; } } } while (0)
    if (gw < nrows) N1_FETCH(gw);
#pragma unroll 1
    for (int r = gw; r < nrows; r += NGW) {
        const int mr = modrow_of(r);
        f32x4 v[4];
        if (mode == 0) {
#pragma unroll
            for (int j = 0; j < 4; ++j) v[j] = xnext[j];
            if (r + NGW < nrows) N1_FETCH(r + NGW);
        } else {
            f32x4 xcur[4]; int pc[4]; float wc[4];
#pragma unroll
            for (int j = 0; j < 4; ++j) xcur[j] = xnext[j];
#pragma unroll
            for (int k = 0; k < 4; ++k) { pc[k] = pnext[k]; wc[k] = wnext[k]; }
            u32x2 yv[4][4];
#pragma unroll
            for (int k = 0; k < 4; ++k) { const bf16* yr = Y + (size_t)pc[k] * DM;
#pragma unroll
                for (int j = 0; j < 4; ++j) yv[k][j] = *(const u32x2*)(yr + 4 * lane + 256 * j); }
            if (r + NGW < nrows) N1_FETCH(r + NGW);
            f32x4 s[4];
#pragma unroll
            for (int j = 0; j < 4; ++j) s[j] = (f32x4){0.f, 0.f, 0.f, 0.f};
#pragma unroll
            for (int k = 0; k < 4; ++k) { const float w = wc[k];
#pragma unroll
                for (int j = 0; j < 4; ++j) { const u32x2 y2 = yv[k][j];
                    s[j][0] += w * __uint_as_float(y2.x << 16); s[j][1] += w * __uint_as_float(y2.x & 0xffff0000u);
                    s[j][2] += w * __uint_as_float(y2.y << 16); s[j][3] += w * __uint_as_float(y2.y & 0xffff0000u); } }
            const float* g2l = mod_ptr(F, (mode == 2) ? 1 : 0, mr, 5);
#pragma unroll
            for (int j = 0; j < 4; ++j) { const f32x4 g = *(const f32x4*)(g2l + 4 * lane + 256 * j); v[j] = xcur[j] + g * s[j]; }
            if (mode == 1) { float* xo = WSP<float>(F, WS_XO) + (size_t)r * DM;
#pragma unroll
                for (int j = 0; j < 4; ++j) *(f32x4*)(xo + 4 * lane + 256 * j) = v[j]; }
        }
        float ss = 0.f;
#pragma unroll
        for (int j = 0; j < 4; ++j) ss += (v[j][0] * v[j][0] + v[j][1] * v[j][1]) + (v[j][2] * v[j][2] + v[j][3] * v[j][3]);
        const float rstd = 1.0f / sqrtf(wave_sum(ss) * (1.0f / DM) + EPS);
        if (mode == 2) {
            const float* fg = IN_(F, 30); float* o = OUT_(F) + (size_t)r * DM;
#pragma unroll
            for (int j = 0; j < 4; ++j) { const f32x4 g = *(const f32x4*)(fg + 4 * lane + 256 * j); *(f32x4*)(o + 4 * lane + 256 * j) = v[j] * rstd * g; }
        } else {
            const float* gw_ = IN_(F, 6) + l * DM; const float* sh = mod_ptr(F, l, mr, 0); const float* sc = mod_ptr(F, l, mr, 1);
            bf16* o = WSP<bf16>(F, WS_XN) + (size_t)r * DM;
#pragma unroll
            for (int j = 0; j < 4; ++j) { const f32x4 g = *(const f32x4*)(gw_ + 4 * lane + 256 * j); const f32x4 a = *(const f32x4*)(sh + 4 * lane + 256 * j); const f32x4 b = *(const f32x4*)(sc + 4 * lane + 256 * j);
                const f32x4 y = v[j] * rstd * g * (b + 1.0f) + a;
                u32x2 w2; w2.x = pk2(y[0], y[1]); w2.y = pk2(y[2], y[3]); *(u32x2*)(o + 4 * lane + 256 * j) = w2; }
        }
    }
#undef N1_FETCH
}

struct EpiP {
    static constexpr bool PERM = true, AFTER_DRAIN = false, KMID = false; static constexpr int NSTORE = 16;
    bf16* O; const float* bg;
    __device__ __forceinline__ static void st8(bf16* p, const float (&v)[8]) { u32x4 w; w.x = pk2(v[0], v[1]); w.y = pk2(v[2], v[3]); w.z = pk2(v[4], v[5]); w.w = pk2(v[6], v[7]); *(u32x4*)p = w; }
    __device__ __forceinline__ void operator()(const f32x4 (&acc)[2][2][4][2], const pg8::Unit& u, int wr, int wc, int fr, int fq) const {
        const int row0 = u.pm * 256 + wr * 64 + fr, pn = u.pn;
        const bool rot = u.pm < (NLAT / 256);
        const bool is_ret = pn < 4, is_aq = (pn == 8 || pn == 9), is_akv = (pn == 10);
        if (!(is_ret || is_aq || is_akv) || (is_akv && wc >= 2)) {
            const int colA = is_akv ? (C_AV + (wc - 2) * 32 + 8 * fq) : (pn * 256 + wc * 32 + 8 * fq), colB = is_akv ? (colA + 64) : (colA + 128);
            f32x4 ba0 = (f32x4){0.f, 0.f, 0.f, 0.f}, ba1 = ba0, bb0 = ba0, bb1 = ba0;
            if (pn >= 17) { ba0 = *(const f32x4*)(bg + colA - C_MG); ba1 = *(const f32x4*)(bg + colA - C_MG + 4); bb0 = *(const f32x4*)(bg + colB - C_MG); bb1 = *(const f32x4*)(bg + colB - C_MG + 4); }
#pragma unroll
            for (int ai = 0; ai < 2; ++ai)
#pragma unroll
                for (int m = 0; m < 4; ++m) { bf16* rowp = O + (size_t)(row0 + ai * 128 + m * 16) * INC;
                    float a[8], b[8];
#pragma unroll
                    for (int j = 0; j < 4; ++j) { a[j] = acc[ai][0][m][0][j] + ba0[j]; a[4 + j] = acc[ai][0][m][1][j] + ba1[j]; b[j] = acc[ai][1][m][0][j] + bb0[j]; b[4 + j] = acc[ai][1][m][1][j] + bb1[j]; }
                    if (pn >= 17) {
                        typedef float f32x2 __attribute__((ext_vector_type(2)));
#pragma unroll
                        for (int j = 0; j < 8; j += 2) { f32x2 za = {a[j], a[j + 1]}, zb = {b[j], b[j + 1]}; za = za * -1.4426950408889634f; zb = zb * -1.4426950408889634f;
                            za.x = __builtin_amdgcn_exp2f(za.x); za.y = __builtin_amdgcn_exp2f(za.y); zb.x = __builtin_amdgcn_exp2f(zb.x); zb.y = __builtin_amdgcn_exp2f(zb.y);
                            za = za + 1.0f; zb = zb + 1.0f;
                            a[j] = fminf(za.x, 1.0e30f); a[j + 1] = fminf(za.y, 1.0e30f); b[j] = fminf(zb.x, 1.0e30f); b[j + 1] = fminf(zb.y, 1.0e30f); } }
                    st8(rowp + colA, a); st8(rowp + colB, b); asm volatile("" ::: "memory"); }
            return;
        }
        int col1, col2, ibase; float fexp; bool use_col = false;
        if (is_ret) { const int hd = wc >> 1; ibase = (wc & 1) * 32 + 8 * fq; col1 = pn * 256 + hd * 128 + ibase; col2 = col1 + 64; fexp = 13.287712379549449f / 63.0f; }
        else { const int rc = fq >> 1; ibase = 8 * (fq & 1); const int hb = is_aq ? (pn * 256 + wc * 64) : (C_AK + wc * 64); col1 = hb + rc * 32 + ibase; col2 = col1 + 16; fexp = 13.287712379549449f / 16.0f; use_col = rc != 0; }
        float invf[8];
#pragma unroll
        for (int k = 0; k < 8; ++k) invf[k] = __builtin_amdgcn_exp2f(-(float)(ibase + k) * fexp) * 0.15915494309189535f;
#pragma unroll
        for (int ai = 0; ai < 2; ++ai)
#pragma unroll
            for (int m = 0; m < 4; ++m) { const int row = row0 + ai * 128 + m * 16; bf16* rowp = O + (size_t)row * INC;
                const int t = row & 4095;
                const float pos = is_ret ? (float)t : (use_col ? (float)(t & 63) : (float)(t >> 6));
                float o1[8], o2[8];
#pragma unroll
                for (int k = 0; k < 8; ++k) { const float x1 = acc[ai][0][m][k >> 2][k & 3], x2 = acc[ai][1][m][k >> 2][k & 3];
                    float cs = 1.0f, sn = 0.0f;
                    if (rot) { const float rev = pos * invf[k]; cs = cos_rev(rev); sn = sin_rev(rev); }
                    o1[k] = x1 * cs - x2 * sn; o2[k] = x1 * sn + x2 * cs; }
                st8(rowp + col1, o1); st8(rowp + col2, o2); asm volatile("" ::: "memory"); }
    }
};
struct EpiMerge {
    static constexpr bool PERM = true, AFTER_DRAIN = false, KMID = true; static constexpr int NSTORE = 16;
    const bf16* P; bf16* Mo;
    typedef float f32x2 __attribute__((ext_vector_type(2)));
    __device__ __forceinline__ static f32x2 g2(unsigned w) { f32x2 r; r.x = __uint_as_float(w << 16); r.y = __uint_as_float(w & 0xffff0000u); return r; }
    struct Batch { u32x4 gn[2][2], go[2][2]; };
    __device__ __forceinline__ void fetch(Batch& B, int row0, unsigned col0, unsigned g_old, int ai, int mh) const {
#pragma unroll
        for (int mm = 0; mm < 2; ++mm) { const unsigned rowb = (unsigned)(row0 + ai * 128 + (2 * mh + mm) * 16) * (unsigned)(INC * 2);
#pragma unroll
            for (int bj = 0; bj < 2; ++bj) { const unsigned c = col0 + bj * 128;
                B.gn[mm][bj] = *(const u32x4*)((const char*)P + rowb + (C_MG + (g_old + 1) * 1024 + c) * 2); B.go[mm][bj] = *(const u32x4*)((const char*)P + rowb + (C_MG + g_old * 1024 + c) * 2); } }
    }
    __device__ __forceinline__ static void apply(const Batch& B, f32x4 (&acc)[2][2][4][2], int ai, int mh) {
#pragma unroll
        for (int mm = 0; mm < 2; ++mm)
#pragma unroll
            for (int bj = 0; bj < 2; ++bj) { const unsigned gnw[4] = {B.gn[mm][bj].x, B.gn[mm][bj].y, B.gn[mm][bj].z, B.gn[mm][bj].w}, gow[4] = {B.go[mm][bj].x, B.go[mm][bj].y, B.go[mm][bj].z, B.go[mm][bj].w};
#pragma unroll
                for (int i = 0; i < 4; ++i) { const f32x2 dold = g2(gow[i]); f32x2 ro; ro.x = __builtin_amdgcn_rcpf(dold.x); ro.y = __builtin_amdgcn_rcpf(dold.y);
                    const f32x2 r = g2(gnw[i]) * ro;
                    f32x4& A = acc[ai][bj][2 * mh + mm][i >> 1];
                    if (i & 1) { A.z *= r.x; A.w *= r.y; } else { A.x *= r.x; A.y *= r.y; } } }
    }
    __device__ __forceinline__ void kmid(int t, f32x4 (&acc)[2][2][4][2], const pg8::Unit& u, int wr, int wc, int fr, int fq) const {
        int row0 = u.pm * 256 + wr * 64 + fr; asm volatile("" : "+v"(row0));
        const unsigned col0 = (unsigned)(u.pn * 256 + wc * 32 + 8 * fq), g_old = (t == 8) ? 0u : 1u;
        Batch B0, B1;
        fetch(B0, row0, col0, g_old, 0, 0);
        fetch(B1, row0, col0, g_old, 0, 1); asm volatile("" ::: "memory");
        apply(B0, acc, 0, 0);
        fetch(B0, row0, col0, g_old, 1, 0); asm volatile("" ::: "memory");
        apply(B1, acc, 0, 1);
        fetch(B1, row0, col0, g_old, 1, 1); asm volatile("" ::: "memory");
        apply(B0, acc, 1, 0);
        apply(B1, acc, 1, 1);
    }
    __device__ __forceinline__ void operator()(const f32x4 (&acc)[2][2][4][2], const pg8::Unit& u, int wr, int wc, int fr, int fq) const {
        int row0 = u.pm * 256 + wr * 64 + fr; asm volatile("" : "+v"(row0));
        const unsigned col0 = (unsigned)(u.pn * 256 + wc * 32 + 8 * fq);
        u32x4 gh[2][4][2];
#pragma unroll
        for (int ai = 0; ai < 2; ++ai)
#pragma unroll
            for (int m = 0; m < 4; ++m) { const unsigned rowb = (unsigned)(row0 + ai * 128 + m * 16) * (unsigned)(INC * 2);
#pragma unroll
                for (int bj = 0; bj < 2; ++bj) gh[ai][m][bj] = *(const u32x4*)((const char*)P + rowb + (C_MG + 2048 + col0 + bj * 128) * 2); }
#pragma unroll
        for (int ai = 0; ai < 2; ++ai) {
#pragma unroll
            for (int m = 0; m < 4; ++m) { const unsigned row = (unsigned)(row0 + ai * 128 + m * 16);
#pragma unroll
                for (int bj = 0; bj < 2; ++bj) { float v[8]; const unsigned ghw[4] = {gh[ai][m][bj].x, gh[ai][m][bj].y, gh[ai][m][bj].z, gh[ai][m][bj].w};
#pragma unroll
                    for (int i = 0; i < 4; ++i) { const f32x2 d = g2(ghw[i]); v[2 * i] = acc[ai][bj][m][i >> 1][2 * (i & 1)] * __builtin_amdgcn_rcpf(d.x); v[2 * i + 1] = acc[ai][bj][m][i >> 1][2 * (i & 1) + 1] * __builtin_amdgcn_rcpf(d.y); }
                    u32x4 w; w.x = pk2(v[0], v[1]); w.y = pk2(v[2], v[3]); w.z = pk2(v[4], v[5]); w.w = pk2(v[6], v[7]);
                    *(u32x4*)((char*)Mo + (row * (unsigned)(DM * 2) + (col0 + bj * 128) * 2)) = w; } }
            asm volatile("" ::: "memory"); }
    }
};
struct EpiOut {
    static constexpr bool PERM = false, AFTER_DRAIN = false, KMID = false; static constexpr int NSTORE = 32;
    const float* xlat; const float* xctx; const float* g1base; float* XM;
    __device__ __forceinline__ void operator()(const f32x4 (&acc)[2][2][4][2], const pg8::Unit& u, int wr, int wc, int fr, int fq) const {
        int row0 = u.pm * 256 + wr * 64 + fr; asm volatile("" : "+v"(row0));
        const int col0 = u.pn * 256 + wc * 32 + 4 * fq;
        const bool lat = u.pm < (NLAT / 256);
        const float* xb = lat ? xlat : xctx - (size_t)NLAT * DM;
        const float* g1 = g1base + (size_t)modrow_of(u.pm * 256) * 6 * DM + col0;
        f32x4 gv[2][2];
#pragma unroll
        for (int bj = 0; bj < 2; ++bj)
#pragma unroll
            for (int n = 0; n < 2; ++n) gv[bj][n] = *(const f32x4*)(g1 + bj * 128 + n * 16);
#pragma unroll
        for (int ai = 0; ai < 2; ++ai) {
            f32x4 xv[4][2][2];
#pragma unroll
            for (int m = 0; m < 4; ++m) { const float* xr = xb + (size_t)(row0 + ai * 128 + m * 16) * DM + col0;
#pragma unroll
                for (int bj = 0; bj < 2; ++bj)
#pragma unroll
                    for (int n = 0; n < 2; ++n) xv[m][bj][n] = *(const f32x4*)(xr + bj * 128 + n * 16); }
#pragma unroll
            for (int m = 0; m < 4; ++m) { float* xo = XM + (size_t)(row0 + ai * 128 + m * 16) * DM + col0;
#pragma unroll
                for (int bj = 0; bj < 2; ++bj)
#pragma unroll
                    for (int n = 0; n < 2; ++n) *(f32x4*)(xo + bj * 128 + n * 16) = xv[m][bj][n] + gv[bj][n] * acc[ai][bj][m][n]; }
            asm volatile("" ::: "memory"); }
    }
};
struct EpiMoe1 {
    static constexpr bool PERM = true, AFTER_DRAIN = false, KMID = false; static constexpr int NSTORE = 8;
    const float* b1; bf16* ACT;
    __device__ __forceinline__ void operator()(const f32x4 (&acc)[2][2][4][2], const pg8::Unit& u, int wr, int wc, int fr, int fq) const {
        const int e = u.pn >> 3, p = u.pn & 7;
        const int row0 = u.pm * 256 + wr * 64 + fr, gcol0 = p * 128 + wc * 32 + 8 * fq;
        const float* bb = b1 + (size_t)e * 2048 + gcol0;
        typedef float f32x2 __attribute__((ext_vector_type(2)));
        const f32x4 bgv[2] = {*(const f32x4*)(bb), *(const f32x4*)(bb + 4)};
        const f32x4 blv[2] = {*(const f32x4*)(bb + 1024) + 1.0f, *(const f32x4*)(bb + 1028) + 1.0f};
#pragma unroll
        for (int ai = 0; ai < 2; ++ai)
#pragma unroll
            for (int m = 0; m < 4; ++m) { bf16* rowp = ACT + (size_t)(row0 + ai * 128 + m * 16) * DFF + gcol0;
                unsigned w[4];
#pragma unroll
                for (int n = 0; n < 2; ++n)
#pragma unroll
                    for (int hp = 0; hp < 2; ++hp) {
                        const f32x2 av = hp ? acc[ai][0][m][n].hi : acc[ai][0][m][n].lo, lv = hp ? acc[ai][1][m][n].hi : acc[ai][1][m][n].lo;
                        const f32x2 bg = hp ? bgv[n].hi : bgv[n].lo, bl = hp ? blv[n].hi : blv[n].lo;
                        f32x2 glu = av + bg, lin = lv + bl;
                        glu.x = fminf(glu.x, 7.0f); glu.y = fminf(glu.y, 7.0f);
                        lin.x = __builtin_amdgcn_fmed3f(lin.x, -6.0f, 8.0f); lin.y = __builtin_amdgcn_fmed3f(lin.y, -6.0f, 8.0f);
                        f32x2 ex = glu * -2.4554669595930156f;
                        ex.x = __builtin_amdgcn_exp2f(ex.x); ex.y = __builtin_amdgcn_exp2f(ex.y);
                        ex = ex + 1.0f;
                        ex.x = __builtin_amdgcn_rcpf(ex.x); ex.y = __builtin_amdgcn_rcpf(ex.y);
                        const f32x2 a = (glu * ex) * lin;
                        w[2 * n + hp] = pk2(a.x, a.y); }
                u32x4 wv; wv.x = w[0]; wv.y = w[1]; wv.z = w[2]; wv.w = w[3];
                *(u32x4*)rowp = wv;
                asm volatile("" ::: "memory"); }
    }
};
struct EpiMoe2 {
    static constexpr bool PERM = true, AFTER_DRAIN = false, KMID = false; static constexpr int NSTORE = 16;
    const float* b2; bf16* Y;
    __device__ __forceinline__ void operator()(const f32x4 (&acc)[2][2][4][2], const pg8::Unit& u, int wr, int wc, int fr, int fq) const {
        const int e = u.pn >> 2, p = u.pn & 3;
        const int row0 = u.pm * 256 + wr * 64 + fr, col0 = p * 256 + wc * 32 + 8 * fq;
        f32x4 bv[2][2];
#pragma unroll
        for (int bj = 0; bj < 2; ++bj)
#pragma unroll
            for (int n = 0; n < 2; ++n) bv[bj][n] = *(const f32x4*)(b2 + (size_t)e * 1024 + col0 + bj * 128 + 4 * n);
#pragma unroll
        for (int ai = 0; ai < 2; ++ai)
#pragma unroll
            for (int m = 0; m < 4; ++m) { bf16* rowp = Y + (size_t)(row0 + ai * 128 + m * 16) * DM + col0;
#pragma unroll
                for (int bj = 0; bj < 2; ++bj) { const f32x4 v0 = acc[ai][bj][m][0] + bv[bj][0], v1 = acc[ai][bj][m][1] + bv[bj][1];
                    u32x4 w; w.x = pk2(v0[0], v0[1]); w.y = pk2(v0[2], v0[3]); w.z = pk2(v1[0], v1[1]); w.w = pk2(v1[2], v1[3]);
                    *(u32x4*)(rowp + bj * 128) = w; } }
    }
};
struct MoeOrder {
    static constexpr bool GATHER = false; const LAS int* src;
    const LAS int* list; int n;
    __device__ __forceinline__ bool next(int i, pg8::Unit& u) const { if (i >= n) return false; u.pm = __builtin_amdgcn_readfirstlane(list[2 * i]); u.pn = __builtin_amdgcn_readfirstlane(list[2 * i + 1]); return true; }
    __device__ __forceinline__ void a_ready(const pg8::Unit&) const {}
    __device__ __forceinline__ void done(const pg8::Unit&) const {}
};
struct MoeOrderG {
    static constexpr bool GATHER = true; const LAS int* src;
    const LAS int* list; int n;
    __device__ __forceinline__ bool next(int i, pg8::Unit& u) const { if (i >= n) return false; u.pm = __builtin_amdgcn_readfirstlane(list[2 * i]); u.pn = __builtin_amdgcn_readfirstlane(list[2 * i + 1]); return true; }
    __device__ __forceinline__ void a_ready(const pg8::Unit&) const {}
    __device__ __forceinline__ void done(const pg8::Unit&) const {}
};
__device__ __forceinline__ int moe_list_units(Frame& F, int nN, LAS int* list) {
    const int* tl = WSP<int>(F, WS_TILES);
    const int T = __builtin_amdgcn_readfirstlane(tl[32]);
    const int tlv = tl[F.lane & 31];
    pg8::StaticOrder SO; SO.init(T * 256, nN * 256, F.G, F.bx);
    int n = 0;
#pragma unroll 1
    for (int i = 0;; ++i) {
        pg8::Unit u; if (!SO.next(i, u)) break;
        const int pm = u.pm, pnl = u.pn;
        const int e = __popcll(__ballot(F.lane < 32 && tlv <= pm)) - 1;
        if (F.tid == 0) { list[2 * i] = pm; list[2 * i + 1] = e * nN + pnl; }
        n = i + 1;
    }
    __syncthreads();
    return n;
}


typedef short bf16x8 __attribute__((ext_vector_type(8)));
typedef short bf16x4 __attribute__((ext_vector_type(4)));
constexpr int RLD = 136;
constexpr int RTILE = 128 * RLD * 2;
__device__ __forceinline__ bf16x8 lds_frag16(const LAS bf16* tile, int row0, int k0, int lane) {
    return *(const LAS bf16x8*)(tile + (row0 + (lane & 15)) * RLD + k0 + 8 * (lane >> 4));
}
__device__ __forceinline__ bf16x8 lds_frag16s(const LAS bf16* tile, int row0, int k0, int lane) {
    return *(const LAS bf16x8*)(tile + (row0 + (lane & 15)) * RLD + ((k0 + 8 * (lane >> 4)) ^ ((row0 >> 5) << 4)));
}
__device__ __forceinline__ void lds_frag16x4s(bf16x8 (&f)[4], const LAS bf16* tile, int row0, int lane) {
#pragma unroll
    for (int ks = 0; ks < 4; ++ks) f[ks] = lds_frag16s(tile, row0, 32 * ks, lane);
}
__device__ __forceinline__ void lds_frag16x4(bf16x8 (&f)[4], const LAS bf16* tile, int row0, int lane) {
#pragma unroll
    for (int ks = 0; ks < 4; ++ks) f[ks] = lds_frag16(tile, row0, 32 * ks, lane);
}
__device__ __forceinline__ void ret_unit_decode(int u, int& bh, int& ci, int& rowbase) {
    bh = u / 34; ci = u - bh * 34; const int b = bh >> 2;
    rowbase = (ci < 2) ? (NLAT + b * CTXL + ci * 128) : (b * SEQ + (ci - 2) * 128);
}
__device__ __forceinline__ void ret_load_tile(LAS bf16* tile, const bf16* g, size_t gp, int tid) {
    const int r = tid >> 2, seg = tid & 3;
#pragma unroll
    for (int q = 0; q < 4; ++q) *(LAS u32x4*)(tile + r * RLD + seg * 32 + q * 8) = *(const u32x4*)(g + (size_t)r * gp + seg * 32 + q * 8);
}
__device__ __forceinline__ void ret_kv_unit(Frame& F, int l, int u) {
    const bf16* P = WSP<bf16>(F, WS_P);
    LAS bf16* Ktf = (LAS bf16*)F.lds; LAS bf16* Ktb = Ktf + 128 * RLD; LAS bf16* Vt = Ktb + 128 * RLD;
    int bh, ci, rowbase; ret_unit_decode(u, bh, ci, rowbase);
    const int h = bh & 3, tid = F.tid, lane = F.lane, w = F.wave;
    const float LOG2E = 1.4426950408889634f;
    const float lgf = log_sigmoid_(IN_(F, 8)[l * 8 + h]) * LOG2E, lgb = log_sigmoid_(IN_(F, 8)[l * 8 + 4 + h]) * LOG2E;
    __syncthreads();
    { const int j = tid >> 2, seg = tid & 3;
      const float wf = __builtin_amdgcn_exp2f(lgf * (float)(127 - j)), wb = __builtin_amdgcn_exp2f(lgb * (float)j);
      const bf16* kp = P + (size_t)(rowbase + j) * INC + C_RK + h * 128 + seg * 32; const bf16* vp = P + (size_t)(rowbase + j) * INC + C_RV + h * 128 + seg * 32;
      u32x4 kkv[4], vvv[4];
#pragma unroll
      for (int q = 0; q < 4; ++q) { kkv[q] = *(const u32x4*)(kp + q * 8); vvv[q] = *(const u32x4*)(vp + q * 8); }
      __builtin_amdgcn_sched_barrier(0);
#pragma unroll
      for (int q = 0; q < 4; ++q) { const u32x4 kk = kkv[q], vv = vvv[q];
          const unsigned kw[4] = {kk.x, kk.y, kk.z, kk.w}, vw[4] = {vv.x, vv.y, vv.z, vv.w};
#pragma unroll
          for (int i = 0; i < 4; ++i) { const int d = seg * 32 + q * 8 + 2 * i;
              const float k0 = __uint_as_float(kw[i] << 16), k1 = __uint_as_float(kw[i] & 0xffff0000u);
              const int js = j ^ (seg << 4);
              Ktf[d * RLD + js] = f2bf(k0 * wf); Ktf[(d + 1) * RLD + js] = f2bf(k1 * wf);
              Ktb[d * RLD + js] = f2bf(k0 * wb); Ktb[(d + 1) * RLD + js] = f2bf(k1 * wb);
              Vt[d * RLD + js] = (bf16)(vw[i] & 0xffffu); Vt[(d + 1) * RLD + js] = (bf16)(vw[i] >> 16); } } }
    __syncthreads();
    bf16x8 af[4], ab[4];
#pragma unroll
    for (int ks = 0; ks < 4; ++ks) { af[ks] = lds_frag16s(Ktf, 16 * w, 32 * ks, lane); ab[ks] = lds_frag16s(Ktb, 16 * w, 32 * ks, lane); }
    float* KV = WSP<float>(F, WS_KV) + ((size_t)(bh * 34 + ci) * 2) * 16384;
    const int d0 = 16 * w + 4 * (lane >> 4);
    bf16x8 vf[2][4];
    lds_frag16x4s(vf[0], Vt, 0, lane);
#pragma unroll
    for (int et = 0; et < 8; ++et) {
        if (et + 1 < 8) lds_frag16x4s(vf[(et + 1) & 1], Vt, 16 * (et + 1), lane);
        __builtin_amdgcn_sched_barrier(0);
        f32x4 cf = (f32x4){0.f, 0.f, 0.f, 0.f}, cb = cf;
#pragma unroll
        for (int ks = 0; ks < 4; ++ks) { cf = __builtin_amdgcn_mfma_f32_16x16x32_bf16(af[ks], vf[et & 1][ks], cf, 0, 0, 0); cb = __builtin_amdgcn_mfma_f32_16x16x32_bf16(ab[ks], vf[et & 1][ks], cb, 0, 0, 0); }
        const int e = 16 * et + (lane & 15);
        *(f32x4*)(KV + (size_t)e * 128 + d0) = cf; *(f32x4*)(KV + 16384 + (size_t)e * 128 + d0) = cb;
    }
}
__device__ __forceinline__ void ret_scan(Frame& F, int l) {
    const float* KV = WSP<float>(F, WS_KV); bf16* SP = WSP<bf16>(F, WS_SP);
    const float LOG2E = 1.4426950408889634f;
    const int total = 64 * 4096, stride = F.G * NTHR;
#pragma unroll 1
    for (int idx = F.bx * NTHR + F.tid; idx < total; idx += stride) {
        const int bhd = idx >> 12, elem = (idx & 4095) * 4, bh = bhd >> 1, dir = bhd & 1, h = bh & 3;
        const float cd = __builtin_amdgcn_exp2f(log_sigmoid_(IN_(F, 8)[l * 8 + dir * 4 + h]) * LOG2E * 128.0f);
        const size_t base = ((size_t)bh * 34 * 2 + dir) * 16384 + elem;
        f32x4 s = (f32x4){0.f, 0.f, 0.f, 0.f};
#pragma unroll 1
        for (int half = 0; half < 2; ++half) {
            f32x4 kv[17];
#pragma unroll
            for (int k = 0; k < 17; ++k) { const int st = half * 17 + k; const int ci = dir == 0 ? st : (st == 0 ? 1 : (st == 1 ? 0 : 35 - st)); kv[k] = *(const f32x4*)(KV + base + (size_t)ci * 2 * 16384); }
#pragma unroll
            for (int k = 0; k < 17; ++k) { const int st = half * 17 + k; const int ci = dir == 0 ? st : (st == 0 ? 1 : (st == 1 ? 0 : 35 - st));
                u32x2 o; o.x = pk2(s[0], s[1]); o.y = pk2(s[2], s[3]); *(u32x2*)(SP + base + (size_t)ci * 2 * 16384) = o;
                s = s * cd + kv[k]; }
        }
    }
}
__device__ __forceinline__ void ret_out_unit(Frame& F, int l, int u) {
    const bf16* P = WSP<bf16>(F, WS_P);
    LAS bf16* Qs = (LAS bf16*)F.lds; LAS bf16* Ks = Qs + 128 * RLD; LAS bf16* Vt = Ks + 128 * RLD; LAS bf16* Ps = Vt + 128 * RLD;
    int bh, ci, rowbase; ret_unit_decode(u, bh, ci, rowbase);
    const int h = bh & 3, tid = F.tid, lane = F.lane, w = F.wave;
    const float LOG2E = 1.4426950408889634f;
    const float lgf = log_sigmoid_(IN_(F, 8)[l * 8 + h]) * LOG2E, lgb = log_sigmoid_(IN_(F, 8)[l * 8 + 4 + h]) * LOG2E;
    __syncthreads();
    ret_load_tile(Qs, P + (size_t)rowbase * INC + C_RQ + h * 128, INC, tid);
    ret_load_tile(Ks, P + (size_t)rowbase * INC + C_RK + h * 128, INC, tid);
    { const int j = tid >> 2, seg = tid & 3; const bf16* vp = P + (size_t)(rowbase + j) * INC + C_RV + h * 128 + seg * 32;
#pragma unroll
      for (int q = 0; q < 4; ++q) { const u32x4 vv = *(const u32x4*)(vp + q * 8); const unsigned vw[4] = {vv.x, vv.y, vv.z, vv.w};
#pragma unroll
          for (int i = 0; i < 4; ++i) { const int d = seg * 32 + q * 8 + 2 * i, js = j ^ (seg << 4); Vt[d * RLD + js] = (bf16)(vw[i] & 0xffffu); Vt[(d + 1) * RLD + js] = (bf16)(vw[i] >> 16); } } }
    u32x4 spre[2][4];
    { const bf16* SPg = WSP<bf16>(F, WS_SP) + ((size_t)(bh * 34 + ci) * 2) * 16384; const int rr = tid >> 2, seg = tid & 3;
#pragma unroll
      for (int dir = 0; dir < 2; ++dir) { const bool zero = (dir == 0) ? (ci == 0) : (ci == 1);
#pragma unroll
          for (int q = 0; q < 4; ++q) spre[dir][q] = zero ? (u32x4){0u, 0u, 0u, 0u} : *(const u32x4*)(SPg + (size_t)dir * 16384 + (size_t)rr * 128 + seg * 32 + q * 8); } }
    __syncthreads();
    const int icol = 16 * w + (lane & 15);
    bf16x8 bq[4];
#pragma unroll
    for (int ks = 0; ks < 4; ++ks) bq[ks] = lds_frag16(Qs, 16 * w, 32 * ks, lane);
    bf16x8 tf[2][4];
    lds_frag16x4(tf[0], Ks, 0, lane);
#pragma unroll
    for (int jt = 0; jt < 8; ++jt) {
        if (jt + 1 < 8) lds_frag16x4(tf[(jt + 1) & 1], Ks, 16 * (jt + 1), lane);
        __builtin_amdgcn_sched_barrier(0);
        f32x4 c = (f32x4){0.f, 0.f, 0.f, 0.f};
#pragma unroll
        for (int ks = 0; ks < 4; ++ks) c = __builtin_amdgcn_mfma_f32_16x16x32_bf16(tf[jt & 1][ks], bq[ks], c, 0, 0, 0);
        const int j0 = 16 * jt + 4 * (lane >> 4);
        float pv[4];
#pragma unroll
        for (int r = 0; r < 4; ++r) { const int dd = icol - (j0 + r); const float dec = dd >= 0 ? __builtin_amdgcn_exp2f(lgf * (float)dd) : __builtin_amdgcn_exp2f(lgb * (float)(-dd)); pv[r] = c[r] * dec; }
        u32x2 pw; pw.x = pk2(pv[0], pv[1]); pw.y = pk2(pv[2], pv[3]);
        *(LAS u32x2*)(Ps + icol * RLD + j0) = pw;
    }
    LDS_WAIT(); asm volatile("" ::: "memory");
    f32x4 acc[8];
    {
        bf16x8 bp[4];
#pragma unroll
        for (int ks = 0; ks < 4; ++ks) bp[ks] = lds_frag16(Ps, 16 * w, 32 * ks, lane);
        lds_frag16x4s(tf[0], Vt, 0, lane);
#pragma unroll
        for (int et = 0; et < 8; ++et) {
            if (et + 1 < 8) lds_frag16x4s(tf[(et + 1) & 1], Vt, 16 * (et + 1), lane);
            __builtin_amdgcn_sched_barrier(0);
            f32x4 c = (f32x4){0.f, 0.f, 0.f, 0.f};
#pragma unroll
            for (int ks = 0; ks < 4; ++ks) c = __builtin_amdgcn_mfma_f32_16x16x32_bf16(tf[et & 1][ks], bp[ks], c, 0, 0, 0);
            acc[et] = c; }
    }
#pragma unroll
    for (int dir = 0; dir < 2; ++dir) {
        const bool zero = (dir == 0) ? (ci == 0) : (ci == 1);
        __syncthreads();
        if (!zero) { const int rr = tid >> 2, seg = tid & 3;
#pragma unroll
            for (int q = 0; q < 4; ++q) *(LAS u32x4*)(Ks + rr * RLD + seg * 32 + q * 8) = spre[dir][q]; }
        __syncthreads();
        if (!zero) {
            const float sc = (dir == 0) ? __builtin_amdgcn_exp2f(lgf * (float)((icol & 127) + 1)) : __builtin_amdgcn_exp2f(lgb * (float)(128 - (icol & 127)));
            lds_frag16x4(tf[0], Ks, 0, lane);
#pragma unroll
            for (int et = 0; et < 8; ++et) {
                if (et + 1 < 8) lds_frag16x4(tf[(et + 1) & 1], Ks, 16 * (et + 1), lane);
                __builtin_amdgcn_sched_barrier(0);
                f32x4 c = (f32x4){0.f, 0.f, 0.f, 0.f};
#pragma unroll
                for (int ks = 0; ks < 4; ++ks) c = __builtin_amdgcn_mfma_f32_16x16x32_bf16(tf[et & 1][ks], bq[ks], c, 0, 0, 0);
                acc[et] = acc[et] + c * sc; }
        }
    }
    const float ksc = 0.08838834764831845f;
    float ss = 0.f;
#pragma unroll
    for (int et = 0; et < 8; ++et) { acc[et] = acc[et] * ksc; ss += (acc[et][0] * acc[et][0] + acc[et][1] * acc[et][1]) + (acc[et][2] * acc[et][2] + acc[et][3] * acc[et][3]); }
    ss += __shfl_xor(ss, 16); ss += __shfl_xor(ss, 32);
    const float rs = 1.0f / sqrtf(ss * (1.0f / 128.0f) + EPS);
    const size_t row = (size_t)(rowbase + icol);
    const bf16* gp = P + row * INC + C_RG + h * 128; bf16* op = WSP<bf16>(F, WS_RET) + row * 1536 + h * 128;
#pragma unroll
    for (int et = 0; et < 8; ++et) { const int e0 = 16 * et + 4 * (lane >> 4);
        const u32x2 g2 = *(const u32x2*)(gp + e0);
        const float g0 = __uint_as_float(g2.x << 16), g1 = __uint_as_float(g2.x & 0xffff0000u), g2f = __uint_as_float(g2.y << 16), g3 = __uint_as_float(g2.y & 0xffff0000u);
        u32x2 o; o.x = pk2(acc[et][0] * rs * siluf_(g0), acc[et][1] * rs * siluf_(g1)); o.y = pk2(acc[et][2] * rs * siluf_(g2f), acc[et][3] * rs * siluf_(g3));
        *(u32x2*)(op + e0) = o; }
}

typedef float f32x2 __attribute__((ext_vector_type(2)));
__device__ __forceinline__ f32x2 cmul_(f32x2 a, f32x2 b) { return (f32x2){a.x * b.x - a.y * b.y, a.x * b.y + a.y * b.x}; }
__device__ __forceinline__ f32x2 cmulc_(f32x2 a, f32x2 b) { return (f32x2){a.x * b.x + a.y * b.y, a.y * b.x - a.x * b.y}; }
__device__ __forceinline__ f32x2 twid_(float rev) { return (f32x2){cos_rev(rev), -sin_rev(rev)}; }
__device__ __forceinline__ int fpad(int n) { return n + (n >> 3); }
template <int R> __device__ __forceinline__ void fft_twiddles(f32x2 (&tw)[R - 1], int t, int s, int M) {
    int o = 0, u = 0;
#pragma unroll
    for (int half = R / 2; half >= 1; half >>= 1) {
        const float invMu = 1.0f / (float)(M >> u);
#pragma unroll
        for (int qq = 0; qq < half; ++qq) tw[o + qq] = twid_((float)(t + qq * s) * invMu);
        o += half; ++u;
    }
}
template <int R, int HALF, int OFF> __device__ __forceinline__ void fft_sub_fwd(f32x2 (&v)[R], const f32x2 (&tw)[R - 1]) {
#pragma unroll
    for (int qq = 0; qq < HALF; ++qq) {
        const f32x2 w = tw[OFF + qq];
#pragma unroll
        for (int g0 = 0; g0 < R; g0 += 2 * HALF) { const f32x2 a = v[g0 + qq], b = v[g0 + qq + HALF]; v[g0 + qq] = a + b; v[g0 + qq + HALF] = cmul_(a - b, w); }
    }
}
template <int R, int HALF, int OFF> __device__ __forceinline__ void fft_sub_inv(f32x2 (&v)[R], const f32x2 (&tw)[R - 1]) {
#pragma unroll
    for (int qq = 0; qq < HALF; ++qq) {
        const f32x2 w = tw[OFF + qq];
#pragma unroll
        for (int g0 = 0; g0 < R; g0 += 2 * HALF) { const f32x2 A = v[g0 + qq], Bp = cmulc_(v[g0 + qq + HALF], w); v[g0 + qq] = A + Bp; v[g0 + qq + HALF] = A - Bp; }
    }
}
template <int R> __device__ __forceinline__ void fft_bf_fwd(f32x2 (&v)[R], const f32x2 (&tw)[R - 1]) {
    if constexpr (R == 16) { fft_sub_fwd<16, 8, 0>(v, tw); fft_sub_fwd<16, 4, 8>(v, tw); fft_sub_fwd<16, 2, 12>(v, tw); fft_sub_fwd<16, 1, 14>(v, tw); }
    else { fft_sub_fwd<8, 4, 0>(v, tw); fft_sub_fwd<8, 2, 4>(v, tw); fft_sub_fwd<8, 1, 6>(v, tw); }
}
template <int R> __device__ __forceinline__ void fft_bf_inv(f32x2 (&v)[R], const f32x2 (&tw)[R - 1]) {
    if constexpr (R == 16) { fft_sub_inv<16, 1, 14>(v, tw); fft_sub_inv<16, 2, 12>(v, tw); fft_sub_inv<16, 4, 8>(v, tw); fft_sub_inv<16, 8, 0>(v, tw); }
    else { fft_sub_inv<8, 1, 6>(v, tw); fft_sub_inv<8, 2, 4>(v, tw); fft_sub_inv<8, 4, 0>(v, tw); }
}
__device__ __forceinline__ void fft_tw_last(f32x2 (&tw)[7]) {
    const float h = 0.70710678118654752f;
    tw[0] = (f32x2){1.f, 0.f}; tw[1] = (f32x2){h, -h}; tw[2] = (f32x2){0.f, -1.f}; tw[3] = (f32x2){-h, -h};
    tw[4] = (f32x2){1.f, 0.f}; tw[5] = (f32x2){0.f, -1.f}; tw[6] = (f32x2){1.f, 0.f};
}
struct FftTw { f32x2 t1[15]; f32x2 t2[2][7]; f32x2 t3[2][7]; };
__device__ __forceinline__ void fft_tw_init(FftTw& T, int tid) {
    fft_twiddles<16>(T.t1, tid, 512, 8192);
#pragma unroll
    for (int it = 0; it < 2; ++it) { const int uu = tid + 512 * it; fft_twiddles<8>(T.t2[it], uu & 63, 64, 512); fft_twiddles<8>(T.t3[it], uu & 7, 8, 64); }
}
template <bool INV, int M> __device__ __forceinline__ void fft_pass8(LAS f32x2* X, int tid, const f32x2 (&tw)[2][7]) {
    asm volatile("" : "+v"(tid));
    constexpr int s = M >> 3;
#pragma unroll
    for (int it = 0; it < 2; ++it) {
        const int uu = tid + 512 * it, blk = uu / s, t = uu - blk * s, n0 = blk * M + t;
        f32x2 v[8];
#pragma unroll
        for (int q = 0; q < 8; ++q) v[q] = X[fpad(n0 + q * s)];
        if (INV) fft_bf_inv<8>(v, tw[it]); else fft_bf_fwd<8>(v, tw[it]);
#pragma unroll
        for (int q = 0; q < 8; ++q) X[fpad(n0 + q * s)] = v[q];
    }
}
__device__ __forceinline__ void fft_filter_unit(Frame& F, const FftTw& T, int l, int c) {
    LAS f32x2* X = (LAS f32x2*)F.lds;
    const float* HFp = WSP<float>(F, WS_HF + (size_t)l * 16 * MiB); const float* HBp = WSP<float>(F, WS_HF + (size_t)l * 16 * MiB + 8 * MiB);
    const float scale = hy_inv_l1(F, l, c) * (1.0f / 8192.0f);
    int tid = F.tid; asm volatile("" : "+v"(tid));
    __syncthreads();
    {   f32x2 v[16];
#pragma unroll
        for (int q = 0; q < 16; ++q) { const int n = tid + 512 * q; float x;
            if (q < 8) x = HFp[(size_t)n * 512 + c]; else x = (n == 4096) ? 0.f : HBp[(size_t)(8192 - n) * 512 + c];
            v[q] = (f32x2){x * scale, 0.f}; }
        fft_bf_fwd<16>(v, T.t1);
#pragma unroll
        for (int q = 0; q < 16; ++q) X[fpad(tid + 512 * q)] = v[q];
    }
    __syncthreads(); fft_pass8<false, 512>(X, tid, T.t2);
    __syncthreads(); fft_pass8<false, 64>(X, tid, T.t3);
    __syncthreads();
    f32x2* Hc = WSP<f32x2>(F, WS_HSPEC) + ((size_t)l * 512 + c) * 8192;
    asm volatile("" : "+v"(tid));
    f32x2 tl[7]; fft_tw_last(tl);
#pragma unroll
    for (int it = 0; it < 2; ++it) {
        const int uu = tid + 512 * it;
        f32x2 v[8];
#pragma unroll
        for (int q = 0; q < 8; ++q) v[q] = X[fpad(8 * uu + q)];
        fft_bf_fwd<8>(v, tl);
#pragma unroll
        for (int q = 0; q < 4; ++q) { f32x4 o; o[0] = v[2 * q].x; o[1] = v[2 * q].y; o[2] = v[2 * q + 1].x; o[3] = v[2 * q + 1].y; *(f32x4*)(Hc + 8 * uu + 2 * q) = o; }
    }
}
__device__ __forceinline__ void fft_zfetch(Frame& F, int unit, int tid, unsigned (&zp)[8]) {
    const bf16* n1 = WSP<bf16>(F, WS_ZT) + ((size_t)(unit >> 2) * NB + 2 * (unit & 3)) * SEQ; const bf16* n2 = n1 + SEQ;
#pragma unroll
    for (int q = 0; q < 8; ++q) { const int n = tid + 512 * q; zp[q] = (unsigned)n1[n] | ((unsigned)n2[n] << 16); }
}
__device__ __forceinline__ void fft_stage_first(LAS f32x2* X, const FftTw& T, int tid, const unsigned (&zp)[8]) {
    f32x2 v[16];
#pragma unroll
    for (int q = 0; q < 8; ++q) v[q] = (f32x2){__uint_as_float(zp[q] << 16), __uint_as_float(zp[q] & 0xffff0000u)};
#pragma unroll
    for (int q = 8; q < 16; ++q) v[q] = (f32x2){0.f, 0.f};
    fft_bf_fwd<16>(v, T.t1);
#pragma unroll
    for (int q = 0; q < 16; ++q) X[fpad(tid + 512 * q)] = v[q];
}
__device__ __forceinline__ void fft_stage_mid(LAS f32x2* X, int tid, const f32x4 (&hp)[2][4]) {
    f32x2 tl[7]; fft_tw_last(tl);
#pragma unroll
    for (int it = 0; it < 2; ++it) {
        const int uu = tid + 512 * it;
        f32x2 v[8];
#pragma unroll
        for (int q = 0; q < 8; ++q) v[q] = X[fpad(8 * uu + q)];
        fft_bf_fwd<8>(v, tl);
#pragma unroll
        for (int q = 0; q < 4; ++q) { const f32x4 h = hp[it][q]; v[2 * q] = cmul_(v[2 * q], (f32x2){h[0], h[1]}); v[2 * q + 1] = cmul_(v[2 * q + 1], (f32x2){h[2], h[3]}); }
        fft_bf_inv<8>(v, tl);
#pragma unroll
        for (int q = 0; q < 8; ++q) X[fpad(8 * uu + q)] = v[q];
    }
}
__device__ __forceinline__ void fft_stage_last(Frame& F, LAS f32x2* X, const FftTw& T, int tid, int unit) {
    f32x2 v[16];
#pragma unroll
    for (int q = 0; q < 16; ++q) v[q] = X[fpad(tid + 512 * q)];
    fft_bf_inv<16>(v, T.t1);
    bf16* y1 = WSP<bf16>(F, WS_YT) + ((size_t)(unit >> 2) * NB + 2 * (unit & 3)) * SEQ; bf16* y2 = y1 + SEQ;
#pragma unroll
    for (int q = 0; q < 8; ++q) { const int n = tid + 512 * q; y1[n] = f2bf(v[q].x); y2[n] = f2bf(v[q].y); }
}
__device__ __forceinline__ void fft_conv_pair(Frame& F, const FftTw& T, int l, int ua, int ub, int na, int nb, unsigned (&zpa)[8], unsigned (&zpb)[8]) {
    LAS f32x2* X0 = (LAS f32x2*)F.lds; LAS f32x2* X1 = X0 + 9216;
    int tid = F.tid; asm volatile("" : "+v"(tid));
    __syncthreads();
    fft_stage_first(X0, T, tid, zpa); if (na < 2048) fft_zfetch(F, na, tid, zpa);
    fft_stage_first(X1, T, tid, zpb); if (nb < 2048) fft_zfetch(F, nb, tid, zpb);
    __syncthreads(); fft_pass8<false, 512>(X0, tid, T.t2); fft_pass8<false, 512>(X1, tid, T.t2);
    f32x4 hpa[2][4], hpb[2][4];
    { const f32x2* Ha = WSP<f32x2>(F, WS_HSPEC) + ((size_t)l * 512 + (ua >> 2)) * 8192; const f32x2* Hb = WSP<f32x2>(F, WS_HSPEC) + ((size_t)l * 512 + (ub >> 2)) * 8192;
#pragma unroll
      for (int it = 0; it < 2; ++it)
#pragma unroll
          for (int q = 0; q < 4; ++q) { hpa[it][q] = *(const f32x4*)(Ha + 8 * (tid + 512 * it) + 2 * q); hpb[it][q] = *(const f32x4*)(Hb + 8 * (tid + 512 * it) + 2 * q); } }
    __syncthreads(); fft_pass8<false, 64>(X0, tid, T.t3); fft_pass8<false, 64>(X1, tid, T.t3);
    __syncthreads(); asm volatile("" : "+v"(tid)); fft_stage_mid(X0, tid, hpa); fft_stage_mid(X1, tid, hpb);
    __syncthreads(); fft_pass8<true, 64>(X0, tid, T.t3); fft_pass8<true, 64>(X1, tid, T.t3);
    __syncthreads(); fft_pass8<true, 512>(X0, tid, T.t2); fft_pass8<true, 512>(X1, tid, T.t2);
    __syncthreads(); asm volatile("" : "+v"(tid)); fft_stage_last(F, X0, T, tid, ua); fft_stage_last(F, X1, T, tid, ub);
}

constexpr int HLD = 72;
struct HyRaw { u32x4 c0, c1, c2; };
__device__ __forceinline__ void hy_fetch8(const bf16* P, int base, int t, int L, int ch0, HyRaw& r) {
    const bf16* p1 = P + (size_t)(base + t) * INC + C_HU + ch0;
    const u32x4 zero = (u32x4){0u, 0u, 0u, 0u};
    r.c1 = *(const u32x4*)p1; r.c0 = (t > 0) ? *(const u32x4*)(p1 - INC) : zero; r.c2 = (t + 1 < L) ? *(const u32x4*)(p1 + INC) : zero;
}
__device__ __forceinline__ void hy_conv8(const HyRaw& r, const float (&w)[4][8], float (&out)[8]) {
    const unsigned a0[4] = {r.c0.x, r.c0.y, r.c0.z, r.c0.w}, a1[4] = {r.c1.x, r.c1.y, r.c1.z, r.c1.w}, a2[4] = {r.c2.x, r.c2.y, r.c2.z, r.c2.w};
#pragma unroll
    for (int i = 0; i < 4; ++i) {
        out[2 * i] = w[3][2 * i] + __uint_as_float(a0[i] << 16) * w[0][2 * i] + __uint_as_float(a1[i] << 16) * w[1][2 * i] + __uint_as_float(a2[i] << 16) * w[2][2 * i];
        out[2 * i + 1] = w[3][2 * i + 1] + __uint_as_float(a0[i] & 0xffff0000u) * w[0][2 * i + 1] + __uint_as_float(a1[i] & 0xffff0000u) * w[1][2 * i + 1] + __uint_as_float(a2[i] & 0xffff0000u) * w[2][2 * i + 1];
    }
}
__device__ __forceinline__ void hy_load_w8(const float* cw, const float* cb, int ch0, float (&w)[4][8]) {
#pragma unroll
    for (int i = 0; i < 8; ++i) { w[0][i] = cw[ch0 + i]; w[1][i] = cw[1536 + ch0 + i]; w[2][i] = cw[2 * 1536 + ch0 + i]; w[3][i] = cb[ch0 + i]; }
}
__device__ __forceinline__ void hy_item_decode(int it, int& ct, int& base, int& t0, int& L, int& b, bool& isctx) {
    isctx = it >= 4096;
    if (!isctx) { ct = it & 7; t0 = ((it >> 3) & 63) * 64; b = it >> 9; base = b * SEQ; L = SEQ; }
    else { const int j = it - 4096; ct = j & 7; t0 = ((j >> 3) & 3) * 64; b = j >> 5; base = NLAT + b * CTXL; L = CTXL; }
}
template <int VAR> __device__ __forceinline__ int hy_nitems(int bx, bool reb, int nit) {
    if (!reb) return (nit - bx + 255) >> 8;
    if (bx < 64) return 11;
    if (VAR == 0) return bx < 192 ? 20 : 17;
    return 19;
}
template <int VAR> __device__ __forceinline__ int hy_item(int bx, bool reb, int idx) {
    if (!reb || idx < ((bx < 64) ? 11 : 17)) return bx + 256 * idx;
    const int e = idx - 17, donor = bx & 63, grp = (bx >> 6) - 1;
    const int k = (VAR == 0) ? (11 + 3 * grp + e) : (11 + 2 * grp + e);
    return donor + 256 * k;
}
__device__ __forceinline__ void ph_hyprep2(Frame& F, int l, bool do_ctx) {
    const bf16* P = WSP<bf16>(F, WS_P);
    const float* cw = IN_(F, 10) + l * 3 * 1536; const float* cb = IN_(F, 11) + l * 1536;
    LAS bf16* Zs = (LAS bf16*)F.lds;
    int tid = F.tid; asm volatile("" : "+v"(tid));
    const int cg = tid & 7, tl = tid >> 3, c0 = (F.bx & 7) * 64;
    float w1[4][8], wv[4][8];
    hy_load_w8(cw, cb, 512 + c0 + 8 * cg, w1); hy_load_w8(cw, cb, 1024 + c0 + 8 * cg, wv);
    const int nit = do_ctx ? 4352 : 4096;
    HyRaw r1, rv;
    const int nmy = hy_nitems<0>(F.bx, do_ctx, nit);
    { int ct, base, t0, L, b; bool isctx; hy_item_decode(hy_item<0>(F.bx, do_ctx, 0), ct, base, t0, L, b, isctx); hy_fetch8(P, base, t0 + tl, L, 512 + c0 + 8 * cg, r1); hy_fetch8(P, base, t0 + tl, L, 1024 + c0 + 8 * cg, rv); }
#pragma unroll 1
    for (int ii = 0; ii < nmy; ++ii) {
        const int it = hy_item<0>(F.bx, do_ctx, ii);
        int ct, base, t0, L, b; bool isctx; hy_item_decode(it, ct, base, t0, L, b, isctx);
        float x1[8], v[8];
        hy_conv8(r1, w1, x1); hy_conv8(rv, wv, v);
        if (ii + 1 < nmy) { int ct2, base2, t02, L2, b2; bool ic2; hy_item_decode(hy_item<0>(F.bx, do_ctx, ii + 1), ct2, base2, t02, L2, b2, ic2); hy_fetch8(P, base2, t02 + tl, L2, 512 + c0 + 8 * cg, r1); hy_fetch8(P, base2, t02 + tl, L2, 1024 + c0 + 8 * cg, rv); }
        __syncthreads();
#pragma unroll
        for (int i = 0; i < 8; ++i) Zs[(8 * cg + i) * HLD + (tl ^ (8 * cg))] = f2bf(x1[i] * v[i]);
        __syncthreads();
        { const int c = tid >> 3, seg = tid & 7;
          const u32x4 o = *(const LAS u32x4*)(Zs + c * HLD + 8 * (seg ^ (c >> 3)));
          bf16* dst = isctx ? (WSP<bf16>(F, WS_ZTC) + ((size_t)(c0 + c) * NB + b) * CTXL + t0 + 8 * seg) : (WSP<bf16>(F, WS_ZT) + ((size_t)(c0 + c) * NB + b) * SEQ + t0 + 8 * seg);
          *(u32x4*)dst = o; }
    }
}
__device__ __forceinline__ void ph_hypost2(Frame& F, int l, bool do_ctx) {
    const bf16* P = WSP<bf16>(F, WS_P);
    const float* cw = IN_(F, 10) + l * 3 * 1536; const float* cb = IN_(F, 11) + l * 1536; const float* skip = IN_(F, 19) + l * 512;
    LAS bf16* Ys = (LAS bf16*)F.lds;
    int tid = F.tid; asm volatile("" : "+v"(tid));
    const int cg = tid & 7, tl = tid >> 3, c0 = (F.bx & 7) * 64;
    float w0[4][8], w1[4][8], wv[4][8], sk[8];
    hy_load_w8(cw, cb, c0 + 8 * cg, w0); hy_load_w8(cw, cb, 512 + c0 + 8 * cg, w1); hy_load_w8(cw, cb, 1024 + c0 + 8 * cg, wv);
#pragma unroll
    for (int i = 0; i < 8; ++i) sk[i] = skip[c0 + 8 * cg + i];
    bf16* HY = WSP<bf16>(F, WS_RET) + 1024;
    const int nit = do_ctx ? 4352 : 4096;
    const int cY = tid >> 3, segY = tid & 7;
    HyRaw r0, r1, rv; u32x4 yraw;
#define HYP_FETCH(it_) do { int ct_, base_, t0_, L_, b_; bool ic_; hy_item_decode((it_), ct_, base_, t0_, L_, b_, ic_); \
        hy_fetch8(P, base_, t0_ + tl, L_, c0 + 8 * cg, r0); hy_fetch8(P, base_, t0_ + tl, L_, 512 + c0 + 8 * cg, r1); hy_fetch8(P, base_, t0_ + tl, L_, 1024 + c0 + 8 * cg, rv); \
        const bf16* src_ = ic_ ? (WSP<bf16>(F, WS_YTC) + ((size_t)(c0 + cY) * NB + b_) * CTXL + t0_ + 8 * segY) : (WSP<bf16>(F, WS_YT) + ((size_t)(c0 + cY) * NB + b_) * SEQ + t0_ + 8 * segY); \
        yraw = *(const u32x4*)src_; } while (0)
    const int nmy = hy_nitems<1>(F.bx, do_ctx, nit);
    HYP_FETCH(hy_item<1>(F.bx, do_ctx, 0));
#pragma unroll 1
    for (int ii = 0; ii < nmy; ++ii) {
        const int it = hy_item<1>(F.bx, do_ctx, ii);
        int ct, base, t0, L, b; bool isctx; hy_item_decode(it, ct, base, t0, L, b, isctx);
        float x0[8], x1[8], v[8];
        hy_conv8(r0, w0, x0); hy_conv8(r1, w1, x1); hy_conv8(rv, wv, v);
        __syncthreads();
        *(LAS u32x4*)(Ys + cY * HLD + 8 * (segY ^ (cY >> 3))) = yraw;
        if (ii + 1 < nmy) HYP_FETCH(hy_item<1>(F.bx, do_ctx, ii + 1));
        __syncthreads();
        float hy[8];
#pragma unroll
        for (int i = 0; i < 8; ++i) { const float y = bf2f(Ys[(8 * cg + i) * HLD + (tl ^ (8 * cg))]); hy[i] = x0[i] * (y + sk[i] * (x1[i] * v[i])); }
        u32x4 o; o.x = pk2(hy[0], hy[1]); o.y = pk2(hy[2], hy[3]); o.z = pk2(hy[4], hy[5]); o.w = pk2(hy[6], hy[7]);
        *(u32x4*)(HY + (size_t)(base + t0 + tl) * 1536 + c0 + 8 * cg) = o;
    }
#undef HYP_FETCH
}
__device__ __forceinline__ void hyconv_ctx_item2(Frame& F, int c) {
    const float* HFp = WSP<float>(F, WS_HFC); const float* HBp = WSP<float>(F, WS_HFC + 512 * 1024);
    LAS float* Kc = (LAS float*)F.lds; LAS float* Zs = Kc + 512;
    const float il1 = hy_inv_l1(F, 2, c);
    const bf16* Z = WSP<bf16>(F, WS_ZTC) + (size_t)c * NB * CTXL; bf16* Yo = WSP<bf16>(F, WS_YTC) + (size_t)c * NB * CTXL;
    const int tid = F.tid;
    __syncthreads();
    if (tid < 511) { const int d = tid - 255; Kc[tid] = (d >= 0 ? HFp[(size_t)d * 512 + c] : HBp[(size_t)(-d) * 512 + c]) * il1; }
#pragma unroll
    for (int i = 0; i < 4; ++i) Zs[tid + 512 * i] = bf2f(Z[tid + 512 * i]);
    __syncthreads();
    const int t = tid & 255, b0 = tid >> 8;
    float a[4] = {0.f, 0.f, 0.f, 0.f};
#pragma unroll 4
    for (int s = 0; s < CTXL; ++s) { const float k = Kc[t - s + 255];
#pragma unroll
        for (int i = 0; i < 4; ++i) a[i] += k * Zs[(b0 + 2 * i) * CTXL + s]; }
#pragma unroll
    for (int i = 0; i < 4; ++i) Yo[(b0 + 2 * i) * CTXL + t] = f2bf(a[i]);
}

constexpr int ALD = 72;
__device__ __forceinline__ void attn_unit(Frame& F, int l, int unit) {
    const bf16* P = WSP<bf16>(F, WS_P);
    LAS bf16* Kb = (LAS bf16*)F.lds; LAS bf16* Vt = Kb + 64 * ALD;
    const bool isctx = unit >= 1024;
    int b, kvh, qb;
    if (!isctx) { b = unit >> 7; kvh = (unit >> 6) & 1; qb = unit & 63; } else { const int it = unit - 1024; b = it >> 3; kvh = (it >> 2) & 1; qb = it & 3; }
    int tid = F.tid; asm volatile("" : "+v"(tid));
    const int lane = tid & 63, w = F.wave, g = w >> 1, h = kvh * 4 + g, lg = lane >> 4, lc = lane & 15;
    const int start = qb * 64, q0 = start + (w & 1) * 32;
    const int rowq0 = isctx ? (NLAT + b * CTXL + q0) : (b * SEQ + q0);
    bf16x8 bq[2][2];
#pragma unroll
    for (int qt = 0; qt < 2; ++qt)
#pragma unroll
        for (int ks = 0; ks < 2; ++ks) bq[qt][ks] = *(const bf16x8*)(P + (size_t)(rowq0 + 16 * qt + lc) * INC + C_AQ + h * 64 + 32 * ks + 8 * lg);
    const float sink = IN_(F, 9)[l * 8 + h];
    float mrun[2], lsum[2]; f32x4 o[4][2];
#pragma unroll
    for (int qt = 0; qt < 2; ++qt) { mrun[qt] = sink * 1.4426950408889634f; lsum[qt] = (lg == 0) ? 1.0f : 0.0f;
#pragma unroll
        for (int dt = 0; dt < 4; ++dt) o[dt][qt] = (f32x4){0.f, 0.f, 0.f, 0.f}; }
    const int nkb = isctx ? 4 : 9;
    const int key = tid >> 3, d0 = (tid & 7) * 8;
    u32x4 kk, vv;
#define ATT_FETCH(kb_) do { const bool cb_ = isctx || (kb_) >= 5; int row_ = -1; \
        if (cb_) row_ = NLAT + b * CTXL + (isctx ? (kb_) : (kb_) - 5) * 64 + key; \
        else { const int kpos_ = start - 128 + (kb_) * 64 + key; if (kpos_ >= 0 && kpos_ < SEQ) row_ = b * SEQ + kpos_; } \
        kk = (u32x4){0u, 0u, 0u, 0u}; vv = kk; \
        if (row_ >= 0) { kk = *(const u32x4*)(P + (size_t)row_ * INC + C_AK + kvh * 64 + d0); vv = *(const u32x4*)(P + (size_t)row_ * INC + C_AV + kvh * 64 + d0); } } while (0)
    const int kb_lo = isctx ? 0 : ((start >= 128) ? 0 : 2 - (start >> 6)), kb_hi = isctx ? 0 : (((SEQ + 128 - start) >> 6) < 5 ? ((SEQ + 128 - start) >> 6) : 5);
#define ATT_NEXT(kb_) ((!isctx && (kb_) + 1 == kb_hi) ? 5 : (kb_) + 1)
    ATT_FETCH(kb_lo);
#pragma unroll 1
    for (int kb = kb_lo; kb < nkb; kb = ATT_NEXT(kb)) {
        const bool ctxblk = isctx || kb >= 5;
        __syncthreads();
        { *(LAS u32x4*)(Kb + key * ALD + d0) = kk;
          const unsigned vw[4] = {vv.x, vv.y, vv.z, vv.w};
#pragma unroll
          for (int i = 0; i < 4; ++i) { Vt[(d0 + 2 * i) * ALD + (key ^ d0)] = (bf16)(vw[i] & 0xffffu); Vt[(d0 + 2 * i + 1) * ALD + (key ^ d0)] = (bf16)(vw[i] >> 16); } }
        __syncthreads();
        { const int kn = ATT_NEXT(kb); if (kn < nkb) ATT_FETCH(kn); }
        f32x4 s[4][2];
        bf16x8 kf[4][2];
#pragma unroll
        for (int kt = 0; kt < 4; ++kt) { kf[kt][0] = *(const LAS bf16x8*)(Kb + (16 * kt + lc) * ALD + 8 * lg); kf[kt][1] = *(const LAS bf16x8*)(Kb + (16 * kt + lc) * ALD + 32 + 8 * lg); }
        __builtin_amdgcn_sched_barrier(0);
#pragma unroll
        for (int kt = 0; kt < 4; ++kt)
#pragma unroll
            for (int qt = 0; qt < 2; ++qt) { f32x4 c = (f32x4){0.f, 0.f, 0.f, 0.f};
                c = __builtin_amdgcn_mfma_f32_16x16x32_bf16(kf[kt][0], bq[qt][0], c, 0, 0, 0); c = __builtin_amdgcn_mfma_f32_16x16x32_bf16(kf[kt][1], bq[qt][1], c, 0, 0, 0);
                s[kt][qt] = c; }
        if (!ctxblk && (kb == 0 || kb == 4)) {
#pragma unroll
            for (int kt = 0; kt < 4; ++kt)
#pragma unroll
                for (int qt = 0; qt < 2; ++qt)
#pragma unroll
                    for (int r = 0; r < 4; ++r) { const int kpos = start - 128 + kb * 64 + 16 * kt + 4 * lg + r, qpos = q0 + 16 * qt + lc, dd = qpos - kpos;
                        const bool valid = (kpos >= 0) && (kpos < SEQ) && (dd <= 128) && (dd >= -128);
                        s[kt][qt][r] = valid ? s[kt][qt][r] : -1.0e30f; }
        }
        bf16x8 pf[2][2];
#pragma unroll
        for (int qt = 0; qt < 2; ++qt) {
            float bm = -3.0e38f;
#pragma unroll
            for (int kt = 0; kt < 4; ++kt) bm = fmaxf(bm, fmaxf(fmaxf(s[kt][qt][0], s[kt][qt][1]), fmaxf(s[kt][qt][2], s[kt][qt][3])));
            bm = fmaxf(bm, __shfl_xor(bm, 16)); bm = fmaxf(bm, __shfl_xor(bm, 32));
            const float KS = 0.125f * 1.4426950408889634f;
            const float mold = mrun[qt], mnew = fmaxf(mold, bm * KS);
            mrun[qt] = mnew;
            float ps = 0.f; unsigned pw[8];
#pragma unroll
            for (int kt = 0; kt < 4; ++kt) { const float p0 = __builtin_amdgcn_exp2f(fmaf(s[kt][qt][0], KS, -mnew)), p1 = __builtin_amdgcn_exp2f(fmaf(s[kt][qt][1], KS, -mnew)), p2 = __builtin_amdgcn_exp2f(fmaf(s[kt][qt][2], KS, -mnew)), p3 = __builtin_amdgcn_exp2f(fmaf(s[kt][qt][3], KS, -mnew));
                ps += (p0 + p1) + (p2 + p3); pw[2 * kt] = pk2(p0, p1); pw[2 * kt + 1] = pk2(p2, p3); }
            if (__any(mnew > mold)) {
                const float sc = __builtin_amdgcn_exp2f(mold - mnew);
                lsum[qt] = lsum[qt] * sc;
#pragma unroll
                for (int dt = 0; dt < 4; ++dt) o[dt][qt] = o[dt][qt] * sc; }
            lsum[qt] += ps;
            u32x4 f0; f0.x = pw[0]; f0.y = pw[1]; f0.z = pw[2]; f0.w = pw[3];
            u32x4 f1; f1.x = pw[4]; f1.y = pw[5]; f1.z = pw[6]; f1.w = pw[7];
            pf[qt][0] = __builtin_bit_cast(bf16x8, f0); pf[qt][1] = __builtin_bit_cast(bf16x8, f1);
        }
        bf16x8 vfr[4][2];
#pragma unroll
        for (int dt = 0; dt < 4; ++dt)
#pragma unroll
            for (int ks = 0; ks < 2; ++ks) {
                const int vsw = ((16 * dt + lc) >> 3) << 3;
                const u32x2 a0 = *(const LAS u32x2*)(Vt + (16 * dt + lc) * ALD + ((32 * ks + 4 * lg) ^ vsw)), a1 = *(const LAS u32x2*)(Vt + (16 * dt + lc) * ALD + ((32 * ks + 16 + 4 * lg) ^ vsw));
                u32x4 av; av.x = a0.x; av.y = a0.y; av.z = a1.x; av.w = a1.y;
                vfr[dt][ks] = __builtin_bit_cast(bf16x8, av); }
        __builtin_amdgcn_sched_barrier(0);
#pragma unroll
        for (int dt = 0; dt < 4; ++dt)
#pragma unroll
            for (int ks = 0; ks < 2; ++ks)
#pragma unroll
                for (int qt = 0; qt < 2; ++qt) o[dt][qt] = __builtin_amdgcn_mfma_f32_16x16x32_bf16(vfr[dt][ks], pf[qt][ks], o[dt][qt], 0, 0, 0);
    }
#undef ATT_FETCH
#undef ATT_NEXT
    bf16* ATT = WSP<bf16>(F, WS_RET) + 512;
#pragma unroll
    for (int qt = 0; qt < 2; ++qt) {
        float lt = lsum[qt]; lt += __shfl_xor(lt, 16); lt += __shfl_xor(lt, 32);
        const float inv = 1.0f / lt;
        bf16* op = ATT + (size_t)(rowq0 + 16 * qt + lc) * 1536 + h * 64 + 4 * lg;
#pragma unroll
        for (int dt = 0; dt < 4; ++dt) { u32x2 ov; ov.x = pk2(o[dt][qt][0] * inv, o[dt][qt][1] * inv); ov.y = pk2(o[dt][qt][2] * inv, o[dt][qt][3] * inv); *(u32x2*)(op + 16 * dt) = ov; }
    }
}

__device__ __forceinline__ void ph_norm2_router(Frame& F, int l, int nrows) {
    const int lane = F.lane, RPB = nrows / 256;
    LAS float* RW = (LAS float*)F.lds;
    LAS unsigned* cnt = (LAS unsigned*)(F.lds + LDSX + 64);
    __syncthreads();
    { const float* rw = IN_(F, 24) + (size_t)l * 1024 * 32;
      for (int i = F.tid; i < 1024 * 32 / 4; i += NTHR) { const int col = i >> 3, ch = i & 7, ll = (col >> 2) & 63, ridx = ((col & 3) * 4 + (col >> 8)) * 64 + ll;
          *(LAS f32x4*)(RW + ridx * 32 + ((ch ^ ((ll >> 1) & 7)) << 2)) = *(const f32x4*)(rw + 4 * i); } }
    if (F.tid < 32) cnt[F.tid] = 0u;
    { int* SRC = WSP<int>(F, WS_SRC); for (int i = F.bx * NTHR + F.tid; i < MPAD; i += F.G * NTHR) SRC[i] = 0; }
    __syncthreads();
    const float* xm_all = WSP<float>(F, WS_XM);
    const float* gw_ = IN_(F, 23) + l * DM;
    const int e = lane >> 1, sw = (lane >> 1) & 7;
    const float rb = IN_(F, 25)[l * 32 + e];
    int* TOPI = WSP<int>(F, WS_TOPI); float* TOPW = WSP<float>(F, WS_TOPW);
    typedef float f32x2 __attribute__((ext_vector_type(2)));
    f32x4 vnext[2][4];
    { const float* xr0 = xm_all + (size_t)(F.bx * RPB + 2 * F.wave) * DM;
#pragma unroll
      for (int t = 0; t < 2; ++t)
#pragma unroll
        for (int j = 0; j < 4; ++j) vnext[t][j] = *(const f32x4*)(xr0 + t * DM + 4 * lane + 256 * j); }
#pragma unroll 1
    for (int rr = 2 * F.wave; rr < RPB; rr += 2 * NWAVES) {
        const int r = F.bx * RPB + rr, mr = modrow_of(r);
        f32x4 shq[4], aq[4];
        { const float* sh = mod_ptr(F, l, mr, 3); const float* sc = mod_ptr(F, l, mr, 4);
#pragma unroll
          for (int j = 0; j < 4; ++j) { shq[j] = *(const f32x4*)(sh + 4 * lane + 256 * j); aq[j] = *(const f32x4*)(gw_ + 4 * lane + 256 * j) * (*(const f32x4*)(sc + 4 * lane + 256 * j) + 1.0f); } }
        f32x4 v[2][4]; float ss[2] = {0.f, 0.f};
#pragma unroll
        for (int t = 0; t < 2; ++t)
#pragma unroll
            for (int j = 0; j < 4; ++j) { v[t][j] = vnext[t][j]; ss[t] += (v[t][j][0] * v[t][j][0] + v[t][j][1] * v[t][j][1]) + (v[t][j][2] * v[t][j][2] + v[t][j][3] * v[t][j][3]); }
        const float* xn = xm_all + (size_t)((rr + 2 * NWAVES < RPB) ? r + 2 * NWAVES : r) * DM;
#pragma unroll
        for (int t = 0; t < 2; ++t) {
            const float rstd = 1.0f / sqrtf(wave_sum(ss[t]) * (1.0f / DM) + EPS);
            bf16* o = WSP<bf16>(F, WS_XN) + (size_t)(r + t) * DM;
#pragma unroll
            for (int j = 0; j < 4; ++j) { v[t][j] = v[t][j] * rstd * aq[j] + shq[j];
                u32x2 w2; w2.x = pk2(v[t][j][0], v[t][j][1]); w2.y = pk2(v[t][j][2], v[t][j][3]); *(u32x2*)(o + 4 * lane + 256 * j) = w2; } }
        f32x2 acc[2][16];
#pragma unroll
        for (int t = 0; t < 2; ++t)
#pragma unroll
            for (int i = 0; i < 16; ++i) acc[t][i] = (f32x2){0.f, 0.f};
        f32x4 wa[8], wb[8];
#define RT_LOAD(W, c) { const int j_ = (c) >> 2, q_ = (c) & 3, ri_ = (q_ * 4 + j_) * 64 + lane; \
            _Pragma("unroll") for (int c8 = 0; c8 < 8; ++c8) W[c8] = *(const LAS f32x4*)(RW + ri_ * 32 + ((c8 ^ sw) << 2)); }
#define RT_FMA(W, c) { const int j_ = (c) >> 2, q_ = (c) & 3; const float h0 = v[0][j_][q_], h1 = v[1][j_][q_]; const f32x2 hh0 = {h0, h0}, hh1 = {h1, h1}; \
            _Pragma("unroll") for (int c8 = 0; c8 < 8; ++c8) { acc[0][2 * c8] += hh0 * W[c8].lo; acc[0][2 * c8 + 1] += hh0 * W[c8].hi; acc[1][2 * c8] += hh1 * W[c8].lo; acc[1][2 * c8 + 1] += hh1 * W[c8].hi; } }
        RT_LOAD(wa, 0)
#pragma unroll
        for (int c = 0; c < 16; c += 2) {
            RT_LOAD(wb, c + 1)
            __builtin_amdgcn_sched_barrier(0);
            RT_FMA(wa, c)
            __builtin_amdgcn_sched_barrier(0);
            if (c + 2 < 16) RT_LOAD(wa, c + 2)
            __builtin_amdgcn_sched_barrier(0);
            RT_FMA(wb, c + 1)
            __builtin_amdgcn_sched_barrier(0);
            if ((c & 3) == 2) { const int jj = c >> 2;
#pragma unroll
                for (int t = 0; t < 2; ++t) vnext[t][jj] = *(const f32x4*)(xn + t * DM + 4 * lane + 256 * jj);
                __builtin_amdgcn_sched_barrier(0); }
        }
#undef RT_LOAD
#undef RT_FMA
#pragma unroll
        for (int i = 0; i < 16; ++i) asm volatile("" : "+v"(acc[1][i]));
#pragma unroll
        for (int t = 0; t < 2; ++t) {
        float r16[16], r8[8], r4[4], r2[2];
#pragma unroll
        for (int i = 0; i < 16; ++i) { const auto sw2 = __builtin_amdgcn_permlane32_swap(__float_as_uint(acc[t][i >> 1][i & 1]), __float_as_uint(acc[t][8 + (i >> 1)][i & 1]), false, false);
            r16[i] = __uint_as_float(sw2[0]) + __uint_as_float(sw2[1]); }
#pragma unroll
        for (int i = 0; i < 8; ++i) { const auto sw2 = __builtin_amdgcn_permlane16_swap(__float_as_uint(r16[i]), __float_as_uint(r16[8 + i]), false, false);
            r8[i] = __uint_as_float(sw2[0]) + __uint_as_float(sw2[1]); }
#define RT_DPP(old, v, ctrl, bm) __int_as_float(__builtin_amdgcn_update_dpp(__float_as_int(old), __float_as_int(v), (ctrl), 0xF, (bm), false))
        { const bool hi = (lane & 8) != 0;
#pragma unroll
          for (int i = 0; i < 4; ++i) { const float a = r8[i], b = r8[4 + i]; const float u = RT_DPP(RT_DPP(0.f, a, 0x128, 0x3), b, 0x128, 0xC); r4[i] = (hi ? b : a) + u; } }
        { const bool hi = (lane & 4) != 0;
#pragma unroll
          for (int i = 0; i < 2; ++i) { const float a = r4[i], b = r4[2 + i]; const float u = RT_DPP(RT_DPP(0.f, a, 0x12C, 0x5), b, 0x124, 0xA); r2[i] = (hi ? b : a) + u; } }
        float logit;
        { const bool hi = (lane & 2) != 0; const float keep = hi ? r2[1] : r2[0], send = hi ? r2[0] : r2[1]; logit = keep + RT_DPP(0.f, send, 0x4E, 0xF); }
        logit += RT_DPP(0.f, logit, 0xB1, 0xF);
#undef RT_DPP
        logit += rb;
        int rank = 0;
#pragma unroll
        for (int q = 0; q < 32; ++q) { const float lq = rdlane(logit, 2 * q); rank += (lq > logit) ? 1 : 0; }
        { const bool ev = (lane & 1) == 0;
          const bool uniq = __builtin_popcountll(__ballot(ev && rank == 0)) == 1 && __builtin_popcountll(__ballot(ev && rank == 1)) == 1 && __builtin_popcountll(__ballot(ev && rank == 2)) == 1 && __builtin_popcountll(__ballot(ev && rank == 3)) == 1;
          if (!uniq) { rank = 0;
#pragma unroll 1
              for (int q = 0; q < 32; ++q) { const float lq = rdlane(logit, 2 * q); rank += (lq > logit || (lq == logit && q < e)) ? 1 : 0; } } }
        const bool sel = (rank < 4) && ((lane & 1) == 0);
        const unsigned long long m0 = __ballot(sel && rank == 0), m1 = __ballot(sel && rank == 1), m2 = __ballot(sel && rank == 2), m3 = __ballot(sel && rank == 3);
        const int l0 = __builtin_ctzll(m0), l1 = __builtin_ctzll(m1), l2 = __builtin_ctzll(m2), l3 = __builtin_ctzll(m3);
        const float t0 = rdlane(logit, l0), t1 = rdlane(logit, l1), t2 = rdlane(logit, l2), t3 = rdlane(logit, l3);
        const float e1 = __expf(t1 - t0), e2 = __expf(t2 - t0), e3 = __expf(t3 - t0), inv = 1.0f / (1.0f + e1 + e2 + e3);
        if (lane < 4) { const int id = ((lane == 0) ? l0 : (lane == 1) ? l1 : (lane == 2) ? l2 : l3) >> 1; const float wv = ((lane == 0) ? 1.0f : (lane == 1) ? e1 : (lane == 2) ? e2 : e3) * inv;
            TOPI[(r + t) * 4 + lane] = id; TOPW[(r + t) * 4 + lane] = wv; __hip_atomic_fetch_add(cnt + id, 1u, __ATOMIC_RELAXED, __HIP_MEMORY_SCOPE_WORKGROUP); }
        }
    }
    __syncthreads();
    if (F.tid < 32) WSP<int>(F, WS_BLKCNT)[F.bx * 32 + F.tid] = (int)cnt[F.tid];
}

__device__ __forceinline__ void ph_moe_assign(Frame& F, int nrows) {
    const int RPB = nrows / 256, lane = F.lane;
    LAS int* part = (LAS int*)F.lds;
    LAS int* base = part + 1024;
    LAS int* idx = base + 32;
    LAS int* posl = idx + 1024;
    const int* BC = WSP<int>(F, WS_BLKCNT);
    __syncthreads();
    { const int e = F.tid & 31, pt = F.tid >> 5; int st = 0, sp = 0;
      for (int q = 0; q < 16; ++q) { const int blk = pt * 16 + q; const int v = BC[blk * 32 + e]; st += v; if (blk < F.bx) sp += v; }
      part[pt * 32 + e] = st; part[512 + pt * 32 + e] = sp; }
    for (int i = F.tid; i < RPB * 4; i += NTHR) idx[i] = WSP<int>(F, WS_TOPI)[F.bx * RPB * 4 + i];
    __syncthreads();
    if (F.tid < 32) { int st = 0, sp = 0; for (int q = 0; q < 16; ++q) { st += part[q * 32 + F.tid]; sp += part[512 + q * 32 + F.tid]; }
        part[F.tid] = st; part[512 + F.tid] = sp; }
    __syncthreads();
    if (F.tid == 0) { int t0 = 0; int* tl = WSP<int>(F, WS_TILES);
        for (int e = 0; e < 32; ++e) { base[e] = t0 * 256 + part[512 + e]; if (F.bx == 0) tl[e] = t0; t0 += (part[e] + 255) >> 8; }
        if (F.bx == 0) tl[32] = t0; }
    __syncthreads();
    LAS int* cc = posl + 1024;
    const int nent = RPB * 4;
    for (int ch = F.wave; ch * 64 < nent; ch += NWAVES) { const int j = ch * 64 + lane; const int my = (j < nent) ? idx[j] : -1; int rk = 0, cnte = 0;
#pragma unroll
        for (int e = 0; e < 32; ++e) { const unsigned long long m = __ballot(my == e); const int below = __builtin_amdgcn_mbcnt_hi((unsigned)(m >> 32), __builtin_amdgcn_mbcnt_lo((unsigned)m, 0));
            if (my == e) rk = below; if (lane == e) cnte = __builtin_popcountll(m); }
        if (lane < 32) cc[ch * 32 + lane] = cnte;
        if (j < nent) posl[j] = rk; }
    __syncthreads();
    for (int j = F.tid; j < nent; j += NTHR) { const int e = idx[j], ch = j >> 6; int p = base[e] + posl[j]; for (int q = 0; q < ch; ++q) p += cc[q * 32 + e]; posl[j] = p; }
    __syncthreads();
    int* POS = WSP<int>(F, WS_POS); int* SRC = WSP<int>(F, WS_SRC);
    for (int j = F.tid; j < RPB * 4; j += NTHR) { const int p = posl[j]; POS[F.bx * RPB * 4 + j] = p; SRC[p] = F.bx * RPB + (j >> 2); }
}

#define PHASE_FN __device__ __forceinline__
#ifndef MK_STAG_G
#define MK_STAG_G 1
#endif
#ifndef MK_STAG_US
#define MK_STAG_US 12
#endif
__device__ __forceinline__ void phase_stagger(const Frame& F) {
    if (MK_STAG_G > 1) { const int grp = (F.bx >> 3) % MK_STAG_G;
        if (grp) { const unsigned long long t0 = __builtin_amdgcn_s_memrealtime(), dt = (unsigned long long)(grp * MK_STAG_US * 100 / MK_STAG_G);
            while (__builtin_amdgcn_s_memrealtime() - t0 < dt) __builtin_amdgcn_s_sleep(32); } }
}
PHASE_FN void P_prologue() { Frame F = make_frame(); p0_prologue(F); }
PHASE_FN void P_norm1(int mode) { Frame F = make_frame(); ph_norm1(F, mode);
    if (mode == 0) { FftTw T; fft_tw_init(T, F.tid); for (int it = F.bx; it < 1024; it += F.G) fft_filter_unit(F, T, it >> 9, it & 511); } }
PHASE_FN void P_inproj(int l) { Frame F = make_frame(); phase_stagger(F);
    pg8::Gemm g{WSP<bf16>(F, WS_XN), WSP<bf16>(F, WS_WIN) + (size_t)l * INC * 1024, NROWS, INC, 1024};
    pg8::StaticOrder S; S.init(NROWS, INC, F.G, F.bx);
    EpiP E{WSP<bf16>(F, WS_P), IN_(F, 21) + l * 3072};
    pg8::gemm_phase<EpiP, pg8::StaticOrder, true, true>(F.lds, g, S, E);
    if (l == 0 && F.bx >= F.G - 8) hy_filter_item(F, 2, F.bx - (F.G - 8));
    if (l == 0 && F.bx >= 104) tr_deferred(F, 0, 5400, F.bx - 104, 152); }
#ifndef MK_REP2
#define MK_REP2 0u
#endif
PHASE_FN void P_mix(int l) { Frame F = make_frame(); const bool last = (l == 1);
    const int na = last ? 1024 : 1088;
    for (int rep = 0; rep < ((MK_REP2 & 1u) ? 2 : 1); ++rep)
    for (int it = F.bx; it < na; it += F.G) attn_unit(F, l, it);
    for (int rep = 0; rep < ((MK_REP2 & 2u) ? 2 : 1); ++rep)
    for (int it = F.G - 1 - F.bx; it < 1088; it += F.G) ret_kv_unit(F, l, it);
    for (int rep = 0; rep < ((MK_REP2 & 4u) ? 2 : 1); ++rep) ph_hyprep2(F, l, !last); }

PHASE_FN void P_hyconv(int l) { Frame F = make_frame(); const bool last = (l == 1);
    for (int rep = 0; rep < ((MK_REP2 & 8u) ? 2 : 1); ++rep) ret_scan(F, l);
    { FftTw T; fft_tw_init(T, F.tid); unsigned zpa[8], zpb[8];
      fft_zfetch(F, F.bx, F.tid, zpa); fft_zfetch(F, F.bx + F.G, F.tid, zpb);
      for (int rep = 0; rep < ((MK_REP2 & 16u) ? 2 : 1); ++rep)
      for (int it = F.bx; it < 2048; it += 2 * F.G) { const int na = (it + 2 * F.G < 2048) ? it + 2 * F.G : F.bx, nb = (it + 3 * F.G < 2048) ? it + 3 * F.G : F.bx + F.G;
          fft_conv_pair(F, T, l, it, it + F.G, na, nb, zpa, zpb); } }
    if (!last) for (int it = F.bx; it < 512; it += F.G) hyconv_ctx_item2(F, it); }
PHASE_FN void P_hypost(int l) { Frame F = make_frame(); const bool last = (l == 1);
    for (int rep = 0; rep < ((MK_REP2 & 32u) ? 2 : 1); ++rep)
    for (int it = F.bx; it < 1088; it += F.G) { const int ci = it % 34; if (last && ci < 2) continue; ret_out_unit(F, l, it); }
    for (int rep = 0; rep < ((MK_REP2 & 64u) ? 2 : 1); ++rep) ph_hypost2(F, l, !last); }
PHASE_FN void P_merge(int l) { Frame F = make_frame(); const int mrows = (l == 1) ? NLAT : NROWS;
    pg8::Gemm g{WSP<bf16>(F, WS_RET), WSP<bf16>(F, WS_WBR) + (size_t)l * 1024 * 1536, mrows, 1024, 1536};
    pg8::StaticOrder S; S.init(mrows, 1024, F.G, F.bx);
    EpiMerge E{WSP<bf16>(F, WS_P), WSP<bf16>(F, WS_M)};
    pg8::gemm_phase<EpiMerge, pg8::StaticOrder, true, true>(F.lds, g, S, E);
    if (l == 0 && F.bx >= 32) tr_deferred(F, 5400, 11300, F.bx - 32, 224); }
PHASE_FN void P_out(int l) { Frame F = make_frame(); const int mrows = (l == 1) ? NLAT : NROWS;
    pg8::Gemm g{WSP<bf16>(F, WS_M), WSP<bf16>(F, WS_WOUT) + (size_t)l * 1024 * 1024, mrows, 1024, 1024};
    pg8::StaticOrder S; S.init(mrows, 1024, F.G, F.bx);
    const float* xl = (l == 0) ? IN_(F, 0) : WSP<float>(F, WS_XO);
    const float* xc = (l == 0) ? IN_(F, 2) : WSP<float>(F, WS_XO) + (size_t)NLAT * DM;
    EpiOut E{xl, xc, mod_ptr(F, l, 0, 2), WSP<float>(F, WS_XM)};
    pg8::gemm_phase<EpiOut, pg8::StaticOrder, true, true>(F.lds, g, S, E);
    if (l == 0 && F.bx >= 32) tr_deferred(F, 16700, TRD_TOTAL - 16700, F.bx - 32, 224); }
PHASE_FN void P_router(int l) { Frame F = make_frame(); ph_norm2_router(F, l, (l == 1) ? NLAT : NROWS); }
PHASE_FN void P_assign(int l) { Frame F = make_frame(); ph_moe_assign(F, (l == 1) ? NLAT : NROWS); }
PHASE_FN void P_moe1(int l) { Frame F = make_frame();
    LAS int* list = (LAS int*)(F.lds + LDSX + 256);
    const int n = moe_list_units(F, 8, list);
    LAS int* srcl = (LAS int*)(F.lds + LDS_SRC);
    { const int* SRC = WSP<int>(F, WS_SRC);
      for (int i = F.tid; i < n * 256; i += NTHR) srcl[i] = SRC[list[2 * (i >> 8)] * 256 + (i & 255)]; }
    __syncthreads();
    pg8::Gemm g{WSP<bf16>(F, WS_XN), WSP<bf16>(F, WS_W1) + (size_t)l * 32 * 2048 * 1024, MPAD, 32 * 2048, 1024};
    phase_stagger(F);
    MoeOrderG S{srcl, list, n};
    EpiMoe1 E{IN_(F, 27) + (size_t)l * 32 * 2048, WSP<bf16>(F, WS_ACT)};
    pg8::gemm_phase<EpiMoe1, MoeOrderG, true, true>(F.lds, g, S, E); }
PHASE_FN void P_moe2(int l) { Frame F = make_frame();
    LAS int* list = (LAS int*)(F.lds + LDSX + 256);
    const int n = moe_list_units(F, 4, list);
    pg8::Gemm g{WSP<bf16>(F, WS_ACT), WSP<bf16>(F, WS_W2) + (size_t)l * 32 * 1024 * 1024, MPAD, 32 * 1024, 1024};
    phase_stagger(F);
    MoeOrder S{nullptr, list, n};
    EpiMoe2 E{IN_(F, 29) + (size_t)l * 32 * 1024, WSP<bf16>(F, WS_HS)};
    pg8::gemm_phase<EpiMoe2, MoeOrder, true, true>(F.lds, g, S, E); }

template <int ONLY> __global__ void __launch_bounds__(NTHR, 2) mk_fwd(Args args) {
    LAS unsigned char* lds = (LAS unsigned char*)lds_raw;
    const int tid = threadIdx.x;
    for (int u = tid; u < (LDS_BYTES - LDSX) / 4; u += NTHR) ((LAS unsigned*)(lds + LDSX))[u] = 0u;
    __syncthreads();
    if (tid < 33) { const unsigned long long v = (tid < 31) ? (unsigned long long)args.in[tid] : (tid == 31 ? (unsigned long long)args.out : (unsigned long long)args.ws);
        *(LAS unsigned long long*)(lds + LDS_PTAB + 8 * tid) = v; }
    __syncthreads();
    const int lo = args.ph_lo, hi = args.ph_hi;
    const bool one_launch = (hi - lo) > 1;
    unsigned* barw = (unsigned*)(args.ws + WS_CTL + CTL_BAR);
    XcdBarrier bar; bar.bar = barw; bar.x = 0; bar.st = nullptr;
    if (one_launch) bar = xcd_barrier_post(barw, (volatile LAS unsigned*)(lds + LDSX));
#ifndef MK_MASK
#define MK_MASK 0xFFFFFFFFu
#endif
#define ENAB(k) ((ONLY < 0 && ((MK_MASK >> ((k) >= 100 ? (k) - 100 + 14 : (k))) & 1u)) || ONLY == (k))
#ifndef MK_REP
#define MK_REP 0u
#endif
#define REPB(k) (((MK_REP) >> ((k) >= 100 ? (k) - 100 + 14 : (k))) & 1u)
#define IN(k) (lo <= (k) && (k) < hi)
#define SEAM(k) do { if (IN(k) && IN((k) + 1)) xcd_barrier(bar); } while (0)
    if (ENAB(100)) if (IN(0)) { P_prologue(); if (REPB(100)) { xcd_barrier(bar); P_prologue(); } } SEAM(0);
    for (int l = 0; l < 2; ++l) {
        const int pb = 1 + NPH_LAYER * l;
        if (ENAB(0)) if (IN(pb + 0)) { P_norm1(l == 0 ? 0 : 1); if (REPB(0)) { xcd_barrier(bar); P_norm1(l == 0 ? 0 : 1); } } SEAM(pb + 0);
        if (ENAB(1)) if (IN(pb + 1)) { P_inproj(l); if (REPB(1)) { xcd_barrier(bar); P_inproj(l); } } SEAM(pb + 1);
        if (ENAB(3)) if (IN(pb + 3)) { P_mix(l); if (REPB(3)) { xcd_barrier(bar); P_mix(l); } } SEAM(pb + 3);
        if (ENAB(4)) if (IN(pb + 4)) { P_hyconv(l); if (REPB(4)) { xcd_barrier(bar); P_hyconv(l); } } SEAM(pb + 4);
        if (ENAB(5)) if (IN(pb + 5)) { P_hypost(l); if (REPB(5)) { xcd_barrier(bar); P_hypost(l); } } SEAM(pb + 5);
        if (ENAB(6)) if (IN(pb + 6)) { P_merge(l); if (REPB(6)) { xcd_barrier(bar); P_merge(l); } } SEAM(pb + 6);
        if (ENAB(9)) if (IN(pb + 9)) { P_out(l); if (REPB(9)) { xcd_barrier(bar); P_out(l); } } SEAM(pb + 9);
        if (ENAB(10)) if (IN(pb + 10)) { P_router(l); if (REPB(10)) { xcd_barrier(bar); P_router(l); } } SEAM(pb + 10);
        if (ENAB(11)) if (IN(pb + 11)) { P_assign(l); if (REPB(11)) { xcd_barrier(bar); P_assign(l); } } SEAM(pb + 11);
        if (ENAB(12)) if (IN(pb + 12)) { P_moe1(l); if (REPB(12)) { xcd_barrier(bar); P_moe1(l); } } SEAM(pb + 12);
        if (ENAB(13)) if (IN(pb + 13)) { P_moe2(l); if (REPB(13)) { xcd_barrier(bar); P_moe2(l); } } SEAM(pb + 13);
    }
    if (ENAB(101)) if (IN(NPH - 1)) { P_norm1(2); }
#undef IN
#undef SEAM
#undef ENAB
}

template <int ONLY> static void launch_phase(Args a, int lo, int hi, int grid, hipStream_t stream) {
    static bool attr_set = false;
    if (!attr_set) { (void)hipFuncSetAttribute((const void*)mk_fwd<ONLY>, hipFuncAttributeMaxDynamicSharedMemorySize, LDS_BYTES); attr_set = true; }
    a.ph_lo = lo; a.ph_hi = hi;
    hipLaunchKernelGGL(mk_fwd<ONLY>, dim3(grid), dim3(NTHR), LDS_BYTES, stream, a);
}
extern "C" void kernel_launch(void* const* d_in, const int* in_sizes, int n_in, void* d_out, int out_size, void* d_ws, size_t ws_size, hipStream_t stream) {
    static int grid = 0;
    if (grid == 0) {
        if (n_in != 31 || ws_size < WS_END) { fprintf(stderr, "kernel_launch: unexpected n_in %d / ws_size %zu\n", n_in, ws_size); grid = -1; return; }
        int dev = 0, cus = 0;
        if (hipGetDevice(&dev) != hipSuccess || hipDeviceGetAttribute(&cus, hipDeviceAttributeMultiprocessorCount, dev) != hipSuccess) { grid = -1; return; }
        grid = (cus == 256) ? 256 : -1;
        if (grid < 0) { fprintf(stderr, "kernel_launch: needs a 256-CU device, got %d\n", cus); return; }
    }
    if (grid < 0) return;
    (void)hipMemsetAsync((char*)d_ws + WS_CTL, 0, CTL_ZERO_BYTES, stream);
    Args a{};
    for (int i = 0; i < 31; ++i) a.in[i] = (const float*)d_in[i];
    a.out = (float*)d_out; a.ws = (unsigned char*)d_ws;
#if MK_ONE_LAUNCH
    launch_phase<-1>(a, 0, NPH, grid, stream);
#else
    launch_phase<100>(a, 0, 1, grid, stream);
    for (int l = 0; l < 2; ++l) {
        const int pb = 1 + NPH_LAYER * l;
        launch_phase<0>(a, pb + 0, pb + 1, grid, stream);   launch_phase<1>(a, pb + 1, pb + 2, grid, stream);   launch_phase<2>(a, pb + 2, pb + 3, grid, stream);
        launch_phase<3>(a, pb + 3, pb + 4, grid, stream);   launch_phase<4>(a, pb + 4, pb + 5, grid, stream);   launch_phase<5>(a, pb + 5, pb + 6, grid, stream);
        launch_phase<6>(a, pb + 6, pb + 7, grid, stream);   launch_phase<7>(a, pb + 7, pb + 8, grid, stream);   launch_phase<8>(a, pb + 8, pb + 9, grid, stream);
        launch_phase<9>(a, pb + 9, pb + 10, grid, stream);  launch_phase<10>(a, pb + 10, pb + 11, grid, stream); launch_phase<11>(a, pb + 11, pb + 12, grid, stream);
        launch_phase<12>(a, pb + 12, pb + 13, grid, stream); launch_phase<13>(a, pb + 13, pb + 14, grid, stream);
    }
    launch_phase<101>(a, NPH - 1, NPH, grid, stream);
#endif
}
```

```cpp
#include <hip/hip_runtime.h>
#include <cstdio>
#include <cstdint>
#define MK_ONE_LAUNCH 1
namespace pg8 {
#define PG8_LAS __attribute__((address_space(3)))
typedef unsigned short bf16_t;
typedef short bf16x8 __attribute__((ext_vector_type(8)));
typedef float f32x4 __attribute__((ext_vector_type(4)));
typedef unsigned u32x4 __attribute__((ext_vector_type(4)));
constexpr int BM = 256, BK = 64, HALF = 128, HTB = HALF * BK * 2  , STAGE_BYTES = 8 * HTB, NXCD = 8, WGM = 8;

__host__ __device__ __forceinline__ int lds_byte(int r, int c) { const int st = (r >> 4) * 2 + (c >> 5), rr = r & 15, cc = c & 31, ob = rr * 64 + cc * 2; return st * 1024 + (ob ^ (((ob >> 9) & 1) << 5)); }
__host__ __device__ __forceinline__ void stage_rc(int b, int& R, int& C) { const int st = b / 1024, sb = b % 1024, swz = sb ^ (((sb >> 9) & 1) << 5); R = (st >> 1) * 16 + swz / 64; C = (st & 1) * 32 + (swz % 64) / 2; }
__host__ __device__ __forceinline__ int perm32(int rho) { const int n = rho >> 4, i = rho & 15; return 8 * (i >> 2) + 4 * n + (i & 3); }

struct Unit { int pm, pn; };
struct Gemm { const bf16_t* A; const bf16_t* Bt; int M, N, K; };

struct StaticOrder {
    static constexpr bool GATHER = false; const PG8_LAS int* src;
    int nM, nN, nwg, G, c;
    __host__ __device__ void init(int M, int N, int G_, int c_) { nM = M / BM; nN = N / BM; nwg = nM * nN; G = G_; c = c_; }
    __host__ __device__ bool next(int i, Unit& u) const {
        const long L = (long)i * G + c; if (L >= nwg) return false;
        int wgid = (int)L; { const int q = nwg / NXCD, r = nwg % NXCD, xcd = wgid % NXCD, off = wgid / NXCD; wgid = (xcd < r ? xcd * (q + 1) : r * (q + 1) + (xcd - r) * q) + off; }
        const int nig = WGM * nN, gid = wgid / nig, fm = gid * WGM, gsz = (nM - fm) < WGM ? (nM - fm) : WGM;
        u.pm = fm + ((wgid % nig) % gsz); u.pn = (wgid % nig) / gsz; return true;
    }
    __device__ __forceinline__ void a_ready(const Unit&) const {}
    __device__ __forceinline__ void done(const Unit&) const {}
};

__device__ __forceinline__ unsigned cvt_pk_bf16(float lo, float hi) { unsigned r; asm("v_cvt_pk_bf16_f32 %0, %1, %2" : "=v"(r) : "v"(lo), "v"(hi));     return r; }
template <class Epi, class Sched, bool ALIGN_EPI = false, bool SP2 = false>
__device__ __forceinline__ void gemm_phase(PG8_LAS unsigned char* lds, const Gemm g, const Sched& S, const Epi& E) {
    int tid_ = threadIdx.x; asm volatile("" : "+v"(tid_));
    const int tid = tid_, wid = __builtin_amdgcn_readfirstlane(tid >> 6), lane = tid & 63, wr = wid >> 2, wc = wid & 3, fr = lane & 15, fq = lane >> 4;
    const int K = g.K, nt = K / BK;
    unsigned voffA[2], voffB[2];
#pragma unroll
    for (int i = 0; i < 2; ++i) { int R, C; stage_rc(tid * 16 + i * 8192, R, C); const int Rb = Epi::PERM ? ((R & ~31) + perm32(R & 31)) : R;
        voffA[i] = (unsigned)(R * K + C) * 2u; voffB[i] = (unsigned)(Rb * K + C) * 2u; }
    constexpr bool GATHER = Sched::GATHER;
    static_assert(!GATHER || SP2, "the gathered A path is wired into the SP2 loop only");
    unsigned vAc[2][2], vAn[2][2];
#define PG8_GIDX(dst, ord) do { _Pragma("unroll") for (int _h = 0; _h < 2; ++_h) _Pragma("unroll") for (int _i = 0; _i < 2; ++_i) { int _R, _C; stage_rc(tid * 16 + _i * 8192, _R, _C); \
        dst[_h][_i] = (unsigned)S.src[(ord) * 256 + _h * 128 + _R] * (unsigned)(K * 2) + (unsigned)(_C * 2); } } while (0)
    const size_t kstep = (size_t)(BK * 2);
    const size_t hstep = (size_t)HALF * K * 2;
    const size_t tstep = 2 * hstep;
    const unsigned ldsw = (unsigned)wid * 1024u;
    const int aoff = lds_byte(wr * 64 + fr, fq * 8), boff = lds_byte(wc * 32 + fr, fq * 8);
#define PG8_SA(b, h) (((b) * 2 + (h)) * HTB)
#define PG8_SB(b, h) ((4 + (b) * 2 + (h)) * HTB)
#define PG8_STAGE(bufoff, gbase, voff) do { _Pragma("unroll") for (int _i = 0; _i < 2; ++_i) \
        __builtin_amdgcn_global_load_lds((const unsigned*)((const char*)(gbase) + (voff)[_i]), (PG8_LAS unsigned*)(lds + (bufoff) + ldsw + _i * 8192), 16, 0, 0); } while (0)
#define PG8_STAGE_A(bufoff, gbase, h, vg) do { if constexpr (GATHER) { PG8_STAGE(bufoff, gbase, (vg)[h]); } else { PG8_STAGE(bufoff, (gbase) + ((h) ? hstep : 0), voffA); } } while (0)
#define PG8_LDA(dst, b, h) do { _Pragma("unroll") for (int m = 0; m < 4; ++m) _Pragma("unroll") for (int k = 0; k < 2; ++k) dst[m][k] = *(const PG8_LAS bf16x8*)(lds + PG8_SA(b, h) + aoff + m * 2048 + k * 1024); } while (0)
#define PG8_LDB(dst, b, h) do { _Pragma("unroll") for (int n = 0; n < 2; ++n) _Pragma("unroll") for (int k = 0; k < 2; ++k) dst[n][k] = *(const PG8_LAS bf16x8*)(lds + PG8_SB(b, h) + boff + n * 2048 + k * 1024); } while (0)
#define PG8_MMA(ai, bj, At, Bt) do { __builtin_amdgcn_s_setprio(1); _Pragma("unroll") for (int m = 0; m < 4; ++m) _Pragma("unroll") for (int n = 0; n < 2; ++n) _Pragma("unroll") for (int k = 0; k < 2; ++k) \
        acc[ai][bj][m][n] = __builtin_amdgcn_mfma_f32_16x16x32_bf16(Bt[n][k], At[m][k], acc[ai][bj][m][n], 0, 0, 0); __builtin_amdgcn_s_setprio(0); } while (0)
#define PG8_WAIT_V(n) asm volatile("s_waitcnt vmcnt(" #n ")" ::: "memory")
#define PG8_WAIT_L(n) asm volatile("s_waitcnt lgkmcnt(" #n ")" ::: "memory")
#define PG8_BAR __builtin_amdgcn_s_barrier()
#define PG8_SCHED __builtin_amdgcn_sched_barrier(0)
    Unit cur, nxt; int ui = 0;
    if (!S.next(0, cur)) return;
    f32x4 acc[2][2][4][2];
#pragma unroll
    for (int a = 0; a < 2; ++a)
#pragma unroll
        for (int b = 0; b < 2; ++b)
#pragma unroll
            for (int m = 0; m < 4; ++m)
#pragma unroll
                for (int n = 0; n < 2; ++n) acc[a][b][m][n] = (f32x4){0.f, 0.f, 0.f, 0.f};
    bf16x8 At[4][2], B0[2][2], B1[2][2];
    const char* cA = (const char*)g.A + (GATHER ? (size_t)0 : (size_t)cur.pm * tstep); const char* cB = (const char*)g.Bt + (size_t)cur.pn * tstep;
    S.a_ready(cur);
    if constexpr (GATHER) { PG8_GIDX(vAc, 0); }
    if constexpr (SP2) {
        PG8_STAGE(PG8_SB(0, 0), cB, voffB); PG8_STAGE(PG8_SB(0, 1), cB + hstep, voffB); PG8_STAGE_A(PG8_SA(0, 0), cA, 0, vAc); PG8_STAGE_A(PG8_SA(0, 1), cA, 1, vAc);
        if (wr == 1) PG8_BAR;
        PG8_WAIT_V(2); PG8_BAR;
        PG8_STAGE(PG8_SB(1, 0), cB + kstep, voffB); PG8_STAGE_A(PG8_SA(1, 0), cA + kstep, 0, vAc); PG8_STAGE(PG8_SB(1, 1), cB + hstep + kstep, voffB);
        PG8_WAIT_V(6); PG8_BAR;
    } else {
        PG8_STAGE(PG8_SB(0, 0), cB, voffB); PG8_STAGE(PG8_SA(0, 0), cA, voffA); PG8_STAGE(PG8_SB(0, 1), cB + hstep, voffB); PG8_STAGE(PG8_SA(0, 1), cA + hstep, voffA);
        if (wr == 1) PG8_BAR;
        PG8_WAIT_V(4); PG8_BAR;
        PG8_STAGE(PG8_SB(1, 0), cB + kstep, voffB); PG8_STAGE(PG8_SA(1, 0), cA + kstep, voffA); PG8_STAGE(PG8_SB(1, 1), cB + hstep + kstep, voffB);
        PG8_WAIT_V(6); PG8_BAR;
    }
    for (;;) {
        const bool has_next = S.next(ui + 1, nxt);
        if constexpr (GATHER) { if (has_next) { PG8_GIDX(vAn, ui + 1); } else { _Pragma("unroll") for (int _h = 0; _h < 2; ++_h) _Pragma("unroll") for (int _i = 0; _i < 2; ++_i) vAn[_h][_i] = vAc[_h][_i]; } }
        const char* nA = GATHER ? cA : (has_next ? (const char*)g.A + (size_t)nxt.pm * tstep : cA); const char* nB = has_next ? (const char*)g.Bt + (size_t)nxt.pn * tstep : cB;
        for (int t = 0; t < nt; t += 2) {
            if constexpr (Epi::KMID) { if (t == 8 || t == 16) E.kmid(t, acc, cur, wr, wc, fr, fq); }
            const bool last = (t == nt - 2);
            const char* a1 = cA + (size_t)(t + 1) * kstep;
            const char* a2 = last ? nA : cA + (size_t)(t + 2) * kstep; const char* b2 = last ? nB : cB + (size_t)(t + 2) * kstep;
            const char* a3 = a2 + kstep; const char* b3 = b2 + kstep;
            if (last && has_next) S.a_ready(nxt);
            unsigned v2[2][2];
            if constexpr (GATHER) { _Pragma("unroll") for (int _h = 0; _h < 2; ++_h) _Pragma("unroll") for (int _i = 0; _i < 2; ++_i) v2[_h][_i] = last ? vAn[_h][_i] : vAc[_h][_i]; }
            if constexpr (SP2) {
            PG8_LDB(B0, 0, 0); PG8_LDB(B1, 0, 1); PG8_SCHED; PG8_LDA(At, 0, 0); PG8_STAGE_A(PG8_SA(1, 1), a1, 1, vAc);
            PG8_WAIT_V(8); PG8_WAIT_L(0); PG8_BAR; PG8_MMA(0, 0, At, B0); PG8_MMA(0, 1, At, B1); PG8_BAR; PG8_SCHED;
            PG8_LDA(At, 0, 1); PG8_STAGE(PG8_SB(0, 0), b2, voffB); PG8_STAGE(PG8_SB(0, 1), b2 + hstep, voffB); PG8_STAGE_A(PG8_SA(0, 0), a2, 0, v2);
            PG8_WAIT_V(8); PG8_WAIT_L(0); PG8_BAR; PG8_MMA(1, 0, At, B0); PG8_MMA(1, 1, At, B1); PG8_BAR; PG8_SCHED;
            PG8_LDB(B0, 1, 0); PG8_LDB(B1, 1, 1); PG8_SCHED; PG8_LDA(At, 1, 0); PG8_STAGE_A(PG8_SA(0, 1), a2, 1, v2);
            PG8_WAIT_V(8); PG8_WAIT_L(0); PG8_BAR; PG8_MMA(0, 0, At, B0); PG8_MMA(0, 1, At, B1); PG8_BAR; PG8_SCHED;
            PG8_LDA(At, 1, 1); PG8_STAGE(PG8_SB(1, 0), b3, voffB); PG8_STAGE(PG8_SB(1, 1), b3 + hstep, voffB); PG8_STAGE_A(PG8_SA(1, 0), a3, 0, v2);
            PG8_WAIT_V(8); PG8_WAIT_L(0); PG8_BAR; PG8_MMA(1, 0, At, B0); PG8_MMA(1, 1, At, B1); PG8_BAR; PG8_SCHED;
            } else {
            PG8_LDB(B0, 0, 0); PG8_SCHED; PG8_LDA(At, 0, 0); PG8_STAGE(PG8_SA(1, 1), a1 + hstep, voffA);
            PG8_WAIT_L(8); PG8_BAR; PG8_WAIT_L(0); PG8_MMA(0, 0, At, B0); PG8_BAR; PG8_SCHED;
            PG8_LDB(B1, 0, 1); PG8_STAGE(PG8_SB(0, 0), b2, voffB);
            PG8_BAR; PG8_WAIT_L(0); PG8_MMA(0, 1, At, B1); PG8_BAR;
            PG8_LDA(At, 0, 1); PG8_STAGE(PG8_SA(0, 0), a2, voffA);
            PG8_BAR; PG8_WAIT_L(0); PG8_MMA(1, 0, At, B0); PG8_BAR; PG8_SCHED;
            PG8_STAGE(PG8_SB(0, 1), b2 + hstep, voffB);
            PG8_WAIT_V(6); PG8_BAR; PG8_MMA(1, 1, At, B1); PG8_BAR;
            PG8_LDB(B0, 1, 0); PG8_SCHED; PG8_LDA(At, 1, 0); PG8_STAGE(PG8_SA(0, 1), a2 + hstep, voffA);
            PG8_WAIT_L(8); PG8_BAR; PG8_WAIT_L(0); PG8_MMA(0, 0, At, B0); PG8_BAR; PG8_SCHED;
            PG8_LDB(B1, 1, 1); PG8_STAGE(PG8_SB(1, 0), b3, voffB);
            PG8_BAR; PG8_WAIT_L(0); PG8_MMA(0, 1, At, B1); PG8_BAR;
            PG8_LDA(At, 1, 1); PG8_STAGE(PG8_SA(1, 0), a3, voffA);
            PG8_BAR; PG8_WAIT_L(0); PG8_MMA(1, 0, At, B0); PG8_BAR; PG8_SCHED;
            PG8_STAGE(PG8_SB(1, 1), b3 + hstep, voffB);
            PG8_WAIT_V(6); PG8_BAR; PG8_MMA(1, 1, At, B1); PG8_BAR;
            }
        }
        if constexpr (ALIGN_EPI) { if (wr == 0) PG8_BAR; }
        if constexpr (!Epi::AFTER_DRAIN) { E(acc, cur, wr, wc, fr, fq);
#ifdef MK_EPI2
            asm volatile("" ::: "memory"); E(acc, cur, wr, wc, fr, fq);
#endif
#ifdef MK_EPI3
            { char* sp = (char*)MK_EPI3_BASE + (size_t)blockIdx.x * 131072 + (size_t)wid * 16384 + (size_t)lane * 16;
              _Pragma("unroll") for (int q_ = 0; q_ < 16; ++q_) { u32x4 w_; w_.x = __float_as_uint(acc[q_ >> 3][(q_ >> 2) & 1][q_ & 3][0][0]); w_.y = __float_as_uint(acc[q_ >> 3][(q_ >> 2) & 1][q_ & 3][0][1]); w_.z = __float_as_uint(acc[q_ >> 3][(q_ >> 2) & 1][q_ & 3][1][0]); w_.w = __float_as_uint(acc[q_ >> 3][(q_ >> 2) & 1][q_ & 3][1][1]);
                  *(u32x4*)(sp + q_ * 1024) = w_; } }
#endif
            S.done(cur); }
        if (!has_next) break;
#pragma unroll
        for (int a = 0; a < 2; ++a)
#pragma unroll
            for (int b = 0; b < 2; ++b)
#pragma unroll
                for (int m = 0; m < 4; ++m)
#pragma unroll
                    for (int n = 0; n < 2; ++n) acc[a][b][m][n] = (f32x4){0.f, 0.f, 0.f, 0.f};
        cur = nxt; cA = nA; cB = nB; ++ui;
        if constexpr (GATHER) { _Pragma("unroll") for (int _h = 0; _h < 2; ++_h) _Pragma("unroll") for (int _i = 0; _i < 2; ++_i) vAc[_h][_i] = vAn[_h][_i]; }
        if constexpr (ALIGN_EPI) { if (wr == 1) PG8_BAR; }
    }
    PG8_WAIT_V(0);
    if constexpr (!ALIGN_EPI) { if (wr == 0) PG8_BAR; }
    PG8_BAR;
    if constexpr (Epi::AFTER_DRAIN) { E.fused(acc, cur, wr, wc, fr, fq, lds, wid, lane); S.done(cur); }
#undef PG8_SA
#undef PG8_SB
#undef PG8_STAGE
#undef PG8_STAGE_A
#undef PG8_GIDX
#undef PG8_LDA
#undef PG8_LDB
#undef PG8_MMA
#undef PG8_WAIT_V
#undef PG8_WAIT_L
#undef PG8_BAR
#undef PG8_SCHED
}
}
#define XB_TMO      128
#define XB_XCNT(j)  (256  + 64 * (j))
#define XB_XSUB(j)  (1280 + 64 * (j))
#define XB_XGEN(j)  (2304 + 64 * (j))
#define XB_TOP      3328
#define XB_TOPGEN   3392
#define XCD_BAR_WORDS 3456
#define XB_SPIN_CAP (1u << 18)
#define LAS __attribute__((address_space(3)))

__device__ __forceinline__ unsigned xb_ld(unsigned* p)              { return __hip_atomic_load(p, __ATOMIC_RELAXED, __HIP_MEMORY_SCOPE_AGENT); }
__device__ __forceinline__ unsigned xb_add(unsigned* p, unsigned v) { return __hip_atomic_fetch_add(p, v, __ATOMIC_RELAXED, __HIP_MEMORY_SCOPE_AGENT); }
__device__ __forceinline__ unsigned xb_xcc_id() { return (unsigned)__builtin_amdgcn_s_getreg((3 << 11) | 20) & 0xFu; }
#define XB_SPIN(cond, bar) do { unsigned _sp = 0; while (cond) { __builtin_amdgcn_s_sleep(1); \
    if ((++_sp & 255u) == 0u) { if (xb_ld(&(bar)[XB_TMO])) break; if (_sp > XB_SPIN_CAP) { atomicAdd(&(bar)[XB_TMO], 1u); break; } } } } while (0)

struct XcdBarrier {
    unsigned* bar; unsigned x;
    volatile LAS unsigned* st;
};

__device__ __forceinline__ XcdBarrier xcd_barrier_post(unsigned* bar, volatile LAS unsigned* st) {
    XcdBarrier b; b.bar = bar; b.x = xb_xcc_id(); b.st = st;
    if (threadIdx.x == 0) (void)xb_add(&bar[XB_XCNT(b.x)], 1u);
    return b;
}
__device__ __forceinline__ void xcd_barrier_complete(unsigned* bar, unsigned x, unsigned& nloc, unsigned& nx) {
    const unsigned G = gridDim.x * gridDim.y * gridDim.z;
    unsigned sum, cnt, mine, sp = 0u;
    for (;;) {
        sum = 0u; cnt = 0u; mine = 0u;
#pragma unroll
        for (unsigned j = 0; j < 16; ++j) { const unsigned c = xb_ld(&bar[XB_XCNT(j)]); sum += c; cnt += (c > 0u) ? 1u : 0u; mine = (j == x) ? c : mine; }
        if (sum == G) break;
        __builtin_amdgcn_s_sleep(1);
        if ((++sp & 255u) == 0u) { if (xb_ld(&bar[XB_TMO])) break; if (sp > XB_SPIN_CAP) { atomicAdd(&bar[XB_TMO], 1u); break; } }
    }
    nloc = mine > 0u ? mine : 1u; nx = cnt > 0u ? cnt : 1u;
}

__device__ __forceinline__ void xcd_barrier(const XcdBarrier& b) {
    asm volatile("s_waitcnt vmcnt(0)" ::: "memory");
    __syncthreads();
    if (threadIdx.x == 0) {
        unsigned* bar = b.bar;
        __builtin_amdgcn_s_waitcnt(0);
        unsigned nloc = b.st[0], nx = b.st[1];
        if (nloc == 0u) { xcd_barrier_complete(bar, b.x, nloc, nx); b.st[0] = nloc; b.st[1] = nx; }
        const unsigned old = xb_add(&bar[XB_XSUB(b.x)], 1u);
        const unsigned gen = old / nloc;
        if (old + 1u == (gen + 1u) * nloc) {
            __builtin_amdgcn_fence(__ATOMIC_RELEASE, "agent");
            asm volatile("s_waitcnt vmcnt(0)" ::: "memory");
            const unsigned og = xb_add(&bar[XB_TOP], 1u);
            const unsigned tg = og / nx;
            if (og + 1u == (tg + 1u) * nx) xb_add(&bar[XB_TOPGEN], 1u);
            else XB_SPIN(xb_ld(&bar[XB_TOPGEN]) == tg, bar);
            __builtin_amdgcn_fence(__ATOMIC_ACQUIRE, "agent");
            xb_add(&bar[XB_XGEN(b.x)], 1u);
            asm volatile("s_waitcnt vmcnt(0)" ::: "memory");
        } else {
            XB_SPIN(xb_ld(&bar[XB_XGEN(b.x)]) == gen, bar);
            __builtin_amdgcn_fence(__ATOMIC_ACQUIRE, "agent");
            asm volatile("s_waitcnt vmcnt(0)" ::: "memory");
        }
    }
    __syncthreads();
}

#define GAS __attribute__((address_space(1)))
typedef unsigned short bf16;
typedef float f32x4 __attribute__((ext_vector_type(4)));
typedef unsigned u32x4 __attribute__((ext_vector_type(4)));
typedef unsigned u32x2 __attribute__((ext_vector_type(2)));
constexpr int DM = 1024, NB = 8, SEQ = 4096, CTXL = 256, NLAT = NB * SEQ, NCTX = NB * CTXL, NROWS = NLAT + NCTX;
constexpr int INC = 7424;
constexpr int C_RQ = 0, C_RK = 512, C_RV = 1024, C_RG = 1536, C_AQ = 2048, C_AK = 2560, C_AV = 2688, C_HU = 2816, C_MG = 4352;
constexpr int NEXP = 32, DFF = 1024;
constexpr int MPAD = 147456;
constexpr float EPS = 1e-6f;
constexpr int NWAVES = 8, NTHR = 512;
constexpr int LDS_BYTES = 163840, LDSX = 155648, LDS_SRC = 131072;
constexpr int NPH_LAYER = 14, NPH = 1 + 2 * NPH_LAYER + 1;

constexpr size_t MiB = 1u << 20;
constexpr size_t WS_CTL = 0, CTL_ZERO_BYTES = 32768;
constexpr size_t CTL_BAR = 16384;
constexpr size_t CTL_MOD = 262144;
constexpr size_t WS_SRC = 6 * MiB;
constexpr size_t WS_L1P = 5 * MiB;
constexpr size_t WS_TOPI = 1 * MiB, WS_TOPW = 2 * MiB, WS_POS = 3 * MiB, WS_BLKCNT = 4 * MiB, WS_TILES = 4 * MiB + 65536;
constexpr size_t WS_WIN = 8 * MiB, WS_WBR = 37 * MiB, WS_WOUT = 43 * MiB, WS_W1 = 48 * MiB, WS_W2 = 304 * MiB;
constexpr size_t WS_HF = 432 * MiB;
constexpr size_t WS_HFC = 464 * MiB;
constexpr size_t WS_XM = 466 * MiB, WS_XO = 602 * MiB, WS_XN = 738 * MiB;
constexpr size_t WS_A = 806 * MiB;
constexpr size_t WS_P = WS_A, WS_RET = WS_A + 494 * MiB, WS_ATT = WS_RET + 34 * MiB, WS_HY = WS_ATT + 34 * MiB;
constexpr size_t WS_HS = WS_A, WS_ACT = WS_A + 288 * MiB;
constexpr size_t WS_MF32 = 1406 * MiB, WS_M = 1542 * MiB;
constexpr size_t WS_ZT = 1610 * MiB, WS_ZTC = 1674 * MiB, WS_YT = 1678 * MiB, WS_YTC = 1742 * MiB;
constexpr size_t WS_KV = 1746 * MiB, WS_SP = 1882 * MiB, WS_HSPEC = 1950 * MiB, WS_END = 2014 * MiB;
static_assert(WS_HY + 34 * MiB <= WS_MF32 && WS_ACT + 288 * MiB <= WS_MF32, "region A");
static_assert((size_t)NROWS * INC * 2 <= 494 * MiB, "P size");

__device__ __forceinline__ float bf2f(bf16 v) { return __uint_as_float(((unsigned)v) << 16); }
__device__ __forceinline__ bf16 f2bf(float f) { unsigned u = __float_as_uint(f); u += 0x7FFFu + ((u >> 16) & 1u); return (bf16)(u >> 16); }
__device__ __forceinline__ unsigned pk2(float lo, float hi) { return pg8::cvt_pk_bf16(lo, hi); }
#define WS_DPP(v, ctrl) __int_as_float(__builtin_amdgcn_update_dpp(0, __float_as_int(v), (ctrl), 0xF, 0xF, false))
__device__ __forceinline__ float wave_sum(float v) {
    v += WS_DPP(v, 0xB1);
    v += WS_DPP(v, 0x4E);
    v += WS_DPP(v, 0x124);
    v += WS_DPP(v, 0x128);
    const float s0 = __int_as_float(__builtin_amdgcn_readlane(__float_as_int(v), 0)), s1 = __int_as_float(__builtin_amdgcn_readlane(__float_as_int(v), 16));
    const float s2 = __int_as_float(__builtin_amdgcn_readlane(__float_as_int(v), 32)), s3 = __int_as_float(__builtin_amdgcn_readlane(__float_as_int(v), 48));
    return (s0 + s1) + (s2 + s3);
}
__device__ __forceinline__ float rdlane(float v, int l) { return __int_as_float(__builtin_amdgcn_readlane(__float_as_int(v), l)); }
__device__ __forceinline__ float sin_rev(float rev) { return __builtin_amdgcn_sinf(__builtin_amdgcn_fractf(rev)); }
__device__ __forceinline__ float cos_rev(float rev) { return __builtin_amdgcn_cosf(__builtin_amdgcn_fractf(rev)); }
__device__ __forceinline__ float sin_rad(float x) { return sin_rev(x * 0.15915494309189535f); }
__device__ __forceinline__ float sigmoidf_(float x) { return 1.0f / (1.0f + __expf(-x)); }
__device__ __forceinline__ float siluf_(float x) { return x / (1.0f + __expf(-x)); }
__device__ __forceinline__ float log_sigmoid_(float x) {
    const float y = __expf(-x);
    if (y < 0.1f) { return -(y * (1.0f + y * (-0.5f + y * (0.33333333f + y * (-0.25f + y * (0.2f + y * (-0.16666667f + y * (0.14285714f + y * (-0.125f))))))))); }
    return -logf(1.0f + y);
}
#define LDS_WAIT() asm volatile("s_waitcnt lgkmcnt(0)" ::: "memory")
#define VM_WAIT() asm volatile("s_waitcnt vmcnt(0)" ::: "memory")

struct Args { const float* in[31]; float* out; unsigned char* ws; int ph_lo, ph_hi; };

extern __shared__ __attribute__((aligned(16))) unsigned char lds_raw[];
constexpr int LDS_PTAB = LDSX + 1024;
struct Frame {
    LAS unsigned char* lds;
    int tid, lane, wave, G, bx;
    unsigned char* ws;
};
__device__ __forceinline__ unsigned long long ptab_read(int i) {
    const LAS unsigned* p = (const LAS unsigned*)((LAS unsigned char*)lds_raw + LDS_PTAB) + 2 * i;
    const unsigned lo = (unsigned)__builtin_amdgcn_readfirstlane((int)p[0]), hi = (unsigned)__builtin_amdgcn_readfirstlane((int)p[1]);
    return ((unsigned long long)hi << 32) | lo;
}
__device__ __forceinline__ const float* IN_(const Frame& F, int i) { return (const float*)(const GAS float*)ptab_read(i); }
__device__ __forceinline__ float* OUT_(const Frame& F) { return (float*)(GAS float*)ptab_read(31); }
__device__ __forceinline__ Frame make_frame() {
    Frame F; F.lds = (LAS unsigned char*)lds_raw;
    int t = threadIdx.x; asm volatile("" : "+v"(t)); F.tid = t; F.lane = t & 63; F.wave = __builtin_amdgcn_readfirstlane(t >> 6);
    int g = gridDim.x, bx = blockIdx.x; asm volatile("" : "+s"(g), "+s"(bx)); F.G = g; F.bx = bx;
    unsigned long long w = ptab_read(32); asm volatile("" : "+s"(w)); F.ws = (unsigned char*)(GAS unsigned char*)w; return F;
}
template <class T> __device__ __forceinline__ T* WSP(const Frame& F, size_t off) { return (T*)(F.ws + off); }
__device__ __forceinline__ const float* mod_ptr(const Frame& F, int l, int modrow, int chunk) { return WSP<float>(F, WS_CTL + CTL_MOD) + ((size_t)(l * 9 + modrow) * 6 + chunk) * DM; }
__device__ __forceinline__ int modrow_of(int r) { return r < NLAT ? (r >> 12) : 8; }

constexpr int TRP = 65;
__device__ __forceinline__ void tr_item(const float* W, int K, int N, bf16* WT, int ldk, int item, int w1map, LAS float* scr, int lane) {
    const int nblk = N >> 6, kb = item / nblk, nb = item - kb * nblk, k0 = 64 * kb, n0 = 64 * nb;
    const int r = lane >> 4, cq = lane & 15;
    const float* src = W + (size_t)(k0 + r) * N + n0 + 4 * cq;
#pragma unroll 1
    for (int hh = 0; hh < 2; ++hh) {
        f32x4 v[8];
#pragma unroll
        for (int i = 0; i < 8; ++i) v[i] = *(const f32x4*)(src + (size_t)(4 * (8 * hh + i)) * N);
#pragma unroll
        for (int i = 0; i < 8; ++i) { LAS float* d = scr + (4 * (8 * hh + i) + r) * TRP + 4 * cq; d[0] = v[i][0]; d[1] = v[i][1]; d[2] = v[i][2]; d[3] = v[i][3]; }
    }
    LDS_WAIT(); asm volatile("" ::: "memory");
    int r0 = n0;
    if (w1map == 1) r0 = (n0 < 1024) ? ((n0 >> 7) * 256 + (n0 & 127)) : ((((n0 - 1024) >> 7) * 256) + 128 + ((n0 - 1024) & 127));
    const int kc = lane & 7;
#pragma unroll
    for (int j = 0; j < 8; ++j) { const int n = (lane >> 3) + 8 * j; const LAS float* s = scr + (8 * kc) * TRP + n;
        u32x4 o; o.x = pk2(s[0 * TRP], s[1 * TRP]); o.y = pk2(s[2 * TRP], s[3 * TRP]); o.z = pk2(s[4 * TRP], s[5 * TRP]); o.w = pk2(s[6 * TRP], s[7 * TRP]);
        int row = r0 + n;
        if (w1map == 2) {
            const int c = n0 + n;
            if (c < 1024) row = (c & ~255) + ((c >> 6) & 1) * 128 + ((c >> 7) & 1) * 64 + (c & 63);
            else if (c >= C_AQ && c < C_AV) { const int d = c & 63, gq = d >> 4, hd = (c >> 6) & 3; row = (c & ~255) + (gq & 1) * 128 + hd * 32 + (gq >> 1) * 16 + (d & 15); }
            else if (c >= C_AV && c < C_HU) { const int jv = c - C_AV; row = C_AK + (jv >> 6) * 128 + 64 + (jv & 63); }
        }
        *(u32x4*)(WT + (size_t)row * ldk + k0 + 8 * kc) = o; }
    LDS_WAIT(); asm volatile("" ::: "memory");
}

__device__ __forceinline__ void hy_filter_item(Frame& F, int f, int tb) {
    const int lane = F.lane;
    float* L1P = WSP<float>(F, WS_L1P);
    LAS float* H2 = (LAS float*)F.lds + 16384;
    LAS float* red = H2 + 32 * 64;
    const int L = (f == 2) ? 256 : 4096, l = (f == 1) ? 1 : 0;
    const float* w1 = IN_(F, 12) + l * 33 * 64; const float* b1 = IN_(F, 13) + l * 64; const float* f1 = IN_(F, 14) + l * 64;
    const float* w2 = IN_(F, 15) + l * 64 * 64; const float* b2 = IN_(F, 16) + l * 64; const float* f2 = IN_(F, 17) + l * 64;
    const float* w3 = IN_(F, 18) + (size_t)l * 64 * 1024;
    float* HFp = (f == 2) ? WSP<float>(F, WS_HFC) : WSP<float>(F, WS_HF + (size_t)l * 16 * MiB);
    float* HBp = (f == 2) ? WSP<float>(F, WS_HFC + 512 * 1024) : WSP<float>(F, WS_HF + (size_t)l * 16 * MiB + 8 * MiB);
    __syncthreads();
    {
        float w1c[33], w2c[64];
#pragma unroll
        for (int i = 0; i < 33; ++i) w1c[i] = w1[i * 64 + lane];
#pragma unroll
        for (int i = 0; i < 64; ++i) w2c[i] = w2[i * 64 + lane];
        const float b1l = b1[lane], f1l = f1[lane], b2l = b2[lane], f2l = f2[lane];
#pragma unroll 1
        for (int r = 0; r < 4; ++r) {
            const int n = tb * 32 + F.wave * 4 + r;
            float zl = 0.f;
            if (lane == 0) zl = (float)n / (float)(L - 1);
            else if (lane <= 32) { const int j = (lane - 1) & 15; const float band = 1e-4f + (15.0f - 1e-4f) * (float)j / 15.0f; const float rev = (float)n * band / (float)L;
                zl = (lane <= 16) ? cos_rev(rev) : -sin_rev(rev); }
            float a = 0.f;
#pragma unroll
            for (int i = 0; i < 33; ++i) a += rdlane(zl, i) * w1c[i];
            const float h1 = sin_rad(f1l * (a + b1l));
            float a2 = 0.f;
#pragma unroll
            for (int i = 0; i < 64; ++i) a2 += rdlane(h1, i) * w2c[i];
            H2[(F.wave * 4 + r) * 64 + lane] = sin_rad(f2l * (a2 + b2l));
        }
    }
    __syncthreads();
    const int c1 = F.wave * 128 + lane, c2 = c1 + 64;
    float l1p[2] = {0.f, 0.f};
#pragma unroll 1
    for (int rh = 0; rh < 2; ++rh) {
        float acc[16][2];
#pragma unroll
        for (int r = 0; r < 16; ++r) { acc[r][0] = 0.f; acc[r][1] = 0.f; }
#pragma unroll 1
        for (int i = 0; i < 64; i += 4) {
            float wa[4], wb[4];
#pragma unroll
            for (int k = 0; k < 4; ++k) { wa[k] = w3[(i + k) * 1024 + c1]; wb[k] = w3[(i + k) * 1024 + c2]; }
            f32x4 hh[16];
#pragma unroll
            for (int r = 0; r < 16; ++r) hh[r] = *(const LAS f32x4*)(H2 + (rh * 16 + r) * 64 + i);
            __builtin_amdgcn_sched_barrier(0);
#pragma unroll
            for (int r = 0; r < 16; ++r) { const f32x4 h = hh[r];
                acc[r][0] += h[0] * wa[0] + h[1] * wa[1] + h[2] * wa[2] + h[3] * wa[3]; acc[r][1] += h[0] * wb[0] + h[1] * wb[1] + h[2] * wb[2] + h[3] * wb[3]; }
        }
#pragma unroll
        for (int q = 0; q < 2; ++q) {
            const int c = q ? c2 : c1, cc = c & 511;
            const float delta = 3.0701134573253944f + (15.350567286626973f - 3.0701134573253944f) * (float)cc / 511.0f;
            float* dst = ((c < 512) ? HFp : HBp) + (size_t)(tb * 32 + rh * 16) * 512 + cc;
#pragma unroll
            for (int r = 0; r < 16; ++r) { const int n = tb * 32 + rh * 16 + r; const float tn = (float)n / (float)(L - 1); const float v = acc[r][q] * __expf(-tn * delta);
                dst[r * 512] = v;
                if (c < 512 || n >= 1) l1p[q] += fabsf(v); }
        }
    }
    red[c1] = l1p[0]; red[c2] = l1p[1];
    __syncthreads();
    L1P[(size_t)(f * 128 + tb) * 512 + F.tid] = red[F.tid] + red[512 + F.tid];
}
__device__ __forceinline__ void p0_prologue(Frame& F) {
    LAS float* scr = (LAS float*)(F.lds + F.wave * (64 * TRP * 4));
    const int gw = F.bx * NWAVES + F.wave, NGW = F.G * NWAVES, lane = F.lane;
    constexpr int I_WIN = 16 * 116, I_WBR = 8 * 16, I_WOUT = 16 * 16, I_W1 = 16 * 32, I_W2 = 16 * 16;
    constexpr int N_WIN = 2 * I_WIN, N_WBR = 6 * I_WBR, N_WOUT = 2 * I_WOUT, N_W1 = 32 * I_W1, N_W2 = 32 * I_W2;
    constexpr int NTR = N_WIN + N_WBR + N_WOUT + N_W1 + N_W2;
#pragma unroll 1
    for (int it = gw; it < NTR; it += NGW) {
        int r = it; const float* W; bf16* WT; int K, N, item, w1map = 0, ldk = 1024;
        if (r < N_WIN) { const int l = r / I_WIN; W = IN_(F, 7) + (size_t)l * 1024 * INC; K = 1024; N = INC; WT = WSP<bf16>(F, WS_WIN) + (size_t)l * INC * 1024; item = r % I_WIN; w1map = 2; }
        else if ((r -= N_WIN) < N_WBR) { const int q = r / I_WBR; W = IN_(F, 20) + (size_t)q * 512 * 1024; K = 512; N = 1024; WT = WSP<bf16>(F, WS_WBR) + (size_t)(q / 3) * 1024 * 1536 + (q % 3) * 512; ldk = 1536; item = r % I_WBR; }
        else if ((r -= N_WBR) < N_WOUT) { const int l = r / I_WOUT; W = IN_(F, 22) + (size_t)l * 1024 * 1024; K = 1024; N = 1024; WT = WSP<bf16>(F, WS_WOUT) + (size_t)l * 1024 * 1024; item = r % I_WOUT; }
        else if ((r -= N_WOUT) < N_W1) { const int q = r / I_W1; W = IN_(F, 26) + (size_t)q * 1024 * 2048; K = 1024; N = 2048; WT = WSP<bf16>(F, WS_W1) + (size_t)q * 2048 * 1024; item = r % I_W1; w1map = 1; }
        else { r -= N_W1; const int q = r / I_W2; W = IN_(F, 28) + (size_t)q * 1024 * 1024; K = 1024; N = 1024; WT = WSP<bf16>(F, WS_W2) + (size_t)q * 1024 * 1024; item = r % I_W2; }
        tr_item(W, K, N, WT, ldk, item, w1map, scr, lane);
    }
#ifndef PRO_B
#define PRO_B 1
#endif
#ifndef PRO_C
#define PRO_C 1
#endif
    __syncthreads();
    if (PRO_B) {
        float* mod = WSP<float>(F, WS_CTL + CTL_MOD);
        LAS float* sc = (LAS float*)F.lds;
        LAS float* red = sc + 1024 * 12;
        if (F.bx < 192) {
            for (int i = F.tid; i < 9 * 1024; i += NTHR) { const int r = i >> 10, k = i & 1023; const float cv = (r < 8) ? IN_(F, 1)[r * 1024 + k] : IN_(F, 3)[k]; sc[k * 12 + r] = siluf_(cv); }
            __syncthreads();
            const int it = F.bx, l = it / 96, cc = it % 96, col = cc * 64 + lane, k0 = F.wave * 128;
            const float* wm = IN_(F, 4) + (size_t)l * 1024 * 6144 + col;
            float acc[9];
#pragma unroll
            for (int r = 0; r < 9; ++r) acc[r] = 0.f;
#pragma unroll 1
            for (int kb = 0; kb < 128; kb += 16) {
                float w[16];
#pragma unroll
                for (int k = 0; k < 16; ++k) w[k] = wm[(size_t)(k0 + kb + k) * 6144];
#pragma unroll
                for (int k = 0; k < 16; ++k) { const LAS float* s = sc + (k0 + kb + k) * 12; const f32x4 s0 = *(const LAS f32x4*)s, s1 = *(const LAS f32x4*)(s + 4); const float s8 = s[8];
                    acc[0] += s0[0] * w[k]; acc[1] += s0[1] * w[k]; acc[2] += s0[2] * w[k]; acc[3] += s0[3] * w[k];
                    acc[4] += s1[0] * w[k]; acc[5] += s1[1] * w[k]; acc[6] += s1[2] * w[k]; acc[7] += s1[3] * w[k]; acc[8] += s8 * w[k]; }
            }
#pragma unroll
            for (int r = 0; r < 9; ++r) red[(F.wave * 9 + r) * 64 + lane] = acc[r];
            __syncthreads();
            for (int idx = F.tid; idx < 576; idx += NTHR) { const int r = idx >> 6, c = idx & 63; float s = 0.f;
#pragma unroll
                for (int w = 0; w < 8; ++w) s += red[(w * 9 + r) * 64 + c];
                mod[(size_t)(l * 9 + r) * 6144 + cc * 64 + c] = s + IN_(F, 5)[l * 6144 + cc * 64 + c]; }
        }
    }
    if (PRO_C) {
#pragma unroll 1
        for (int it = F.bx; it < 256; it += F.G) hy_filter_item(F, it >> 7, it & 127);
    }
}
constexpr int TRD_TOTAL = 32 * 512 + 32 * 256;
__device__ __forceinline__ void tr_deferred(Frame& F, int first, int count, int rank, int nblk) {
    LAS float* scr = (LAS float*)(F.lds + F.wave * (64 * TRP * 4));
    __syncthreads();
#pragma unroll 1
    for (int d = first + rank * NWAVES + F.wave; d < first + count; d += nblk * NWAVES) {
        if (d < 32 * 512) { const int q = 32 + (d >> 9); tr_item(IN_(F, 26) + (size_t)q * 1024 * 2048, 1024, 2048, WSP<bf16>(F, WS_W1) + (size_t)q * 2048 * 1024, 1024, d & 511, 1, scr, F.lane); }
        else { const int dd = d - 32 * 512, q = 32 + (dd >> 8); tr_item(IN_(F, 28) + (size_t)q * 1024 * 1024, 1024, 1024, WSP<bf16>(F, WS_W2) + (size_t)q * 1024 * 1024, 1024, dd & 255, 0, scr, F.lane); }
    }
}
__device__ __forceinline__ float hy_inv_l1(const Frame& F, int f, int c) {
    const float* L1P = WSP<float>(F, WS_L1P) + (size_t)f * 128 * 512 + c; const int nb = (f == 2) ? 8 : 128; const int lane = F.lane;
    float s = (lane < nb ? L1P[(size_t)lane * 512] : 0.f) + (lane + 64 < nb ? L1P[(size_t)(lane + 64) * 512] : 0.f);
    return 1.0f / wave_sum(s);
}

__device__ __forceinline__ void ph_norm1(Frame& F, int mode) {
    const int gw = F.bx * NWAVES + F.wave, NGW = F.G * NWAVES, lane = F.lane;
    const int nrows = (mode == 2) ? NLAT : NROWS;
    const int l = (mode == 0) ? 0 : 1;
    const bf16* Y = WSP<bf16>(F, WS_HS);
    const int* POS = WSP<int>(F, WS_POS); const float* TOPW = WSP<float>(F, WS_TOPW);
    f32x4 xnext[4]; int pnext[4]; float wnext[4];
#define N1_FETCH(r_) do { const int rf_ = (r_); \
        const float* xr_ = (mode == 0) ? ((rf_ < NLAT) ? IN_(F, 0) + (size_t)rf_ * DM : IN_(F, 2) + (size_t)(rf_ - NLAT) * DM) : (WSP<float>(F, WS_XM) + (size_t)rf_ * DM); \
        _Pragma("unroll") for (int j = 0; j < 4; ++j) xnext[j] = *(const f32x4*)(xr_ + 4 * lane + 256 * j); \
        if (mode != 0) { _Pragma("unroll") for (int k = 0; k < 4; ++k) { pnext[k] = POS[rf_ * 4 + k]; wnext[k] = TOPW[rf_ * 4 + k]; } } } while (0)
    if (gw < nrows) N1_FETCH(gw);
#pragma unroll 1
    for (int r = gw; r < nrows; r += NGW) {
        const int mr = modrow_of(r);
        f32x4 v[4];
        if (mode == 0) {
#pragma unroll
            for (int j = 0; j < 4; ++j) v[j] = xnext[j];
            if (r + NGW < nrows) N1_FETCH(r + NGW);
        } else {
            f32x4 xcur[4]; int pc[4]; float wc[4];
#pragma unroll
            for (int j = 0; j < 4; ++j) xcur[j] = xnext[j];
#pragma unroll
            for (int k = 0; k < 4; ++k) { pc[k] = pnext[k]; wc[k] = wnext[k]; }
            u32x2 yv[4][4];
#pragma unroll
            for (int k = 0; k < 4; ++k) { const bf16* yr = Y + (size_t)pc[k] * DM;
#pragma unroll
                for (int j = 0; j < 4; ++j) yv[k][j] = *(const u32x2*)(yr + 4 * lane + 256 * j); }
            if (r + NGW < nrows) N1_FETCH(r + NGW);
            f32x4 s[4];
#pragma unroll
            for (int j = 0; j < 4; ++j) s[j] = (f32x4){0.f, 0.f, 0.f, 0.f};
#pragma unroll
            for (int k = 0; k < 4; ++k) { const float w = wc[k];
#pragma unroll
                for (int j = 0; j < 4; ++j) { const u32x2 y2 = yv[k][j];
                    s[j][0] += w * __uint_as_float(y2.x << 16); s[j][1] += w * __uint_as_float(y2.x & 0xffff0000u);
                    s[j][2] += w * __uint_as_float(y2.y << 16); s[j][3] += w * __uint_as_float(y2.y & 0xffff0000u); } }
            const float* g2l = mod_ptr(F, (mode == 2) ? 1 : 0, mr, 5);
#pragma unroll
            for (int j = 0; j < 4; ++j) { const f32x4 g = *(const f32x4*)(g2l + 4 * lane + 256 * j); v[j] = xcur[j] + g * s[j]; }
            if (mode == 1) { float* xo = WSP<float>(F, WS_XO) + (size_t)r * DM;
#pragma unroll
                for (int j = 0; j < 4; ++j) *(f32x4*)(xo + 4 * lane + 256 * j) = v[j]; }
        }
        float ss = 0.f;
#pragma unroll
        for (int j = 0; j < 4; ++j) ss += (v[j][0] * v[j][0] + v[j][1] * v[j][1]) + (v[j][2] * v[j][2] + v[j][3] * v[j][3]);
        const float rstd = 1.0f / sqrtf(wave_sum(ss) * (1.0f / DM) + EPS);
        if (mode == 2) {
            const float* fg = IN_(F, 30); float* o = OUT_(F) + (size_t)r * DM;
#pragma unroll
            for (int j = 0; j < 4; ++j) { const f32x4 g = *(const f32x4*)(fg + 4 * lane + 256 * j); *(f32x4*)(o + 4 * lane + 256 * j) = v[j] * rstd * g; }
        } else {
            const float* gw_ = IN_(F, 6) + l * DM; const float* sh = mod_ptr(F, l, mr, 0); const float* sc = mod_ptr(F, l, mr, 1);
            bf16* o = WSP<bf16>(F, WS_XN) + (size_t)r * DM;
#pragma unroll
            for (int j = 0; j < 4; ++j) { const f32x4 g = *(const f32x4*)(gw_ + 4 * lane + 256 * j); const f32x4 a = *(const f32x4*)(sh + 4 * lane + 256 * j); const f32x4 b = *(const f32x4*)(sc + 4 * lane + 256 * j);
                const f32x4 y = v[j] * rstd * g * (b + 1.0f) + a;
                u32x2 w2; w2.x = pk2(y[0], y[1]); w2.y = pk2(y[2], y[3]); *(u32x2*)(o + 4 * lane + 256 * j) = w2; }
        }
    }
#undef N1_FETCH
}

struct EpiP {
    static constexpr bool PERM = true, AFTER_DRAIN = false, KMID = false; static constexpr int NSTORE = 16;
    bf16* O; const float* bg;
    __device__ __forceinline__ static void st8(bf16* p, const float (&v)[8]) { u32x4 w; w.x = pk2(v[0], v[1]); w.y = pk2(v[2], v[3]); w.z = pk2(v[4], v[5]); w.w = pk2(v[6], v[7]); *(u32x4*)p = w; }
    __device__ __forceinline__ void operator()(const f32x4 (&acc)[2][2][4][2], const pg8::Unit& u, int wr, int wc, int fr, int fq) const {
        const int row0 = u.pm * 256 + wr * 64 + fr, pn = u.pn;
        const bool rot = u.pm < (NLAT / 256);
        const bool is_ret = pn < 4, is_aq = (pn == 8 || pn == 9), is_akv = (pn == 10);
        if (!(is_ret || is_aq || is_akv) || (is_akv && wc >= 2)) {
            const int colA = is_akv ? (C_AV + (wc - 2) * 32 + 8 * fq) : (pn * 256 + wc * 32 + 8 * fq), colB = is_akv ? (colA + 64) : (colA + 128);
            f32x4 ba0 = (f32x4){0.f, 0.f, 0.f, 0.f}, ba1 = ba0, bb0 = ba0, bb1 = ba0;
            if (pn >= 17) { ba0 = *(const f32x4*)(bg + colA - C_MG); ba1 = *(const f32x4*)(bg + colA - C_MG + 4); bb0 = *(const f32x4*)(bg + colB - C_MG); bb1 = *(const f32x4*)(bg + colB - C_MG + 4); }
#pragma unroll
            for (int ai = 0; ai < 2; ++ai)
#pragma unroll
                for (int m = 0; m < 4; ++m) { bf16* rowp = O + (size_t)(row0 + ai * 128 + m * 16) * INC;
                    float a[8], b[8];
#pragma unroll
                    for (int j = 0; j < 4; ++j) { a[j] = acc[ai][0][m][0][j] + ba0[j]; a[4 + j] = acc[ai][0][m][1][j] + ba1[j]; b[j] = acc[ai][1][m][0][j] + bb0[j]; b[4 + j] = acc[ai][1][m][1][j] + bb1[j]; }
                    if (pn >= 17) {
                        typedef float f32x2 __attribute__((ext_vector_type(2)));
#pragma unroll
                        for (int j = 0; j < 8; j += 2) { f32x2 za = {a[j], a[j + 1]}, zb = {b[j], b[j + 1]}; za = za * -1.4426950408889634f; zb = zb * -1.4426950408889634f;
                            za.x = __builtin_amdgcn_exp2f(za.x); za.y = __builtin_amdgcn_exp2f(za.y); zb.x = __builtin_amdgcn_exp2f(zb.x); zb.y = __builtin_amdgcn_exp2f(zb.y);
                            za = za + 1.0f; zb = zb + 1.0f;
                            a[j] = fminf(za.x, 1.0e30f); a[j + 1] = fminf(za.y, 1.0e30f); b[j] = fminf(zb.x, 1.0e30f); b[j + 1] = fminf(zb.y, 1.0e30f); } }
                    st8(rowp + colA, a); st8(rowp + colB, b); asm volatile("" ::: "memory"); }
            return;
        }
        int col1, col2, ibase; float fexp; bool use_col = false;
        if (is_ret) { const int hd = wc >> 1; ibase = (wc & 1) * 32 + 8 * fq; col1 = pn * 256 + hd * 128 + ibase; col2 = col1 + 64; fexp = 13.287712379549449f / 63.0f; }
        else { const int rc = fq >> 1; ibase = 8 * (fq & 1); const int hb = is_aq ? (pn * 256 + wc * 64) : (C_AK + wc * 64); col1 = hb + rc * 32 + ibase; col2 = col1 + 16; fexp = 13.287712379549449f / 16.0f; use_col = rc != 0; }
        float invf[8];
#pragma unroll
        for (int k = 0; k < 8; ++k) invf[k] = __builtin_amdgcn_exp2f(-(float)(ibase + k) * fexp) * 0.15915494309189535f;
#pragma unroll
        for (int ai = 0; ai < 2; ++ai)
#pragma unroll
            for (int m = 0; m < 4; ++m) { const int row = row0 + ai * 128 + m * 16; bf16* rowp = O + (size_t)row * INC;
                const int t = row & 4095;
                const float pos = is_ret ? (float)t : (use_col ? (float)(t & 63) : (float)(t >> 6));
                float o1[8], o2[8];
#pragma unroll
                for (int k = 0; k < 8; ++k) { const float x1 = acc[ai][0][m][k >> 2][k & 3], x2 = acc[ai][1][m][k >> 2][k & 3];
                    float cs = 1.0f, sn = 0.0f;
                    if (rot) { const float rev = pos * invf[k]; cs = cos_rev(rev); sn = sin_rev(rev); }
                    o1[k] = x1 * cs - x2 * sn; o2[k] = x1 * sn + x2 * cs; }
                st8(rowp + col1, o1); st8(rowp + col2, o2); asm volatile("" ::: "memory"); }
    }
};
struct EpiMerge {
    static constexpr bool PERM = true, AFTER_DRAIN = false, KMID = true; static constexpr int NSTORE = 16;
    const bf16* P; bf16* Mo;
    typedef float f32x2 __attribute__((ext_vector_type(2)));
    __device__ __forceinline__ static f32x2 g2(unsigned w) { f32x2 r; r.x = __uint_as_float(w << 16); r.y = __uint_as_float(w & 0xffff0000u); return r; }
    struct Batch { u32x4 gn[2][2], go[2][2]; };
    __device__ __forceinline__ void fetch(Batch& B, int row0, unsigned col0, unsigned g_old, int ai, int mh) const {
#pragma unroll
        for (int mm = 0; mm < 2; ++mm) { const unsigned rowb = (unsigned)(row0 + ai * 128 + (2 * mh + mm) * 16) * (unsigned)(INC * 2);
#pragma unroll
            for (int bj = 0; bj < 2; ++bj) { const unsigned c = col0 + bj * 128;
                B.gn[mm][bj] = *(const u32x4*)((const char*)P + rowb + (C_MG + (g_old + 1) * 1024 + c) * 2); B.go[mm][bj] = *(const u32x4*)((const char*)P + rowb + (C_MG + g_old * 1024 + c) * 2); } }
    }
    __device__ __forceinline__ static void apply(const Batch& B, f32x4 (&acc)[2][2][4][2], int ai, int mh) {
#pragma unroll
        for (int mm = 0; mm < 2; ++mm)
#pragma unroll
            for (int bj = 0; bj < 2; ++bj) { const unsigned gnw[4] = {B.gn[mm][bj].x, B.gn[mm][bj].y, B.gn[mm][bj].z, B.gn[mm][bj].w}, gow[4] = {B.go[mm][bj].x, B.go[mm][bj].y, B.go[mm][bj].z, B.go[mm][bj].w};
#pragma unroll
                for (int i = 0; i < 4; ++i) { const f32x2 dold = g2(gow[i]); f32x2 ro; ro.x = __builtin_amdgcn_rcpf(dold.x); ro.y = __builtin_amdgcn_rcpf(dold.y);
                    const f32x2 r = g2(gnw[i]) * ro;
                    f32x4& A = acc[ai][bj][2 * mh + mm][i >> 1];
                    if (i & 1) { A.z *= r.x; A.w *= r.y; } else { A.x *= r.x; A.y *= r.y; } } }
    }
    __device__ __forceinline__ void kmid(int t, f32x4 (&acc)[2][2][4][2], const pg8::Unit& u, int wr, int wc, int fr, int fq) const {
        int row0 = u.pm * 256 + wr * 64 + fr; asm volatile("" : "+v"(row0));
        const unsigned col0 = (unsigned)(u.pn * 256 + wc * 32 + 8 * fq), g_old = (t == 8) ? 0u : 1u;
        Batch B0, B1;
        fetch(B0, row0, col0, g_old, 0, 0);
        fetch(B1, row0, col0, g_old, 0, 1); asm volatile("" ::: "memory");
        apply(B0, acc, 0, 0);
        fetch(B0, row0, col0, g_old, 1, 0); asm volatile("" ::: "memory");
        apply(B1, acc, 0, 1);
        fetch(B1, row0, col0, g_old, 1, 1); asm volatile("" ::: "memory");
        apply(B0, acc, 1, 0);
        apply(B1, acc, 1, 1);
    }
    __device__ __forceinline__ void operator()(const f32x4 (&acc)[2][2][4][2], const pg8::Unit& u, int wr, int wc, int fr, int fq) const {
        int row0 = u.pm * 256 + wr * 64 + fr; asm volatile("" : "+v"(row0));
        const unsigned col0 = (unsigned)(u.pn * 256 + wc * 32 + 8 * fq);
        u32x4 gh[2][4][2];
#pragma unroll
        for (int ai = 0; ai < 2; ++ai)
#pragma unroll
            for (int m = 0; m < 4; ++m) { const unsigned rowb = (unsigned)(row0 + ai * 128 + m * 16) * (unsigned)(INC * 2);
#pragma unroll
                for (int bj = 0; bj < 2; ++bj) gh[ai][m][bj] = *(const u32x4*)((const char*)P + rowb + (C_MG + 2048 + col0 + bj * 128) * 2); }
#pragma unroll
        for (int ai = 0; ai < 2; ++ai) {
#pragma unroll
            for (int m = 0; m < 4; ++m) { const unsigned row = (unsigned)(row0 + ai * 128 + m * 16);
#pragma unroll
                for (int bj = 0; bj < 2; ++bj) { float v[8]; const unsigned ghw[4] = {gh[ai][m][bj].x, gh[ai][m][bj].y, gh[ai][m][bj].z, gh[ai][m][bj].w};
#pragma unroll
                    for (int i = 0; i < 4; ++i) { const f32x2 d = g2(ghw[i]); v[2 * i] = acc[ai][bj][m][i >> 1][2 * (i & 1)] * __builtin_amdgcn_rcpf(d.x); v[2 * i + 1] = acc[ai][bj][m][i >> 1][2 * (i & 1) + 1] * __builtin_amdgcn_rcpf(d.y); }
                    u32x4 w; w.x = pk2(v[0], v[1]); w.y = pk2(v[2], v[3]); w.z = pk2(v[4], v[5]); w.w = pk2(v[6], v[7]);
                    *(u32x4*)((char*)Mo + (row * (unsigned)(DM * 2) + (col0 + bj * 128) * 2)) = w; } }
            asm volatile("" ::: "memory"); }
    }
};
struct EpiOut {
    static constexpr bool PERM = false, AFTER_DRAIN = false, KMID = false; static constexpr int NSTORE = 32;
    const float* xlat; const float* xctx; const float* g1base; float* XM;
    __device__ __forceinline__ void operator()(const f32x4 (&acc)[2][2][4][2], const pg8::Unit& u, int wr, int wc, int fr, int fq) const {
        int row0 = u.pm * 256 + wr * 64 + fr; asm volatile("" : "+v"(row0));
        const int col0 = u.pn * 256 + wc * 32 + 4 * fq;
        const bool lat = u.pm < (NLAT / 256);
        const float* xb = lat ? xlat : xctx - (size_t)NLAT * DM;
        const float* g1 = g1base + (size_t)modrow_of(u.pm * 256) * 6 * DM + col0;
        f32x4 gv[2][2];
#pragma unroll
        for (int bj = 0; bj < 2; ++bj)
#pragma unroll
            for (int n = 0; n < 2; ++n) gv[bj][n] = *(const f32x4*)(g1 + bj * 128 + n * 16);
#pragma unroll
        for (int ai = 0; ai < 2; ++ai) {
            f32x4 xv[4][2][2];
#pragma unroll
            for (int m = 0; m < 4; ++m) { const float* xr = xb + (size_t)(row0 + ai * 128 + m * 16) * DM + col0;
#pragma unroll
                for (int bj = 0; bj < 2; ++bj)
#pragma unroll
                    for (int n = 0; n < 2; ++n) xv[m][bj][n] = *(const f32x4*)(xr + bj * 128 + n * 16); }
#pragma unroll
            for (int m = 0; m < 4; ++m) { float* xo = XM + (size_t)(row0 + ai * 128 + m * 16) * DM + col0;
#pragma unroll
                for (int bj = 0; bj < 2; ++bj)
#pragma unroll
                    for (int n = 0; n < 2; ++n) *(f32x4*)(xo + bj * 128 + n * 16) = xv[m][bj][n] + gv[bj][n] * acc[ai][bj][m][n]; }
            asm volatile("" ::: "memory"); }
    }
};
struct EpiMoe1 {
    static constexpr bool PERM = true, AFTER_DRAIN = false, KMID = false; static constexpr int NSTORE = 8;
    const float* b1; bf16* ACT;
    __device__ __forceinline__ void operator()(const f32x4 (&acc)[2][2][4][2], const pg8::Unit& u, int wr, int wc, int fr, int fq) const {
        const int e = u.pn >> 3, p = u.pn & 7;
        const int row0 = u.pm * 256 + wr * 64 + fr, gcol0 = p * 128 + wc * 32 + 8 * fq;
        const float* bb = b1 + (size_t)e * 2048 + gcol0;
        typedef float f32x2 __attribute__((ext_vector_type(2)));
        const f32x4 bgv[2] = {*(const f32x4*)(bb), *(const f32x4*)(bb + 4)};
        const f32x4 blv[2] = {*(const f32x4*)(bb + 1024) + 1.0f, *(const f32x4*)(bb + 1028) + 1.0f};
#pragma unroll
        for (int ai = 0; ai < 2; ++ai)
#pragma unroll
            for (int m = 0; m < 4; ++m) { bf16* rowp = ACT + (size_t)(row0 + ai * 128 + m * 16) * DFF + gcol0;
                unsigned w[4];
#pragma unroll
                for (int n = 0; n < 2; ++n)
#pragma unroll
                    for (int hp = 0; hp < 2; ++hp) {
                        const f32x2 av = hp ? acc[ai][0][m][n].hi : acc[ai][0][m][n].lo, lv = hp ? acc[ai][1][m][n].hi : acc[ai][1][m][n].lo;
                        const f32x2 bg = hp ? bgv[n].hi : bgv[n].lo, bl = hp ? blv[n].hi : blv[n].lo;
                        f32x2 glu = av + bg, lin = lv + bl;
                        glu.x = fminf(glu.x, 7.0f); glu.y = fminf(glu.y, 7.0f);
                        lin.x = __builtin_amdgcn_fmed3f(lin.x, -6.0f, 8.0f); lin.y = __builtin_amdgcn_fmed3f(lin.y, -6.0f, 8.0f);
                        f32x2 ex = glu * -2.4554669595930156f;
                        ex.x = __builtin_amdgcn_exp2f(ex.x); ex.y = __builtin_amdgcn_exp2f(ex.y);
                        ex = ex + 1.0f;
                        ex.x = __builtin_amdgcn_rcpf(ex.x); ex.y = __builtin_amdgcn_rcpf(ex.y);
                        const f32x2 a = (glu * ex) * lin;
                        w[2 * n + hp] = pk2(a.x, a.y); }
                u32x4 wv; wv.x = w[0]; wv.y = w[1]; wv.z = w[2]; wv.w = w[3];
                *(u32x4*)rowp = wv;
                asm volatile("" ::: "memory"); }
    }
};
struct EpiMoe2 {
    static constexpr bool PERM = true, AFTER_DRAIN = false, KMID = false; static constexpr int NSTORE = 16;
    const float* b2; bf16* Y;
    __device__ __forceinline__ void operator()(const f32x4 (&acc)[2][2][4][2], const pg8::Unit& u, int wr, int wc, int fr, int fq) const {
        const int e = u.pn >> 2, p = u.pn & 3;
        const int row0 = u.pm * 256 + wr * 64 + fr, col0 = p * 256 + wc * 32 + 8 * fq;
        f32x4 bv[2][2];
#pragma unroll
        for (int bj = 0; bj < 2; ++bj)
#pragma unroll
            for (int n = 0; n < 2; ++n) bv[bj][n] = *(const f32x4*)(b2 + (size_t)e * 1024 + col0 + bj * 128 + 4 * n);
#pragma unroll
        for (int ai = 0; ai < 2; ++ai)
#pragma unroll
            for (int m = 0; m < 4; ++m) { bf16* rowp = Y + (size_t)(row0 + ai * 128 + m * 16) * DM + col0;
#pragma unroll
                for (int bj = 0; bj < 2; ++bj) { const f32x4 v0 = acc[ai][bj][m][0] + bv[bj][0], v1 = acc[ai][bj][m][1] + bv[bj][1];
                    u32x4 w; w.x = pk2(v0[0], v0[1]); w.y = pk2(v0[2], v0[3]); w.z = pk2(v1[0], v1[1]); w.w = pk2(v1[2], v1[3]);
                    *(u32x4*)(rowp + bj * 128) = w; } }
    }
};
struct MoeOrder {
    static constexpr bool GATHER = false; const LAS int* src;
    const LAS int* list; int n;
    __device__ __forceinline__ bool next(int i, pg8::Unit& u) const { if (i >= n) return false; u.pm = __builtin_amdgcn_readfirstlane(list[2 * i]); u.pn = __builtin_amdgcn_readfirstlane(list[2 * i + 1]); return true; }
    __device__ __forceinline__ void a_ready(const pg8::Unit&) const {}
    __device__ __forceinline__ void done(const pg8::Unit&) const {}
};
struct MoeOrderG {
    static constexpr bool GATHER = true; const LAS int* src;
    const LAS int* list; int n;
    __device__ __forceinline__ bool next(int i, pg8::Unit& u) const { if (i >= n) return false; u.pm = __builtin_amdgcn_readfirstlane(list[2 * i]); u.pn = __builtin_amdgcn_readfirstlane(list[2 * i + 1]); return true; }
    __device__ __forceinline__ void a_ready(const pg8::Unit&) const {}
    __device__ __forceinline__ void done(const pg8::Unit&) const {}
};
__device__ __forceinline__ int moe_list_units(Frame& F, int nN, LAS int* list) {
    const int* tl = WSP<int>(F, WS_TILES);
    const int T = __builtin_amdgcn_readfirstlane(tl[32]);
    const int tlv = tl[F.lane & 31];
    pg8::StaticOrder SO; SO.init(T * 256, nN * 256, F.G, F.bx);
    int n = 0;
#pragma unroll 1
    for (int i = 0;; ++i) {
        pg8::Unit u; if (!SO.next(i, u)) break;
        const int pm = u.pm, pnl = u.pn;
        const int e = __popcll(__ballot(F.lane < 32 && tlv <= pm)) - 1;
        if (F.tid == 0) { list[2 * i] = pm; list[2 * i + 1] = e * nN + pnl; }
        n = i + 1;
    }
    __syncthreads();
    return n;
}


typedef short bf16x8 __attribute__((ext_vector_type(8)));
typedef short bf16x4 __attribute__((ext_vector_type(4)));
constexpr int RLD = 136;
constexpr int RTILE = 128 * RLD * 2;
__device__ __forceinline__ bf16x8 lds_frag16(const LAS bf16* tile, int row0, int k0, int lane) {
    return *(const LAS bf16x8*)(tile + (row0 + (lane & 15)) * RLD + k0 + 8 * (lane >> 4));
}
__device__ __forceinline__ bf16x8 lds_frag16s(const LAS bf16* tile, int row0, int k0, int lane) {
    return *(const LAS bf16x8*)(tile + (row0 + (lane & 15)) * RLD + ((k0 + 8 * (lane >> 4)) ^ ((row0 >> 5) << 4)));
}
__device__ __forceinline__ void lds_frag16x4s(bf16x8 (&f)[4], const LAS bf16* tile, int row0, int lane) {
#pragma unroll
    for (int ks = 0; ks < 4; ++ks) f[ks] = lds_frag16s(tile, row0, 32 * ks, lane);
}
__device__ __forceinline__ void lds_frag16x4(bf16x8 (&f)[4], const LAS bf16* tile, int row0, int lane) {
#pragma unroll
    for (int ks = 0; ks < 4; ++ks) f[ks] = lds_frag16(tile, row0, 32 * ks, lane);
}
__device__ __forceinline__ void ret_unit_decode(int u, int& bh, int& ci, int& rowbase) {
    bh = u / 34; ci = u - bh * 34; const int b = bh >> 2;
    rowbase = (ci < 2) ? (NLAT + b * CTXL + ci * 128) : (b * SEQ + (ci - 2) * 128);
}
__device__ __forceinline__ void ret_load_tile(LAS bf16* tile, const bf16* g, size_t gp, int tid) {
    const int r = tid >> 2, seg = tid & 3;
#pragma unroll
    for (int q = 0; q < 4; ++q) *(LAS u32x4*)(tile + r * RLD + seg * 32 + q * 8) = *(const u32x4*)(g + (size_t)r * gp + seg * 32 + q * 8);
}
__device__ __forceinline__ void ret_kv_unit(Frame& F, int l, int u) {
    const bf16* P = WSP<bf16>(F, WS_P);
    LAS bf16* Ktf = (LAS bf16*)F.lds; LAS bf16* Ktb = Ktf + 128 * RLD; LAS bf16* Vt = Ktb + 128 * RLD;
    int bh, ci, rowbase; ret_unit_decode(u, bh, ci, rowbase);
    const int h = bh & 3, tid = F.tid, lane = F.lane, w = F.wave;
    const float LOG2E = 1.4426950408889634f;
    const float lgf = log_sigmoid_(IN_(F, 8)[l * 8 + h]) * LOG2E, lgb = log_sigmoid_(IN_(F, 8)[l * 8 + 4 + h]) * LOG2E;
    __syncthreads();
    { const int j = tid >> 2, seg = tid & 3;
      const float wf = __builtin_amdgcn_exp2f(lgf * (float)(127 - j)), wb = __builtin_amdgcn_exp2f(lgb * (float)j);
      const bf16* kp = P + (size_t)(rowbase + j) * INC + C_RK + h * 128 + seg * 32; const bf16* vp = P + (size_t)(rowbase + j) * INC + C_RV + h * 128 + seg * 32;
      u32x4 kkv[4], vvv[4];
#pragma unroll
      for (int q = 0; q < 4; ++q) { kkv[q] = *(const u32x4*)(kp + q * 8); vvv[q] = *(const u32x4*)(vp + q * 8); }
      __builtin_amdgcn_sched_barrier(0);
#pragma unroll
      for (int q = 0; q < 4; ++q) { const u32x4 kk = kkv[q], vv = vvv[q];
          const unsigned kw[4] = {kk.x, kk.y, kk.z, kk.w}, vw[4] = {vv.x, vv.y, vv.z, vv.w};
#pragma unroll
          for (int i = 0; i < 4; ++i) { const int d = seg * 32 + q * 8 + 2 * i;
              const float k0 = __uint_as_float(kw[i] << 16), k1 = __uint_as_float(kw[i] & 0xffff0000u);
              const int js = j ^ (seg << 4);
              Ktf[d * RLD + js] = f2bf(k0 * wf); Ktf[(d + 1) * RLD + js] = f2bf(k1 * wf);
              Ktb[d * RLD + js] = f2bf(k0 * wb); Ktb[(d + 1) * RLD + js] = f2bf(k1 * wb);
              Vt[d * RLD + js] = (bf16)(vw[i] & 0xffffu); Vt[(d + 1) * RLD + js] = (bf16)(vw[i] >> 16); } } }
    __syncthreads();
    bf16x8 af[4], ab[4];
#pragma unroll
    for (int ks = 0; ks < 4; ++ks) { af[ks] = lds_frag16s(Ktf, 16 * w, 32 * ks, lane); ab[ks] = lds_frag16s(Ktb, 16 * w, 32 * ks, lane); }
    float* KV = WSP<float>(F, WS_KV) + ((size_t)(bh * 34 + ci) * 2) * 16384;
    const int d0 = 16 * w + 4 * (lane >> 4);
    bf16x8 vf[2][4];
    lds_frag16x4s(vf[0], Vt, 0, lane);
#pragma unroll
    for (int et = 0; et < 8; ++et) {
        if (et + 1 < 8) lds_frag16x4s(vf[(et + 1) & 1], Vt, 16 * (et + 1), lane);
        __builtin_amdgcn_sched_barrier(0);
        f32x4 cf = (f32x4){0.f, 0.f, 0.f, 0.f}, cb = cf;
#pragma unroll
        for (int ks = 0; ks < 4; ++ks) { cf = __builtin_amdgcn_mfma_f32_16x16x32_bf16(af[ks], vf[et & 1][ks], cf, 0, 0, 0); cb = __builtin_amdgcn_mfma_f32_16x16x32_bf16(ab[ks], vf[et & 1][ks], cb, 0, 0, 0); }
        const int e = 16 * et + (lane & 15);
        *(f32x4*)(KV + (size_t)e * 128 + d0) = cf; *(f32x4*)(KV + 16384 + (size_t)e * 128 + d0) = cb;
    }
}
__device__ __forceinline__ void ret_scan(Frame& F, int l) {
    const float* KV = WSP<float>(F, WS_KV); bf16* SP = WSP<bf16>(F, WS_SP);
    const float LOG2E = 1.4426950408889634f;
    const int total = 64 * 4096, stride = F.G * NTHR;
#pragma unroll 1
    for (int idx = F.bx * NTHR + F.tid; idx < total; idx += stride) {
        const int bhd = idx >> 12, elem = (idx & 4095) * 4, bh = bhd >> 1, dir = bhd & 1, h = bh & 3;
        const float cd = __builtin_amdgcn_exp2f(log_sigmoid_(IN_(F, 8)[l * 8 + dir * 4 + h]) * LOG2E * 128.0f);
        const size_t base = ((size_t)bh * 34 * 2 + dir) * 16384 + elem;
        f32x4 s = (f32x4){0.f, 0.f, 0.f, 0.f};
#pragma unroll 1
        for (int half = 0; half < 2; ++half) {
            f32x4 kv[17];
#pragma unroll
            for (int k = 0; k < 17; ++k) { const int st = half * 17 + k; const int ci = dir == 0 ? st : (st == 0 ? 1 : (st == 1 ? 0 : 35 - st)); kv[k] = *(const f32x4*)(KV + base + (size_t)ci * 2 * 16384); }
#pragma unroll
            for (int k = 0; k < 17; ++k) { const int st = half * 17 + k; const int ci = dir == 0 ? st : (st == 0 ? 1 : (st == 1 ? 0 : 35 - st));
                u32x2 o; o.x = pk2(s[0], s[1]); o.y = pk2(s[2], s[3]); *(u32x2*)(SP + base + (size_t)ci * 2 * 16384) = o;
                s = s * cd + kv[k]; }
        }
    }
}
__device__ __forceinline__ void ret_out_unit(Frame& F, int l, int u) {
    const bf16* P = WSP<bf16>(F, WS_P);
    LAS bf16* Qs = (LAS bf16*)F.lds; LAS bf16* Ks = Qs + 128 * RLD; LAS bf16* Vt = Ks + 128 * RLD; LAS bf16* Ps = Vt + 128 * RLD;
    int bh, ci, rowbase; ret_unit_decode(u, bh, ci, rowbase);
    const int h = bh & 3, tid = F.tid, lane = F.lane, w = F.wave;
    const float LOG2E = 1.4426950408889634f;
    const float lgf = log_sigmoid_(IN_(F, 8)[l * 8 + h]) * LOG2E, lgb = log_sigmoid_(IN_(F, 8)[l * 8 + 4 + h]) * LOG2E;
    __syncthreads();
    ret_load_tile(Qs, P + (size_t)rowbase * INC + C_RQ + h * 128, INC, tid);
    ret_load_tile(Ks, P + (size_t)rowbase * INC + C_RK + h * 128, INC, tid);
    { const int j = tid >> 2, seg = tid & 3; const bf16* vp = P + (size_t)(rowbase + j) * INC + C_RV + h * 128 + seg * 32;
#pragma unroll
      for (int q = 0; q < 4; ++q) { const u32x4 vv = *(const u32x4*)(vp + q * 8); const unsigned vw[4] = {vv.x, vv.y, vv.z, vv.w};
#pragma unroll
          for (int i = 0; i < 4; ++i) { const int d = seg * 32 + q * 8 + 2 * i, js = j ^ (seg << 4); Vt[d * RLD + js] = (bf16)(vw[i] & 0xffffu); Vt[(d + 1) * RLD + js] = (bf16)(vw[i] >> 16); } } }
    u32x4 spre[2][4];
    { const bf16* SPg = WSP<bf16>(F, WS_SP) + ((size_t)(bh * 34 + ci) * 2) * 16384; const int rr = tid >> 2, seg = tid & 3;
#pragma unroll
      for (int dir = 0; dir < 2; ++dir) { const bool zero = (dir == 0) ? (ci == 0) : (ci == 1);
#pragma unroll
          for (int q = 0; q < 4; ++q) spre[dir][q] = zero ? (u32x4){0u, 0u, 0u, 0u} : *(const u32x4*)(SPg + (size_t)dir * 16384 + (size_t)rr * 128 + seg * 32 + q * 8); } }
    __syncthreads();
    const int icol = 16 * w + (lane & 15);
    bf16x8 bq[4];
#pragma unroll
    for (int ks = 0; ks < 4; ++ks) bq[ks] = lds_frag16(Qs, 16 * w, 32 * ks, lane);
    bf16x8 tf[2][4];
    lds_frag16x4(tf[0], Ks, 0, lane);
#pragma unroll
    for (int jt = 0; jt < 8; ++jt) {
        if (jt + 1 < 8) lds_frag16x4(tf[(jt + 1) & 1], Ks, 16 * (jt + 1), lane);
        __builtin_amdgcn_sched_barrier(0);
        f32x4 c = (f32x4){0.f, 0.f, 0.f, 0.f};
#pragma unroll
        for (int ks = 0; ks < 4; ++ks) c = __builtin_amdgcn_mfma_f32_16x16x32_bf16(tf[jt & 1][ks], bq[ks], c, 0, 0, 0);
        const int j0 = 16 * jt + 4 * (lane >> 4);
        float pv[4];
#pragma unroll
        for (int r = 0; r < 4; ++r) { const int dd = icol - (j0 + r); const float dec = dd >= 0 ? __builtin_amdgcn_exp2f(lgf * (float)dd) : __builtin_amdgcn_exp2f(lgb * (float)(-dd)); pv[r] = c[r] * dec; }
        u32x2 pw; pw.x = pk2(pv[0], pv[1]); pw.y = pk2(pv[2], pv[3]);
        *(LAS u32x2*)(Ps + icol * RLD + j0) = pw;
    }
    LDS_WAIT(); asm volatile("" ::: "memory");
    f32x4 acc[8];
    {
        bf16x8 bp[4];
#pragma unroll
        for (int ks = 0; ks < 4; ++ks) bp[ks] = lds_frag16(Ps, 16 * w, 32 * ks, lane);
        lds_frag16x4s(tf[0], Vt, 0, lane);
#pragma unroll
        for (int et = 0; et < 8; ++et) {
            if (et + 1 < 8) lds_frag16x4s(tf[(et + 1) & 1], Vt, 16 * (et + 1), lane);
            __builtin_amdgcn_sched_barrier(0);
            f32x4 c = (f32x4){0.f, 0.f, 0.f, 0.f};
#pragma unroll
            for (int ks = 0; ks < 4; ++ks) c = __builtin_amdgcn_mfma_f32_16x16x32_bf16(tf[et & 1][ks], bp[ks], c, 0, 0, 0);
            acc[et] = c; }
    }
#pragma unroll
    for (int dir = 0; dir < 2; ++dir) {
        const bool zero = (dir == 0) ? (ci == 0) : (ci == 1);
        __syncthreads();
        if (!zero) { const int rr = tid >> 2, seg = tid & 3;
#pragma unroll
            for (int q = 0; q < 4; ++q) *(LAS u32x4*)(Ks + rr * RLD + seg * 32 + q * 8) = spre[dir][q]; }
        __syncthreads();
        if (!zero) {
            const float sc = (dir == 0) ? __builtin_amdgcn_exp2f(lgf * (float)((icol & 127) + 1)) : __builtin_amdgcn_exp2f(lgb * (float)(128 - (icol & 127)));
            lds_frag16x4(tf[0], Ks, 0, lane);
#pragma unroll
            for (int et = 0; et < 8; ++et) {
                if (et + 1 < 8) lds_frag16x4(tf[(et + 1) & 1], Ks, 16 * (et + 1), lane);
                __builtin_amdgcn_sched_barrier(0);
                f32x4 c = (f32x4){0.f, 0.f, 0.f, 0.f};
#pragma unroll
                for (int ks = 0; ks < 4; ++ks) c = __builtin_amdgcn_mfma_f32_16x16x32_bf16(tf[et & 1][ks], bq[ks], c, 0, 0, 0);
                acc[et] = acc[et] + c * sc; }
        }
    }
    const float ksc = 0.08838834764831845f;
    float ss = 0.f;
#pragma unroll
    for (int et = 0; et < 8; ++et) { acc[et] = acc[et] * ksc; ss += (acc[et][0] * acc[et][0] + acc[et][1] * acc[et][1]) + (acc[et][2] * acc[et][2] + acc[et][3] * acc[et][3]); }
    ss += __shfl_xor(ss, 16); ss += __shfl_xor(ss, 32);
    const float rs = 1.0f / sqrtf(ss * (1.0f / 128.0f) + EPS);
    const size_t row = (size_t)(rowbase + icol);
    const bf16* gp = P + row * INC + C_RG + h * 128; bf16* op = WSP<bf16>(F, WS_RET) + row * 1536 + h * 128;
#pragma unroll
    for (int et = 0; et < 8; ++et) { const int e0 = 16 * et + 4 * (lane >> 4);
        const u32x2 g2 = *(const u32x2*)(gp + e0);
        const float g0 = __uint_as_float(g2.x << 16), g1 = __uint_as_float(g2.x & 0xffff0000u), g2f = __uint_as_float(g2.y << 16), g3 = __uint_as_float(g2.y & 0xffff0000u);
        u32x2 o; o.x = pk2(acc[et][0] * rs * siluf_(g0), acc[et][1] * rs * siluf_(g1)); o.y = pk2(acc[et][2] * rs * siluf_(g2f), acc[et][3] * rs * siluf_(g3));
        *(u32x2*)(op + e0) = o; }
}

typedef float f32x2 __attribute__((ext_vector_type(2)));
__device__ __forceinline__ f32x2 cmul_(f32x2 a, f32x2 b) { return (f32x2){a.x * b.x - a.y * b.y, a.x * b.y + a.y * b.x}; }
__device__ __forceinline__ f32x2 cmulc_(f32x2 a, f32x2 b) { return (f32x2){a.x * b.x + a.y * b.y, a.y * b.x - a.x * b.y}; }
__device__ __forceinline__ f32x2 twid_(float rev) { return (f32x2){cos_rev(rev), -sin_rev(rev)}; }
__device__ __forceinline__ int fpad(int n) { return n + (n >> 3); }
template <int R> __device__ __forceinline__ void fft_twiddles(f32x2 (&tw)[R - 1], int t, int s, int M) {
    int o = 0, u = 0;
#pragma unroll
    for (int half = R / 2; half >= 1; half >>= 1) {
        const float invMu = 1.0f / (float)(M >> u);
#pragma unroll
        for (int qq = 0; qq < half; ++qq) tw[o + qq] = twid_((float)(t + qq * s) * invMu);
        o += half; ++u;
    }
}
template <int R, int HALF, int OFF> __device__ __forceinline__ void fft_sub_fwd(f32x2 (&v)[R], const f32x2 (&tw)[R - 1]) {
#pragma unroll
    for (int qq = 0; qq < HALF; ++qq) {
        const f32x2 w = tw[OFF + qq];
#pragma unroll
        for (int g0 = 0; g0 < R; g0 += 2 * HALF) { const f32x2 a = v[g0 + qq], b = v[g0 + qq + HALF]; v[g0 + qq] = a + b; v[g0 + qq + HALF] = cmul_(a - b, w); }
    }
}
template <int R, int HALF, int OFF> __device__ __forceinline__ void fft_sub_inv(f32x2 (&v)[R], const f32x2 (&tw)[R - 1]) {
#pragma unroll
    for (int qq = 0; qq < HALF; ++qq) {
        const f32x2 w = tw[OFF + qq];
#pragma unroll
        for (int g0 = 0; g0 < R; g0 += 2 * HALF) { const f32x2 A = v[g0 + qq], Bp = cmulc_(v[g0 + qq + HALF], w); v[g0 + qq] = A + Bp; v[g0 + qq + HALF] = A - Bp; }
    }
}
template <int R> __device__ __forceinline__ void fft_bf_fwd(f32x2 (&v)[R], const f32x2 (&tw)[R - 1]) {
    if constexpr (R == 16) { fft_sub_fwd<16, 8, 0>(v, tw); fft_sub_fwd<16, 4, 8>(v, tw); fft_sub_fwd<16, 2, 12>(v, tw); fft_sub_fwd<16, 1, 14>(v, tw); }
    else { fft_sub_fwd<8, 4, 0>(v, tw); fft_sub_fwd<8, 2, 4>(v, tw); fft_sub_fwd<8, 1, 6>(v, tw); }
}
template <int R> __device__ __forceinline__ void fft_bf_inv(f32x2 (&v)[R], const f32x2 (&tw)[R - 1]) {
    if constexpr (R == 16) { fft_sub_inv<16, 1, 14>(v, tw); fft_sub_inv<16, 2, 12>(v, tw); fft_sub_inv<16, 4, 8>(v, tw); fft_sub_inv<16, 8, 0>(v, tw); }
    else { fft_sub_inv<8, 1, 6>(v, tw); fft_sub_inv<8, 2, 4>(v, tw); fft_sub_inv<8, 4, 0>(v, tw); }
}
__device__ __forceinline__ void fft_tw_last(f32x2 (&tw)[7]) {
    const float h = 0.70710678118654752f;
    tw[0] = (f32x2){1.f, 0.f}; tw[1] = (f32x2){h, -h}; tw[2] = (f32x2){0.f, -1.f}; tw[3] = (f32x2){-h, -h};
    tw[4] = (f32x2){1.f, 0.f}; tw[5] = (f32x2){0.f, -1.f}; tw[6] = (f32x2){1.f, 0.f};
}
struct FftTw { f32x2 t1[15]; f32x2 t2[2][7]; f32x2 t3[2][7]; };
__device__ __forceinline__ void fft_tw_init(FftTw& T, int tid) {
    fft_twiddles<16>(T.t1, tid, 512, 8192);
#pragma unroll
    for (int it = 0; it < 2; ++it) { const int uu = tid + 512 * it; fft_twiddles<8>(T.t2[it], uu & 63, 64, 512); fft_twiddles<8>(T.t3[it], uu & 7, 8, 64); }
}
template <bool INV, int M> __device__ __forceinline__ void fft_pass8(LAS f32x2* X, int tid, const f32x2 (&tw)[2][7]) {
    asm volatile("" : "+v"(tid));
    constexpr int s = M >> 3;
#pragma unroll
    for (int it = 0; it < 2; ++it) {
        const int uu = tid + 512 * it, blk = uu / s, t = uu - blk * s, n0 = blk * M + t;
        f32x2 v[8];
#pragma unroll
        for (int q = 0; q < 8; ++q) v[q] = X[fpad(n0 + q * s)];
        if (INV) fft_bf_inv<8>(v, tw[it]); else fft_bf_fwd<8>(v, tw[it]);
#pragma unroll
        for (int q = 0; q < 8; ++q) X[fpad(n0 + q * s)] = v[q];
    }
}
__device__ __forceinline__ void fft_filter_unit(Frame& F, const FftTw& T, int l, int c) {
    LAS f32x2* X = (LAS f32x2*)F.lds;
    const float* HFp = WSP<float>(F, WS_HF + (size_t)l * 16 * MiB); const float* HBp = WSP<float>(F, WS_HF + (size_t)l * 16 * MiB + 8 * MiB);
    const float scale = hy_inv_l1(F, l, c) * (1.0f / 8192.0f);
    int tid = F.tid; asm volatile("" : "+v"(tid));
    __syncthreads();
    {   f32x2 v[16];
#pragma unroll
        for (int q = 0; q < 16; ++q) { const int n = tid + 512 * q; float x;
            if (q < 8) x = HFp[(size_t)n * 512 + c]; else x = (n == 4096) ? 0.f : HBp[(size_t)(8192 - n) * 512 + c];
            v[q] = (f32x2){x * scale, 0.f}; }
        fft_bf_fwd<16>(v, T.t1);
#pragma unroll
        for (int q = 0; q < 16; ++q) X[fpad(tid + 512 * q)] = v[q];
    }
    __syncthreads(); fft_pass8<false, 512>(X, tid, T.t2);
    __syncthreads(); fft_pass8<false, 64>(X, tid, T.t3);
    __syncthreads();
    f32x2* Hc = WSP<f32x2>(F, WS_HSPEC) + ((size_t)l * 512 + c) * 8192;
    asm volatile("" : "+v"(tid));
    f32x2 tl[7]; fft_tw_last(tl);
#pragma unroll
    for (int it = 0; it < 2; ++it) {
        const int uu = tid + 512 * it;
        f32x2 v[8];
#pragma unroll
        for (int q = 0; q < 8; ++q) v[q] = X[fpad(8 * uu + q)];
        fft_bf_fwd<8>(v, tl);
#pragma unroll
        for (int q = 0; q < 4; ++q) { f32x4 o; o[0] = v[2 * q].x; o[1] = v[2 * q].y; o[2] = v[2 * q + 1].x; o[3] = v[2 * q + 1].y; *(f32x4*)(Hc + 8 * uu + 2 * q) = o; }
    }
}
__device__ __forceinline__ void fft_zfetch(Frame& F, int unit, int tid, unsigned (&zp)[8]) {
    const bf16* n1 = WSP<bf16>(F, WS_ZT) + ((size_t)(unit >> 2) * NB + 2 * (unit & 3)) * SEQ; const bf16* n2 = n1 + SEQ;
#pragma unroll
    for (int q = 0; q < 8; ++q) { const int n = tid + 512 * q; zp[q] = (unsigned)n1[n] | ((unsigned)n2[n] << 16); }
}
__device__ __forceinline__ void fft_zfetch_raw(Frame& F, int unit, int tid, unsigned (&zr)[16]) {
    const bf16* n1 = WSP<bf16>(F, WS_ZT) + ((size_t)(unit >> 2) * NB + 2 * (unit & 3)) * SEQ; const bf16* n2 = n1 + SEQ;
#pragma unroll
    for (int q = 0; q < 8; ++q) { const int n = tid + 512 * q; zr[q] = (unsigned)n1[n]; zr[8 + q] = (unsigned)n2[n]; }
}
__device__ __forceinline__ void fft_zcombine(unsigned (&zp)[8], const unsigned (&zr)[16]) {
#pragma unroll
    for (int q = 0; q < 8; ++q) zp[q] = zr[q] | (zr[8 + q] << 16);
}
__device__ __forceinline__ void fft_stage_first(LAS f32x2* X, const FftTw& T, int tid, const unsigned (&zp)[8]) {
    f32x2 v[16];
#pragma unroll
    for (int q = 0; q < 8; ++q) v[q] = (f32x2){__uint_as_float(zp[q] << 16), __uint_as_float(zp[q] & 0xffff0000u)};
#pragma unroll
    for (int q = 8; q < 16; ++q) v[q] = (f32x2){0.f, 0.f};
    fft_bf_fwd<16>(v, T.t1);
#pragma unroll
    for (int q = 0; q < 16; ++q) X[fpad(tid + 512 * q)] = v[q];
}
__device__ __forceinline__ void fft_stage_mid(LAS f32x2* X, int tid, const f32x4 (&hp)[2][4]) {
    f32x2 tl[7]; fft_tw_last(tl);
#pragma unroll
    for (int it = 0; it < 2; ++it) {
        const int uu = tid + 512 * it;
        f32x2 v[8];
#pragma unroll
        for (int q = 0; q < 8; ++q) v[q] = X[fpad(8 * uu + q)];
        fft_bf_fwd<8>(v, tl);
#pragma unroll
        for (int q = 0; q < 4; ++q) { const f32x4 h = hp[it][q]; v[2 * q] = cmul_(v[2 * q], (f32x2){h[0], h[1]}); v[2 * q + 1] = cmul_(v[2 * q + 1], (f32x2){h[2], h[3]}); }
        fft_bf_inv<8>(v, tl);
#pragma unroll
        for (int q = 0; q < 8; ++q) X[fpad(8 * uu + q)] = v[q];
    }
}
__device__ __forceinline__ void fft_stage_last(Frame& F, LAS f32x2* X, const FftTw& T, int tid, int unit) {
    f32x2 v[16];
#pragma unroll
    for (int q = 0; q < 16; ++q) v[q] = X[fpad(tid + 512 * q)];
    fft_bf_inv<16>(v, T.t1);
    bf16* y1 = WSP<bf16>(F, WS_YT) + ((size_t)(unit >> 2) * NB + 2 * (unit & 3)) * SEQ; bf16* y2 = y1 + SEQ;
#pragma unroll
    for (int q = 0; q < 8; ++q) { const int n = tid + 512 * q; y1[n] = f2bf(v[q].x); y2[n] = f2bf(v[q].y); }
}
__device__ __forceinline__ void fft_conv_pair(Frame& F, const FftTw& T, int l, int ua, int ub, int na, int nb, unsigned (&zpa)[8], unsigned (&zpb)[8]) {
    LAS f32x2* X0 = (LAS f32x2*)F.lds; LAS f32x2* X1 = X0 + 9216;
    int tid = F.tid; asm volatile("" : "+v"(tid));
    __syncthreads();
    unsigned zra[16], zrb[16];
    fft_stage_first(X0, T, tid, zpa); if (na < 2048) fft_zfetch_raw(F, na, tid, zra);
    fft_stage_first(X1, T, tid, zpb); if (nb < 2048) fft_zfetch_raw(F, nb, tid, zrb);
    __syncthreads(); fft_pass8<false, 512>(X0, tid, T.t2); fft_pass8<false, 512>(X1, tid, T.t2);
    if (na < 2048) fft_zcombine(zpa, zra);
    if (nb < 2048) fft_zcombine(zpb, zrb);
    f32x4 hpa[2][4], hpb[2][4];
    { const f32x2* Ha = WSP<f32x2>(F, WS_HSPEC) + ((size_t)l * 512 + (ua >> 2)) * 8192; const f32x2* Hb = WSP<f32x2>(F, WS_HSPEC) + ((size_t)l * 512 + (ub >> 2)) * 8192;
#pragma unroll
      for (int it = 0; it < 2; ++it)
#pragma unroll
          for (int q = 0; q < 4; ++q) { hpa[it][q] = *(const f32x4*)(Ha + 8 * (tid + 512 * it) + 2 * q); hpb[it][q] = *(const f32x4*)(Hb + 8 * (tid + 512 * it) + 2 * q); } }
    __syncthreads(); fft_pass8<false, 64>(X0, tid, T.t3); fft_pass8<false, 64>(X1, tid, T.t3);
    __syncthreads(); asm volatile("" : "+v"(tid)); fft_stage_mid(X0, tid, hpa); fft_stage_mid(X1, tid, hpb);
    __syncthreads(); fft_pass8<true, 64>(X0, tid, T.t3); fft_pass8<true, 64>(X1, tid, T.t3);
    __syncthreads(); fft_pass8<true, 512>(X0, tid, T.t2); fft_pass8<true, 512>(X1, tid, T.t2);
    __syncthreads(); asm volatile("" : "+v"(tid)); fft_stage_last(F, X0, T, tid, ua); fft_stage_last(F, X1, T, tid, ub);
}

constexpr int HLD = 72;
struct HyRaw { u32x4 c0, c1, c2; };
__device__ __forceinline__ void hy_fetch8(const bf16* P, int base, int t, int L, int ch0, HyRaw& r) {
    const bf16* p1 = P + (size_t)(base + t) * INC + C_HU + ch0;
    const u32x4 zero = (u32x4){0u, 0u, 0u, 0u};
    r.c1 = *(const u32x4*)p1; r.c0 = (t > 0) ? *(const u32x4*)(p1 - INC) : zero; r.c2 = (t + 1 < L) ? *(const u32x4*)(p1 + INC) : zero;
}
__device__ __forceinline__ void hy_conv8(const HyRaw& r, const float (&w)[4][8], float (&out)[8]) {
    const unsigned a0[4] = {r.c0.x, r.c0.y, r.c0.z, r.c0.w}, a1[4] = {r.c1.x, r.c1.y, r.c1.z, r.c1.w}, a2[4] = {r.c2.x, r.c2.y, r.c2.z, r.c2.w};
#pragma unroll
    for (int i = 0; i < 4; ++i) {
        out[2 * i] = w[3][2 * i] + __uint_as_float(a0[i] << 16) * w[0][2 * i] + __uint_as_float(a1[i] << 16) * w[1][2 * i] + __uint_as_float(a2[i] << 16) * w[2][2 * i];
        out[2 * i + 1] = w[3][2 * i + 1] + __uint_as_float(a0[i] & 0xffff0000u) * w[0][2 * i + 1] + __uint_as_float(a1[i] & 0xffff0000u) * w[1][2 * i + 1] + __uint_as_float(a2[i] & 0xffff0000u) * w[2][2 * i + 1];
    }
}
__device__ __forceinline__ void hy_load_w8(const float* cw, const float* cb, int ch0, float (&w)[4][8]) {
#pragma unroll
    for (int i = 0; i < 8; ++i) { w[0][i] = cw[ch0 + i]; w[1][i] = cw[1536 + ch0 + i]; w[2][i] = cw[2 * 1536 + ch0 + i]; w[3][i] = cb[ch0 + i]; }
}
__device__ __forceinline__ void hy_item_decode(int it, int& ct, int& base, int& t0, int& L, int& b, bool& isctx) {
    isctx = it >= 4096;
    if (!isctx) { ct = it & 7; t0 = ((it >> 3) & 63) * 64; b = it >> 9; base = b * SEQ; L = SEQ; }
    else { const int j = it - 4096; ct = j & 7; t0 = ((j >> 3) & 3) * 64; b = j >> 5; base = NLAT + b * CTXL; L = CTXL; }
}
template <int VAR> __device__ __forceinline__ int hy_nitems(int bx, bool reb, int nit) {
    if (!reb) return (nit - bx + 255) >> 8;
    if (bx < 64) return 11;
    if (VAR == 0) return bx < 192 ? 20 : 17;
    return 19;
}
template <int VAR> __device__ __forceinline__ int hy_item(int bx, bool reb, int idx) {
    if (!reb || idx < ((bx < 64) ? 11 : 17)) return bx + 256 * idx;
    const int e = idx - 17, donor = bx & 63, grp = (bx >> 6) - 1;
    const int k = (VAR == 0) ? (11 + 3 * grp + e) : (11 + 2 * grp + e);
    return donor + 256 * k;
}
__device__ __forceinline__ void ph_hyprep2(Frame& F, int l, bool do_ctx) {
    const bf16* P = WSP<bf16>(F, WS_P);
    const float* cw = IN_(F, 10) + l * 3 * 1536; const float* cb = IN_(F, 11) + l * 1536;
    LAS bf16* Zs = (LAS bf16*)F.lds;
    int tid = F.tid; asm volatile("" : "+v"(tid));
    const int cg = tid & 7, tl = tid >> 3, c0 = (F.bx & 7) * 64;
    float w1[4][8], wv[4][8];
    hy_load_w8(cw, cb, 512 + c0 + 8 * cg, w1); hy_load_w8(cw, cb, 1024 + c0 + 8 * cg, wv);
    const int nit = do_ctx ? 4352 : 4096;
    HyRaw r1, rv;
    const int nmy = hy_nitems<0>(F.bx, do_ctx, nit);
    { int ct, base, t0, L, b; bool isctx; hy_item_decode(hy_item<0>(F.bx, do_ctx, 0), ct, base, t0, L, b, isctx); hy_fetch8(P, base, t0 + tl, L, 512 + c0 + 8 * cg, r1); hy_fetch8(P, base, t0 + tl, L, 1024 + c0 + 8 * cg, rv); }
#pragma unroll 1
    for (int ii = 0; ii < nmy; ++ii) {
        const int it = hy_item<0>(F.bx, do_ctx, ii);
        int ct, base, t0, L, b; bool isctx; hy_item_decode(it, ct, base, t0, L, b, isctx);
        float x1[8], v[8];
        hy_conv8(r1, w1, x1); hy_conv8(rv, wv, v);
        if (ii + 1 < nmy) { int ct2, base2, t02, L2, b2; bool ic2; hy_item_decode(hy_item<0>(F.bx, do_ctx, ii + 1), ct2, base2, t02, L2, b2, ic2); hy_fetch8(P, base2, t02 + tl, L2, 512 + c0 + 8 * cg, r1); hy_fetch8(P, base2, t02 + tl, L2, 1024 + c0 + 8 * cg, rv); }
        __syncthreads();
#pragma unroll
        for (int i = 0; i < 8; ++i) Zs[(8 * cg + i) * HLD + (tl ^ (8 * cg))] = f2bf(x1[i] * v[i]);
        __syncthreads();
        { const int c = tid >> 3, seg = tid & 7;
          const u32x4 o = *(const LAS u32x4*)(Zs + c * HLD + 8 * (seg ^ (c >> 3)));
          bf16* dst = isctx ? (WSP<bf16>(F, WS_ZTC) + ((size_t)(c0 + c) * NB + b) * CTXL + t0 + 8 * seg) : (WSP<bf16>(F, WS_ZT) + ((size_t)(c0 + c) * NB + b) * SEQ + t0 + 8 * seg);
          *(u32x4*)dst = o; }
    }
}
__device__ __forceinline__ void ph_hypost2(Frame& F, int l, bool do_ctx) {
    const bf16* P = WSP<bf16>(F, WS_P);
    const float* cw = IN_(F, 10) + l * 3 * 1536; const float* cb = IN_(F, 11) + l * 1536; const float* skip = IN_(F, 19) + l * 512;
    LAS bf16* Ys = (LAS bf16*)F.lds;
    int tid = F.tid; asm volatile("" : "+v"(tid));
    const int cg = tid & 7, tl = tid >> 3, c0 = (F.bx & 7) * 64;
    float w0[4][8], w1[4][8], wv[4][8], sk[8];
    hy_load_w8(cw, cb, c0 + 8 * cg, w0); hy_load_w8(cw, cb, 512 + c0 + 8 * cg, w1); hy_load_w8(cw, cb, 1024 + c0 + 8 * cg, wv);
#pragma unroll
    for (int i = 0; i < 8; ++i) sk[i] = skip[c0 + 8 * cg + i];
    bf16* HY = WSP<bf16>(F, WS_RET) + 1024;
    const int nit = do_ctx ? 4352 : 4096;
    const int cY = tid >> 3, segY = tid & 7;
    HyRaw r0, r1, rv; u32x4 yraw;
#define HYP_FETCH(it_) do { int ct_, base_, t0_, L_, b_; bool ic_; hy_item_decode((it_), ct_, base_, t0_, L_, b_, ic_); \
        hy_fetch8(P, base_, t0_ + tl, L_, c0 + 8 * cg, r0); hy_fetch8(P, base_, t0_ + tl, L_, 512 + c0 + 8 * cg, r1); hy_fetch8(P, base_, t0_ + tl, L_, 1024 + c0 + 8 * cg, rv); \
        const bf16* src_ = ic_ ? (WSP<bf16>(F, WS_YTC) + ((size_t)(c0 + cY) * NB + b_) * CTXL + t0_ + 8 * segY) : (WSP<bf16>(F, WS_YT) + ((size_t)(c0 + cY) * NB + b_) * SEQ + t0_ + 8 * segY); \
        yraw = *(const u32x4*)src_; } while (0)
    const int nmy = hy_nitems<1>(F.bx, do_ctx, nit);
    HYP_FETCH(hy_item<1>(F.bx, do_ctx, 0));
#pragma unroll 1
    for (int ii = 0; ii < nmy; ++ii) {
        const int it = hy_item<1>(F.bx, do_ctx, ii);
        int ct, base, t0, L, b; bool isctx; hy_item_decode(it, ct, base, t0, L, b, isctx);
        float x0[8], x1[8], v[8];
        hy_conv8(r0, w0, x0); hy_conv8(r1, w1, x1); hy_conv8(rv, wv, v);
        __syncthreads();
        *(LAS u32x4*)(Ys + cY * HLD + 8 * (segY ^ (cY >> 3))) = yraw;
        if (ii + 1 < nmy) HYP_FETCH(hy_item<1>(F.bx, do_ctx, ii + 1));
        __syncthreads();
        float hy[8];
#pragma unroll
        for (int i = 0; i < 8; ++i) { const float y = bf2f(Ys[(8 * cg + i) * HLD + (tl ^ (8 * cg))]); hy[i] = x0[i] * (y + sk[i] * (x1[i] * v[i])); }
        u32x4 o; o.x = pk2(hy[0], hy[1]); o.y = pk2(hy[2], hy[3]); o.z = pk2(hy[4], hy[5]); o.w = pk2(hy[6], hy[7]);
        *(u32x4*)(HY + (size_t)(base + t0 + tl) * 1536 + c0 + 8 * cg) = o;
    }
#undef HYP_FETCH
}
__device__ __forceinline__ void hyconv_ctx_item2(Frame& F, int c) {
    const float* HFp = WSP<float>(F, WS_HFC); const float* HBp = WSP<float>(F, WS_HFC + 512 * 1024);
    LAS float* Kc = (LAS float*)F.lds; LAS float* Zs = Kc + 512;
    const float il1 = hy_inv_l1(F, 2, c);
    const bf16* Z = WSP<bf16>(F, WS_ZTC) + (size_t)c * NB * CTXL; bf16* Yo = WSP<bf16>(F, WS_YTC) + (size_t)c * NB * CTXL;
    const int tid = F.tid;
    __syncthreads();
    if (tid < 511) { const int d = tid - 255; Kc[tid] = (d >= 0 ? HFp[(size_t)d * 512 + c] : HBp[(size_t)(-d) * 512 + c]) * il1; }
#pragma unroll
    for (int i = 0; i < 4; ++i) Zs[tid + 512 * i] = bf2f(Z[tid + 512 * i]);
    __syncthreads();
    const int t = tid & 255, b0 = tid >> 8;
    float a[4] = {0.f, 0.f, 0.f, 0.f};
#pragma unroll 4
    for (int s = 0; s < CTXL; ++s) { const float k = Kc[t - s + 255];
#pragma unroll
        for (int i = 0; i < 4; ++i) a[i] += k * Zs[(b0 + 2 * i) * CTXL + s]; }
#pragma unroll
    for (int i = 0; i < 4; ++i) Yo[(b0 + 2 * i) * CTXL + t] = f2bf(a[i]);
}

constexpr int ALD = 72;
__device__ __forceinline__ void attn_unit(Frame& F, int l, int unit) {
    const bf16* P = WSP<bf16>(F, WS_P);
    LAS bf16* Kb = (LAS bf16*)F.lds; LAS bf16* Vt = Kb + 64 * ALD;
    const bool isctx = unit >= 1024;
    int b, kvh, qb;
    if (!isctx) { b = unit >> 7; kvh = (unit >> 6) & 1; qb = unit & 63; } else { const int it = unit - 1024; b = it >> 3; kvh = (it >> 2) & 1; qb = it & 3; }
    int tid = F.tid; asm volatile("" : "+v"(tid));
    const int lane = tid & 63, w = F.wave, g = w >> 1, h = kvh * 4 + g, lg = lane >> 4, lc = lane & 15;
    const int start = qb * 64, q0 = start + (w & 1) * 32;
    const int rowq0 = isctx ? (NLAT + b * CTXL + q0) : (b * SEQ + q0);
    bf16x8 bq[2][2];
#pragma unroll
    for (int qt = 0; qt < 2; ++qt)
#pragma unroll
        for (int ks = 0; ks < 2; ++ks) bq[qt][ks] = *(const bf16x8*)(P + (size_t)(rowq0 + 16 * qt + lc) * INC + C_AQ + h * 64 + 32 * ks + 8 * lg);
    const float sink = IN_(F, 9)[l * 8 + h];
    float mrun[2], lsum[2]; f32x4 o[4][2];
#pragma unroll
    for (int qt = 0; qt < 2; ++qt) { mrun[qt] = sink * 1.4426950408889634f; lsum[qt] = (lg == 0) ? 1.0f : 0.0f;
#pragma unroll
        for (int dt = 0; dt < 4; ++dt) o[dt][qt] = (f32x4){0.f, 0.f, 0.f, 0.f}; }
    const int nkb = isctx ? 4 : 9;
    const int key = tid >> 3, d0 = (tid & 7) * 8;
    u32x4 kk, vv;
#define ATT_FETCH(kb_) do { const bool cb_ = isctx || (kb_) >= 5; int row_ = -1; \
        if (cb_) row_ = NLAT + b * CTXL + (isctx ? (kb_) : (kb_) - 5) * 64 + key; \
        else { const int kpos_ = start - 128 + (kb_) * 64 + key; if (kpos_ >= 0 && kpos_ < SEQ) row_ = b * SEQ + kpos_; } \
        kk = (u32x4){0u, 0u, 0u, 0u}; vv = kk; \
        if (row_ >= 0) { kk = *(const u32x4*)(P + (size_t)row_ * INC + C_AK + kvh * 64 + d0); vv = *(const u32x4*)(P + (size_t)row_ * INC + C_AV + kvh * 64 + d0); } } while (0)
    const int kb_lo = isctx ? 0 : ((start >= 128) ? 0 : 2 - (start >> 6)), kb_hi = isctx ? 0 : (((SEQ + 128 - start) >> 6) < 5 ? ((SEQ + 128 - start) >> 6) : 5);
#define ATT_NEXT(kb_) ((!isctx && (kb_) + 1 == kb_hi) ? 5 : (kb_) + 1)
    ATT_FETCH(kb_lo);
#pragma unroll 1
    for (int kb = kb_lo; kb < nkb; kb = ATT_NEXT(kb)) {
        const bool ctxblk = isctx || kb >= 5;
        __syncthreads();
        { *(LAS u32x4*)(Kb + key * ALD + d0) = kk;
          const unsigned vw[4] = {vv.x, vv.y, vv.z, vv.w};
#pragma unroll
          for (int i = 0; i < 4; ++i) { Vt[(d0 + 2 * i) * ALD + (key ^ d0)] = (bf16)(vw[i] & 0xffffu); Vt[(d0 + 2 * i + 1) * ALD + (key ^ d0)] = (bf16)(vw[i] >> 16); } }
        __syncthreads();
        { const int kn = ATT_NEXT(kb); if (kn < nkb) ATT_FETCH(kn); }
        f32x4 s[4][2];
        bf16x8 kf[4][2];
#pragma unroll
        for (int kt = 0; kt < 4; ++kt) { kf[kt][0] = *(const LAS bf16x8*)(Kb + (16 * kt + lc) * ALD + 8 * lg); kf[kt][1] = *(const LAS bf16x8*)(Kb + (16 * kt + lc) * ALD + 32 + 8 * lg); }
        __builtin_amdgcn_sched_barrier(0);
#pragma unroll
        for (int kt = 0; kt < 4; ++kt)
#pragma unroll
            for (int qt = 0; qt < 2; ++qt) { f32x4 c = (f32x4){0.f, 0.f, 0.f, 0.f};
                c = __builtin_amdgcn_mfma_f32_16x16x32_bf16(kf[kt][0], bq[qt][0], c, 0, 0, 0); c = __builtin_amdgcn_mfma_f32_16x16x32_bf16(kf[kt][1], bq[qt][1], c, 0, 0, 0);
                s[kt][qt] = c; }
        if (!ctxblk && (kb == 0 || kb == 4)) {
#pragma unroll
            for (int kt = 0; kt < 4; ++kt)
#pragma unroll
                for (int qt = 0; qt < 2; ++qt)
#pragma unroll
                    for (int r = 0; r < 4; ++r) { const int kpos = start - 128 + kb * 64 + 16 * kt + 4 * lg + r, qpos = q0 + 16 * qt + lc, dd = qpos - kpos;
                        const bool valid = (kpos >= 0) && (kpos < SEQ) && (dd <= 128) && (dd >= -128);
                        s[kt][qt][r] = valid ? s[kt][qt][r] : -1.0e30f; }
        }
        bf16x8 pf[2][2];
#pragma unroll
        for (int qt = 0; qt < 2; ++qt) {
            float bm = -3.0e38f;
#pragma unroll
            for (int kt = 0; kt < 4; ++kt) bm = fmaxf(bm, fmaxf(fmaxf(s[kt][qt][0], s[kt][qt][1]), fmaxf(s[kt][qt][2], s[kt][qt][3])));
            bm = fmaxf(bm, __shfl_xor(bm, 16)); bm = fmaxf(bm, __shfl_xor(bm, 32));
            const float KS = 0.125f * 1.4426950408889634f;
            const float mold = mrun[qt], mnew = fmaxf(mold, bm * KS);
            mrun[qt] = mnew;
            float ps = 0.f; unsigned pw[8];
#pragma unroll
            for (int kt = 0; kt < 4; ++kt) { const float p0 = __builtin_amdgcn_exp2f(fmaf(s[kt][qt][0], KS, -mnew)), p1 = __builtin_amdgcn_exp2f(fmaf(s[kt][qt][1], KS, -mnew)), p2 = __builtin_amdgcn_exp2f(fmaf(s[kt][qt][2], KS, -mnew)), p3 = __builtin_amdgcn_exp2f(fmaf(s[kt][qt][3], KS, -mnew));
                ps += (p0 + p1) + (p2 + p3); pw[2 * kt] = pk2(p0, p1); pw[2 * kt + 1] = pk2(p2, p3); }
            if (__any(mnew > mold)) {
                const float sc = __builtin_amdgcn_exp2f(mold - mnew);
                lsum[qt] = lsum[qt] * sc;
#pragma unroll
                for (int dt = 0; dt < 4; ++dt) o[dt][qt] = o[dt][qt] * sc; }
            lsum[qt] += ps;
            u32x4 f0; f0.x = pw[0]; f0.y = pw[1]; f0.z = pw[2]; f0.w = pw[3];
            u32x4 f1; f1.x = pw[4]; f1.y = pw[5]; f1.z = pw[6]; f1.w = pw[7];
            pf[qt][0] = __builtin_bit_cast(bf16x8, f0); pf[qt][1] = __builtin_bit_cast(bf16x8, f1);
        }
        bf16x8 vfr[4][2];
#pragma unroll
        for (int dt = 0; dt < 4; ++dt)
#pragma unroll
            for (int ks = 0; ks < 2; ++ks) {
                const int vsw = ((16 * dt + lc) >> 3) << 3;
                const u32x2 a0 = *(const LAS u32x2*)(Vt + (16 * dt + lc) * ALD + ((32 * ks + 4 * lg) ^ vsw)), a1 = *(const LAS u32x2*)(Vt + (16 * dt + lc) * ALD + ((32 * ks + 16 + 4 * lg) ^ vsw));
                u32x4 av; av.x = a0.x; av.y = a0.y; av.z = a1.x; av.w = a1.y;
                vfr[dt][ks] = __builtin_bit_cast(bf16x8, av); }
        __builtin_amdgcn_sched_barrier(0);
#pragma unroll
        for (int dt = 0; dt < 4; ++dt)
#pragma unroll
            for (int ks = 0; ks < 2; ++ks)
#pragma unroll
                for (int qt = 0; qt < 2; ++qt) o[dt][qt] = __builtin_amdgcn_mfma_f32_16x16x32_bf16(vfr[dt][ks], pf[qt][ks], o[dt][qt], 0, 0, 0);
    }
#undef ATT_FETCH
#undef ATT_NEXT
    bf16* ATT = WSP<bf16>(F, WS_RET) + 512;
#pragma unroll
    for (int qt = 0; qt < 2; ++qt) {
        float lt = lsum[qt]; lt += __shfl_xor(lt, 16); lt += __shfl_xor(lt, 32);
        const float inv = 1.0f / lt;
        bf16* op = ATT + (size_t)(rowq0 + 16 * qt + lc) * 1536 + h * 64 + 4 * lg;
#pragma unroll
        for (int dt = 0; dt < 4; ++dt) { u32x2 ov; ov.x = pk2(o[dt][qt][0] * inv, o[dt][qt][1] * inv); ov.y = pk2(o[dt][qt][2] * inv, o[dt][qt][3] * inv); *(u32x2*)(op + 16 * dt) = ov; }
    }
}

__device__ __forceinline__ void ph_norm2_router(Frame& F, int l, int nrows) {
    const int lane = F.lane, RPB = nrows / 256;
    LAS float* RW = (LAS float*)F.lds;
    LAS unsigned* cnt = (LAS unsigned*)(F.lds + LDSX + 64);
    __syncthreads();
    { const float* rw = IN_(F, 24) + (size_t)l * 1024 * 32;
#pragma unroll 1
      for (int i0 = F.tid; i0 < 1024 * 32 / 4; i0 += 8 * NTHR) { f32x4 t8[8];
#pragma unroll
          for (int k = 0; k < 8; ++k) t8[k] = *(const f32x4*)(rw + 4 * (i0 + k * NTHR));
          __builtin_amdgcn_sched_barrier(0);
#pragma unroll
          for (int k = 0; k < 8; ++k) { const int i = i0 + k * NTHR, col = i >> 3, ch = i & 7, ll = (col >> 2) & 63, ridx = ((col & 3) * 4 + (col >> 8)) * 64 + ll;
              *(LAS f32x4*)(RW + ridx * 32 + ((ch ^ ((ll >> 1) & 7)) << 2)) = t8[k]; } } }
    if (F.tid < 32) cnt[F.tid] = 0u;
    { int* SRC = WSP<int>(F, WS_SRC); for (int i = F.bx * NTHR + F.tid; i < MPAD; i += F.G * NTHR) SRC[i] = 0; }
    __syncthreads();
    const float* xm_all = WSP<float>(F, WS_XM);
    const float* gw_ = IN_(F, 23) + l * DM;
    const int e = lane >> 1, sw = (lane >> 1) & 7;
    const float rb = IN_(F, 25)[l * 32 + e];
    int* TOPI = WSP<int>(F, WS_TOPI); float* TOPW = WSP<float>(F, WS_TOPW);
    typedef float f32x2 __attribute__((ext_vector_type(2)));
    f32x4 vnext[2][4];
    { const float* xr0 = xm_all + (size_t)(F.bx * RPB + 2 * F.wave) * DM;
#pragma unroll
      for (int t = 0; t < 2; ++t)
#pragma unroll
        for (int j = 0; j < 4; ++j) vnext[t][j] = *(const f32x4*)(xr0 + t * DM + 4 * lane + 256 * j); }
#pragma unroll 1
    for (int rr = 2 * F.wave; rr < RPB; rr += 2 * NWAVES) {
        const int r = F.bx * RPB + rr, mr = modrow_of(r);
        f32x4 shq[4], aq[4];
        { const float* sh = mod_ptr(F, l, mr, 3); const float* sc = mod_ptr(F, l, mr, 4); f32x4 gq_[4], sc_[4];
#pragma unroll
          for (int j = 0; j < 4; ++j) { shq[j] = *(const f32x4*)(sh + 4 * lane + 256 * j); gq_[j] = *(const f32x4*)(gw_ + 4 * lane + 256 * j); sc_[j] = *(const f32x4*)(sc + 4 * lane + 256 * j); }
          __builtin_amdgcn_sched_barrier(0);
#pragma unroll
          for (int j = 0; j < 4; ++j) aq[j] = gq_[j] * (sc_[j] + 1.0f); }
        f32x4 v[2][4]; float ss[2] = {0.f, 0.f};
#pragma unroll
        for (int t = 0; t < 2; ++t)
#pragma unroll
            for (int j = 0; j < 4; ++j) { v[t][j] = vnext[t][j]; ss[t] += (v[t][j][0] * v[t][j][0] + v[t][j][1] * v[t][j][1]) + (v[t][j][2] * v[t][j][2] + v[t][j][3] * v[t][j][3]); }
        const float* xn = xm_all + (size_t)((rr + 2 * NWAVES < RPB) ? r + 2 * NWAVES : r) * DM;
#pragma unroll
        for (int t = 0; t < 2; ++t) {
            const float rstd = 1.0f / sqrtf(wave_sum(ss[t]) * (1.0f / DM) + EPS);
            bf16* o = WSP<bf16>(F, WS_XN) + (size_t)(r + t) * DM;
#pragma unroll
            for (int j = 0; j < 4; ++j) { v[t][j] = v[t][j] * rstd * aq[j] + shq[j];
                u32x2 w2; w2.x = pk2(v[t][j][0], v[t][j][1]); w2.y = pk2(v[t][j][2], v[t][j][3]); *(u32x2*)(o + 4 * lane + 256 * j) = w2; } }
        f32x2 acc[2][16];
#pragma unroll
        for (int t = 0; t < 2; ++t)
#pragma unroll
            for (int i = 0; i < 16; ++i) acc[t][i] = (f32x2){0.f, 0.f};
        f32x4 wa[8], wb[8];
#define RT_LOAD(W, c) { const int j_ = (c) >> 2, q_ = (c) & 3, ri_ = (q_ * 4 + j_) * 64 + lane; \
            _Pragma("unroll") for (int c8 = 0; c8 < 8; ++c8) W[c8] = *(const LAS f32x4*)(RW + ri_ * 32 + ((c8 ^ sw) << 2)); }
#define RT_FMA(W, c) { const int j_ = (c) >> 2, q_ = (c) & 3; const float h0 = v[0][j_][q_], h1 = v[1][j_][q_]; const f32x2 hh0 = {h0, h0}, hh1 = {h1, h1}; \
            _Pragma("unroll") for (int c8 = 0; c8 < 8; ++c8) { acc[0][2 * c8] += hh0 * W[c8].lo; acc[0][2 * c8 + 1] += hh0 * W[c8].hi; acc[1][2 * c8] += hh1 * W[c8].lo; acc[1][2 * c8 + 1] += hh1 * W[c8].hi; } }
        RT_LOAD(wa, 0)
#pragma unroll
        for (int c = 0; c < 16; c += 2) {
            RT_LOAD(wb, c + 1)
            __builtin_amdgcn_sched_barrier(0);
            RT_FMA(wa, c)
            __builtin_amdgcn_sched_barrier(0);
            if (c + 2 < 16) RT_LOAD(wa, c + 2)
            __builtin_amdgcn_sched_barrier(0);
            RT_FMA(wb, c + 1)
            __builtin_amdgcn_sched_barrier(0);
            if ((c & 3) == 2) { const int jj = c >> 2;
#pragma unroll
                for (int t = 0; t < 2; ++t) vnext[t][jj] = *(const f32x4*)(xn + t * DM + 4 * lane + 256 * jj);
                __builtin_amdgcn_sched_barrier(0); }
        }
#undef RT_LOAD
#undef RT_FMA
#pragma unroll
        for (int i = 0; i < 16; ++i) asm volatile("" : "+v"(acc[1][i]));
#pragma unroll
        for (int t = 0; t < 2; ++t) {
        float r16[16], r8[8], r4[4], r2[2];
#pragma unroll
        for (int i = 0; i < 16; ++i) { const auto sw2 = __builtin_amdgcn_permlane32_swap(__float_as_uint(acc[t][i >> 1][i & 1]), __float_as_uint(acc[t][8 + (i >> 1)][i & 1]), false, false);
            r16[i] = __uint_as_float(sw2[0]) + __uint_as_float(sw2[1]); }
#pragma unroll
        for (int i = 0; i < 8; ++i) { const auto sw2 = __builtin_amdgcn_permlane16_swap(__float_as_uint(r16[i]), __float_as_uint(r16[8 + i]), false, false);
            r8[i] = __uint_as_float(sw2[0]) + __uint_as_float(sw2[1]); }
#define RT_DPP(old, v, ctrl, bm) __int_as_float(__builtin_amdgcn_update_dpp(__float_as_int(old), __float_as_int(v), (ctrl), 0xF, (bm), false))
        { const bool hi = (lane & 8) != 0;
#pragma unroll
          for (int i = 0; i < 4; ++i) { const float a = r8[i], b = r8[4 + i]; const float u = RT_DPP(RT_DPP(0.f, a, 0x128, 0x3), b, 0x128, 0xC); r4[i] = (hi ? b : a) + u; } }
        { const bool hi = (lane & 4) != 0;
#pragma unroll
          for (int i = 0; i < 2; ++i) { const float a = r4[i], b = r4[2 + i]; const float u = RT_DPP(RT_DPP(0.f, a, 0x12C, 0x5), b, 0x124, 0xA); r2[i] = (hi ? b : a) + u; } }
        float logit;
        { const bool hi = (lane & 2) != 0; const float keep = hi ? r2[1] : r2[0], send = hi ? r2[0] : r2[1]; logit = keep + RT_DPP(0.f, send, 0x4E, 0xF); }
        logit += RT_DPP(0.f, logit, 0xB1, 0xF);
#undef RT_DPP
        logit += rb;
        int rank = 0;
#pragma unroll
        for (int q = 0; q < 32; ++q) { const float lq = rdlane(logit, 2 * q); rank += (lq > logit) ? 1 : 0; }
        { const bool ev = (lane & 1) == 0;
          const bool uniq = __builtin_popcountll(__ballot(ev && rank == 0)) == 1 && __builtin_popcountll(__ballot(ev && rank == 1)) == 1 && __builtin_popcountll(__ballot(ev && rank == 2)) == 1 && __builtin_popcountll(__ballot(ev && rank == 3)) == 1;
          if (!uniq) { rank = 0;
#pragma unroll 1
              for (int q = 0; q < 32; ++q) { const float lq = rdlane(logit, 2 * q); rank += (lq > logit || (lq == logit && q < e)) ? 1 : 0; } } }
        const bool sel = (rank < 4) && ((lane & 1) == 0);
        const unsigned long long m0 = __ballot(sel && rank == 0), m1 = __ballot(sel && rank == 1), m2 = __ballot(sel && rank == 2), m3 = __ballot(sel && rank == 3);
        const int l0 = __builtin_ctzll(m0), l1 = __builtin_ctzll(m1), l2 = __builtin_ctzll(m2), l3 = __builtin_ctzll(m3);
        const float t0 = rdlane(logit, l0), t1 = rdlane(logit, l1), t2 = rdlane(logit, l2), t3 = rdlane(logit, l3);
        const float e1 = __expf(t1 - t0), e2 = __expf(t2 - t0), e3 = __expf(t3 - t0), inv = 1.0f / (1.0f + e1 + e2 + e3);
        if (lane < 4) { const int id = ((lane == 0) ? l0 : (lane == 1) ? l1 : (lane == 2) ? l2 : l3) >> 1; const float wv = ((lane == 0) ? 1.0f : (lane == 1) ? e1 : (lane == 2) ? e2 : e3) * inv;
            TOPI[(r + t) * 4 + lane] = id; TOPW[(r + t) * 4 + lane] = wv; __hip_atomic_fetch_add(cnt + id, 1u, __ATOMIC_RELAXED, __HIP_MEMORY_SCOPE_WORKGROUP); }
        }
    }
    __syncthreads();
    if (F.tid < 32) WSP<int>(F, WS_BLKCNT)[F.bx * 32 + F.tid] = (int)cnt[F.tid];
}

__device__ __forceinline__ void ph_moe_assign(Frame& F, int nrows) {
    const int RPB = nrows / 256, lane = F.lane;
    LAS int* part = (LAS int*)F.lds;
    LAS int* base = part + 1024;
    LAS int* idx = base + 32;
    LAS int* posl = idx + 1024;
    const int* BC = WSP<int>(F, WS_BLKCNT);
    __syncthreads();
    { const int e = F.tid & 31, pt = F.tid >> 5; int st = 0, sp = 0;
      for (int q = 0; q < 16; ++q) { const int blk = pt * 16 + q; const int v = BC[blk * 32 + e]; st += v; if (blk < F.bx) sp += v; }
      part[pt * 32 + e] = st; part[512 + pt * 32 + e] = sp; }
    for (int i = F.tid; i < RPB * 4; i += NTHR) idx[i] = WSP<int>(F, WS_TOPI)[F.bx * RPB * 4 + i];
    __syncthreads();
    if (F.tid < 32) { int st = 0, sp = 0; for (int q = 0; q < 16; ++q) { st += part[q * 32 + F.tid]; sp += part[512 + q * 32 + F.tid]; }
        part[F.tid] = st; part[512 + F.tid] = sp; }
    __syncthreads();
    if (F.tid == 0) { int t0 = 0; int* tl = WSP<int>(F, WS_TILES);
        for (int e = 0; e < 32; ++e) { base[e] = t0 * 256 + part[512 + e]; if (F.bx == 0) tl[e] = t0; t0 += (part[e] + 255) >> 8; }
        if (F.bx == 0) tl[32] = t0; }
    __syncthreads();
    LAS int* cc = posl + 1024;
    const int nent = RPB * 4;
    for (int ch = F.wave; ch * 64 < nent; ch += NWAVES) { const int j = ch * 64 + lane; const int my = (j < nent) ? idx[j] : -1; int rk = 0, cnte = 0;
#pragma unroll
        for (int e = 0; e < 32; ++e) { const unsigned long long m = __ballot(my == e); const int below = __builtin_amdgcn_mbcnt_hi((unsigned)(m >> 32), __builtin_amdgcn_mbcnt_lo((unsigned)m, 0));
            if (my == e) rk = below; if (lane == e) cnte = __builtin_popcountll(m); }
        if (lane < 32) cc[ch * 32 + lane] = cnte;
        if (j < nent) posl[j] = rk; }
    __syncthreads();
    for (int j = F.tid; j < nent; j += NTHR) { const int e = idx[j], ch = j >> 6; int p = base[e] + posl[j]; for (int q = 0; q < ch; ++q) p += cc[q * 32 + e]; posl[j] = p; }
    __syncthreads();
    int* POS = WSP<int>(F, WS_POS); int* SRC = WSP<int>(F, WS_SRC);
    for (int j = F.tid; j < RPB * 4; j += NTHR) { const int p = posl[j]; POS[F.bx * RPB * 4 + j] = p; SRC[p] = F.bx * RPB + (j >> 2); }
}

#define PHASE_FN __device__ __forceinline__
#ifndef MK_STAG_G
#define MK_STAG_G 1
#endif
#ifndef MK_STAG_US
#define MK_STAG_US 12
#endif
__device__ __forceinline__ void phase_stagger(const Frame& F) {
    if (MK_STAG_G > 1) { const int grp = (F.bx >> 3) % MK_STAG_G;
        if (grp) { const unsigned long long t0 = __builtin_amdgcn_s_memrealtime(), dt = (unsigned long long)(grp * MK_STAG_US * 100 / MK_STAG_G);
            while (__builtin_amdgcn_s_memrealtime() - t0 < dt) __builtin_amdgcn_s_sleep(32); } }
}
PHASE_FN void P_prologue() { Frame F = make_frame(); p0_prologue(F); }
PHASE_FN void P_norm1(int mode) { Frame F = make_frame(); ph_norm1(F, mode);
    if (mode == 0) { FftTw T; fft_tw_init(T, F.tid); for (int it = F.bx; it < 1024; it += F.G) fft_filter_unit(F, T, it >> 9, it & 511); } }
PHASE_FN void P_inproj(int l) { Frame F = make_frame(); phase_stagger(F);
    pg8::Gemm g{WSP<bf16>(F, WS_XN), WSP<bf16>(F, WS_WIN) + (size_t)l * INC * 1024, NROWS, INC, 1024};
    pg8::StaticOrder S; S.init(NROWS, INC, F.G, F.bx);
    EpiP E{WSP<bf16>(F, WS_P), IN_(F, 21) + l * 3072};
    pg8::gemm_phase<EpiP, pg8::StaticOrder, true, true>(F.lds, g, S, E);
    if (l == 0 && F.bx >= F.G - 8) hy_filter_item(F, 2, F.bx - (F.G - 8));
    if (l == 0 && F.bx >= 104) tr_deferred(F, 0, 5400, F.bx - 104, 152); }
#ifndef MK_REP2
#define MK_REP2 0u
#endif
PHASE_FN void P_mix(int l) { Frame F = make_frame(); const bool last = (l == 1);
    const int na = last ? 1024 : 1088;
    for (int rep = 0; rep < ((MK_REP2 & 1u) ? 2 : 1); ++rep)
    for (int it = F.bx; it < na; it += F.G) attn_unit(F, l, it);
    for (int rep = 0; rep < ((MK_REP2 & 2u) ? 2 : 1); ++rep)
    for (int it = F.G - 1 - F.bx; it < 1088; it += F.G) ret_kv_unit(F, l, it);
    for (int rep = 0; rep < ((MK_REP2 & 4u) ? 2 : 1); ++rep) ph_hyprep2(F, l, !last); }

PHASE_FN void P_hyconv(int l) { Frame F = make_frame(); const bool last = (l == 1);
    for (int rep = 0; rep < ((MK_REP2 & 8u) ? 2 : 1); ++rep) ret_scan(F, l);
    { FftTw T; fft_tw_init(T, F.tid); unsigned zpa[8], zpb[8];
      fft_zfetch(F, F.bx, F.tid, zpa); fft_zfetch(F, F.bx + F.G, F.tid, zpb);
      for (int rep = 0; rep < ((MK_REP2 & 16u) ? 2 : 1); ++rep)
      for (int it = F.bx; it < 2048; it += 2 * F.G) { const int na = (it + 2 * F.G < 2048) ? it + 2 * F.G : F.bx, nb = (it + 3 * F.G < 2048) ? it + 3 * F.G : F.bx + F.G;
          fft_conv_pair(F, T, l, it, it + F.G, na, nb, zpa, zpb); } }
    if (!last) for (int it = F.bx; it < 512; it += F.G) hyconv_ctx_item2(F, it); }
PHASE_FN void P_hypost(int l) { Frame F = make_frame(); const bool last = (l == 1);
    for (int rep = 0; rep < ((MK_REP2 & 32u) ? 2 : 1); ++rep)
    for (int it = F.bx; it < 1088; it += F.G) { const int ci = it % 34; if (last && ci < 2) continue; ret_out_unit(F, l, it); }
    for (int rep = 0; rep < ((MK_REP2 & 64u) ? 2 : 1); ++rep) ph_hypost2(F, l, !last); }
PHASE_FN void P_merge(int l) { Frame F = make_frame(); const int mrows = (l == 1) ? NLAT : NROWS;
    pg8::Gemm g{WSP<bf16>(F, WS_RET), WSP<bf16>(F, WS_WBR) + (size_t)l * 1024 * 1536, mrows, 1024, 1536};
    pg8::StaticOrder S; S.init(mrows, 1024, F.G, F.bx);
    EpiMerge E{WSP<bf16>(F, WS_P), WSP<bf16>(F, WS_M)};
    pg8::gemm_phase<EpiMerge, pg8::StaticOrder, true, true>(F.lds, g, S, E);
    if (l == 0 && F.bx >= 32) tr_deferred(F, 5400, 11300, F.bx - 32, 224); }
PHASE_FN void P_out(int l) { Frame F = make_frame(); const int mrows = (l == 1) ? NLAT : NROWS;
    pg8::Gemm g{WSP<bf16>(F, WS_M), WSP<bf16>(F, WS_WOUT) + (size_t)l * 1024 * 1024, mrows, 1024, 1024};
    pg8::StaticOrder S; S.init(mrows, 1024, F.G, F.bx);
    const float* xl = (l == 0) ? IN_(F, 0) : WSP<float>(F, WS_XO);
    const float* xc = (l == 0) ? IN_(F, 2) : WSP<float>(F, WS_XO) + (size_t)NLAT * DM;
    EpiOut E{xl, xc, mod_ptr(F, l, 0, 2), WSP<float>(F, WS_XM)};
    pg8::gemm_phase<EpiOut, pg8::StaticOrder, true, true>(F.lds, g, S, E);
    if (l == 0 && F.bx >= 32) tr_deferred(F, 16700, TRD_TOTAL - 16700, F.bx - 32, 224); }
PHASE_FN void P_router(int l) { Frame F = make_frame(); ph_norm2_router(F, l, (l == 1) ? NLAT : NROWS); }
PHASE_FN void P_assign(int l) { Frame F = make_frame(); ph_moe_assign(F, (l == 1) ? NLAT : NROWS); }
PHASE_FN void P_moe1(int l) { Frame F = make_frame();
    LAS int* list = (LAS int*)(F.lds + LDSX + 256);
    const int n = moe_list_units(F, 8, list);
    LAS int* srcl = (LAS int*)(F.lds + LDS_SRC);
    { const int* SRC = WSP<int>(F, WS_SRC);
      for (int i = F.tid; i < n * 256; i += NTHR) srcl[i] = SRC[list[2 * (i >> 8)] * 256 + (i & 255)]; }
    __syncthreads();
    pg8::Gemm g{WSP<bf16>(F, WS_XN), WSP<bf16>(F, WS_W1) + (size_t)l * 32 * 2048 * 1024, MPAD, 32 * 2048, 1024};
    phase_stagger(F);
    MoeOrderG S{srcl, list, n};
    EpiMoe1 E{IN_(F, 27) + (size_t)l * 32 * 2048, WSP<bf16>(F, WS_ACT)};
    pg8::gemm_phase<EpiMoe1, MoeOrderG, true, true>(F.lds, g, S, E); }
PHASE_FN void P_moe2(int l) { Frame F = make_frame();
    LAS int* list = (LAS int*)(F.lds + LDSX + 256);
    const int n = moe_list_units(F, 4, list);
    pg8::Gemm g{WSP<bf16>(F, WS_ACT), WSP<bf16>(F, WS_W2) + (size_t)l * 32 * 1024 * 1024, MPAD, 32 * 1024, 1024};
    phase_stagger(F);
    MoeOrder S{nullptr, list, n};
    EpiMoe2 E{IN_(F, 29) + (size_t)l * 32 * 1024, WSP<bf16>(F, WS_HS)};
    pg8::gemm_phase<EpiMoe2, MoeOrder, true, true>(F.lds, g, S, E); }

template <int ONLY> __global__ void __launch_bounds__(NTHR, 2) mk_fwd(Args args) {
    LAS unsigned char* lds = (LAS unsigned char*)lds_raw;
    const int tid = threadIdx.x;
    for (int u = tid; u < (LDS_BYTES - LDSX) / 4; u += NTHR) ((LAS unsigned*)(lds + LDSX))[u] = 0u;
    __syncthreads();
    if (tid < 33) { const unsigned long long v = (tid < 31) ? (unsigned long long)args.in[tid] : (tid == 31 ? (unsigned long long)args.out : (unsigned long long)args.ws);
        *(LAS unsigned long long*)(lds + LDS_PTAB + 8 * tid) = v; }
    __syncthreads();
    const int lo = args.ph_lo, hi = args.ph_hi;
    const bool one_launch = (hi - lo) > 1;
    unsigned* barw = (unsigned*)(args.ws + WS_CTL + CTL_BAR);
    XcdBarrier bar; bar.bar = barw; bar.x = 0; bar.st = nullptr;
    if (one_launch) bar = xcd_barrier_post(barw, (volatile LAS unsigned*)(lds + LDSX));
#ifndef MK_MASK
#define MK_MASK 0xFFFFFFFFu
#endif
#define ENAB(k) ((ONLY < 0 && ((MK_MASK >> ((k) >= 100 ? (k) - 100 + 14 : (k))) & 1u)) || ONLY == (k))
#ifndef MK_REP
#define MK_REP 0u
#endif
#define REPB(k) (((MK_REP) >> ((k) >= 100 ? (k) - 100 + 14 : (k))) & 1u)
#define IN(k) (lo <= (k) && (k) < hi)
#define SEAM(k) do { if (IN(k) && IN((k) + 1)) xcd_barrier(bar); } while (0)
    if (ENAB(100)) if (IN(0)) { P_prologue(); if (REPB(100)) { xcd_barrier(bar); P_prologue(); } } SEAM(0);
    for (int l = 0; l < 2; ++l) {
        const int pb = 1 + NPH_LAYER * l;
        if (ENAB(0)) if (IN(pb + 0)) { P_norm1(l == 0 ? 0 : 1); if (REPB(0)) { xcd_barrier(bar); P_norm1(l == 0 ? 0 : 1); } } SEAM(pb + 0);
        if (ENAB(1)) if (IN(pb + 1)) { P_inproj(l); if (REPB(1)) { xcd_barrier(bar); P_inproj(l); } } SEAM(pb + 1);
        if (ENAB(3)) if (IN(pb + 3)) { P_mix(l); if (REPB(3)) { xcd_barrier(bar); P_mix(l); } } SEAM(pb + 3);
        if (ENAB(4)) if (IN(pb + 4)) { P_hyconv(l); if (REPB(4)) { xcd_barrier(bar); P_hyconv(l); } } SEAM(pb + 4);
        if (ENAB(5)) if (IN(pb + 5)) { P_hypost(l); if (REPB(5)) { xcd_barrier(bar); P_hypost(l); } } SEAM(pb + 5);
        if (ENAB(6)) if (IN(pb + 6)) { P_merge(l); if (REPB(6)) { xcd_barrier(bar); P_merge(l); } } SEAM(pb + 6);
        if (ENAB(9)) if (IN(pb + 9)) { P_out(l); if (REPB(9)) { xcd_barrier(bar); P_out(l); } } SEAM(pb + 9);
        if (ENAB(10)) if (IN(pb + 10)) { P_router(l); if (REPB(10)) { xcd_barrier(bar); P_router(l); } } SEAM(pb + 10);
        if (ENAB(11)) if (IN(pb + 11)) { P_assign(l); if (REPB(11)) { xcd_barrier(bar); P_assign(l); } } SEAM(pb + 11);
        if (ENAB(12)) if (IN(pb + 12)) { P_moe1(l); if (REPB(12)) { xcd_barrier(bar); P_moe1(l); } } SEAM(pb + 12);
        if (ENAB(13)) if (IN(pb + 13)) { P_moe2(l); if (REPB(13)) { xcd_barrier(bar); P_moe2(l); } } SEAM(pb + 13);
    }
    if (ENAB(101)) if (IN(NPH - 1)) { P_norm1(2); }
#undef IN
#undef SEAM
#undef ENAB
}

template <int ONLY> static void launch_phase(Args a, int lo, int hi, int grid, hipStream_t stream) {
    static bool attr_set = false;
    if (!attr_set) { (void)hipFuncSetAttribute((const void*)mk_fwd<ONLY>, hipFuncAttributeMaxDynamicSharedMemorySize, LDS_BYTES); attr_set = true; }
    a.ph_lo = lo; a.ph_hi = hi;
    hipLaunchKernelGGL(mk_fwd<ONLY>, dim3(grid), dim3(NTHR), LDS_BYTES, stream, a);
}
extern "C" void kernel_launch(void* const* d_in, const int* in_sizes, int n_in, void* d_out, int out_size, void* d_ws, size_t ws_size, hipStream_t stream) {
    static int grid = 0;
    if (grid == 0) {
        if (n_in != 31 || ws_size < WS_END) { fprintf(stderr, "kernel_launch: unexpected n_in %d / ws_size %zu\n", n_in, ws_size); grid = -1; return; }
        int dev = 0, cus = 0;
        if (hipGetDevice(&dev) != hipSuccess || hipDeviceGetAttribute(&cus, hipDeviceAttributeMultiprocessorCount, dev) != hipSuccess) { grid = -1; return; }
        grid = (cus == 256) ? 256 : -1;
        if (grid < 0) { fprintf(stderr, "kernel_launch: needs a 256-CU device, got %d\n", cus); return; }
    }
    if (grid < 0) return;
    (void)hipMemsetAsync((char*)d_ws + WS_CTL, 0, CTL_ZERO_BYTES, stream);
    Args a{};
    for (int i = 0; i < 31; ++i) a.in[i] = (const float*)d_in[i];
    a.out = (float*)d_out; a.ws = (unsigned char*)d_ws;
#if MK_ONE_LAUNCH
    launch_phase<-1>(a, 0, NPH, grid, stream);
#else
    launch_phase<100>(a, 0, 1, grid, stream);
    for (int l = 0; l < 2; ++l) {
        const int pb = 1 + NPH_LAYER * l;
        launch_phase<0>(a, pb + 0, pb + 1, grid, stream);   launch_phase<1>(a, pb + 1, pb + 2, grid, stream);   launch_phase<2>(a, pb + 2, pb + 3, grid, stream);
        launch_phase<3>(a, pb + 3, pb + 4, grid, stream);   launch_phase<4>(a, pb + 4, pb + 5, grid, stream);   launch_phase<5>(a, pb + 5, pb + 6, grid, stream);
        launch_phase<6>(a, pb + 6, pb + 7, grid, stream);   launch_phase<7>(a, pb + 7, pb + 8, grid, stream);   launch_phase<8>(a, pb + 8, pb + 9, grid, stream);
        launch_phase<9>(a, pb + 9, pb + 10, grid, stream);  launch_phase<10>(a, pb + 10, pb + 11, grid, stream); launch_phase<11>(a, pb + 11, pb + 12, grid, stream);
        launch_phase<12>(a, pb + 12, pb + 13, grid, stream); launch_phase<13>(a, pb + 13, pb + 14, grid, stream);
    }
    launch_phase<101>(a, NPH - 1, NPH, grid, stream);
#endif
}
```

```cpp
#include <hip/hip_runtime.h>
#include <cstdio>
#include <cstdint>
#define MK_ONE_LAUNCH 1
namespace pg8 {
#define PG8_LAS __attribute__((address_space(3)))
typedef unsigned short bf16_t;
typedef short bf16x8 __attribute__((ext_vector_type(8)));
typedef float f32x4 __attribute__((ext_vector_type(4)));
typedef unsigned u32x4 __attribute__((ext_vector_type(4)));
constexpr int BM = 256, BK = 64, HALF = 128, HTB = HALF * BK * 2  , STAGE_BYTES = 8 * HTB, NXCD = 8, WGM = 8;

__host__ __device__ __forceinline__ int lds_byte(int r, int c) { const int st = (r >> 4) * 2 + (c >> 5), rr = r & 15, cc = c & 31, ob = rr * 64 + cc * 2; return st * 1024 + (ob ^ (((ob >> 9) & 1) << 5)); }
__host__ __device__ __forceinline__ void stage_rc(int b, int& R, int& C) { const int st = b / 1024, sb = b % 1024, swz = sb ^ (((sb >> 9) & 1) << 5); R = (st >> 1) * 16 + swz / 64; C = (st & 1) * 32 + (swz % 64) / 2; }
__host__ __device__ __forceinline__ int perm32(int rho) { const int n = rho >> 4, i = rho & 15; return 8 * (i >> 2) + 4 * n + (i & 3); }

struct Unit { int pm, pn; };
struct Gemm { const bf16_t* A; const bf16_t* Bt; int M, N, K; };

struct StaticOrder {
    static constexpr bool GATHER = false; const PG8_LAS int* src;
    int nM, nN, nwg, G, c;
    __host__ __device__ void init(int M, int N, int G_, int c_) { nM = M / BM; nN = N / BM; nwg = nM * nN; G = G_; c = c_; }
    __host__ __device__ bool next(int i, Unit& u) const {
        const long L = (long)i * G + c; if (L >= nwg) return false;
        int wgid = (int)L; { const int q = nwg / NXCD, r = nwg % NXCD, xcd = wgid % NXCD, off = wgid / NXCD; wgid = (xcd < r ? xcd * (q + 1) : r * (q + 1) + (xcd - r) * q) + off; }
        const int nig = WGM * nN, gid = wgid / nig, fm = gid * WGM, gsz = (nM - fm) < WGM ? (nM - fm) : WGM;
        u.pm = fm + ((wgid % nig) % gsz); u.pn = (wgid % nig) / gsz; return true;
    }
    __device__ __forceinline__ void a_ready(const Unit&) const {}
    __device__ __forceinline__ void done(const Unit&) const {}
};

__device__ __forceinline__ unsigned cvt_pk_bf16(float lo, float hi) { unsigned r; asm("v_cvt_pk_bf16_f32 %0, %1, %2" : "=v"(r) : "v"(lo), "v"(hi));     return r; }
template <class Epi, class Sched, bool ALIGN_EPI = false, bool SP2 = false>
__device__ __forceinline__ void gemm_phase(PG8_LAS unsigned char* lds, const Gemm g, const Sched& S, const Epi& E) {
    int tid_ = threadIdx.x; asm volatile("" : "+v"(tid_));
    const int tid = tid_, wid = __builtin_amdgcn_readfirstlane(tid >> 6), lane = tid & 63, wr = wid >> 2, wc = wid & 3, fr = lane & 15, fq = lane >> 4;
    const int K = g.K, nt = K / BK;
    unsigned voffA[2], voffB[2];
#pragma unroll
    for (int i = 0; i < 2; ++i) { int R, C; stage_rc(tid * 16 + i * 8192, R, C); const int Rb = Epi::PERM ? ((R & ~31) + perm32(R & 31)) : R;
        voffA[i] = (unsigned)(R * K + C) * 2u; voffB[i] = (unsigned)(Rb * K + C) * 2u; }
    constexpr bool GATHER = Sched::GATHER;
    static_assert(!GATHER || SP2, "the gathered A path is wired into the SP2 loop only");
    unsigned vAc[2][2], vAn[2][2];
#define PG8_GIDX(dst, ord) do { _Pragma("unroll") for (int _h = 0; _h < 2; ++_h) _Pragma("unroll") for (int _i = 0; _i < 2; ++_i) { int _R, _C; stage_rc(tid * 16 + _i * 8192, _R, _C); \
        dst[_h][_i] = (unsigned)S.src[(ord) * 256 + _h * 128 + _R] * (unsigned)(K * 2) + (unsigned)(_C * 2); } } while (0)
    const size_t kstep = (size_t)(BK * 2);
    const size_t hstep = (size_t)HALF * K * 2;
    const size_t tstep = 2 * hstep;
    const unsigned ldsw = (unsigned)wid * 1024u;
    const int aoff = lds_byte(wr * 64 + fr, fq * 8), boff = lds_byte(wc * 32 + fr, fq * 8);
#define PG8_SA(b, h) (((b) * 2 + (h)) * HTB)
#define PG8_SB(b, h) ((4 + (b) * 2 + (h)) * HTB)
#define PG8_STAGE(bufoff, gbase, voff) do { _Pragma("unroll") for (int _i = 0; _i < 2; ++_i) \
        __builtin_amdgcn_global_load_lds((const unsigned*)((const char*)(gbase) + (voff)[_i]), (PG8_LAS unsigned*)(lds + (bufoff) + ldsw + _i * 8192), 16, 0, 0); } while (0)
#define PG8_STAGE_A(bufoff, gbase, h, vg) do { if constexpr (GATHER) { PG8_STAGE(bufoff, gbase, (vg)[h]); } else { PG8_STAGE(bufoff, (gbase) + ((h) ? hstep : 0), voffA); } } while (0)
#define PG8_LDA(dst, b, h) do { _Pragma("unroll") for (int m = 0; m < 4; ++m) _Pragma("unroll") for (int k = 0; k < 2; ++k) dst[m][k] = *(const PG8_LAS bf16x8*)(lds + PG8_SA(b, h) + aoff + m * 2048 + k * 1024); } while (0)
#define PG8_LDB(dst, b, h) do { _Pragma("unroll") for (int n = 0; n < 2; ++n) _Pragma("unroll") for (int k = 0; k < 2; ++k) dst[n][k] = *(const PG8_LAS bf16x8*)(lds + PG8_SB(b, h) + boff + n * 2048 + k * 1024); } while (0)
#define PG8_MMA(ai, bj, At, Bt) do { __builtin_amdgcn_s_setprio(1); _Pragma("unroll") for (int m = 0; m < 4; ++m) _Pragma("unroll") for (int n = 0; n < 2; ++n) _Pragma("unroll") for (int k = 0; k < 2; ++k) \
        acc[ai][bj][m][n] = __builtin_amdgcn_mfma_f32_16x16x32_bf16(Bt[n][k], At[m][k], acc[ai][bj][m][n], 0, 0, 0); __builtin_amdgcn_s_setprio(0); } while (0)
#define PG8_WAIT_V(n) asm volatile("s_waitcnt vmcnt(" #n ")" ::: "memory")
#define PG8_WAIT_L(n) asm volatile("s_waitcnt lgkmcnt(" #n ")" ::: "memory")
#define PG8_BAR __builtin_amdgcn_s_barrier()
#define PG8_SCHED __builtin_amdgcn_sched_barrier(0)
    Unit cur, nxt; int ui = 0;
    if (!S.next(0, cur)) return;
    f32x4 acc[2][2][4][2];
#pragma unroll
    for (int a = 0; a < 2; ++a)
#pragma unroll
        for (int b = 0; b < 2; ++b)
#pragma unroll
            for (int m = 0; m < 4; ++m)
#pragma unroll
                for (int n = 0; n < 2; ++n) acc[a][b][m][n] = (f32x4){0.f, 0.f, 0.f, 0.f};
    bf16x8 At[4][2], B0[2][2], B1[2][2];
    const char* cA = (const char*)g.A + (GATHER ? (size_t)0 : (size_t)cur.pm * tstep); const char* cB = (const char*)g.Bt + (size_t)cur.pn * tstep;
    S.a_ready(cur);
    if constexpr (GATHER) { PG8_GIDX(vAc, 0); }
    if constexpr (SP2) {
        PG8_STAGE(PG8_SB(0, 0), cB, voffB); PG8_STAGE(PG8_SB(0, 1), cB + hstep, voffB); PG8_STAGE_A(PG8_SA(0, 0), cA, 0, vAc); PG8_STAGE_A(PG8_SA(0, 1), cA, 1, vAc);
        if (wr == 1) PG8_BAR;
        PG8_WAIT_V(2); PG8_BAR;
        PG8_STAGE(PG8_SB(1, 0), cB + kstep, voffB); PG8_STAGE_A(PG8_SA(1, 0), cA + kstep, 0, vAc); PG8_STAGE(PG8_SB(1, 1), cB + hstep + kstep, voffB);
        PG8_WAIT_V(6); PG8_BAR;
    } else {
        PG8_STAGE(PG8_SB(0, 0), cB, voffB); PG8_STAGE(PG8_SA(0, 0), cA, voffA); PG8_STAGE(PG8_SB(0, 1), cB + hstep, voffB); PG8_STAGE(PG8_SA(0, 1), cA + hstep, voffA);
        if (wr == 1) PG8_BAR;
        PG8_WAIT_V(4); PG8_BAR;
        PG8_STAGE(PG8_SB(1, 0), cB + kstep, voffB); PG8_STAGE(PG8_SA(1, 0), cA + kstep, voffA); PG8_STAGE(PG8_SB(1, 1), cB + hstep + kstep, voffB);
        PG8_WAIT_V(6); PG8_BAR;
    }
    for (;;) {
        const bool has_next = S.next(ui + 1, nxt);
        if constexpr (GATHER) { if (has_next) { PG8_GIDX(vAn, ui + 1); } else { _Pragma("unroll") for (int _h = 0; _h < 2; ++_h) _Pragma("unroll") for (int _i = 0; _i < 2; ++_i) vAn[_h][_i] = vAc[_h][_i]; } }
        const char* nA = GATHER ? cA : (has_next ? (const char*)g.A + (size_t)nxt.pm * tstep : cA); const char* nB = has_next ? (const char*)g.Bt + (size_t)nxt.pn * tstep : cB;
        for (int t = 0; t < nt; t += 2) {
            if constexpr (Epi::KMID) { if (t == 8 || t == 16) E.kmid(t, acc, cur, wr, wc, fr, fq); }
            const bool last = (t == nt - 2);
            const char* a1 = cA + (size_t)(t + 1) * kstep;
            const char* a2 = last ? nA : cA + (size_t)(t + 2) * kstep; const char* b2 = last ? nB : cB + (size_t)(t + 2) * kstep;
            const char* a3 = a2 + kstep; const char* b3 = b2 + kstep;
            if (last && has_next) S.a_ready(nxt);
            unsigned v2[2][2];
            if constexpr (GATHER) { _Pragma("unroll") for (int _h = 0; _h < 2; ++_h) _Pragma("unroll") for (int _i = 0; _i < 2; ++_i) v2[_h][_i] = last ? vAn[_h][_i] : vAc[_h][_i]; }
            if constexpr (SP2) {
            PG8_LDB(B0, 0, 0); PG8_LDB(B1, 0, 1); PG8_SCHED; PG8_LDA(At, 0, 0); PG8_STAGE_A(PG8_SA(1, 1), a1, 1, vAc);
            PG8_WAIT_V(8); PG8_WAIT_L(0); PG8_BAR; PG8_MMA(0, 0, At, B0); PG8_MMA(0, 1, At, B1); PG8_BAR; PG8_SCHED;
            PG8_LDA(At, 0, 1); PG8_STAGE(PG8_SB(0, 0), b2, voffB); PG8_STAGE(PG8_SB(0, 1), b2 + hstep, voffB); PG8_STAGE_A(PG8_SA(0, 0), a2, 0, v2);
            PG8_WAIT_V(8); PG8_WAIT_L(0); PG8_BAR; PG8_MMA(1, 0, At, B0); PG8_MMA(1, 1, At, B1); PG8_BAR; PG8_SCHED;
            PG8_LDB(B0, 1, 0); PG8_LDB(B1, 1, 1); PG8_SCHED; PG8_LDA(At, 1, 0); PG8_STAGE_A(PG8_SA(0, 1), a2, 1, v2);
            PG8_WAIT_V(8); PG8_WAIT_L(0); PG8_BAR; PG8_MMA(0, 0, At, B0); PG8_MMA(0, 1, At, B1); PG8_BAR; PG8_SCHED;
            PG8_LDA(At, 1, 1); PG8_STAGE(PG8_SB(1, 0), b3, voffB); PG8_STAGE(PG8_SB(1, 1), b3 + hstep, voffB); PG8_STAGE_A(PG8_SA(1, 0), a3, 0, v2);
            PG8_WAIT_V(8); PG8_WAIT_L(0); PG8_BAR; PG8_MMA(1, 0, At, B0); PG8_MMA(1, 1, At, B1); PG8_BAR; PG8_SCHED;
            } else {
            PG8_LDB(B0, 0, 0); PG8_SCHED; PG8_LDA(At, 0, 0); PG8_STAGE(PG8_SA(1, 1), a1 + hstep, voffA);
            PG8_WAIT_L(8); PG8_BAR; PG8_WAIT_L(0); PG8_MMA(0, 0, At, B0); PG8_BAR; PG8_SCHED;
            PG8_LDB(B1, 0, 1); PG8_STAGE(PG8_SB(0, 0), b2, voffB);
            PG8_BAR; PG8_WAIT_L(0); PG8_MMA(0, 1, At, B1); PG8_BAR;
            PG8_LDA(At, 0, 1); PG8_STAGE(PG8_SA(0, 0), a2, voffA);
            PG8_BAR; PG8_WAIT_L(0); PG8_MMA(1, 0, At, B0); PG8_BAR; PG8_SCHED;
            PG8_STAGE(PG8_SB(0, 1), b2 + hstep, voffB);
            PG8_WAIT_V(6); PG8_BAR; PG8_MMA(1, 1, At, B1); PG8_BAR;
            PG8_LDB(B0, 1, 0); PG8_SCHED; PG8_LDA(At, 1, 0); PG8_STAGE(PG8_SA(0, 1), a2 + hstep, voffA);
            PG8_WAIT_L(8); PG8_BAR; PG8_WAIT_L(0); PG8_MMA(0, 0, At, B0); PG8_BAR; PG8_SCHED;
            PG8_LDB(B1, 1, 1); PG8_STAGE(PG8_SB(1, 0), b3, voffB);
            PG8_BAR; PG8_WAIT_L(0); PG8_MMA(0, 1, At, B1); PG8_BAR;
            PG8_LDA(At, 1, 1); PG8_STAGE(PG8_SA(1, 0), a3, voffA);
            PG8_BAR; PG8_WAIT_L(0); PG8_MMA(1, 0, At, B0); PG8_BAR; PG8_SCHED;
            PG8_STAGE(PG8_SB(1, 1), b3 + hstep, voffB);
            PG8_WAIT_V(6); PG8_BAR; PG8_MMA(1, 1, At, B1); PG8_BAR;
            }
        }
        if constexpr (ALIGN_EPI) { if (wr == 0) PG8_BAR; }
        if constexpr (!Epi::AFTER_DRAIN) { E(acc, cur, wr, wc, fr, fq);
#ifdef MK_EPI2
            asm volatile("" ::: "memory"); E(acc, cur, wr, wc, fr, fq);
#endif
#ifdef MK_EPI3
            { char* sp = (char*)MK_EPI3_BASE + (size_t)blockIdx.x * 131072 + (size_t)wid * 16384 + (size_t)lane * 16;
              _Pragma("unroll") for (int q_ = 0; q_ < 16; ++q_) { u32x4 w_; w_.x = __float_as_uint(acc[q_ >> 3][(q_ >> 2) & 1][q_ & 3][0][0]); w_.y = __float_as_uint(acc[q_ >> 3][(q_ >> 2) & 1][q_ & 3][0][1]); w_.z = __float_as_uint(acc[q_ >> 3][(q_ >> 2) & 1][q_ & 3][1][0]); w_.w = __float_as_uint(acc[q_ >> 3][(q_ >> 2) & 1][q_ & 3][1][1]);
                  *(u32x4*)(sp + q_ * 1024) = w_; } }
#endif
            S.done(cur); }
        if (!has_next) break;
#pragma unroll
        for (int a = 0; a < 2; ++a)
#pragma unroll
            for (int b = 0; b < 2; ++b)
#pragma unroll
                for (int m = 0; m < 4; ++m)
#pragma unroll
                    for (int n = 0; n < 2; ++n) acc[a][b][m][n] = (f32x4){0.f, 0.f, 0.f, 0.f};
        cur = nxt; cA = nA; cB = nB; ++ui;
        if constexpr (GATHER) { _Pragma("unroll") for (int _h = 0; _h < 2; ++_h) _Pragma("unroll") for (int _i = 0; _i < 2; ++_i) vAc[_h][_i] = vAn[_h][_i]; }
        if constexpr (ALIGN_EPI) { if (wr == 1) PG8_BAR; }
    }
    PG8_WAIT_V(0);
    if constexpr (!ALIGN_EPI) { if (wr == 0) PG8_BAR; }
    PG8_BAR;
    if constexpr (Epi::AFTER_DRAIN) { E.fused(acc, cur, wr, wc, fr, fq, lds, wid, lane); S.done(cur); }
#undef PG8_SA
#undef PG8_SB
#undef PG8_STAGE
#undef PG8_STAGE_A
#undef PG8_GIDX
#undef PG8_LDA
#undef PG8_LDB
#undef PG8_MMA
#undef PG8_WAIT_V
#undef PG8_WAIT_L
#undef PG8_BAR
#undef PG8_SCHED
}
}
#define XB_TMO      128
#define XB_XCNT(j)  (256  + 64 * (j))
#define XB_XSUB(j)  (1280 + 64 * (j))
#define XB_XGEN(j)  (2304 + 64 * (j))
#define XB_TOP      3328
#define XB_TOPGEN   3392
#define XCD_BAR_WORDS 3456
#define XB_SPIN_CAP (1u << 18)
#define LAS __attribute__((address_space(3)))

__device__ __forceinline__ unsigned xb_ld(unsigned* p)              { return __hip_atomic_load(p, __ATOMIC_RELAXED, __HIP_MEMORY_SCOPE_AGENT); }
__device__ __forceinline__ unsigned xb_add(unsigned* p, unsigned v) { return __hip_atomic_fetch_add(p, v, __ATOMIC_RELAXED, __HIP_MEMORY_SCOPE_AGENT); }
__device__ __forceinline__ unsigned xb_xcc_id() { return (unsigned)__builtin_amdgcn_s_getreg((3 << 11) | 20) & 0xFu; }
#define XB_SPIN(cond, bar) do { unsigned _sp = 0; while (cond) { __builtin_amdgcn_s_sleep(1); \
    if ((++_sp & 255u) == 0u) { if (xb_ld(&(bar)[XB_TMO])) break; if (_sp > XB_SPIN_CAP) { atomicAdd(&(bar)[XB_TMO], 1u); break; } } } } while (0)

struct XcdBarrier {
    unsigned* bar; unsigned x;
    volatile LAS unsigned* st;
};

__device__ __forceinline__ XcdBarrier xcd_barrier_post(unsigned* bar, volatile LAS unsigned* st) {
    XcdBarrier b; b.bar = bar; b.x = xb_xcc_id(); b.st = st;
    if (threadIdx.x == 0) (void)xb_add(&bar[XB_XCNT(b.x)], 1u);
    return b;
}
__device__ __forceinline__ void xcd_barrier_complete(unsigned* bar, unsigned x, unsigned& nloc, unsigned& nx) {
    const unsigned G = gridDim.x * gridDim.y * gridDim.z;
    unsigned sum, cnt, mine, sp = 0u;
    for (;;) {
        sum = 0u; cnt = 0u; mine = 0u;
#pragma unroll
        for (unsigned j = 0; j < 16; ++j) { const unsigned c = xb_ld(&bar[XB_XCNT(j)]); sum += c; cnt += (c > 0u) ? 1u : 0u; mine = (j == x) ? c : mine; }
        if (sum == G) break;
        __builtin_amdgcn_s_sleep(1);
        if ((++sp & 255u) == 0u) { if (xb_ld(&bar[XB_TMO])) break; if (sp > XB_SPIN_CAP) { atomicAdd(&bar[XB_TMO], 1u); break; } }
    }
    nloc = mine > 0u ? mine : 1u; nx = cnt > 0u ? cnt : 1u;
}

__device__ __forceinline__ void xcd_barrier(const XcdBarrier& b) {
    asm volatile("s_waitcnt vmcnt(0)" ::: "memory");
    __syncthreads();
    if (threadIdx.x == 0) {
        unsigned* bar = b.bar;
        __builtin_amdgcn_s_waitcnt(0);
        unsigned nloc = b.st[0], nx = b.st[1];
        if (nloc == 0u) { xcd_barrier_complete(bar, b.x, nloc, nx); b.st[0] = nloc; b.st[1] = nx; }
        const unsigned old = xb_add(&bar[XB_XSUB(b.x)], 1u);
        const unsigned gen = old / nloc;
        if (old + 1u == (gen + 1u) * nloc) {
            __builtin_amdgcn_fence(__ATOMIC_RELEASE, "agent");
            asm volatile("s_waitcnt vmcnt(0)" ::: "memory");
            const unsigned og = xb_add(&bar[XB_TOP], 1u);
            const unsigned tg = og / nx;
            if (og + 1u == (tg + 1u) * nx) xb_add(&bar[XB_TOPGEN], 1u);
            else XB_SPIN(xb_ld(&bar[XB_TOPGEN]) == tg, bar);
            __builtin_amdgcn_fence(__ATOMIC_ACQUIRE, "agent");
            xb_add(&bar[XB_XGEN(b.x)], 1u);
            asm volatile("s_waitcnt vmcnt(0)" ::: "memory");
        } else {
            XB_SPIN(xb_ld(&bar[XB_XGEN(b.x)]) == gen, bar);
            __builtin_amdgcn_fence(__ATOMIC_ACQUIRE, "agent");
            asm volatile("s_waitcnt vmcnt(0)" ::: "memory");
        }
    }
    __syncthreads();
}

#define GAS __attribute__((address_space(1)))
typedef unsigned short bf16;
typedef float f32x4 __attribute__((ext_vector_type(4)));
typedef unsigned u32x4 __attribute__((ext_vector_type(4)));
typedef unsigned u32x2 __attribute__((ext_vector_type(2)));
constexpr int DM = 1024, NB = 8, SEQ = 4096, CTXL = 256, NLAT = NB * SEQ, NCTX = NB * CTXL, NROWS = NLAT + NCTX;
constexpr int INC = 7424;
constexpr int C_RQ = 0, C_RK = 512, C_RV = 1024, C_RG = 1536, C_AQ = 2048, C_AK = 2560, C_AV = 2688, C_HU = 2816, C_MG = 4352;
constexpr int NEXP = 32, DFF = 1024;
constexpr int MPAD = 147456;
constexpr float EPS = 1e-6f;
constexpr int NWAVES = 8, NTHR = 512;
constexpr int LDS_BYTES = 163840, LDSX = 155648, LDS_SRC = 131072;
constexpr int NPH_LAYER = 14, NPH = 1 + 2 * NPH_LAYER + 1;

constexpr size_t MiB = 1u << 20;
constexpr size_t WS_CTL = 0, CTL_ZERO_BYTES = 32768;
constexpr size_t CTL_BAR = 16384;
constexpr size_t CTL_MOD = 262144;
constexpr size_t WS_SRC = 6 * MiB;
constexpr size_t WS_L1P = 5 * MiB;
constexpr size_t WS_TOPI = 1 * MiB, WS_TOPW = 2 * MiB, WS_POS = 3 * MiB, WS_BLKCNT = 4 * MiB, WS_TILES = 4 * MiB + 65536;
constexpr size_t WS_WIN = 8 * MiB, WS_WBR = 37 * MiB, WS_WOUT = 43 * MiB, WS_W1 = 48 * MiB, WS_W2 = 304 * MiB;
constexpr size_t WS_HF = 432 * MiB;
constexpr size_t WS_HFC = 464 * MiB;
constexpr size_t WS_XM = 466 * MiB, WS_XO = 602 * MiB, WS_XN = 738 * MiB;
constexpr size_t WS_A = 806 * MiB;
constexpr size_t WS_P = WS_A, WS_RET = WS_A + 494 * MiB, WS_ATT = WS_RET + 34 * MiB, WS_HY = WS_ATT + 34 * MiB;
constexpr size_t WS_HS = WS_A, WS_ACT = WS_A + 288 * MiB;
constexpr size_t WS_MF32 = 1406 * MiB, WS_M = 1542 * MiB;
constexpr size_t WS_ZT = 1610 * MiB, WS_ZTC = 1674 * MiB, WS_YT = 1678 * MiB, WS_YTC = 1742 * MiB;
constexpr size_t WS_KV = 1746 * MiB, WS_SP = 1882 * MiB, WS_HSPEC = 1950 * MiB, WS_END = 2014 * MiB;
static_assert(WS_HY + 34 * MiB <= WS_MF32 && WS_ACT + 288 * MiB <= WS_MF32, "region A");
static_assert((size_t)NROWS * INC * 2 <= 494 * MiB, "P size");

__device__ __forceinline__ float bf2f(bf16 v) { return __uint_as_float(((unsigned)v) << 16); }
__device__ __forceinline__ bf16 f2bf(float f) { unsigned u = __float_as_uint(f); u += 0x7FFFu + ((u >> 16) & 1u); return (bf16)(u >> 16); }
__device__ __forceinline__ unsigned pk2(float lo, float hi) { return pg8::cvt_pk_bf16(lo, hi); }
#define WS_DPP(v, ctrl) __int_as_float(__builtin_amdgcn_update_dpp(0, __float_as_int(v), (ctrl), 0xF, 0xF, false))
__device__ __forceinline__ float wave_sum(float v) {
    v += WS_DPP(v, 0xB1);
    v += WS_DPP(v, 0x4E);
    v += WS_DPP(v, 0x124);
    v += WS_DPP(v, 0x128);
    const float s0 = __int_as_float(__builtin_amdgcn_readlane(__float_as_int(v), 0)), s1 = __int_as_float(__builtin_amdgcn_readlane(__float_as_int(v), 16));
    const float s2 = __int_as_float(__builtin_amdgcn_readlane(__float_as_int(v), 32)), s3 = __int_as_float(__builtin_amdgcn_readlane(__float_as_int(v), 48));
    return (s0 + s1) + (s2 + s3);
}
__device__ __forceinline__ float rdlane(float v, int l) { return __int_as_float(__builtin_amdgcn_readlane(__float_as_int(v), l)); }
__device__ __forceinline__ float sin_rev(float rev) { return __builtin_amdgcn_sinf(__builtin_amdgcn_fractf(rev)); }
__device__ __forceinline__ float cos_rev(float rev) { return __builtin_amdgcn_cosf(__builtin_amdgcn_fractf(rev)); }
__device__ __forceinline__ float sin_rad(float x) { return sin_rev(x * 0.15915494309189535f); }
__device__ __forceinline__ float sigmoidf_(float x) { return 1.0f / (1.0f + __expf(-x)); }
__device__ __forceinline__ float siluf_(float x) { return x / (1.0f + __expf(-x)); }
__device__ __forceinline__ float log_sigmoid_(float x) {
    const float y = __expf(-x);
    if (y < 0.1f) { return -(y * (1.0f + y * (-0.5f + y * (0.33333333f + y * (-0.25f + y * (0.2f + y * (-0.16666667f + y * (0.14285714f + y * (-0.125f))))))))); }
    return -logf(1.0f + y);
}
#define LDS_WAIT() asm volatile("s_waitcnt lgkmcnt(0)" ::: "memory")
#define VM_WAIT() asm volatile("s_waitcnt vmcnt(0)" ::: "memory")

struct Args { const float* in[31]; float* out; unsigned char* ws; int ph_lo, ph_hi; };

extern __shared__ __attribute__((aligned(16))) unsigned char lds_raw[];
constexpr int LDS_PTAB = LDSX + 1024;
struct Frame {
    LAS unsigned char* lds;
    int tid, lane, wave, G, bx;
    unsigned char* ws;
};
__device__ __forceinline__ unsigned long long ptab_read(int i) {
    const LAS unsigned* p = (const LAS unsigned*)((LAS unsigned char*)lds_raw + LDS_PTAB) + 2 * i;
    const unsigned lo = (unsigned)__builtin_amdgcn_readfirstlane((int)p[0]), hi = (unsigned)__builtin_amdgcn_readfirstlane((int)p[1]);
    return ((unsigned long long)hi << 32) | lo;
}
__device__ __forceinline__ const float* IN_(const Frame& F, int i) { return (const float*)(const GAS float*)ptab_read(i); }
__device__ __forceinline__ float* OUT_(const Frame& F) { return (float*)(GAS float*)ptab_read(31); }
__device__ __forceinline__ Frame make_frame() {
    Frame F; F.lds = (LAS unsigned char*)lds_raw;
    int t = threadIdx.x; asm volatile("" : "+v"(t)); F.tid = t; F.lane = t & 63; F.wave = __builtin_amdgcn_readfirstlane(t >> 6);
    int g = gridDim.x, bx = blockIdx.x; asm volatile("" : "+s"(g), "+s"(bx)); F.G = g; F.bx = bx;
    unsigned long long w = ptab_read(32); asm volatile("" : "+s"(w)); F.ws = (unsigned char*)(GAS unsigned char*)w; return F;
}
template <class T> __device__ __forceinline__ T* WSP(const Frame& F, size_t off) { return (T*)(F.ws + off); }
__device__ __forceinline__ const float* mod_ptr(const Frame& F, int l, int modrow, int chunk) { return WSP<float>(F, WS_CTL + CTL_MOD) + ((size_t)(l * 9 + modrow) * 6 + chunk) * DM; }
__device__ __forceinline__ int modrow_of(int r) { return r < NLAT ? (r >> 12) : 8; }

constexpr int TRP = 65;
__device__ __forceinline__ void tr_item(const float* W, int K, int N, bf16* WT, int ldk, int item, int w1map, LAS float* scr, int lane) {
    const int nblk = N >> 6, kb = item / nblk, nb = item - kb * nblk, k0 = 64 * kb, n0 = 64 * nb;
    const int r = lane >> 4, cq = lane & 15;
    const float* src = W + (size_t)(k0 + r) * N + n0 + 4 * cq;
#pragma unroll 1
    for (int hh = 0; hh < 2; ++hh) {
        f32x4 v[8];
#pragma unroll
        for (int i = 0; i < 8; ++i) v[i] = *(const f32x4*)(src + (size_t)(4 * (8 * hh + i)) * N);
#pragma unroll
        for (int i = 0; i < 8; ++i) { LAS float* d = scr + (4 * (8 * hh + i) + r) * TRP + 4 * cq; d[0] = v[i][0]; d[1] = v[i][1]; d[2] = v[i][2]; d[3] = v[i][3]; }
    }
    LDS_WAIT(); asm volatile("" ::: "memory");
    int r0 = n0;
    if (w1map == 1) r0 = (n0 < 1024) ? ((n0 >> 7) * 256 + (n0 & 127)) : ((((n0 - 1024) >> 7) * 256) + 128 + ((n0 - 1024) & 127));
    const int kc = lane & 7;
#pragma unroll
    for (int j = 0; j < 8; ++j) { const int n = (lane >> 3) + 8 * j; const LAS float* s = scr + (8 * kc) * TRP + n;
        u32x4 o; o.x = pk2(s[0 * TRP], s[1 * TRP]); o.y = pk2(s[2 * TRP], s[3 * TRP]); o.z = pk2(s[4 * TRP], s[5 * TRP]); o.w = pk2(s[6 * TRP], s[7 * TRP]);
        int row = r0 + n;
        if (w1map == 2) {
            const int c = n0 + n;
            if (c < 1024) row = (c & ~255) + ((c >> 6) & 1) * 128 + ((c >> 7) & 1) * 64 + (c & 63);
            else if (c >= C_AQ && c < C_AV) { const int d = c & 63, gq = d >> 4, hd = (c >> 6) & 3; row = (c & ~255) + (gq & 1) * 128 + hd * 32 + (gq >> 1) * 16 + (d & 15); }
            else if (c >= C_AV && c < C_HU) { const int jv = c - C_AV; row = C_AK + (jv >> 6) * 128 + 64 + (jv & 63); }
        }
        *(u32x4*)(WT + (size_t)row * ldk + k0 + 8 * kc) = o; }
    LDS_WAIT(); asm volatile("" ::: "memory");
}

__device__ __forceinline__ void hy_filter_item(Frame& F, int f, int tb) {
    const int lane = F.lane;
    float* L1P = WSP<float>(F, WS_L1P);
    LAS float* H2 = (LAS float*)F.lds + 16384;
    LAS float* red = H2 + 32 * 64;
    const int L = (f == 2) ? 256 : 4096, l = (f == 1) ? 1 : 0;
    const float* w1 = IN_(F, 12) + l * 33 * 64; const float* b1 = IN_(F, 13) + l * 64; const float* f1 = IN_(F, 14) + l * 64;
    const float* w2 = IN_(F, 15) + l * 64 * 64; const float* b2 = IN_(F, 16) + l * 64; const float* f2 = IN_(F, 17) + l * 64;
    const float* w3 = IN_(F, 18) + (size_t)l * 64 * 1024;
    float* HFp = (f == 2) ? WSP<float>(F, WS_HFC) : WSP<float>(F, WS_HF + (size_t)l * 16 * MiB);
    float* HBp = (f == 2) ? WSP<float>(F, WS_HFC + 512 * 1024) : WSP<float>(F, WS_HF + (size_t)l * 16 * MiB + 8 * MiB);
    __syncthreads();
    {
        float w1c[33], w2c[64];
#pragma unroll
        for (int i = 0; i < 33; ++i) w1c[i] = w1[i * 64 + lane];
#pragma unroll
        for (int i = 0; i < 64; ++i) w2c[i] = w2[i * 64 + lane];
        const float b1l = b1[lane], f1l = f1[lane], b2l = b2[lane], f2l = f2[lane];
#pragma unroll 1
        for (int r = 0; r < 4; ++r) {
            const int n = tb * 32 + F.wave * 4 + r;
            float zl = 0.f;
            if (lane == 0) zl = (float)n / (float)(L - 1);
            else if (lane <= 32) { const int j = (lane - 1) & 15; const float band = 1e-4f + (15.0f - 1e-4f) * (float)j / 15.0f; const float rev = (float)n * band / (float)L;
                zl = (lane <= 16) ? cos_rev(rev) : -sin_rev(rev); }
            float a = 0.f;
#pragma unroll
            for (int i = 0; i < 33; ++i) a += rdlane(zl, i) * w1c[i];
            const float h1 = sin_rad(f1l * (a + b1l));
            float a2 = 0.f;
#pragma unroll
            for (int i = 0; i < 64; ++i) a2 += rdlane(h1, i) * w2c[i];
            H2[(F.wave * 4 + r) * 64 + lane] = sin_rad(f2l * (a2 + b2l));
        }
    }
    __syncthreads();
    const int c1 = F.wave * 128 + lane, c2 = c1 + 64;
    float l1p[2] = {0.f, 0.f};
#pragma unroll 1
    for (int rh = 0; rh < 2; ++rh) {
        float acc[16][2];
#pragma unroll
        for (int r = 0; r < 16; ++r) { acc[r][0] = 0.f; acc[r][1] = 0.f; }
#pragma unroll 1
        for (int i = 0; i < 64; i += 4) {
            float wa[4], wb[4];
#pragma unroll
            for (int k = 0; k < 4; ++k) { wa[k] = w3[(i + k) * 1024 + c1]; wb[k] = w3[(i + k) * 1024 + c2]; }
            f32x4 hh[16];
#pragma unroll
            for (int r = 0; r < 16; ++r) hh[r] = *(const LAS f32x4*)(H2 + (rh * 16 + r) * 64 + i);
            __builtin_amdgcn_sched_barrier(0);
#pragma unroll
            for (int r = 0; r < 16; ++r) { const f32x4 h = hh[r];
                acc[r][0] += h[0] * wa[0] + h[1] * wa[1] + h[2] * wa[2] + h[3] * wa[3]; acc[r][1] += h[0] * wb[0] + h[1] * wb[1] + h[2] * wb[2] + h[3] * wb[3]; }
        }
#pragma unroll
        for (int q = 0; q < 2; ++q) {
            const int c = q ? c2 : c1, cc = c & 511;
            const float delta = 3.0701134573253944f + (15.350567286626973f - 3.0701134573253944f) * (float)cc / 511.0f;
            float* dst = ((c < 512) ? HFp : HBp) + (size_t)(tb * 32 + rh * 16) * 512 + cc;
#pragma unroll
            for (int r = 0; r < 16; ++r) { const int n = tb * 32 + rh * 16 + r; const float tn = (float)n / (float)(L - 1); const float v = acc[r][q] * __expf(-tn * delta);
                dst[r * 512] = v;
                if (c < 512 || n >= 1) l1p[q] += fabsf(v); }
        }
    }
    red[c1] = l1p[0]; red[c2] = l1p[1];
    __syncthreads();
    L1P[(size_t)(f * 128 + tb) * 512 + F.tid] = red[F.tid] + red[512 + F.tid];
}
__device__ __forceinline__ void p0_prologue(Frame& F) {
    LAS float* scr = (LAS float*)(F.lds + F.wave * (64 * TRP * 4));
    const int gw = F.bx * NWAVES + F.wave, NGW = F.G * NWAVES, lane = F.lane;
    constexpr int I_WIN = 16 * 116, I_WBR = 8 * 16, I_WOUT = 16 * 16, I_W1 = 16 * 32, I_W2 = 16 * 16;
    constexpr int N_WIN = 2 * I_WIN, N_WBR = 6 * I_WBR, N_WOUT = 2 * I_WOUT, N_W1 = 32 * I_W1, N_W2 = 32 * I_W2;
    constexpr int NTR = N_WIN + N_WBR + N_WOUT + N_W1 + N_W2;
#pragma unroll 1
    for (int it = gw; it < NTR; it += NGW) {
        int r = it; const float* W; bf16* WT; int K, N, item, w1map = 0, ldk = 1024;
        if (r < N_WIN) { const int l = r / I_WIN; W = IN_(F, 7) + (size_t)l * 1024 * INC; K = 1024; N = INC; WT = WSP<bf16>(F, WS_WIN) + (size_t)l * INC * 1024; item = r % I_WIN; w1map = 2; }
        else if ((r -= N_WIN) < N_WBR) { const int q = r / I_WBR; W = IN_(F, 20) + (size_t)q * 512 * 1024; K = 512; N = 1024; WT = WSP<bf16>(F, WS_WBR) + (size_t)(q / 3) * 1024 * 1536 + (q % 3) * 512; ldk = 1536; item = r % I_WBR; }
        else if ((r -= N_WBR) < N_WOUT) { const int l = r / I_WOUT; W = IN_(F, 22) + (size_t)l * 1024 * 1024; K = 1024; N = 1024; WT = WSP<bf16>(F, WS_WOUT) + (size_t)l * 1024 * 1024; item = r % I_WOUT; }
        else if ((r -= N_WOUT) < N_W1) { const int q = r / I_W1; W = IN_(F, 26) + (size_t)q * 1024 * 2048; K = 1024; N = 2048; WT = WSP<bf16>(F, WS_W1) + (size_t)q * 2048 * 1024; item = r % I_W1; w1map = 1; }
        else { r -= N_W1; const int q = r / I_W2; W = IN_(F, 28) + (size_t)q * 1024 * 1024; K = 1024; N = 1024; WT = WSP<bf16>(F, WS_W2) + (size_t)q * 1024 * 1024; item = r % I_W2; }
        tr_item(W, K, N, WT, ldk, item, w1map, scr, lane);
    }
#ifndef PRO_B
#define PRO_B 1
#endif
#ifndef PRO_C
#define PRO_C 1
#endif
    __syncthreads();
    if (PRO_B) {
        float* mod = WSP<float>(F, WS_CTL + CTL_MOD);
        LAS float* sc = (LAS float*)F.lds;
        LAS float* red = sc + 1024 * 12;
        if (F.bx < 192) {
            for (int i = F.tid; i < 9 * 1024; i += NTHR) { const int r = i >> 10, k = i & 1023; const float cv = (r < 8) ? IN_(F, 1)[r * 1024 + k] : IN_(F, 3)[k]; sc[k * 12 + r] = siluf_(cv); }
            __syncthreads();
            const int it = F.bx, l = it / 96, cc = it % 96, col = cc * 64 + lane, k0 = F.wave * 128;
            const float* wm = IN_(F, 4) + (size_t)l * 1024 * 6144 + col;
            float acc[9];
#pragma unroll
            for (int r = 0; r < 9; ++r) acc[r] = 0.f;
#pragma unroll 1
            for (int kb = 0; kb < 128; kb += 16) {
                float w[16];
#pragma unroll
                for (int k = 0; k < 16; ++k) w[k] = wm[(size_t)(k0 + kb + k) * 6144];
#pragma unroll
                for (int k = 0; k < 16; ++k) { const LAS float* s = sc + (k0 + kb + k) * 12; const f32x4 s0 = *(const LAS f32x4*)s, s1 = *(const LAS f32x4*)(s + 4); const float s8 = s[8];
                    acc[0] += s0[0] * w[k]; acc[1] += s0[1] * w[k]; acc[2] += s0[2] * w[k]; acc[3] += s0[3] * w[k];
                    acc[4] += s1[0] * w[k]; acc[5] += s1[1] * w[k]; acc[6] += s1[2] * w[k]; acc[7] += s1[3] * w[k]; acc[8] += s8 * w[k]; }
            }
#pragma unroll
            for (int r = 0; r < 9; ++r) red[(F.wave * 9 + r) * 64 + lane] = acc[r];
            __syncthreads();
            for (int idx = F.tid; idx < 576; idx += NTHR) { const int r = idx >> 6, c = idx & 63; float s = 0.f;
#pragma unroll
                for (int w = 0; w < 8; ++w) s += red[(w * 9 + r) * 64 + c];
                mod[(size_t)(l * 9 + r) * 6144 + cc * 64 + c] = s + IN_(F, 5)[l * 6144 + cc * 64 + c]; }
        }
    }
    if (PRO_C) {
#pragma unroll 1
        for (int it = F.bx; it < 256; it += F.G) hy_filter_item(F, it >> 7, it & 127);
    }
}
constexpr int TRD_TOTAL = 32 * 512 + 32 * 256;
__device__ __forceinline__ void tr_deferred(Frame& F, int first, int count, int rank, int nblk) {
    LAS float* scr = (LAS float*)(F.lds + F.wave * (64 * TRP * 4));
    __syncthreads();
#pragma unroll 1
    for (int d = first + rank * NWAVES + F.wave; d < first + count; d += nblk * NWAVES) {
        if (d < 32 * 512) { const int q = 32 + (d >> 9); tr_item(IN_(F, 26) + (size_t)q * 1024 * 2048, 1024, 2048, WSP<bf16>(F, WS_W1) + (size_t)q * 2048 * 1024, 1024, d & 511, 1, scr, F.lane); }
        else { const int dd = d - 32 * 512, q = 32 + (dd >> 8); tr_item(IN_(F, 28) + (size_t)q * 1024 * 1024, 1024, 1024, WSP<bf16>(F, WS_W2) + (size_t)q * 1024 * 1024, 1024, dd & 255, 0, scr, F.lane); }
    }
}
__device__ __forceinline__ float hy_inv_l1(const Frame& F, int f, int c) {
    const float* L1P = WSP<float>(F, WS_L1P) + (size_t)f * 128 * 512 + c; const int nb = (f == 2) ? 8 : 128; const int lane = F.lane;
    float s = (lane < nb ? L1P[(size_t)lane * 512] : 0.f) + (lane + 64 < nb ? L1P[(size_t)(lane + 64) * 512] : 0.f);
    return 1.0f / wave_sum(s);
}

__device__ __forceinline__ void ph_norm1(Frame& F, int mode) {
    const int gw = F.bx * NWAVES + F.wave, NGW = F.G * NWAVES, lane = F.lane;
    const int nrows = (mode == 2) ? NLAT : NROWS;
    const int l = (mode == 0) ? 0 : 1;
    const bf16* Y = WSP<bf16>(F, WS_HS);
    const int* POS = WSP<int>(F, WS_POS); const float* TOPW = WSP<float>(F, WS_TOPW);
    f32x4 xnext[4]; int pnext[4]; float wnext[4];
#define N1_FETCH(r_) do { const int rf_ = (r_); \
        const float* xr_ = (mode == 0) ? ((rf_ < NLAT) ? IN_(F, 0) + (size_t)rf_ * DM : IN_(F, 2) + (size_t)(rf_ - NLAT) * DM) : (WSP<float>(F, WS_XM) + (size_t)rf_ * DM); \
        _Pragma("unroll") for (int j = 0; j < 4; ++j) xnext[j] = *(const f32x4*)(xr_ + 4 * lane + 256 * j); \
        if (mode != 0) { _Pragma("unroll") for (int k = 0; k < 4; ++k) { pnext[k] = POS[rf_ * 4 + k]; wnext[k] = TOPW[rf_ * 4 + k]; } } } while (0)
    if (gw < nrows) N1_FETCH(gw);
#pragma unroll 1
    for (int r = gw; r < nrows; r += NGW) {
        const int mr = modrow_of(r);
        f32x4 v[4];
        if (mode == 0) {
#pragma unroll
            for (int j = 0; j < 4; ++j) v[j] = xnext[j];
            if (r + NGW < nrows) N1_FETCH(r + NGW);
        } else {
            f32x4 xcur[4]; int pc[4]; float wc[4];
#pragma unroll
            for (int j = 0; j < 4; ++j) xcur[j] = xnext[j];
#pragma unroll
            for (int k = 0; k < 4; ++k) { pc[k] = pnext[k]; wc[k] = wnext[k]; }
            u32x2 yv[4][4];
#pragma unroll
            for (int k = 0; k < 4; ++k) { const bf16* yr = Y + (size_t)pc[k] * DM;
#pragma unroll
                for (int j = 0; j < 4; ++j) yv[k][j] = *(const u32x2*)(yr + 4 * lane + 256 * j); }
            if (r + NGW < nrows) N1_FETCH(r + NGW);
            f32x4 s[4];
#pragma unroll
            for (int j = 0; j < 4; ++j) s[j] = (f32x4){0.f, 0.f, 0.f, 0.f};
#pragma unroll
            for (int k = 0; k < 4; ++k) { const float w = wc[k];
#pragma unroll
                for (int j = 0; j < 4; ++j) { const u32x2 y2 = yv[k][j];
                    s[j][0] += w * __uint_as_float(y2.x << 16); s[j][1] += w * __uint_as_float(y2.x & 0xffff0000u);
                    s[j][2] += w * __uint_as_float(y2.y << 16); s[j][3] += w * __uint_as_float(y2.y & 0xffff0000u); } }
            const float* g2l = mod_ptr(F, (mode == 2) ? 1 : 0, mr, 5);
#pragma unroll
            for (int j = 0; j < 4; ++j) { const f32x4 g = *(const f32x4*)(g2l + 4 * lane + 256 * j); v[j] = xcur[j] + g * s[j]; }
            if (mode == 1) { float* xo = WSP<float>(F, WS_XO) + (size_t)r * DM;
#pragma unroll
                for (int j = 0; j < 4; ++j) *(f32x4*)(xo + 4 * lane + 256 * j) = v[j]; }
        }
        float ss = 0.f;
#pragma unroll
        for (int j = 0; j < 4; ++j) ss += (v[j][0] * v[j][0] + v[j][1] * v[j][1]) + (v[j][2] * v[j][2] + v[j][3] * v[j][3]);
        const float rstd = 1.0f / sqrtf(wave_sum(ss) * (1.0f / DM) + EPS);
        if (mode == 2) {
            const float* fg = IN_(F, 30); float* o = OUT_(F) + (size_t)r * DM;
#pragma unroll
            for (int j = 0; j < 4; ++j) { const f32x4 g = *(const f32x4*)(fg + 4 * lane + 256 * j); *(f32x4*)(o + 4 * lane + 256 * j) = v[j] * rstd * g; }
        } else {
            const float* gw_ = IN_(F, 6) + l * DM; const float* sh = mod_ptr(F, l, mr, 0); const float* sc = mod_ptr(F, l, mr, 1);
            bf16* o = WSP<bf16>(F, WS_XN) + (size_t)r * DM;
#pragma unroll
            for (int j = 0; j < 4; ++j) { const f32x4 g = *(const f32x4*)(gw_ + 4 * lane + 256 * j); const f32x4 a = *(const f32x4*)(sh + 4 * lane + 256 * j); const f32x4 b = *(const f32x4*)(sc + 4 * lane + 256 * j);
                const f32x4 y = v[j] * rstd * g * (b + 1.0f) + a;
                u32x2 w2; w2.x = pk2(y[0], y[1]); w2.y = pk2(y[2], y[3]); *(u32x2*)(o + 4 * lane + 256 * j) = w2; }
        }
    }
#undef N1_FETCH
}

struct EpiP {
    static constexpr bool PERM = true, AFTER_DRAIN = false, KMID = false; static constexpr int NSTORE = 16;
    bf16* O; const float* bg;
    __device__ __forceinline__ static void st8(bf16* p, const float (&v)[8]) { u32x4 w; w.x = pk2(v[0], v[1]); w.y = pk2(v[2], v[3]); w.z = pk2(v[4], v[5]); w.w = pk2(v[6], v[7]); *(u32x4*)p = w; }
    __device__ __forceinline__ void operator()(const f32x4 (&acc)[2][2][4][2], const pg8::Unit& u, int wr, int wc, int fr, int fq) const {
        const int row0 = u.pm * 256 + wr * 64 + fr, pn = u.pn;
        const bool rot = u.pm < (NLAT / 256);
        const bool is_ret = pn < 4, is_aq = (pn == 8 || pn == 9), is_akv = (pn == 10);
        if (!(is_ret || is_aq || is_akv) || (is_akv && wc >= 2)) {
            const int colA = is_akv ? (C_AV + (wc - 2) * 32 + 8 * fq) : (pn * 256 + wc * 32 + 8 * fq), colB = is_akv ? (colA + 64) : (colA + 128);
            f32x4 ba0 = (f32x4){0.f, 0.f, 0.f, 0.f}, ba1 = ba0, bb0 = ba0, bb1 = ba0;
            if (pn >= 17) { ba0 = *(const f32x4*)(bg + colA - C_MG); ba1 = *(const f32x4*)(bg + colA - C_MG + 4); bb0 = *(const f32x4*)(bg + colB - C_MG); bb1 = *(const f32x4*)(bg + colB - C_MG + 4); }
#pragma unroll
            for (int ai = 0; ai < 2; ++ai)
#pragma unroll
                for (int m = 0; m < 4; ++m) { bf16* rowp = O + (size_t)(row0 + ai * 128 + m * 16) * INC;
                    float a[8], b[8];
#pragma unroll
                    for (int j = 0; j < 4; ++j) { a[j] = acc[ai][0][m][0][j] + ba0[j]; a[4 + j] = acc[ai][0][m][1][j] + ba1[j]; b[j] = acc[ai][1][m][0][j] + bb0[j]; b[4 + j] = acc[ai][1][m][1][j] + bb1[j]; }
                    if (pn >= 17) {
                        typedef float f32x2 __attribute__((ext_vector_type(2)));
#pragma unroll
                        for (int j = 0; j < 8; j += 2) { f32x2 za = {a[j], a[j + 1]}, zb = {b[j], b[j + 1]}; za = za * -1.4426950408889634f; zb = zb * -1.4426950408889634f;
                            za.x = __builtin_amdgcn_exp2f(za.x); za.y = __builtin_amdgcn_exp2f(za.y); zb.x = __builtin_amdgcn_exp2f(zb.x); zb.y = __builtin_amdgcn_exp2f(zb.y);
                            za = za + 1.0f; zb = zb + 1.0f;
                            a[j] = fminf(za.x, 1.0e30f); a[j + 1] = fminf(za.y, 1.0e30f); b[j] = fminf(zb.x, 1.0e30f); b[j + 1] = fminf(zb.y, 1.0e30f); } }
                    st8(rowp + colA, a); st8(rowp + colB, b); asm volatile("" ::: "memory"); }
            return;
        }
        int col1, col2, ibase; float fexp; bool use_col = false;
        if (is_ret) { const int hd = wc >> 1; ibase = (wc & 1) * 32 + 8 * fq; col1 = pn * 256 + hd * 128 + ibase; col2 = col1 + 64; fexp = 13.287712379549449f / 63.0f; }
        else { const int rc = fq >> 1; ibase = 8 * (fq & 1); const int hb = is_aq ? (pn * 256 + wc * 64) : (C_AK + wc * 64); col1 = hb + rc * 32 + ibase; col2 = col1 + 16; fexp = 13.287712379549449f / 16.0f; use_col = rc != 0; }
        float invf[8];
#pragma unroll
        for (int k = 0; k < 8; ++k) invf[k] = __builtin_amdgcn_exp2f(-(float)(ibase + k) * fexp) * 0.15915494309189535f;
#pragma unroll
        for (int ai = 0; ai < 2; ++ai)
#pragma unroll
            for (int m = 0; m < 4; ++m) { const int row = row0 + ai * 128 + m * 16; bf16* rowp = O + (size_t)row * INC;
                const int t = row & 4095;
                const float pos = is_ret ? (float)t : (use_col ? (float)(t & 63) : (float)(t >> 6));
                float o1[8], o2[8];
#pragma unroll
                for (int k = 0; k < 8; ++k) { const float x1 = acc[ai][0][m][k >> 2][k & 3], x2 = acc[ai][1][m][k >> 2][k & 3];
                    float cs = 1.0f, sn = 0.0f;
                    if (rot) { const float rev = pos * invf[k]; cs = cos_rev(rev); sn = sin_rev(rev); }
                    o1[k] = x1 * cs - x2 * sn; o2[k] = x1 * sn + x2 * cs; }
                st8(rowp + col1, o1); st8(rowp + col2, o2); asm volatile("" ::: "memory"); }
    }
};
struct EpiMerge {
    static constexpr bool PERM = true, AFTER_DRAIN = false, KMID = true; static constexpr int NSTORE = 16;
    const bf16* P; bf16* Mo;
    typedef float f32x2 __attribute__((ext_vector_type(2)));
    __device__ __forceinline__ static f32x2 g2(unsigned w) { f32x2 r; r.x = __uint_as_float(w << 16); r.y = __uint_as_float(w & 0xffff0000u); return r; }
    struct Batch { u32x4 gn[2][2], go[2][2]; };
    __device__ __forceinline__ void fetch(Batch& B, int row0, unsigned col0, unsigned g_old, int ai, int mh) const {
#pragma unroll
        for (int mm = 0; mm < 2; ++mm) { const unsigned rowb = (unsigned)(row0 + ai * 128 + (2 * mh + mm) * 16) * (unsigned)(INC * 2);
#pragma unroll
            for (int bj = 0; bj < 2; ++bj) { const unsigned c = col0 + bj * 128;
                B.gn[mm][bj] = *(const u32x4*)((const char*)P + rowb + (C_MG + (g_old + 1) * 1024 + c) * 2); B.go[mm][bj] = *(const u32x4*)((const char*)P + rowb + (C_MG + g_old * 1024 + c) * 2); } }
    }
    __device__ __forceinline__ static void apply(const Batch& B, f32x4 (&acc)[2][2][4][2], int ai, int mh) {
#pragma unroll
        for (int mm = 0; mm < 2; ++mm)
#pragma unroll
            for (int bj = 0; bj < 2; ++bj) { const unsigned gnw[4] = {B.gn[mm][bj].x, B.gn[mm][bj].y, B.gn[mm][bj].z, B.gn[mm][bj].w}, gow[4] = {B.go[mm][bj].x, B.go[mm][bj].y, B.go[mm][bj].z, B.go[mm][bj].w};
#pragma unroll
                for (int i = 0; i < 4; ++i) { const f32x2 dold = g2(gow[i]); f32x2 ro; ro.x = __builtin_amdgcn_rcpf(dold.x); ro.y = __builtin_amdgcn_rcpf(dold.y);
                    const f32x2 r = g2(gnw[i]) * ro;
                    f32x4& A = acc[ai][bj][2 * mh + mm][i >> 1];
                    if (i & 1) { A.z *= r.x; A.w *= r.y; } else { A.x *= r.x; A.y *= r.y; } } }
    }
    __device__ __forceinline__ void kmid(int t, f32x4 (&acc)[2][2][4][2], const pg8::Unit& u, int wr, int wc, int fr, int fq) const {
        int row0 = u.pm * 256 + wr * 64 + fr; asm volatile("" : "+v"(row0));
        const unsigned col0 = (unsigned)(u.pn * 256 + wc * 32 + 8 * fq), g_old = (t == 8) ? 0u : 1u;
        Batch B0, B1;
        fetch(B0, row0, col0, g_old, 0, 0);
        fetch(B1, row0, col0, g_old, 0, 1); asm volatile("" ::: "memory");
        apply(B0, acc, 0, 0);
        fetch(B0, row0, col0, g_old, 1, 0); asm volatile("" ::: "memory");
        apply(B1, acc, 0, 1);
        fetch(B1, row0, col0, g_old, 1, 1); asm volatile("" ::: "memory");
        apply(B0, acc, 1, 0);
        apply(B1, acc, 1, 1);
    }
    __device__ __forceinline__ void operator()(const f32x4 (&acc)[2][2][4][2], const pg8::Unit& u, int wr, int wc, int fr, int fq) const {
        int row0 = u.pm * 256 + wr * 64 + fr; asm volatile("" : "+v"(row0));
        const unsigned col0 = (unsigned)(u.pn * 256 + wc * 32 + 8 * fq);
        u32x4 gh[2][4][2];
#pragma unroll
        for (int ai = 0; ai < 2; ++ai)
#pragma unroll
            for (int m = 0; m < 4; ++m) { const unsigned rowb = (unsigned)(row0 + ai * 128 + m * 16) * (unsigned)(INC * 2);
#pragma unroll
                for (int bj = 0; bj < 2; ++bj) gh[ai][m][bj] = *(const u32x4*)((const char*)P + rowb + (C_MG + 2048 + col0 + bj * 128) * 2); }
#pragma unroll
        for (int ai = 0; ai < 2; ++ai) {
#pragma unroll
            for (int m = 0; m < 4; ++m) { const unsigned row = (unsigned)(row0 + ai * 128 + m * 16);
#pragma unroll
                for (int bj = 0; bj < 2; ++bj) { float v[8]; const unsigned ghw[4] = {gh[ai][m][bj].x, gh[ai][m][bj].y, gh[ai][m][bj].z, gh[ai][m][bj].w};
#pragma unroll
                    for (int i = 0; i < 4; ++i) { const f32x2 d = g2(ghw[i]); v[2 * i] = acc[ai][bj][m][i >> 1][2 * (i & 1)] * __builtin_amdgcn_rcpf(d.x); v[2 * i + 1] = acc[ai][bj][m][i >> 1][2 * (i & 1) + 1] * __builtin_amdgcn_rcpf(d.y); }
                    u32x4 w; w.x = pk2(v[0], v[1]); w.y = pk2(v[2], v[3]); w.z = pk2(v[4], v[5]); w.w = pk2(v[6], v[7]);
                    *(u32x4*)((char*)Mo + (row * (unsigned)(DM * 2) + (col0 + bj * 128) * 2)) = w; } }
            asm volatile("" ::: "memory"); }
    }
};
struct EpiOut {
    static constexpr bool PERM = false, AFTER_DRAIN = false, KMID = false; static constexpr int NSTORE = 32;
    const float* xlat; const float* xctx; const float* g1base; float* XM;
    __device__ __forceinline__ void operator()(const f32x4 (&acc)[2][2][4][2], const pg8::Unit& u, int wr, int wc, int fr, int fq) const {
        int row0 = u.pm * 256 + wr * 64 + fr; asm volatile("" : "+v"(row0));
        const int col0 = u.pn * 256 + wc * 32 + 4 * fq;
        const bool lat = u.pm < (NLAT / 256);
        const float* xb = lat ? xlat : xctx - (size_t)NLAT * DM;
        const float* g1 = g1base + (size_t)modrow_of(u.pm * 256) * 6 * DM + col0;
        f32x4 gv[2][2];
#pragma unroll
        for (int bj = 0; bj < 2; ++bj)
#pragma unroll
            for (int n = 0; n < 2; ++n) gv[bj][n] = *(const f32x4*)(g1 + bj * 128 + n * 16);
#pragma unroll
        for (int ai = 0; ai < 2; ++ai) {
            f32x4 xv[4][2][2];
#pragma unroll
            for (int m = 0; m < 4; ++m) { const float* xr = xb + (size_t)(row0 + ai * 128 + m * 16) * DM + col0;
#pragma unroll
                for (int bj = 0; bj < 2; ++bj)
#pragma unroll
                    for (int n = 0; n < 2; ++n) xv[m][bj][n] = *(const f32x4*)(xr + bj * 128 + n * 16); }
#pragma unroll
            for (int m = 0; m < 4; ++m) { float* xo = XM + (size_t)(row0 + ai * 128 + m * 16) * DM + col0;
#pragma unroll
                for (int bj = 0; bj < 2; ++bj)
#pragma unroll
                    for (int n = 0; n < 2; ++n) *(f32x4*)(xo + bj * 128 + n * 16) = xv[m][bj][n] + gv[bj][n] * acc[ai][bj][m][n]; }
            asm volatile("" ::: "memory"); }
    }
};
struct EpiMoe1 {
    static constexpr bool PERM = true, AFTER_DRAIN = false, KMID = false; static constexpr int NSTORE = 8;
    const float* b1; bf16* ACT;
    __device__ __forceinline__ void operator()(const f32x4 (&acc)[2][2][4][2], const pg8::Unit& u, int wr, int wc, int fr, int fq) const {
        const int e = u.pn >> 3, p = u.pn & 7;
        const int row0 = u.pm * 256 + wr * 64 + fr, gcol0 = p * 128 + wc * 32 + 8 * fq;
        const float* bb = b1 + (size_t)e * 2048 + gcol0;
        typedef float f32x2 __attribute__((ext_vector_type(2)));
        const f32x4 bgv[2] = {*(const f32x4*)(bb), *(const f32x4*)(bb + 4)};
        const f32x4 blv[2] = {*(const f32x4*)(bb + 1024) + 1.0f, *(const f32x4*)(bb + 1028) + 1.0f};
#pragma unroll
        for (int ai = 0; ai < 2; ++ai)
#pragma unroll
            for (int m = 0; m < 4; ++m) { bf16* rowp = ACT + (size_t)(row0 + ai * 128 + m * 16) * DFF + gcol0;
                unsigned w[4];
#pragma unroll
                for (int n = 0; n < 2; ++n)
#pragma unroll
                    for (int hp = 0; hp < 2; ++hp) {
                        const f32x2 av = hp ? acc[ai][0][m][n].hi : acc[ai][0][m][n].lo, lv = hp ? acc[ai][1][m][n].hi : acc[ai][1][m][n].lo;
                        const f32x2 bg = hp ? bgv[n].hi : bgv[n].lo, bl = hp ? blv[n].hi : blv[n].lo;
                        f32x2 glu = av + bg, lin = lv + bl;
                        glu.x = fminf(glu.x, 7.0f); glu.y = fminf(glu.y, 7.0f);
                        lin.x = __builtin_amdgcn_fmed3f(lin.x, -6.0f, 8.0f); lin.y = __builtin_amdgcn_fmed3f(lin.y, -6.0f, 8.0f);
                        f32x2 ex = glu * -2.4554669595930156f;
                        ex.x = __builtin_amdgcn_exp2f(ex.x); ex.y = __builtin_amdgcn_exp2f(ex.y);
                        ex = ex + 1.0f;
                        ex.x = __builtin_amdgcn_rcpf(ex.x); ex.y = __builtin_amdgcn_rcpf(ex.y);
                        const f32x2 a = (glu * ex) * lin;
                        w[2 * n + hp] = pk2(a.x, a.y); }
                u32x4 wv; wv.x = w[0]; wv.y = w[1]; wv.z = w[2]; wv.w = w[3];
                *(u32x4*)rowp = wv;
                asm volatile("" ::: "memory"); }
    }
};
struct EpiMoe2 {
    static constexpr bool PERM = true, AFTER_DRAIN = false, KMID = false; static constexpr int NSTORE = 16;
    const float* b2; bf16* Y;
    __device__ __forceinline__ void operator()(const f32x4 (&acc)[2][2][4][2], const pg8::Unit& u, int wr, int wc, int fr, int fq) const {
        const int e = u.pn >> 2, p = u.pn & 3;
        const int row0 = u.pm * 256 + wr * 64 + fr, col0 = p * 256 + wc * 32 + 8 * fq;
        f32x4 bv[2][2];
#pragma unroll
        for (int bj = 0; bj < 2; ++bj)
#pragma unroll
            for (int n = 0; n < 2; ++n) bv[bj][n] = *(const f32x4*)(b2 + (size_t)e * 1024 + col0 + bj * 128 + 4 * n);
#pragma unroll
        for (int ai = 0; ai < 2; ++ai)
#pragma unroll
            for (int m = 0; m < 4; ++m) { bf16* rowp = Y + (size_t)(row0 + ai * 128 + m * 16) * DM + col0;
#pragma unroll
                for (int bj = 0; bj < 2; ++bj) { const f32x4 v0 = acc[ai][bj][m][0] + bv[bj][0], v1 = acc[ai][bj][m][1] + bv[bj][1];
                    u32x4 w; w.x = pk2(v0[0], v0[1]); w.y = pk2(v0[2], v0[3]); w.z = pk2(v1[0], v1[1]); w.w = pk2(v1[2], v1[3]);
                    *(u32x4*)(rowp + bj * 128) = w; } }
    }
};
struct MoeOrder {
    static constexpr bool GATHER = false; const LAS int* src;
    const LAS int* list; int n;
    __device__ __forceinline__ bool next(int i, pg8::Unit& u) const { if (i >= n) return false; u.pm = __builtin_amdgcn_readfirstlane(list[2 * i]); u.pn = __builtin_amdgcn_readfirstlane(list[2 * i + 1]); return true; }
    __device__ __forceinline__ void a_ready(const pg8::Unit&) const {}
    __device__ __forceinline__ void done(const pg8::Unit&) const {}
};
struct MoeOrderG {
    static constexpr bool GATHER = true; const LAS int* src;
    const LAS int* list; int n;
    __device__ __forceinline__ bool next(int i, pg8::Unit& u) const { if (i >= n) return false; u.pm = __builtin_amdgcn_readfirstlane(list[2 * i]); u.pn = __builtin_amdgcn_readfirstlane(list[2 * i + 1]); return true; }
    __device__ __forceinline__ void a_ready(const pg8::Unit&) const {}
    __device__ __forceinline__ void done(const pg8::Unit&) const {}
};
__device__ __forceinline__ int moe_list_units(Frame& F, int nN, LAS int* list) {
    const int* tl = WSP<int>(F, WS_TILES);
    const int T = __builtin_amdgcn_readfirstlane(tl[32]);
    const int tlv = tl[F.lane & 31];
    pg8::StaticOrder SO; SO.init(T * 256, nN * 256, F.G, F.bx);
    int n = 0;
#pragma unroll 1
    for (int i = 0;; ++i) {
        pg8::Unit u; if (!SO.next(i, u)) break;
        const int pm = u.pm, pnl = u.pn;
        const int e = __popcll(__ballot(F.lane < 32 && tlv <= pm)) - 1;
        if (F.tid == 0) { list[2 * i] = pm; list[2 * i + 1] = e * nN + pnl; }
        n = i + 1;
    }
    __syncthreads();
    return n;
}


typedef short bf16x8 __attribute__((ext_vector_type(8)));
typedef short bf16x4 __attribute__((ext_vector_type(4)));
constexpr int RLD = 136;
constexpr int RTILE = 128 * RLD * 2;
__device__ __forceinline__ bf16x8 lds_frag16(const LAS bf16* tile, int row0, int k0, int lane) {
    return *(const LAS bf16x8*)(tile + (row0 + (lane & 15)) * RLD + k0 + 8 * (lane >> 4));
}
__device__ __forceinline__ bf16x8 lds_frag16s(const LAS bf16* tile, int row0, int k0, int lane) {
    return *(const LAS bf16x8*)(tile + (row0 + (lane & 15)) * RLD + ((k0 + 8 * (lane >> 4)) ^ ((row0 >> 5) << 4)));
}
__device__ __forceinline__ void lds_frag16x4s(bf16x8 (&f)[4], const LAS bf16* tile, int row0, int lane) {
#pragma unroll
    for (int ks = 0; ks < 4; ++ks) f[ks] = lds_frag16s(tile, row0, 32 * ks, lane);
}
__device__ __forceinline__ void lds_frag16x4(bf16x8 (&f)[4], const LAS bf16* tile, int row0, int lane) {
#pragma unroll
    for (int ks = 0; ks < 4; ++ks) f[ks] = lds_frag16(tile, row0, 32 * ks, lane);
}
__device__ __forceinline__ void ret_unit_decode(int u, int& bh, int& ci, int& rowbase) {
    bh = u / 34; ci = u - bh * 34; const int b = bh >> 2;
    rowbase = (ci < 2) ? (NLAT + b * CTXL + ci * 128) : (b * SEQ + (ci - 2) * 128);
}
__device__ __forceinline__ void ret_load_tile(LAS bf16* tile, const bf16* g, size_t gp, int tid) {
    const int r = tid >> 2, seg = tid & 3;
#pragma unroll
    for (int q = 0; q < 4; ++q) *(LAS u32x4*)(tile + r * RLD + seg * 32 + q * 8) = *(const u32x4*)(g + (size_t)r * gp + seg * 32 + q * 8);
}
__device__ __forceinline__ void ret_kv_unit(Frame& F, int l, int u) {
    const bf16* P = WSP<bf16>(F, WS_P);
    LAS bf16* Ktf = (LAS bf16*)F.lds; LAS bf16* Ktb = Ktf + 128 * RLD; LAS bf16* Vt = Ktb + 128 * RLD;
    int bh, ci, rowbase; ret_unit_decode(u, bh, ci, rowbase);
    const int h = bh & 3, tid = F.tid, lane = F.lane, w = F.wave;
    const float LOG2E = 1.4426950408889634f;
    const float lgf = log_sigmoid_(IN_(F, 8)[l * 8 + h]) * LOG2E, lgb = log_sigmoid_(IN_(F, 8)[l * 8 + 4 + h]) * LOG2E;
    __syncthreads();
    { const int j = tid >> 2, seg = tid & 3;
      const float wf = __builtin_amdgcn_exp2f(lgf * (float)(127 - j)), wb = __builtin_amdgcn_exp2f(lgb * (float)j);
      const bf16* kp = P + (size_t)(rowbase + j) * INC + C_RK + h * 128 + seg * 32; const bf16* vp = P + (size_t)(rowbase + j) * INC + C_RV + h * 128 + seg * 32;
      u32x4 kkv[4], vvv[4];
#pragma unroll
      for (int q = 0; q < 4; ++q) { kkv[q] = *(const u32x4*)(kp + q * 8); vvv[q] = *(const u32x4*)(vp + q * 8); }
      __builtin_amdgcn_sched_barrier(0);
#pragma unroll
      for (int q = 0; q < 4; ++q) { const u32x4 kk = kkv[q], vv = vvv[q];
          const unsigned kw[4] = {kk.x, kk.y, kk.z, kk.w}, vw[4] = {vv.x, vv.y, vv.z, vv.w};
#pragma unroll
          for (int i = 0; i < 4; ++i) { const int d = seg * 32 + q * 8 + 2 * i;
              const float k0 = __uint_as_float(kw[i] << 16), k1 = __uint_as_float(kw[i] & 0xffff0000u);
              const int js = j ^ (seg << 4);
              Ktf[d * RLD + js] = f2bf(k0 * wf); Ktf[(d + 1) * RLD + js] = f2bf(k1 * wf);
              Ktb[d * RLD + js] = f2bf(k0 * wb); Ktb[(d + 1) * RLD + js] = f2bf(k1 * wb);
              Vt[d * RLD + js] = (bf16)(vw[i] & 0xffffu); Vt[(d + 1) * RLD + js] = (bf16)(vw[i] >> 16); } } }
    __syncthreads();
    bf16x8 af[4], ab[4];
#pragma unroll
    for (int ks = 0; ks < 4; ++ks) { af[ks] = lds_frag16s(Ktf, 16 * w, 32 * ks, lane); ab[ks] = lds_frag16s(Ktb, 16 * w, 32 * ks, lane); }
    float* KV = WSP<float>(F, WS_KV) + ((size_t)(bh * 34 + ci) * 2) * 16384;
    const int d0 = 16 * w + 4 * (lane >> 4);
    bf16x8 vf[2][4];
    lds_frag16x4s(vf[0], Vt, 0, lane);
#pragma unroll
    for (int et = 0; et < 8; ++et) {
        if (et + 1 < 8) lds_frag16x4s(vf[(et + 1) & 1], Vt, 16 * (et + 1), lane);
        __builtin_amdgcn_sched_barrier(0);
        f32x4 cf = (f32x4){0.f, 0.f, 0.f, 0.f}, cb = cf;
#pragma unroll
        for (int ks = 0; ks < 4; ++ks) { cf = __builtin_amdgcn_mfma_f32_16x16x32_bf16(af[ks], vf[et & 1][ks], cf, 0, 0, 0); cb = __builtin_amdgcn_mfma_f32_16x16x32_bf16(ab[ks], vf[et & 1][ks], cb, 0, 0, 0); }
        const int e = 16 * et + (lane & 15);
        *(f32x4*)(KV + (size_t)e * 128 + d0) = cf; *(f32x4*)(KV + 16384 + (size_t)e * 128 + d0) = cb;
    }
}
__device__ __forceinline__ void ret_scan(Frame& F, int l) {
    const float* KV = WSP<float>(F, WS_KV); bf16* SP = WSP<bf16>(F, WS_SP);
    const float LOG2E = 1.4426950408889634f;
    const int total = 64 * 4096, stride = F.G * NTHR;
#pragma unroll 1
    for (int idx = F.bx * NTHR + F.tid; idx < total; idx += stride) {
        const int bhd = idx >> 12, elem = (idx & 4095) * 4, bh = bhd >> 1, dir = bhd & 1, h = bh & 3;
        const float cd = __builtin_amdgcn_exp2f(log_sigmoid_(IN_(F, 8)[l * 8 + dir * 4 + h]) * LOG2E * 128.0f);
        const size_t base = ((size_t)bh * 34 * 2 + dir) * 16384 + elem;
        f32x4 s = (f32x4){0.f, 0.f, 0.f, 0.f};
#pragma unroll 1
        for (int half = 0; half < 2; ++half) {
            f32x4 kv[17];
#pragma unroll
            for (int k = 0; k < 17; ++k) { const int st = half * 17 + k; const int ci = dir == 0 ? st : (st == 0 ? 1 : (st == 1 ? 0 : 35 - st)); kv[k] = *(const f32x4*)(KV + base + (size_t)ci * 2 * 16384); }
#pragma unroll
            for (int k = 0; k < 17; ++k) { const int st = half * 17 + k; const int ci = dir == 0 ? st : (st == 0 ? 1 : (st == 1 ? 0 : 35 - st));
                u32x2 o; o.x = pk2(s[0], s[1]); o.y = pk2(s[2], s[3]); *(u32x2*)(SP + base + (size_t)ci * 2 * 16384) = o;
                s = s * cd + kv[k]; }
        }
    }
}
__device__ __forceinline__ void ret_out_unit(Frame& F, int l, int u) {
    const bf16* P = WSP<bf16>(F, WS_P);
    LAS bf16* Qs = (LAS bf16*)F.lds; LAS bf16* Ks = Qs + 128 * RLD; LAS bf16* Vt = Ks + 128 * RLD; LAS bf16* Ps = Vt + 128 * RLD;
    int bh, ci, rowbase; ret_unit_decode(u, bh, ci, rowbase);
    const int h = bh & 3, tid = F.tid, lane = F.lane, w = F.wave;
    const float LOG2E = 1.4426950408889634f;
    const float lgf = log_sigmoid_(IN_(F, 8)[l * 8 + h]) * LOG2E, lgb = log_sigmoid_(IN_(F, 8)[l * 8 + 4 + h]) * LOG2E;
    __syncthreads();
    { const int j = tid >> 2, seg = tid & 3;
      const bf16* qp = P + (size_t)(rowbase + j) * INC + C_RQ + h * 128 + seg * 32; const bf16* kp = P + (size_t)(rowbase + j) * INC + C_RK + h * 128 + seg * 32; const bf16* vp = P + (size_t)(rowbase + j) * INC + C_RV + h * 128 + seg * 32;
      u32x4 qv[4], kv4[4], vv4[4];
#pragma unroll
      for (int q = 0; q < 4; ++q) { qv[q] = *(const u32x4*)(qp + q * 8); kv4[q] = *(const u32x4*)(kp + q * 8); vv4[q] = *(const u32x4*)(vp + q * 8); }
      __builtin_amdgcn_sched_barrier(0);
#pragma unroll
      for (int q = 0; q < 4; ++q) { *(LAS u32x4*)(Qs + j * RLD + seg * 32 + q * 8) = qv[q]; *(LAS u32x4*)(Ks + j * RLD + seg * 32 + q * 8) = kv4[q]; }
#pragma unroll
      for (int q = 0; q < 4; ++q) { const u32x4 vv = vv4[q]; const unsigned vw[4] = {vv.x, vv.y, vv.z, vv.w};
#pragma unroll
          for (int i = 0; i < 4; ++i) { const int d = seg * 32 + q * 8 + 2 * i, js = j ^ (seg << 4); Vt[d * RLD + js] = (bf16)(vw[i] & 0xffffu); Vt[(d + 1) * RLD + js] = (bf16)(vw[i] >> 16); } } }
    u32x4 spre[2][4];
    { const bf16* SPg = WSP<bf16>(F, WS_SP) + ((size_t)(bh * 34 + ci) * 2) * 16384; const int rr = tid >> 2, seg = tid & 3;
#pragma unroll
      for (int dir = 0; dir < 2; ++dir) { const bool zero = (dir == 0) ? (ci == 0) : (ci == 1);
#pragma unroll
          for (int q = 0; q < 4; ++q) spre[dir][q] = zero ? (u32x4){0u, 0u, 0u, 0u} : *(const u32x4*)(SPg + (size_t)dir * 16384 + (size_t)rr * 128 + seg * 32 + q * 8); } }
    __syncthreads();
    const int icol = 16 * w + (lane & 15);
    bf16x8 bq[4];
#pragma unroll
    for (int ks = 0; ks < 4; ++ks) bq[ks] = lds_frag16(Qs, 16 * w, 32 * ks, lane);
    bf16x8 tf[2][4];
    lds_frag16x4(tf[0], Ks, 0, lane);
#pragma unroll
    for (int jt = 0; jt < 8; ++jt) {
        if (jt + 1 < 8) lds_frag16x4(tf[(jt + 1) & 1], Ks, 16 * (jt + 1), lane);
        __builtin_amdgcn_sched_barrier(0);
        f32x4 c = (f32x4){0.f, 0.f, 0.f, 0.f};
#pragma unroll
        for (int ks = 0; ks < 4; ++ks) c = __builtin_amdgcn_mfma_f32_16x16x32_bf16(tf[jt & 1][ks], bq[ks], c, 0, 0, 0);
        const int j0 = 16 * jt + 4 * (lane >> 4);
        float pv[4];
#pragma unroll
        for (int r = 0; r < 4; ++r) { const int dd = icol - (j0 + r); const float dec = dd >= 0 ? __builtin_amdgcn_exp2f(lgf * (float)dd) : __builtin_amdgcn_exp2f(lgb * (float)(-dd)); pv[r] = c[r] * dec; }
        u32x2 pw; pw.x = pk2(pv[0], pv[1]); pw.y = pk2(pv[2], pv[3]);
        *(LAS u32x2*)(Ps + icol * RLD + j0) = pw;
    }
    LDS_WAIT(); asm volatile("" ::: "memory");
    f32x4 acc[8];
    {
        bf16x8 bp[4];
#pragma unroll
        for (int ks = 0; ks < 4; ++ks) bp[ks] = lds_frag16(Ps, 16 * w, 32 * ks, lane);
        lds_frag16x4s(tf[0], Vt, 0, lane);
#pragma unroll
        for (int et = 0; et < 8; ++et) {
            if (et + 1 < 8) lds_frag16x4s(tf[(et + 1) & 1], Vt, 16 * (et + 1), lane);
            __builtin_amdgcn_sched_barrier(0);
            f32x4 c = (f32x4){0.f, 0.f, 0.f, 0.f};
#pragma unroll
            for (int ks = 0; ks < 4; ++ks) c = __builtin_amdgcn_mfma_f32_16x16x32_bf16(tf[et & 1][ks], bp[ks], c, 0, 0, 0);
            acc[et] = c; }
    }
#pragma unroll
    for (int dir = 0; dir < 2; ++dir) {
        const bool zero = (dir == 0) ? (ci == 0) : (ci == 1);
        __syncthreads();
        if (!zero) { const int rr = tid >> 2, seg = tid & 3;
#pragma unroll
            for (int q = 0; q < 4; ++q) *(LAS u32x4*)(Ks + rr * RLD + seg * 32 + q * 8) = spre[dir][q]; }
        __syncthreads();
        if (!zero) {
            const float sc = (dir == 0) ? __builtin_amdgcn_exp2f(lgf * (float)((icol & 127) + 1)) : __builtin_amdgcn_exp2f(lgb * (float)(128 - (icol & 127)));
            lds_frag16x4(tf[0], Ks, 0, lane);
#pragma unroll
            for (int et = 0; et < 8; ++et) {
                if (et + 1 < 8) lds_frag16x4(tf[(et + 1) & 1], Ks, 16 * (et + 1), lane);
                __builtin_amdgcn_sched_barrier(0);
                f32x4 c = (f32x4){0.f, 0.f, 0.f, 0.f};
#pragma unroll
                for (int ks = 0; ks < 4; ++ks) c = __builtin_amdgcn_mfma_f32_16x16x32_bf16(tf[et & 1][ks], bq[ks], c, 0, 0, 0);
                acc[et] = acc[et] + c * sc; }
        }
    }
    const float ksc = 0.08838834764831845f;
    float ss = 0.f;
#pragma unroll
    for (int et = 0; et < 8; ++et) { acc[et] = acc[et] * ksc; ss += (acc[et][0] * acc[et][0] + acc[et][1] * acc[et][1]) + (acc[et][2] * acc[et][2] + acc[et][3] * acc[et][3]); }
    ss += __shfl_xor(ss, 16); ss += __shfl_xor(ss, 32);
    const float rs = 1.0f / sqrtf(ss * (1.0f / 128.0f) + EPS);
    const size_t row = (size_t)(rowbase + icol);
    const bf16* gp = P + row * INC + C_RG + h * 128; bf16* op = WSP<bf16>(F, WS_RET) + row * 1536 + h * 128;
#pragma unroll
    for (int et = 0; et < 8; ++et) { const int e0 = 16 * et + 4 * (lane >> 4);
        const u32x2 g2 = *(const u32x2*)(gp + e0);
        const float g0 = __uint_as_float(g2.x << 16), g1 = __uint_as_float(g2.x & 0xffff0000u), g2f = __uint_as_float(g2.y << 16), g3 = __uint_as_float(g2.y & 0xffff0000u);
        u32x2 o; o.x = pk2(acc[et][0] * rs * siluf_(g0), acc[et][1] * rs * siluf_(g1)); o.y = pk2(acc[et][2] * rs * siluf_(g2f), acc[et][3] * rs * siluf_(g3));
        *(u32x2*)(op + e0) = o; }
}

typedef float f32x2 __attribute__((ext_vector_type(2)));
__device__ __forceinline__ f32x2 cmul_(f32x2 a, f32x2 b) { return (f32x2){a.x * b.x - a.y * b.y, a.x * b.y + a.y * b.x}; }
__device__ __forceinline__ f32x2 cmulc_(f32x2 a, f32x2 b) { return (f32x2){a.x * b.x + a.y * b.y, a.y * b.x - a.x * b.y}; }
__device__ __forceinline__ f32x2 twid_(float rev) { return (f32x2){cos_rev(rev), -sin_rev(rev)}; }
__device__ __forceinline__ int fpad(int n) { return n + (n >> 3); }
template <int R> __device__ __forceinline__ void fft_twiddles(f32x2 (&tw)[R - 1], int t, int s, int M) {
    int o = 0, u = 0;
#pragma unroll
    for (int half = R / 2; half >= 1; half >>= 1) {
        const float invMu = 1.0f / (float)(M >> u);
#pragma unroll
        for (int qq = 0; qq < half; ++qq) tw[o + qq] = twid_((float)(t + qq * s) * invMu);
        o += half; ++u;
    }
}
template <int R, int HALF, int OFF> __device__ __forceinline__ void fft_sub_fwd(f32x2 (&v)[R], const f32x2 (&tw)[R - 1]) {
#pragma unroll
    for (int qq = 0; qq < HALF; ++qq) {
        const f32x2 w = tw[OFF + qq];
#pragma unroll
        for (int g0 = 0; g0 < R; g0 += 2 * HALF) { const f32x2 a = v[g0 + qq], b = v[g0 + qq + HALF]; v[g0 + qq] = a + b; v[g0 + qq + HALF] = cmul_(a - b, w); }
    }
}
template <int R, int HALF, int OFF> __device__ __forceinline__ void fft_sub_inv(f32x2 (&v)[R], const f32x2 (&tw)[R - 1]) {
#pragma unroll
    for (int qq = 0; qq < HALF; ++qq) {
        const f32x2 w = tw[OFF + qq];
#pragma unroll
        for (int g0 = 0; g0 < R; g0 += 2 * HALF) { const f32x2 A = v[g0 + qq], Bp = cmulc_(v[g0 + qq + HALF], w); v[g0 + qq] = A + Bp; v[g0 + qq + HALF] = A - Bp; }
    }
}
template <int R> __device__ __forceinline__ void fft_bf_fwd(f32x2 (&v)[R], const f32x2 (&tw)[R - 1]) {
    if constexpr (R == 16) { fft_sub_fwd<16, 8, 0>(v, tw); fft_sub_fwd<16, 4, 8>(v, tw); fft_sub_fwd<16, 2, 12>(v, tw); fft_sub_fwd<16, 1, 14>(v, tw); }
    else { fft_sub_fwd<8, 4, 0>(v, tw); fft_sub_fwd<8, 2, 4>(v, tw); fft_sub_fwd<8, 1, 6>(v, tw); }
}
template <int R> __device__ __forceinline__ void fft_bf_inv(f32x2 (&v)[R], const f32x2 (&tw)[R - 1]) {
    if constexpr (R == 16) { fft_sub_inv<16, 1, 14>(v, tw); fft_sub_inv<16, 2, 12>(v, tw); fft_sub_inv<16, 4, 8>(v, tw); fft_sub_inv<16, 8, 0>(v, tw); }
    else { fft_sub_inv<8, 1, 6>(v, tw); fft_sub_inv<8, 2, 4>(v, tw); fft_sub_inv<8, 4, 0>(v, tw); }
}
__device__ __forceinline__ void fft_tw_last(f32x2 (&tw)[7]) {
    const float h = 0.70710678118654752f;
    tw[0] = (f32x2){1.f, 0.f}; tw[1] = (f32x2){h, -h}; tw[2] = (f32x2){0.f, -1.f}; tw[3] = (f32x2){-h, -h};
    tw[4] = (f32x2){1.f, 0.f}; tw[5] = (f32x2){0.f, -1.f}; tw[6] = (f32x2){1.f, 0.f};
}
struct FftTw { f32x2 t1[15]; f32x2 t2[2][7]; f32x2 t3[2][7]; };
__device__ __forceinline__ void fft_tw_init(FftTw& T, int tid) {
    fft_twiddles<16>(T.t1, tid, 512, 8192);
#pragma unroll
    for (int it = 0; it < 2; ++it) { const int uu = tid + 512 * it; fft_twiddles<8>(T.t2[it], uu & 63, 64, 512); fft_twiddles<8>(T.t3[it], uu & 7, 8, 64); }
}
template <bool INV, int M> __device__ __forceinline__ void fft_pass8(LAS f32x2* X, int tid, const f32x2 (&tw)[2][7]) {
    asm volatile("" : "+v"(tid));
    constexpr int s = M >> 3;
#pragma unroll
    for (int it = 0; it < 2; ++it) {
        const int uu = tid + 512 * it, blk = uu / s, t = uu - blk * s, n0 = blk * M + t;
        f32x2 v[8];
#pragma unroll
        for (int q = 0; q < 8; ++q) v[q] = X[fpad(n0 + q * s)];
        if (INV) fft_bf_inv<8>(v, tw[it]); else fft_bf_fwd<8>(v, tw[it]);
#pragma unroll
        for (int q = 0; q < 8; ++q) X[fpad(n0 + q * s)] = v[q];
    }
}
__device__ __forceinline__ void fft_filter_unit(Frame& F, const FftTw& T, int l, int c) {
    LAS f32x2* X = (LAS f32x2*)F.lds;
    const float* HFp = WSP<float>(F, WS_HF + (size_t)l * 16 * MiB); const float* HBp = WSP<float>(F, WS_HF + (size_t)l * 16 * MiB + 8 * MiB);
    const float scale = hy_inv_l1(F, l, c) * (1.0f / 8192.0f);
    int tid = F.tid; asm volatile("" : "+v"(tid));
    __syncthreads();
    {   f32x2 v[16];
#pragma unroll
        for (int q = 0; q < 16; ++q) { const int n = tid + 512 * q; float x;
            if (q < 8) x = HFp[(size_t)n * 512 + c]; else x = (n == 4096) ? 0.f : HBp[(size_t)(8192 - n) * 512 + c];
            v[q] = (f32x2){x * scale, 0.f}; }
        fft_bf_fwd<16>(v, T.t1);
#pragma unroll
        for (int q = 0; q < 16; ++q) X[fpad(tid + 512 * q)] = v[q];
    }
    __syncthreads(); fft_pass8<false, 512>(X, tid, T.t2);
    __syncthreads(); fft_pass8<false, 64>(X, tid, T.t3);
    __syncthreads();
    f32x2* Hc = WSP<f32x2>(F, WS_HSPEC) + ((size_t)l * 512 + c) * 8192;
    asm volatile("" : "+v"(tid));
    f32x2 tl[7]; fft_tw_last(tl);
#pragma unroll
    for (int it = 0; it < 2; ++it) {
        const int uu = tid + 512 * it;
        f32x2 v[8];
#pragma unroll
        for (int q = 0; q < 8; ++q) v[q] = X[fpad(8 * uu + q)];
        fft_bf_fwd<8>(v, tl);
#pragma unroll
        for (int q = 0; q < 4; ++q) { f32x4 o; o[0] = v[2 * q].x; o[1] = v[2 * q].y; o[2] = v[2 * q + 1].x; o[3] = v[2 * q + 1].y; *(f32x4*)(Hc + 8 * uu + 2 * q) = o; }
    }
}
__device__ __forceinline__ void fft_zfetch(Frame& F, int unit, int tid, unsigned (&zp)[8]) {
    const bf16* n1 = WSP<bf16>(F, WS_ZT) + ((size_t)(unit >> 2) * NB + 2 * (unit & 3)) * SEQ; const bf16* n2 = n1 + SEQ;
#pragma unroll
    for (int q = 0; q < 8; ++q) { const int n = tid + 512 * q; zp[q] = (unsigned)n1[n] | ((unsigned)n2[n] << 16); }
}
__device__ __forceinline__ void fft_zfetch_raw(Frame& F, int unit, int tid, unsigned (&zr)[16]) {
    const bf16* n1 = WSP<bf16>(F, WS_ZT) + ((size_t)(unit >> 2) * NB + 2 * (unit & 3)) * SEQ; const bf16* n2 = n1 + SEQ;
#pragma unroll
    for (int q = 0; q < 8; ++q) { const int n = tid + 512 * q; zr[q] = (unsigned)n1[n]; zr[8 + q] = (unsigned)n2[n]; }
}
__device__ __forceinline__ void fft_zcombine(unsigned (&zp)[8], const unsigned (&zr)[16]) {
#pragma unroll
    for (int q = 0; q < 8; ++q) zp[q] = zr[q] | (zr[8 + q] << 16);
}
__device__ __forceinline__ void fft_stage_first(LAS f32x2* X, const FftTw& T, int tid, const unsigned (&zp)[8]) {
    f32x2 v[16];
#pragma unroll
    for (int q = 0; q < 8; ++q) v[q] = (f32x2){__uint_as_float(zp[q] << 16), __uint_as_float(zp[q] & 0xffff0000u)};
#pragma unroll
    for (int q = 8; q < 16; ++q) v[q] = (f32x2){0.f, 0.f};
    fft_bf_fwd<16>(v, T.t1);
#pragma unroll
    for (int q = 0; q < 16; ++q) X[fpad(tid + 512 * q)] = v[q];
}
__device__ __forceinline__ void fft_stage_mid(LAS f32x2* X, int tid, const f32x4 (&hp)[2][4]) {
    f32x2 tl[7]; fft_tw_last(tl);
#pragma unroll
    for (int it = 0; it < 2; ++it) {
        const int uu = tid + 512 * it;
        f32x2 v[8];
#pragma unroll
        for (int q = 0; q < 8; ++q) v[q] = X[fpad(8 * uu + q)];
        fft_bf_fwd<8>(v, tl);
#pragma unroll
        for (int q = 0; q < 4; ++q) { const f32x4 h = hp[it][q]; v[2 * q] = cmul_(v[2 * q], (f32x2){h[0], h[1]}); v[2 * q + 1] = cmul_(v[2 * q + 1], (f32x2){h[2], h[3]}); }
        fft_bf_inv<8>(v, tl);
#pragma unroll
        for (int q = 0; q < 8; ++q) X[fpad(8 * uu + q)] = v[q];
    }
}
__device__ __forceinline__ void fft_stage_last(Frame& F, LAS f32x2* X, const FftTw& T, int tid, int unit) {
    f32x2 v[16];
#pragma unroll
    for (int q = 0; q < 16; ++q) v[q] = X[fpad(tid + 512 * q)];
    fft_bf_inv<16>(v, T.t1);
    bf16* y1 = WSP<bf16>(F, WS_YT) + ((size_t)(unit >> 2) * NB + 2 * (unit & 3)) * SEQ; bf16* y2 = y1 + SEQ;
#pragma unroll
    for (int q = 0; q < 8; ++q) { const int n = tid + 512 * q; y1[n] = f2bf(v[q].x); y2[n] = f2bf(v[q].y); }
}
__device__ __forceinline__ void fft_conv_pair(Frame& F, const FftTw& T, int l, int ua, int ub, int na, int nb, unsigned (&zpa)[8], unsigned (&zpb)[8]) {
    LAS f32x2* X0 = (LAS f32x2*)F.lds; LAS f32x2* X1 = X0 + 9216;
    int tid = F.tid; asm volatile("" : "+v"(tid));
    __syncthreads();
    unsigned zra[16], zrb[16];
    fft_stage_first(X0, T, tid, zpa); if (na < 2048) fft_zfetch_raw(F, na, tid, zra);
    fft_stage_first(X1, T, tid, zpb); if (nb < 2048) fft_zfetch_raw(F, nb, tid, zrb);
    __syncthreads(); fft_pass8<false, 512>(X0, tid, T.t2); fft_pass8<false, 512>(X1, tid, T.t2);
    if (na < 2048) fft_zcombine(zpa, zra);
    if (nb < 2048) fft_zcombine(zpb, zrb);
    f32x4 hpa[2][4], hpb[2][4];
    { const f32x2* Ha = WSP<f32x2>(F, WS_HSPEC) + ((size_t)l * 512 + (ua >> 2)) * 8192; const f32x2* Hb = WSP<f32x2>(F, WS_HSPEC) + ((size_t)l * 512 + (ub >> 2)) * 8192;
#pragma unroll
      for (int it = 0; it < 2; ++it)
#pragma unroll
          for (int q = 0; q < 4; ++q) { hpa[it][q] = *(const f32x4*)(Ha + 8 * (tid + 512 * it) + 2 * q); hpb[it][q] = *(const f32x4*)(Hb + 8 * (tid + 512 * it) + 2 * q); } }
    __syncthreads(); fft_pass8<false, 64>(X0, tid, T.t3); fft_pass8<false, 64>(X1, tid, T.t3);
    __syncthreads(); asm volatile("" : "+v"(tid)); fft_stage_mid(X0, tid, hpa); fft_stage_mid(X1, tid, hpb);
    __syncthreads(); fft_pass8<true, 64>(X0, tid, T.t3); fft_pass8<true, 64>(X1, tid, T.t3);
    __syncthreads(); fft_pass8<true, 512>(X0, tid, T.t2); fft_pass8<true, 512>(X1, tid, T.t2);
    __syncthreads(); asm volatile("" : "+v"(tid)); fft_stage_last(F, X0, T, tid, ua); fft_stage_last(F, X1, T, tid, ub);
}

constexpr int HLD = 72;
struct HyRaw { u32x4 c0, c1, c2; };
__device__ __forceinline__ void hy_fetch8(const bf16* P, int base, int t, int L, int ch0, HyRaw& r) {
    const bf16* p1 = P + (size_t)(base + t) * INC + C_HU + ch0;
    const u32x4 zero = (u32x4){0u, 0u, 0u, 0u};
    r.c1 = *(const u32x4*)p1; r.c0 = (t > 0) ? *(const u32x4*)(p1 - INC) : zero; r.c2 = (t + 1 < L) ? *(const u32x4*)(p1 + INC) : zero;
}
__device__ __forceinline__ void hy_conv8(const HyRaw& r, const float (&w)[4][8], float (&out)[8]) {
    const unsigned a0[4] = {r.c0.x, r.c0.y, r.c0.z, r.c0.w}, a1[4] = {r.c1.x, r.c1.y, r.c1.z, r.c1.w}, a2[4] = {r.c2.x, r.c2.y, r.c2.z, r.c2.w};
#pragma unroll
    for (int i = 0; i < 4; ++i) {
        out[2 * i] = w[3][2 * i] + __uint_as_float(a0[i] << 16) * w[0][2 * i] + __uint_as_float(a1[i] << 16) * w[1][2 * i] + __uint_as_float(a2[i] << 16) * w[2][2 * i];
        out[2 * i + 1] = w[3][2 * i + 1] + __uint_as_float(a0[i] & 0xffff0000u) * w[0][2 * i + 1] + __uint_as_float(a1[i] & 0xffff0000u) * w[1][2 * i + 1] + __uint_as_float(a2[i] & 0xffff0000u) * w[2][2 * i + 1];
    }
}
__device__ __forceinline__ void hy_load_w8(const float* cw, const float* cb, int ch0, float (&w)[4][8]) {
#pragma unroll
    for (int i = 0; i < 8; ++i) { w[0][i] = cw[ch0 + i]; w[1][i] = cw[1536 + ch0 + i]; w[2][i] = cw[2 * 1536 + ch0 + i]; w[3][i] = cb[ch0 + i]; }
}
__device__ __forceinline__ void hy_item_decode(int it, int& ct, int& base, int& t0, int& L, int& b, bool& isctx) {
    isctx = it >= 4096;
    if (!isctx) { ct = it & 7; t0 = ((it >> 3) & 63) * 64; b = it >> 9; base = b * SEQ; L = SEQ; }
    else { const int j = it - 4096; ct = j & 7; t0 = ((j >> 3) & 3) * 64; b = j >> 5; base = NLAT + b * CTXL; L = CTXL; }
}
template <int VAR> __device__ __forceinline__ int hy_nitems(int bx, bool reb, int nit) {
    if (!reb) return (nit - bx + 255) >> 8;
    if (bx < 64) return 11;
    if (VAR == 0) return bx < 192 ? 20 : 17;
    return 19;
}
template <int VAR> __device__ __forceinline__ int hy_item(int bx, bool reb, int idx) {
    if (!reb || idx < ((bx < 64) ? 11 : 17)) return bx + 256 * idx;
    const int e = idx - 17, donor = bx & 63, grp = (bx >> 6) - 1;
    const int k = (VAR == 0) ? (11 + 3 * grp + e) : (11 + 2 * grp + e);
    return donor + 256 * k;
}
__device__ __forceinline__ void ph_hyprep2(Frame& F, int l, bool do_ctx) {
    const bf16* P = WSP<bf16>(F, WS_P);
    const float* cw = IN_(F, 10) + l * 3 * 1536; const float* cb = IN_(F, 11) + l * 1536;
    LAS bf16* Zs = (LAS bf16*)F.lds;
    int tid = F.tid; asm volatile("" : "+v"(tid));
    const int cg = tid & 7, tl = tid >> 3, c0 = (F.bx & 7) * 64;
    float w1[4][8], wv[4][8];
    hy_load_w8(cw, cb, 512 + c0 + 8 * cg, w1); hy_load_w8(cw, cb, 1024 + c0 + 8 * cg, wv);
    const int nit = do_ctx ? 4352 : 4096;
    HyRaw r1, rv;
    const int nmy = hy_nitems<0>(F.bx, do_ctx, nit);
    { int ct, base, t0, L, b; bool isctx; hy_item_decode(hy_item<0>(F.bx, do_ctx, 0), ct, base, t0, L, b, isctx); hy_fetch8(P, base, t0 + tl, L, 512 + c0 + 8 * cg, r1); hy_fetch8(P, base, t0 + tl, L, 1024 + c0 + 8 * cg, rv); }
#pragma unroll 1
    for (int ii = 0; ii < nmy; ++ii) {
        const int it = hy_item<0>(F.bx, do_ctx, ii);
        int ct, base, t0, L, b; bool isctx; hy_item_decode(it, ct, base, t0, L, b, isctx);
        float x1[8], v[8];
        hy_conv8(r1, w1, x1); hy_conv8(rv, wv, v);
        if (ii + 1 < nmy) { int ct2, base2, t02, L2, b2; bool ic2; hy_item_decode(hy_item<0>(F.bx, do_ctx, ii + 1), ct2, base2, t02, L2, b2, ic2); hy_fetch8(P, base2, t02 + tl, L2, 512 + c0 + 8 * cg, r1); hy_fetch8(P, base2, t02 + tl, L2, 1024 + c0 + 8 * cg, rv); }
        __syncthreads();
#pragma unroll
        for (int i = 0; i < 8; ++i) Zs[(8 * cg + i) * HLD + (tl ^ (8 * cg))] = f2bf(x1[i] * v[i]);
        __syncthreads();
        { const int c = tid >> 3, seg = tid & 7;
          const u32x4 o = *(const LAS u32x4*)(Zs + c * HLD + 8 * (seg ^ (c >> 3)));
          bf16* dst = isctx ? (WSP<bf16>(F, WS_ZTC) + ((size_t)(c0 + c) * NB + b) * CTXL + t0 + 8 * seg) : (WSP<bf16>(F, WS_ZT) + ((size_t)(c0 + c) * NB + b) * SEQ + t0 + 8 * seg);
          *(u32x4*)dst = o; }
    }
}
__device__ __forceinline__ void ph_hypost2(Frame& F, int l, bool do_ctx) {
    const bf16* P = WSP<bf16>(F, WS_P);
    const float* cw = IN_(F, 10) + l * 3 * 1536; const float* cb = IN_(F, 11) + l * 1536; const float* skip = IN_(F, 19) + l * 512;
    LAS bf16* Ys = (LAS bf16*)F.lds;
    int tid = F.tid; asm volatile("" : "+v"(tid));
    const int cg = tid & 7, tl = tid >> 3, c0 = (F.bx & 7) * 64;
    float w0[4][8], w1[4][8], wv[4][8], sk[8];
    hy_load_w8(cw, cb, c0 + 8 * cg, w0); hy_load_w8(cw, cb, 512 + c0 + 8 * cg, w1); hy_load_w8(cw, cb, 1024 + c0 + 8 * cg, wv);
#pragma unroll
    for (int i = 0; i < 8; ++i) sk[i] = skip[c0 + 8 * cg + i];
    bf16* HY = WSP<bf16>(F, WS_RET) + 1024;
    const int nit = do_ctx ? 4352 : 4096;
    const int cY = tid >> 3, segY = tid & 7;
    HyRaw r0, r1, rv; u32x4 yraw;
#define HYP_FETCH(it_) do { int ct_, base_, t0_, L_, b_; bool ic_; hy_item_decode((it_), ct_, base_, t0_, L_, b_, ic_); \
        hy_fetch8(P, base_, t0_ + tl, L_, c0 + 8 * cg, r0); hy_fetch8(P, base_, t0_ + tl, L_, 512 + c0 + 8 * cg, r1); hy_fetch8(P, base_, t0_ + tl, L_, 1024 + c0 + 8 * cg, rv); \
        const bf16* src_ = ic_ ? (WSP<bf16>(F, WS_YTC) + ((size_t)(c0 + cY) * NB + b_) * CTXL + t0_ + 8 * segY) : (WSP<bf16>(F, WS_YT) + ((size_t)(c0 + cY) * NB + b_) * SEQ + t0_ + 8 * segY); \
        yraw = *(const u32x4*)src_; } while (0)
    const int nmy = hy_nitems<1>(F.bx, do_ctx, nit);
    HYP_FETCH(hy_item<1>(F.bx, do_ctx, 0));
#pragma unroll 1
    for (int ii = 0; ii < nmy; ++ii) {
        const int it = hy_item<1>(F.bx, do_ctx, ii);
        int ct, base, t0, L, b; bool isctx; hy_item_decode(it, ct, base, t0, L, b, isctx);
        float x0[8], x1[8], v[8];
        hy_conv8(r0, w0, x0); hy_conv8(r1, w1, x1); hy_conv8(rv, wv, v);
        __syncthreads();
        *(LAS u32x4*)(Ys + cY * HLD + 8 * (segY ^ (cY >> 3))) = yraw;
        if (ii + 1 < nmy) HYP_FETCH(hy_item<1>(F.bx, do_ctx, ii + 1));
        __syncthreads();
        float hy[8];
#pragma unroll
        for (int i = 0; i < 8; ++i) { const float y = bf2f(Ys[(8 * cg + i) * HLD + (tl ^ (8 * cg))]); hy[i] = x0[i] * (y + sk[i] * (x1[i] * v[i])); }
        u32x4 o; o.x = pk2(hy[0], hy[1]); o.y = pk2(hy[2], hy[3]); o.z = pk2(hy[4], hy[5]); o.w = pk2(hy[6], hy[7]);
        *(u32x4*)(HY + (size_t)(base + t0 + tl) * 1536 + c0 + 8 * cg) = o;
    }
#undef HYP_FETCH
}
__device__ __forceinline__ void hyconv_ctx_item2(Frame& F, int c) {
    const float* HFp = WSP<float>(F, WS_HFC); const float* HBp = WSP<float>(F, WS_HFC + 512 * 1024);
    LAS float* Kc = (LAS float*)F.lds; LAS float* Zs = Kc + 512;
    const float il1 = hy_inv_l1(F, 2, c);
    const bf16* Z = WSP<bf16>(F, WS_ZTC) + (size_t)c * NB * CTXL; bf16* Yo = WSP<bf16>(F, WS_YTC) + (size_t)c * NB * CTXL;
    const int tid = F.tid;
    __syncthreads();
    if (tid < 511) { const int d = tid - 255; Kc[tid] = (d >= 0 ? HFp[(size_t)d * 512 + c] : HBp[(size_t)(-d) * 512 + c]) * il1; }
#pragma unroll
    for (int i = 0; i < 4; ++i) Zs[tid + 512 * i] = bf2f(Z[tid + 512 * i]);
    __syncthreads();
    const int t = tid & 255, b0 = tid >> 8;
    float a[4] = {0.f, 0.f, 0.f, 0.f};
#pragma unroll 4
    for (int s = 0; s < CTXL; ++s) { const float k = Kc[t - s + 255];
#pragma unroll
        for (int i = 0; i < 4; ++i) a[i] += k * Zs[(b0 + 2 * i) * CTXL + s]; }
#pragma unroll
    for (int i = 0; i < 4; ++i) Yo[(b0 + 2 * i) * CTXL + t] = f2bf(a[i]);
}

constexpr int ALD = 72;
__device__ __forceinline__ void attn_unit(Frame& F, int l, int unit) {
    const bf16* P = WSP<bf16>(F, WS_P);
    LAS bf16* Kb = (LAS bf16*)F.lds; LAS bf16* Vt = Kb + 64 * ALD;
    const bool isctx = unit >= 1024;
    int b, kvh, qb;
    if (!isctx) { b = unit >> 7; kvh = (unit >> 6) & 1; qb = unit & 63; } else { const int it = unit - 1024; b = it >> 3; kvh = (it >> 2) & 1; qb = it & 3; }
    int tid = F.tid; asm volatile("" : "+v"(tid));
    const int lane = tid & 63, w = F.wave, g = w >> 1, h = kvh * 4 + g, lg = lane >> 4, lc = lane & 15;
    const int start = qb * 64, q0 = start + (w & 1) * 32;
    const int rowq0 = isctx ? (NLAT + b * CTXL + q0) : (b * SEQ + q0);
    bf16x8 bq[2][2];
#pragma unroll
    for (int qt = 0; qt < 2; ++qt)
#pragma unroll
        for (int ks = 0; ks < 2; ++ks) bq[qt][ks] = *(const bf16x8*)(P + (size_t)(rowq0 + 16 * qt + lc) * INC + C_AQ + h * 64 + 32 * ks + 8 * lg);
    const float sink = IN_(F, 9)[l * 8 + h];
    float mrun[2], lsum[2]; f32x4 o[4][2];
#pragma unroll
    for (int qt = 0; qt < 2; ++qt) { mrun[qt] = sink * 1.4426950408889634f; lsum[qt] = (lg == 0) ? 1.0f : 0.0f;
#pragma unroll
        for (int dt = 0; dt < 4; ++dt) o[dt][qt] = (f32x4){0.f, 0.f, 0.f, 0.f}; }
    const int nkb = isctx ? 4 : 9;
    const int key = tid >> 3, d0 = (tid & 7) * 8;
    u32x4 kk, vv;
#define ATT_FETCH(kb_) do { const bool cb_ = isctx || (kb_) >= 5; int row_ = -1; \
        if (cb_) row_ = NLAT + b * CTXL + (isctx ? (kb_) : (kb_) - 5) * 64 + key; \
        else { const int kpos_ = start - 128 + (kb_) * 64 + key; if (kpos_ >= 0 && kpos_ < SEQ) row_ = b * SEQ + kpos_; } \
        kk = (u32x4){0u, 0u, 0u, 0u}; vv = kk; \
        if (row_ >= 0) { kk = *(const u32x4*)(P + (size_t)row_ * INC + C_AK + kvh * 64 + d0); vv = *(const u32x4*)(P + (size_t)row_ * INC + C_AV + kvh * 64 + d0); } } while (0)
    const int kb_lo = isctx ? 0 : ((start >= 128) ? 0 : 2 - (start >> 6)), kb_hi = isctx ? 0 : (((SEQ + 128 - start) >> 6) < 5 ? ((SEQ + 128 - start) >> 6) : 5);
#define ATT_NEXT(kb_) ((!isctx && (kb_) + 1 == kb_hi) ? 5 : (kb_) + 1)
    ATT_FETCH(kb_lo);
#pragma unroll 1
    for (int kb = kb_lo; kb < nkb; kb = ATT_NEXT(kb)) {
        const bool ctxblk = isctx || kb >= 5;
        __syncthreads();
        { *(LAS u32x4*)(Kb + key * ALD + d0) = kk;
          const unsigned vw[4] = {vv.x, vv.y, vv.z, vv.w};
#pragma unroll
          for (int i = 0; i < 4; ++i) { Vt[(d0 + 2 * i) * ALD + (key ^ d0)] = (bf16)(vw[i] & 0xffffu); Vt[(d0 + 2 * i + 1) * ALD + (key ^ d0)] = (bf16)(vw[i] >> 16); } }
        __syncthreads();
        { const int kn = ATT_NEXT(kb); if (kn < nkb) ATT_FETCH(kn); }
        f32x4 s[4][2];
        bf16x8 kf[4][2];
#pragma unroll
        for (int kt = 0; kt < 4; ++kt) { kf[kt][0] = *(const LAS bf16x8*)(Kb + (16 * kt + lc) * ALD + 8 * lg); kf[kt][1] = *(const LAS bf16x8*)(Kb + (16 * kt + lc) * ALD + 32 + 8 * lg); }
        __builtin_amdgcn_sched_barrier(0);
#pragma unroll
        for (int kt = 0; kt < 4; ++kt)
#pragma unroll
            for (int qt = 0; qt < 2; ++qt) { f32x4 c = (f32x4){0.f, 0.f, 0.f, 0.f};
                c = __builtin_amdgcn_mfma_f32_16x16x32_bf16(kf[kt][0], bq[qt][0], c, 0, 0, 0); c = __builtin_amdgcn_mfma_f32_16x16x32_bf16(kf[kt][1], bq[qt][1], c, 0, 0, 0);
                s[kt][qt] = c; }
        if (!ctxblk && (kb == 0 || kb == 4)) {
#pragma unroll
            for (int kt = 0; kt < 4; ++kt)
#pragma unroll
                for (int qt = 0; qt < 2; ++qt)
#pragma unroll
                    for (int r = 0; r < 4; ++r) { const int kpos = start - 128 + kb * 64 + 16 * kt + 4 * lg + r, qpos = q0 + 16 * qt + lc, dd = qpos - kpos;
                        const bool valid = (kpos >= 0) && (kpos < SEQ) && (dd <= 128) && (dd >= -128);
                        s[kt][qt][r] = valid ? s[kt][qt][r] : -1.0e30f; }
        }
        bf16x8 pf[2][2];
#pragma unroll
        for (int qt = 0; qt < 2; ++qt) {
            float bm = -3.0e38f;
#pragma unroll
            for (int kt = 0; kt < 4; ++kt) bm = fmaxf(bm, fmaxf(fmaxf(s[kt][qt][0], s[kt][qt][1]), fmaxf(s[kt][qt][2], s[kt][qt][3])));
            bm = fmaxf(bm, __shfl_xor(bm, 16)); bm = fmaxf(bm, __shfl_xor(bm, 32));
            const float KS = 0.125f * 1.4426950408889634f;
            const float mold = mrun[qt], mnew = fmaxf(mold, bm * KS);
            mrun[qt] = mnew;
            float ps = 0.f; unsigned pw[8];
#pragma unroll
            for (int kt = 0; kt < 4; ++kt) { const float p0 = __builtin_amdgcn_exp2f(fmaf(s[kt][qt][0], KS, -mnew)), p1 = __builtin_amdgcn_exp2f(fmaf(s[kt][qt][1], KS, -mnew)), p2 = __builtin_amdgcn_exp2f(fmaf(s[kt][qt][2], KS, -mnew)), p3 = __builtin_amdgcn_exp2f(fmaf(s[kt][qt][3], KS, -mnew));
                ps += (p0 + p1) + (p2 + p3); pw[2 * kt] = pk2(p0, p1); pw[2 * kt + 1] = pk2(p2, p3); }
            if (__any(mnew > mold)) {
                const float sc = __builtin_amdgcn_exp2f(mold - mnew);
                lsum[qt] = lsum[qt] * sc;
#pragma unroll
                for (int dt = 0; dt < 4; ++dt) o[dt][qt] = o[dt][qt] * sc; }
            lsum[qt] += ps;
            u32x4 f0; f0.x = pw[0]; f0.y = pw[1]; f0.z = pw[2]; f0.w = pw[3];
            u32x4 f1; f1.x = pw[4]; f1.y = pw[5]; f1.z = pw[6]; f1.w = pw[7];
            pf[qt][0] = __builtin_bit_cast(bf16x8, f0); pf[qt][1] = __builtin_bit_cast(bf16x8, f1);
        }
        bf16x8 vfr[4][2];
#pragma unroll
        for (int dt = 0; dt < 4; ++dt)
#pragma unroll
            for (int ks = 0; ks < 2; ++ks) {
                const int vsw = ((16 * dt + lc) >> 3) << 3;
                const u32x2 a0 = *(const LAS u32x2*)(Vt + (16 * dt + lc) * ALD + ((32 * ks + 4 * lg) ^ vsw)), a1 = *(const LAS u32x2*)(Vt + (16 * dt + lc) * ALD + ((32 * ks + 16 + 4 * lg) ^ vsw));
                u32x4 av; av.x = a0.x; av.y = a0.y; av.z = a1.x; av.w = a1.y;
                vfr[dt][ks] = __builtin_bit_cast(bf16x8, av); }
        __builtin_amdgcn_sched_barrier(0);
#pragma unroll
        for (int dt = 0; dt < 4; ++dt)
#pragma unroll
            for (int ks = 0; ks < 2; ++ks)
#pragma unroll
                for (int qt = 0; qt < 2; ++qt) o[dt][qt] = __builtin_amdgcn_mfma_f32_16x16x32_bf16(vfr[dt][ks], pf[qt][ks], o[dt][qt], 0, 0, 0);
    }
#undef ATT_FETCH
#undef ATT_NEXT
    bf16* ATT = WSP<bf16>(F, WS_RET) + 512;
#pragma unroll
    for (int qt = 0; qt < 2; ++qt) {
        float lt = lsum[qt]; lt += __shfl_xor(lt, 16); lt += __shfl_xor(lt, 32);
        const float inv = 1.0f / lt;
        bf16* op = ATT + (size_t)(rowq0 + 16 * qt + lc) * 1536 + h * 64 + 4 * lg;
#pragma unroll
        for (int dt = 0; dt < 4; ++dt) { u32x2 ov; ov.x = pk2(o[dt][qt][0] * inv, o[dt][qt][1] * inv); ov.y = pk2(o[dt][qt][2] * inv, o[dt][qt][3] * inv); *(u32x2*)(op + 16 * dt) = ov; }
    }
}

__device__ __forceinline__ void ph_norm2_router(Frame& F, int l, int nrows) {
    const int lane = F.lane, RPB = nrows / 256;
    LAS float* RW = (LAS float*)F.lds;
    LAS unsigned* cnt = (LAS unsigned*)(F.lds + LDSX + 64);
    __syncthreads();
    { const float* rw = IN_(F, 24) + (size_t)l * 1024 * 32;
#pragma unroll 1
      for (int i0 = F.tid; i0 < 1024 * 32 / 4; i0 += 8 * NTHR) { f32x4 t8[8];
#pragma unroll
          for (int k = 0; k < 8; ++k) t8[k] = *(const f32x4*)(rw + 4 * (i0 + k * NTHR));
          __builtin_amdgcn_sched_barrier(0);
#pragma unroll
          for (int k = 0; k < 8; ++k) { const int i = i0 + k * NTHR, col = i >> 3, ch = i & 7, ll = (col >> 2) & 63, ridx = ((col & 3) * 4 + (col >> 8)) * 64 + ll;
              *(LAS f32x4*)(RW + ridx * 32 + ((ch ^ ((ll >> 1) & 7)) << 2)) = t8[k]; } } }
    if (F.tid < 32) cnt[F.tid] = 0u;
    { int* SRC = WSP<int>(F, WS_SRC); for (int i = F.bx * NTHR + F.tid; i < MPAD; i += F.G * NTHR) SRC[i] = 0; }
    __syncthreads();
    const float* xm_all = WSP<float>(F, WS_XM);
    const float* gw_ = IN_(F, 23) + l * DM;
    const int e = lane >> 1, sw = (lane >> 1) & 7;
    const float rb = IN_(F, 25)[l * 32 + e];
    int* TOPI = WSP<int>(F, WS_TOPI); float* TOPW = WSP<float>(F, WS_TOPW);
    typedef float f32x2 __attribute__((ext_vector_type(2)));
    f32x4 vnext[2][4];
    { const float* xr0 = xm_all + (size_t)(F.bx * RPB + 2 * F.wave) * DM;
#pragma unroll
      for (int t = 0; t < 2; ++t)
#pragma unroll
        for (int j = 0; j < 4; ++j) vnext[t][j] = *(const f32x4*)(xr0 + t * DM + 4 * lane + 256 * j); }
#pragma unroll 1
    for (int rr = 2 * F.wave; rr < RPB; rr += 2 * NWAVES) {
        const int r = F.bx * RPB + rr, mr = modrow_of(r);
        f32x4 shq[4], aq[4];
        { const float* sh = mod_ptr(F, l, mr, 3); const float* sc = mod_ptr(F, l, mr, 4); f32x4 gq_[4], sc_[4];
#pragma unroll
          for (int j = 0; j < 4; ++j) { shq[j] = *(const f32x4*)(sh + 4 * lane + 256 * j); gq_[j] = *(const f32x4*)(gw_ + 4 * lane + 256 * j); sc_[j] = *(const f32x4*)(sc + 4 * lane + 256 * j); }
          __builtin_amdgcn_sched_barrier(0);
#pragma unroll
          for (int j = 0; j < 4; ++j) aq[j] = gq_[j] * (sc_[j] + 1.0f); }
        f32x4 v[2][4]; float ss[2] = {0.f, 0.f};
#pragma unroll
        for (int t = 0; t < 2; ++t)
#pragma unroll
            for (int j = 0; j < 4; ++j) { v[t][j] = vnext[t][j]; ss[t] += (v[t][j][0] * v[t][j][0] + v[t][j][1] * v[t][j][1]) + (v[t][j][2] * v[t][j][2] + v[t][j][3] * v[t][j][3]); }
        const float* xn = xm_all + (size_t)((rr + 2 * NWAVES < RPB) ? r + 2 * NWAVES : r) * DM;
#pragma unroll
        for (int t = 0; t < 2; ++t) {
            const float rstd = 1.0f / sqrtf(wave_sum(ss[t]) * (1.0f / DM) + EPS);
            bf16* o = WSP<bf16>(F, WS_XN) + (size_t)(r + t) * DM;
#pragma unroll
            for (int j = 0; j < 4; ++j) { v[t][j] = v[t][j] * rstd * aq[j] + shq[j];
                u32x2 w2; w2.x = pk2(v[t][j][0], v[t][j][1]); w2.y = pk2(v[t][j][2], v[t][j][3]); *(u32x2*)(o + 4 * lane + 256 * j) = w2; } }
        f32x2 acc[2][16];
#pragma unroll
        for (int t = 0; t < 2; ++t)
#pragma unroll
            for (int i = 0; i < 16; ++i) acc[t][i] = (f32x2){0.f, 0.f};
        f32x4 wa[8], wb[8];
#define RT_LOAD(W, c) { const int j_ = (c) >> 2, q_ = (c) & 3, ri_ = (q_ * 4 + j_) * 64 + lane; \
            _Pragma("unroll") for (int c8 = 0; c8 < 8; ++c8) W[c8] = *(const LAS f32x4*)(RW + ri_ * 32 + ((c8 ^ sw) << 2)); }
#define RT_FMA(W, c) { const int j_ = (c) >> 2, q_ = (c) & 3; const float h0 = v[0][j_][q_], h1 = v[1][j_][q_]; const f32x2 hh0 = {h0, h0}, hh1 = {h1, h1}; \
            _Pragma("unroll") for (int c8 = 0; c8 < 8; ++c8) { acc[0][2 * c8] += hh0 * W[c8].lo; acc[0][2 * c8 + 1] += hh0 * W[c8].hi; acc[1][2 * c8] += hh1 * W[c8].lo; acc[1][2 * c8 + 1] += hh1 * W[c8].hi; } }
        RT_LOAD(wa, 0)
#pragma unroll
        for (int c = 0; c < 16; c += 2) {
            RT_LOAD(wb, c + 1)
            __builtin_amdgcn_sched_barrier(0);
            RT_FMA(wa, c)
            __builtin_amdgcn_sched_barrier(0);
            if (c + 2 < 16) RT_LOAD(wa, c + 2)
            __builtin_amdgcn_sched_barrier(0);
            RT_FMA(wb, c + 1)
            __builtin_amdgcn_sched_barrier(0);
            if ((c & 3) == 2) { const int jj = c >> 2;
#pragma unroll
                for (int t = 0; t < 2; ++t) vnext[t][jj] = *(const f32x4*)(xn + t * DM + 4 * lane + 256 * jj);
                __builtin_amdgcn_sched_barrier(0); }
        }
#undef RT_LOAD
#undef RT_FMA
#pragma unroll
        for (int i = 0; i < 16; ++i) asm volatile("" : "+v"(acc[1][i]));
#pragma unroll
        for (int t = 0; t < 2; ++t) {
        float r16[16], r8[8], r4[4], r2[2];
#pragma unroll
        for (int i = 0; i < 16; ++i) { const auto sw2 = __builtin_amdgcn_permlane32_swap(__float_as_uint(acc[t][i >> 1][i & 1]), __float_as_uint(acc[t][8 + (i >> 1)][i & 1]), false, false);
            r16[i] = __uint_as_float(sw2[0]) + __uint_as_float(sw2[1]); }
#pragma unroll
        for (int i = 0; i < 8; ++i) { const auto sw2 = __builtin_amdgcn_permlane16_swap(__float_as_uint(r16[i]), __float_as_uint(r16[8 + i]), false, false);
            r8[i] = __uint_as_float(sw2[0]) + __uint_as_float(sw2[1]); }
#define RT_DPP(old, v, ctrl, bm) __int_as_float(__builtin_amdgcn_update_dpp(__float_as_int(old), __float_as_int(v), (ctrl), 0xF, (bm), false))
        { const bool hi = (lane & 8) != 0;
#pragma unroll
          for (int i = 0; i < 4; ++i) { const float a = r8[i], b = r8[4 + i]; const float u = RT_DPP(RT_DPP(0.f, a, 0x128, 0x3), b, 0x128, 0xC); r4[i] = (hi ? b : a) + u; } }
        { const bool hi = (lane & 4) != 0;
#pragma unroll
          for (int i = 0; i < 2; ++i) { const float a = r4[i], b = r4[2 + i]; const float u = RT_DPP(RT_DPP(0.f, a, 0x12C, 0x5), b, 0x124, 0xA); r2[i] = (hi ? b : a) + u; } }
        float logit;
        { const bool hi = (lane & 2) != 0; const float keep = hi ? r2[1] : r2[0], send = hi ? r2[0] : r2[1]; logit = keep + RT_DPP(0.f, send, 0x4E, 0xF); }
        logit += RT_DPP(0.f, logit, 0xB1, 0xF);
#undef RT_DPP
        logit += rb;
        int rank = 0;
#pragma unroll
        for (int q = 0; q < 32; ++q) { const float lq = rdlane(logit, 2 * q); rank += (lq > logit) ? 1 : 0; }
        { const bool ev = (lane & 1) == 0;
          const bool uniq = __builtin_popcountll(__ballot(ev && rank == 0)) == 1 && __builtin_popcountll(__ballot(ev && rank == 1)) == 1 && __builtin_popcountll(__ballot(ev && rank == 2)) == 1 && __builtin_popcountll(__ballot(ev && rank == 3)) == 1;
          if (!uniq) { rank = 0;
#pragma unroll 1
              for (int q = 0; q < 32; ++q) { const float lq = rdlane(logit, 2 * q); rank += (lq > logit || (lq == logit && q < e)) ? 1 : 0; } } }
        const bool sel = (rank < 4) && ((lane & 1) == 0);
        const unsigned long long m0 = __ballot(sel && rank == 0), m1 = __ballot(sel && rank == 1), m2 = __ballot(sel && rank == 2), m3 = __ballot(sel && rank == 3);
        const int l0 = __builtin_ctzll(m0), l1 = __builtin_ctzll(m1), l2 = __builtin_ctzll(m2), l3 = __builtin_ctzll(m3);
        const float t0 = rdlane(logit, l0), t1 = rdlane(logit, l1), t2 = rdlane(logit, l2), t3 = rdlane(logit, l3);
        const float e1 = __expf(t1 - t0), e2 = __expf(t2 - t0), e3 = __expf(t3 - t0), inv = 1.0f / (1.0f + e1 + e2 + e3);
        if (lane < 4) { const int id = ((lane == 0) ? l0 : (lane == 1) ? l1 : (lane == 2) ? l2 : l3) >> 1; const float wv = ((lane == 0) ? 1.0f : (lane == 1) ? e1 : (lane == 2) ? e2 : e3) * inv;
            TOPI[(r + t) * 4 + lane] = id; TOPW[(r + t) * 4 + lane] = wv; __hip_atomic_fetch_add(cnt + id, 1u, __ATOMIC_RELAXED, __HIP_MEMORY_SCOPE_WORKGROUP); }
        }
    }
    __syncthreads();
    if (F.tid < 32) WSP<int>(F, WS_BLKCNT)[F.bx * 32 + F.tid] = (int)cnt[F.tid];
}

__device__ __forceinline__ void ph_moe_assign(Frame& F, int nrows) {
    const int RPB = nrows / 256, lane = F.lane;
    LAS int* part = (LAS int*)F.lds;
    LAS int* base = part + 1024;
    LAS int* idx = base + 32;
    LAS int* posl = idx + 1024;
    const int* BC = WSP<int>(F, WS_BLKCNT);
    __syncthreads();
    { const int e = F.tid & 31, pt = F.tid >> 5; int st = 0, sp = 0;
      for (int q = 0; q < 16; ++q) { const int blk = pt * 16 + q; const int v = BC[blk * 32 + e]; st += v; if (blk < F.bx) sp += v; }
      part[pt * 32 + e] = st; part[512 + pt * 32 + e] = sp; }
    for (int i = F.tid; i < RPB * 4; i += NTHR) idx[i] = WSP<int>(F, WS_TOPI)[F.bx * RPB * 4 + i];
    __syncthreads();
    if (F.tid < 32) { int st = 0, sp = 0; for (int q = 0; q < 16; ++q) { st += part[q * 32 + F.tid]; sp += part[512 + q * 32 + F.tid]; }
        part[F.tid] = st; part[512 + F.tid] = sp; }
    __syncthreads();
    if (F.tid == 0) { int t0 = 0; int* tl = WSP<int>(F, WS_TILES);
        for (int e = 0; e < 32; ++e) { base[e] = t0 * 256 + part[512 + e]; if (F.bx == 0) tl[e] = t0; t0 += (part[e] + 255) >> 8; }
        if (F.bx == 0) tl[32] = t0; }
    __syncthreads();
    LAS int* cc = posl + 1024;
    const int nent = RPB * 4;
    for (int ch = F.wave; ch * 64 < nent; ch += NWAVES) { const int j = ch * 64 + lane; const int my = (j < nent) ? idx[j] : -1; int rk = 0, cnte = 0;
#pragma unroll
        for (int e = 0; e < 32; ++e) { const unsigned long long m = __ballot(my == e); const int below = __builtin_amdgcn_mbcnt_hi((unsigned)(m >> 32), __builtin_amdgcn_mbcnt_lo((unsigned)m, 0));
            if (my == e) rk = below; if (lane == e) cnte = __builtin_popcountll(m); }
        if (lane < 32) cc[ch * 32 + lane] = cnte;
        if (j < nent) posl[j] = rk; }
    __syncthreads();
    for (int j = F.tid; j < nent; j += NTHR) { const int e = idx[j], ch = j >> 6; int p = base[e] + posl[j]; for (int q = 0; q < ch; ++q) p += cc[q * 32 + e]; posl[j] = p; }
    __syncthreads();
    int* POS = WSP<int>(F, WS_POS); int* SRC = WSP<int>(F, WS_SRC);
    for (int j = F.tid; j < RPB * 4; j += NTHR) { const int p = posl[j]; POS[F.bx * RPB * 4 + j] = p; SRC[p] = F.bx * RPB + (j >> 2); }
}

#define PHASE_FN __device__ __forceinline__
#ifndef MK_STAG_G
#define MK_STAG_G 1
#endif
#ifndef MK_STAG_US
#define MK_STAG_US 12
#endif
__device__ __forceinline__ void phase_stagger(const Frame& F) {
    if (MK_STAG_G > 1) { const int grp = (F.bx >> 3) % MK_STAG_G;
        if (grp) { const unsigned long long t0 = __builtin_amdgcn_s_memrealtime(), dt = (unsigned long long)(grp * MK_STAG_US * 100 / MK_STAG_G);
            while (__builtin_amdgcn_s_memrealtime() - t0 < dt) __builtin_amdgcn_s_sleep(32); } }
}
PHASE_FN void P_prologue() { Frame F = make_frame(); p0_prologue(F); }
PHASE_FN void P_norm1(int mode) { Frame F = make_frame(); ph_norm1(F, mode);
    if (mode == 0) { FftTw T; fft_tw_init(T, F.tid); for (int it = F.bx; it < 1024; it += F.G) fft_filter_unit(F, T, it >> 9, it & 511); } }
PHASE_FN void P_inproj(int l) { Frame F = make_frame(); phase_stagger(F);
    pg8::Gemm g{WSP<bf16>(F, WS_XN), WSP<bf16>(F, WS_WIN) + (size_t)l * INC * 1024, NROWS, INC, 1024};
    pg8::StaticOrder S; S.init(NROWS, INC, F.G, F.bx);
    EpiP E{WSP<bf16>(F, WS_P), IN_(F, 21) + l * 3072};
    pg8::gemm_phase<EpiP, pg8::StaticOrder, true, true>(F.lds, g, S, E);
    if (l == 0 && F.bx >= F.G - 8) hy_filter_item(F, 2, F.bx - (F.G - 8));
    if (l == 0 && F.bx >= 104) tr_deferred(F, 0, 5400, F.bx - 104, 152); }
#ifndef MK_REP2
#define MK_REP2 0u
#endif
PHASE_FN void P_mix(int l) { Frame F = make_frame(); const bool last = (l == 1);
    const int na = last ? 1024 : 1088;
    for (int rep = 0; rep < ((MK_REP2 & 1u) ? 2 : 1); ++rep)
    for (int it = F.bx; it < na; it += F.G) attn_unit(F, l, it);
    for (int rep = 0; rep < ((MK_REP2 & 2u) ? 2 : 1); ++rep)
    for (int it = F.G - 1 - F.bx; it < 1088; it += F.G) ret_kv_unit(F, l, it);
    for (int rep = 0; rep < ((MK_REP2 & 4u) ? 2 : 1); ++rep) ph_hyprep2(F, l, !last); }

PHASE_FN void P_hyconv(int l) { Frame F = make_frame(); const bool last = (l == 1);
    for (int rep = 0; rep < ((MK_REP2 & 8u) ? 2 : 1); ++rep) ret_scan(F, l);
    { FftTw T; fft_tw_init(T, F.tid); unsigned zpa[8], zpb[8];
      fft_zfetch(F, F.bx, F.tid, zpa); fft_zfetch(F, F.bx + F.G, F.tid, zpb);
      for (int rep = 0; rep < ((MK_REP2 & 16u) ? 2 : 1); ++rep)
      for (int it = F.bx; it < 2048; it += 2 * F.G) { const int na = (it + 2 * F.G < 2048) ? it + 2 * F.G : F.bx, nb = (it + 3 * F.G < 2048) ? it + 3 * F.G : F.bx + F.G;
          fft_conv_pair(F, T, l, it, it + F.G, na, nb, zpa, zpb); } }
    if (!last) for (int it = F.bx; it < 512; it += F.G) hyconv_ctx_item2(F, it); }
PHASE_FN void P_hypost(int l) { Frame F = make_frame(); const bool last = (l == 1);
    for (int rep = 0; rep < ((MK_REP2 & 32u) ? 2 : 1); ++rep)
    for (int it = F.bx; it < 1088; it += F.G) { const int ci = it % 34; if (last && ci < 2) continue; ret_out_unit(F, l, it); }
    for (int rep = 0; rep < ((MK_REP2 & 64u) ? 2 : 1); ++rep) ph_hypost2(F, l, !last); }
PHASE_FN void P_merge(int l) { Frame F = make_frame(); const int mrows = (l == 1) ? NLAT : NROWS;
    pg8::Gemm g{WSP<bf16>(F, WS_RET), WSP<bf16>(F, WS_WBR) + (size_t)l * 1024 * 1536, mrows, 1024, 1536};
    pg8::StaticOrder S; S.init(mrows, 1024, F.G, F.bx);
    EpiMerge E{WSP<bf16>(F, WS_P), WSP<bf16>(F, WS_M)};
    pg8::gemm_phase<EpiMerge, pg8::StaticOrder, true, true>(F.lds, g, S, E);
    if (l == 0 && F.bx >= 32) tr_deferred(F, 5400, 11300, F.bx - 32, 224); }
PHASE_FN void P_out(int l) { Frame F = make_frame(); const int mrows = (l == 1) ? NLAT : NROWS;
    pg8::Gemm g{WSP<bf16>(F, WS_M), WSP<bf16>(F, WS_WOUT) + (size_t)l * 1024 * 1024, mrows, 1024, 1024};
    pg8::StaticOrder S; S.init(mrows, 1024, F.G, F.bx);
    const float* xl = (l == 0) ? IN_(F, 0) : WSP<float>(F, WS_XO);
    const float* xc = (l == 0) ? IN_(F, 2) : WSP<float>(F, WS_XO) + (size_t)NLAT * DM;
    EpiOut E{xl, xc, mod_ptr(F, l, 0, 2), WSP<float>(F, WS_XM)};
    pg8::gemm_phase<EpiOut, pg8::StaticOrder, true, true>(F.lds, g, S, E);
    if (l == 0 && F.bx >= 32) tr_deferred(F, 16700, TRD_TOTAL - 16700, F.bx - 32, 224); }
PHASE_FN void P_router(int l) { Frame F = make_frame(); ph_norm2_router(F, l, (l == 1) ? NLAT : NROWS); }
PHASE_FN void P_assign(int l) { Frame F = make_frame(); ph_moe_assign(F, (l == 1) ? NLAT : NROWS); }
PHASE_FN void P_moe1(int l) { Frame F = make_frame();
    LAS int* list = (LAS int*)(F.lds + LDSX + 256);
    const int n = moe_list_units(F, 8, list);
    LAS int* srcl = (LAS int*)(F.lds + LDS_SRC);
    { const int* SRC = WSP<int>(F, WS_SRC);
      int sv[12];
#pragma unroll
      for (int k = 0; k < 12; ++k) { const int i = F.tid + k * NTHR; sv[k] = (i < n * 256) ? SRC[list[2 * (i >> 8)] * 256 + (i & 255)] : 0; }
      __builtin_amdgcn_sched_barrier(0);
#pragma unroll
      for (int k = 0; k < 12; ++k) { const int i = F.tid + k * NTHR; if (i < n * 256) srcl[i] = sv[k]; }
      for (int i = F.tid + 12 * NTHR; i < n * 256; i += NTHR) srcl[i] = SRC[list[2 * (i >> 8)] * 256 + (i & 255)]; }
    __syncthreads();
    pg8::Gemm g{WSP<bf16>(F, WS_XN), WSP<bf16>(F, WS_W1) + (size_t)l * 32 * 2048 * 1024, MPAD, 32 * 2048, 1024};
    phase_stagger(F);
    MoeOrderG S{srcl, list, n};
    EpiMoe1 E{IN_(F, 27) + (size_t)l * 32 * 2048, WSP<bf16>(F, WS_ACT)};
    pg8::gemm_phase<EpiMoe1, MoeOrderG, true, true>(F.lds, g, S, E); }
PHASE_FN void P_moe2(int l) { Frame F = make_frame();
    LAS int* list = (LAS int*)(F.lds + LDSX + 256);
    const int n = moe_list_units(F, 4, list);
    pg8::Gemm g{WSP<bf16>(F, WS_ACT), WSP<bf16>(F, WS_W2) + (size_t)l * 32 * 1024 * 1024, MPAD, 32 * 1024, 1024};
    phase_stagger(F);
    MoeOrder S{nullptr, list, n};
    EpiMoe2 E{IN_(F, 29) + (size_t)l * 32 * 1024, WSP<bf16>(F, WS_HS)};
    pg8::gemm_phase<EpiMoe2, MoeOrder, true, true>(F.lds, g, S, E); }

template <int ONLY> __global__ void __launch_bounds__(NTHR, 2) mk_fwd(Args args) {
    LAS unsigned char* lds = (LAS unsigned char*)lds_raw;
    const int tid = threadIdx.x;
    for (int u = tid; u < (LDS_BYTES - LDSX) / 4; u += NTHR) ((LAS unsigned*)(lds + LDSX))[u] = 0u;
    __syncthreads();
    if (tid < 33) { const unsigned long long v = (tid < 31) ? (unsigned long long)args.in[tid] : (tid == 31 ? (unsigned long long)args.out : (unsigned long long)args.ws);
        *(LAS unsigned long long*)(lds + LDS_PTAB + 8 * tid) = v; }
    __syncthreads();
    const int lo = args.ph_lo, hi = args.ph_hi;
    const bool one_launch = (hi - lo) > 1;
    unsigned* barw = (unsigned*)(args.ws + WS_CTL + CTL_BAR);
    XcdBarrier bar; bar.bar = barw; bar.x = 0; bar.st = nullptr;
    if (one_launch) bar = xcd_barrier_post(barw, (volatile LAS unsigned*)(lds + LDSX));
#ifndef MK_MASK
#define MK_MASK 0xFFFFFFFFu
#endif
#define ENAB(k) ((ONLY < 0 && ((MK_MASK >> ((k) >= 100 ? (k) - 100 + 14 : (k))) & 1u)) || ONLY == (k))
#ifndef MK_REP
#define MK_REP 0u
#endif
#define REPB(k) (((MK_REP) >> ((k) >= 100 ? (k) - 100 + 14 : (k))) & 1u)
#define IN(k) (lo <= (k) && (k) < hi)
#define SEAM(k) do { if (IN(k) && IN((k) + 1)) xcd_barrier(bar); } while (0)
    if (ENAB(100)) if (IN(0)) { P_prologue(); if (REPB(100)) { xcd_barrier(bar); P_prologue(); } } SEAM(0);
    for (int l = 0; l < 2; ++l) {
        const int pb = 1 + NPH_LAYER * l;
        if (ENAB(0)) if (IN(pb + 0)) { P_norm1(l == 0 ? 0 : 1); if (REPB(0)) { xcd_barrier(bar); P_norm1(l == 0 ? 0 : 1); } } SEAM(pb + 0);
        if (ENAB(1)) if (IN(pb + 1)) { P_inproj(l); if (REPB(1)) { xcd_barrier(bar); P_inproj(l); } } SEAM(pb + 1);
        if (ENAB(3)) if (IN(pb + 3)) { P_mix(l); if (REPB(3)) { xcd_barrier(bar); P_mix(l); } } SEAM(pb + 3);
        if (ENAB(4)) if (IN(pb + 4)) { P_hyconv(l); if (REPB(4)) { xcd_barrier(bar); P_hyconv(l); } } SEAM(pb + 4);
        if (ENAB(5)) if (IN(pb + 5)) { P_hypost(l); if (REPB(5)) { xcd_barrier(bar); P_hypost(l); } } SEAM(pb + 5);
        if (ENAB(6)) if (IN(pb + 6)) { P_merge(l); if (REPB(6)) { xcd_barrier(bar); P_merge(l); } } SEAM(pb + 6);
        if (ENAB(9)) if (IN(pb + 9)) { P_out(l); if (REPB(9)) { xcd_barrier(bar); P_out(l); } } SEAM(pb + 9);
        if (ENAB(10)) if (IN(pb + 10)) { P_router(l); if (REPB(10)) { xcd_barrier(bar); P_router(l); } } SEAM(pb + 10);
        if (ENAB(11)) if (IN(pb + 11)) { P_assign(l); if (REPB(11)) { xcd_barrier(bar); P_assign(l); } } SEAM(pb + 11);
        if (ENAB(12)) if (IN(pb + 12)) { P_moe1(l); if (REPB(12)) { xcd_barrier(bar); P_moe1(l); } } SEAM(pb + 12);
        if (ENAB(13)) if (IN(pb + 13)) { P_moe2(l); if (REPB(13)) { xcd_barrier(bar); P_moe2(l); } } SEAM(pb + 13);
    }
    if (ENAB(101)) if (IN(NPH - 1)) { P_norm1(2); }
#undef IN
#undef SEAM
#undef ENAB
}

template <int ONLY> static void launch_phase(Args a, int lo, int hi, int grid, hipStream_t stream) {
    static bool attr_set = false;
    if (!attr_set) { (void)hipFuncSetAttribute((const void*)mk_fwd<ONLY>, hipFuncAttributeMaxDynamicSharedMemorySize, LDS_BYTES); attr_set = true; }
    a.ph_lo = lo; a.ph_hi = hi;
    hipLaunchKernelGGL(mk_fwd<ONLY>, dim3(grid), dim3(NTHR), LDS_BYTES, stream, a);
}
extern "C" void kernel_launch(void* const* d_in, const int* in_sizes, int n_in, void* d_out, int out_size, void* d_ws, size_t ws_size, hipStream_t stream) {
    static int grid = 0;
    if (grid == 0) {
        if (n_in != 31 || ws_size < WS_END) { fprintf(stderr, "kernel_launch: unexpected n_in %d / ws_size %zu\n", n_in, ws_size); grid = -1; return; }
        int dev = 0, cus = 0;
        if (hipGetDevice(&dev) != hipSuccess || hipDeviceGetAttribute(&cus, hipDeviceAttributeMultiprocessorCount, dev) != hipSuccess) { grid = -1; return; }
        grid = (cus == 256) ? 256 : -1;
        if (grid < 0) { fprintf(stderr, "kernel_launch: needs a 256-CU device, got %d\n", cus); return; }
    }
    if (grid < 0) return;
    (void)hipMemsetAsync((char*)d_ws + WS_CTL, 0, CTL_ZERO_BYTES, stream);
    Args a{};
    for (int i = 0; i < 31; ++i) a.in[i] = (const float*)d_in[i];
    a.out = (float*)d_out; a.ws = (unsigned char*)d_ws;
#if MK_ONE_LAUNCH
    launch_phase<-1>(a, 0, NPH, grid, stream);
#else
    launch_phase<100>(a, 0, 1, grid, stream);
    for (int l = 0; l < 2; ++l) {
        const int pb = 1 + NPH_LAYER * l;
        launch_phase<0>(a, pb + 0, pb + 1, grid, stream);   launch_phase<1>(a, pb + 1, pb + 2, grid, stream);   launch_phase<2>(a, pb + 2, pb + 3, grid, stream);
        launch_phase<3>(a, pb + 3, pb + 4, grid, stream);   launch_phase<4>(a, pb + 4, pb + 5, grid, stream);   launch_phase<5>(a, pb + 5, pb + 6, grid, stream);
        launch_phase<6>(a, pb + 6, pb + 7, grid, stream);   launch_phase<7>(a, pb + 7, pb + 8, grid, stream);   launch_phase<8>(a, pb + 8, pb + 9, grid, stream);
        launch_phase<9>(a, pb + 9, pb + 10, grid, stream);  launch_phase<10>(a, pb + 10, pb + 11, grid, stream); launch_phase<11>(a, pb + 11, pb + 12, grid, stream);
        launch_phase<12>(a, pb + 12, pb + 13, grid, stream); launch_phase<13>(a, pb + 13, pb + 14, grid, stream);
    }
    launch_phase<101>(a, NPH - 1, NPH, grid, stream);
#endif
}
```

```cpp
#include <hip/hip_runtime.h>
#include <cstdio>
#include <cstdint>
#define MK_ONE_LAUNCH 1
namespace pg8 {
#define PG8_LAS __attribute__((address_space(3)))
typedef unsigned short bf16_t;
typedef short bf16x8 __attribute__((ext_vector_type(8)));
typedef float f32x4 __attribute__((ext_vector_type(4)));
typedef unsigned u32x4 __attribute__((ext_vector_type(4)));
constexpr int BM = 256, BK = 64, HALF = 128, HTB = HALF * BK * 2  , STAGE_BYTES = 8 * HTB, NXCD = 8, WGM = 8;

__host__ __device__ __forceinline__ int lds_byte(int r, int c) { const int st = (r >> 4) * 2 + (c >> 5), rr = r & 15, cc = c & 31, ob = rr * 64 + cc * 2; return st * 1024 + (ob ^ (((ob >> 9) & 1) << 5)); }
__host__ __device__ __forceinline__ void stage_rc(int b, int& R, int& C) { const int st = b / 1024, sb = b % 1024, swz = sb ^ (((sb >> 9) & 1) << 5); R = (st >> 1) * 16 + swz / 64; C = (st & 1) * 32 + (swz % 64) / 2; }
__host__ __device__ __forceinline__ int perm32(int rho) { const int n = rho >> 4, i = rho & 15; return 8 * (i >> 2) + 4 * n + (i & 3); }

struct Unit { int pm, pn; };
struct Gemm { const bf16_t* A; const bf16_t* Bt; int M, N, K; };

struct StaticOrder {
    static constexpr bool GATHER = false; const PG8_LAS int* src;
    int nM, nN, nwg, G, c;
    __host__ __device__ void init(int M, int N, int G_, int c_) { nM = M / BM; nN = N / BM; nwg = nM * nN; G = G_; c = c_; }
    __host__ __device__ bool next(int i, Unit& u) const {
        const long L = (long)i * G + c; if (L >= nwg) return false;
        int wgid = (int)L; { const int q = nwg / NXCD, r = nwg % NXCD, xcd = wgid % NXCD, off = wgid / NXCD; wgid = (xcd < r ? xcd * (q + 1) : r * (q + 1) + (xcd - r) * q) + off; }
        const int nig = WGM * nN, gid = wgid / nig, fm = gid * WGM, gsz = (nM - fm) < WGM ? (nM - fm) : WGM;
        u.pm = fm + ((wgid % nig) % gsz); u.pn = (wgid % nig) / gsz; return true;
    }
    __device__ __forceinline__ void a_ready(const Unit&) const {}
    __device__ __forceinline__ void done(const Unit&) const {}
};

__device__ __forceinline__ unsigned cvt_pk_bf16(float lo, float hi) { unsigned r; asm("v_cvt_pk_bf16_f32 %0, %1, %2" : "=v"(r) : "v"(lo), "v"(hi));     return r; }
template <class Epi, class Sched, bool ALIGN_EPI = false, bool SP2 = false>
__device__ __forceinline__ void gemm_phase(PG8_LAS unsigned char* lds, const Gemm g, const Sched& S, const Epi& E) {
    int tid_ = threadIdx.x; asm volatile("" : "+v"(tid_));
    const int tid = tid_, wid = __builtin_amdgcn_readfirstlane(tid >> 6), lane = tid & 63, wr = wid >> 2, wc = wid & 3, fr = lane & 15, fq = lane >> 4;
    const int K = g.K, nt = K / BK;
    unsigned voffA[2], voffB[2];
#pragma unroll
    for (int i = 0; i < 2; ++i) { int R, C; stage_rc(tid * 16 + i * 8192, R, C); const int Rb = Epi::PERM ? ((R & ~31) + perm32(R & 31)) : R;
        voffA[i] = (unsigned)(R * K + C) * 2u; voffB[i] = (unsigned)(Rb * K + C) * 2u; }
    constexpr bool GATHER = Sched::GATHER;
    static_assert(!GATHER || SP2, "the gathered A path is wired into the SP2 loop only");
    unsigned vAc[2][2], vAn[2][2];
#define PG8_GIDX(dst, ord) do { _Pragma("unroll") for (int _h = 0; _h < 2; ++_h) _Pragma("unroll") for (int _i = 0; _i < 2; ++_i) { int _R, _C; stage_rc(tid * 16 + _i * 8192, _R, _C); \
        dst[_h][_i] = (unsigned)S.src[(ord) * 256 + _h * 128 + _R] * (unsigned)(K * 2) + (unsigned)(_C * 2); } } while (0)
    const size_t kstep = (size_t)(BK * 2);
    const size_t hstep = (size_t)HALF * K * 2;
    const size_t tstep = 2 * hstep;
    const unsigned ldsw = (unsigned)wid * 1024u;
    const int aoff = lds_byte(wr * 64 + fr, fq * 8), boff = lds_byte(wc * 32 + fr, fq * 8);
#define PG8_SA(b, h) (((b) * 2 + (h)) * HTB)
#define PG8_SB(b, h) ((4 + (b) * 2 + (h)) * HTB)
#define PG8_STAGE(bufoff, gbase, voff) do { _Pragma("unroll") for (int _i = 0; _i < 2; ++_i) \
        __builtin_amdgcn_global_load_lds((const unsigned*)((const char*)(gbase) + (voff)[_i]), (PG8_LAS unsigned*)(lds + (bufoff) + ldsw + _i * 8192), 16, 0, 0); } while (0)
#define PG8_STAGE_A(bufoff, gbase, h, vg) do { if constexpr (GATHER) { PG8_STAGE(bufoff, gbase, (vg)[h]); } else { PG8_STAGE(bufoff, (gbase) + ((h) ? hstep : 0), voffA); } } while (0)
#define PG8_LDA(dst, b, h) do { _Pragma("unroll") for (int m = 0; m < 4; ++m) _Pragma("unroll") for (int k = 0; k < 2; ++k) dst[m][k] = *(const PG8_LAS bf16x8*)(lds + PG8_SA(b, h) + aoff + m * 2048 + k * 1024); } while (0)
#define PG8_LDB(dst, b, h) do { _Pragma("unroll") for (int n = 0; n < 2; ++n) _Pragma("unroll") for (int k = 0; k < 2; ++k) dst[n][k] = *(const PG8_LAS bf16x8*)(lds + PG8_SB(b, h) + boff + n * 2048 + k * 1024); } while (0)
#define PG8_MMA(ai, bj, At, Bt) do { __builtin_amdgcn_s_setprio(1); _Pragma("unroll") for (int m = 0; m < 4; ++m) _Pragma("unroll") for (int n = 0; n < 2; ++n) _Pragma("unroll") for (int k = 0; k < 2; ++k) \
        acc[ai][bj][m][n] = __builtin_amdgcn_mfma_f32_16x16x32_bf16(Bt[n][k], At[m][k], acc[ai][bj][m][n], 0, 0, 0); __builtin_amdgcn_s_setprio(0); } while (0)
#define PG8_WAIT_V(n) asm volatile("s_waitcnt vmcnt(" #n ")" ::: "memory")
#define PG8_WAIT_L(n) asm volatile("s_waitcnt lgkmcnt(" #n ")" ::: "memory")
#define PG8_BAR __builtin_amdgcn_s_barrier()
#define PG8_SCHED __builtin_amdgcn_sched_barrier(0)
    Unit cur, nxt; int ui = 0;
    if (!S.next(0, cur)) return;
    f32x4 acc[2][2][4][2];
#pragma unroll
    for (int a = 0; a < 2; ++a)
#pragma unroll
        for (int b = 0; b < 2; ++b)
#pragma unroll
            for (int m = 0; m < 4; ++m)
#pragma unroll
                for (int n = 0; n < 2; ++n) acc[a][b][m][n] = (f32x4){0.f, 0.f, 0.f, 0.f};
    bf16x8 At[4][2], B0[2][2], B1[2][2];
    const char* cA = (const char*)g.A + (GATHER ? (size_t)0 : (size_t)cur.pm * tstep); const char* cB = (const char*)g.Bt + (size_t)cur.pn * tstep;
    S.a_ready(cur);
    if constexpr (GATHER) { PG8_GIDX(vAc, 0); }
    if constexpr (SP2) {
        PG8_STAGE(PG8_SB(0, 0), cB, voffB); PG8_STAGE(PG8_SB(0, 1), cB + hstep, voffB); PG8_STAGE_A(PG8_SA(0, 0), cA, 0, vAc); PG8_STAGE_A(PG8_SA(0, 1), cA, 1, vAc);
        if (wr == 1) PG8_BAR;
        PG8_WAIT_V(2); PG8_BAR;
        PG8_STAGE(PG8_SB(1, 0), cB + kstep, voffB); PG8_STAGE_A(PG8_SA(1, 0), cA + kstep, 0, vAc); PG8_STAGE(PG8_SB(1, 1), cB + hstep + kstep, voffB);
        PG8_WAIT_V(6); PG8_BAR;
    } else {
        PG8_STAGE(PG8_SB(0, 0), cB, voffB); PG8_STAGE(PG8_SA(0, 0), cA, voffA); PG8_STAGE(PG8_SB(0, 1), cB + hstep, voffB); PG8_STAGE(PG8_SA(0, 1), cA + hstep, voffA);
        if (wr == 1) PG8_BAR;
        PG8_WAIT_V(4); PG8_BAR;
        PG8_STAGE(PG8_SB(1, 0), cB + kstep, voffB); PG8_STAGE(PG8_SA(1, 0), cA + kstep, voffA); PG8_STAGE(PG8_SB(1, 1), cB + hstep + kstep, voffB);
        PG8_WAIT_V(6); PG8_BAR;
    }
    for (;;) {
        const bool has_next = S.next(ui + 1, nxt);
        if constexpr (GATHER) { if (has_next) { PG8_GIDX(vAn, ui + 1); } else { _Pragma("unroll") for (int _h = 0; _h < 2; ++_h) _Pragma("unroll") for (int _i = 0; _i < 2; ++_i) vAn[_h][_i] = vAc[_h][_i]; } }
        const char* nA = GATHER ? cA : (has_next ? (const char*)g.A + (size_t)nxt.pm * tstep : cA); const char* nB = has_next ? (const char*)g.Bt + (size_t)nxt.pn * tstep : cB;
        for (int t = 0; t < nt; t += 2) {
            if constexpr (Epi::KMID) { if (t == 8 || t == 16) E.kmid(t, acc, cur, wr, wc, fr, fq); }
            const bool last = (t == nt - 2);
            const char* a1 = cA + (size_t)(t + 1) * kstep;
            const char* a2 = last ? nA : cA + (size_t)(t + 2) * kstep; const char* b2 = last ? nB : cB + (size_t)(t + 2) * kstep;
            const char* a3 = a2 + kstep; const char* b3 = b2 + kstep;
            if (last && has_next) S.a_ready(nxt);
            unsigned v2[2][2];
            if constexpr (GATHER) { _Pragma("unroll") for (int _h = 0; _h < 2; ++_h) _Pragma("unroll") for (int _i = 0; _i < 2; ++_i) v2[_h][_i] = last ? vAn[_h][_i] : vAc[_h][_i]; }
            if constexpr (SP2) {
            PG8_LDB(B0, 0, 0); PG8_LDB(B1, 0, 1); PG8_SCHED; PG8_LDA(At, 0, 0); PG8_STAGE_A(PG8_SA(1, 1), a1, 1, vAc);
            PG8_WAIT_V(8); PG8_WAIT_L(0); PG8_BAR; PG8_MMA(0, 0, At, B0); PG8_MMA(0, 1, At, B1); PG8_BAR; PG8_SCHED;
            PG8_LDA(At, 0, 1); PG8_STAGE(PG8_SB(0, 0), b2, voffB); PG8_STAGE(PG8_SB(0, 1), b2 + hstep, voffB); PG8_STAGE_A(PG8_SA(0, 0), a2, 0, v2);
            PG8_WAIT_V(8); PG8_WAIT_L(0); PG8_BAR; PG8_MMA(1, 0, At, B0); PG8_MMA(1, 1, At, B1); PG8_BAR; PG8_SCHED;
            PG8_LDB(B0, 1, 0); PG8_LDB(B1, 1, 1); PG8_SCHED; PG8_LDA(At, 1, 0); PG8_STAGE_A(PG8_SA(0, 1), a2, 1, v2);
            PG8_WAIT_V(8); PG8_WAIT_L(0); PG8_BAR; PG8_MMA(0, 0, At, B0); PG8_MMA(0, 1, At, B1); PG8_BAR; PG8_SCHED;
            PG8_LDA(At, 1, 1); PG8_STAGE(PG8_SB(1, 0), b3, voffB); PG8_STAGE(PG8_SB(1, 1), b3 + hstep, voffB); PG8_STAGE_A(PG8_SA(1, 0), a3, 0, v2);
            PG8_WAIT_V(8); PG8_WAIT_L(0); PG8_BAR; PG8_MMA(1, 0, At, B0); PG8_MMA(1, 1, At, B1); PG8_BAR; PG8_SCHED;
            } else {
            PG8_LDB(B0, 0, 0); PG8_SCHED; PG8_LDA(At, 0, 0); PG8_STAGE(PG8_SA(1, 1), a1 + hstep, voffA);
            PG8_WAIT_L(8); PG8_BAR; PG8_WAIT_L(0); PG8_MMA(0, 0, At, B0); PG8_BAR; PG8_SCHED;
            PG8_LDB(B1, 0, 1); PG8_STAGE(PG8_SB(0, 0), b2, voffB);
            PG8_BAR; PG8_WAIT_L(0); PG8_MMA(0, 1, At, B1); PG8_BAR;
            PG8_LDA(At, 0, 1); PG8_STAGE(PG8_SA(0, 0), a2, voffA);
            PG8_BAR; PG8_WAIT_L(0); PG8_MMA(1, 0, At, B0); PG8_BAR; PG8_SCHED;
            PG8_STAGE(PG8_SB(0, 1), b2 + hstep, voffB);
            PG8_WAIT_V(6); PG8_BAR; PG8_MMA(1, 1, At, B1); PG8_BAR;
            PG8_LDB(B0, 1, 0); PG8_SCHED; PG8_LDA(At, 1, 0); PG8_STAGE(PG8_SA(0, 1), a2 + hstep, voffA);
            PG8_WAIT_L(8); PG8_BAR; PG8_WAIT_L(0); PG8_MMA(0, 0, At, B0); PG8_BAR; PG8_SCHED;
            PG8_LDB(B1, 1, 1); PG8_STAGE(PG8_SB(1, 0), b3, voffB);
            PG8_BAR; PG8_WAIT_L(0); PG8_MMA(0, 1, At, B1); PG8_BAR;
            PG8_LDA(At, 1, 1); PG8_STAGE(PG8_SA(1, 0), a3, voffA);
            PG8_BAR; PG8_WAIT_L(0); PG8_MMA(1, 0, At, B0); PG8_BAR; PG8_SCHED;
            PG8_STAGE(PG8_SB(1, 1), b3 + hstep, voffB);
            PG8_WAIT_V(6); PG8_BAR; PG8_MMA(1, 1, At, B1); PG8_BAR;
            }
        }
        if constexpr (ALIGN_EPI) { if (wr == 0) PG8_BAR; }
        if constexpr (!Epi::AFTER_DRAIN) { E(acc, cur, wr, wc, fr, fq);
#ifdef MK_EPI2
            asm volatile("" ::: "memory"); E(acc, cur, wr, wc, fr, fq);
#endif
#ifdef MK_EPI3
            { char* sp = (char*)MK_EPI3_BASE + (size_t)blockIdx.x * 131072 + (size_t)wid * 16384 + (size_t)lane * 16;
              _Pragma("unroll") for (int q_ = 0; q_ < 16; ++q_) { u32x4 w_; w_.x = __float_as_uint(acc[q_ >> 3][(q_ >> 2) & 1][q_ & 3][0][0]); w_.y = __float_as_uint(acc[q_ >> 3][(q_ >> 2) & 1][q_ & 3][0][1]); w_.z = __float_as_uint(acc[q_ >> 3][(q_ >> 2) & 1][q_ & 3][1][0]); w_.w = __float_as_uint(acc[q_ >> 3][(q_ >> 2) & 1][q_ & 3][1][1]);
                  *(u32x4*)(sp + q_ * 1024) = w_; } }
#endif
            S.done(cur); }
        if (!has_next) break;
#pragma unroll
        for (int a = 0; a < 2; ++a)
#pragma unroll
            for (int b = 0; b < 2; ++b)
#pragma unroll
                for (int m = 0; m < 4; ++m)
#pragma unroll
                    for (int n = 0; n < 2; ++n) acc[a][b][m][n] = (f32x4){0.f, 0.f, 0.f, 0.f};
        cur = nxt; cA = nA; cB = nB; ++ui;
        if constexpr (GATHER) { _Pragma("unroll") for (int _h = 0; _h < 2; ++_h) _Pragma("unroll") for (int _i = 0; _i < 2; ++_i) vAc[_h][_i] = vAn[_h][_i]; }
        if constexpr (ALIGN_EPI) { if (wr == 1) PG8_BAR; }
    }
    PG8_WAIT_V(0);
    if constexpr (!ALIGN_EPI) { if (wr == 0) PG8_BAR; }
    PG8_BAR;
    if constexpr (Epi::AFTER_DRAIN) { E.fused(acc, cur, wr, wc, fr, fq, lds, wid, lane); S.done(cur); }
#undef PG8_SA
#undef PG8_SB
#undef PG8_STAGE
#undef PG8_STAGE_A
#undef PG8_GIDX
#undef PG8_LDA
#undef PG8_LDB
#undef PG8_MMA
#undef PG8_WAIT_V
#undef PG8_WAIT_L
#undef PG8_BAR
#undef PG8_SCHED
}
}
#define XB_TMO      128
#define XB_XCNT(j)  (256  + 64 * (j))
#define XB_XSUB(j)  (1280 + 64 * (j))
#define XB_XGEN(j)  (2304 + 64 * (j))
#define XB_TOP      3328
#define XB_TOPGEN   3392
#define XCD_BAR_WORDS 3456
#define XB_SPIN_CAP (1u << 18)
#define LAS __attribute__((address_space(3)))

__device__ __forceinline__ unsigned xb_ld(unsigned* p)              { return __hip_atomic_load(p, __ATOMIC_RELAXED, __HIP_MEMORY_SCOPE_AGENT); }
__device__ __forceinline__ unsigned xb_add(unsigned* p, unsigned v) { return __hip_atomic_fetch_add(p, v, __ATOMIC_RELAXED, __HIP_MEMORY_SCOPE_AGENT); }
__device__ __forceinline__ unsigned xb_xcc_id() { return (unsigned)__builtin_amdgcn_s_getreg((3 << 11) | 20) & 0xFu; }
#define XB_SPIN(cond, bar) do { unsigned _sp = 0; while (cond) { __builtin_amdgcn_s_sleep(1); \
    if ((++_sp & 255u) == 0u) { if (xb_ld(&(bar)[XB_TMO])) break; if (_sp > XB_SPIN_CAP) { atomicAdd(&(bar)[XB_TMO], 1u); break; } } } } while (0)

struct XcdBarrier {
    unsigned* bar; unsigned x;
    volatile LAS unsigned* st;
};

__device__ __forceinline__ XcdBarrier xcd_barrier_post(unsigned* bar, volatile LAS unsigned* st) {
    XcdBarrier b; b.bar = bar; b.x = xb_xcc_id(); b.st = st;
    if (threadIdx.x == 0) (void)xb_add(&bar[XB_XCNT(b.x)], 1u);
    return b;
}
__device__ __forceinline__ void xcd_barrier_complete(unsigned* bar, unsigned x, unsigned& nloc, unsigned& nx) {
    const unsigned G = gridDim.x * gridDim.y * gridDim.z;
    unsigned sum, cnt, mine, sp = 0u;
    for (;;) {
        sum = 0u; cnt = 0u; mine = 0u;
#pragma unroll
        for (unsigned j = 0; j < 16; ++j) { const unsigned c = xb_ld(&bar[XB_XCNT(j)]); sum += c; cnt += (c > 0u) ? 1u : 0u; mine = (j == x) ? c : mine; }
        if (sum == G) break;
        __builtin_amdgcn_s_sleep(1);
        if ((++sp & 255u) == 0u) { if (xb_ld(&bar[XB_TMO])) break; if (sp > XB_SPIN_CAP) { atomicAdd(&bar[XB_TMO], 1u); break; } }
    }
    nloc = mine > 0u ? mine : 1u; nx = cnt > 0u ? cnt : 1u;
}

__device__ __forceinline__ void xcd_barrier(const XcdBarrier& b) {
    asm volatile("s_waitcnt vmcnt(0)" ::: "memory");
    __syncthreads();
    if (threadIdx.x == 0) {
        unsigned* bar = b.bar;
        __builtin_amdgcn_s_waitcnt(0);
        unsigned nloc = b.st[0], nx = b.st[1];
        if (nloc == 0u) { xcd_barrier_complete(bar, b.x, nloc, nx); b.st[0] = nloc; b.st[1] = nx; }
        const unsigned old = xb_add(&bar[XB_XSUB(b.x)], 1u);
        const unsigned gen = old / nloc;
        if (old + 1u == (gen + 1u) * nloc) {
            __builtin_amdgcn_fence(__ATOMIC_RELEASE, "agent");
            asm volatile("s_waitcnt vmcnt(0)" ::: "memory");
            const unsigned og = xb_add(&bar[XB_TOP], 1u);
            const unsigned tg = og / nx;
            if (og + 1u == (tg + 1u) * nx) xb_add(&bar[XB_TOPGEN], 1u);
            else XB_SPIN(xb_ld(&bar[XB_TOPGEN]) == tg, bar);
            __builtin_amdgcn_fence(__ATOMIC_ACQUIRE, "agent");
            xb_add(&bar[XB_XGEN(b.x)], 1u);
            asm volatile("s_waitcnt vmcnt(0)" ::: "memory");
        } else {
            XB_SPIN(xb_ld(&bar[XB_XGEN(b.x)]) == gen, bar);
            __builtin_amdgcn_fence(__ATOMIC_ACQUIRE, "agent");
            asm volatile("s_waitcnt vmcnt(0)" ::: "memory");
        }
    }
    __syncthreads();
}

#define GAS __attribute__((address_space(1)))
typedef unsigned short bf16;
typedef float f32x4 __attribute__((ext_vector_type(4)));
typedef unsigned u32x4 __attribute__((ext_vector_type(4)));
typedef unsigned u32x2 __attribute__((ext_vector_type(2)));
constexpr int DM = 1024, NB = 8, SEQ = 4096, CTXL = 256, NLAT = NB * SEQ, NCTX = NB * CTXL, NROWS = NLAT + NCTX;
constexpr int INC = 7424;
constexpr int C_RQ = 0, C_RK = 512, C_RV = 1024, C_RG = 1536, C_AQ = 2048, C_AK = 2560, C_AV = 2688, C_HU = 2816, C_MG = 4352;
constexpr int NEXP = 32, DFF = 1024;
constexpr int MPAD = 147456;
constexpr float EPS = 1e-6f;
constexpr int NWAVES = 8, NTHR = 512;
constexpr int LDS_BYTES = 163840, LDSX = 155648, LDS_SRC = 131072;
constexpr int NPH_LAYER = 14, NPH = 1 + 2 * NPH_LAYER + 1;

constexpr size_t MiB = 1u << 20;
constexpr size_t WS_CTL = 0, CTL_ZERO_BYTES = 32768;
constexpr size_t CTL_BAR = 16384;
constexpr size_t CTL_MOD = 262144;
constexpr size_t WS_SRC = 6 * MiB;
constexpr size_t WS_L1P = 5 * MiB;
constexpr size_t WS_TOPI = 1 * MiB, WS_TOPW = 2 * MiB, WS_POS = 3 * MiB, WS_BLKCNT = 4 * MiB, WS_TILES = 4 * MiB + 65536;
constexpr size_t WS_WIN = 8 * MiB, WS_WBR = 37 * MiB, WS_WOUT = 43 * MiB, WS_W1 = 48 * MiB, WS_W2 = 304 * MiB;
constexpr size_t WS_HF = 432 * MiB;
constexpr size_t WS_HFC = 464 * MiB;
constexpr size_t WS_XM = 466 * MiB, WS_XO = 602 * MiB, WS_XN = 738 * MiB;
constexpr size_t WS_A = 806 * MiB;
constexpr size_t WS_P = WS_A, WS_RET = WS_A + 494 * MiB, WS_ATT = WS_RET + 34 * MiB, WS_HY = WS_ATT + 34 * MiB;
constexpr size_t WS_HS = WS_A, WS_ACT = WS_A + 288 * MiB;
constexpr size_t WS_MF32 = 1406 * MiB, WS_M = 1542 * MiB;
constexpr size_t WS_ZT = 1610 * MiB, WS_ZTC = 1674 * MiB, WS_YT = 1678 * MiB, WS_YTC = 1742 * MiB;
constexpr size_t WS_KV = 1746 * MiB, WS_SP = 1882 * MiB, WS_HSPEC = 1950 * MiB, WS_END = 2014 * MiB;
static_assert(WS_HY + 34 * MiB <= WS_MF32 && WS_ACT + 288 * MiB <= WS_MF32, "region A");
static_assert((size_t)NROWS * INC * 2 <= 494 * MiB, "P size");

__device__ __forceinline__ float bf2f(bf16 v) { return __uint_as_float(((unsigned)v) << 16); }
__device__ __forceinline__ bf16 f2bf(float f) { unsigned u = __float_as_uint(f); u += 0x7FFFu + ((u >> 16) & 1u); return (bf16)(u >> 16); }
__device__ __forceinline__ unsigned pk2(float lo, float hi) { return pg8::cvt_pk_bf16(lo, hi); }
#define WS_DPP(v, ctrl) __int_as_float(__builtin_amdgcn_update_dpp(0, __float_as_int(v), (ctrl), 0xF, 0xF, false))
__device__ __forceinline__ float wave_sum(float v) {
    v += WS_DPP(v, 0xB1);
    v += WS_DPP(v, 0x4E);
    v += WS_DPP(v, 0x124);
    v += WS_DPP(v, 0x128);
    const float s0 = __int_as_float(__builtin_amdgcn_readlane(__float_as_int(v), 0)), s1 = __int_as_float(__builtin_amdgcn_readlane(__float_as_int(v), 16));
    const float s2 = __int_as_float(__builtin_amdgcn_readlane(__float_as_int(v), 32)), s3 = __int_as_float(__builtin_amdgcn_readlane(__float_as_int(v), 48));
    return (s0 + s1) + (s2 + s3);
}
__device__ __forceinline__ float rdlane(float v, int l) { return __int_as_float(__builtin_amdgcn_readlane(__float_as_int(v), l)); }
__device__ __forceinline__ float sin_rev(float rev) { return __builtin_amdgcn_sinf(__builtin_amdgcn_fractf(rev)); }
__device__ __forceinline__ float cos_rev(float rev) { return __builtin_amdgcn_cosf(__builtin_amdgcn_fractf(rev)); }
__device__ __forceinline__ float sin_rad(float x) { return sin_rev(x * 0.15915494309189535f); }
__device__ __forceinline__ float sigmoidf_(float x) { return 1.0f / (1.0f + __expf(-x)); }
__device__ __forceinline__ float siluf_(float x) { return x / (1.0f + __expf(-x)); }
__device__ __forceinline__ float log_sigmoid_(float x) {
    const float y = __expf(-x);
    if (y < 0.1f) { return -(y * (1.0f + y * (-0.5f + y * (0.33333333f + y * (-0.25f + y * (0.2f + y * (-0.16666667f + y * (0.14285714f + y * (-0.125f))))))))); }
    return -logf(1.0f + y);
}
#define LDS_WAIT() asm volatile("s_waitcnt lgkmcnt(0)" ::: "memory")
#define VM_WAIT() asm volatile("s_waitcnt vmcnt(0)" ::: "memory")

struct Args { const float* in[31]; float* out; unsigned char* ws; int ph_lo, ph_hi; };

extern __shared__ __attribute__((aligned(16))) unsigned char lds_raw[];
constexpr int LDS_PTAB = LDSX + 1024;
struct Frame {
    LAS unsigned char* lds;
    int tid, lane, wave, G, bx;
    unsigned char* ws;
};
__device__ __forceinline__ unsigned long long ptab_read(int i) {
    const LAS unsigned* p = (const LAS unsigned*)((LAS unsigned char*)lds_raw + LDS_PTAB) + 2 * i;
    const unsigned lo = (unsigned)__builtin_amdgcn_readfirstlane((int)p[0]), hi = (unsigned)__builtin_amdgcn_readfirstlane((int)p[1]);
    return ((unsigned long long)hi << 32) | lo;
}
__device__ __forceinline__ const float* IN_(const Frame& F, int i) { return (const float*)(const GAS float*)ptab_read(i); }
__device__ __forceinline__ float* OUT_(const Frame& F) { return (float*)(GAS float*)ptab_read(31); }
__device__ __forceinline__ Frame make_frame() {
    Frame F; F.lds = (LAS unsigned char*)lds_raw;
    int t = threadIdx.x; asm volatile("" : "+v"(t)); F.tid = t; F.lane = t & 63; F.wave = __builtin_amdgcn_readfirstlane(t >> 6);
    int g = gridDim.x, bx = blockIdx.x; asm volatile("" : "+s"(g), "+s"(bx)); F.G = g; F.bx = bx;
    unsigned long long w = ptab_read(32); asm volatile("" : "+s"(w)); F.ws = (unsigned char*)(GAS unsigned char*)w; return F;
}
template <class T> __device__ __forceinline__ T* WSP(const Frame& F, size_t off) { return (T*)(F.ws + off); }
__device__ __forceinline__ const float* mod_ptr(const Frame& F, int l, int modrow, int chunk) { return WSP<float>(F, WS_CTL + CTL_MOD) + ((size_t)(l * 9 + modrow) * 6 + chunk) * DM; }
__device__ __forceinline__ int modrow_of(int r) { return r < NLAT ? (r >> 12) : 8; }

constexpr int TRP = 65;
__device__ __forceinline__ void tr_item(const float* W, int K, int N, bf16* WT, int ldk, int item, int w1map, LAS float* scr, int lane) {
    const int nblk = N >> 6, kb = item / nblk, nb = item - kb * nblk, k0 = 64 * kb, n0 = 64 * nb;
    const int r = lane >> 4, cq = lane & 15;
    const float* src = W + (size_t)(k0 + r) * N + n0 + 4 * cq;
#pragma unroll 1
    for (int hh = 0; hh < 2; ++hh) {
        f32x4 v[8];
#pragma unroll
        for (int i = 0; i < 8; ++i) v[i] = *(const f32x4*)(src + (size_t)(4 * (8 * hh + i)) * N);
#pragma unroll
        for (int i = 0; i < 8; ++i) { LAS float* d = scr + (4 * (8 * hh + i) + r) * TRP + 4 * cq; d[0] = v[i][0]; d[1] = v[i][1]; d[2] = v[i][2]; d[3] = v[i][3]; }
    }
    LDS_WAIT(); asm volatile("" ::: "memory");
    int r0 = n0;
    if (w1map == 1) r0 = (n0 < 1024) ? ((n0 >> 7) * 256 + (n0 & 127)) : ((((n0 - 1024) >> 7) * 256) + 128 + ((n0 - 1024) & 127));
    const int kc = lane & 7;
#pragma unroll
    for (int j = 0; j < 8; ++j) { const int n = (lane >> 3) + 8 * j; const LAS float* s = scr + (8 * kc) * TRP + n;
        u32x4 o; o.x = pk2(s[0 * TRP], s[1 * TRP]); o.y = pk2(s[2 * TRP], s[3 * TRP]); o.z = pk2(s[4 * TRP], s[5 * TRP]); o.w = pk2(s[6 * TRP], s[7 * TRP]);
        int row = r0 + n;
        if (w1map == 2) {
            const int c = n0 + n;
            if (c < 1024) row = (c & ~255) + ((c >> 6) & 1) * 128 + ((c >> 7) & 1) * 64 + (c & 63);
            else if (c >= C_AQ && c < C_AV) { const int d = c & 63, gq = d >> 4, hd = (c >> 6) & 3; row = (c & ~255) + (gq & 1) * 128 + hd * 32 + (gq >> 1) * 16 + (d & 15); }
            else if (c >= C_AV && c < C_HU) { const int jv = c - C_AV; row = C_AK + (jv >> 6) * 128 + 64 + (jv & 63); }
        }
        *(u32x4*)(WT + (size_t)row * ldk + k0 + 8 * kc) = o; }
    LDS_WAIT(); asm volatile("" ::: "memory");
}

__device__ __forceinline__ void hy_filter_item(Frame& F, int f, int tb) {
    const int lane = F.lane;
    float* L1P = WSP<float>(F, WS_L1P);
    LAS float* H2 = (LAS float*)F.lds + 16384;
    LAS float* red = H2 + 32 * 64;
    const int L = (f == 2) ? 256 : 4096, l = (f == 1) ? 1 : 0;
    const float* w1 = IN_(F, 12) + l * 33 * 64; const float* b1 = IN_(F, 13) + l * 64; const float* f1 = IN_(F, 14) + l * 64;
    const float* w2 = IN_(F, 15) + l * 64 * 64; const float* b2 = IN_(F, 16) + l * 64; const float* f2 = IN_(F, 17) + l * 64;
    const float* w3 = IN_(F, 18) + (size_t)l * 64 * 1024;
    float* HFp = (f == 2) ? WSP<float>(F, WS_HFC) : WSP<float>(F, WS_HF + (size_t)l * 16 * MiB);
    float* HBp = (f == 2) ? WSP<float>(F, WS_HFC + 512 * 1024) : WSP<float>(F, WS_HF + (size_t)l * 16 * MiB + 8 * MiB);
    __syncthreads();
    {
        float w1c[33], w2c[64];
#pragma unroll
        for (int i = 0; i < 33; ++i) w1c[i] = w1[i * 64 + lane];
#pragma unroll
        for (int i = 0; i < 64; ++i) w2c[i] = w2[i * 64 + lane];
        const float b1l = b1[lane], f1l = f1[lane], b2l = b2[lane], f2l = f2[lane];
#pragma unroll 1
        for (int r = 0; r < 4; ++r) {
            const int n = tb * 32 + F.wave * 4 + r;
            float zl = 0.f;
            if (lane == 0) zl = (float)n / (float)(L - 1);
            else if (lane <= 32) { const int j = (lane - 1) & 15; const float band = 1e-4f + (15.0f - 1e-4f) * (float)j / 15.0f; const float rev = (float)n * band / (float)L;
                zl = (lane <= 16) ? cos_rev(rev) : -sin_rev(rev); }
            float a = 0.f;
#pragma unroll
            for (int i = 0; i < 33; ++i) a += rdlane(zl, i) * w1c[i];
            const float h1 = sin_rad(f1l * (a + b1l));
            float a2 = 0.f;
#pragma unroll
            for (int i = 0; i < 64; ++i) a2 += rdlane(h1, i) * w2c[i];
            H2[(F.wave * 4 + r) * 64 + lane] = sin_rad(f2l * (a2 + b2l));
        }
    }
    __syncthreads();
    const int c1 = F.wave * 128 + lane, c2 = c1 + 64;
    float l1p[2] = {0.f, 0.f};
#pragma unroll 1
    for (int rh = 0; rh < 2; ++rh) {
        float acc[16][2];
#pragma unroll
        for (int r = 0; r < 16; ++r) { acc[r][0] = 0.f; acc[r][1] = 0.f; }
#pragma unroll 1
        for (int i = 0; i < 64; i += 4) {
            float wa[4], wb[4];
#pragma unroll
            for (int k = 0; k < 4; ++k) { wa[k] = w3[(i + k) * 1024 + c1]; wb[k] = w3[(i + k) * 1024 + c2]; }
            f32x4 hh[16];
#pragma unroll
            for (int r = 0; r < 16; ++r) hh[r] = *(const LAS f32x4*)(H2 + (rh * 16 + r) * 64 + i);
            __builtin_amdgcn_sched_barrier(0);
#pragma unroll
            for (int r = 0; r < 16; ++r) { const f32x4 h = hh[r];
                acc[r][0] += h[0] * wa[0] + h[1] * wa[1] + h[2] * wa[2] + h[3] * wa[3]; acc[r][1] += h[0] * wb[0] + h[1] * wb[1] + h[2] * wb[2] + h[3] * wb[3]; }
        }
#pragma unroll
        for (int q = 0; q < 2; ++q) {
            const int c = q ? c2 : c1, cc = c & 511;
            const float delta = 3.0701134573253944f + (15.350567286626973f - 3.0701134573253944f) * (float)cc / 511.0f;
            float* dst = ((c < 512) ? HFp : HBp) + (size_t)(tb * 32 + rh * 16) * 512 + cc;
#pragma unroll
            for (int r = 0; r < 16; ++r) { const int n = tb * 32 + rh * 16 + r; const float tn = (float)n / (float)(L - 1); const float v = acc[r][q] * __expf(-tn * delta);
                dst[r * 512] = v;
                if (c < 512 || n >= 1) l1p[q] += fabsf(v); }
        }
    }
    red[c1] = l1p[0]; red[c2] = l1p[1];
    __syncthreads();
    L1P[(size_t)(f * 128 + tb) * 512 + F.tid] = red[F.tid] + red[512 + F.tid];
}
__device__ __forceinline__ void p0_prologue(Frame& F) {
    LAS float* scr = (LAS float*)(F.lds + F.wave * (64 * TRP * 4));
    const int gw = F.bx * NWAVES + F.wave, NGW = F.G * NWAVES, lane = F.lane;
    constexpr int I_WIN = 16 * 116, I_WBR = 8 * 16, I_WOUT = 16 * 16, I_W1 = 16 * 32, I_W2 = 16 * 16;
    constexpr int N_WIN = 2 * I_WIN, N_WBR = 6 * I_WBR, N_WOUT = 2 * I_WOUT, N_W1 = 32 * I_W1, N_W2 = 32 * I_W2;
    constexpr int NTR = N_WIN + N_WBR + N_WOUT + N_W1 + N_W2;
#pragma unroll 1
    for (int it = gw; it < NTR; it += NGW) {
        int r = it; const float* W; bf16* WT; int K, N, item, w1map = 0, ldk = 1024;
        if (r < N_WIN) { const int l = r / I_WIN; W = IN_(F, 7) + (size_t)l * 1024 * INC; K = 1024; N = INC; WT = WSP<bf16>(F, WS_WIN) + (size_t)l * INC * 1024; item = r % I_WIN; w1map = 2; }
        else if ((r -= N_WIN) < N_WBR) { const int q = r / I_WBR; W = IN_(F, 20) + (size_t)q * 512 * 1024; K = 512; N = 1024; WT = WSP<bf16>(F, WS_WBR) + (size_t)(q / 3) * 1024 * 1536 + (q % 3) * 512; ldk = 1536; item = r % I_WBR; }
        else if ((r -= N_WBR) < N_WOUT) { const int l = r / I_WOUT; W = IN_(F, 22) + (size_t)l * 1024 * 1024; K = 1024; N = 1024; WT = WSP<bf16>(F, WS_WOUT) + (size_t)l * 1024 * 1024; item = r % I_WOUT; }
        else if ((r -= N_WOUT) < N_W1) { const int q = r / I_W1; W = IN_(F, 26) + (size_t)q * 1024 * 2048; K = 1024; N = 2048; WT = WSP<bf16>(F, WS_W1) + (size_t)q * 2048 * 1024; item = r % I_W1; w1map = 1; }
        else { r -= N_W1; const int q = r / I_W2; W = IN_(F, 28) + (size_t)q * 1024 * 1024; K = 1024; N = 1024; WT = WSP<bf16>(F, WS_W2) + (size_t)q * 1024 * 1024; item = r % I_W2; }
        tr_item(W, K, N, WT, ldk, item, w1map, scr, lane);
    }
#ifndef PRO_B
#define PRO_B 1
#endif
#ifndef PRO_C
#define PRO_C 1
#endif
    __syncthreads();
    if (PRO_B) {
        float* mod = WSP<float>(F, WS_CTL + CTL_MOD);
        LAS float* sc = (LAS float*)F.lds;
        LAS float* red = sc + 1024 * 12;
        if (F.bx < 192) {
            for (int i = F.tid; i < 9 * 1024; i += NTHR) { const int r = i >> 10, k = i & 1023; const float cv = (r < 8) ? IN_(F, 1)[r * 1024 + k] : IN_(F, 3)[k]; sc[k * 12 + r] = siluf_(cv); }
            __syncthreads();
            const int it = F.bx, l = it / 96, cc = it % 96, col = cc * 64 + lane, k0 = F.wave * 128;
            const float* wm = IN_(F, 4) + (size_t)l * 1024 * 6144 + col;
            float acc[9];
#pragma unroll
            for (int r = 0; r < 9; ++r) acc[r] = 0.f;
#pragma unroll 1
            for (int kb = 0; kb < 128; kb += 16) {
                float w[16];
#pragma unroll
                for (int k = 0; k < 16; ++k) w[k] = wm[(size_t)(k0 + kb + k) * 6144];
#pragma unroll
                for (int k = 0; k < 16; ++k) { const LAS float* s = sc + (k0 + kb + k) * 12; const f32x4 s0 = *(const LAS f32x4*)s, s1 = *(const LAS f32x4*)(s + 4); const float s8 = s[8];
                    acc[0] += s0[0] * w[k]; acc[1] += s0[1] * w[k]; acc[2] += s0[2] * w[k]; acc[3] += s0[3] * w[k];
                    acc[4] += s1[0] * w[k]; acc[5] += s1[1] * w[k]; acc[6] += s1[2] * w[k]; acc[7] += s1[3] * w[k]; acc[8] += s8 * w[k]; }
            }
#pragma unroll
            for (int r = 0; r < 9; ++r) red[(F.wave * 9 + r) * 64 + lane] = acc[r];
            __syncthreads();
            for (int idx = F.tid; idx < 576; idx += NTHR) { const int r = idx >> 6, c = idx & 63; float s = 0.f;
#pragma unroll
                for (int w = 0; w < 8; ++w) s += red[(w * 9 + r) * 64 + c];
                mod[(size_t)(l * 9 + r) * 6144 + cc * 64 + c] = s + IN_(F, 5)[l * 6144 + cc * 64 + c]; }
        }
    }
    if (PRO_C) {
#pragma unroll 1
        for (int it = F.bx; it < 256; it += F.G) hy_filter_item(F, it >> 7, it & 127);
    }
}
constexpr int TRD_TOTAL = 32 * 512 + 32 * 256;
__device__ __forceinline__ void tr_deferred(Frame& F, int first, int count, int rank, int nblk) {
    LAS float* scr = (LAS float*)(F.lds + F.wave * (64 * TRP * 4));
    __syncthreads();
#pragma unroll 1
    for (int d = first + rank * NWAVES + F.wave; d < first + count; d += nblk * NWAVES) {
        if (d < 32 * 512) { const int q = 32 + (d >> 9); tr_item(IN_(F, 26) + (size_t)q * 1024 * 2048, 1024, 2048, WSP<bf16>(F, WS_W1) + (size_t)q * 2048 * 1024, 1024, d & 511, 1, scr, F.lane); }
        else { const int dd = d - 32 * 512, q = 32 + (dd >> 8); tr_item(IN_(F, 28) + (size_t)q * 1024 * 1024, 1024, 1024, WSP<bf16>(F, WS_W2) + (size_t)q * 1024 * 1024, 1024, dd & 255, 0, scr, F.lane); }
    }
}
__device__ __forceinline__ float hy_inv_l1(const Frame& F, int f, int c) {
    const float* L1P = WSP<float>(F, WS_L1P) + (size_t)f * 128 * 512 + c; const int nb = (f == 2) ? 8 : 128; const int lane = F.lane;
    float s = (lane < nb ? L1P[(size_t)lane * 512] : 0.f) + (lane + 64 < nb ? L1P[(size_t)(lane + 64) * 512] : 0.f);
    return 1.0f / wave_sum(s);
}

__device__ __forceinline__ void ph_norm1(Frame& F, int mode) {
    const int gw = F.bx * NWAVES + F.wave, NGW = F.G * NWAVES, lane = F.lane;
    const int nrows = (mode == 2) ? NLAT : NROWS;
    const int l = (mode == 0) ? 0 : 1;
    const bf16* Y = WSP<bf16>(F, WS_HS);
    const int* POS = WSP<int>(F, WS_POS); const float* TOPW = WSP<float>(F, WS_TOPW);
    f32x4 xnext[4]; int pnext[4]; float wnext[4];
#define N1_FETCH(r_) do { const int rf_ = (r_); \
        const float* xr_ = (mode == 0) ? ((rf_ < NLAT) ? IN_(F, 0) + (size_t)rf_ * DM : IN_(F, 2) + (size_t)(rf_ - NLAT) * DM) : (WSP<float>(F, WS_XM) + (size_t)rf_ * DM); \
        _Pragma("unroll") for (int j = 0; j < 4; ++j) xnext[j] = *(const f32x4*)(xr_ + 4 * lane + 256 * j); \
        if (mode != 0) { _Pragma("unroll") for (int k = 0; k < 4; ++k) { pnext[k] = POS[rf_ * 4 + k]; wnext[k] = TOPW[rf_ * 4 + k]; } } } while (0)
    if (gw < nrows) N1_FETCH(gw);
#pragma unroll 1
    for (int r = gw; r < nrows; r += NGW) {
        const int mr = modrow_of(r);
        f32x4 mg[4], ma[4], mb[4], g2v[4];
        { const float* gp_ = (mode == 2) ? IN_(F, 30) : IN_(F, 6) + l * DM;
#pragma unroll
          for (int j = 0; j < 4; ++j) mg[j] = *(const f32x4*)(gp_ + 4 * lane + 256 * j);
          if (mode != 2) { const float* sh = mod_ptr(F, l, mr, 0); const float* sc = mod_ptr(F, l, mr, 1);
#pragma unroll
              for (int j = 0; j < 4; ++j) { ma[j] = *(const f32x4*)(sh + 4 * lane + 256 * j); mb[j] = *(const f32x4*)(sc + 4 * lane + 256 * j); } }
          if (mode != 0) { const float* g2l = mod_ptr(F, (mode == 2) ? 1 : 0, mr, 5);
#pragma unroll
              for (int j = 0; j < 4; ++j) g2v[j] = *(const f32x4*)(g2l + 4 * lane + 256 * j); } }
        __builtin_amdgcn_sched_barrier(0);
        f32x4 v[4];
        if (mode == 0) {
#pragma unroll
            for (int j = 0; j < 4; ++j) v[j] = xnext[j];
            if (r + NGW < nrows) N1_FETCH(r + NGW);
        } else {
            f32x4 xcur[4]; int pc[4]; float wc[4];
#pragma unroll
            for (int j = 0; j < 4; ++j) xcur[j] = xnext[j];
#pragma unroll
            for (int k = 0; k < 4; ++k) { pc[k] = pnext[k]; wc[k] = wnext[k]; }
            u32x2 yv[4][4];
#pragma unroll
            for (int k = 0; k < 4; ++k) { const bf16* yr = Y + (size_t)pc[k] * DM;
#pragma unroll
                for (int j = 0; j < 4; ++j) yv[k][j] = *(const u32x2*)(yr + 4 * lane + 256 * j); }
            if (r + NGW < nrows) N1_FETCH(r + NGW);
            f32x4 s[4];
#pragma unroll
            for (int j = 0; j < 4; ++j) s[j] = (f32x4){0.f, 0.f, 0.f, 0.f};
#pragma unroll
            for (int k = 0; k < 4; ++k) { const float w = wc[k];
#pragma unroll
                for (int j = 0; j < 4; ++j) { const u32x2 y2 = yv[k][j];
                    s[j][0] += w * __uint_as_float(y2.x << 16); s[j][1] += w * __uint_as_float(y2.x & 0xffff0000u);
                    s[j][2] += w * __uint_as_float(y2.y << 16); s[j][3] += w * __uint_as_float(y2.y & 0xffff0000u); } }
#pragma unroll
            for (int j = 0; j < 4; ++j) v[j] = xcur[j] + g2v[j] * s[j];
            if (mode == 1) { float* xo = WSP<float>(F, WS_XO) + (size_t)r * DM;
#pragma unroll
                for (int j = 0; j < 4; ++j) *(f32x4*)(xo + 4 * lane + 256 * j) = v[j]; }
        }
        float ss = 0.f;
#pragma unroll
        for (int j = 0; j < 4; ++j) ss += (v[j][0] * v[j][0] + v[j][1] * v[j][1]) + (v[j][2] * v[j][2] + v[j][3] * v[j][3]);
        const float rstd = 1.0f / sqrtf(wave_sum(ss) * (1.0f / DM) + EPS);
        if (mode == 2) {
            float* o = OUT_(F) + (size_t)r * DM;
#pragma unroll
            for (int j = 0; j < 4; ++j) *(f32x4*)(o + 4 * lane + 256 * j) = v[j] * rstd * mg[j];
        } else {
            bf16* o = WSP<bf16>(F, WS_XN) + (size_t)r * DM;
#pragma unroll
            for (int j = 0; j < 4; ++j) { const f32x4 y = v[j] * rstd * mg[j] * (mb[j] + 1.0f) + ma[j];
                u32x2 w2; w2.x = pk2(y[0], y[1]); w2.y = pk2(y[2], y[3]); *(u32x2*)(o + 4 * lane + 256 * j) = w2; }
        }
    }
#undef N1_FETCH
}

struct EpiP {
    static constexpr bool PERM = true, AFTER_DRAIN = false, KMID = false; static constexpr int NSTORE = 16;
    bf16* O; const float* bg;
    __device__ __forceinline__ static void st8(bf16* p, const float (&v)[8]) { u32x4 w; w.x = pk2(v[0], v[1]); w.y = pk2(v[2], v[3]); w.z = pk2(v[4], v[5]); w.w = pk2(v[6], v[7]); *(u32x4*)p = w; }
    __device__ __forceinline__ void operator()(const f32x4 (&acc)[2][2][4][2], const pg8::Unit& u, int wr, int wc, int fr, int fq) const {
        const int row0 = u.pm * 256 + wr * 64 + fr, pn = u.pn;
        const bool rot = u.pm < (NLAT / 256);
        const bool is_ret = pn < 4, is_aq = (pn == 8 || pn == 9), is_akv = (pn == 10);
        if (!(is_ret || is_aq || is_akv) || (is_akv && wc >= 2)) {
            const int colA = is_akv ? (C_AV + (wc - 2) * 32 + 8 * fq) : (pn * 256 + wc * 32 + 8 * fq), colB = is_akv ? (colA + 64) : (colA + 128);
            f32x4 ba0 = (f32x4){0.f, 0.f, 0.f, 0.f}, ba1 = ba0, bb0 = ba0, bb1 = ba0;
            if (pn >= 17) { ba0 = *(const f32x4*)(bg + colA - C_MG); ba1 = *(const f32x4*)(bg + colA - C_MG + 4); bb0 = *(const f32x4*)(bg + colB - C_MG); bb1 = *(const f32x4*)(bg + colB - C_MG + 4); }
#pragma unroll
            for (int ai = 0; ai < 2; ++ai)
#pragma unroll
                for (int m = 0; m < 4; ++m) { bf16* rowp = O + (size_t)(row0 + ai * 128 + m * 16) * INC;
                    float a[8], b[8];
#pragma unroll
                    for (int j = 0; j < 4; ++j) { a[j] = acc[ai][0][m][0][j] + ba0[j]; a[4 + j] = acc[ai][0][m][1][j] + ba1[j]; b[j] = acc[ai][1][m][0][j] + bb0[j]; b[4 + j] = acc[ai][1][m][1][j] + bb1[j]; }
                    if (pn >= 17) {
                        typedef float f32x2 __attribute__((ext_vector_type(2)));
#pragma unroll
                        for (int j = 0; j < 8; j += 2) { f32x2 za = {a[j], a[j + 1]}, zb = {b[j], b[j + 1]}; za = za * -1.4426950408889634f; zb = zb * -1.4426950408889634f;
                            za.x = __builtin_amdgcn_exp2f(za.x); za.y = __builtin_amdgcn_exp2f(za.y); zb.x = __builtin_amdgcn_exp2f(zb.x); zb.y = __builtin_amdgcn_exp2f(zb.y);
                            za = za + 1.0f; zb = zb + 1.0f;
                            a[j] = fminf(za.x, 1.0e30f); a[j + 1] = fminf(za.y, 1.0e30f); b[j] = fminf(zb.x, 1.0e30f); b[j + 1] = fminf(zb.y, 1.0e30f); } }
                    st8(rowp + colA, a); st8(rowp + colB, b); asm volatile("" ::: "memory"); }
            return;
        }
        int col1, col2, ibase; float fexp; bool use_col = false;
        if (is_ret) { const int hd = wc >> 1; ibase = (wc & 1) * 32 + 8 * fq; col1 = pn * 256 + hd * 128 + ibase; col2 = col1 + 64; fexp = 13.287712379549449f / 63.0f; }
        else { const int rc = fq >> 1; ibase = 8 * (fq & 1); const int hb = is_aq ? (pn * 256 + wc * 64) : (C_AK + wc * 64); col1 = hb + rc * 32 + ibase; col2 = col1 + 16; fexp = 13.287712379549449f / 16.0f; use_col = rc != 0; }
        float invf[8];
#pragma unroll
        for (int k = 0; k < 8; ++k) invf[k] = __builtin_amdgcn_exp2f(-(float)(ibase + k) * fexp) * 0.15915494309189535f;
#pragma unroll
        for (int ai = 0; ai < 2; ++ai)
#pragma unroll
            for (int m = 0; m < 4; ++m) { const int row = row0 + ai * 128 + m * 16; bf16* rowp = O + (size_t)row * INC;
                const int t = row & 4095;
                const float pos = is_ret ? (float)t : (use_col ? (float)(t & 63) : (float)(t >> 6));
                float o1[8], o2[8];
#pragma unroll
                for (int k = 0; k < 8; ++k) { const float x1 = acc[ai][0][m][k >> 2][k & 3], x2 = acc[ai][1][m][k >> 2][k & 3];
                    float cs = 1.0f, sn = 0.0f;
                    if (rot) { const float rev = pos * invf[k]; cs = cos_rev(rev); sn = sin_rev(rev); }
                    o1[k] = x1 * cs - x2 * sn; o2[k] = x1 * sn + x2 * cs; }
                st8(rowp + col1, o1); st8(rowp + col2, o2); asm volatile("" ::: "memory"); }
    }
};
struct EpiMerge {
    static constexpr bool PERM = true, AFTER_DRAIN = false, KMID = true; static constexpr int NSTORE = 16;
    const bf16* P; bf16* Mo;
    typedef float f32x2 __attribute__((ext_vector_type(2)));
    __device__ __forceinline__ static f32x2 g2(unsigned w) { f32x2 r; r.x = __uint_as_float(w << 16); r.y = __uint_as_float(w & 0xffff0000u); return r; }
    struct Batch { u32x4 gn[2][2], go[2][2]; };
    __device__ __forceinline__ void fetch(Batch& B, int row0, unsigned col0, unsigned g_old, int ai, int mh) const {
#pragma unroll
        for (int mm = 0; mm < 2; ++mm) { const unsigned rowb = (unsigned)(row0 + ai * 128 + (2 * mh + mm) * 16) * (unsigned)(INC * 2);
#pragma unroll
            for (int bj = 0; bj < 2; ++bj) { const unsigned c = col0 + bj * 128;
                B.gn[mm][bj] = *(const u32x4*)((const char*)P + rowb + (C_MG + (g_old + 1) * 1024 + c) * 2); B.go[mm][bj] = *(const u32x4*)((const char*)P + rowb + (C_MG + g_old * 1024 + c) * 2); } }
    }
    __device__ __forceinline__ static void apply(const Batch& B, f32x4 (&acc)[2][2][4][2], int ai, int mh) {
#pragma unroll
        for (int mm = 0; mm < 2; ++mm)
#pragma unroll
            for (int bj = 0; bj < 2; ++bj) { const unsigned gnw[4] = {B.gn[mm][bj].x, B.gn[mm][bj].y, B.gn[mm][bj].z, B.gn[mm][bj].w}, gow[4] = {B.go[mm][bj].x, B.go[mm][bj].y, B.go[mm][bj].z, B.go[mm][bj].w};
#pragma unroll
                for (int i = 0; i < 4; ++i) { const f32x2 dold = g2(gow[i]); f32x2 ro; ro.x = __builtin_amdgcn_rcpf(dold.x); ro.y = __builtin_amdgcn_rcpf(dold.y);
                    const f32x2 r = g2(gnw[i]) * ro;
                    f32x4& A = acc[ai][bj][2 * mh + mm][i >> 1];
                    if (i & 1) { A.z *= r.x; A.w *= r.y; } else { A.x *= r.x; A.y *= r.y; } } }
    }
    __device__ __forceinline__ void kmid(int t, f32x4 (&acc)[2][2][4][2], const pg8::Unit& u, int wr, int wc, int fr, int fq) const {
        int row0 = u.pm * 256 + wr * 64 + fr; asm volatile("" : "+v"(row0));
        const unsigned col0 = (unsigned)(u.pn * 256 + wc * 32 + 8 * fq), g_old = (t == 8) ? 0u : 1u;
        Batch B0, B1;
        fetch(B0, row0, col0, g_old, 0, 0);
        fetch(B1, row0, col0, g_old, 0, 1); asm volatile("" ::: "memory");
        apply(B0, acc, 0, 0);
        fetch(B0, row0, col0, g_old, 1, 0); asm volatile("" ::: "memory");
        apply(B1, acc, 0, 1);
        fetch(B1, row0, col0, g_old, 1, 1); asm volatile("" ::: "memory");
        apply(B0, acc, 1, 0);
        apply(B1, acc, 1, 1);
    }
    __device__ __forceinline__ void operator()(const f32x4 (&acc)[2][2][4][2], const pg8::Unit& u, int wr, int wc, int fr, int fq) const {
        int row0 = u.pm * 256 + wr * 64 + fr; asm volatile("" : "+v"(row0));
        const unsigned col0 = (unsigned)(u.pn * 256 + wc * 32 + 8 * fq);
        u32x4 gh[2][4][2];
#pragma unroll
        for (int ai = 0; ai < 2; ++ai)
#pragma unroll
            for (int m = 0; m < 4; ++m) { const unsigned rowb = (unsigned)(row0 + ai * 128 + m * 16) * (unsigned)(INC * 2);
#pragma unroll
                for (int bj = 0; bj < 2; ++bj) gh[ai][m][bj] = *(const u32x4*)((const char*)P + rowb + (C_MG + 2048 + col0 + bj * 128) * 2); }
#pragma unroll
        for (int ai = 0; ai < 2; ++ai) {
#pragma unroll
            for (int m = 0; m < 4; ++m) { const unsigned row = (unsigned)(row0 + ai * 128 + m * 16);
#pragma unroll
                for (int bj = 0; bj < 2; ++bj) { float v[8]; const unsigned ghw[4] = {gh[ai][m][bj].x, gh[ai][m][bj].y, gh[ai][m][bj].z, gh[ai][m][bj].w};
#pragma unroll
                    for (int i = 0; i < 4; ++i) { const f32x2 d = g2(ghw[i]); v[2 * i] = acc[ai][bj][m][i >> 1][2 * (i & 1)] * __builtin_amdgcn_rcpf(d.x); v[2 * i + 1] = acc[ai][bj][m][i >> 1][2 * (i & 1) + 1] * __builtin_amdgcn_rcpf(d.y); }
                    u32x4 w; w.x = pk2(v[0], v[1]); w.y = pk2(v[2], v[3]); w.z = pk2(v[4], v[5]); w.w = pk2(v[6], v[7]);
                    *(u32x4*)((char*)Mo + (row * (unsigned)(DM * 2) + (col0 + bj * 128) * 2)) = w; } }
            asm volatile("" ::: "memory"); }
    }
};
struct EpiOut {
    static constexpr bool PERM = false, AFTER_DRAIN = false, KMID = false; static constexpr int NSTORE = 32;
    const float* xlat; const float* xctx; const float* g1base; float* XM;
    __device__ __forceinline__ void operator()(const f32x4 (&acc)[2][2][4][2], const pg8::Unit& u, int wr, int wc, int fr, int fq) const {
        int row0 = u.pm * 256 + wr * 64 + fr; asm volatile("" : "+v"(row0));
        const int col0 = u.pn * 256 + wc * 32 + 4 * fq;
        const bool lat = u.pm < (NLAT / 256);
        const float* xb = lat ? xlat : xctx - (size_t)NLAT * DM;
        const float* g1 = g1base + (size_t)modrow_of(u.pm * 256) * 6 * DM + col0;
        f32x4 gv[2][2];
#pragma unroll
        for (int bj = 0; bj < 2; ++bj)
#pragma unroll
            for (int n = 0; n < 2; ++n) gv[bj][n] = *(const f32x4*)(g1 + bj * 128 + n * 16);
#pragma unroll
        for (int ai = 0; ai < 2; ++ai) {
            f32x4 xv[4][2][2];
#pragma unroll
            for (int m = 0; m < 4; ++m) { const float* xr = xb + (size_t)(row0 + ai * 128 + m * 16) * DM + col0;
#pragma unroll
                for (int bj = 0; bj < 2; ++bj)
#pragma unroll
                    for (int n = 0; n < 2; ++n) xv[m][bj][n] = *(const f32x4*)(xr + bj * 128 + n * 16); }
#pragma unroll
            for (int m = 0; m < 4; ++m) { float* xo = XM + (size_t)(row0 + ai * 128 + m * 16) * DM + col0;
#pragma unroll
                for (int bj = 0; bj < 2; ++bj)
#pragma unroll
                    for (int n = 0; n < 2; ++n) *(f32x4*)(xo + bj * 128 + n * 16) = xv[m][bj][n] + gv[bj][n] * acc[ai][bj][m][n]; }
            asm volatile("" ::: "memory"); }
    }
};
struct EpiMoe1 {
    static constexpr bool PERM = true, AFTER_DRAIN = false, KMID = false; static constexpr int NSTORE = 8;
    const float* b1; bf16* ACT;
    __device__ __forceinline__ void operator()(const f32x4 (&acc)[2][2][4][2], const pg8::Unit& u, int wr, int wc, int fr, int fq) const {
        const int e = u.pn >> 3, p = u.pn & 7;
        const int row0 = u.pm * 256 + wr * 64 + fr, gcol0 = p * 128 + wc * 32 + 8 * fq;
        const float* bb = b1 + (size_t)e * 2048 + gcol0;
        typedef float f32x2 __attribute__((ext_vector_type(2)));
        const f32x4 bgv[2] = {*(const f32x4*)(bb), *(const f32x4*)(bb + 4)};
        const f32x4 blv[2] = {*(const f32x4*)(bb + 1024) + 1.0f, *(const f32x4*)(bb + 1028) + 1.0f};
#pragma unroll
        for (int ai = 0; ai < 2; ++ai)
#pragma unroll
            for (int m = 0; m < 4; ++m) { bf16* rowp = ACT + (size_t)(row0 + ai * 128 + m * 16) * DFF + gcol0;
                unsigned w[4];
#pragma unroll
                for (int n = 0; n < 2; ++n)
#pragma unroll
                    for (int hp = 0; hp < 2; ++hp) {
                        const f32x2 av = hp ? acc[ai][0][m][n].hi : acc[ai][0][m][n].lo, lv = hp ? acc[ai][1][m][n].hi : acc[ai][1][m][n].lo;
                        const f32x2 bg = hp ? bgv[n].hi : bgv[n].lo, bl = hp ? blv[n].hi : blv[n].lo;
                        f32x2 glu = av + bg, lin = lv + bl;
                        glu.x = fminf(glu.x, 7.0f); glu.y = fminf(glu.y, 7.0f);
                        lin.x = __builtin_amdgcn_fmed3f(lin.x, -6.0f, 8.0f); lin.y = __builtin_amdgcn_fmed3f(lin.y, -6.0f, 8.0f);
                        f32x2 ex = glu * -2.4554669595930156f;
                        ex.x = __builtin_amdgcn_exp2f(ex.x); ex.y = __builtin_amdgcn_exp2f(ex.y);
                        ex = ex + 1.0f;
                        ex.x = __builtin_amdgcn_rcpf(ex.x); ex.y = __builtin_amdgcn_rcpf(ex.y);
                        const f32x2 a = (glu * ex) * lin;
                        w[2 * n + hp] = pk2(a.x, a.y); }
                u32x4 wv; wv.x = w[0]; wv.y = w[1]; wv.z = w[2]; wv.w = w[3];
                *(u32x4*)rowp = wv;
                asm volatile("" ::: "memory"); }
    }
};
struct EpiMoe2 {
    static constexpr bool PERM = true, AFTER_DRAIN = false, KMID = false; static constexpr int NSTORE = 16;
    const float* b2; bf16* Y;
    __device__ __forceinline__ void operator()(const f32x4 (&acc)[2][2][4][2], const pg8::Unit& u, int wr, int wc, int fr, int fq) const {
        const int e = u.pn >> 2, p = u.pn & 3;
        const int row0 = u.pm * 256 + wr * 64 + fr, col0 = p * 256 + wc * 32 + 8 * fq;
        f32x4 bv[2][2];
#pragma unroll
        for (int bj = 0; bj < 2; ++bj)
#pragma unroll
            for (int n = 0; n < 2; ++n) bv[bj][n] = *(const f32x4*)(b2 + (size_t)e * 1024 + col0 + bj * 128 + 4 * n);
#pragma unroll
        for (int ai = 0; ai < 2; ++ai)
#pragma unroll
            for (int m = 0; m < 4; ++m) { bf16* rowp = Y + (size_t)(row0 + ai * 128 + m * 16) * DM + col0;
#pragma unroll
                for (int bj = 0; bj < 2; ++bj) { const f32x4 v0 = acc[ai][bj][m][0] + bv[bj][0], v1 = acc[ai][bj][m][1] + bv[bj][1];
                    u32x4 w; w.x = pk2(v0[0], v0[1]); w.y = pk2(v0[2], v0[3]); w.z = pk2(v1[0], v1[1]); w.w = pk2(v1[2], v1[3]);
                    *(u32x4*)(rowp + bj * 128) = w; } }
    }
};
struct MoeOrder {
    static constexpr bool GATHER = false; const LAS int* src;
    const LAS int* list; int n;
    __device__ __forceinline__ bool next(int i, pg8::Unit& u) const { if (i >= n) return false; u.pm = __builtin_amdgcn_readfirstlane(list[2 * i]); u.pn = __builtin_amdgcn_readfirstlane(list[2 * i + 1]); return true; }
    __device__ __forceinline__ void a_ready(const pg8::Unit&) const {}
    __device__ __forceinline__ void done(const pg8::Unit&) const {}
};
struct MoeOrderG {
    static constexpr bool GATHER = true; const LAS int* src;
    const LAS int* list; int n;
    __device__ __forceinline__ bool next(int i, pg8::Unit& u) const { if (i >= n) return false; u.pm = __builtin_amdgcn_readfirstlane(list[2 * i]); u.pn = __builtin_amdgcn_readfirstlane(list[2 * i + 1]); return true; }
    __device__ __forceinline__ void a_ready(const pg8::Unit&) const {}
    __device__ __forceinline__ void done(const pg8::Unit&) const {}
};
__device__ __forceinline__ int moe_list_units(Frame& F, int nN, LAS int* list) {
    const int* tl = WSP<int>(F, WS_TILES);
    const int T = __builtin_amdgcn_readfirstlane(tl[32]);
    const int tlv = tl[F.lane & 31];
    pg8::StaticOrder SO; SO.init(T * 256, nN * 256, F.G, F.bx);
    int n = 0;
#pragma unroll 1
    for (int i = 0;; ++i) {
        pg8::Unit u; if (!SO.next(i, u)) break;
        const int pm = u.pm, pnl = u.pn;
        const int e = __popcll(__ballot(F.lane < 32 && tlv <= pm)) - 1;
        if (F.tid == 0) { list[2 * i] = pm; list[2 * i + 1] = e * nN + pnl; }
        n = i + 1;
    }
    __syncthreads();
    return n;
}


typedef short bf16x8 __attribute__((ext_vector_type(8)));
typedef short bf16x4 __attribute__((ext_vector_type(4)));
constexpr int RLD = 136;
constexpr int RTILE = 128 * RLD * 2;
__device__ __forceinline__ bf16x8 lds_frag16(const LAS bf16* tile, int row0, int k0, int lane) {
    return *(const LAS bf16x8*)(tile + (row0 + (lane & 15)) * RLD + k0 + 8 * (lane >> 4));
}
__device__ __forceinline__ bf16x8 lds_frag16s(const LAS bf16* tile, int row0, int k0, int lane) {
    return *(const LAS bf16x8*)(tile + (row0 + (lane & 15)) * RLD + ((k0 + 8 * (lane >> 4)) ^ ((row0 >> 5) << 4)));
}
__device__ __forceinline__ void lds_frag16x4s(bf16x8 (&f)[4], const LAS bf16* tile, int row0, int lane) {
#pragma unroll
    for (int ks = 0; ks < 4; ++ks) f[ks] = lds_frag16s(tile, row0, 32 * ks, lane);
}
__device__ __forceinline__ void lds_frag16x4(bf16x8 (&f)[4], const LAS bf16* tile, int row0, int lane) {
#pragma unroll
    for (int ks = 0; ks < 4; ++ks) f[ks] = lds_frag16(tile, row0, 32 * ks, lane);
}
__device__ __forceinline__ void ret_unit_decode(int u, int& bh, int& ci, int& rowbase) {
    bh = u / 34; ci = u - bh * 34; const int b = bh >> 2;
    rowbase = (ci < 2) ? (NLAT + b * CTXL + ci * 128) : (b * SEQ + (ci - 2) * 128);
}
__device__ __forceinline__ void ret_load_tile(LAS bf16* tile, const bf16* g, size_t gp, int tid) {
    const int r = tid >> 2, seg = tid & 3;
#pragma unroll
    for (int q = 0; q < 4; ++q) *(LAS u32x4*)(tile + r * RLD + seg * 32 + q * 8) = *(const u32x4*)(g + (size_t)r * gp + seg * 32 + q * 8);
}
__device__ __forceinline__ void ret_kv_unit(Frame& F, int l, int u) {
    const bf16* P = WSP<bf16>(F, WS_P);
    LAS bf16* Ktf = (LAS bf16*)F.lds; LAS bf16* Ktb = Ktf + 128 * RLD; LAS bf16* Vt = Ktb + 128 * RLD;
    int bh, ci, rowbase; ret_unit_decode(u, bh, ci, rowbase);
    const int h = bh & 3, tid = F.tid, lane = F.lane, w = F.wave;
    const float LOG2E = 1.4426950408889634f;
    const float lgf = log_sigmoid_(IN_(F, 8)[l * 8 + h]) * LOG2E, lgb = log_sigmoid_(IN_(F, 8)[l * 8 + 4 + h]) * LOG2E;
    __syncthreads();
    { const int j = tid >> 2, seg = tid & 3;
      const float wf = __builtin_amdgcn_exp2f(lgf * (float)(127 - j)), wb = __builtin_amdgcn_exp2f(lgb * (float)j);
      const bf16* kp = P + (size_t)(rowbase + j) * INC + C_RK + h * 128 + seg * 32; const bf16* vp = P + (size_t)(rowbase + j) * INC + C_RV + h * 128 + seg * 32;
      u32x4 kkv[4], vvv[4];
#pragma unroll
      for (int q = 0; q < 4; ++q) { kkv[q] = *(const u32x4*)(kp + q * 8); vvv[q] = *(const u32x4*)(vp + q * 8); }
      __builtin_amdgcn_sched_barrier(0);
#pragma unroll
      for (int q = 0; q < 4; ++q) { const u32x4 kk = kkv[q], vv = vvv[q];
          const unsigned kw[4] = {kk.x, kk.y, kk.z, kk.w}, vw[4] = {vv.x, vv.y, vv.z, vv.w};
#pragma unroll
          for (int i = 0; i < 4; ++i) { const int d = seg * 32 + q * 8 + 2 * i;
              const float k0 = __uint_as_float(kw[i] << 16), k1 = __uint_as_float(kw[i] & 0xffff0000u);
              const int js = j ^ (seg << 4);
              Ktf[d * RLD + js] = f2bf(k0 * wf); Ktf[(d + 1) * RLD + js] = f2bf(k1 * wf);
              Ktb[d * RLD + js] = f2bf(k0 * wb); Ktb[(d + 1) * RLD + js] = f2bf(k1 * wb);
              Vt[d * RLD + js] = (bf16)(vw[i] & 0xffffu); Vt[(d + 1) * RLD + js] = (bf16)(vw[i] >> 16); } } }
    __syncthreads();
    bf16x8 af[4], ab[4];
#pragma unroll
    for (int ks = 0; ks < 4; ++ks) { af[ks] = lds_frag16s(Ktf, 16 * w, 32 * ks, lane); ab[ks] = lds_frag16s(Ktb, 16 * w, 32 * ks, lane); }
    float* KV = WSP<float>(F, WS_KV) + ((size_t)(bh * 34 + ci) * 2) * 16384;
    const int d0 = 16 * w + 4 * (lane >> 4);
    bf16x8 vf[2][4];
    lds_frag16x4s(vf[0], Vt, 0, lane);
#pragma unroll
    for (int et = 0; et < 8; ++et) {
        if (et + 1 < 8) lds_frag16x4s(vf[(et + 1) & 1], Vt, 16 * (et + 1), lane);
        __builtin_amdgcn_sched_barrier(0);
        f32x4 cf = (f32x4){0.f, 0.f, 0.f, 0.f}, cb = cf;
#pragma unroll
        for (int ks = 0; ks < 4; ++ks) { cf = __builtin_amdgcn_mfma_f32_16x16x32_bf16(af[ks], vf[et & 1][ks], cf, 0, 0, 0); cb = __builtin_amdgcn_mfma_f32_16x16x32_bf16(ab[ks], vf[et & 1][ks], cb, 0, 0, 0); }
        const int e = 16 * et + (lane & 15);
        *(f32x4*)(KV + (size_t)e * 128 + d0) = cf; *(f32x4*)(KV + 16384 + (size_t)e * 128 + d0) = cb;
    }
}
__device__ __forceinline__ void ret_scan(Frame& F, int l) {
    const float* KV = WSP<float>(F, WS_KV); bf16* SP = WSP<bf16>(F, WS_SP);
    const float LOG2E = 1.4426950408889634f;
    const int total = 64 * 4096, stride = F.G * NTHR;
#pragma unroll 1
    for (int idx = F.bx * NTHR + F.tid; idx < total; idx += stride) {
        const int bhd = idx >> 12, elem = (idx & 4095) * 4, bh = bhd >> 1, dir = bhd & 1, h = bh & 3;
        const float cd = __builtin_amdgcn_exp2f(log_sigmoid_(IN_(F, 8)[l * 8 + dir * 4 + h]) * LOG2E * 128.0f);
        const size_t base = ((size_t)bh * 34 * 2 + dir) * 16384 + elem;
        f32x4 s = (f32x4){0.f, 0.f, 0.f, 0.f};
#pragma unroll 1
        for (int half = 0; half < 2; ++half) {
            f32x4 kv[17];
#pragma unroll
            for (int k = 0; k < 17; ++k) { const int st = half * 17 + k; const int ci = dir == 0 ? st : (st == 0 ? 1 : (st == 1 ? 0 : 35 - st)); kv[k] = *(const f32x4*)(KV + base + (size_t)ci * 2 * 16384); }
#pragma unroll
            for (int k = 0; k < 17; ++k) { const int st = half * 17 + k; const int ci = dir == 0 ? st : (st == 0 ? 1 : (st == 1 ? 0 : 35 - st));
                u32x2 o; o.x = pk2(s[0], s[1]); o.y = pk2(s[2], s[3]); *(u32x2*)(SP + base + (size_t)ci * 2 * 16384) = o;
                s = s * cd + kv[k]; }
        }
    }
}
__device__ __forceinline__ void ret_out_unit(Frame& F, int l, int u) {
    const bf16* P = WSP<bf16>(F, WS_P);
    LAS bf16* Qs = (LAS bf16*)F.lds; LAS bf16* Ks = Qs + 128 * RLD; LAS bf16* Vt = Ks + 128 * RLD; LAS bf16* Ps = Vt + 128 * RLD;
    int bh, ci, rowbase; ret_unit_decode(u, bh, ci, rowbase);
    const int h = bh & 3, tid = F.tid, lane = F.lane, w = F.wave;
    const float LOG2E = 1.4426950408889634f;
    const float lgf = log_sigmoid_(IN_(F, 8)[l * 8 + h]) * LOG2E, lgb = log_sigmoid_(IN_(F, 8)[l * 8 + 4 + h]) * LOG2E;
    __syncthreads();
    { const int j = tid >> 2, seg = tid & 3;
      const bf16* qp = P + (size_t)(rowbase + j) * INC + C_RQ + h * 128 + seg * 32; const bf16* kp = P + (size_t)(rowbase + j) * INC + C_RK + h * 128 + seg * 32; const bf16* vp = P + (size_t)(rowbase + j) * INC + C_RV + h * 128 + seg * 32;
      u32x4 qv[4], kv4[4], vv4[4];
#pragma unroll
      for (int q = 0; q < 4; ++q) { qv[q] = *(const u32x4*)(qp + q * 8); kv4[q] = *(const u32x4*)(kp + q * 8); vv4[q] = *(const u32x4*)(vp + q * 8); }
      __builtin_amdgcn_sched_barrier(0);
#pragma unroll
      for (int q = 0; q < 4; ++q) { *(LAS u32x4*)(Qs + j * RLD + seg * 32 + q * 8) = qv[q]; *(LAS u32x4*)(Ks + j * RLD + seg * 32 + q * 8) = kv4[q]; }
#pragma unroll
      for (int q = 0; q < 4; ++q) { const u32x4 vv = vv4[q]; const unsigned vw[4] = {vv.x, vv.y, vv.z, vv.w};
#pragma unroll
          for (int i = 0; i < 4; ++i) { const int d = seg * 32 + q * 8 + 2 * i, js = j ^ (seg << 4); Vt[d * RLD + js] = (bf16)(vw[i] & 0xffffu); Vt[(d + 1) * RLD + js] = (bf16)(vw[i] >> 16); } } }
    u32x4 spre[2][4];
    { const bf16* SPg = WSP<bf16>(F, WS_SP) + ((size_t)(bh * 34 + ci) * 2) * 16384; const int rr = tid >> 2, seg = tid & 3;
#pragma unroll
      for (int dir = 0; dir < 2; ++dir) { const bool zero = (dir == 0) ? (ci == 0) : (ci == 1);
#pragma unroll
          for (int q = 0; q < 4; ++q) spre[dir][q] = zero ? (u32x4){0u, 0u, 0u, 0u} : *(const u32x4*)(SPg + (size_t)dir * 16384 + (size_t)rr * 128 + seg * 32 + q * 8); } }
    __syncthreads();
    const int icol = 16 * w + (lane & 15);
    bf16x8 bq[4];
#pragma unroll
    for (int ks = 0; ks < 4; ++ks) bq[ks] = lds_frag16(Qs, 16 * w, 32 * ks, lane);
    bf16x8 tf[2][4];
    lds_frag16x4(tf[0], Ks, 0, lane);
#pragma unroll
    for (int jt = 0; jt < 8; ++jt) {
        if (jt + 1 < 8) lds_frag16x4(tf[(jt + 1) & 1], Ks, 16 * (jt + 1), lane);
        __builtin_amdgcn_sched_barrier(0);
        f32x4 c = (f32x4){0.f, 0.f, 0.f, 0.f};
#pragma unroll
        for (int ks = 0; ks < 4; ++ks) c = __builtin_amdgcn_mfma_f32_16x16x32_bf16(tf[jt & 1][ks], bq[ks], c, 0, 0, 0);
        const int j0 = 16 * jt + 4 * (lane >> 4);
        float pv[4];
#pragma unroll
        for (int r = 0; r < 4; ++r) { const int dd = icol - (j0 + r); const float dec = dd >= 0 ? __builtin_amdgcn_exp2f(lgf * (float)dd) : __builtin_amdgcn_exp2f(lgb * (float)(-dd)); pv[r] = c[r] * dec; }
        u32x2 pw; pw.x = pk2(pv[0], pv[1]); pw.y = pk2(pv[2], pv[3]);
        *(LAS u32x2*)(Ps + icol * RLD + j0) = pw;
    }
    LDS_WAIT(); asm volatile("" ::: "memory");
    f32x4 acc[8];
    {
        bf16x8 bp[4];
#pragma unroll
        for (int ks = 0; ks < 4; ++ks) bp[ks] = lds_frag16(Ps, 16 * w, 32 * ks, lane);
        lds_frag16x4s(tf[0], Vt, 0, lane);
#pragma unroll
        for (int et = 0; et < 8; ++et) {
            if (et + 1 < 8) lds_frag16x4s(tf[(et + 1) & 1], Vt, 16 * (et + 1), lane);
            __builtin_amdgcn_sched_barrier(0);
            f32x4 c = (f32x4){0.f, 0.f, 0.f, 0.f};
#pragma unroll
            for (int ks = 0; ks < 4; ++ks) c = __builtin_amdgcn_mfma_f32_16x16x32_bf16(tf[et & 1][ks], bp[ks], c, 0, 0, 0);
            acc[et] = c; }
    }
#pragma unroll
    for (int dir = 0; dir < 2; ++dir) {
        const bool zero = (dir == 0) ? (ci == 0) : (ci == 1);
        __syncthreads();
        if (!zero) { const int rr = tid >> 2, seg = tid & 3;
#pragma unroll
            for (int q = 0; q < 4; ++q) *(LAS u32x4*)(Ks + rr * RLD + seg * 32 + q * 8) = spre[dir][q]; }
        __syncthreads();
        if (!zero) {
            const float sc = (dir == 0) ? __builtin_amdgcn_exp2f(lgf * (float)((icol & 127) + 1)) : __builtin_amdgcn_exp2f(lgb * (float)(128 - (icol & 127)));
            lds_frag16x4(tf[0], Ks, 0, lane);
#pragma unroll
            for (int et = 0; et < 8; ++et) {
                if (et + 1 < 8) lds_frag16x4(tf[(et + 1) & 1], Ks, 16 * (et + 1), lane);
                __builtin_amdgcn_sched_barrier(0);
                f32x4 c = (f32x4){0.f, 0.f, 0.f, 0.f};
#pragma unroll
                for (int ks = 0; ks < 4; ++ks) c = __builtin_amdgcn_mfma_f32_16x16x32_bf16(tf[et & 1][ks], bq[ks], c, 0, 0, 0);
                acc[et] = acc[et] + c * sc; }
        }
    }
    const float ksc = 0.08838834764831845f;
    float ss = 0.f;
#pragma unroll
    for (int et = 0; et < 8; ++et) { acc[et] = acc[et] * ksc; ss += (acc[et][0] * acc[et][0] + acc[et][1] * acc[et][1]) + (acc[et][2] * acc[et][2] + acc[et][3] * acc[et][3]); }
    ss += __shfl_xor(ss, 16); ss += __shfl_xor(ss, 32);
    const float rs = 1.0f / sqrtf(ss * (1.0f / 128.0f) + EPS);
    const size_t row = (size_t)(rowbase + icol);
    const bf16* gp = P + row * INC + C_RG + h * 128; bf16* op = WSP<bf16>(F, WS_RET) + row * 1536 + h * 128;
#pragma unroll
    for (int et = 0; et < 8; ++et) { const int e0 = 16 * et + 4 * (lane >> 4);
        const u32x2 g2 = *(const u32x2*)(gp + e0);
        const float g0 = __uint_as_float(g2.x << 16), g1 = __uint_as_float(g2.x & 0xffff0000u), g2f = __uint_as_float(g2.y << 16), g3 = __uint_as_float(g2.y & 0xffff0000u);
        u32x2 o; o.x = pk2(acc[et][0] * rs * siluf_(g0), acc[et][1] * rs * siluf_(g1)); o.y = pk2(acc[et][2] * rs * siluf_(g2f), acc[et][3] * rs * siluf_(g3));
        *(u32x2*)(op + e0) = o; }
}

typedef float f32x2 __attribute__((ext_vector_type(2)));
__device__ __forceinline__ f32x2 cmul_(f32x2 a, f32x2 b) { return (f32x2){a.x * b.x - a.y * b.y, a.x * b.y + a.y * b.x}; }
__device__ __forceinline__ f32x2 cmulc_(f32x2 a, f32x2 b) { return (f32x2){a.x * b.x + a.y * b.y, a.y * b.x - a.x * b.y}; }
__device__ __forceinline__ f32x2 twid_(float rev) { return (f32x2){cos_rev(rev), -sin_rev(rev)}; }
__device__ __forceinline__ int fpad(int n) { return n + (n >> 3); }
template <int R> __device__ __forceinline__ void fft_twiddles(f32x2 (&tw)[R - 1], int t, int s, int M) {
    int o = 0, u = 0;
#pragma unroll
    for (int half = R / 2; half >= 1; half >>= 1) {
        const float invMu = 1.0f / (float)(M >> u);
#pragma unroll
        for (int qq = 0; qq < half; ++qq) tw[o + qq] = twid_((float)(t + qq * s) * invMu);
        o += half; ++u;
    }
}
template <int R, int HALF, int OFF> __device__ __forceinline__ void fft_sub_fwd(f32x2 (&v)[R], const f32x2 (&tw)[R - 1]) {
#pragma unroll
    for (int qq = 0; qq < HALF; ++qq) {
        const f32x2 w = tw[OFF + qq];
#pragma unroll
        for (int g0 = 0; g0 < R; g0 += 2 * HALF) { const f32x2 a = v[g0 + qq], b = v[g0 + qq + HALF]; v[g0 + qq] = a + b; v[g0 + qq + HALF] = cmul_(a - b, w); }
    }
}
template <int R, int HALF, int OFF> __device__ __forceinline__ void fft_sub_inv(f32x2 (&v)[R], const f32x2 (&tw)[R - 1]) {
#pragma unroll
    for (int qq = 0; qq < HALF; ++qq) {
        const f32x2 w = tw[OFF + qq];
#pragma unroll
        for (int g0 = 0; g0 < R; g0 += 2 * HALF) { const f32x2 A = v[g0 + qq], Bp = cmulc_(v[g0 + qq + HALF], w); v[g0 + qq] = A + Bp; v[g0 + qq + HALF] = A - Bp; }
    }
}
template <int R> __device__ __forceinline__ void fft_bf_fwd(f32x2 (&v)[R], const f32x2 (&tw)[R - 1]) {
    if constexpr (R == 16) { fft_sub_fwd<16, 8, 0>(v, tw); fft_sub_fwd<16, 4, 8>(v, tw); fft_sub_fwd<16, 2, 12>(v, tw); fft_sub_fwd<16, 1, 14>(v, tw); }
    else { fft_sub_fwd<8, 4, 0>(v, tw); fft_sub_fwd<8, 2, 4>(v, tw); fft_sub_fwd<8, 1, 6>(v, tw); }
}
template <int R> __device__ __forceinline__ void fft_bf_inv(f32x2 (&v)[R], const f32x2 (&tw)[R - 1]) {
    if constexpr (R == 16) { fft_sub_inv<16, 1, 14>(v, tw); fft_sub_inv<16, 2, 12>(v, tw); fft_sub_inv<16, 4, 8>(v, tw); fft_sub_inv<16, 8, 0>(v, tw); }
    else { fft_sub_inv<8, 1, 6>(v, tw); fft_sub_inv<8, 2, 4>(v, tw); fft_sub_inv<8, 4, 0>(v, tw); }
}
__device__ __forceinline__ void fft_tw_last(f32x2 (&tw)[7]) {
    const float h = 0.70710678118654752f;
    tw[0] = (f32x2){1.f, 0.f}; tw[1] = (f32x2){h, -h}; tw[2] = (f32x2){0.f, -1.f}; tw[3] = (f32x2){-h, -h};
    tw[4] = (f32x2){1.f, 0.f}; tw[5] = (f32x2){0.f, -1.f}; tw[6] = (f32x2){1.f, 0.f};
}
struct FftTw { f32x2 t1[15]; f32x2 t2[2][7]; f32x2 t3[2][7]; };
__device__ __forceinline__ void fft_tw_init(FftTw& T, int tid) {
    fft_twiddles<16>(T.t1, tid, 512, 8192);
#pragma unroll
    for (int it = 0; it < 2; ++it) { const int uu = tid + 512 * it; fft_twiddles<8>(T.t2[it], uu & 63, 64, 512); fft_twiddles<8>(T.t3[it], uu & 7, 8, 64); }
}
template <bool INV, int M> __device__ __forceinline__ void fft_pass8(LAS f32x2* X, int tid, const f32x2 (&tw)[2][7]) {
    asm volatile("" : "+v"(tid));
    constexpr int s = M >> 3;
#pragma unroll
    for (int it = 0; it < 2; ++it) {
        const int uu = tid + 512 * it, blk = uu / s, t = uu - blk * s, n0 = blk * M + t;
        f32x2 v[8];
#pragma unroll
        for (int q = 0; q < 8; ++q) v[q] = X[fpad(n0 + q * s)];
        if (INV) fft_bf_inv<8>(v, tw[it]); else fft_bf_fwd<8>(v, tw[it]);
#pragma unroll
        for (int q = 0; q < 8; ++q) X[fpad(n0 + q * s)] = v[q];
    }
}
__device__ __forceinline__ void fft_filter_unit(Frame& F, const FftTw& T, int l, int c) {
    LAS f32x2* X = (LAS f32x2*)F.lds;
    const float* HFp = WSP<float>(F, WS_HF + (size_t)l * 16 * MiB); const float* HBp = WSP<float>(F, WS_HF + (size_t)l * 16 * MiB + 8 * MiB);
    const float scale = hy_inv_l1(F, l, c) * (1.0f / 8192.0f);
    int tid = F.tid; asm volatile("" : "+v"(tid));
    __syncthreads();
    {   f32x2 v[16];
#pragma unroll
        for (int q = 0; q < 16; ++q) { const int n = tid + 512 * q; float x;
            if (q < 8) x = HFp[(size_t)n * 512 + c]; else x = (n == 4096) ? 0.f : HBp[(size_t)(8192 - n) * 512 + c];
            v[q] = (f32x2){x * scale, 0.f}; }
        fft_bf_fwd<16>(v, T.t1);
#pragma unroll
        for (int q = 0; q < 16; ++q) X[fpad(tid + 512 * q)] = v[q];
    }
    __syncthreads(); fft_pass8<false, 512>(X, tid, T.t2);
    __syncthreads(); fft_pass8<false, 64>(X, tid, T.t3);
    __syncthreads();
    f32x2* Hc = WSP<f32x2>(F, WS_HSPEC) + ((size_t)l * 512 + c) * 8192;
    asm volatile("" : "+v"(tid));
    f32x2 tl[7]; fft_tw_last(tl);
#pragma unroll
    for (int it = 0; it < 2; ++it) {
        const int uu = tid + 512 * it;
        f32x2 v[8];
#pragma unroll
        for (int q = 0; q < 8; ++q) v[q] = X[fpad(8 * uu + q)];
        fft_bf_fwd<8>(v, tl);
#pragma unroll
        for (int q = 0; q < 4; ++q) { f32x4 o; o[0] = v[2 * q].x; o[1] = v[2 * q].y; o[2] = v[2 * q + 1].x; o[3] = v[2 * q + 1].y; *(f32x4*)(Hc + 8 * uu + 2 * q) = o; }
    }
}
__device__ __forceinline__ void fft_zfetch(Frame& F, int unit, int tid, unsigned (&zp)[8]) {
    const bf16* n1 = WSP<bf16>(F, WS_ZT) + ((size_t)(unit >> 2) * NB + 2 * (unit & 3)) * SEQ; const bf16* n2 = n1 + SEQ;
#pragma unroll
    for (int q = 0; q < 8; ++q) { const int n = tid + 512 * q; zp[q] = (unsigned)n1[n] | ((unsigned)n2[n] << 16); }
}
__device__ __forceinline__ void fft_zfetch_raw(Frame& F, int unit, int tid, unsigned (&zr)[16]) {
    const bf16* n1 = WSP<bf16>(F, WS_ZT) + ((size_t)(unit >> 2) * NB + 2 * (unit & 3)) * SEQ; const bf16* n2 = n1 + SEQ;
#pragma unroll
    for (int q = 0; q < 8; ++q) { const int n = tid + 512 * q; zr[q] = (unsigned)n1[n]; zr[8 + q] = (unsigned)n2[n]; }
}
__device__ __forceinline__ void fft_zcombine(unsigned (&zp)[8], const unsigned (&zr)[16]) {
#pragma unroll
    for (int q = 0; q < 8; ++q) zp[q] = zr[q] | (zr[8 + q] << 16);
}
__device__ __forceinline__ void fft_stage_first(LAS f32x2* X, const FftTw& T, int tid, const unsigned (&zp)[8]) {
    f32x2 v[16];
#pragma unroll
    for (int q = 0; q < 8; ++q) v[q] = (f32x2){__uint_as_float(zp[q] << 16), __uint_as_float(zp[q] & 0xffff0000u)};
#pragma unroll
    for (int q = 8; q < 16; ++q) v[q] = (f32x2){0.f, 0.f};
    fft_bf_fwd<16>(v, T.t1);
#pragma unroll
    for (int q = 0; q < 16; ++q) X[fpad(tid + 512 * q)] = v[q];
}
__device__ __forceinline__ void fft_stage_mid(LAS f32x2* X, int tid, const f32x4 (&hp)[2][4]) {
    f32x2 tl[7]; fft_tw_last(tl);
#pragma unroll
    for (int it = 0; it < 2; ++it) {
        const int uu = tid + 512 * it;
        f32x2 v[8];
#pragma unroll
        for (int q = 0; q < 8; ++q) v[q] = X[fpad(8 * uu + q)];
        fft_bf_fwd<8>(v, tl);
#pragma unroll
        for (int q = 0; q < 4; ++q) { const f32x4 h = hp[it][q]; v[2 * q] = cmul_(v[2 * q], (f32x2){h[0], h[1]}); v[2 * q + 1] = cmul_(v[2 * q + 1], (f32x2){h[2], h[3]}); }
        fft_bf_inv<8>(v, tl);
#pragma unroll
        for (int q = 0; q < 8; ++q) X[fpad(8 * uu + q)] = v[q];
    }
}
__device__ __forceinline__ void fft_stage_last(Frame& F, LAS f32x2* X, const FftTw& T, int tid, int unit) {
    f32x2 v[16];
#pragma unroll
    for (int q = 0; q < 16; ++q) v[q] = X[fpad(tid + 512 * q)];
    fft_bf_inv<16>(v, T.t1);
    bf16* y1 = WSP<bf16>(F, WS_YT) + ((size_t)(unit >> 2) * NB + 2 * (unit & 3)) * SEQ; bf16* y2 = y1 + SEQ;
#pragma unroll
    for (int q = 0; q < 8; ++q) { const int n = tid + 512 * q; y1[n] = f2bf(v[q].x); y2[n] = f2bf(v[q].y); }
}
__device__ __forceinline__ void fft_conv_pair(Frame& F, const FftTw& T, int l, int ua, int ub, int na, int nb, unsigned (&zpa)[8], unsigned (&zpb)[8]) {
    LAS f32x2* X0 = (LAS f32x2*)F.lds; LAS f32x2* X1 = X0 + 9216;
    int tid = F.tid; asm volatile("" : "+v"(tid));
    __syncthreads();
    unsigned zra[16], zrb[16];
    fft_stage_first(X0, T, tid, zpa); if (na < 2048) fft_zfetch_raw(F, na, tid, zra);
    fft_stage_first(X1, T, tid, zpb); if (nb < 2048) fft_zfetch_raw(F, nb, tid, zrb);
    __syncthreads(); fft_pass8<false, 512>(X0, tid, T.t2); fft_pass8<false, 512>(X1, tid, T.t2);
    if (na < 2048) fft_zcombine(zpa, zra);
    if (nb < 2048) fft_zcombine(zpb, zrb);
    f32x4 hpa[2][4], hpb[2][4];
    { const f32x2* Ha = WSP<f32x2>(F, WS_HSPEC) + ((size_t)l * 512 + (ua >> 2)) * 8192; const f32x2* Hb = WSP<f32x2>(F, WS_HSPEC) + ((size_t)l * 512 + (ub >> 2)) * 8192;
#pragma unroll
      for (int it = 0; it < 2; ++it)
#pragma unroll
          for (int q = 0; q < 4; ++q) { hpa[it][q] = *(const f32x4*)(Ha + 8 * (tid + 512 * it) + 2 * q); hpb[it][q] = *(const f32x4*)(Hb + 8 * (tid + 512 * it) + 2 * q); } }
    __syncthreads(); fft_pass8<false, 64>(X0, tid, T.t3); fft_pass8<false, 64>(X1, tid, T.t3);
    __syncthreads(); asm volatile("" : "+v"(tid)); fft_stage_mid(X0, tid, hpa); fft_stage_mid(X1, tid, hpb);
    __syncthreads(); fft_pass8<true, 64>(X0, tid, T.t3); fft_pass8<true, 64>(X1, tid, T.t3);
    __syncthreads(); fft_pass8<true, 512>(X0, tid, T.t2); fft_pass8<true, 512>(X1, tid, T.t2);
    __syncthreads(); asm volatile("" : "+v"(tid)); fft_stage_last(F, X0, T, tid, ua); fft_stage_last(F, X1, T, tid, ub);
}

constexpr int HLD = 72;
struct HyRaw { u32x4 c0, c1, c2; };
__device__ __forceinline__ void hy_fetch8(const bf16* P, int base, int t, int L, int ch0, HyRaw& r) {
    const bf16* p1 = P + (size_t)(base + t) * INC + C_HU + ch0;
    const u32x4 zero = (u32x4){0u, 0u, 0u, 0u};
    r.c1 = *(const u32x4*)p1; r.c0 = (t > 0) ? *(const u32x4*)(p1 - INC) : zero; r.c2 = (t + 1 < L) ? *(const u32x4*)(p1 + INC) : zero;
}
__device__ __forceinline__ void hy_conv8(const HyRaw& r, const float (&w)[4][8], float (&out)[8]) {
    const unsigned a0[4] = {r.c0.x, r.c0.y, r.c0.z, r.c0.w}, a1[4] = {r.c1.x, r.c1.y, r.c1.z, r.c1.w}, a2[4] = {r.c2.x, r.c2.y, r.c2.z, r.c2.w};
#pragma unroll
    for (int i = 0; i < 4; ++i) {
        out[2 * i] = w[3][2 * i] + __uint_as_float(a0[i] << 16) * w[0][2 * i] + __uint_as_float(a1[i] << 16) * w[1][2 * i] + __uint_as_float(a2[i] << 16) * w[2][2 * i];
        out[2 * i + 1] = w[3][2 * i + 1] + __uint_as_float(a0[i] & 0xffff0000u) * w[0][2 * i + 1] + __uint_as_float(a1[i] & 0xffff0000u) * w[1][2 * i + 1] + __uint_as_float(a2[i] & 0xffff0000u) * w[2][2 * i + 1];
    }
}
__device__ __forceinline__ void hy_load_w8(const float* cw, const float* cb, int ch0, float (&w)[4][8]) {
#pragma unroll
    for (int i = 0; i < 8; ++i) { w[0][i] = cw[ch0 + i]; w[1][i] = cw[1536 + ch0 + i]; w[2][i] = cw[2 * 1536 + ch0 + i]; w[3][i] = cb[ch0 + i]; }
}
__device__ __forceinline__ void hy_item_decode(int it, int& ct, int& base, int& t0, int& L, int& b, bool& isctx) {
    isctx = it >= 4096;
    if (!isctx) { ct = it & 7; t0 = ((it >> 3) & 63) * 64; b = it >> 9; base = b * SEQ; L = SEQ; }
    else { const int j = it - 4096; ct = j & 7; t0 = ((j >> 3) & 3) * 64; b = j >> 5; base = NLAT + b * CTXL; L = CTXL; }
}
template <int VAR> __device__ __forceinline__ int hy_nitems(int bx, bool reb, int nit) {
    if (!reb) return (nit - bx + 255) >> 8;
    if (bx < 64) return 11;
    if (VAR == 0) return bx < 192 ? 20 : 17;
    return 19;
}
template <int VAR> __device__ __forceinline__ int hy_item(int bx, bool reb, int idx) {
    if (!reb || idx < ((bx < 64) ? 11 : 17)) return bx + 256 * idx;
    const int e = idx - 17, donor = bx & 63, grp = (bx >> 6) - 1;
    const int k = (VAR == 0) ? (11 + 3 * grp + e) : (11 + 2 * grp + e);
    return donor + 256 * k;
}
__device__ __forceinline__ void ph_hyprep2(Frame& F, int l, bool do_ctx) {
    const bf16* P = WSP<bf16>(F, WS_P);
    const float* cw = IN_(F, 10) + l * 3 * 1536; const float* cb = IN_(F, 11) + l * 1536;
    LAS bf16* Zs = (LAS bf16*)F.lds;
    int tid = F.tid; asm volatile("" : "+v"(tid));
    const int cg = tid & 7, tl = tid >> 3, c0 = (F.bx & 7) * 64;
    float w1[4][8], wv[4][8];
    hy_load_w8(cw, cb, 512 + c0 + 8 * cg, w1); hy_load_w8(cw, cb, 1024 + c0 + 8 * cg, wv);
    const int nit = do_ctx ? 4352 : 4096;
    HyRaw r1, rv;
    const int nmy = hy_nitems<0>(F.bx, do_ctx, nit);
    { int ct, base, t0, L, b; bool isctx; hy_item_decode(hy_item<0>(F.bx, do_ctx, 0), ct, base, t0, L, b, isctx); hy_fetch8(P, base, t0 + tl, L, 512 + c0 + 8 * cg, r1); hy_fetch8(P, base, t0 + tl, L, 1024 + c0 + 8 * cg, rv); }
#pragma unroll 1
    for (int ii = 0; ii < nmy; ++ii) {
        const int it = hy_item<0>(F.bx, do_ctx, ii);
        int ct, base, t0, L, b; bool isctx; hy_item_decode(it, ct, base, t0, L, b, isctx);
        float x1[8], v[8];
        hy_conv8(r1, w1, x1); hy_conv8(rv, wv, v);
        if (ii + 1 < nmy) { int ct2, base2, t02, L2, b2; bool ic2; hy_item_decode(hy_item<0>(F.bx, do_ctx, ii + 1), ct2, base2, t02, L2, b2, ic2); hy_fetch8(P, base2, t02 + tl, L2, 512 + c0 + 8 * cg, r1); hy_fetch8(P, base2, t02 + tl, L2, 1024 + c0 + 8 * cg, rv); }
        __syncthreads();
#pragma unroll
        for (int i = 0; i < 8; ++i) Zs[(8 * cg + i) * HLD + (tl ^ (8 * cg))] = f2bf(x1[i] * v[i]);
        __syncthreads();
        { const int c = tid >> 3, seg = tid & 7;
          const u32x4 o = *(const LAS u32x4*)(Zs + c * HLD + 8 * (seg ^ (c >> 3)));
          bf16* dst = isctx ? (WSP<bf16>(F, WS_ZTC) + ((size_t)(c0 + c) * NB + b) * CTXL + t0 + 8 * seg) : (WSP<bf16>(F, WS_ZT) + ((size_t)(c0 + c) * NB + b) * SEQ + t0 + 8 * seg);
          *(u32x4*)dst = o; }
    }
}
__device__ __forceinline__ void ph_hypost2(Frame& F, int l, bool do_ctx) {
    const bf16* P = WSP<bf16>(F, WS_P);
    const float* cw = IN_(F, 10) + l * 3 * 1536; const float* cb = IN_(F, 11) + l * 1536; const float* skip = IN_(F, 19) + l * 512;
    LAS bf16* Ys = (LAS bf16*)F.lds;
    int tid = F.tid; asm volatile("" : "+v"(tid));
    const int cg = tid & 7, tl = tid >> 3, c0 = (F.bx & 7) * 64;
    float w0[4][8], w1[4][8], wv[4][8], sk[8];
    hy_load_w8(cw, cb, c0 + 8 * cg, w0); hy_load_w8(cw, cb, 512 + c0 + 8 * cg, w1); hy_load_w8(cw, cb, 1024 + c0 + 8 * cg, wv);
#pragma unroll
    for (int i = 0; i < 8; ++i) sk[i] = skip[c0 + 8 * cg + i];
    bf16* HY = WSP<bf16>(F, WS_RET) + 1024;
    const int nit = do_ctx ? 4352 : 4096;
    const int cY = tid >> 3, segY = tid & 7;
    HyRaw r0, r1, rv; u32x4 yraw;
#define HYP_FETCH(it_) do { int ct_, base_, t0_, L_, b_; bool ic_; hy_item_decode((it_), ct_, base_, t0_, L_, b_, ic_); \
        hy_fetch8(P, base_, t0_ + tl, L_, c0 + 8 * cg, r0); hy_fetch8(P, base_, t0_ + tl, L_, 512 + c0 + 8 * cg, r1); hy_fetch8(P, base_, t0_ + tl, L_, 1024 + c0 + 8 * cg, rv); \
        const bf16* src_ = ic_ ? (WSP<bf16>(F, WS_YTC) + ((size_t)(c0 + cY) * NB + b_) * CTXL + t0_ + 8 * segY) : (WSP<bf16>(F, WS_YT) + ((size_t)(c0 + cY) * NB + b_) * SEQ + t0_ + 8 * segY); \
        yraw = *(const u32x4*)src_; } while (0)
    const int nmy = hy_nitems<1>(F.bx, do_ctx, nit);
    HYP_FETCH(hy_item<1>(F.bx, do_ctx, 0));
#pragma unroll 1
    for (int ii = 0; ii < nmy; ++ii) {
        const int it = hy_item<1>(F.bx, do_ctx, ii);
        int ct, base, t0, L, b; bool isctx; hy_item_decode(it, ct, base, t0, L, b, isctx);
        float x0[8], x1[8], v[8];
        hy_conv8(r0, w0, x0); hy_conv8(r1, w1, x1); hy_conv8(rv, wv, v);
        __syncthreads();
        *(LAS u32x4*)(Ys + cY * HLD + 8 * (segY ^ (cY >> 3))) = yraw;
        if (ii + 1 < nmy) HYP_FETCH(hy_item<1>(F.bx, do_ctx, ii + 1));
        __syncthreads();
        float hy[8];
#pragma unroll
        for (int i = 0; i < 8; ++i) { const float y = bf2f(Ys[(8 * cg + i) * HLD + (tl ^ (8 * cg))]); hy[i] = x0[i] * (y + sk[i] * (x1[i] * v[i])); }
        u32x4 o; o.x = pk2(hy[0], hy[1]); o.y = pk2(hy[2], hy[3]); o.z = pk2(hy[4], hy[5]); o.w = pk2(hy[6], hy[7]);
        *(u32x4*)(HY + (size_t)(base + t0 + tl) * 1536 + c0 + 8 * cg) = o;
    }
#undef HYP_FETCH
}
__device__ __forceinline__ void hyconv_ctx_item2(Frame& F, int c) {
    const float* HFp = WSP<float>(F, WS_HFC); const float* HBp = WSP<float>(F, WS_HFC + 512 * 1024);
    LAS float* Kc = (LAS float*)F.lds; LAS float* Zs = Kc + 512;
    const float il1 = hy_inv_l1(F, 2, c);
    const bf16* Z = WSP<bf16>(F, WS_ZTC) + (size_t)c * NB * CTXL; bf16* Yo = WSP<bf16>(F, WS_YTC) + (size_t)c * NB * CTXL;
    const int tid = F.tid;
    __syncthreads();
    if (tid < 511) { const int d = tid - 255; Kc[tid] = (d >= 0 ? HFp[(size_t)d * 512 + c] : HBp[(size_t)(-d) * 512 + c]) * il1; }
#pragma unroll
    for (int i = 0; i < 4; ++i) Zs[tid + 512 * i] = bf2f(Z[tid + 512 * i]);
    __syncthreads();
    const int t = tid & 255, b0 = tid >> 8;
    float a[4] = {0.f, 0.f, 0.f, 0.f};
#pragma unroll 4
    for (int s = 0; s < CTXL; ++s) { const float k = Kc[t - s + 255];
#pragma unroll
        for (int i = 0; i < 4; ++i) a[i] += k * Zs[(b0 + 2 * i) * CTXL + s]; }
#pragma unroll
    for (int i = 0; i < 4; ++i) Yo[(b0 + 2 * i) * CTXL + t] = f2bf(a[i]);
}

constexpr int ALD = 72;
__device__ __forceinline__ void attn_unit(Frame& F, int l, int unit) {
    const bf16* P = WSP<bf16>(F, WS_P);
    LAS bf16* Kb = (LAS bf16*)F.lds; LAS bf16* Vt = Kb + 64 * ALD;
    const bool isctx = unit >= 1024;
    int b, kvh, qb;
    if (!isctx) { b = unit >> 7; kvh = (unit >> 6) & 1; qb = unit & 63; } else { const int it = unit - 1024; b = it >> 3; kvh = (it >> 2) & 1; qb = it & 3; }
    int tid = F.tid; asm volatile("" : "+v"(tid));
    const int lane = tid & 63, w = F.wave, g = w >> 1, h = kvh * 4 + g, lg = lane >> 4, lc = lane & 15;
    const int start = qb * 64, q0 = start + (w & 1) * 32;
    const int rowq0 = isctx ? (NLAT + b * CTXL + q0) : (b * SEQ + q0);
    bf16x8 bq[2][2];
#pragma unroll
    for (int qt = 0; qt < 2; ++qt)
#pragma unroll
        for (int ks = 0; ks < 2; ++ks) bq[qt][ks] = *(const bf16x8*)(P + (size_t)(rowq0 + 16 * qt + lc) * INC + C_AQ + h * 64 + 32 * ks + 8 * lg);
    const float sink = IN_(F, 9)[l * 8 + h];
    float mrun[2], lsum[2]; f32x4 o[4][2];
#pragma unroll
    for (int qt = 0; qt < 2; ++qt) { mrun[qt] = sink * 1.4426950408889634f; lsum[qt] = (lg == 0) ? 1.0f : 0.0f;
#pragma unroll
        for (int dt = 0; dt < 4; ++dt) o[dt][qt] = (f32x4){0.f, 0.f, 0.f, 0.f}; }
    const int nkb = isctx ? 4 : 9;
    const int key = tid >> 3, d0 = (tid & 7) * 8;
    u32x4 kk, vv;
#define ATT_FETCH(kb_) do { const bool cb_ = isctx || (kb_) >= 5; int row_ = -1; \
        if (cb_) row_ = NLAT + b * CTXL + (isctx ? (kb_) : (kb_) - 5) * 64 + key; \
        else { const int kpos_ = start - 128 + (kb_) * 64 + key; if (kpos_ >= 0 && kpos_ < SEQ) row_ = b * SEQ + kpos_; } \
        kk = (u32x4){0u, 0u, 0u, 0u}; vv = kk; \
        if (row_ >= 0) { kk = *(const u32x4*)(P + (size_t)row_ * INC + C_AK + kvh * 64 + d0); vv = *(const u32x4*)(P + (size_t)row_ * INC + C_AV + kvh * 64 + d0); } } while (0)
    const int kb_lo = isctx ? 0 : ((start >= 128) ? 0 : 2 - (start >> 6)), kb_hi = isctx ? 0 : (((SEQ + 128 - start) >> 6) < 5 ? ((SEQ + 128 - start) >> 6) : 5);
#define ATT_NEXT(kb_) ((!isctx && (kb_) + 1 == kb_hi) ? 5 : (kb_) + 1)
    ATT_FETCH(kb_lo);
#pragma unroll 1
    for (int kb = kb_lo; kb < nkb; kb = ATT_NEXT(kb)) {
        const bool ctxblk = isctx || kb >= 5;
        __syncthreads();
        { *(LAS u32x4*)(Kb + key * ALD + d0) = kk;
          const unsigned vw[4] = {vv.x, vv.y, vv.z, vv.w};
#pragma unroll
          for (int i = 0; i < 4; ++i) { Vt[(d0 + 2 * i) * ALD + (key ^ d0)] = (bf16)(vw[i] & 0xffffu); Vt[(d0 + 2 * i + 1) * ALD + (key ^ d0)] = (bf16)(vw[i] >> 16); } }
        __syncthreads();
        { const int kn = ATT_NEXT(kb); if (kn < nkb) ATT_FETCH(kn); }
        f32x4 s[4][2];
        bf16x8 kf[4][2];
#pragma unroll
        for (int kt = 0; kt < 4; ++kt) { kf[kt][0] = *(const LAS bf16x8*)(Kb + (16 * kt + lc) * ALD + 8 * lg); kf[kt][1] = *(const LAS bf16x8*)(Kb + (16 * kt + lc) * ALD + 32 + 8 * lg); }
        __builtin_amdgcn_sched_barrier(0);
#pragma unroll
        for (int kt = 0; kt < 4; ++kt)
#pragma unroll
            for (int qt = 0; qt < 2; ++qt) { f32x4 c = (f32x4){0.f, 0.f, 0.f, 0.f};
                c = __builtin_amdgcn_mfma_f32_16x16x32_bf16(kf[kt][0], bq[qt][0], c, 0, 0, 0); c = __builtin_amdgcn_mfma_f32_16x16x32_bf16(kf[kt][1], bq[qt][1], c, 0, 0, 0);
                s[kt][qt] = c; }
        if (!ctxblk && (kb == 0 || kb == 4)) {
#pragma unroll
            for (int kt = 0; kt < 4; ++kt)
#pragma unroll
                for (int qt = 0; qt < 2; ++qt)
#pragma unroll
                    for (int r = 0; r < 4; ++r) { const int kpos = start - 128 + kb * 64 + 16 * kt + 4 * lg + r, qpos = q0 + 16 * qt + lc, dd = qpos - kpos;
                        const bool valid = (kpos >= 0) && (kpos < SEQ) && (dd <= 128) && (dd >= -128);
                        s[kt][qt][r] = valid ? s[kt][qt][r] : -1.0e30f; }
        }
        bf16x8 pf[2][2];
#pragma unroll
        for (int qt = 0; qt < 2; ++qt) {
            float bm = -3.0e38f;
#pragma unroll
            for (int kt = 0; kt < 4; ++kt) bm = fmaxf(bm, fmaxf(fmaxf(s[kt][qt][0], s[kt][qt][1]), fmaxf(s[kt][qt][2], s[kt][qt][3])));
            bm = fmaxf(bm, __shfl_xor(bm, 16)); bm = fmaxf(bm, __shfl_xor(bm, 32));
            const float KS = 0.125f * 1.4426950408889634f;
            const float mold = mrun[qt], mnew = fmaxf(mold, bm * KS);
            mrun[qt] = mnew;
            float ps = 0.f; unsigned pw[8];
#pragma unroll
            for (int kt = 0; kt < 4; ++kt) { const float p0 = __builtin_amdgcn_exp2f(fmaf(s[kt][qt][0], KS, -mnew)), p1 = __builtin_amdgcn_exp2f(fmaf(s[kt][qt][1], KS, -mnew)), p2 = __builtin_amdgcn_exp2f(fmaf(s[kt][qt][2], KS, -mnew)), p3 = __builtin_amdgcn_exp2f(fmaf(s[kt][qt][3], KS, -mnew));
                ps += (p0 + p1) + (p2 + p3); pw[2 * kt] = pk2(p0, p1); pw[2 * kt + 1] = pk2(p2, p3); }
            if (__any(mnew > mold)) {
                const float sc = __builtin_amdgcn_exp2f(mold - mnew);
                lsum[qt] = lsum[qt] * sc;
#pragma unroll
                for (int dt = 0; dt < 4; ++dt) o[dt][qt] = o[dt][qt] * sc; }
            lsum[qt] += ps;
            u32x4 f0; f0.x = pw[0]; f0.y = pw[1]; f0.z = pw[2]; f0.w = pw[3];
            u32x4 f1; f1.x = pw[4]; f1.y = pw[5]; f1.z = pw[6]; f1.w = pw[7];
            pf[qt][0] = __builtin_bit_cast(bf16x8, f0); pf[qt][1] = __builtin_bit_cast(bf16x8, f1);
        }
        bf16x8 vfr[4][2];
#pragma unroll
        for (int dt = 0; dt < 4; ++dt)
#pragma unroll
            for (int ks = 0; ks < 2; ++ks) {
                const int vsw = ((16 * dt + lc) >> 3) << 3;
                const u32x2 a0 = *(const LAS u32x2*)(Vt + (16 * dt + lc) * ALD + ((32 * ks + 4 * lg) ^ vsw)), a1 = *(const LAS u32x2*)(Vt + (16 * dt + lc) * ALD + ((32 * ks + 16 + 4 * lg) ^ vsw));
                u32x4 av; av.x = a0.x; av.y = a0.y; av.z = a1.x; av.w = a1.y;
                vfr[dt][ks] = __builtin_bit_cast(bf16x8, av); }
        __builtin_amdgcn_sched_barrier(0);
#pragma unroll
        for (int dt = 0; dt < 4; ++dt)
#pragma unroll
            for (int ks = 0; ks < 2; ++ks)
#pragma unroll
                for (int qt = 0; qt < 2; ++qt) o[dt][qt] = __builtin_amdgcn_mfma_f32_16x16x32_bf16(vfr[dt][ks], pf[qt][ks], o[dt][qt], 0, 0, 0);
    }
#undef ATT_FETCH
#undef ATT_NEXT
    bf16* ATT = WSP<bf16>(F, WS_RET) + 512;
#pragma unroll
    for (int qt = 0; qt < 2; ++qt) {
        float lt = lsum[qt]; lt += __shfl_xor(lt, 16); lt += __shfl_xor(lt, 32);
        const float inv = 1.0f / lt;
        bf16* op = ATT + (size_t)(rowq0 + 16 * qt + lc) * 1536 + h * 64 + 4 * lg;
#pragma unroll
        for (int dt = 0; dt < 4; ++dt) { u32x2 ov; ov.x = pk2(o[dt][qt][0] * inv, o[dt][qt][1] * inv); ov.y = pk2(o[dt][qt][2] * inv, o[dt][qt][3] * inv); *(u32x2*)(op + 16 * dt) = ov; }
    }
}

__device__ __forceinline__ void ph_norm2_router(Frame& F, int l, int nrows) {
    const int lane = F.lane, RPB = nrows / 256;
    LAS float* RW = (LAS float*)F.lds;
    LAS unsigned* cnt = (LAS unsigned*)(F.lds + LDSX + 64);
    __syncthreads();
    { const float* rw = IN_(F, 24) + (size_t)l * 1024 * 32;
#pragma unroll 1
      for (int i0 = F.tid; i0 < 1024 * 32 / 4; i0 += 8 * NTHR) { f32x4 t8[8];
#pragma unroll
          for (int k = 0; k < 8; ++k) t8[k] = *(const f32x4*)(rw + 4 * (i0 + k * NTHR));
          __builtin_amdgcn_sched_barrier(0);
#pragma unroll
          for (int k = 0; k < 8; ++k) { const int i = i0 + k * NTHR, col = i >> 3, ch = i & 7, ll = (col >> 2) & 63, ridx = ((col & 3) * 4 + (col >> 8)) * 64 + ll;
              *(LAS f32x4*)(RW + ridx * 32 + ((ch ^ ((ll >> 1) & 7)) << 2)) = t8[k]; } } }
    if (F.tid < 32) cnt[F.tid] = 0u;
    { int* SRC = WSP<int>(F, WS_SRC); for (int i = F.bx * NTHR + F.tid; i < MPAD; i += F.G * NTHR) SRC[i] = 0; }
    __syncthreads();
    const float* xm_all = WSP<float>(F, WS_XM);
    const float* gw_ = IN_(F, 23) + l * DM;
    const int e = lane >> 1, sw = (lane >> 1) & 7;
    const float rb = IN_(F, 25)[l * 32 + e];
    int* TOPI = WSP<int>(F, WS_TOPI); float* TOPW = WSP<float>(F, WS_TOPW);
    typedef float f32x2 __attribute__((ext_vector_type(2)));
    f32x4 vnext[2][4];
    { const float* xr0 = xm_all + (size_t)(F.bx * RPB + 2 * F.wave) * DM;
#pragma unroll
      for (int t = 0; t < 2; ++t)
#pragma unroll
        for (int j = 0; j < 4; ++j) vnext[t][j] = *(const f32x4*)(xr0 + t * DM + 4 * lane + 256 * j); }
#pragma unroll 1
    for (int rr = 2 * F.wave; rr < RPB; rr += 2 * NWAVES) {
        const int r = F.bx * RPB + rr, mr = modrow_of(r);
        f32x4 shq[4], aq[4];
        { const float* sh = mod_ptr(F, l, mr, 3); const float* sc = mod_ptr(F, l, mr, 4); f32x4 gq_[4], sc_[4];
#pragma unroll
          for (int j = 0; j < 4; ++j) { shq[j] = *(const f32x4*)(sh + 4 * lane + 256 * j); gq_[j] = *(const f32x4*)(gw_ + 4 * lane + 256 * j); sc_[j] = *(const f32x4*)(sc + 4 * lane + 256 * j); }
          __builtin_amdgcn_sched_barrier(0);
#pragma unroll
          for (int j = 0; j < 4; ++j) aq[j] = gq_[j] * (sc_[j] + 1.0f); }
        f32x4 v[2][4]; float ss[2] = {0.f, 0.f};
#pragma unroll
        for (int t = 0; t < 2; ++t)
#pragma unroll
            for (int j = 0; j < 4; ++j) { v[t][j] = vnext[t][j]; ss[t] += (v[t][j][0] * v[t][j][0] + v[t][j][1] * v[t][j][1]) + (v[t][j][2] * v[t][j][2] + v[t][j][3] * v[t][j][3]); }
        const float* xn = xm_all + (size_t)((rr + 2 * NWAVES < RPB) ? r + 2 * NWAVES : r) * DM;
#pragma unroll
        for (int t = 0; t < 2; ++t) {
            const float rstd = 1.0f / sqrtf(wave_sum(ss[t]) * (1.0f / DM) + EPS);
            bf16* o = WSP<bf16>(F, WS_XN) + (size_t)(r + t) * DM;
#pragma unroll
            for (int j = 0; j < 4; ++j) { v[t][j] = v[t][j] * rstd * aq[j] + shq[j];
                u32x2 w2; w2.x = pk2(v[t][j][0], v[t][j][1]); w2.y = pk2(v[t][j][2], v[t][j][3]); *(u32x2*)(o + 4 * lane + 256 * j) = w2; } }
        f32x2 acc[2][16];
#pragma unroll
        for (int t = 0; t < 2; ++t)
#pragma unroll
            for (int i = 0; i < 16; ++i) acc[t][i] = (f32x2){0.f, 0.f};
        f32x4 wa[8], wb[8];
#define RT_LOAD(W, c) { const int j_ = (c) >> 2, q_ = (c) & 3, ri_ = (q_ * 4 + j_) * 64 + lane; \
            _Pragma("unroll") for (int c8 = 0; c8 < 8; ++c8) W[c8] = *(const LAS f32x4*)(RW + ri_ * 32 + ((c8 ^ sw) << 2)); }
#define RT_FMA(W, c) { const int j_ = (c) >> 2, q_ = (c) & 3; const float h0 = v[0][j_][q_], h1 = v[1][j_][q_]; const f32x2 hh0 = {h0, h0}, hh1 = {h1, h1}; \
            _Pragma("unroll") for (int c8 = 0; c8 < 8; ++c8) { acc[0][2 * c8] += hh0 * W[c8].lo; acc[0][2 * c8 + 1] += hh0 * W[c8].hi; acc[1][2 * c8] += hh1 * W[c8].lo; acc[1][2 * c8 + 1] += hh1 * W[c8].hi; } }
        RT_LOAD(wa, 0)
#pragma unroll
        for (int c = 0; c < 16; c += 2) {
            RT_LOAD(wb, c + 1)
            __builtin_amdgcn_sched_barrier(0);
            RT_FMA(wa, c)
            __builtin_amdgcn_sched_barrier(0);
            if (c + 2 < 16) RT_LOAD(wa, c + 2)
            __builtin_amdgcn_sched_barrier(0);
            RT_FMA(wb, c + 1)
            __builtin_amdgcn_sched_barrier(0);
            if ((c & 3) == 2) { const int jj = c >> 2;
#pragma unroll
                for (int t = 0; t < 2; ++t) vnext[t][jj] = *(const f32x4*)(xn + t * DM + 4 * lane + 256 * jj);
                __builtin_amdgcn_sched_barrier(0); }
        }
#undef RT_LOAD
#undef RT_FMA
#pragma unroll
        for (int i = 0; i < 16; ++i) asm volatile("" : "+v"(acc[1][i]));
#pragma unroll
        for (int t = 0; t < 2; ++t) {
        float r16[16], r8[8], r4[4], r2[2];
#pragma unroll
        for (int i = 0; i < 16; ++i) { const auto sw2 = __builtin_amdgcn_permlane32_swap(__float_as_uint(acc[t][i >> 1][i & 1]), __float_as_uint(acc[t][8 + (i >> 1)][i & 1]), false, false);
            r16[i] = __uint_as_float(sw2[0]) + __uint_as_float(sw2[1]); }
#pragma unroll
        for (int i = 0; i < 8; ++i) { const auto sw2 = __builtin_amdgcn_permlane16_swap(__float_as_uint(r16[i]), __float_as_uint(r16[8 + i]), false, false);
            r8[i] = __uint_as_float(sw2[0]) + __uint_as_float(sw2[1]); }
#define RT_DPP(old, v, ctrl, bm) __int_as_float(__builtin_amdgcn_update_dpp(__float_as_int(old), __float_as_int(v), (ctrl), 0xF, (bm), false))
        { const bool hi = (lane & 8) != 0;
#pragma unroll
          for (int i = 0; i < 4; ++i) { const float a = r8[i], b = r8[4 + i]; const float u = RT_DPP(RT_DPP(0.f, a, 0x128, 0x3), b, 0x128, 0xC); r4[i] = (hi ? b : a) + u; } }
        { const bool hi = (lane & 4) != 0;
#pragma unroll
          for (int i = 0; i < 2; ++i) { const float a = r4[i], b = r4[2 + i]; const float u = RT_DPP(RT_DPP(0.f, a, 0x12C, 0x5), b, 0x124, 0xA); r2[i] = (hi ? b : a) + u; } }
        float logit;
        { const bool hi = (lane & 2) != 0; const float keep = hi ? r2[1] : r2[0], send = hi ? r2[0] : r2[1]; logit = keep + RT_DPP(0.f, send, 0x4E, 0xF); }
        logit += RT_DPP(0.f, logit, 0xB1, 0xF);
#undef RT_DPP
        logit += rb;
        int rank = 0;
#pragma unroll
        for (int q = 0; q < 32; ++q) { const float lq = rdlane(logit, 2 * q); rank += (lq > logit) ? 1 : 0; }
        { const bool ev = (lane & 1) == 0;
          const bool uniq = __builtin_popcountll(__ballot(ev && rank == 0)) == 1 && __builtin_popcountll(__ballot(ev && rank == 1)) == 1 && __builtin_popcountll(__ballot(ev && rank == 2)) == 1 && __builtin_popcountll(__ballot(ev && rank == 3)) == 1;
          if (!uniq) { rank = 0;
#pragma unroll 1
              for (int q = 0; q < 32; ++q) { const float lq = rdlane(logit, 2 * q); rank += (lq > logit || (lq == logit && q < e)) ? 1 : 0; } } }
        const bool sel = (rank < 4) && ((lane & 1) == 0);
        const unsigned long long m0 = __ballot(sel && rank == 0), m1 = __ballot(sel && rank == 1), m2 = __ballot(sel && rank == 2), m3 = __ballot(sel && rank == 3);
        const int l0 = __builtin_ctzll(m0), l1 = __builtin_ctzll(m1), l2 = __builtin_ctzll(m2), l3 = __builtin_ctzll(m3);
        const float t0 = rdlane(logit, l0), t1 = rdlane(logit, l1), t2 = rdlane(logit, l2), t3 = rdlane(logit, l3);
        const float e1 = __expf(t1 - t0), e2 = __expf(t2 - t0), e3 = __expf(t3 - t0), inv = 1.0f / (1.0f + e1 + e2 + e3);
        if (lane < 4) { const int id = ((lane == 0) ? l0 : (lane == 1) ? l1 : (lane == 2) ? l2 : l3) >> 1; const float wv = ((lane == 0) ? 1.0f : (lane == 1) ? e1 : (lane == 2) ? e2 : e3) * inv;
            TOPI[(r + t) * 4 + lane] = id; TOPW[(r + t) * 4 + lane] = wv; __hip_atomic_fetch_add(cnt + id, 1u, __ATOMIC_RELAXED, __HIP_MEMORY_SCOPE_WORKGROUP); }
        }
    }
    __syncthreads();
    if (F.tid < 32) WSP<int>(F, WS_BLKCNT)[F.bx * 32 + F.tid] = (int)cnt[F.tid];
}

__device__ __forceinline__ void ph_moe_assign(Frame& F, int nrows) {
    const int RPB = nrows / 256, lane = F.lane;
    LAS int* part = (LAS int*)F.lds;
    LAS int* base = part + 1024;
    LAS int* idx = base + 32;
    LAS int* posl = idx + 1024;
    const int* BC = WSP<int>(F, WS_BLKCNT);
    __syncthreads();
    { const int e = F.tid & 31, pt = F.tid >> 5; int st = 0, sp = 0;
      for (int q = 0; q < 16; ++q) { const int blk = pt * 16 + q; const int v = BC[blk * 32 + e]; st += v; if (blk < F.bx) sp += v; }
      part[pt * 32 + e] = st; part[512 + pt * 32 + e] = sp; }
    for (int i = F.tid; i < RPB * 4; i += NTHR) idx[i] = WSP<int>(F, WS_TOPI)[F.bx * RPB * 4 + i];
    __syncthreads();
    if (F.tid < 32) { int st = 0, sp = 0; for (int q = 0; q < 16; ++q) { st += part[q * 32 + F.tid]; sp += part[512 + q * 32 + F.tid]; }
        part[F.tid] = st; part[512 + F.tid] = sp; }
    __syncthreads();
    if (F.tid == 0) { int t0 = 0; int* tl = WSP<int>(F, WS_TILES);
        for (int e = 0; e < 32; ++e) { base[e] = t0 * 256 + part[512 + e]; if (F.bx == 0) tl[e] = t0; t0 += (part[e] + 255) >> 8; }
        if (F.bx == 0) tl[32] = t0; }
    __syncthreads();
    LAS int* cc = posl + 1024;
    const int nent = RPB * 4;
    for (int ch = F.wave; ch * 64 < nent; ch += NWAVES) { const int j = ch * 64 + lane; const int my = (j < nent) ? idx[j] : -1; int rk = 0, cnte = 0;
#pragma unroll
        for (int e = 0; e < 32; ++e) { const unsigned long long m = __ballot(my == e); const int below = __builtin_amdgcn_mbcnt_hi((unsigned)(m >> 32), __builtin_amdgcn_mbcnt_lo((unsigned)m, 0));
            if (my == e) rk = below; if (lane == e) cnte = __builtin_popcountll(m); }
        if (lane < 32) cc[ch * 32 + lane] = cnte;
        if (j < nent) posl[j] = rk; }
    __syncthreads();
    for (int j = F.tid; j < nent; j += NTHR) { const int e = idx[j], ch = j >> 6; int p = base[e] + posl[j]; for (int q = 0; q < ch; ++q) p += cc[q * 32 + e]; posl[j] = p; }
    __syncthreads();
    int* POS = WSP<int>(F, WS_POS); int* SRC = WSP<int>(F, WS_SRC);
    for (int j = F.tid; j < RPB * 4; j += NTHR) { const int p = posl[j]; POS[F.bx * RPB * 4 + j] = p; SRC[p] = F.bx * RPB + (j >> 2); }
}

#define PHASE_FN __device__ __forceinline__
#ifndef MK_STAG_G
#define MK_STAG_G 1
#endif
#ifndef MK_STAG_US
#define MK_STAG_US 12
#endif
__device__ __forceinline__ void phase_stagger(const Frame& F) {
    if (MK_STAG_G > 1) { const int grp = (F.bx >> 3) % MK_STAG_G;
        if (grp) { const unsigned long long t0 = __builtin_amdgcn_s_memrealtime(), dt = (unsigned long long)(grp * MK_STAG_US * 100 / MK_STAG_G);
            while (__builtin_amdgcn_s_memrealtime() - t0 < dt) __builtin_amdgcn_s_sleep(32); } }
}
PHASE_FN void P_prologue() { Frame F = make_frame(); p0_prologue(F); }
PHASE_FN void P_norm1(int mode) { Frame F = make_frame(); ph_norm1(F, mode);
    if (mode == 0) { FftTw T; fft_tw_init(T, F.tid); for (int it = F.bx; it < 1024; it += F.G) fft_filter_unit(F, T, it >> 9, it & 511); } }
PHASE_FN void P_inproj(int l) { Frame F = make_frame(); phase_stagger(F);
    pg8::Gemm g{WSP<bf16>(F, WS_XN), WSP<bf16>(F, WS_WIN) + (size_t)l * INC * 1024, NROWS, INC, 1024};
    pg8::StaticOrder S; S.init(NROWS, INC, F.G, F.bx);
    EpiP E{WSP<bf16>(F, WS_P), IN_(F, 21) + l * 3072};
    pg8::gemm_phase<EpiP, pg8::StaticOrder, true, true>(F.lds, g, S, E);
    if (l == 0 && F.bx >= F.G - 8) hy_filter_item(F, 2, F.bx - (F.G - 8));
    if (l == 0 && F.bx >= 104) tr_deferred(F, 0, 5400, F.bx - 104, 152); }
#ifndef MK_REP2
#define MK_REP2 0u
#endif
PHASE_FN void P_mix(int l) { Frame F = make_frame(); const bool last = (l == 1);
    const int na = last ? 1024 : 1088;
    for (int rep = 0; rep < ((MK_REP2 & 1u) ? 2 : 1); ++rep)
    for (int it = F.bx; it < na; it += F.G) attn_unit(F, l, it);
    for (int rep = 0; rep < ((MK_REP2 & 2u) ? 2 : 1); ++rep)
    for (int it = F.G - 1 - F.bx; it < 1088; it += F.G) ret_kv_unit(F, l, it);
    for (int rep = 0; rep < ((MK_REP2 & 4u) ? 2 : 1); ++rep) ph_hyprep2(F, l, !last); }

PHASE_FN void P_hyconv(int l) { Frame F = make_frame(); const bool last = (l == 1);
    for (int rep = 0; rep < ((MK_REP2 & 8u) ? 2 : 1); ++rep) ret_scan(F, l);
    { FftTw T; fft_tw_init(T, F.tid); unsigned zpa[8], zpb[8];
      fft_zfetch(F, F.bx, F.tid, zpa); fft_zfetch(F, F.bx + F.G, F.tid, zpb);
      for (int rep = 0; rep < ((MK_REP2 & 16u) ? 2 : 1); ++rep)
      for (int it = F.bx; it < 2048; it += 2 * F.G) { const int na = (it + 2 * F.G < 2048) ? it + 2 * F.G : F.bx, nb = (it + 3 * F.G < 2048) ? it + 3 * F.G : F.bx + F.G;
          fft_conv_pair(F, T, l, it, it + F.G, na, nb, zpa, zpb); } }
    if (!last) for (int it = F.bx; it < 512; it += F.G) hyconv_ctx_item2(F, it); }
PHASE_FN void P_hypost(int l) { Frame F = make_frame(); const bool last = (l == 1);
    for (int rep = 0; rep < ((MK_REP2 & 32u) ? 2 : 1); ++rep)
    for (int it = F.bx; it < 1088; it += F.G) { const int ci = it % 34; if (last && ci < 2) continue; ret_out_unit(F, l, it); }
    for (int rep = 0; rep < ((MK_REP2 & 64u) ? 2 : 1); ++rep) ph_hypost2(F, l, !last); }
PHASE_FN void P_merge(int l) { Frame F = make_frame(); const int mrows = (l == 1) ? NLAT : NROWS;
    pg8::Gemm g{WSP<bf16>(F, WS_RET), WSP<bf16>(F, WS_WBR) + (size_t)l * 1024 * 1536, mrows, 1024, 1536};
    pg8::StaticOrder S; S.init(mrows, 1024, F.G, F.bx);
    EpiMerge E{WSP<bf16>(F, WS_P), WSP<bf16>(F, WS_M)};
    pg8::gemm_phase<EpiMerge, pg8::StaticOrder, true, true>(F.lds, g, S, E);
    if (l == 0 && F.bx >= 32) tr_deferred(F, 5400, 11300, F.bx - 32, 224); }
PHASE_FN void P_out(int l) { Frame F = make_frame(); const int mrows = (l == 1) ? NLAT : NROWS;
    pg8::Gemm g{WSP<bf16>(F, WS_M), WSP<bf16>(F, WS_WOUT) + (size_t)l * 1024 * 1024, mrows, 1024, 1024};
    pg8::StaticOrder S; S.init(mrows, 1024, F.G, F.bx);
    const float* xl = (l == 0) ? IN_(F, 0) : WSP<float>(F, WS_XO);
    const float* xc = (l == 0) ? IN_(F, 2) : WSP<float>(F, WS_XO) + (size_t)NLAT * DM;
    EpiOut E{xl, xc, mod_ptr(F, l, 0, 2), WSP<float>(F, WS_XM)};
    pg8::gemm_phase<EpiOut, pg8::StaticOrder, true, true>(F.lds, g, S, E);
    if (l == 0 && F.bx >= 32) tr_deferred(F, 16700, TRD_TOTAL - 16700, F.bx - 32, 224); }
PHASE_FN void P_router(int l) { Frame F = make_frame(); ph_norm2_router(F, l, (l == 1) ? NLAT : NROWS); }
PHASE_FN void P_assign(int l) { Frame F = make_frame(); ph_moe_assign(F, (l == 1) ? NLAT : NROWS); }
PHASE_FN void P_moe1(int l) { Frame F = make_frame();
    LAS int* list = (LAS int*)(F.lds + LDSX + 256);
    const int n = moe_list_units(F, 8, list);
    LAS int* srcl = (LAS int*)(F.lds + LDS_SRC);
    { const int* SRC = WSP<int>(F, WS_SRC);
      int sv[12];
#pragma unroll
      for (int k = 0; k < 12; ++k) { const int i = F.tid + k * NTHR; sv[k] = (i < n * 256) ? SRC[list[2 * (i >> 8)] * 256 + (i & 255)] : 0; }
      __builtin_amdgcn_sched_barrier(0);
#pragma unroll
      for (int k = 0; k < 12; ++k) { const int i = F.tid + k * NTHR; if (i < n * 256) srcl[i] = sv[k]; }
      for (int i = F.tid + 12 * NTHR; i < n * 256; i += NTHR) srcl[i] = SRC[list[2 * (i >> 8)] * 256 + (i & 255)]; }
    __syncthreads();
    pg8::Gemm g{WSP<bf16>(F, WS_XN), WSP<bf16>(F, WS_W1) + (size_t)l * 32 * 2048 * 1024, MPAD, 32 * 2048, 1024};
    phase_stagger(F);
    MoeOrderG S{srcl, list, n};
    EpiMoe1 E{IN_(F, 27) + (size_t)l * 32 * 2048, WSP<bf16>(F, WS_ACT)};
    pg8::gemm_phase<EpiMoe1, MoeOrderG, true, true>(F.lds, g, S, E); }
PHASE_FN void P_moe2(int l) { Frame F = make_frame();
    LAS int* list = (LAS int*)(F.lds + LDSX + 256);
    const int n = moe_list_units(F, 4, list);
    pg8::Gemm g{WSP<bf16>(F, WS_ACT), WSP<bf16>(F, WS_W2) + (size_t)l * 32 * 1024 * 1024, MPAD, 32 * 1024, 1024};
    phase_stagger(F);
    MoeOrder S{nullptr, list, n};
    EpiMoe2 E{IN_(F, 29) + (size_t)l * 32 * 1024, WSP<bf16>(F, WS_HS)};
    pg8::gemm_phase<EpiMoe2, MoeOrder, true, true>(F.lds, g, S, E); }

template <int ONLY> __global__ void __launch_bounds__(NTHR, 2) mk_fwd(Args args) {
    LAS unsigned char* lds = (LAS unsigned char*)lds_raw;
    const int tid = threadIdx.x;
    for (int u = tid; u < (LDS_BYTES - LDSX) / 4; u += NTHR) ((LAS unsigned*)(lds + LDSX))[u] = 0u;
    __syncthreads();
    if (tid < 33) { const unsigned long long v = (tid < 31) ? (unsigned long long)args.in[tid] : (tid == 31 ? (unsigned long long)args.out : (unsigned long long)args.ws);
        *(LAS unsigned long long*)(lds + LDS_PTAB + 8 * tid) = v; }
    __syncthreads();
    const int lo = args.ph_lo, hi = args.ph_hi;
    const bool one_launch = (hi - lo) > 1;
    unsigned* barw = (unsigned*)(args.ws + WS_CTL + CTL_BAR);
    XcdBarrier bar; bar.bar = barw; bar.x = 0; bar.st = nullptr;
    if (one_launch) bar = xcd_barrier_post(barw, (volatile LAS unsigned*)(lds + LDSX));
#ifndef MK_MASK
#define MK_MASK 0xFFFFFFFFu
#endif
#define ENAB(k) ((ONLY < 0 && ((MK_MASK >> ((k) >= 100 ? (k) - 100 + 14 : (k))) & 1u)) || ONLY == (k))
#ifndef MK_REP
#define MK_REP 0u
#endif
#define REPB(k) (((MK_REP) >> ((k) >= 100 ? (k) - 100 + 14 : (k))) & 1u)
#define IN(k) (lo <= (k) && (k) < hi)
#define SEAM(k) do { if (IN(k) && IN((k) + 1)) xcd_barrier(bar); } while (0)
    if (ENAB(100)) if (IN(0)) { P_prologue(); if (REPB(100)) { xcd_barrier(bar); P_prologue(); } } SEAM(0);
    for (int l = 0; l < 2; ++l) {
        const int pb = 1 + NPH_LAYER * l;
        if (ENAB(0)) if (IN(pb + 0)) { P_norm1(l == 0 ? 0 : 1); if (REPB(0)) { xcd_barrier(bar); P_norm1(l == 0 ? 0 : 1); } } SEAM(pb + 0);
        if (ENAB(1)) if (IN(pb + 1)) { P_inproj(l); if (REPB(1)) { xcd_barrier(bar); P_inproj(l); } } SEAM(pb + 1);
        if (ENAB(3)) if (IN(pb + 3)) { P_mix(l); if (REPB(3)) { xcd_barrier(bar); P_mix(l); } } SEAM(pb + 3);
        if (ENAB(4)) if (IN(pb + 4)) { P_hyconv(l); if (REPB(4)) { xcd_barrier(bar); P_hyconv(l); } } SEAM(pb + 4);
        if (ENAB(5)) if (IN(pb + 5)) { P_hypost(l); if (REPB(5)) { xcd_barrier(bar); P_hypost(l); } } SEAM(pb + 5);
        if (ENAB(6)) if (IN(pb + 6)) { P_merge(l); if (REPB(6)) { xcd_barrier(bar); P_merge(l); } } SEAM(pb + 6);
        if (ENAB(9)) if (IN(pb + 9)) { P_out(l); if (REPB(9)) { xcd_barrier(bar); P_out(l); } } SEAM(pb + 9);
        if (ENAB(10)) if (IN(pb + 10)) { P_router(l); if (REPB(10)) { xcd_barrier(bar); P_router(l); } } SEAM(pb + 10);
        if (ENAB(11)) if (IN(pb + 11)) { P_assign(l); if (REPB(11)) { xcd_barrier(bar); P_assign(l); } } SEAM(pb + 11);
        if (ENAB(12)) if (IN(pb + 12)) { P_moe1(l); if (REPB(12)) { xcd_barrier(bar); P_moe1(l); } } SEAM(pb + 12);
        if (ENAB(13)) if (IN(pb + 13)) { P_moe2(l); if (REPB(13)) { xcd_barrier(bar); P_moe2(l); } } SEAM(pb + 13);
    }
    if (ENAB(101)) if (IN(NPH - 1)) { P_norm1(2); }
#undef IN
#undef SEAM
#undef ENAB
}

template <int ONLY> static void launch_phase(Args a, int lo, int hi, int grid, hipStream_t stream) {
    static bool attr_set = false;
    if (!attr_set) { (void)hipFuncSetAttribute((const void*)mk_fwd<ONLY>, hipFuncAttributeMaxDynamicSharedMemorySize, LDS_BYTES); attr_set = true; }
    a.ph_lo = lo; a.ph_hi = hi;
    hipLaunchKernelGGL(mk_fwd<ONLY>, dim3(grid), dim3(NTHR), LDS_BYTES, stream, a);
}
extern "C" void kernel_launch(void* const* d_in, const int* in_sizes, int n_in, void* d_out, int out_size, void* d_ws, size_t ws_size, hipStream_t stream) {
    static int grid = 0;
    if (grid == 0) {
        if (n_in != 31 || ws_size < WS_END) { fprintf(stderr, "kernel_launch: unexpected n_in %d / ws_size %zu\n", n_in, ws_size); grid = -1; return; }
        int dev = 0, cus = 0;
        if (hipGetDevice(&dev) != hipSuccess || hipDeviceGetAttribute(&cus, hipDeviceAttributeMultiprocessorCount, dev) != hipSuccess) { grid = -1; return; }
        grid = (cus == 256) ? 256 : -1;
        if (grid < 0) { fprintf(stderr, "kernel_launch: needs a 256-CU device, got %d\n", cus); return; }
    }
    if (grid < 0) return;
    (void)hipMemsetAsync((char*)d_ws + WS_CTL, 0, CTL_ZERO_BYTES, stream);
    Args a{};
    for (int i = 0; i < 31; ++i) a.in[i] = (const float*)d_in[i];
    a.out = (float*)d_out; a.ws = (unsigned char*)d_ws;
#if MK_ONE_LAUNCH
    launch_phase<-1>(a, 0, NPH, grid, stream);
#else
    launch_phase<100>(a, 0, 1, grid, stream);
    for (int l = 0; l < 2; ++l) {
        const int pb = 1 + NPH_LAYER * l;
        launch_phase<0>(a, pb + 0, pb + 1, grid, stream);   launch_phase<1>(a, pb + 1, pb + 2, grid, stream);   launch_phase<2>(a, pb + 2, pb + 3, grid, stream);
        launch_phase<3>(a, pb + 3, pb + 4, grid, stream);   launch_phase<4>(a, pb + 4, pb + 5, grid, stream);   launch_phase<5>(a, pb + 5, pb + 6, grid, stream);
        launch_phase<6>(a, pb + 6, pb + 7, grid, stream);   launch_phase<7>(a, pb + 7, pb + 8, grid, stream);   launch_phase<8>(a, pb + 8, pb + 9, grid, stream);
        launch_phase<9>(a, pb + 9, pb + 10, grid, stream);  launch_phase<10>(a, pb + 10, pb + 11, grid, stream); launch_phase<11>(a, pb + 11, pb + 12, grid, stream);
        launch_phase<12>(a, pb + 12, pb + 13, grid, stream); launch_phase<13>(a, pb + 13, pb + 14, grid, stream);
    }
    launch_phase<101>(a, NPH - 1, NPH, grid, stream);
#endif
}
```

```cpp
#include <hip/hip_runtime.h>
#include <cstdio>
#include <cstdint>
#define MK_ONE_LAUNCH 1
namespace pg8 {
#define PG8_LAS __attribute__((address_space(3)))
typedef unsigned short bf16_t;
typedef short bf16x8 __attribute__((ext_vector_type(8)));
typedef float f32x4 __attribute__((ext_vector_type(4)));
typedef unsigned u32x4 __attribute__((ext_vector_type(4)));
constexpr int BM = 256, BK = 64, HALF = 128, HTB = HALF * BK * 2  , STAGE_BYTES = 8 * HTB, NXCD = 8, WGM = 8;

__host__ __device__ __forceinline__ int lds_byte(int r, int c) { const int st = (r >> 4) * 2 + (c >> 5), rr = r & 15, cc = c & 31, ob = rr * 64 + cc * 2; return st * 1024 + (ob ^ (((ob >> 9) & 1) << 5)); }
__host__ __device__ __forceinline__ void stage_rc(int b, int& R, int& C) { const int st = b / 1024, sb = b % 1024, swz = sb ^ (((sb >> 9) & 1) << 5); R = (st >> 1) * 16 + swz / 64; C = (st & 1) * 32 + (swz % 64) / 2; }
__host__ __device__ __forceinline__ int perm32(int rho) { const int n = rho >> 4, i = rho & 15; return 8 * (i >> 2) + 4 * n + (i & 3); }

struct Unit { int pm, pn; };
struct Gemm { const bf16_t* A; const bf16_t* Bt; int M, N, K; };

struct StaticOrder {
    static constexpr bool GATHER = false; const PG8_LAS int* src;
    int nM, nN, nwg, G, c;
    __host__ __device__ void init(int M, int N, int G_, int c_) { nM = M / BM; nN = N / BM; nwg = nM * nN; G = G_; c = c_; }
    __host__ __device__ bool next(int i, Unit& u) const {
        const long L = (long)i * G + c; if (L >= nwg) return false;
        int wgid = (int)L; { const int q = nwg / NXCD, r = nwg % NXCD, xcd = wgid % NXCD, off = wgid / NXCD; wgid = (xcd < r ? xcd * (q + 1) : r * (q + 1) + (xcd - r) * q) + off; }
        const int nig = WGM * nN, gid = wgid / nig, fm = gid * WGM, gsz = (nM - fm) < WGM ? (nM - fm) : WGM;
        u.pm = fm + ((wgid % nig) % gsz); u.pn = (wgid % nig) / gsz; return true;
    }
    __device__ __forceinline__ void a_ready(const Unit&) const {}
    __device__ __forceinline__ void done(const Unit&) const {}
};

__device__ __forceinline__ unsigned cvt_pk_bf16(float lo, float hi) { unsigned r; asm("v_cvt_pk_bf16_f32 %0, %1, %2" : "=v"(r) : "v"(lo), "v"(hi));     return r; }
template <class Epi, class Sched, bool ALIGN_EPI = false, bool SP2 = false>
__device__ __forceinline__ void gemm_phase(PG8_LAS unsigned char* lds, const Gemm g, const Sched& S, const Epi& E) {
    int tid_ = threadIdx.x; asm volatile("" : "+v"(tid_));
    const int tid = tid_, wid = __builtin_amdgcn_readfirstlane(tid >> 6), lane = tid & 63, wr = wid >> 2, wc = wid & 3, fr = lane & 15, fq = lane >> 4;
    const int K = g.K, nt = K / BK;
    unsigned voffA[2], voffB[2];
#pragma unroll
    for (int i = 0; i < 2; ++i) { int R, C; stage_rc(tid * 16 + i * 8192, R, C); const int Rb = Epi::PERM ? ((R & ~31) + perm32(R & 31)) : R;
        voffA[i] = (unsigned)(R * K + C) * 2u; voffB[i] = (unsigned)(Rb * K + C) * 2u; }
    constexpr bool GATHER = Sched::GATHER;
    static_assert(!GATHER || SP2, "the gathered A path is wired into the SP2 loop only");
    unsigned vAc[2][2], vAn[2][2];
#define PG8_GIDX(dst, ord) do { _Pragma("unroll") for (int _h = 0; _h < 2; ++_h) _Pragma("unroll") for (int _i = 0; _i < 2; ++_i) { int _R, _C; stage_rc(tid * 16 + _i * 8192, _R, _C); \
        dst[_h][_i] = (unsigned)S.src[(ord) * 256 + _h * 128 + _R] * (unsigned)(K * 2) + (unsigned)(_C * 2); } } while (0)
    const size_t kstep = (size_t)(BK * 2);
    const size_t hstep = (size_t)HALF * K * 2;
    const size_t tstep = 2 * hstep;
    const unsigned ldsw = (unsigned)wid * 1024u;
    const int aoff = lds_byte(wr * 64 + fr, fq * 8), boff = lds_byte(wc * 32 + fr, fq * 8);
#define PG8_SA(b, h) (((b) * 2 + (h)) * HTB)
#define PG8_SB(b, h) ((4 + (b) * 2 + (h)) * HTB)
#define PG8_STAGE(bufoff, gbase, voff) do { _Pragma("unroll") for (int _i = 0; _i < 2; ++_i) \
        __builtin_amdgcn_global_load_lds((const unsigned*)((const char*)(gbase) + (voff)[_i]), (PG8_LAS unsigned*)(lds + (bufoff) + ldsw + _i * 8192), 16, 0, 0); } while (0)
#define PG8_STAGE_A(bufoff, gbase, h, vg) do { if constexpr (GATHER) { PG8_STAGE(bufoff, gbase, (vg)[h]); } else { PG8_STAGE(bufoff, (gbase) + ((h) ? hstep : 0), voffA); } } while (0)
#define PG8_LDA(dst, b, h) do { _Pragma("unroll") for (int m = 0; m < 4; ++m) _Pragma("unroll") for (int k = 0; k < 2; ++k) dst[m][k] = *(const PG8_LAS bf16x8*)(lds + PG8_SA(b, h) + aoff + m * 2048 + k * 1024); } while (0)
#define PG8_LDB(dst, b, h) do { _Pragma("unroll") for (int n = 0; n < 2; ++n) _Pragma("unroll") for (int k = 0; k < 2; ++k) dst[n][k] = *(const PG8_LAS bf16x8*)(lds + PG8_SB(b, h) + boff + n * 2048 + k * 1024); } while (0)
#define PG8_MMA(ai, bj, At, Bt) do { __builtin_amdgcn_s_setprio(1); _Pragma("unroll") for (int m = 0; m < 4; ++m) _Pragma("unroll") for (int n = 0; n < 2; ++n) _Pragma("unroll") for (int k = 0; k < 2; ++k) \
        acc[ai][bj][m][n] = __builtin_amdgcn_mfma_f32_16x16x32_bf16(Bt[n][k], At[m][k], acc[ai][bj][m][n], 0, 0, 0); __builtin_amdgcn_s_setprio(0); } while (0)
#define PG8_WAIT_V(n) asm volatile("s_waitcnt vmcnt(" #n ")" ::: "memory")
#define PG8_WAIT_L(n) asm volatile("s_waitcnt lgkmcnt(" #n ")" ::: "memory")
#define PG8_BAR __builtin_amdgcn_s_barrier()
#define PG8_SCHED __builtin_amdgcn_sched_barrier(0)
    Unit cur, nxt; int ui = 0;
    if (!S.next(0, cur)) return;
    f32x4 acc[2][2][4][2];
#pragma unroll
    for (int a = 0; a < 2; ++a)
#pragma unroll
        for (int b = 0; b < 2; ++b)
#pragma unroll
            for (int m = 0; m < 4; ++m)
#pragma unroll
                for (int n = 0; n < 2; ++n) acc[a][b][m][n] = (f32x4){0.f, 0.f, 0.f, 0.f};
    bf16x8 At[4][2], B0[2][2], B1[2][2];
    const char* cA = (const char*)g.A + (GATHER ? (size_t)0 : (size_t)cur.pm * tstep); const char* cB = (const char*)g.Bt + (size_t)cur.pn * tstep;
    S.a_ready(cur);
    if constexpr (GATHER) { PG8_GIDX(vAc, 0); }
    if constexpr (SP2) {
        PG8_STAGE(PG8_SB(0, 0), cB, voffB); PG8_STAGE(PG8_SB(0, 1), cB + hstep, voffB); PG8_STAGE_A(PG8_SA(0, 0), cA, 0, vAc); PG8_STAGE_A(PG8_SA(0, 1), cA, 1, vAc);
        if (wr == 1) PG8_BAR;
        PG8_WAIT_V(2); PG8_BAR;
        PG8_STAGE(PG8_SB(1, 0), cB + kstep, voffB); PG8_STAGE_A(PG8_SA(1, 0), cA + kstep, 0, vAc); PG8_STAGE(PG8_SB(1, 1), cB + hstep + kstep, voffB);
        PG8_WAIT_V(6); PG8_BAR;
    } else {
        PG8_STAGE(PG8_SB(0, 0), cB, voffB); PG8_STAGE(PG8_SA(0, 0), cA, voffA); PG8_STAGE(PG8_SB(0, 1), cB + hstep, voffB); PG8_STAGE(PG8_SA(0, 1), cA + hstep, voffA);
        if (wr == 1) PG8_BAR;
        PG8_WAIT_V(4); PG8_BAR;
        PG8_STAGE(PG8_SB(1, 0), cB + kstep, voffB); PG8_STAGE(PG8_SA(1, 0), cA + kstep, voffA); PG8_STAGE(PG8_SB(1, 1), cB + hstep + kstep, voffB);
        PG8_WAIT_V(6); PG8_BAR;
    }
    for (;;) {
        const bool has_next = S.next(ui + 1, nxt);
        if constexpr (GATHER) { if (has_next) { PG8_GIDX(vAn, ui + 1); } else { _Pragma("unroll") for (int _h = 0; _h < 2; ++_h) _Pragma("unroll") for (int _i = 0; _i < 2; ++_i) vAn[_h][_i] = vAc[_h][_i]; } }
        const char* nA = GATHER ? cA : (has_next ? (const char*)g.A + (size_t)nxt.pm * tstep : cA); const char* nB = has_next ? (const char*)g.Bt + (size_t)nxt.pn * tstep : cB;
        for (int t = 0; t < nt; t += 2) {
            if constexpr (Epi::KMID) { if (t == 8 || t == 16) E.kmid(t, acc, cur, wr, wc, fr, fq); }
            const bool last = (t == nt - 2);
            const char* a1 = cA + (size_t)(t + 1) * kstep;
            const char* a2 = last ? nA : cA + (size_t)(t + 2) * kstep; const char* b2 = last ? nB : cB + (size_t)(t + 2) * kstep;
            const char* a3 = a2 + kstep; const char* b3 = b2 + kstep;
            if (last && has_next) S.a_ready(nxt);
            unsigned v2[2][2];
            if constexpr (GATHER) { _Pragma("unroll") for (int _h = 0; _h < 2; ++_h) _Pragma("unroll") for (int _i = 0; _i < 2; ++_i) v2[_h][_i] = last ? vAn[_h][_i] : vAc[_h][_i]; }
            if constexpr (SP2) {
            PG8_LDB(B0, 0, 0); PG8_LDB(B1, 0, 1); PG8_SCHED; PG8_LDA(At, 0, 0); PG8_STAGE_A(PG8_SA(1, 1), a1, 1, vAc);
            PG8_WAIT_V(8); PG8_WAIT_L(0); PG8_BAR; PG8_MMA(0, 0, At, B0); PG8_MMA(0, 1, At, B1); PG8_BAR; PG8_SCHED;
            PG8_LDA(At, 0, 1); PG8_STAGE(PG8_SB(0, 0), b2, voffB); PG8_STAGE(PG8_SB(0, 1), b2 + hstep, voffB); PG8_STAGE_A(PG8_SA(0, 0), a2, 0, v2);
            PG8_WAIT_V(8); PG8_WAIT_L(0); PG8_BAR; PG8_MMA(1, 0, At, B0); PG8_MMA(1, 1, At, B1); PG8_BAR; PG8_SCHED;
            PG8_LDB(B0, 1, 0); PG8_LDB(B1, 1, 1); PG8_SCHED; PG8_LDA(At, 1, 0); PG8_STAGE_A(PG8_SA(0, 1), a2, 1, v2);
            PG8_WAIT_V(8); PG8_WAIT_L(0); PG8_BAR; PG8_MMA(0, 0, At, B0); PG8_MMA(0, 1, At, B1); PG8_BAR; PG8_SCHED;
            PG8_LDA(At, 1, 1); PG8_STAGE(PG8_SB(1, 0), b3, voffB); PG8_STAGE(PG8_SB(1, 1), b3 + hstep, voffB); PG8_STAGE_A(PG8_SA(1, 0), a3, 0, v2);
            PG8_WAIT_V(8); PG8_WAIT_L(0); PG8_BAR; PG8_MMA(1, 0, At, B0); PG8_MMA(1, 1, At, B1); PG8_BAR; PG8_SCHED;
            } else {
            PG8_LDB(B0, 0, 0); PG8_SCHED; PG8_LDA(At, 0, 0); PG8_STAGE(PG8_SA(1, 1), a1 + hstep, voffA);
            PG8_WAIT_L(8); PG8_BAR; PG8_WAIT_L(0); PG8_MMA(0, 0, At, B0); PG8_BAR; PG8_SCHED;
            PG8_LDB(B1, 0, 1); PG8_STAGE(PG8_SB(0, 0), b2, voffB);
            PG8_BAR; PG8_WAIT_L(0); PG8_MMA(0, 1, At, B1); PG8_BAR;
            PG8_LDA(At, 0, 1); PG8_STAGE(PG8_SA(0, 0), a2, voffA);
            PG8_BAR; PG8_WAIT_L(0); PG8_MMA(1, 0, At, B0); PG8_BAR; PG8_SCHED;
            PG8_STAGE(PG8_SB(0, 1), b2 + hstep, voffB);
            PG8_WAIT_V(6); PG8_BAR; PG8_MMA(1, 1, At, B1); PG8_BAR;
            PG8_LDB(B0, 1, 0); PG8_SCHED; PG8_LDA(At, 1, 0); PG8_STAGE(PG8_SA(0, 1), a2 + hstep, voffA);
            PG8_WAIT_L(8); PG8_BAR; PG8_WAIT_L(0); PG8_MMA(0, 0, At, B0); PG8_BAR; PG8_SCHED;
            PG8_LDB(B1, 1, 1); PG8_STAGE(PG8_SB(1, 0), b3, voffB);
            PG8_BAR; PG8_WAIT_L(0); PG8_MMA(0, 1, At, B1); PG8_BAR;
            PG8_LDA(At, 1, 1); PG8_STAGE(PG8_SA(1, 0), a3, voffA);
            PG8_BAR; PG8_WAIT_L(0); PG8_MMA(1, 0, At, B0); PG8_BAR; PG8_SCHED;
            PG8_STAGE(PG8_SB(1, 1), b3 + hstep, voffB);
            PG8_WAIT_V(6); PG8_BAR; PG8_MMA(1, 1, At, B1); PG8_BAR;
            }
        }
        if constexpr (ALIGN_EPI) { if (wr == 0) PG8_BAR; }
        if constexpr (!Epi::AFTER_DRAIN) { E(acc, cur, wr, wc, fr, fq);
#ifdef MK_EPI2
            asm volatile("" ::: "memory"); E(acc, cur, wr, wc, fr, fq);
#endif
#ifdef MK_EPI3
            { char* sp = (char*)MK_EPI3_BASE + (size_t)blockIdx.x * 131072 + (size_t)wid * 16384 + (size_t)lane * 16;
              _Pragma("unroll") for (int q_ = 0; q_ < 16; ++q_) { u32x4 w_; w_.x = __float_as_uint(acc[q_ >> 3][(q_ >> 2) & 1][q_ & 3][0][0]); w_.y = __float_as_uint(acc[q_ >> 3][(q_ >> 2) & 1][q_ & 3][0][1]); w_.z = __float_as_uint(acc[q_ >> 3][(q_ >> 2) & 1][q_ & 3][1][0]); w_.w = __float_as_uint(acc[q_ >> 3][(q_ >> 2) & 1][q_ & 3][1][1]);
                  *(u32x4*)(sp + q_ * 1024) = w_; } }
#endif
            S.done(cur); }
        if (!has_next) break;
#pragma unroll
        for (int a = 0; a < 2; ++a)
#pragma unroll
            for (int b = 0; b < 2; ++b)
#pragma unroll
                for (int m = 0; m < 4; ++m)
#pragma unroll
                    for (int n = 0; n < 2; ++n) acc[a][b][m][n] = (f32x4){0.f, 0.f, 0.f, 0.f};
        cur = nxt; cA = nA; cB = nB; ++ui;
        if constexpr (GATHER) { _Pragma("unroll") for (int _h = 0; _h < 2; ++_h) _Pragma("unroll") for (int _i = 0; _i < 2; ++_i) vAc[_h][_i] = vAn[_h][_i]; }
        if constexpr (ALIGN_EPI) { if (wr == 1) PG8_BAR; }
    }
    PG8_WAIT_V(0);
    if constexpr (!ALIGN_EPI) { if (wr == 0) PG8_BAR; }
    PG8_BAR;
    if constexpr (Epi::AFTER_DRAIN) { E.fused(acc, cur, wr, wc, fr, fq, lds, wid, lane); S.done(cur); }
#undef PG8_SA
#undef PG8_SB
#undef PG8_STAGE
#undef PG8_STAGE_A
#undef PG8_GIDX
#undef PG8_LDA
#undef PG8_LDB
#undef PG8_MMA
#undef PG8_WAIT_V
#undef PG8_WAIT_L
#undef PG8_BAR
#undef PG8_SCHED
}
}
#define XB_TMO      128
#define XB_XCNT(j)  (256  + 64 * (j))
#define XB_XSUB(j)  (1280 + 64 * (j))
#define XB_XGEN(j)  (2304 + 64 * (j))
#define XB_TOP      3328
#define XB_TOPGEN   3392
#define XCD_BAR_WORDS 3456
#define XB_SPIN_CAP (1u << 18)
#define LAS __attribute__((address_space(3)))

__device__ __forceinline__ unsigned xb_ld(unsigned* p)              { return __hip_atomic_load(p, __ATOMIC_RELAXED, __HIP_MEMORY_SCOPE_AGENT); }
__device__ __forceinline__ unsigned xb_add(unsigned* p, unsigned v) { return __hip_atomic_fetch_add(p, v, __ATOMIC_RELAXED, __HIP_MEMORY_SCOPE_AGENT); }
__device__ __forceinline__ unsigned xb_xcc_id() { return (unsigned)__builtin_amdgcn_s_getreg((3 << 11) | 20) & 0xFu; }
#define XB_SPIN(cond, bar) do { unsigned _sp = 0; while (cond) { __builtin_amdgcn_s_sleep(1); \
    if ((++_sp & 255u) == 0u) { if (xb_ld(&(bar)[XB_TMO])) break; if (_sp > XB_SPIN_CAP) { atomicAdd(&(bar)[XB_TMO], 1u); break; } } } } while (0)

struct XcdBarrier {
    unsigned* bar; unsigned x;
    volatile LAS unsigned* st;
};

__device__ __forceinline__ XcdBarrier xcd_barrier_post(unsigned* bar, volatile LAS unsigned* st) {
    XcdBarrier b; b.bar = bar; b.x = xb_xcc_id(); b.st = st;
    if (threadIdx.x == 0) (void)xb_add(&bar[XB_XCNT(b.x)], 1u);
    return b;
}
__device__ __forceinline__ void xcd_barrier_complete(unsigned* bar, unsigned x, unsigned& nloc, unsigned& nx) {
    const unsigned G = gridDim.x * gridDim.y * gridDim.z;
    unsigned sum, cnt, mine, sp = 0u;
    for (;;) {
        sum = 0u; cnt = 0u; mine = 0u;
#pragma unroll
        for (unsigned j = 0; j < 16; ++j) { const unsigned c = xb_ld(&bar[XB_XCNT(j)]); sum += c; cnt += (c > 0u) ? 1u : 0u; mine = (j == x) ? c : mine; }
        if (sum == G) break;
        __builtin_amdgcn_s_sleep(1);
        if ((++sp & 255u) == 0u) { if (xb_ld(&bar[XB_TMO])) break; if (sp > XB_SPIN_CAP) { atomicAdd(&bar[XB_TMO], 1u); break; } }
    }
    nloc = mine > 0u ? mine : 1u; nx = cnt > 0u ? cnt : 1u;
}

__device__ __forceinline__ void xcd_barrier(const XcdBarrier& b) {
    asm volatile("s_waitcnt vmcnt(0)" ::: "memory");
    __syncthreads();
    if (threadIdx.x == 0) {
        unsigned* bar = b.bar;
        __builtin_amdgcn_s_waitcnt(0);
        unsigned nloc = b.st[0], nx = b.st[1];
        if (nloc == 0u) { xcd_barrier_complete(bar, b.x, nloc, nx); b.st[0] = nloc; b.st[1] = nx; }
        const unsigned old = xb_add(&bar[XB_XSUB(b.x)], 1u);
        const unsigned gen = old / nloc;
        if (old + 1u == (gen + 1u) * nloc) {
            __builtin_amdgcn_fence(__ATOMIC_RELEASE, "agent");
            asm volatile("s_waitcnt vmcnt(0)" ::: "memory");
            const unsigned og = xb_add(&bar[XB_TOP], 1u);
            const unsigned tg = og / nx;
            if (og + 1u == (tg + 1u) * nx) xb_add(&bar[XB_TOPGEN], 1u);
            else XB_SPIN(xb_ld(&bar[XB_TOPGEN]) == tg, bar);
            __builtin_amdgcn_fence(__ATOMIC_ACQUIRE, "agent");
            xb_add(&bar[XB_XGEN(b.x)], 1u);
            asm volatile("s_waitcnt vmcnt(0)" ::: "memory");
        } else {
            XB_SPIN(xb_ld(&bar[XB_XGEN(b.x)]) == gen, bar);
            __builtin_amdgcn_fence(__ATOMIC_ACQUIRE, "agent");
            asm volatile("s_waitcnt vmcnt(0)" ::: "memory");
        }
    }
    __syncthreads();
}

#define GAS __attribute__((address_space(1)))
typedef unsigned short bf16;
typedef float f32x4 __attribute__((ext_vector_type(4)));
typedef unsigned u32x4 __attribute__((ext_vector_type(4)));
typedef unsigned u32x2 __attribute__((ext_vector_type(2)));
constexpr int DM = 1024, NB = 8, SEQ = 4096, CTXL = 256, NLAT = NB * SEQ, NCTX = NB * CTXL, NROWS = NLAT + NCTX;
constexpr int INC = 7424;
constexpr int C_RQ = 0, C_RK = 512, C_RV = 1024, C_RG = 1536, C_AQ = 2048, C_AK = 2560, C_AV = 2688, C_HU = 2816, C_MG = 4352;
constexpr int NEXP = 32, DFF = 1024;
constexpr int MPAD = 147456;
constexpr float EPS = 1e-6f;
constexpr int NWAVES = 8, NTHR = 512;
constexpr int LDS_BYTES = 163840, LDSX = 155648, LDS_SRC = 131072;
constexpr int NPH_LAYER = 14, NPH = 1 + 2 * NPH_LAYER + 1;

constexpr size_t MiB = 1u << 20;
constexpr size_t WS_CTL = 0, CTL_ZERO_BYTES = 32768;
constexpr size_t CTL_BAR = 16384;
constexpr size_t CTL_MOD = 262144;
constexpr size_t WS_SRC = 6 * MiB;
constexpr size_t WS_L1P = 5 * MiB;
constexpr size_t WS_TOPI = 1 * MiB, WS_TOPW = 2 * MiB, WS_POS = 3 * MiB, WS_BLKCNT = 4 * MiB, WS_TILES = 4 * MiB + 65536;
constexpr size_t WS_WIN = 8 * MiB, WS_WBR = 37 * MiB, WS_WOUT = 43 * MiB, WS_W1 = 48 * MiB, WS_W2 = 304 * MiB;
constexpr size_t WS_HF = 432 * MiB;
constexpr size_t WS_HFC = 464 * MiB;
constexpr size_t WS_XM = 466 * MiB, WS_XO = 602 * MiB, WS_XN = 738 * MiB;
constexpr size_t WS_A = 806 * MiB;
constexpr size_t WS_P = WS_A, WS_RET = WS_A + 494 * MiB, WS_ATT = WS_RET + 34 * MiB, WS_HY = WS_ATT + 34 * MiB;
constexpr size_t WS_HS = WS_A, WS_ACT = WS_A + 288 * MiB;
constexpr size_t WS_MF32 = 1406 * MiB, WS_M = 1542 * MiB;
constexpr size_t WS_ZT = 1610 * MiB, WS_ZTC = 1674 * MiB, WS_YT = 1678 * MiB, WS_YTC = 1742 * MiB;
constexpr size_t WS_KV = 1746 * MiB, WS_SP = 1882 * MiB, WS_HSPEC = 1950 * MiB, WS_END = 2014 * MiB;
static_assert(WS_HY + 34 * MiB <= WS_MF32 && WS_ACT + 288 * MiB <= WS_MF32, "region A");
static_assert((size_t)NROWS * INC * 2 <= 494 * MiB, "P size");

__device__ __forceinline__ float bf2f(bf16 v) { return __uint_as_float(((unsigned)v) << 16); }
__device__ __forceinline__ unsigned pk2s(float lo, float hi) { unsigned a = __float_as_uint(lo), b = __float_as_uint(hi); a += 0x7FFFu + ((a >> 16) & 1u); b += 0x7FFFu + ((b >> 16) & 1u); return (a >> 16) | (b & 0xffff0000u); }
__device__ __forceinline__ bf16 f2bf(float f) { unsigned u = __float_as_uint(f); u += 0x7FFFu + ((u >> 16) & 1u); return (bf16)(u >> 16); }
__device__ __forceinline__ unsigned pk2(float lo, float hi) { return pg8::cvt_pk_bf16(lo, hi); }
__device__ __forceinline__ void store_row_bf16(bf16* o, int lane, const u32x2 (&p)[4]) {
    const bool odd = (lane & 1) != 0;
#pragma unroll
    for (int jp = 0; jp < 2; ++jp) { const int j0 = 2 * jp, j1 = j0 + 1;
        const unsigned sx = odd ? p[j0].x : p[j1].x, sy = odd ? p[j0].y : p[j1].y;
        const unsigned rx = (unsigned)__builtin_amdgcn_update_dpp(0, (int)sx, 0xB1, 0xF, 0xF, false), ry = (unsigned)__builtin_amdgcn_update_dpp(0, (int)sy, 0xB1, 0xF, 0xF, false);
        u32x4 w; w.x = odd ? rx : p[j0].x; w.y = odd ? ry : p[j0].y; w.z = odd ? p[j1].x : rx; w.w = odd ? p[j1].y : ry;
        *(u32x4*)(o + 256 * (odd ? j1 : j0) + 4 * (lane & ~1)) = w; }
}
#define WS_DPP(v, ctrl) __int_as_float(__builtin_amdgcn_update_dpp(0, __float_as_int(v), (ctrl), 0xF, 0xF, false))
__device__ __forceinline__ float wave_sum(float v) {
    v += WS_DPP(v, 0xB1);
    v += WS_DPP(v, 0x4E);
    v += WS_DPP(v, 0x124);
    v += WS_DPP(v, 0x128);
    const float s0 = __int_as_float(__builtin_amdgcn_readlane(__float_as_int(v), 0)), s1 = __int_as_float(__builtin_amdgcn_readlane(__float_as_int(v), 16));
    const float s2 = __int_as_float(__builtin_amdgcn_readlane(__float_as_int(v), 32)), s3 = __int_as_float(__builtin_amdgcn_readlane(__float_as_int(v), 48));
    return (s0 + s1) + (s2 + s3);
}
__device__ __forceinline__ float rdlane(float v, int l) { return __int_as_float(__builtin_amdgcn_readlane(__float_as_int(v), l)); }
__device__ __forceinline__ float sin_rev(float rev) { return __builtin_amdgcn_sinf(__builtin_amdgcn_fractf(rev)); }
__device__ __forceinline__ float cos_rev(float rev) { return __builtin_amdgcn_cosf(__builtin_amdgcn_fractf(rev)); }
__device__ __forceinline__ float sin_rad(float x) { return sin_rev(x * 0.15915494309189535f); }
__device__ __forceinline__ float sigmoidf_(float x) { return 1.0f / (1.0f + __expf(-x)); }
__device__ __forceinline__ float siluf_(float x) { return x / (1.0f + __expf(-x)); }
__device__ __forceinline__ float log_sigmoid_(float x) {
    const float y = __expf(-x);
    if (y < 0.1f) { return -(y * (1.0f + y * (-0.5f + y * (0.33333333f + y * (-0.25f + y * (0.2f + y * (-0.16666667f + y * (0.14285714f + y * (-0.125f))))))))); }
    return -logf(1.0f + y);
}
#define LDS_WAIT() asm volatile("s_waitcnt lgkmcnt(0)" ::: "memory")
#define VM_WAIT() asm volatile("s_waitcnt vmcnt(0)" ::: "memory")

struct Args { const float* in[31]; float* out; unsigned char* ws; int ph_lo, ph_hi; };

extern __shared__ __attribute__((aligned(16))) unsigned char lds_raw[];
constexpr int LDS_PTAB = LDSX + 1024;
struct Frame {
    LAS unsigned char* lds;
    int tid, lane, wave, G, bx;
    unsigned char* ws;
};
__device__ __forceinline__ unsigned long long ptab_read(int i) {
    const LAS unsigned* p = (const LAS unsigned*)((LAS unsigned char*)lds_raw + LDS_PTAB) + 2 * i;
    const unsigned lo = (unsigned)__builtin_amdgcn_readfirstlane((int)p[0]), hi = (unsigned)__builtin_amdgcn_readfirstlane((int)p[1]);
    return ((unsigned long long)hi << 32) | lo;
}
__device__ __forceinline__ const float* IN_(const Frame& F, int i) { return (const float*)(const GAS float*)ptab_read(i); }
__device__ __forceinline__ float* OUT_(const Frame& F) { return (float*)(GAS float*)ptab_read(31); }
__device__ __forceinline__ Frame make_frame() {
    Frame F; F.lds = (LAS unsigned char*)lds_raw;
    int t = threadIdx.x; asm volatile("" : "+v"(t)); F.tid = t; F.lane = t & 63; F.wave = __builtin_amdgcn_readfirstlane(t >> 6);
    int g = gridDim.x, bx = blockIdx.x; asm volatile("" : "+s"(g), "+s"(bx)); F.G = g; F.bx = bx;
    unsigned long long w = ptab_read(32); asm volatile("" : "+s"(w)); F.ws = (unsigned char*)(GAS unsigned char*)w; return F;
}
template <class T> __device__ __forceinline__ T* WSP(const Frame& F, size_t off) { return (T*)(F.ws + off); }
__device__ __forceinline__ const float* mod_ptr(const Frame& F, int l, int modrow, int chunk) { return WSP<float>(F, WS_CTL + CTL_MOD) + ((size_t)(l * 9 + modrow) * 6 + chunk) * DM; }
__device__ __forceinline__ int modrow_of(int r) { return r < NLAT ? (r >> 12) : 8; }

constexpr int TRP = 65;
__device__ __forceinline__ void tr_item(const float* W, int K, int N, bf16* WT, int ldk, int item, int w1map, LAS float* scr, int lane) {
    const int nblk = N >> 6, kb = item / nblk, nb = item - kb * nblk, k0 = 64 * kb, n0 = 64 * nb;
    const int r = lane >> 4, cq = lane & 15;
    const float* src = W + (size_t)(k0 + r) * N + n0 + 4 * cq;
#pragma unroll 1
    for (int hh = 0; hh < 2; ++hh) {
        f32x4 v[8];
#pragma unroll
        for (int i = 0; i < 8; ++i) v[i] = *(const f32x4*)(src + (size_t)(4 * (8 * hh + i)) * N);
#pragma unroll
        for (int i = 0; i < 8; ++i) { LAS float* d = scr + (4 * (8 * hh + i) + r) * TRP + 4 * cq; d[0] = v[i][0]; d[1] = v[i][1]; d[2] = v[i][2]; d[3] = v[i][3]; }
    }
    LDS_WAIT(); asm volatile("" ::: "memory");
    int r0 = n0;
    if (w1map == 1) r0 = (n0 < 1024) ? ((n0 >> 7) * 256 + (n0 & 127)) : ((((n0 - 1024) >> 7) * 256) + 128 + ((n0 - 1024) & 127));
    const int kc = lane & 7;
#pragma unroll
    for (int j = 0; j < 8; ++j) { const int n = (lane >> 3) + 8 * j; const LAS float* s = scr + (8 * kc) * TRP + n;
        u32x4 o; o.x = pk2(s[0 * TRP], s[1 * TRP]); o.y = pk2(s[2 * TRP], s[3 * TRP]); o.z = pk2(s[4 * TRP], s[5 * TRP]); o.w = pk2(s[6 * TRP], s[7 * TRP]);
        int row = r0 + n;
        if (w1map == 2) {
            const int c = n0 + n;
            if (c < 1024) row = (c & ~255) + ((c >> 6) & 1) * 128 + ((c >> 7) & 1) * 64 + (c & 63);
            else if (c >= C_AQ && c < C_AV) { const int d = c & 63, gq = d >> 4, hd = (c >> 6) & 3; row = (c & ~255) + (gq & 1) * 128 + hd * 32 + (gq >> 1) * 16 + (d & 15); }
            else if (c >= C_AV && c < C_HU) { const int jv = c - C_AV; row = C_AK + (jv >> 6) * 128 + 64 + (jv & 63); }
        }
        *(u32x4*)(WT + (size_t)row * ldk + k0 + 8 * kc) = o; }
    LDS_WAIT(); asm volatile("" ::: "memory");
}

__device__ __forceinline__ void hy_filter_item(Frame& F, int f, int tb) {
    const int lane = F.lane;
    float* L1P = WSP<float>(F, WS_L1P);
    LAS float* H2 = (LAS float*)F.lds + 16384;
    LAS float* red = H2 + 32 * 64;
    const int L = (f == 2) ? 256 : 4096, l = (f == 1) ? 1 : 0;
    const float* w1 = IN_(F, 12) + l * 33 * 64; const float* b1 = IN_(F, 13) + l * 64; const float* f1 = IN_(F, 14) + l * 64;
    const float* w2 = IN_(F, 15) + l * 64 * 64; const float* b2 = IN_(F, 16) + l * 64; const float* f2 = IN_(F, 17) + l * 64;
    const float* w3 = IN_(F, 18) + (size_t)l * 64 * 1024;
    float* HFp = (f == 2) ? WSP<float>(F, WS_HFC) : WSP<float>(F, WS_HF + (size_t)l * 16 * MiB);
    float* HBp = (f == 2) ? WSP<float>(F, WS_HFC + 512 * 1024) : WSP<float>(F, WS_HF + (size_t)l * 16 * MiB + 8 * MiB);
    __syncthreads();
    {
        float w1c[33], w2c[64];
#pragma unroll
        for (int i = 0; i < 33; ++i) w1c[i] = w1[i * 64 + lane];
#pragma unroll
        for (int i = 0; i < 64; ++i) w2c[i] = w2[i * 64 + lane];
        const float b1l = b1[lane], f1l = f1[lane], b2l = b2[lane], f2l = f2[lane];
#pragma unroll 1
        for (int r = 0; r < 4; ++r) {
            const int n = tb * 32 + F.wave * 4 + r;
            float zl = 0.f;
            if (lane == 0) zl = (float)n / (float)(L - 1);
            else if (lane <= 32) { const int j = (lane - 1) & 15; const float band = 1e-4f + (15.0f - 1e-4f) * (float)j / 15.0f; const float rev = (float)n * band / (float)L;
                zl = (lane <= 16) ? cos_rev(rev) : -sin_rev(rev); }
            float a = 0.f;
#pragma unroll
            for (int i = 0; i < 33; ++i) a += rdlane(zl, i) * w1c[i];
            const float h1 = sin_rad(f1l * (a + b1l));
            float a2 = 0.f;
#pragma unroll
            for (int i = 0; i < 64; ++i) a2 += rdlane(h1, i) * w2c[i];
            H2[(F.wave * 4 + r) * 64 + lane] = sin_rad(f2l * (a2 + b2l));
        }
    }
    __syncthreads();
    const int c1 = F.wave * 128 + lane, c2 = c1 + 64;
    float l1p[2] = {0.f, 0.f};
#pragma unroll 1
    for (int rh = 0; rh < 2; ++rh) {
        float acc[16][2];
#pragma unroll
        for (int r = 0; r < 16; ++r) { acc[r][0] = 0.f; acc[r][1] = 0.f; }
#pragma unroll 1
        for (int i = 0; i < 64; i += 4) {
            float wa[4], wb[4];
#pragma unroll
            for (int k = 0; k < 4; ++k) { wa[k] = w3[(i + k) * 1024 + c1]; wb[k] = w3[(i + k) * 1024 + c2]; }
            f32x4 hh[16];
#pragma unroll
            for (int r = 0; r < 16; ++r) hh[r] = *(const LAS f32x4*)(H2 + (rh * 16 + r) * 64 + i);
            __builtin_amdgcn_sched_barrier(0);
#pragma unroll
            for (int r = 0; r < 16; ++r) { const f32x4 h = hh[r];
                acc[r][0] += h[0] * wa[0] + h[1] * wa[1] + h[2] * wa[2] + h[3] * wa[3]; acc[r][1] += h[0] * wb[0] + h[1] * wb[1] + h[2] * wb[2] + h[3] * wb[3]; }
        }
#pragma unroll
        for (int q = 0; q < 2; ++q) {
            const int c = q ? c2 : c1, cc = c & 511;
            const float delta = 3.0701134573253944f + (15.350567286626973f - 3.0701134573253944f) * (float)cc / 511.0f;
            float* dst = ((c < 512) ? HFp : HBp) + ((f == 2) ? (size_t)(tb * 32 + rh * 16) * 512 + cc : (size_t)cc * 4096 + tb * 32 + rh * 16);
            const int dstep = (f == 2) ? 512 : 1;
#pragma unroll
            for (int r = 0; r < 16; ++r) { const int n = tb * 32 + rh * 16 + r; const float tn = (float)n / (float)(L - 1); const float v = acc[r][q] * __expf(-tn * delta);
                dst[r * dstep] = v;
                if (c < 512 || n >= 1) l1p[q] += fabsf(v); }
        }
    }
    red[c1] = l1p[0]; red[c2] = l1p[1];
    __syncthreads();
    L1P[(size_t)(f * 128 + tb) * 512 + F.tid] = red[F.tid] + red[512 + F.tid];
}
__device__ __forceinline__ void p0_prologue(Frame& F) {
    LAS float* scr = (LAS float*)(F.lds + F.wave * (64 * TRP * 4));
    const int gw = F.bx * NWAVES + F.wave, NGW = F.G * NWAVES, lane = F.lane;
    constexpr int I_WIN = 16 * 116, I_WBR = 8 * 16, I_WOUT = 16 * 16, I_W1 = 16 * 32, I_W2 = 16 * 16;
    constexpr int N_WIN = 2 * I_WIN, N_WBR = 6 * I_WBR, N_WOUT = 2 * I_WOUT, N_W1 = 32 * I_W1, N_W2 = 32 * I_W2;
    constexpr int NTR = N_WIN + N_WBR + N_WOUT + N_W1 + N_W2;
#pragma unroll 1
    for (int it = gw; it < NTR; it += NGW) {
        int r = it; const float* W; bf16* WT; int K, N, item, w1map = 0, ldk = 1024;
        if (r < N_WIN) { const int l = r / I_WIN; W = IN_(F, 7) + (size_t)l * 1024 * INC; K = 1024; N = INC; WT = WSP<bf16>(F, WS_WIN) + (size_t)l * INC * 1024; item = r % I_WIN; w1map = 2; }
        else if ((r -= N_WIN) < N_WBR) { const int q = r / I_WBR; W = IN_(F, 20) + (size_t)q * 512 * 1024; K = 512; N = 1024; WT = WSP<bf16>(F, WS_WBR) + (size_t)(q / 3) * 1024 * 1536 + (q % 3) * 512; ldk = 1536; item = r % I_WBR; }
        else if ((r -= N_WBR) < N_WOUT) { const int l = r / I_WOUT; W = IN_(F, 22) + (size_t)l * 1024 * 1024; K = 1024; N = 1024; WT = WSP<bf16>(F, WS_WOUT) + (size_t)l * 1024 * 1024; item = r % I_WOUT; }
        else if ((r -= N_WOUT) < N_W1) { const int q = r / I_W1; W = IN_(F, 26) + (size_t)q * 1024 * 2048; K = 1024; N = 2048; WT = WSP<bf16>(F, WS_W1) + (size_t)q * 2048 * 1024; item = r % I_W1; w1map = 1; }
        else { r -= N_W1; const int q = r / I_W2; W = IN_(F, 28) + (size_t)q * 1024 * 1024; K = 1024; N = 1024; WT = WSP<bf16>(F, WS_W2) + (size_t)q * 1024 * 1024; item = r % I_W2; }
        tr_item(W, K, N, WT, ldk, item, w1map, scr, lane);
    }
#ifndef PRO_B
#define PRO_B 1
#endif
#ifndef PRO_C
#define PRO_C 1
#endif
    __syncthreads();
    if (PRO_B) {
        float* mod = WSP<float>(F, WS_CTL + CTL_MOD);
        LAS float* sc = (LAS float*)F.lds;
        LAS float* red = sc + 1024 * 12;
        if (F.bx < 192) {
            for (int i = F.tid; i < 9 * 1024; i += NTHR) { const int r = i >> 10, k = i & 1023; const float cv = (r < 8) ? IN_(F, 1)[r * 1024 + k] : IN_(F, 3)[k]; sc[k * 12 + r] = siluf_(cv); }
            __syncthreads();
            const int it = F.bx, l = it / 96, cc = it % 96, col = cc * 64 + lane, k0 = F.wave * 128;
            const float* wm = IN_(F, 4) + (size_t)l * 1024 * 6144 + col;
            float acc[9];
#pragma unroll
            for (int r = 0; r < 9; ++r) acc[r] = 0.f;
#pragma unroll 1
            for (int kb = 0; kb < 128; kb += 16) {
                float w[16];
#pragma unroll
                for (int k = 0; k < 16; ++k) w[k] = wm[(size_t)(k0 + kb + k) * 6144];
#pragma unroll
                for (int k = 0; k < 16; ++k) { const LAS float* s = sc + (k0 + kb + k) * 12; const f32x4 s0 = *(const LAS f32x4*)s, s1 = *(const LAS f32x4*)(s + 4); const float s8 = s[8];
                    acc[0] += s0[0] * w[k]; acc[1] += s0[1] * w[k]; acc[2] += s0[2] * w[k]; acc[3] += s0[3] * w[k];
                    acc[4] += s1[0] * w[k]; acc[5] += s1[1] * w[k]; acc[6] += s1[2] * w[k]; acc[7] += s1[3] * w[k]; acc[8] += s8 * w[k]; }
            }
#pragma unroll
            for (int r = 0; r < 9; ++r) red[(F.wave * 9 + r) * 64 + lane] = acc[r];
            __syncthreads();
            for (int idx = F.tid; idx < 576; idx += NTHR) { const int r = idx >> 6, c = idx & 63; float s = 0.f;
#pragma unroll
                for (int w = 0; w < 8; ++w) s += red[(w * 9 + r) * 64 + c];
                mod[(size_t)(l * 9 + r) * 6144 + cc * 64 + c] = s + IN_(F, 5)[l * 6144 + cc * 64 + c]; }
        }
    }
}
__device__ __forceinline__ void p0_filters(Frame& F) {
    if (PRO_C) {
#pragma unroll 1
        for (int it = F.bx; it < 256; it += F.G) hy_filter_item(F, it >> 7, it & 127);
    }
}
constexpr int TRD_TOTAL = 32 * 512 + 32 * 256;
__device__ __forceinline__ void tr_deferred(Frame& F, int first, int count, int rank, int nblk) {
    LAS float* scr = (LAS float*)(F.lds + F.wave * (64 * TRP * 4));
    __syncthreads();
#pragma unroll 1
    for (int d = first + rank * NWAVES + F.wave; d < first + count; d += nblk * NWAVES) {
        if (d < 32 * 512) { const int q = 32 + (d >> 9); tr_item(IN_(F, 26) + (size_t)q * 1024 * 2048, 1024, 2048, WSP<bf16>(F, WS_W1) + (size_t)q * 2048 * 1024, 1024, d & 511, 1, scr, F.lane); }
        else { const int dd = d - 32 * 512, q = 32 + (dd >> 8); tr_item(IN_(F, 28) + (size_t)q * 1024 * 1024, 1024, 1024, WSP<bf16>(F, WS_W2) + (size_t)q * 1024 * 1024, 1024, dd & 255, 0, scr, F.lane); }
    }
}
__device__ __forceinline__ float hy_inv_l1(const Frame& F, int f, int c) {
    const float* L1P = WSP<float>(F, WS_L1P) + (size_t)f * 128 * 512 + c; const int nb = (f == 2) ? 8 : 128; const int lane = F.lane;
    float s = (lane < nb ? L1P[(size_t)lane * 512] : 0.f) + (lane + 64 < nb ? L1P[(size_t)(lane + 64) * 512] : 0.f);
    return 1.0f / wave_sum(s);
}

__device__ __forceinline__ void ph_norm1(Frame& F, int mode) {
    const int gw = F.bx * NWAVES + F.wave, NGW = F.G * NWAVES, lane = F.lane;
    const int nrows = (mode == 2) ? NLAT : NROWS;
    const int l = (mode == 0) ? 0 : 1;
    const bf16* Y = WSP<bf16>(F, WS_HS);
    const int* POS = WSP<int>(F, WS_POS); const float* TOPW = WSP<float>(F, WS_TOPW);
    f32x4 xnext[4]; int pnext[4]; float wnext[4];
#define N1_FETCH(r_) do { const int rf_ = (r_); \
        const float* xr_ = (mode == 0) ? ((rf_ < NLAT) ? IN_(F, 0) + (size_t)rf_ * DM : IN_(F, 2) + (size_t)(rf_ - NLAT) * DM) : (WSP<float>(F, WS_XM) + (size_t)rf_ * DM); \
        _Pragma("unroll") for (int j = 0; j < 4; ++j) xnext[j] = *(const f32x4*)(xr_ + 4 * lane + 256 * j); \
        if (mode != 0) { _Pragma("unroll") for (int k = 0; k < 4; ++k) { pnext[k] = POS[rf_ * 4 + k]; wnext[k] = TOPW[rf_ * 4 + k]; } } } while (0)
    f32x4 xc[4]; float wcq[4]; u32x2 yc[4][4];
#define N1_GATHER() do { _Pragma("unroll") for (int k = 0; k < 4; ++k) { const bf16* yr_ = Y + (size_t)pnext[k] * DM; wcq[k] = wnext[k]; \
            _Pragma("unroll") for (int j = 0; j < 4; ++j) yc[k][j] = *(const u32x2*)(yr_ + 4 * lane + 256 * j); } \
        _Pragma("unroll") for (int j = 0; j < 4; ++j) xc[j] = xnext[j]; } while (0)
    if (gw < nrows) { N1_FETCH(gw); if (mode != 0) { N1_GATHER(); if (gw + NGW < nrows) N1_FETCH(gw + NGW); } }
#pragma unroll 1
    for (int r = gw; r < nrows; r += NGW) {
        const int mr = modrow_of(r);
        f32x4 mg[4], ma[4], mb[4], g2v[4];
        if (mode != 0) { const float* g2l = mod_ptr(F, (mode == 2) ? 1 : 0, mr, 5);
#pragma unroll
            for (int j = 0; j < 4; ++j) g2v[j] = *(const f32x4*)(g2l + 4 * lane + 256 * j); }
        __builtin_amdgcn_sched_barrier(0);
        f32x4 v[4];
        if (mode == 0) {
#pragma unroll
            for (int j = 0; j < 4; ++j) v[j] = xnext[j];
            if (r + NGW < nrows) N1_FETCH(r + NGW);
        } else {
            f32x4 xcur[4]; float wc[4]; u32x2 yv[4][4];
#pragma unroll
            for (int j = 0; j < 4; ++j) xcur[j] = xc[j];
#pragma unroll
            for (int k = 0; k < 4; ++k) { wc[k] = wcq[k];
#pragma unroll
                for (int j = 0; j < 4; ++j) yv[k][j] = yc[k][j]; }
            if (r + NGW < nrows) { N1_GATHER(); if (r + 2 * NGW < nrows) N1_FETCH(r + 2 * NGW); }
            f32x4 s[4];
#pragma unroll
            for (int j = 0; j < 4; ++j) s[j] = (f32x4){0.f, 0.f, 0.f, 0.f};
#pragma unroll
            for (int k = 0; k < 4; ++k) { const float w = wc[k];
#pragma unroll
                for (int j = 0; j < 4; ++j) { const u32x2 y2 = yv[k][j];
                    s[j][0] += w * __uint_as_float(y2.x << 16); s[j][1] += w * __uint_as_float(y2.x & 0xffff0000u);
                    s[j][2] += w * __uint_as_float(y2.y << 16); s[j][3] += w * __uint_as_float(y2.y & 0xffff0000u); } }
#pragma unroll
            for (int j = 0; j < 4; ++j) v[j] = xcur[j] + g2v[j] * s[j];
            if (mode == 1) { float* xo = WSP<float>(F, WS_XO) + (size_t)r * DM;
#pragma unroll
                for (int j = 0; j < 4; ++j) *(f32x4*)(xo + 4 * lane + 256 * j) = v[j]; }
        }
        { const float* gp_ = (mode == 2) ? IN_(F, 30) : IN_(F, 6) + l * DM;
#pragma unroll
          for (int j = 0; j < 4; ++j) mg[j] = *(const f32x4*)(gp_ + 4 * lane + 256 * j);
          if (mode != 2) { const float* sh = mod_ptr(F, l, mr, 0); const float* sc = mod_ptr(F, l, mr, 1);
#pragma unroll
              for (int j = 0; j < 4; ++j) { ma[j] = *(const f32x4*)(sh + 4 * lane + 256 * j); mb[j] = *(const f32x4*)(sc + 4 * lane + 256 * j); } } }
        __builtin_amdgcn_sched_barrier(0);
        float ss = 0.f;
#pragma unroll
        for (int j = 0; j < 4; ++j) ss += (v[j][0] * v[j][0] + v[j][1] * v[j][1]) + (v[j][2] * v[j][2] + v[j][3] * v[j][3]);
        const float rstd = 1.0f / sqrtf(wave_sum(ss) * (1.0f / DM) + EPS);
        if (mode == 2) {
            float* o = OUT_(F) + (size_t)r * DM;
#pragma unroll
            for (int j = 0; j < 4; ++j) *(f32x4*)(o + 4 * lane + 256 * j) = v[j] * rstd * mg[j];
        } else {
            bf16* o = WSP<bf16>(F, WS_XN) + (size_t)r * DM;
            u32x2 pw[4];
#pragma unroll
            for (int j = 0; j < 4; ++j) { const f32x4 y = v[j] * rstd * mg[j] * (mb[j] + 1.0f) + ma[j]; pw[j].x = pk2(y[0], y[1]); pw[j].y = pk2(y[2], y[3]); }
            store_row_bf16(o, lane, pw);
        }
    }
#undef N1_FETCH
#undef N1_GATHER
}

struct EpiP {
    static constexpr bool PERM = true, AFTER_DRAIN = false, KMID = false; static constexpr int NSTORE = 16;
    bf16* O; const float* bg;
    __device__ __forceinline__ static void st8(bf16* p, const float (&v)[8]) { u32x4 w; w.x = pk2(v[0], v[1]); w.y = pk2(v[2], v[3]); w.z = pk2(v[4], v[5]); w.w = pk2(v[6], v[7]); *(u32x4*)p = w; }
    __device__ __forceinline__ void operator()(const f32x4 (&acc)[2][2][4][2], const pg8::Unit& u, int wr, int wc, int fr, int fq) const {
        const int row0 = u.pm * 256 + wr * 64 + fr, pn = u.pn;
        const bool rot = u.pm < (NLAT / 256);
        const bool is_ret = pn < 4, is_aq = (pn == 8 || pn == 9), is_akv = (pn == 10);
        if (!(is_ret || is_aq || is_akv) || (is_akv && wc >= 2)) {
            const int colA = is_akv ? (C_AV + (wc - 2) * 32 + 8 * fq) : (pn * 256 + wc * 32 + 8 * fq), colB = is_akv ? (colA + 64) : (colA + 128);
            f32x4 ba0 = (f32x4){0.f, 0.f, 0.f, 0.f}, ba1 = ba0, bb0 = ba0, bb1 = ba0;
            if (pn >= 17) { ba0 = *(const f32x4*)(bg + colA - C_MG); ba1 = *(const f32x4*)(bg + colA - C_MG + 4); bb0 = *(const f32x4*)(bg + colB - C_MG); bb1 = *(const f32x4*)(bg + colB - C_MG + 4); }
#pragma unroll
            for (int ai = 0; ai < 2; ++ai)
#pragma unroll
                for (int m = 0; m < 4; ++m) { bf16* rowp = O + (size_t)(row0 + ai * 128 + m * 16) * INC;
                    float a[8], b[8];
#pragma unroll
                    for (int j = 0; j < 4; ++j) { a[j] = acc[ai][0][m][0][j] + ba0[j]; a[4 + j] = acc[ai][0][m][1][j] + ba1[j]; b[j] = acc[ai][1][m][0][j] + bb0[j]; b[4 + j] = acc[ai][1][m][1][j] + bb1[j]; }
                    if (pn >= 17) {
                        typedef float f32x2 __attribute__((ext_vector_type(2)));
#pragma unroll
                        for (int j = 0; j < 8; j += 2) { f32x2 za = {a[j], a[j + 1]}, zb = {b[j], b[j + 1]}; za = za * -1.4426950408889634f; zb = zb * -1.4426950408889634f;
                            za.x = __builtin_amdgcn_exp2f(za.x); za.y = __builtin_amdgcn_exp2f(za.y); zb.x = __builtin_amdgcn_exp2f(zb.x); zb.y = __builtin_amdgcn_exp2f(zb.y);
                            za = za + 1.0f; zb = zb + 1.0f;
                            a[j] = fminf(za.x, 1.0e30f); a[j + 1] = fminf(za.y, 1.0e30f); b[j] = fminf(zb.x, 1.0e30f); b[j + 1] = fminf(zb.y, 1.0e30f); } }
                    st8(rowp + colA, a); st8(rowp + colB, b); asm volatile("" ::: "memory"); }
            return;
        }
        int col1, col2, ibase; float fexp; bool use_col = false;
        if (is_ret) { const int hd = wc >> 1; ibase = (wc & 1) * 32 + 8 * fq; col1 = pn * 256 + hd * 128 + ibase; col2 = col1 + 64; fexp = 13.287712379549449f / 63.0f; }
        else { const int rc = fq >> 1; ibase = 8 * (fq & 1); const int hb = is_aq ? (pn * 256 + wc * 64) : (C_AK + wc * 64); col1 = hb + rc * 32 + ibase; col2 = col1 + 16; fexp = 13.287712379549449f / 16.0f; use_col = rc != 0; }
        float invf[8];
#pragma unroll
        for (int k = 0; k < 8; ++k) invf[k] = __builtin_amdgcn_exp2f(-(float)(ibase + k) * fexp) * 0.15915494309189535f;
#pragma unroll
        for (int ai = 0; ai < 2; ++ai)
#pragma unroll
            for (int m = 0; m < 4; ++m) { const int row = row0 + ai * 128 + m * 16; bf16* rowp = O + (size_t)row * INC;
                const int t = row & 4095;
                const float pos = is_ret ? (float)t : (use_col ? (float)(t & 63) : (float)(t >> 6));
                float o1[8], o2[8];
#pragma unroll
                for (int k = 0; k < 8; ++k) { const float x1 = acc[ai][0][m][k >> 2][k & 3], x2 = acc[ai][1][m][k >> 2][k & 3];
                    float cs = 1.0f, sn = 0.0f;
                    if (rot) { const float rev = pos * invf[k]; cs = cos_rev(rev); sn = sin_rev(rev); }
                    o1[k] = x1 * cs - x2 * sn; o2[k] = x1 * sn + x2 * cs; }
                st8(rowp + col1, o1); st8(rowp + col2, o2); asm volatile("" ::: "memory"); }
    }
};
struct EpiMerge {
    static constexpr bool PERM = true, AFTER_DRAIN = false, KMID = true; static constexpr int NSTORE = 16;
    const bf16* P; bf16* Mo;
    typedef float f32x2 __attribute__((ext_vector_type(2)));
    __device__ __forceinline__ static f32x2 g2(unsigned w) { f32x2 r; r.x = __uint_as_float(w << 16); r.y = __uint_as_float(w & 0xffff0000u); return r; }
    struct Batch { u32x4 gn[2][2], go[2][2]; };
    __device__ __forceinline__ void fetch(Batch& B, int row0, unsigned col0, unsigned g_old, int ai, int mh) const {
#pragma unroll
        for (int mm = 0; mm < 2; ++mm) { const unsigned rowb = (unsigned)(row0 + ai * 128 + (2 * mh + mm) * 16) * (unsigned)(INC * 2);
#pragma unroll
            for (int bj = 0; bj < 2; ++bj) { const unsigned c = col0 + bj * 128;
                B.gn[mm][bj] = *(const u32x4*)((const char*)P + rowb + (C_MG + (g_old + 1) * 1024 + c) * 2); B.go[mm][bj] = *(const u32x4*)((const char*)P + rowb + (C_MG + g_old * 1024 + c) * 2); } }
    }
    __device__ __forceinline__ static void apply(const Batch& B, f32x4 (&acc)[2][2][4][2], int ai, int mh) {
#pragma unroll
        for (int mm = 0; mm < 2; ++mm)
#pragma unroll
            for (int bj = 0; bj < 2; ++bj) { const unsigned gnw[4] = {B.gn[mm][bj].x, B.gn[mm][bj].y, B.gn[mm][bj].z, B.gn[mm][bj].w}, gow[4] = {B.go[mm][bj].x, B.go[mm][bj].y, B.go[mm][bj].z, B.go[mm][bj].w};
#pragma unroll
                for (int i = 0; i < 4; ++i) { const f32x2 dold = g2(gow[i]); f32x2 ro; ro.x = __builtin_amdgcn_rcpf(dold.x); ro.y = __builtin_amdgcn_rcpf(dold.y);
                    const f32x2 r = g2(gnw[i]) * ro;
                    f32x4& A = acc[ai][bj][2 * mh + mm][i >> 1];
                    if (i & 1) { A.z *= r.x; A.w *= r.y; } else { A.x *= r.x; A.y *= r.y; } } }
    }
    __device__ __forceinline__ void kmid(int t, f32x4 (&acc)[2][2][4][2], const pg8::Unit& u, int wr, int wc, int fr, int fq) const {
        int row0 = u.pm * 256 + wr * 64 + fr; asm volatile("" : "+v"(row0));
        const unsigned col0 = (unsigned)(u.pn * 256 + wc * 32 + 8 * fq), g_old = (t == 8) ? 0u : 1u;
        Batch B0, B1;
        fetch(B0, row0, col0, g_old, 0, 0);
        fetch(B1, row0, col0, g_old, 0, 1); asm volatile("" ::: "memory");
        apply(B0, acc, 0, 0);
        fetch(B0, row0, col0, g_old, 1, 0); asm volatile("" ::: "memory");
        apply(B1, acc, 0, 1);
        fetch(B1, row0, col0, g_old, 1, 1); asm volatile("" ::: "memory");
        apply(B0, acc, 1, 0);
        apply(B1, acc, 1, 1);
    }
    __device__ __forceinline__ void operator()(const f32x4 (&acc)[2][2][4][2], const pg8::Unit& u, int wr, int wc, int fr, int fq) const {
        int row0 = u.pm * 256 + wr * 64 + fr; asm volatile("" : "+v"(row0));
        const unsigned col0 = (unsigned)(u.pn * 256 + wc * 32 + 8 * fq);
        u32x4 gh[2][4][2];
#pragma unroll
        for (int ai = 0; ai < 2; ++ai)
#pragma unroll
            for (int m = 0; m < 4; ++m) { const unsigned rowb = (unsigned)(row0 + ai * 128 + m * 16) * (unsigned)(INC * 2);
#pragma unroll
                for (int bj = 0; bj < 2; ++bj) gh[ai][m][bj] = *(const u32x4*)((const char*)P + rowb + (C_MG + 2048 + col0 + bj * 128) * 2); }
#pragma unroll
        for (int ai = 0; ai < 2; ++ai) {
#pragma unroll
            for (int m = 0; m < 4; ++m) { const unsigned row = (unsigned)(row0 + ai * 128 + m * 16);
#pragma unroll
                for (int bj = 0; bj < 2; ++bj) { float v[8]; const unsigned ghw[4] = {gh[ai][m][bj].x, gh[ai][m][bj].y, gh[ai][m][bj].z, gh[ai][m][bj].w};
#pragma unroll
                    for (int i = 0; i < 4; ++i) { const f32x2 d = g2(ghw[i]); v[2 * i] = acc[ai][bj][m][i >> 1][2 * (i & 1)] * __builtin_amdgcn_rcpf(d.x); v[2 * i + 1] = acc[ai][bj][m][i >> 1][2 * (i & 1) + 1] * __builtin_amdgcn_rcpf(d.y); }
                    u32x4 w; w.x = pk2(v[0], v[1]); w.y = pk2(v[2], v[3]); w.z = pk2(v[4], v[5]); w.w = pk2(v[6], v[7]);
                    *(u32x4*)((char*)Mo + (row * (unsigned)(DM * 2) + (col0 + bj * 128) * 2)) = w; } }
            asm volatile("" ::: "memory"); }
    }
};
struct EpiOut {
    static constexpr bool PERM = false, AFTER_DRAIN = false, KMID = false; static constexpr int NSTORE = 32;
    const float* xlat; const float* xctx; const float* g1base; float* XM;
    __device__ __forceinline__ void operator()(const f32x4 (&acc)[2][2][4][2], const pg8::Unit& u, int wr, int wc, int fr, int fq) const {
        int row0 = u.pm * 256 + wr * 64 + fr; asm volatile("" : "+v"(row0));
        const int col0 = u.pn * 256 + wc * 32 + 4 * fq;
        const bool lat = u.pm < (NLAT / 256);
        const float* xb = lat ? xlat : xctx - (size_t)NLAT * DM;
        const float* g1 = g1base + (size_t)modrow_of(u.pm * 256) * 6 * DM + col0;
        f32x4 gv[2][2];
#pragma unroll
        for (int bj = 0; bj < 2; ++bj)
#pragma unroll
            for (int n = 0; n < 2; ++n) gv[bj][n] = *(const f32x4*)(g1 + bj * 128 + n * 16);
#pragma unroll
        for (int ai = 0; ai < 2; ++ai) {
            f32x4 xv[4][2][2];
#pragma unroll
            for (int m = 0; m < 4; ++m) { const float* xr = xb + (size_t)(row0 + ai * 128 + m * 16) * DM + col0;
#pragma unroll
                for (int bj = 0; bj < 2; ++bj)
#pragma unroll
                    for (int n = 0; n < 2; ++n) xv[m][bj][n] = *(const f32x4*)(xr + bj * 128 + n * 16); }
#pragma unroll
            for (int m = 0; m < 4; ++m) { float* xo = XM + (size_t)(row0 + ai * 128 + m * 16) * DM + col0;
#pragma unroll
                for (int bj = 0; bj < 2; ++bj)
#pragma unroll
                    for (int n = 0; n < 2; ++n) *(f32x4*)(xo + bj * 128 + n * 16) = xv[m][bj][n] + gv[bj][n] * acc[ai][bj][m][n]; }
            asm volatile("" ::: "memory"); }
    }
};
struct EpiMoe1 {
    static constexpr bool PERM = true, AFTER_DRAIN = false, KMID = false; static constexpr int NSTORE = 8;
    const float* b1; bf16* ACT;
    __device__ __forceinline__ void operator()(const f32x4 (&acc)[2][2][4][2], const pg8::Unit& u, int wr, int wc, int fr, int fq) const {
        const int e = u.pn >> 3, p = u.pn & 7;
        const int row0 = u.pm * 256 + wr * 64 + fr, gcol0 = p * 128 + wc * 32 + 8 * fq;
        const float* bb = b1 + (size_t)e * 2048 + gcol0;
        typedef float f32x2 __attribute__((ext_vector_type(2)));
        const f32x4 bgv[2] = {*(const f32x4*)(bb), *(const f32x4*)(bb + 4)};
        const f32x4 blv[2] = {*(const f32x4*)(bb + 1024) + 1.0f, *(const f32x4*)(bb + 1028) + 1.0f};
#pragma unroll
        for (int ai = 0; ai < 2; ++ai)
#pragma unroll
            for (int m = 0; m < 4; ++m) { bf16* rowp = ACT + (size_t)(row0 + ai * 128 + m * 16) * DFF + gcol0;
                unsigned w[4];
#pragma unroll
                for (int n = 0; n < 2; ++n)
#pragma unroll
                    for (int hp = 0; hp < 2; ++hp) {
                        const f32x2 av = hp ? acc[ai][0][m][n].hi : acc[ai][0][m][n].lo, lv = hp ? acc[ai][1][m][n].hi : acc[ai][1][m][n].lo;
                        const f32x2 bg = hp ? bgv[n].hi : bgv[n].lo, bl = hp ? blv[n].hi : blv[n].lo;
                        f32x2 glu = av + bg, lin = lv + bl;
                        glu.x = fminf(glu.x, 7.0f); glu.y = fminf(glu.y, 7.0f);
                        lin.x = __builtin_amdgcn_fmed3f(lin.x, -6.0f, 8.0f); lin.y = __builtin_amdgcn_fmed3f(lin.y, -6.0f, 8.0f);
                        f32x2 ex = glu * -2.4554669595930156f;
                        ex.x = __builtin_amdgcn_exp2f(ex.x); ex.y = __builtin_amdgcn_exp2f(ex.y);
                        ex = ex + 1.0f;
                        ex.x = __builtin_amdgcn_rcpf(ex.x); ex.y = __builtin_amdgcn_rcpf(ex.y);
                        const f32x2 a = (glu * ex) * lin;
                        w[2 * n + hp] = pk2(a.x, a.y); }
                u32x4 wv; wv.x = w[0]; wv.y = w[1]; wv.z = w[2]; wv.w = w[3];
                *(u32x4*)rowp = wv;
                asm volatile("" ::: "memory"); }
    }
};
struct EpiMoe2 {
    static constexpr bool PERM = true, AFTER_DRAIN = false, KMID = false; static constexpr int NSTORE = 16;
    const float* b2; bf16* Y;
    __device__ __forceinline__ void operator()(const f32x4 (&acc)[2][2][4][2], const pg8::Unit& u, int wr, int wc, int fr, int fq) const {
        const int e = u.pn >> 2, p = u.pn & 3;
        const int row0 = u.pm * 256 + wr * 64 + fr, col0 = p * 256 + wc * 32 + 8 * fq;
        f32x4 bv[2][2];
#pragma unroll
        for (int bj = 0; bj < 2; ++bj)
#pragma unroll
            for (int n = 0; n < 2; ++n) bv[bj][n] = *(const f32x4*)(b2 + (size_t)e * 1024 + col0 + bj * 128 + 4 * n);
#pragma unroll
        for (int ai = 0; ai < 2; ++ai)
#pragma unroll
            for (int m = 0; m < 4; ++m) { bf16* rowp = Y + (size_t)(row0 + ai * 128 + m * 16) * DM + col0;
#pragma unroll
                for (int bj = 0; bj < 2; ++bj) { const f32x4 v0 = acc[ai][bj][m][0] + bv[bj][0], v1 = acc[ai][bj][m][1] + bv[bj][1];
                    u32x4 w; w.x = pk2(v0[0], v0[1]); w.y = pk2(v0[2], v0[3]); w.z = pk2(v1[0], v1[1]); w.w = pk2(v1[2], v1[3]);
                    *(u32x4*)(rowp + bj * 128) = w; } }
    }
};
struct MoeOrder {
    static constexpr bool GATHER = false; const LAS int* src;
    const LAS int* list; int n;
    __device__ __forceinline__ bool next(int i, pg8::Unit& u) const { if (i >= n) return false; u.pm = __builtin_amdgcn_readfirstlane(list[2 * i]); u.pn = __builtin_amdgcn_readfirstlane(list[2 * i + 1]); return true; }
    __device__ __forceinline__ void a_ready(const pg8::Unit&) const {}
    __device__ __forceinline__ void done(const pg8::Unit&) const {}
};
struct MoeOrderG {
    static constexpr bool GATHER = true; const LAS int* src;
    const LAS int* list; int n;
    __device__ __forceinline__ bool next(int i, pg8::Unit& u) const { if (i >= n) return false; u.pm = __builtin_amdgcn_readfirstlane(list[2 * i]); u.pn = __builtin_amdgcn_readfirstlane(list[2 * i + 1]); return true; }
    __device__ __forceinline__ void a_ready(const pg8::Unit&) const {}
    __device__ __forceinline__ void done(const pg8::Unit&) const {}
};
__device__ __forceinline__ int moe_list_units(Frame& F, int nN, LAS int* list, bool rev = false) {
    const int* tl = WSP<int>(F, WS_TILES);
    const int T = __builtin_amdgcn_readfirstlane(tl[32]);
    const int tlv = tl[F.lane & 31];
    pg8::StaticOrder SO; SO.init(T * 256, nN * 256, F.G, F.bx);
    int n = 0;
#pragma unroll 1
    for (int i = 0;; ++i) {
        pg8::Unit u; if (!SO.next(i, u)) break;
        const int pm = rev ? (T - 1 - u.pm) : u.pm, pnl = u.pn;
        const int e = __popcll(__ballot(F.lane < 32 && tlv <= pm)) - 1;
        if (F.tid == 0) { list[2 * i] = pm; list[2 * i + 1] = e * nN + pnl; }
        n = i + 1;
    }
    __syncthreads();
    return n;
}


typedef short bf16x8 __attribute__((ext_vector_type(8)));
typedef short bf16x4 __attribute__((ext_vector_type(4)));
constexpr int RLD = 136;
constexpr int RTILE = 128 * RLD * 2;
__device__ __forceinline__ bf16x8 lds_frag16(const LAS bf16* tile, int row0, int k0, int lane) {
    return *(const LAS bf16x8*)(tile + (row0 + (lane & 15)) * RLD + k0 + 8 * (lane >> 4));
}
__device__ __forceinline__ bf16x8 lds_frag16s(const LAS bf16* tile, int row0, int k0, int lane) {
    return *(const LAS bf16x8*)(tile + (row0 + (lane & 15)) * RLD + ((k0 + 8 * (lane >> 4)) ^ ((row0 >> 5) << 4)));
}
__device__ __forceinline__ void lds_frag16x4s(bf16x8 (&f)[4], const LAS bf16* tile, int row0, int lane) {
#pragma unroll
    for (int ks = 0; ks < 4; ++ks) f[ks] = lds_frag16s(tile, row0, 32 * ks, lane);
}
__device__ __forceinline__ void lds_frag16x4(bf16x8 (&f)[4], const LAS bf16* tile, int row0, int lane) {
#pragma unroll
    for (int ks = 0; ks < 4; ++ks) f[ks] = lds_frag16(tile, row0, 32 * ks, lane);
}
__device__ __forceinline__ void ret_unit_decode(int u, int& bh, int& ci, int& rowbase) {
    bh = u / 34; ci = u - bh * 34; const int b = bh >> 2;
    rowbase = (ci < 2) ? (NLAT + b * CTXL + ci * 128) : (b * SEQ + (ci - 2) * 128);
}
__device__ __forceinline__ void ret_load_tile(LAS bf16* tile, const bf16* g, size_t gp, int tid) {
    const int r = tid >> 2, seg = tid & 3;
#pragma unroll
    for (int q = 0; q < 4; ++q) *(LAS u32x4*)(tile + r * RLD + seg * 32 + q * 8) = *(const u32x4*)(g + (size_t)r * gp + seg * 32 + q * 8);
}
__device__ __forceinline__ void ret_kv_unit(Frame& F, int l, int u) {
    const bf16* P = WSP<bf16>(F, WS_P);
    LAS bf16* Ktf = (LAS bf16*)F.lds; LAS bf16* Ktb = Ktf + 128 * RLD; LAS bf16* Vt = Ktb + 128 * RLD;
    int bh, ci, rowbase; ret_unit_decode(u, bh, ci, rowbase);
    const int h = bh & 3, tid = F.tid, lane = F.lane, w = F.wave;
    const float LOG2E = 1.4426950408889634f;
    const float lgf = log_sigmoid_(IN_(F, 8)[l * 8 + h]) * LOG2E, lgb = log_sigmoid_(IN_(F, 8)[l * 8 + 4 + h]) * LOG2E;
    __syncthreads();
    { const int j = tid >> 2, seg = tid & 3;
      const float wf = __builtin_amdgcn_exp2f(lgf * (float)(127 - j)), wb = __builtin_amdgcn_exp2f(lgb * (float)j);
      const bf16* kp = P + (size_t)(rowbase + j) * INC + C_RK + h * 128 + seg * 32; const bf16* vp = P + (size_t)(rowbase + j) * INC + C_RV + h * 128 + seg * 32;
      u32x4 kkv[4], vvv[4];
#pragma unroll
      for (int q = 0; q < 4; ++q) { kkv[q] = *(const u32x4*)(kp + q * 8); vvv[q] = *(const u32x4*)(vp + q * 8); }
      __builtin_amdgcn_sched_barrier(0);
#pragma unroll
      for (int q = 0; q < 4; ++q) { const u32x4 kk = kkv[q], vv = vvv[q];
          const unsigned kw[4] = {kk.x, kk.y, kk.z, kk.w}, vw[4] = {vv.x, vv.y, vv.z, vv.w};
#pragma unroll
          for (int i = 0; i < 4; ++i) { const int d = seg * 32 + q * 8 + 2 * i;
              const float k0 = __uint_as_float(kw[i] << 16), k1 = __uint_as_float(kw[i] & 0xffff0000u);
              const int js = j ^ (seg << 4);
              Ktf[d * RLD + js] = f2bf(k0 * wf); Ktf[(d + 1) * RLD + js] = f2bf(k1 * wf);
              Ktb[d * RLD + js] = f2bf(k0 * wb); Ktb[(d + 1) * RLD + js] = f2bf(k1 * wb);
              Vt[d * RLD + js] = (bf16)(vw[i] & 0xffffu); Vt[(d + 1) * RLD + js] = (bf16)(vw[i] >> 16); } } }
    __syncthreads();
    bf16x8 af[4], ab[4];
#pragma unroll
    for (int ks = 0; ks < 4; ++ks) { af[ks] = lds_frag16s(Ktf, 16 * w, 32 * ks, lane); ab[ks] = lds_frag16s(Ktb, 16 * w, 32 * ks, lane); }
    bf16* KV = WSP<bf16>(F, WS_KV) + (size_t)(bh * 34 + ci) * 32768;
    const int d0 = 16 * w + 4 * (lane >> 4);
    bf16x8 vf[2][4];
    lds_frag16x4s(vf[0], Vt, 0, lane);
#pragma unroll
    for (int et = 0; et < 8; ++et) {
        if (et + 1 < 8) lds_frag16x4s(vf[(et + 1) & 1], Vt, 16 * (et + 1), lane);
        __builtin_amdgcn_sched_barrier(0);
        f32x4 cf = (f32x4){0.f, 0.f, 0.f, 0.f}, cb = cf;
#pragma unroll
        for (int ks = 0; ks < 4; ++ks) { cf = __builtin_amdgcn_mfma_f32_16x16x32_bf16(af[ks], vf[et & 1][ks], cf, 0, 0, 0); cb = __builtin_amdgcn_mfma_f32_16x16x32_bf16(ab[ks], vf[et & 1][ks], cb, 0, 0, 0); }
        const int e = 16 * et + (lane & 15);
        u32x4 o; o.x = (unsigned)f2bf(cf[0]) | ((unsigned)f2bf(cb[0]) << 16); o.y = (unsigned)f2bf(cf[1]) | ((unsigned)f2bf(cb[1]) << 16);
        o.z = (unsigned)f2bf(cf[2]) | ((unsigned)f2bf(cb[2]) << 16); o.w = (unsigned)f2bf(cf[3]) | ((unsigned)f2bf(cb[3]) << 16);
        *(u32x4*)(KV + ((size_t)e * 128 + d0) * 2) = o;
    }
}
__device__ __forceinline__ void ret_scan(Frame& F, int l) {
    const bf16* KV = WSP<bf16>(F, WS_KV); bf16* SP = WSP<bf16>(F, WS_SP);
    const float LOG2E = 1.4426950408889634f;
    const int total = 32 * 4096, stride = F.G * NTHR;
#pragma unroll 1
    for (int idx = F.bx * NTHR + F.tid; idx < total; idx += stride) {
        const int bh = idx >> 12, elem = (idx & 4095) * 4, h = bh & 3;
        const float cdf = __builtin_amdgcn_exp2f(log_sigmoid_(IN_(F, 8)[l * 8 + h]) * LOG2E * 128.0f), cdb = __builtin_amdgcn_exp2f(log_sigmoid_(IN_(F, 8)[l * 8 + 4 + h]) * LOG2E * 128.0f);
        const bf16* kvp = KV + (size_t)bh * 34 * 32768 + (size_t)elem * 2;
        u32x4 kv[34];
#pragma unroll
        for (int ci = 0; ci < 34; ++ci) kv[ci] = *(const u32x4*)(kvp + (size_t)ci * 32768);
        bf16* spf = SP + ((size_t)bh * 34 * 2) * 16384 + elem; bf16* spb = spf + 16384;
        f32x4 sf = (f32x4){0.f, 0.f, 0.f, 0.f}, sb = sf;
#pragma unroll
        for (int st = 0; st < 34; ++st) { const int cf = st, cb = (st == 0) ? 1 : ((st == 1) ? 0 : 35 - st);
            u32x2 of; of.x = pk2(sf[0], sf[1]); of.y = pk2(sf[2], sf[3]); *(u32x2*)(spf + (size_t)cf * 2 * 16384) = of;
            u32x2 ob; ob.x = pk2(sb[0], sb[1]); ob.y = pk2(sb[2], sb[3]); *(u32x2*)(spb + (size_t)cb * 2 * 16384) = ob;
            const u32x4 a = kv[cf], c = kv[cb];
            sf = sf * cdf + (f32x4){__uint_as_float(a.x << 16), __uint_as_float(a.y << 16), __uint_as_float(a.z << 16), __uint_as_float(a.w << 16)};
            sb = sb * cdb + (f32x4){__uint_as_float(c.x & 0xffff0000u), __uint_as_float(c.y & 0xffff0000u), __uint_as_float(c.z & 0xffff0000u), __uint_as_float(c.w & 0xffff0000u)}; }
    }
}
__device__ __forceinline__ void ret_out_unit(Frame& F, int l, int u) {
    const bf16* P = WSP<bf16>(F, WS_P);
    LAS bf16* Qs = (LAS bf16*)F.lds; LAS bf16* Ks = Qs + 128 * RLD; LAS bf16* Vt = Ks + 128 * RLD; LAS bf16* Ps = Vt + 128 * RLD;
    int bh, ci, rowbase; ret_unit_decode(u, bh, ci, rowbase);
    const int h = bh & 3, tid = F.tid, lane = F.lane, w = F.wave;
    const float LOG2E = 1.4426950408889634f;
    const float lgf = log_sigmoid_(IN_(F, 8)[l * 8 + h]) * LOG2E, lgb = log_sigmoid_(IN_(F, 8)[l * 8 + 4 + h]) * LOG2E;
    __syncthreads();
    { const int j = tid >> 2, seg = tid & 3;
      const bf16* qp = P + (size_t)(rowbase + j) * INC + C_RQ + h * 128 + seg * 32; const bf16* kp = P + (size_t)(rowbase + j) * INC + C_RK + h * 128 + seg * 32; const bf16* vp = P + (size_t)(rowbase + j) * INC + C_RV + h * 128 + seg * 32;
      u32x4 qv[4], kv4[4], vv4[4];
#pragma unroll
      for (int q = 0; q < 4; ++q) { qv[q] = *(const u32x4*)(qp + q * 8); kv4[q] = *(const u32x4*)(kp + q * 8); vv4[q] = *(const u32x4*)(vp + q * 8); }
      __builtin_amdgcn_sched_barrier(0);
#pragma unroll
      for (int q = 0; q < 4; ++q) { *(LAS u32x4*)(Qs + j * RLD + seg * 32 + q * 8) = qv[q]; *(LAS u32x4*)(Ks + j * RLD + seg * 32 + q * 8) = kv4[q]; }
#pragma unroll
      for (int q = 0; q < 4; ++q) { const u32x4 vv = vv4[q]; const unsigned vw[4] = {vv.x, vv.y, vv.z, vv.w};
#pragma unroll
          for (int i = 0; i < 4; ++i) { const int d = seg * 32 + q * 8 + 2 * i, js = j ^ (seg << 4); Vt[d * RLD + js] = (bf16)(vw[i] & 0xffffu); Vt[(d + 1) * RLD + js] = (bf16)(vw[i] >> 16); } } }
    u32x4 spre[2][4];
    { const bf16* SPg = WSP<bf16>(F, WS_SP) + ((size_t)(bh * 34 + ci) * 2) * 16384; const int rr = tid >> 2, seg = tid & 3;
#pragma unroll
      for (int dir = 0; dir < 2; ++dir) { const bool zero = (dir == 0) ? (ci == 0) : (ci == 1);
#pragma unroll
          for (int q = 0; q < 4; ++q) spre[dir][q] = zero ? (u32x4){0u, 0u, 0u, 0u} : *(const u32x4*)(SPg + (size_t)dir * 16384 + (size_t)rr * 128 + seg * 32 + q * 8); } }
    __syncthreads();
    const int icol = 16 * w + (lane & 15);
    bf16x8 bq[4];
#pragma unroll
    for (int ks = 0; ks < 4; ++ks) bq[ks] = lds_frag16(Qs, 16 * w, 32 * ks, lane);
    bf16x8 tf[2][4];
    lds_frag16x4(tf[0], Ks, 0, lane);
#pragma unroll
    for (int jt = 0; jt < 8; ++jt) {
        if (jt + 1 < 8) lds_frag16x4(tf[(jt + 1) & 1], Ks, 16 * (jt + 1), lane);
        __builtin_amdgcn_sched_barrier(0);
        f32x4 c = (f32x4){0.f, 0.f, 0.f, 0.f};
#pragma unroll
        for (int ks = 0; ks < 4; ++ks) c = __builtin_amdgcn_mfma_f32_16x16x32_bf16(tf[jt & 1][ks], bq[ks], c, 0, 0, 0);
        const int j0 = 16 * jt + 4 * (lane >> 4);
        float pv[4];
#pragma unroll
        for (int r = 0; r < 4; ++r) { const int dd = icol - (j0 + r); const float dec = dd >= 0 ? __builtin_amdgcn_exp2f(lgf * (float)dd) : __builtin_amdgcn_exp2f(lgb * (float)(-dd)); pv[r] = c[r] * dec; }
        u32x2 pw; pw.x = pk2(pv[0], pv[1]); pw.y = pk2(pv[2], pv[3]);
        *(LAS u32x2*)(Ps + icol * RLD + j0) = pw;
    }
    LDS_WAIT(); asm volatile("" ::: "memory");
    f32x4 acc[8];
    {
        bf16x8 bp[4];
#pragma unroll
        for (int ks = 0; ks < 4; ++ks) bp[ks] = lds_frag16(Ps, 16 * w, 32 * ks, lane);
        lds_frag16x4s(tf[0], Vt, 0, lane);
#pragma unroll
        for (int et = 0; et < 8; ++et) {
            if (et + 1 < 8) lds_frag16x4s(tf[(et + 1) & 1], Vt, 16 * (et + 1), lane);
            __builtin_amdgcn_sched_barrier(0);
            f32x4 c = (f32x4){0.f, 0.f, 0.f, 0.f};
#pragma unroll
            for (int ks = 0; ks < 4; ++ks) c = __builtin_amdgcn_mfma_f32_16x16x32_bf16(tf[et & 1][ks], bp[ks], c, 0, 0, 0);
            acc[et] = c; }
    }
#pragma unroll
    for (int dir = 0; dir < 2; ++dir) {
        const bool zero = (dir == 0) ? (ci == 0) : (ci == 1);
        __syncthreads();
        if (!zero) { const int rr = tid >> 2, seg = tid & 3;
#pragma unroll
            for (int q = 0; q < 4; ++q) *(LAS u32x4*)(Ks + rr * RLD + seg * 32 + q * 8) = spre[dir][q]; }
        __syncthreads();
        if (!zero) {
            const float sc = (dir == 0) ? __builtin_amdgcn_exp2f(lgf * (float)((icol & 127) + 1)) : __builtin_amdgcn_exp2f(lgb * (float)(128 - (icol & 127)));
            lds_frag16x4(tf[0], Ks, 0, lane);
#pragma unroll
            for (int et = 0; et < 8; ++et) {
                if (et + 1 < 8) lds_frag16x4(tf[(et + 1) & 1], Ks, 16 * (et + 1), lane);
                __builtin_amdgcn_sched_barrier(0);
                f32x4 c = (f32x4){0.f, 0.f, 0.f, 0.f};
#pragma unroll
                for (int ks = 0; ks < 4; ++ks) c = __builtin_amdgcn_mfma_f32_16x16x32_bf16(tf[et & 1][ks], bq[ks], c, 0, 0, 0);
                acc[et] = acc[et] + c * sc; }
        }
    }
    u32x2 gpre[8];
    { const bf16* gp0 = P + (size_t)(rowbase + icol) * INC + C_RG + h * 128 + 4 * (lane >> 4);
#pragma unroll
      for (int et = 0; et < 8; ++et) gpre[et] = *(const u32x2*)(gp0 + 16 * et); }
    __builtin_amdgcn_sched_barrier(0);
    const float ksc = 0.08838834764831845f;
    float ss = 0.f;
#pragma unroll
    for (int et = 0; et < 8; ++et) { acc[et] = acc[et] * ksc; ss += (acc[et][0] * acc[et][0] + acc[et][1] * acc[et][1]) + (acc[et][2] * acc[et][2] + acc[et][3] * acc[et][3]); }
    ss += __shfl_xor(ss, 16); ss += __shfl_xor(ss, 32);
    const float rs = 1.0f / sqrtf(ss * (1.0f / 128.0f) + EPS);
    const size_t row = (size_t)(rowbase + icol);
    bf16* op = WSP<bf16>(F, WS_RET) + row * 1536 + h * 128;
#pragma unroll
    for (int ep = 0; ep < 4; ++ep) {
        unsigned pq[2][2];
#pragma unroll
        for (int k = 0; k < 2; ++k) { const int et = 2 * ep + k; const u32x2 g2 = gpre[et];
            const float g0 = __uint_as_float(g2.x << 16), g1 = __uint_as_float(g2.x & 0xffff0000u), g2f = __uint_as_float(g2.y << 16), g3 = __uint_as_float(g2.y & 0xffff0000u);
            pq[k][0] = pk2s(acc[et][0] * rs * siluf_(g0), acc[et][1] * rs * siluf_(g1)); pq[k][1] = pk2s(acc[et][2] * rs * siluf_(g2f), acc[et][3] * rs * siluf_(g3)); }
        const auto sx = __builtin_amdgcn_permlane16_swap(pq[0][0], pq[1][0], false, false), sy = __builtin_amdgcn_permlane16_swap(pq[0][1], pq[1][1], false, false);
        u32x4 wv; wv.x = sx[0]; wv.y = sy[0]; wv.z = sx[1]; wv.w = sy[1];
        const int lgq = lane >> 4;
        *(u32x4*)(op + 16 * (2 * ep + (lgq & 1)) + 8 * (lgq >> 1)) = wv; }
}

typedef float f32x2 __attribute__((ext_vector_type(2)));
__device__ __forceinline__ f32x2 cmul_(f32x2 a, f32x2 b) { return (f32x2){a.x * b.x - a.y * b.y, a.x * b.y + a.y * b.x}; }
__device__ __forceinline__ f32x2 cmulc_(f32x2 a, f32x2 b) { return (f32x2){a.x * b.x + a.y * b.y, a.y * b.x - a.x * b.y}; }
__device__ __forceinline__ f32x2 twid_(float rev) { return (f32x2){cos_rev(rev), -sin_rev(rev)}; }
__device__ __forceinline__ int fpad(int n) { return n + (n >> 3); }
template <int R> __device__ __forceinline__ void fft_twiddles(f32x2 (&tw)[R - 1], int t, int s, int M) {
    int o = 0, u = 0;
#pragma unroll
    for (int half = R / 2; half >= 1; half >>= 1) {
        const float invMu = 1.0f / (float)(M >> u);
#pragma unroll
        for (int qq = 0; qq < half; ++qq) tw[o + qq] = twid_((float)(t + qq * s) * invMu);
        o += half; ++u;
    }
}
template <int R, int HALF, int OFF> __device__ __forceinline__ void fft_sub_fwd(f32x2 (&v)[R], const f32x2 (&tw)[R - 1]) {
#pragma unroll
    for (int qq = 0; qq < HALF; ++qq) {
        const f32x2 w = tw[OFF + qq];
#pragma unroll
        for (int g0 = 0; g0 < R; g0 += 2 * HALF) { const f32x2 a = v[g0 + qq], b = v[g0 + qq + HALF]; v[g0 + qq] = a + b; v[g0 + qq + HALF] = cmul_(a - b, w); }
    }
}
template <int R, int HALF, int OFF> __device__ __forceinline__ void fft_sub_inv(f32x2 (&v)[R], const f32x2 (&tw)[R - 1]) {
#pragma unroll
    for (int qq = 0; qq < HALF; ++qq) {
        const f32x2 w = tw[OFF + qq];
#pragma unroll
        for (int g0 = 0; g0 < R; g0 += 2 * HALF) { const f32x2 A = v[g0 + qq], Bp = cmulc_(v[g0 + qq + HALF], w); v[g0 + qq] = A + Bp; v[g0 + qq + HALF] = A - Bp; }
    }
}
template <int R> __device__ __forceinline__ void fft_bf_fwd(f32x2 (&v)[R], const f32x2 (&tw)[R - 1]) {
    if constexpr (R == 16) { fft_sub_fwd<16, 8, 0>(v, tw); fft_sub_fwd<16, 4, 8>(v, tw); fft_sub_fwd<16, 2, 12>(v, tw); fft_sub_fwd<16, 1, 14>(v, tw); }
    else { fft_sub_fwd<8, 4, 0>(v, tw); fft_sub_fwd<8, 2, 4>(v, tw); fft_sub_fwd<8, 1, 6>(v, tw); }
}
template <int R> __device__ __forceinline__ void fft_bf_inv(f32x2 (&v)[R], const f32x2 (&tw)[R - 1]) {
    if constexpr (R == 16) { fft_sub_inv<16, 1, 14>(v, tw); fft_sub_inv<16, 2, 12>(v, tw); fft_sub_inv<16, 4, 8>(v, tw); fft_sub_inv<16, 8, 0>(v, tw); }
    else { fft_sub_inv<8, 1, 6>(v, tw); fft_sub_inv<8, 2, 4>(v, tw); fft_sub_inv<8, 4, 0>(v, tw); }
}
__device__ __forceinline__ void fft_tw_last(f32x2 (&tw)[7]) {
    const float h = 0.70710678118654752f;
    tw[0] = (f32x2){1.f, 0.f}; tw[1] = (f32x2){h, -h}; tw[2] = (f32x2){0.f, -1.f}; tw[3] = (f32x2){-h, -h};
    tw[4] = (f32x2){1.f, 0.f}; tw[5] = (f32x2){0.f, -1.f}; tw[6] = (f32x2){1.f, 0.f};
}
struct FftTw { f32x2 t1[15]; f32x2 t2[2][7]; f32x2 t3[2][7]; };
__device__ __forceinline__ void fft_tw_init(FftTw& T, int tid) {
    fft_twiddles<16>(T.t1, tid, 512, 8192);
#pragma unroll
    for (int it = 0; it < 2; ++it) { const int uu = tid + 512 * it; fft_twiddles<8>(T.t2[it], uu & 63, 64, 512); fft_twiddles<8>(T.t3[it], uu & 7, 8, 64); }
}
template <bool INV, int M> __device__ __forceinline__ void fft_pass8(LAS f32x2* X, int tid, const f32x2 (&tw)[2][7]) {
    asm volatile("" : "+v"(tid));
    constexpr int s = M >> 3;
#pragma unroll
    for (int it = 0; it < 2; ++it) {
        const int uu = tid + 512 * it, blk = uu / s, t = uu - blk * s, n0 = blk * M + t;
        f32x2 v[8];
#pragma unroll
        for (int q = 0; q < 8; ++q) v[q] = X[fpad(n0 + q * s)];
        if (INV) fft_bf_inv<8>(v, tw[it]); else fft_bf_fwd<8>(v, tw[it]);
#pragma unroll
        for (int q = 0; q < 8; ++q) X[fpad(n0 + q * s)] = v[q];
    }
}
__device__ __forceinline__ void fft_filter_unit(Frame& F, const FftTw& T, int l, int c) {
    LAS f32x2* X = (LAS f32x2*)F.lds;
    const float* HFp = WSP<float>(F, WS_HF + (size_t)l * 16 * MiB); const float* HBp = WSP<float>(F, WS_HF + (size_t)l * 16 * MiB + 8 * MiB);
    const float scale = hy_inv_l1(F, l, c) * (1.0f / 8192.0f);
    int tid = F.tid; asm volatile("" : "+v"(tid));
    __syncthreads();
    {   f32x2 v[16];
#pragma unroll
        for (int q = 0; q < 16; ++q) { const int n = tid + 512 * q; float x;
            if (q < 8) x = HFp[(size_t)c * 4096 + n]; else x = (n == 4096) ? 0.f : HBp[(size_t)c * 4096 + (8192 - n)];
            v[q] = (f32x2){x * scale, 0.f}; }
        fft_bf_fwd<16>(v, T.t1);
#pragma unroll
        for (int q = 0; q < 16; ++q) X[fpad(tid + 512 * q)] = v[q];
    }
    __syncthreads(); fft_pass8<false, 512>(X, tid, T.t2);
    __syncthreads(); fft_pass8<false, 64>(X, tid, T.t3);
    __syncthreads();
    f32x2* Hc = WSP<f32x2>(F, WS_HSPEC) + ((size_t)l * 512 + c) * 8192;
    asm volatile("" : "+v"(tid));
    f32x2 tl[7]; fft_tw_last(tl);
#pragma unroll
    for (int it = 0; it < 2; ++it) {
        const int uu = tid + 512 * it;
        f32x2 v[8];
#pragma unroll
        for (int q = 0; q < 8; ++q) v[q] = X[fpad(8 * uu + q)];
        fft_bf_fwd<8>(v, tl);
#pragma unroll
        for (int q = 0; q < 4; ++q) { f32x4 o; o[0] = v[2 * q].x; o[1] = v[2 * q].y; o[2] = v[2 * q + 1].x; o[3] = v[2 * q + 1].y; *(f32x4*)(Hc + 8 * uu + 2 * q) = o; }
    }
}
__device__ __forceinline__ void fft_zfetch(Frame& F, int unit, int tid, unsigned (&zp)[8]) {
    const bf16* n1 = WSP<bf16>(F, WS_ZT) + ((size_t)(unit >> 2) * NB + 2 * (unit & 3)) * SEQ; const bf16* n2 = n1 + SEQ;
#pragma unroll
    for (int q = 0; q < 8; ++q) { const int n = tid + 512 * q; zp[q] = (unsigned)n1[n] | ((unsigned)n2[n] << 16); }
}
__device__ __forceinline__ void fft_zfetch_raw(Frame& F, int unit, int tid, unsigned (&zr)[16]) {
    const bf16* n1 = WSP<bf16>(F, WS_ZT) + ((size_t)(unit >> 2) * NB + 2 * (unit & 3)) * SEQ; const bf16* n2 = n1 + SEQ;
#pragma unroll
    for (int q = 0; q < 8; ++q) { const int n = tid + 512 * q; zr[q] = (unsigned)n1[n]; zr[8 + q] = (unsigned)n2[n]; }
}
__device__ __forceinline__ void fft_zcombine(unsigned (&zp)[8], const unsigned (&zr)[16]) {
#pragma unroll
    for (int q = 0; q < 8; ++q) zp[q] = zr[q] | (zr[8 + q] << 16);
}
__device__ __forceinline__ void fft_stage_first(LAS f32x2* X, const FftTw& T, int tid, const unsigned (&zp)[8]) {
    f32x2 v[16];
#pragma unroll
    for (int q = 0; q < 8; ++q) v[q] = (f32x2){__uint_as_float(zp[q] << 16), __uint_as_float(zp[q] & 0xffff0000u)};
#pragma unroll
    for (int q = 8; q < 16; ++q) v[q] = (f32x2){0.f, 0.f};
    fft_bf_fwd<16>(v, T.t1);
#pragma unroll
    for (int q = 0; q < 16; ++q) X[fpad(tid + 512 * q)] = v[q];
}
__device__ __forceinline__ void fft_stage_mid(LAS f32x2* X, int tid, const f32x4 (&hp)[2][4]) {
    f32x2 tl[7]; fft_tw_last(tl);
#pragma unroll
    for (int it = 0; it < 2; ++it) {
        const int uu = tid + 512 * it;
        f32x2 v[8];
#pragma unroll
        for (int q = 0; q < 8; ++q) v[q] = X[fpad(8 * uu + q)];
        fft_bf_fwd<8>(v, tl);
#pragma unroll
        for (int q = 0; q < 4; ++q) { const f32x4 h = hp[it][q]; v[2 * q] = cmul_(v[2 * q], (f32x2){h[0], h[1]}); v[2 * q + 1] = cmul_(v[2 * q + 1], (f32x2){h[2], h[3]}); }
        fft_bf_inv<8>(v, tl);
#pragma unroll
        for (int q = 0; q < 8; ++q) X[fpad(8 * uu + q)] = v[q];
    }
}
__device__ __forceinline__ void fft_stage_last(Frame& F, LAS f32x2* X, const FftTw& T, int tid, int unit) {
    f32x2 v[16];
#pragma unroll
    for (int q = 0; q < 16; ++q) v[q] = X[fpad(tid + 512 * q)];
    fft_bf_inv<16>(v, T.t1);
    bf16* y1 = WSP<bf16>(F, WS_YT) + ((size_t)(unit >> 2) * NB + 2 * (unit & 3)) * SEQ; bf16* y2 = y1 + SEQ;
#pragma unroll
    for (int q = 0; q < 8; ++q) { const int n = tid + 512 * q; y1[n] = f2bf(v[q].x); y2[n] = f2bf(v[q].y); }
}
__device__ __forceinline__ void fft_conv_pair(Frame& F, const FftTw& T, int l, int ua, int ub, int na, int nb, unsigned (&zpa)[8], unsigned (&zpb)[8]) {
    LAS f32x2* X0 = (LAS f32x2*)F.lds; LAS f32x2* X1 = X0 + 9216;
    int tid = F.tid; asm volatile("" : "+v"(tid));
    __syncthreads();
    unsigned zra[16], zrb[16];
    fft_stage_first(X0, T, tid, zpa); if (na < 2048) fft_zfetch_raw(F, na, tid, zra);
    fft_stage_first(X1, T, tid, zpb); if (nb < 2048) fft_zfetch_raw(F, nb, tid, zrb);
    __syncthreads(); fft_pass8<false, 512>(X0, tid, T.t2); fft_pass8<false, 512>(X1, tid, T.t2);
    if (na < 2048) fft_zcombine(zpa, zra);
    if (nb < 2048) fft_zcombine(zpb, zrb);
    f32x4 hpa[2][4];
    { const f32x2* Ha = WSP<f32x2>(F, WS_HSPEC) + ((size_t)l * 512 + (ua >> 2)) * 8192; const f32x2* Hb = WSP<f32x2>(F, WS_HSPEC) + ((size_t)l * 512 + (ub >> 2)) * 8192;
#pragma unroll
      for (int it = 0; it < 2; ++it)
#pragma unroll
          for (int q = 0; q < 4; ++q) { hpa[it][q] = *(const f32x4*)(Ha + 8 * (tid + 512 * it) + 2 * q); } (void)Hb; }
    __syncthreads(); fft_pass8<false, 64>(X0, tid, T.t3); fft_pass8<false, 64>(X1, tid, T.t3);
    __syncthreads(); asm volatile("" : "+v"(tid)); fft_stage_mid(X0, tid, hpa); fft_stage_mid(X1, tid, hpa);
    __syncthreads(); fft_pass8<true, 64>(X0, tid, T.t3); fft_pass8<true, 64>(X1, tid, T.t3);
    __syncthreads(); fft_pass8<true, 512>(X0, tid, T.t2); fft_pass8<true, 512>(X1, tid, T.t2);
    __syncthreads(); asm volatile("" : "+v"(tid)); fft_stage_last(F, X0, T, tid, ua); fft_stage_last(F, X1, T, tid, ub);
}

constexpr int HLD = 72;
struct HyRaw { u32x4 c0, c1, c2; };
__device__ __forceinline__ void hy_fetch8(const bf16* P, int base, int t, int L, int ch0, HyRaw& r) {
    const bf16* p1 = P + (size_t)(base + t) * INC + C_HU + ch0;
    const u32x4 zero = (u32x4){0u, 0u, 0u, 0u};
    r.c1 = *(const u32x4*)p1; r.c0 = (t > 0) ? *(const u32x4*)(p1 - INC) : zero; r.c2 = (t + 1 < L) ? *(const u32x4*)(p1 + INC) : zero;
}
__device__ __forceinline__ void hy_conv8(const HyRaw& r, const float (&w)[4][8], float (&out)[8]) {
    const unsigned a0[4] = {r.c0.x, r.c0.y, r.c0.z, r.c0.w}, a1[4] = {r.c1.x, r.c1.y, r.c1.z, r.c1.w}, a2[4] = {r.c2.x, r.c2.y, r.c2.z, r.c2.w};
#pragma unroll
    for (int i = 0; i < 4; ++i) {
        out[2 * i] = w[3][2 * i] + __uint_as_float(a0[i] << 16) * w[0][2 * i] + __uint_as_float(a1[i] << 16) * w[1][2 * i] + __uint_as_float(a2[i] << 16) * w[2][2 * i];
        out[2 * i + 1] = w[3][2 * i + 1] + __uint_as_float(a0[i] & 0xffff0000u) * w[0][2 * i + 1] + __uint_as_float(a1[i] & 0xffff0000u) * w[1][2 * i + 1] + __uint_as_float(a2[i] & 0xffff0000u) * w[2][2 * i + 1];
    }
}
__device__ __forceinline__ void hy_load_w8(const float* cw, const float* cb, int ch0, float (&w)[4][8]) {
#pragma unroll
    for (int i = 0; i < 8; ++i) { w[0][i] = cw[ch0 + i]; w[1][i] = cw[1536 + ch0 + i]; w[2][i] = cw[2 * 1536 + ch0 + i]; w[3][i] = cb[ch0 + i]; }
}
__device__ __forceinline__ void hy_item_decode(int it, int& ct, int& base, int& t0, int& L, int& b, bool& isctx) {
    isctx = it >= 4096;
    if (!isctx) { ct = it & 7; t0 = ((it >> 3) & 63) * 64; b = it >> 9; base = b * SEQ; L = SEQ; }
    else { const int j = it - 4096; ct = j & 7; t0 = ((j >> 3) & 3) * 64; b = j >> 5; base = NLAT + b * CTXL; L = CTXL; }
}
template <int VAR> __device__ __forceinline__ int hy_nitems(int bx, bool reb, int nit) {
    if (!reb) return (nit - bx + 255) >> 8;
    if (bx < 64) return 11;
    if (VAR == 0) return bx < 192 ? 20 : 17;
    return 19;
}
template <int VAR> __device__ __forceinline__ int hy_item(int bx, bool reb, int idx) {
    if (!reb || idx < ((bx < 64) ? 11 : 17)) return bx + 256 * idx;
    const int e = idx - 17, donor = bx & 63, grp = (bx >> 6) - 1;
    const int k = (VAR == 0) ? (11 + 3 * grp + e) : (11 + 2 * grp + e);
    return donor + 256 * k;
}
__device__ __forceinline__ void ph_hyprep2(Frame& F, int l, bool do_ctx) {
    const bf16* P = WSP<bf16>(F, WS_P);
    const float* cw = IN_(F, 10) + l * 3 * 1536; const float* cb = IN_(F, 11) + l * 1536;
    LAS bf16* Zs = (LAS bf16*)F.lds;
    int tid = F.tid; asm volatile("" : "+v"(tid));
    const int cg = tid & 7, tl = tid >> 3, c0 = (F.bx & 7) * 64;
    float w1[4][8], wv[4][8];
    hy_load_w8(cw, cb, 512 + c0 + 8 * cg, w1); hy_load_w8(cw, cb, 1024 + c0 + 8 * cg, wv);
    const int nit = do_ctx ? 4352 : 4096;
    HyRaw r1, rv;
    const int nmy = hy_nitems<0>(F.bx, do_ctx, nit);
    { int ct, base, t0, L, b; bool isctx; hy_item_decode(hy_item<0>(F.bx, do_ctx, 0), ct, base, t0, L, b, isctx); hy_fetch8(P, base, t0 + tl, L, 512 + c0 + 8 * cg, r1); hy_fetch8(P, base, t0 + tl, L, 1024 + c0 + 8 * cg, rv); }
#pragma unroll 1
    for (int ii = 0; ii < nmy; ++ii) {
        const int it = hy_item<0>(F.bx, do_ctx, ii);
        int ct, base, t0, L, b; bool isctx; hy_item_decode(it, ct, base, t0, L, b, isctx);
        float x1[8], v[8];
        hy_conv8(r1, w1, x1); hy_conv8(rv, wv, v);
        if (ii + 1 < nmy) { int ct2, base2, t02, L2, b2; bool ic2; hy_item_decode(hy_item<0>(F.bx, do_ctx, ii + 1), ct2, base2, t02, L2, b2, ic2); hy_fetch8(P, base2, t02 + tl, L2, 512 + c0 + 8 * cg, r1); hy_fetch8(P, base2, t02 + tl, L2, 1024 + c0 + 8 * cg, rv); }
        __syncthreads();
#pragma unroll
        for (int i = 0; i < 8; ++i) Zs[(8 * cg + i) * HLD + (tl ^ (8 * cg))] = f2bf(x1[i] * v[i]);
        __syncthreads();
        { const int c = tid >> 3, seg = tid & 7;
          const u32x4 o = *(const LAS u32x4*)(Zs + c * HLD + 8 * (seg ^ (c >> 3)));
          bf16* dst = isctx ? (WSP<bf16>(F, WS_ZTC) + ((size_t)(c0 + c) * NB + b) * CTXL + t0 + 8 * seg) : (WSP<bf16>(F, WS_ZT) + ((size_t)(c0 + c) * NB + b) * SEQ + t0 + 8 * seg);
          *(u32x4*)dst = o; }
    }
}
__device__ __forceinline__ void ph_hypost2(Frame& F, int l, bool do_ctx) {
    const bf16* P = WSP<bf16>(F, WS_P);
    const float* cw = IN_(F, 10) + l * 3 * 1536; const float* cb = IN_(F, 11) + l * 1536; const float* skip = IN_(F, 19) + l * 512;
    LAS bf16* Ys = (LAS bf16*)F.lds; LAS bf16* Zs = Ys + 64 * HLD;
    int tid = F.tid; asm volatile("" : "+v"(tid));
    const int cg = tid & 7, tl = tid >> 3, c0 = (F.bx & 7) * 64;
    float w0[4][8], sk[8];
    hy_load_w8(cw, cb, c0 + 8 * cg, w0);
#pragma unroll
    for (int i = 0; i < 8; ++i) sk[i] = skip[c0 + 8 * cg + i];
    bf16* HY = WSP<bf16>(F, WS_RET) + 1024;
    const int nit = do_ctx ? 4352 : 4096;
    const int cY = tid >> 3, segY = tid & 7;
    HyRaw r0; u32x4 yraw, zraw;
#define HYP_FETCH(it_) do { int ct_, base_, t0_, L_, b_; bool ic_; hy_item_decode((it_), ct_, base_, t0_, L_, b_, ic_); \
        hy_fetch8(P, base_, t0_ + tl, L_, c0 + 8 * cg, r0); \
        const size_t off_ = ic_ ? (((size_t)(c0 + cY) * NB + b_) * CTXL + t0_ + 8 * segY) : (((size_t)(c0 + cY) * NB + b_) * SEQ + t0_ + 8 * segY); \
        yraw = *(const u32x4*)((ic_ ? WSP<bf16>(F, WS_YTC) : WSP<bf16>(F, WS_YT)) + off_); zraw = *(const u32x4*)((ic_ ? WSP<bf16>(F, WS_ZTC) : WSP<bf16>(F, WS_ZT)) + off_); } while (0)
    const int nmy = hy_nitems<1>(F.bx, do_ctx, nit);
    HYP_FETCH(hy_item<1>(F.bx, do_ctx, 0));
#pragma unroll 1
    for (int ii = 0; ii < nmy; ++ii) {
        const int it = hy_item<1>(F.bx, do_ctx, ii);
        int ct, base, t0, L, b; bool isctx; hy_item_decode(it, ct, base, t0, L, b, isctx);
        float x0[8];
        hy_conv8(r0, w0, x0);
        __syncthreads();
        *(LAS u32x4*)(Ys + cY * HLD + 8 * (segY ^ (cY >> 3))) = yraw;
        *(LAS u32x4*)(Zs + cY * HLD + 8 * (segY ^ (cY >> 3))) = zraw;
        if (ii + 1 < nmy) HYP_FETCH(hy_item<1>(F.bx, do_ctx, ii + 1));
        __syncthreads();
        float hy[8];
#pragma unroll
        for (int i = 0; i < 8; ++i) { const int a_ = (8 * cg + i) * HLD + (tl ^ (8 * cg)); const float y = bf2f(Ys[a_]), z = bf2f(Zs[a_]); hy[i] = x0[i] * (y + sk[i] * z); }
        u32x4 o; o.x = pk2(hy[0], hy[1]); o.y = pk2(hy[2], hy[3]); o.z = pk2(hy[4], hy[5]); o.w = pk2(hy[6], hy[7]);
        *(u32x4*)(HY + (size_t)(base + t0 + tl) * 1536 + c0 + 8 * cg) = o;
    }
#undef HYP_FETCH
}
__device__ __forceinline__ void hyconv_ctx_item2(Frame& F, int c) {
    const float* HFp = WSP<float>(F, WS_HFC); const float* HBp = WSP<float>(F, WS_HFC + 512 * 1024);
    LAS float* Kc = (LAS float*)F.lds; LAS float* Zs = Kc + 512;
    const float il1 = hy_inv_l1(F, 2, c);
    const bf16* Z = WSP<bf16>(F, WS_ZTC) + (size_t)c * NB * CTXL; bf16* Yo = WSP<bf16>(F, WS_YTC) + (size_t)c * NB * CTXL;
    const int tid = F.tid;
    __syncthreads();
    if (tid < 511) { const int d = tid - 255; Kc[tid] = (d >= 0 ? HFp[(size_t)d * 512 + c] : HBp[(size_t)(-d) * 512 + c]) * il1; }
#pragma unroll
    for (int i = 0; i < 4; ++i) Zs[tid + 512 * i] = bf2f(Z[tid + 512 * i]);
    __syncthreads();
    const int t = tid & 255, b0 = tid >> 8;
    float a[4] = {0.f, 0.f, 0.f, 0.f};
#pragma unroll 4
    for (int s = 0; s < CTXL; ++s) { const float k = Kc[t - s + 255];
#pragma unroll
        for (int i = 0; i < 4; ++i) a[i] += k * Zs[(b0 + 2 * i) * CTXL + s]; }
#pragma unroll
    for (int i = 0; i < 4; ++i) Yo[(b0 + 2 * i) * CTXL + t] = f2bf(a[i]);
}

constexpr int ALD = 72;
#define ATT_TILE_WRITE(Kt_, kk_, vv_) do { LAS bf16* Kt__ = (Kt_); LAS bf16* Vt__ = Kt__ + 64 * ALD; *(LAS u32x4*)(Kt__ + key * ALD + d0) = (kk_); const unsigned vw_[4] = {(vv_).x, (vv_).y, (vv_).z, (vv_).w}; \
        _Pragma("unroll") for (int i_ = 0; i_ < 4; ++i_) { Vt__[(d0 + 2 * i_) * ALD + (key ^ d0)] = (bf16)(vw_[i_] & 0xffffu); Vt__[(d0 + 2 * i_ + 1) * ALD + (key ^ d0)] = (bf16)(vw_[i_] >> 16); } } while (0)
__device__ __forceinline__ void attn_unit(Frame& F, int l, int unit, int& ckey, int& wq) {
    const bf16* P = WSP<bf16>(F, WS_P);
    LAS bf16* T0 = (LAS bf16*)F.lds;
    const bool isctx = unit >= 1024;
    int b, kvh, qb;
    if (!isctx) { const int rd = unit >> 8, r = unit & 255; b = r >> 5; kvh = (r >> 4) & 1; qb = 4 * (r & 15) + rd; } else { const int it = unit - 1024; b = it >> 3; kvh = (it >> 2) & 1; qb = it & 3; }
    int tid = F.tid; asm volatile("" : "+v"(tid));
    const int lane = tid & 63, w = F.wave, g = w >> 1, h = kvh * 4 + g, lg = lane >> 4, lc = lane & 15;
    const int start = qb * 64, q0 = start + (w & 1) * 32;
    const int rowq0 = isctx ? (NLAT + b * CTXL + q0) : (b * SEQ + q0);
    bf16x8 bq[2][2];
#pragma unroll
    for (int qt = 0; qt < 2; ++qt)
#pragma unroll
        for (int ks = 0; ks < 2; ++ks) bq[qt][ks] = *(const bf16x8*)(P + (size_t)(rowq0 + 16 * qt + lc) * INC + C_AQ + h * 64 + 32 * ks + 8 * lg);
    const float sink = IN_(F, 9)[l * 8 + h];
    float mrun[2], lsum[2]; f32x4 o[4][2];
#pragma unroll
    for (int qt = 0; qt < 2; ++qt) { mrun[qt] = sink * 1.4426950408889634f; lsum[qt] = (lg == 0) ? 1.0f : 0.0f;
#pragma unroll
        for (int dt = 0; dt < 4; ++dt) o[dt][qt] = (f32x4){0.f, 0.f, 0.f, 0.f}; }
    const int key = tid >> 3, d0 = (tid & 7) * 8;
    const size_t kcol = (size_t)C_AK + kvh * 64 + d0, vcol = (size_t)C_AV + kvh * 64 + d0;
    const int ck = b * 2 + kvh;
    const int klo = (qb >= 2) ? qb - 2 : 0, khi = (qb + 2 <= SEQ / 64 - 1) ? qb + 2 : SEQ / 64 - 1, nwin = isctx ? 0 : khi - klo + 1;
    const bool res = !isctx && (ckey == ck) && (wq == qb - 1);
    u32x4 kk = (u32x4){0u, 0u, 0u, 0u}, vv = kk;
    if (nwin == 5) { const size_t row = (size_t)(b * SEQ + khi * 64 + key); kk = *(const u32x4*)(P + row * INC + kcol); vv = *(const u32x4*)(P + row * INC + vcol); }
    {
        const bool cfill = (ckey != ck);
        bool wneed[4]; bool any = cfill;
#pragma unroll
        for (int j = 0; j < 4; ++j) { const int k = klo + j; wneed[j] = !isctx && (k <= khi) && !(res && k <= qb + 1); any = any || wneed[j]; }
        if (any) {
            u32x4 ckv[4], cvv[4], wkv[4], wvv[4];
            if (cfill) {
#pragma unroll
                for (int j = 0; j < 4; ++j) { const size_t row = (size_t)(NLAT + b * CTXL + j * 64 + key); ckv[j] = *(const u32x4*)(P + row * INC + kcol); cvv[j] = *(const u32x4*)(P + row * INC + vcol); } }
#pragma unroll
            for (int j = 0; j < 4; ++j) if (wneed[j]) { const size_t row = (size_t)(b * SEQ + (klo + j) * 64 + key); wkv[j] = *(const u32x4*)(P + row * INC + kcol); wvv[j] = *(const u32x4*)(P + row * INC + vcol); }
            __syncthreads();
            if (cfill) {
#pragma unroll
                for (int j = 0; j < 4; ++j) ATT_TILE_WRITE(T0 + (8 + 2 * j) * 64 * ALD, ckv[j], cvv[j]); }
#pragma unroll
            for (int j = 0; j < 4; ++j) if (wneed[j]) ATT_TILE_WRITE(T0 + (2 * ((klo + j) & 3)) * 64 * ALD, wkv[j], wvv[j]);
            __syncthreads();
            ckey = ck;
        }
    }
#pragma unroll 1
    for (int i = 0; i < nwin + 4; ++i) {
        const bool ctxblk = i >= nwin;
        const int kblk = klo + i;
        if (i == 1 && nwin == 5) {
            __syncthreads();
            ATT_TILE_WRITE(T0 + (2 * (khi & 3)) * 64 * ALD, kk, vv);
            __syncthreads();
        }
        const LAS bf16* Kb = ctxblk ? (T0 + (8 + 2 * (i - nwin)) * 64 * ALD) : (T0 + (2 * (kblk & 3)) * 64 * ALD); const LAS bf16* Vt = Kb + 64 * ALD;
        const bool domask = !ctxblk && (kblk == qb - 2 || kblk == qb + 2);
        f32x4 s[4][2];
        bf16x8 kf[4][2];
#pragma unroll
        for (int kt = 0; kt < 4; ++kt) { kf[kt][0] = *(const LAS bf16x8*)(Kb + (16 * kt + lc) * ALD + 8 * lg); kf[kt][1] = *(const LAS bf16x8*)(Kb + (16 * kt + lc) * ALD + 32 + 8 * lg); }
        __builtin_amdgcn_sched_barrier(0);
#pragma unroll
        for (int kt = 0; kt < 4; ++kt)
#pragma unroll
            for (int qt = 0; qt < 2; ++qt) { f32x4 c = (f32x4){0.f, 0.f, 0.f, 0.f};
                c = __builtin_amdgcn_mfma_f32_16x16x32_bf16(kf[kt][0], bq[qt][0], c, 0, 0, 0); c = __builtin_amdgcn_mfma_f32_16x16x32_bf16(kf[kt][1], bq[qt][1], c, 0, 0, 0);
                s[kt][qt] = c; }
        if (domask) {
#pragma unroll
            for (int kt = 0; kt < 4; ++kt)
#pragma unroll
                for (int qt = 0; qt < 2; ++qt)
#pragma unroll
                    for (int r = 0; r < 4; ++r) { const int kpos = kblk * 64 + 16 * kt + 4 * lg + r, qpos = q0 + 16 * qt + lc, dd = qpos - kpos;
                        const bool valid = (kpos >= 0) && (kpos < SEQ) && (dd <= 128) && (dd >= -128);
                        s[kt][qt][r] = valid ? s[kt][qt][r] : -1.0e30f; }
        }
        bf16x8 pf[2][2];
#pragma unroll
        for (int qt = 0; qt < 2; ++qt) {
            float bm = -3.0e38f;
#pragma unroll
            for (int kt = 0; kt < 4; ++kt) bm = fmaxf(bm, fmaxf(fmaxf(s[kt][qt][0], s[kt][qt][1]), fmaxf(s[kt][qt][2], s[kt][qt][3])));
            bm = fmaxf(bm, __shfl_xor(bm, 16)); bm = fmaxf(bm, __shfl_xor(bm, 32));
            const float KS = 0.125f * 1.4426950408889634f;
            const float mold = mrun[qt], mnew = fmaxf(mold, bm * KS);
            mrun[qt] = mnew;
            float ps = 0.f; unsigned pw[8];
#pragma unroll
            for (int kt = 0; kt < 4; ++kt) { const float p0 = __builtin_amdgcn_exp2f(fmaf(s[kt][qt][0], KS, -mnew)), p1 = __builtin_amdgcn_exp2f(fmaf(s[kt][qt][1], KS, -mnew)), p2 = __builtin_amdgcn_exp2f(fmaf(s[kt][qt][2], KS, -mnew)), p3 = __builtin_amdgcn_exp2f(fmaf(s[kt][qt][3], KS, -mnew));
                ps += (p0 + p1) + (p2 + p3); pw[2 * kt] = pk2(p0, p1); pw[2 * kt + 1] = pk2(p2, p3); }
            if (__any(mnew > mold)) {
                const float sc = __builtin_amdgcn_exp2f(mold - mnew);
                lsum[qt] = lsum[qt] * sc;
#pragma unroll
                for (int dt = 0; dt < 4; ++dt) o[dt][qt] = o[dt][qt] * sc; }
            lsum[qt] += ps;
            u32x4 f0; f0.x = pw[0]; f0.y = pw[1]; f0.z = pw[2]; f0.w = pw[3];
            u32x4 f1; f1.x = pw[4]; f1.y = pw[5]; f1.z = pw[6]; f1.w = pw[7];
            pf[qt][0] = __builtin_bit_cast(bf16x8, f0); pf[qt][1] = __builtin_bit_cast(bf16x8, f1);
        }
        bf16x8 vfr[4][2];
#pragma unroll
        for (int dt = 0; dt < 4; ++dt)
#pragma unroll
            for (int ks = 0; ks < 2; ++ks) {
                const int vsw = ((16 * dt + lc) >> 3) << 3;
                const u32x2 a0 = *(const LAS u32x2*)(Vt + (16 * dt + lc) * ALD + ((32 * ks + 4 * lg) ^ vsw)), a1 = *(const LAS u32x2*)(Vt + (16 * dt + lc) * ALD + ((32 * ks + 16 + 4 * lg) ^ vsw));
                u32x4 av; av.x = a0.x; av.y = a0.y; av.z = a1.x; av.w = a1.y;
                vfr[dt][ks] = __builtin_bit_cast(bf16x8, av); }
        __builtin_amdgcn_sched_barrier(0);
#pragma unroll
        for (int dt = 0; dt < 4; ++dt)
#pragma unroll
            for (int ks = 0; ks < 2; ++ks)
#pragma unroll
                for (int qt = 0; qt < 2; ++qt) o[dt][qt] = __builtin_amdgcn_mfma_f32_16x16x32_bf16(vfr[dt][ks], pf[qt][ks], o[dt][qt], 0, 0, 0);
    }
    wq = isctx ? -100 : qb;
    bf16* ATT = WSP<bf16>(F, WS_RET) + 512;
#pragma unroll
    for (int qt = 0; qt < 2; ++qt) {
        float lt = lsum[qt]; lt += __shfl_xor(lt, 16); lt += __shfl_xor(lt, 32);
        const float inv = 1.0f / lt;
        bf16* rowp = ATT + (size_t)(rowq0 + 16 * qt + lc) * 1536 + h * 64;
#pragma unroll
        for (int dp = 0; dp < 2; ++dp) {
            const unsigned ax = pk2s(o[2 * dp][qt][0] * inv, o[2 * dp][qt][1] * inv), ay = pk2s(o[2 * dp][qt][2] * inv, o[2 * dp][qt][3] * inv);
            const unsigned bx_ = pk2s(o[2 * dp + 1][qt][0] * inv, o[2 * dp + 1][qt][1] * inv), by_ = pk2s(o[2 * dp + 1][qt][2] * inv, o[2 * dp + 1][qt][3] * inv);
            const auto sx = __builtin_amdgcn_permlane16_swap(ax, bx_, false, false), sy = __builtin_amdgcn_permlane16_swap(ay, by_, false, false);
            u32x4 wv; wv.x = sx[0]; wv.y = sy[0]; wv.z = sx[1]; wv.w = sy[1];
            *(u32x4*)(rowp + 16 * (2 * dp + (lg & 1)) + 8 * (lg >> 1)) = wv; }
    }
}

__device__ __forceinline__ void ph_norm2_router(Frame& F, int l, int nrows) {
    const int lane = F.lane, RPB = nrows / 256;
    LAS float* RW = (LAS float*)F.lds;
    LAS unsigned* cnt = (LAS unsigned*)(F.lds + LDSX + 64);
    __syncthreads();
    { const float* rw = IN_(F, 24) + (size_t)l * 1024 * 32;
#pragma unroll 1
      for (int i0 = F.tid; i0 < 1024 * 32 / 4; i0 += 8 * NTHR) { f32x4 t8[8];
#pragma unroll
          for (int k = 0; k < 8; ++k) t8[k] = *(const f32x4*)(rw + 4 * (i0 + k * NTHR));
          __builtin_amdgcn_sched_barrier(0);
#pragma unroll
          for (int k = 0; k < 8; ++k) { const int i = i0 + k * NTHR, col = i >> 3, ch = i & 7, ll = (col >> 2) & 63, ridx = ((col & 3) * 4 + (col >> 8)) * 64 + ll;
              *(LAS f32x4*)(RW + ridx * 32 + ((ch ^ ((ll >> 1) & 7)) << 2)) = t8[k]; } } }
    if (F.tid < 32) cnt[F.tid] = 0u;
    { int* SRC = WSP<int>(F, WS_SRC); for (int i = F.bx * NTHR + F.tid; i < MPAD; i += F.G * NTHR) SRC[i] = 0; }
    __syncthreads();
    const float* xm_all = WSP<float>(F, WS_XM);
    const float* gw_ = IN_(F, 23) + l * DM;
    const int e = lane >> 1, sw = (lane >> 1) & 7;
    const float rb = IN_(F, 25)[l * 32 + e];
    int* TOPI = WSP<int>(F, WS_TOPI); float* TOPW = WSP<float>(F, WS_TOPW);
    typedef float f32x2 __attribute__((ext_vector_type(2)));
    f32x4 vnext[2][4];
    { const float* xr0 = xm_all + (size_t)(F.bx * RPB + 2 * F.wave) * DM;
#pragma unroll
      for (int t = 0; t < 2; ++t)
#pragma unroll
        for (int j = 0; j < 4; ++j) vnext[t][j] = *(const f32x4*)(xr0 + t * DM + 4 * lane + 256 * j); }
#pragma unroll 1
    for (int rr = 2 * F.wave; rr < RPB; rr += 2 * NWAVES) {
        const int r = F.bx * RPB + rr, mr = modrow_of(r);
        f32x4 shq[4], aq[4];
        { const float* sh = mod_ptr(F, l, mr, 3); const float* sc = mod_ptr(F, l, mr, 4); f32x4 gq_[4], sc_[4];
#pragma unroll
          for (int j = 0; j < 4; ++j) { shq[j] = *(const f32x4*)(sh + 4 * lane + 256 * j); gq_[j] = *(const f32x4*)(gw_ + 4 * lane + 256 * j); sc_[j] = *(const f32x4*)(sc + 4 * lane + 256 * j); }
          __builtin_amdgcn_sched_barrier(0);
#pragma unroll
          for (int j = 0; j < 4; ++j) aq[j] = gq_[j] * (sc_[j] + 1.0f); }
        f32x4 v[2][4]; float ss[2] = {0.f, 0.f};
#pragma unroll
        for (int t = 0; t < 2; ++t)
#pragma unroll
            for (int j = 0; j < 4; ++j) { v[t][j] = vnext[t][j]; ss[t] += (v[t][j][0] * v[t][j][0] + v[t][j][1] * v[t][j][1]) + (v[t][j][2] * v[t][j][2] + v[t][j][3] * v[t][j][3]); }
        const float* xn = xm_all + (size_t)((rr + 2 * NWAVES < RPB) ? r + 2 * NWAVES : r) * DM;
#pragma unroll
        for (int t = 0; t < 2; ++t) {
            const float rstd = 1.0f / sqrtf(wave_sum(ss[t]) * (1.0f / DM) + EPS);
            bf16* o = WSP<bf16>(F, WS_XN) + (size_t)(r + t) * DM;
            u32x2 pw[4];
#pragma unroll
            for (int j = 0; j < 4; ++j) { v[t][j] = v[t][j] * rstd * aq[j] + shq[j]; pw[j].x = pk2(v[t][j][0], v[t][j][1]); pw[j].y = pk2(v[t][j][2], v[t][j][3]); }
            store_row_bf16(o, lane, pw); }
        f32x2 acc[2][16];
#pragma unroll
        for (int t = 0; t < 2; ++t)
#pragma unroll
            for (int i = 0; i < 16; ++i) acc[t][i] = (f32x2){0.f, 0.f};
        f32x4 wa[8], wb[8];
#define RT_LOAD(W, c) { const int j_ = (c) >> 2, q_ = (c) & 3, ri_ = (q_ * 4 + j_) * 64 + lane; \
            _Pragma("unroll") for (int c8 = 0; c8 < 8; ++c8) W[c8] = *(const LAS f32x4*)(RW + ri_ * 32 + ((c8 ^ sw) << 2)); }
#define RT_FMA(W, c) { const int j_ = (c) >> 2, q_ = (c) & 3; const float h0 = v[0][j_][q_], h1 = v[1][j_][q_]; const f32x2 hh0 = {h0, h0}, hh1 = {h1, h1}; \
            _Pragma("unroll") for (int c8 = 0; c8 < 8; ++c8) { acc[0][2 * c8] += hh0 * W[c8].lo; acc[0][2 * c8 + 1] += hh0 * W[c8].hi; acc[1][2 * c8] += hh1 * W[c8].lo; acc[1][2 * c8 + 1] += hh1 * W[c8].hi; } }
        RT_LOAD(wa, 0)
#pragma unroll
        for (int c = 0; c < 16; c += 2) {
            RT_LOAD(wb, c + 1)
            __builtin_amdgcn_sched_barrier(0);
            RT_FMA(wa, c)
            __builtin_amdgcn_sched_barrier(0);
            if (c + 2 < 16) RT_LOAD(wa, c + 2)
            __builtin_amdgcn_sched_barrier(0);
            RT_FMA(wb, c + 1)
            __builtin_amdgcn_sched_barrier(0);
            if ((c & 3) == 2) { const int jj = c >> 2;
#pragma unroll
                for (int t = 0; t < 2; ++t) vnext[t][jj] = *(const f32x4*)(xn + t * DM + 4 * lane + 256 * jj);
                __builtin_amdgcn_sched_barrier(0); }
        }
#undef RT_LOAD
#undef RT_FMA
#pragma unroll
        for (int i = 0; i < 16; ++i) asm volatile("" : "+v"(acc[1][i]));
#pragma unroll
        for (int t = 0; t < 2; ++t) {
        float r16[16], r8[8], r4[4], r2[2];
#pragma unroll
        for (int i = 0; i < 16; ++i) { const auto sw2 = __builtin_amdgcn_permlane32_swap(__float_as_uint(acc[t][i >> 1][i & 1]), __float_as_uint(acc[t][8 + (i >> 1)][i & 1]), false, false);
            r16[i] = __uint_as_float(sw2[0]) + __uint_as_float(sw2[1]); }
#pragma unroll
        for (int i = 0; i < 8; ++i) { const auto sw2 = __builtin_amdgcn_permlane16_swap(__float_as_uint(r16[i]), __float_as_uint(r16[8 + i]), false, false);
            r8[i] = __uint_as_float(sw2[0]) + __uint_as_float(sw2[1]); }
#define RT_DPP(old, v, ctrl, bm) __int_as_float(__builtin_amdgcn_update_dpp(__float_as_int(old), __float_as_int(v), (ctrl), 0xF, (bm), false))
        { const bool hi = (lane & 8) != 0;
#pragma unroll
          for (int i = 0; i < 4; ++i) { const float a = r8[i], b = r8[4 + i]; const float u = RT_DPP(RT_DPP(0.f, a, 0x128, 0x3), b, 0x128, 0xC); r4[i] = (hi ? b : a) + u; } }
        { const bool hi = (lane & 4) != 0;
#pragma unroll
          for (int i = 0; i < 2; ++i) { const float a = r4[i], b = r4[2 + i]; const float u = RT_DPP(RT_DPP(0.f, a, 0x12C, 0x5), b, 0x124, 0xA); r2[i] = (hi ? b : a) + u; } }
        float logit;
        { const bool hi = (lane & 2) != 0; const float keep = hi ? r2[1] : r2[0], send = hi ? r2[0] : r2[1]; logit = keep + RT_DPP(0.f, send, 0x4E, 0xF); }
        logit += RT_DPP(0.f, logit, 0xB1, 0xF);
#undef RT_DPP
        logit += rb;
        int rank = 0;
#pragma unroll
        for (int q = 0; q < 32; ++q) { const float lq = rdlane(logit, 2 * q); rank += (lq > logit) ? 1 : 0; }
        { const bool ev = (lane & 1) == 0;
          const bool uniq = __builtin_popcountll(__ballot(ev && rank == 0)) == 1 && __builtin_popcountll(__ballot(ev && rank == 1)) == 1 && __builtin_popcountll(__ballot(ev && rank == 2)) == 1 && __builtin_popcountll(__ballot(ev && rank == 3)) == 1;
          if (!uniq) { rank = 0;
#pragma unroll 1
              for (int q = 0; q < 32; ++q) { const float lq = rdlane(logit, 2 * q); rank += (lq > logit || (lq == logit && q < e)) ? 1 : 0; } } }
        const bool sel = (rank < 4) && ((lane & 1) == 0);
        const unsigned long long m0 = __ballot(sel && rank == 0), m1 = __ballot(sel && rank == 1), m2 = __ballot(sel && rank == 2), m3 = __ballot(sel && rank == 3);
        const int l0 = __builtin_ctzll(m0), l1 = __builtin_ctzll(m1), l2 = __builtin_ctzll(m2), l3 = __builtin_ctzll(m3);
        const float t0 = rdlane(logit, l0), t1 = rdlane(logit, l1), t2 = rdlane(logit, l2), t3 = rdlane(logit, l3);
        const float e1 = __expf(t1 - t0), e2 = __expf(t2 - t0), e3 = __expf(t3 - t0), inv = 1.0f / (1.0f + e1 + e2 + e3);
        if (lane < 4) { const int id = ((lane == 0) ? l0 : (lane == 1) ? l1 : (lane == 2) ? l2 : l3) >> 1; const float wv = ((lane == 0) ? 1.0f : (lane == 1) ? e1 : (lane == 2) ? e2 : e3) * inv;
            TOPI[(r + t) * 4 + lane] = id; TOPW[(r + t) * 4 + lane] = wv; __hip_atomic_fetch_add(cnt + id, 1u, __ATOMIC_RELAXED, __HIP_MEMORY_SCOPE_WORKGROUP); }
        }
    }
    __syncthreads();
    if (F.tid < 32) WSP<int>(F, WS_BLKCNT)[F.bx * 32 + F.tid] = (int)cnt[F.tid];
}

__device__ __forceinline__ void ph_moe_assign(Frame& F, int nrows) {
    const int RPB = nrows / 256, lane = F.lane;
    LAS int* part = (LAS int*)F.lds;
    LAS int* base = part + 1024;
    LAS int* idx = base + 32;
    LAS int* posl = idx + 1024;
    const int* BC = WSP<int>(F, WS_BLKCNT);
    __syncthreads();
    { const int e = F.tid & 31, pt = F.tid >> 5; int st = 0, sp = 0;
      for (int q = 0; q < 16; ++q) { const int blk = pt * 16 + q; const int v = BC[blk * 32 + e]; st += v; if (blk < F.bx) sp += v; }
      part[pt * 32 + e] = st; part[512 + pt * 32 + e] = sp; }
    for (int i = F.tid; i < RPB * 4; i += NTHR) idx[i] = WSP<int>(F, WS_TOPI)[F.bx * RPB * 4 + i];
    __syncthreads();
    if (F.tid < 32) { int st = 0, sp = 0; for (int q = 0; q < 16; ++q) { st += part[q * 32 + F.tid]; sp += part[512 + q * 32 + F.tid]; }
        part[F.tid] = st; part[512 + F.tid] = sp; }
    __syncthreads();
    if (F.tid == 0) { int t0 = 0; int* tl = WSP<int>(F, WS_TILES);
        for (int e = 0; e < 32; ++e) { base[e] = t0 * 256 + part[512 + e]; if (F.bx == 0) tl[e] = t0; t0 += (part[e] + 255) >> 8; }
        if (F.bx == 0) tl[32] = t0; }
    __syncthreads();
    LAS int* cc = posl + 1024;
    const int nent = RPB * 4;
    for (int ch = F.wave; ch * 64 < nent; ch += NWAVES) { const int j = ch * 64 + lane; const int my = (j < nent) ? idx[j] : -1; int rk = 0, cnte = 0;
#pragma unroll
        for (int e = 0; e < 32; ++e) { const unsigned long long m = __ballot(my == e); const int below = __builtin_amdgcn_mbcnt_hi((unsigned)(m >> 32), __builtin_amdgcn_mbcnt_lo((unsigned)m, 0));
            if (my == e) rk = below; if (lane == e) cnte = __builtin_popcountll(m); }
        if (lane < 32) cc[ch * 32 + lane] = cnte;
        if (j < nent) posl[j] = rk; }
    __syncthreads();
    for (int j = F.tid; j < nent; j += NTHR) { const int e = idx[j], ch = j >> 6; int p = base[e] + posl[j]; for (int q = 0; q < ch; ++q) p += cc[q * 32 + e]; posl[j] = p; }
    __syncthreads();
    int* POS = WSP<int>(F, WS_POS); int* SRC = WSP<int>(F, WS_SRC);
    for (int j = F.tid; j < RPB * 4; j += NTHR) { const int p = posl[j]; POS[F.bx * RPB * 4 + j] = p; SRC[p] = F.bx * RPB + (j >> 2); }
}

#define PHASE_FN __device__ __forceinline__
#ifndef MK_STAG_G
#define MK_STAG_G 1
#endif
#ifndef MK_STAG_US
#define MK_STAG_US 12
#endif
__device__ __forceinline__ void phase_stagger(const Frame& F) {
    if (MK_STAG_G > 1) { const int grp = (F.bx >> 3) % MK_STAG_G;
        if (grp) { const unsigned long long t0 = __builtin_amdgcn_s_memrealtime(), dt = (unsigned long long)(grp * MK_STAG_US * 100 / MK_STAG_G);
            while (__builtin_amdgcn_s_memrealtime() - t0 < dt) __builtin_amdgcn_s_sleep(32); } }
}
PHASE_FN void P_prologue() {
#pragma unroll 1
    for (int s = 0; s < 2; ++s) { Frame F = make_frame(); const int flip = (F.bx >> 3) & 1;
        if ((s ^ flip) == 0) p0_prologue(F); else p0_filters(F);
        __syncthreads(); } }
PHASE_FN void P_norm1(int mode) {
#pragma unroll 1
    for (int s = 0; s < 2; ++s) { Frame F = make_frame();
        const int flip = (mode == 0) ? ((F.bx >> 3) & 1) : 0;
        if ((s ^ flip) == 0) ph_norm1(F, mode);
        else if (mode == 0) { FftTw T; fft_tw_init(T, F.tid); for (int it = F.bx; it < 512; it += F.G) fft_filter_unit(F, T, 0, it); } } }
PHASE_FN void P_inproj(int l) { Frame F = make_frame(); phase_stagger(F);
    pg8::Gemm g{WSP<bf16>(F, WS_XN), WSP<bf16>(F, WS_WIN) + (size_t)l * INC * 1024, NROWS, INC, 1024};
    pg8::StaticOrder S; S.init(NROWS, INC, F.G, F.bx);
    EpiP E{WSP<bf16>(F, WS_P), IN_(F, 21) + l * 3072};
    pg8::gemm_phase<EpiP, pg8::StaticOrder, true, true>(F.lds, g, S, E);
    if (l == 0 && F.bx >= F.G - 8) hy_filter_item(F, 2, F.bx - (F.G - 8));
    if (l == 0 && F.bx >= 104) tr_deferred(F, 0, 5400, F.bx - 104, 152);
    if (l == 1 && F.bx >= 104) { FftTw T; fft_tw_init(T, F.tid); for (int it = F.bx - 104; it < 512; it += 152) fft_filter_unit(F, T, 1, it); } }
#ifndef MK_REP2
#define MK_REP2 0u
#endif
PHASE_FN void P_mix(int l) { Frame F = make_frame(); const bool last = (l == 1);
    const int na = last ? 1024 : 1088;
    for (int rep = 0; rep < ((MK_REP2 & 1u) ? 2 : 1); ++rep)
    { int ckey = -1, wq = -100; for (int it = F.bx; it < na; it += F.G) attn_unit(F, l, it, ckey, wq); }
    for (int rep = 0; rep < ((MK_REP2 & 2u) ? 2 : 1); ++rep)
    for (int it = F.G - 1 - F.bx; it < 1088; it += F.G) ret_kv_unit(F, l, it);
    for (int rep = 0; rep < ((MK_REP2 & 4u) ? 2 : 1); ++rep) ph_hyprep2(F, l, !last); }

PHASE_FN void P_hyconv(int l) { const bool last = (l == 1);
#pragma unroll 1
    for (int s = 0; s < 2; ++s) { Frame F = make_frame(); const int flip = (F.bx >> 3) & 1;
        if ((s ^ flip) == 0) ret_scan(F, l);
        else { FftTw T; fft_tw_init(T, F.tid); unsigned zpa[8], zpb[8];
#define HYC_UA(k_) ((F.bx + F.G * ((k_) >> 1)) * 4 + 2 * ((k_) & 1))
          fft_zfetch(F, HYC_UA(0), F.tid, zpa); fft_zfetch(F, HYC_UA(0) + 1, F.tid, zpb);
          for (int k = 0; k < 4; ++k) { const int ua = HYC_UA(k), kn = (k + 1 < 4) ? k + 1 : 0, na = HYC_UA(kn);
              fft_conv_pair(F, T, l, ua, ua + 1, na, na + 1, zpa, zpb); }
#undef HYC_UA
        } }
    if (!last) { Frame F = make_frame(); for (int it = F.bx; it < 512; it += F.G) hyconv_ctx_item2(F, it); } }
PHASE_FN void P_hypost(int l) { const bool last = (l == 1);
#pragma unroll 1
    for (int s = 0; s < 2; ++s) { Frame F = make_frame(); const int flip = (F.bx >> 3) & 1;
        if ((s ^ flip) == 0) { for (int it = F.bx; it < 1088; it += F.G) { const int ci = it % 34; if (last && ci < 2) continue; ret_out_unit(F, l, it); } }
        else ph_hypost2(F, l, !last); } }
PHASE_FN void P_merge(int l) { Frame F = make_frame(); const int mrows = (l == 1) ? NLAT : NROWS;
    pg8::Gemm g{WSP<bf16>(F, WS_RET), WSP<bf16>(F, WS_WBR) + (size_t)l * 1024 * 1536, mrows, 1024, 1536};
    pg8::StaticOrder S; S.init(mrows, 1024, F.G, F.bx);
    EpiMerge E{WSP<bf16>(F, WS_P), WSP<bf16>(F, WS_M)};
    pg8::gemm_phase<EpiMerge, pg8::StaticOrder, true, true>(F.lds, g, S, E);
    if (l == 0 && F.bx >= 32) tr_deferred(F, 5400, 11300, F.bx - 32, 224); }
PHASE_FN void P_out(int l) { Frame F = make_frame(); const int mrows = (l == 1) ? NLAT : NROWS;
    pg8::Gemm g{WSP<bf16>(F, WS_M), WSP<bf16>(F, WS_WOUT) + (size_t)l * 1024 * 1024, mrows, 1024, 1024};
    pg8::StaticOrder S; S.init(mrows, 1024, F.G, F.bx);
    const float* xl = (l == 0) ? IN_(F, 0) : WSP<float>(F, WS_XO);
    const float* xc = (l == 0) ? IN_(F, 2) : WSP<float>(F, WS_XO) + (size_t)NLAT * DM;
    EpiOut E{xl, xc, mod_ptr(F, l, 0, 2), WSP<float>(F, WS_XM)};
    pg8::gemm_phase<EpiOut, pg8::StaticOrder, true, true>(F.lds, g, S, E);
    if (l == 0 && F.bx >= 32) tr_deferred(F, 16700, TRD_TOTAL - 16700, F.bx - 32, 224); }
PHASE_FN void P_router(int l) { Frame F = make_frame(); ph_norm2_router(F, l, (l == 1) ? NLAT : NROWS); }
PHASE_FN void P_assign(int l) { Frame F = make_frame(); ph_moe_assign(F, (l == 1) ? NLAT : NROWS); }
PHASE_FN void P_moe1(int l) { Frame F = make_frame();
    LAS int* list = (LAS int*)(F.lds + LDSX + 256);
    const int n = moe_list_units(F, 8, list);
    LAS int* srcl = (LAS int*)(F.lds + LDS_SRC);
    { const int* SRC = WSP<int>(F, WS_SRC);
      int sv[12];
#pragma unroll
      for (int k = 0; k < 12; ++k) { const int i = F.tid + k * NTHR; sv[k] = (i < n * 256) ? SRC[list[2 * (i >> 8)] * 256 + (i & 255)] : 0; }
      __builtin_amdgcn_sched_barrier(0);
#pragma unroll
      for (int k = 0; k < 12; ++k) { const int i = F.tid + k * NTHR; if (i < n * 256) srcl[i] = sv[k]; }
      for (int i = F.tid + 12 * NTHR; i < n * 256; i += NTHR) srcl[i] = SRC[list[2 * (i >> 8)] * 256 + (i & 255)]; }
    __syncthreads();
    pg8::Gemm g{WSP<bf16>(F, WS_XN), WSP<bf16>(F, WS_W1) + (size_t)l * 32 * 2048 * 1024, MPAD, 32 * 2048, 1024};
    phase_stagger(F);
    MoeOrderG S{srcl, list, n};
    EpiMoe1 E{IN_(F, 27) + (size_t)l * 32 * 2048, WSP<bf16>(F, WS_ACT)};
    pg8::gemm_phase<EpiMoe1, MoeOrderG, true, true>(F.lds, g, S, E); }
PHASE_FN void P_moe2(int l) { Frame F = make_frame();
    LAS int* list = (LAS int*)(F.lds + LDSX + 256);
    const int n = moe_list_units(F, 4, list, true);
    pg8::Gemm g{WSP<bf16>(F, WS_ACT), WSP<bf16>(F, WS_W2) + (size_t)l * 32 * 1024 * 1024, MPAD, 32 * 1024, 1024};
    phase_stagger(F);
    MoeOrder S{nullptr, list, n};
    EpiMoe2 E{IN_(F, 29) + (size_t)l * 32 * 1024, WSP<bf16>(F, WS_HS)};
    pg8::gemm_phase<EpiMoe2, MoeOrder, true, true>(F.lds, g, S, E); }

template <int ONLY> __global__ void __launch_bounds__(NTHR, 2) mk_fwd(Args args) {
    LAS unsigned char* lds = (LAS unsigned char*)lds_raw;
    const int tid = threadIdx.x;
    for (int u = tid; u < (LDS_BYTES - LDSX) / 4; u += NTHR) ((LAS unsigned*)(lds + LDSX))[u] = 0u;
    __syncthreads();
    if (tid < 33) { const unsigned long long v = (tid < 31) ? (unsigned long long)args.in[tid] : (tid == 31 ? (unsigned long long)args.out : (unsigned long long)args.ws);
        *(LAS unsigned long long*)(lds + LDS_PTAB + 8 * tid) = v; }
    __syncthreads();
    const int lo = args.ph_lo, hi = args.ph_hi;
    const bool one_launch = (hi - lo) > 1;
    unsigned* barw = (unsigned*)(args.ws + WS_CTL + CTL_BAR);
    XcdBarrier bar; bar.bar = barw; bar.x = 0; bar.st = nullptr;
    if (one_launch) bar = xcd_barrier_post(barw, (volatile LAS unsigned*)(lds + LDSX));
#ifndef MK_MASK
#define MK_MASK 0xFFFFFFFFu
#endif
#define ENAB(k) ((ONLY < 0 && ((MK_MASK >> ((k) >= 100 ? (k) - 100 + 14 : (k))) & 1u)) || ONLY == (k))
#ifndef MK_REP
#define MK_REP 0u
#endif
#define REPB(k) (((MK_REP) >> ((k) >= 100 ? (k) - 100 + 14 : (k))) & 1u)
#define IN(k) (lo <= (k) && (k) < hi)
#define SEAM(k) do { if (IN(k) && IN((k) + 1)) xcd_barrier(bar); } while (0)
    if (ENAB(100)) if (IN(0)) { P_prologue(); if (REPB(100)) { xcd_barrier(bar); P_prologue(); } } SEAM(0);
    for (int l = 0; l < 2; ++l) {
        const int pb = 1 + NPH_LAYER * l;
        if (ENAB(0)) if (IN(pb + 0)) { P_norm1(l == 0 ? 0 : 1); if (REPB(0)) { xcd_barrier(bar); P_norm1(l == 0 ? 0 : 1); } } SEAM(pb + 0);
        if (ENAB(1)) if (IN(pb + 1)) { P_inproj(l); if (REPB(1)) { xcd_barrier(bar); P_inproj(l); } } SEAM(pb + 1);
        if (ENAB(3)) if (IN(pb + 3)) { P_mix(l); if (REPB(3)) { xcd_barrier(bar); P_mix(l); } } SEAM(pb + 3);
        if (ENAB(4)) if (IN(pb + 4)) { P_hyconv(l); if (REPB(4)) { xcd_barrier(bar); P_hyconv(l); } } SEAM(pb + 4);
        if (ENAB(5)) if (IN(pb + 5)) { P_hypost(l); if (REPB(5)) { xcd_barrier(bar); P_hypost(l); } } SEAM(pb + 5);
        if (ENAB(6)) if (IN(pb + 6)) { P_merge(l); if (REPB(6)) { xcd_barrier(bar); P_merge(l); } } SEAM(pb + 6);
        if (ENAB(9)) if (IN(pb + 9)) { P_out(l); if (REPB(9)) { xcd_barrier(bar); P_out(l); } } SEAM(pb + 9);
        if (ENAB(10)) if (IN(pb + 10)) { P_router(l); if (REPB(10)) { xcd_barrier(bar); P_router(l); } } SEAM(pb + 10);
        if (ENAB(11)) if (IN(pb + 11)) { P_assign(l); if (REPB(11)) { xcd_barrier(bar); P_assign(l); } } SEAM(pb + 11);
        if (ENAB(12)) if (IN(pb + 12)) { P_moe1(l); if (REPB(12)) { xcd_barrier(bar); P_moe1(l); } } SEAM(pb + 12);
        if (ENAB(13)) if (IN(pb + 13)) { P_moe2(l); if (REPB(13)) { xcd_barrier(bar); P_moe2(l); } } SEAM(pb + 13);
    }
    if (ENAB(101)) if (IN(NPH - 1)) { P_norm1(2); }
#undef IN
#undef SEAM
#undef ENAB
}

template <int ONLY> static void launch_phase(Args a, int lo, int hi, int grid, hipStream_t stream) {
    static bool attr_set = false;
    if (!attr_set) { (void)hipFuncSetAttribute((const void*)mk_fwd<ONLY>, hipFuncAttributeMaxDynamicSharedMemorySize, LDS_BYTES); attr_set = true; }
    a.ph_lo = lo; a.ph_hi = hi;
    hipLaunchKernelGGL(mk_fwd<ONLY>, dim3(grid), dim3(NTHR), LDS_BYTES, stream, a);
}
extern "C" void kernel_launch(void* const* d_in, const int* in_sizes, int n_in, void* d_out, int out_size, void* d_ws, size_t ws_size, hipStream_t stream) {
    static int grid = 0;
    if (grid == 0) {
        if (n_in != 31 || ws_size < WS_END) { fprintf(stderr, "kernel_launch: unexpected n_in %d / ws_size %zu\n", n_in, ws_size); grid = -1; return; }
        int dev = 0, cus = 0;
        if (hipGetDevice(&dev) != hipSuccess || hipDeviceGetAttribute(&cus, hipDeviceAttributeMultiprocessorCount, dev) != hipSuccess) { grid = -1; return; }
        grid = (cus == 256) ? 256 : -1;
        if (grid < 0) { fprintf(stderr, "kernel_launch: needs a 256-CU device, got %d\n", cus); return; }
    }
    if (grid < 0) return;
    (void)hipMemsetAsync((char*)d_ws + WS_CTL, 0, CTL_ZERO_BYTES, stream);
    Args a{};
    for (int i = 0; i < 31; ++i) a.in[i] = (const float*)d_in[i];
    a.out = (float*)d_out; a.ws = (unsigned char*)d_ws;
#if MK_ONE_LAUNCH
    launch_phase<-1>(a, 0, NPH, grid, stream);
#else
    launch_phase<100>(a, 0, 1, grid, stream);
    for (int l = 0; l < 2; ++l) {
        const int pb = 1 + NPH_LAYER * l;
        launch_phase<0>(a, pb + 0, pb + 1, grid, stream);   launch_phase<1>(a, pb + 1, pb + 2, grid, stream);   launch_phase<2>(a, pb + 2, pb + 3, grid, stream);
        launch_phase<3>(a, pb + 3, pb + 4, grid, stream);   launch_phase<4>(a, pb + 4, pb + 5, grid, stream);   launch_phase<5>(a, pb + 5, pb + 6, grid, stream);
        launch_phase<6>(a, pb + 6, pb + 7, grid, stream);   launch_phase<7>(a, pb + 7, pb + 8, grid, stream);   launch_phase<8>(a, pb + 8, pb + 9, grid, stream);
        launch_phase<9>(a, pb + 9, pb + 10, grid, stream);  launch_phase<10>(a, pb + 10, pb + 11, grid, stream); launch_phase<11>(a, pb + 11, pb + 12, grid, stream);
        launch_phase<12>(a, pb + 12, pb + 13, grid, stream); launch_phase<13>(a, pb + 13, pb + 14, grid, stream);
    }
    launch_phase<101>(a, NPH - 1, NPH, grid, stream);
#endif
}
```
